# Optimizing an MI355X kernel written in HIP

```python
import math
import jax, jax.numpy as jnp
from jax import lax
import numpy as np

D_MODEL = 1024
BATCH = 16
SEQ = 256
DEPTH = 4
DEC_BATCH = 8
DEC_SEQ = 4096
PAST_LEN = 256

GRID_W = 64
HEAD_DIM = 64
N_EVEN = (DEPTH + 1) // 2
N_ODD = DEPTH // 2
H_A = D_MODEL // (2 * HEAD_DIM)
WIN_R = 8
WIN_C = 16
H_B = D_MODEL // (2 * HEAD_DIM)
DK_B = HEAD_DIM
DV_B = HEAD_DIM
GLA_RANK = 16
GLA_TAU = 16.0
H_C = D_MODEL // (2 * HEAD_DIM)
KV_C = H_C // 4
WIN_1D = 128
ROPE_BASE = 10000.0
H_D = D_MODEL // (2 * HEAD_DIM)
DK_D = HEAD_DIM
DV_D = HEAD_DIM
SHORT_CONV = 3
CHUNK = 64
Q_BLOCK = 128
D_FF = ((8 * D_MODEL // 3 + 127) // 128) * 128
FFN_CONV = 3
EPS = 1e-6
EV_SIZES = (H_A * HEAD_DIM, H_A * HEAD_DIM, H_A * HEAD_DIM, H_B * DK_B, H_B * DK_B, H_B * DV_B, 2 * GLA_RANK, H_B * DV_B)
OD_SIZES = (H_C * HEAD_DIM, KV_C * HEAD_DIM, KV_C * HEAD_DIM, H_D * DK_D, H_D * DK_D, H_D * DV_D, 2 * H_D, 2 * H_D, H_D * DV_D)
EV_IN = sum(EV_SIZES)
OD_IN = sum(OD_SIZES)
EV_OUT = H_A * HEAD_DIM + H_B * DV_B
OD_OUT = H_C * HEAD_DIM + H_D * DV_D
F32 = jnp.float32

kernel_name = 'hybrid_flow_trunk_step'


def rmsnorm(x, g):
    xf = x.astype(F32)
    y = xf * lax.rsqrt(jnp.mean(xf * xf, axis=-1, keepdims=True) + EPS)
    return (y * g.astype(F32)).astype(x.dtype)


def l2norm(x):
    return x * lax.rsqrt(jnp.sum(x * x, axis=-1, keepdims=True) + EPS)


def split_cols(p, sizes):
    cuts = [int(s) for s in np.cumsum(sizes)[:-1]]
    return jnp.split(p, cuts, axis=-1)


def adaln(cond, w, b):
    return jnp.split(jax.nn.silu(cond) @ w + b, 6, axis=-1)


def modulate(h, shift, scale):
    return h * (1.0 + scale) + shift


def dwconv(x, w):
    K = w.shape[0]
    T = x.shape[1]
    pad = K // 2
    xp = jnp.pad(x, ((0, 0), (pad, pad), (0, 0)))
    out = xp[:, 0:T] * w[0]
    for i in range(1, K):
        out = out + xp[:, i:i + T] * w[i]
    return out


def softmax_sink(s, sink):
    if sink is None:
        return jax.nn.softmax(s, axis=-1)
    m = jnp.maximum(jnp.max(s, axis=-1, keepdims=True), sink)
    e = jnp.exp(s - m)
    return e / (jnp.sum(e, axis=-1, keepdims=True) + jnp.exp(sink - m))


def axial_rope(x):
    T = x.shape[1]
    t = jnp.arange(T)
    half = HEAD_DIM // 2
    quarter = half // 2
    inv = 1.0 / (ROPE_BASE ** (jnp.arange(quarter, dtype=F32) / quarter))

    def rot(xa, pos):
        ang = pos.astype(F32)[:, None] * inv[None, :]
        cos = jnp.cos(ang)[None, :, None, :]
        sin = jnp.sin(ang)[None, :, None, :]
        x1, x2 = xa[..., :quarter], xa[..., quarter:]
        return jnp.concatenate([x1 * cos - x2 * sin, x1 * sin + x2 * cos], axis=-1)

    xf = x.astype(F32)
    out = jnp.concatenate([rot(xf[..., :half], t // GRID_W), rot(xf[..., half:], t % GRID_W)], axis=-1)
    return out.astype(x.dtype)


def dense_attn(q, k, v, sink):
    B, Tq, Hq, Dh = q.shape
    Hk = k.shape[1]
    G = Hq // Hk
    nb = Tq // Q_BLOCK
    qb = q.reshape(B, nb, Q_BLOCK, Hk, G, Dh).swapaxes(0, 1)
    sk = None if sink is None else sink.astype(F32).reshape(Hk, G, 1, 1)
    scale = Dh ** -0.5

    def one(qblk):
        s = jnp.einsum('bqkgd,bksd->bkgqs', qblk, k).astype(F32) * scale
        p = softmax_sink(s, sk).astype(v.dtype)
        return jnp.einsum('bkgqs,bksd->bqkgd', p, v)

    o = lax.map(one, qb)
    return o.swapaxes(0, 1).reshape(B, Tq, Hq, Dh)


def neighborhood_attn(q, k, v, rpb, ck, cv):
    B, T, H, Dh = q.shape
    R = T // GRID_W
    kr = min(WIN_R, R)
    kc = WIN_C
    qg = q.reshape(B, R, GRID_W, H, Dh)
    kg = k.reshape(B, R, GRID_W, H, Dh)
    vg = v.reshape(B, R, GRID_W, H, Dh)
    col = jnp.arange(GRID_W)
    col_idx = jnp.clip(col - kc // 2, 0, GRID_W - kc)[:, None] + jnp.arange(kc)[None, :]
    dc = col_idx - col[:, None] + (WIN_C - 1)
    scale = Dh ** -0.5
    rpb32 = rpb.astype(F32)

    def one(i):
        r0 = jnp.clip(i - kr // 2, 0, R - kr)
        kb = lax.dynamic_slice_in_dim(kg, r0, kr, axis=1)[:, :, col_idx]
        vb = lax.dynamic_slice_in_dim(vg, r0, kr, axis=1)[:, :, col_idx]
        qi = lax.dynamic_index_in_dim(qg, i, axis=1, keepdims=False)
        dr = r0 + jnp.arange(kr) - i + (WIN_R - 1)
        bias = rpb32[:, dr[None, :, None], dc[:, None, :]]
        s_loc = jnp.einsum('bwhd,brwchd->bhwrc', qi, kb).astype(F32) * scale + bias
        s_loc = s_loc.reshape(B, H, GRID_W, kr * kc)
        s_ctx = jnp.einsum('bwhd,bhld->bhwl', qi, ck).astype(F32) * scale
        p = jax.nn.softmax(jnp.concatenate([s_loc, s_ctx], axis=-1), axis=-1).astype(v.dtype)
        p_loc = p[..., :kr * kc].reshape(B, H, GRID_W, kr, kc)
        return (jnp.einsum('bhwrc,brwchd->bwhd', p_loc, vb)
                + jnp.einsum('bhwl,bhld->bwhd', p[..., kr * kc:], cv))

    o = lax.map(one, jnp.arange(R))
    return o.swapaxes(0, 1).reshape(B, T, H, Dh)


def window_attn(q, k, v, sink, ck, cv):
    B, T, Hq, Dh = q.shape
    Hk = k.shape[2]
    G = Hq // Hk
    blk = Q_BLOCK
    nb = T // blk
    pad = ((0, 0), (blk, blk), (0, 0), (0, 0))
    kp = jnp.pad(k, pad)
    vp = jnp.pad(v, pad)
    sk = sink.astype(F32).reshape(1, Hk, G, 1, 1)
    scale = Dh ** -0.5

    def one(n):
        q0 = n * blk
        qn = lax.dynamic_slice_in_dim(q, q0, blk, axis=1).reshape(B, blk, Hk, G, Dh)
        kn = lax.dynamic_slice_in_dim(kp, q0, 3 * blk, axis=1)
        vn = lax.dynamic_slice_in_dim(vp, q0, 3 * blk, axis=1)
        qpos = q0 + jnp.arange(blk)
        kpos = q0 - blk + jnp.arange(3 * blk)
        valid = ((jnp.abs(kpos[None, :] - qpos[:, None]) <= WIN_1D)
                 & (kpos >= 0)[None, :] & (kpos < T)[None, :])
        s_loc = jnp.einsum('bqkgd,bskd->bkgqs', qn, kn).astype(F32) * scale
        s_loc = jnp.where(valid, s_loc, -jnp.inf)
        s_ctx = jnp.einsum('bqkgd,bksd->bkgqs', qn, ck).astype(F32) * scale
        p = softmax_sink(jnp.concatenate([s_loc, s_ctx], axis=-1), sk).astype(v.dtype)
        o = (jnp.einsum('bkgqs,bskd->bqkgd', p[..., :3 * blk], vn)
             + jnp.einsum('bkgqs,bksd->bqkgd', p[..., 3 * blk:], cv))
        return o.reshape(B, blk, Hq, Dh)

    o = lax.map(one, jnp.arange(nb))
    return o.swapaxes(0, 1).reshape(B, T, Hq, Dh)


def gla_scan(q, k, v, g, s0):
    B, T, H, dk = q.shape
    dv = v.shape[-1]
    n = T // CHUNK
    q, k, v, g = [a.reshape(B, n, CHUNK, H, a.shape[-1]) for a in (q, k, v, g)]
    G = jnp.cumsum(g, axis=2)
    G_last = G[:, :, -1:]
    q_t = q * jnp.exp(G)
    k_t = k * jnp.exp(-G)
    k_end = k * jnp.exp(G_last - G)
    causal = jnp.tril(jnp.ones((CHUNK, CHUNK), bool))
    att = jnp.where(causal, jnp.einsum('bnchd,bnshd->bnhcs', q_t, k_t), 0.0)
    o_intra = jnp.einsum('bnhcs,bnshv->bnchv', att, v)
    u = jnp.einsum('bnshd,bnshv->bnhdv', k_end, v)
    decay = jnp.exp(G_last[:, :, 0])

    def step(S, inp):
        d, du = inp
        return d[..., None] * S + du, S

    S_fin, S_start = lax.scan(step, s0, (decay.swapaxes(0, 1), u.swapaxes(0, 1)))
    o_inter = jnp.einsum('bnchd,bnhdv->bnchv', q_t, S_start.swapaxes(0, 1))
    return (o_intra + o_inter).reshape(B, T, H, dv), S_fin


def delta_scan(q, k, v, beta, g, s0):
    B, T, H, dk = q.shape
    dv = v.shape[-1]
    n = T // CHUNK
    blk = lambda a: a.reshape((B, n, CHUNK) + a.shape[2:]).swapaxes(2, 3)
    q, k, v, beta, g = [blk(a) for a in (q, k, v, beta, g)]
    G = jnp.cumsum(g, axis=-1)
    lower = jnp.tril(jnp.ones((CHUNK, CHUNK), bool))
    strict = jnp.tril(jnp.ones((CHUNK, CHUNK), bool), -1)
    diff = G[..., :, None] - G[..., None, :]
    gam = jnp.where(lower, jnp.exp(jnp.where(lower, diff, 0.0)), 0.0)
    k_beta = k * beta[..., None]
    a_mat = jnp.where(strict, jnp.einsum('bnhcd,bnhsd->bnhcs', k_beta, k) * gam, 0.0)
    m_mat = a_mat + jnp.eye(CHUNK, dtype=F32)
    rhs = jnp.concatenate([v * beta[..., None], k_beta * jnp.exp(G)[..., None]], axis=-1)
    sol = lax.linalg.triangular_solve(m_mat, rhs, left_side=True, lower=True, unit_diagonal=True)
    w_val, k_cum = sol[..., :dv], sol[..., dv:]
    a_qk = jnp.einsum('bnhcd,bnhsd->bnhcs', q, k) * gam
    q_g = q * jnp.exp(G)[..., None]
    k_end = k * jnp.exp(G[..., -1:] - G)[..., None]
    d_last = jnp.exp(G[..., -1])

    def step(S, inp):
        aqk, wv, kc, qg, ke, d = inp
        v_new = wv - jnp.einsum('bhcd,bhdv->bhcv', kc, S)
        o = jnp.einsum('bhcd,bhdv->bhcv', qg, S) + jnp.einsum('bhcs,bhsv->bhcv', aqk, v_new)
        S = S * d[..., None, None] + jnp.einsum('bhcd,bhcv->bhdv', ke, v_new)
        return S, o

    xs = tuple(a.swapaxes(0, 1) for a in (a_qk, w_val, k_cum, q_g, k_end, d_last))
    S_fin, o = lax.scan(step, s0, xs)
    return o.transpose(1, 0, 3, 2, 4).reshape(B, T, H, dv), S_fin


def gla_mixer(bq, bk, bv, glr, br, w_g2, b_g, norm_g, s0):
    B, T, _ = bq.shape
    q = bq.reshape(B, T, H_B, DK_B).astype(F32) * DK_B ** -0.5
    k = bk.reshape(B, T, H_B, DK_B).astype(F32)
    v = bv.reshape(B, T, H_B, DV_B).astype(F32)
    z = jnp.einsum('btzr,zrc->btzc', glr.reshape(B, T, 2, GLA_RANK).astype(F32), w_g2.astype(F32)) + b_g.astype(F32)
    g = (jax.nn.log_sigmoid(z) / GLA_TAU).reshape(B, T, 2, H_B, DK_B)
    s0 = s0.astype(F32)
    fl = lambda a: jnp.flip(a, 1)
    o_f, s_f = gla_scan(q, k, v, g[:, :, 0], s0[:, 0])
    o_b, s_b = gla_scan(fl(q), fl(k), fl(v), fl(g[:, :, 1]), s0[:, 1])
    o = o_f + fl(o_b)
    o = rmsnorm(o, norm_g.reshape(H_B, DV_B)) * jax.nn.silu(br.reshape(B, T, H_B, DV_B).astype(F32))
    return o.reshape(B, T, H_B * DV_B).astype(bq.dtype), jnp.stack([s_f, s_b], axis=1).astype(bq.dtype)


def delta_mixer(dq, dk, dv, da, db, dz, w_conv, a_log, dt_bias, norm_g, s0):
    B, T, _ = dq.shape
    qkv = jax.nn.silu(dwconv(jnp.concatenate([dq, dk, dv], axis=-1), w_conv).astype(F32))
    q, k, v = split_cols(qkv, (H_D * DK_D, H_D * DK_D, H_D * DV_D))
    q = l2norm(q.reshape(B, T, H_D, DK_D)) * DK_D ** -0.5
    k = l2norm(k.reshape(B, T, H_D, DK_D))
    v = v.reshape(B, T, H_D, DV_D)
    beta = jax.nn.sigmoid(db.reshape(B, T, 2, H_D).astype(F32))
    g = -jnp.exp(a_log.astype(F32)) * jax.nn.softplus(da.reshape(B, T, 2, H_D).astype(F32) + dt_bias.astype(F32))
    s0 = s0.astype(F32)
    fl = lambda a: jnp.flip(a, 1)
    o_f, s_f = delta_scan(q, k, v, beta[:, :, 0], g[:, :, 0], s0[:, 0])
    o_b, s_b = delta_scan(fl(q), fl(k), fl(v), fl(beta[:, :, 1]), fl(g[:, :, 1]), s0[:, 1])
    o = o_f + fl(o_b)
    o = rmsnorm(o, norm_g) * jax.nn.silu(dz.reshape(B, T, H_D, DV_D).astype(F32))
    return o.reshape(B, T, H_D * DV_D).astype(dq.dtype), jnp.stack([s_f, s_b], axis=1).astype(dq.dtype)


def even_context(h, w_in, w_out, w_g2, b_g, norm_g):
    B, T, _ = h.shape
    aq, ak, av, bq, bk, bv, glr, br = split_cols(h @ w_in, EV_SIZES)
    k_h = ak.reshape(B, T, H_A, HEAD_DIM).transpose(0, 2, 1, 3)
    v_h = av.reshape(B, T, H_A, HEAD_DIM).transpose(0, 2, 1, 3)
    o_a = dense_attn(aq.reshape(B, T, H_A, HEAD_DIM), k_h, v_h, None)
    o_b, s_b = gla_mixer(bq, bk, bv, glr, br, w_g2, b_g, norm_g, jnp.zeros((B, 2, H_B, DK_B, DV_B), F32))
    out = jnp.concatenate([o_a.reshape(B, T, H_A * HEAD_DIM), o_b], axis=-1) @ w_out
    return out, k_h, v_h, s_b


def even_latent(h, w_in, w_out, rpb, w_g2, b_g, norm_g, ak_cache, av_cache, sb_cache):
    B, T, _ = h.shape
    aq, ak, av, bq, bk, bv, glr, br = split_cols(h @ w_in, EV_SIZES)
    o_a = neighborhood_attn(aq.reshape(B, T, H_A, HEAD_DIM), ak.reshape(B, T, H_A, HEAD_DIM),
                            av.reshape(B, T, H_A, HEAD_DIM), rpb, ak_cache, av_cache)
    o_b, _ = gla_mixer(bq, bk, bv, glr, br, w_g2, b_g, norm_g, sb_cache)
    return jnp.concatenate([o_a.reshape(B, T, H_A * HEAD_DIM), o_b], axis=-1) @ w_out


def odd_context(h, w_in, w_out, sink, w_conv, a_log, dt_bias, norm_g):
    B, T, _ = h.shape
    cq, ck, cv, dq, dk, dv, da, db, dz = split_cols(h @ w_in, OD_SIZES)
    k_h = ck.reshape(B, T, KV_C, HEAD_DIM).transpose(0, 2, 1, 3)
    v_h = cv.reshape(B, T, KV_C, HEAD_DIM).transpose(0, 2, 1, 3)
    o_c = dense_attn(cq.reshape(B, T, H_C, HEAD_DIM), k_h, v_h, sink)
    o_d, s_d = delta_mixer(dq, dk, dv, da, db, dz, w_conv, a_log, dt_bias, norm_g,
                           jnp.zeros((B, 2, H_D, DK_D, DV_D), F32))
    out = jnp.concatenate([o_c.reshape(B, T, H_C * HEAD_DIM), o_d], axis=-1) @ w_out
    return out, k_h, v_h, s_d


def odd_latent(h, w_in, w_out, sink, w_conv, a_log, dt_bias, norm_g, ck_cache, cv_cache, sd_cache):
    B, T, _ = h.shape
    cq, ck, cv, dq, dk, dv, da, db, dz = split_cols(h @ w_in, OD_SIZES)
    q = axial_rope(cq.reshape(B, T, H_C, HEAD_DIM))
    k = axial_rope(ck.reshape(B, T, KV_C, HEAD_DIM))
    o_c = window_attn(q, k, cv.reshape(B, T, KV_C, HEAD_DIM), sink, ck_cache, cv_cache)
    o_d, _ = delta_mixer(dq, dk, dv, da, db, dz, w_conv, a_log, dt_bias, norm_g, sd_cache)
    return jnp.concatenate([o_c.reshape(B, T, H_C * HEAD_DIM), o_d], axis=-1) @ w_out


def conv_ffn(h, w_up, w_conv, w_down):
    u = dwconv(h @ w_up, w_conv)
    a, gt = jnp.split(u, 2, axis=-1)
    return (a * jax.nn.silu(gt)) @ w_down


def setup_inputs(seed: int = 0) -> dict:
    key = jax.random.key(seed)
    ks = iter(jax.random.split(key, 40))
    nrm = lambda shape, s: jax.random.normal(next(ks), shape, F32) * s
    gain = lambda shape: 1.0 + nrm(shape, 0.02)
    x_prompt = nrm((BATCH, SEQ, D_MODEL), 1.0)
    x_sample = nrm((DEC_BATCH, DEC_SEQ, D_MODEL), 1.0)
    cache_a_k = nrm((DEC_BATCH, N_EVEN, H_A, PAST_LEN, HEAD_DIM), 1.0)
    cache_a_v = nrm((DEC_BATCH, N_EVEN, H_A, PAST_LEN, HEAD_DIM), 1.0)
    state_b = nrm((DEC_BATCH, N_EVEN, 2, H_B, DK_B, DV_B), 0.5)
    cache_c_k = nrm((DEC_BATCH, N_ODD, KV_C, PAST_LEN, HEAD_DIM), 1.0)
    cache_c_v = nrm((DEC_BATCH, N_ODD, KV_C, PAST_LEN, HEAD_DIM), 1.0)
    state_d = nrm((DEC_BATCH, N_ODD, 2, H_D, DK_D, DV_D), 0.5)
    c = nrm((DEC_BATCH, D_MODEL), 1.0)
    c_ctx = nrm((D_MODEL,), 1.0)
    ada_w = nrm((DEPTH, D_MODEL, 6 * D_MODEL), 0.5 * D_MODEL ** -0.5)
    ada_b = nrm((DEPTH, 6 * D_MODEL), 0.02)
    norm1_g = gain((DEPTH, D_MODEL))
    norm2_g = gain((DEPTH, D_MODEL))
    ffn_up = nrm((DEPTH, D_MODEL, 2 * D_FF), D_MODEL ** -0.5)
    ffn_conv = nrm((DEPTH, FFN_CONV, 2 * D_FF), FFN_CONV ** -0.5)
    ffn_down = nrm((DEPTH, D_FF, D_MODEL), D_FF ** -0.5)
    ev_w_in = nrm((N_EVEN, D_MODEL, EV_IN), D_MODEL ** -0.5)
    ev_w_out = nrm((N_EVEN, EV_OUT, D_MODEL), EV_OUT ** -0.5)
    a_rpb = nrm((N_EVEN, H_A, 2 * WIN_R - 1, 2 * WIN_C - 1), 0.1)
    b_w_g2 = nrm((N_EVEN, 2, GLA_RANK, H_B * DK_B), GLA_RANK ** -0.5)
    b_b_g = nrm((N_EVEN, 2, H_B * DK_B), 0.1)
    b_norm_g = gain((N_EVEN, H_B * DV_B))
    od_w_in = nrm((N_ODD, D_MODEL, OD_IN), D_MODEL ** -0.5)
    od_w_out = nrm((N_ODD, OD_OUT, D_MODEL), OD_OUT ** -0.5)
    c_sink = nrm((N_ODD, H_C), 0.5)
    d_conv = nrm((N_ODD, SHORT_CONV, H_D * (2 * DK_D + DV_D)), SHORT_CONV ** -0.5)
    d_a_log = jnp.log(jax.random.uniform(next(ks), (N_ODD, 2, H_D), F32, 1.0, 16.0))
    u = jax.random.uniform(next(ks), (N_ODD, 2, H_D), F32)
    dt = jnp.exp(u * (math.log(0.1) - math.log(0.001)) + math.log(0.001))
    d_dt_bias = dt + jnp.log(-jnp.expm1(-dt))
    d_norm_g = gain((N_ODD, DV_D))
    final_g = gain((D_MODEL,))
    return {'x_prompt': x_prompt, 'x_sample': x_sample,
            'cache_a_k': cache_a_k, 'cache_a_v': cache_a_v, 'state_b': state_b,
            'cache_c_k': cache_c_k, 'cache_c_v': cache_c_v, 'state_d': state_d,
            'c': c, 'c_ctx': c_ctx, 'ada_w': ada_w, 'ada_b': ada_b,
            'norm1_g': norm1_g, 'norm2_g': norm2_g,
            'ffn_up': ffn_up, 'ffn_conv': ffn_conv, 'ffn_down': ffn_down,
            'ev_w_in': ev_w_in, 'ev_w_out': ev_w_out, 'a_rpb': a_rpb,
            'b_w_g2': b_w_g2, 'b_b_g': b_b_g, 'b_norm_g': b_norm_g,
            'od_w_in': od_w_in, 'od_w_out': od_w_out, 'c_sink': c_sink,
            'd_conv': d_conv, 'd_a_log': d_a_log, 'd_dt_bias': d_dt_bias, 'd_norm_g': d_norm_g,
            'final_g': final_g}


def reference(x_prompt, x_sample, cache_a_k, cache_a_v, state_b, cache_c_k, cache_c_v, state_d, c,
              c_ctx, ada_w, ada_b, norm1_g, norm2_g, ffn_up, ffn_conv, ffn_down,
              ev_w_in, ev_w_out, a_rpb, b_w_g2, b_b_g, b_norm_g,
              od_w_in, od_w_out, c_sink, d_conv, d_a_log, d_dt_bias, d_norm_g, final_g):
    xp = x_prompt
    xs = x_sample
    ak_l, av_l, sb_l, ck_l, cv_l, sd_l = [], [], [], [], [], []
    for l in range(DEPTH):
        j = l // 2
        sh1p, sc1p, g1p, sh2p, sc2p, g2p = adaln(c_ctx, ada_w[l], ada_b[l])
        sh1s, sc1s, g1s, sh2s, sc2s, g2s = [m[:, None, :] for m in adaln(c, ada_w[l], ada_b[l])]
        hp = modulate(rmsnorm(xp, norm1_g[l]), sh1p, sc1p)
        hs = modulate(rmsnorm(xs, norm1_g[l]), sh1s, sc1s)
        if l % 2 == 0:
            mp, ak, av, sb = even_context(hp, ev_w_in[j], ev_w_out[j], b_w_g2[j], b_b_g[j], b_norm_g[j])
            ms = even_latent(hs, ev_w_in[j], ev_w_out[j], a_rpb[j], b_w_g2[j], b_b_g[j], b_norm_g[j],
                             cache_a_k[:, j], cache_a_v[:, j], state_b[:, j])
            ak_l.append(ak)
            av_l.append(av)
            sb_l.append(sb)
        else:
            mp, ck, cv, sd = odd_context(hp, od_w_in[j], od_w_out[j], c_sink[j], d_conv[j],
                                         d_a_log[j], d_dt_bias[j], d_norm_g[j])
            ms = odd_latent(hs, od_w_in[j], od_w_out[j], c_sink[j], d_conv[j], d_a_log[j], d_dt_bias[j],
                            d_norm_g[j], cache_c_k[:, j], cache_c_v[:, j], state_d[:, j])
            ck_l.append(ck)
            cv_l.append(cv)
            sd_l.append(sd)
        xp = xp + g1p * mp
        xs = xs + g1s * ms
        hp = modulate(rmsnorm(xp, norm2_g[l]), sh2p, sc2p)
        hs = modulate(rmsnorm(xs, norm2_g[l]), sh2s, sc2s)
        xp = xp + g2p * conv_ffn(hp, ffn_up[l], ffn_conv[l], ffn_down[l])
        xs = xs + g2s * conv_ffn(hs, ffn_up[l], ffn_conv[l], ffn_down[l])
    y_prompt = rmsnorm(xp, final_g)
    y_sample = rmsnorm(xs, final_g)
    new_a_k = jnp.stack(ak_l, axis=1)
    new_a_v = jnp.stack(av_l, axis=1)
    new_state_b = jnp.stack(sb_l, axis=1)
    new_c_k = jnp.stack(ck_l, axis=1)
    new_c_v = jnp.stack(cv_l, axis=1)
    new_state_d = jnp.stack(sd_l, axis=1)
    return (y_prompt, y_sample, new_a_k, new_a_v, new_state_b, new_c_k, new_c_v, new_state_d)
```

```cpp
#include <hip/hip_runtime.h>
#include <hip/hip_cooperative_groups.h>
#include <cstdio>
namespace cg = cooperative_groups;

#ifndef MK_MULTI
#define MK_MULTI 0
#endif

#define DI __device__ __forceinline__
#define DN __device__ __noinline__
typedef unsigned short u16;
typedef __attribute__((ext_vector_type(8))) short bf16x8;
typedef __attribute__((ext_vector_type(4))) short s16x4;
typedef __attribute__((ext_vector_type(16))) float f32x16;
#define MFMA(a, b, c) __builtin_amdgcn_mfma_f32_32x32x16_bf16((a), (b), (c), 0, 0, 0)

static constexpr int NP_ = 4096, NT_ = 36864;
static constexpr int EVN = 3616, ODN = 2848;
static constexpr size_t OFF_AK = 37748736, OFF_AV = 41943040, OFF_SB = 46137344, OFF_CK = 48234496, OFF_CV = 49283072, OFF_SD = 50331648;
static constexpr size_t LW = 13500416, WO_UP = 0, WO_DN = 5767168, WO_IN = 8650752, WO_OUT = 12451840;
static constexpr int NPH = 34;
static constexpr int SMEM_BYTES = 80 * 1024;

struct P {
  const float *x_prompt, *x_sample, *cache_a_k, *cache_a_v, *state_b, *cache_c_k, *cache_c_v, *state_d, *c, *c_ctx, *ada_w, *ada_b,
      *norm1_g, *norm2_g, *ffn_up, *ffn_conv, *ffn_down, *ev_w_in, *ev_w_out, *a_rpb, *b_w_g2, *b_b_g, *b_norm_g, *od_w_in, *od_w_out,
      *c_sink, *d_conv, *d_a_log, *d_dt_bias, *d_norm_g, *final_g;
  float* out;
  u16 *hn, *proj, *ot1, *wt;
  float *mods, *rope;
};

DI u16 f2bf(float x) { unsigned u = __float_as_uint(x); u += 0x7fffu + ((u >> 16) & 1u); return (u16)(u >> 16); }
DI float bf2f(u16 b) { return __uint_as_float(((unsigned)b) << 16); }
DI int crow(int i, int h) { return (i & 3) + 8 * (i >> 2) + 4 * h; }
template <int S> DI bf16x8 packs(const f32x16& x) {
  bf16x8 v;
#pragma unroll
  for (int j = 0; j < 8; ++j) v[j] = (short)f2bf(x[8 * S + j]);
  return v;
}
DI bf16x8 ld2x4(const u16* p) {
  s16x4 lo = *(const s16x4*)p, hi = *(const s16x4*)(p + 8);
  return __builtin_shufflevector(lo, hi, 0, 1, 2, 3, 4, 5, 6, 7);
}
DI float siluf(float x) { return x / (1.f + __expf(-x)); }
DI void zero16(f32x16& a) {
#pragma unroll
  for (int i = 0; i < 16; ++i) a[i] = 0.f;
}

DI void prep_phase(const P* __restrict__ gp, char* smem) {
  const P& p = *gp;
  int tid_ = threadIdx.x; asm volatile("" : "+v"(tid_)); const int tid = tid_;
  const int NWT = 4 * (1408 + 704 + 256) + 2 * (928 + 736);
  const int NADA = 384;
  const int total = NWT + NADA + 1;
  for (int item = blockIdx.x; item < total; item += gridDim.x) {
    if (item < NWT) {
      int rem = item; const float* src = nullptr; u16* dst = nullptr; int K = 0, N = 0, NPd = 0;
      for (int l = 0; l < 4; ++l) {
        const int jj = l >> 1; const bool ev = !(l & 1);
        const int nin = ev ? 928 : 736;
        if (rem < 1408) { src = p.ffn_up + (size_t)l * 1024 * 5632; dst = p.wt + l * LW + WO_UP; K = 1024; N = 5632; NPd = 5632; break; }
        rem -= 1408;
        if (rem < 704) { src = p.ffn_down + (size_t)l * 2816 * 1024; dst = p.wt + l * LW + WO_DN; K = 2816; N = 1024; NPd = 1024; break; }
        rem -= 704;
        if (rem < nin) { src = ev ? p.ev_w_in + (size_t)jj * 1024 * EVN : p.od_w_in + (size_t)jj * 1024 * ODN; dst = p.wt + l * LW + WO_IN; K = 1024; N = ev ? EVN : ODN; NPd = ev ? 3712 : 2944; break; }
        rem -= nin;
        if (rem < 256) { src = (ev ? p.ev_w_out : p.od_w_out) + (size_t)jj * 1024 * 1024; dst = p.wt + l * LW + WO_OUT; K = 1024; N = 1024; NPd = 1024; break; }
        rem -= 256;
      }
      const int ntn = NPd >> 6;
      const int tk = rem / ntn, tn = rem - tk * ntn;
      float* T = (float*)smem;
      __syncthreads();
#pragma unroll
      for (int i = 0; i < 16; ++i) {
        const int k = i * 4 + (tid >> 6), n = tid & 63;
        const int gn = tn * 64 + n;
        T[k * 65 + n] = (gn < N) ? src[(size_t)(tk * 64 + k) * N + gn] : 0.f;
      }
      __syncthreads();
#pragma unroll
      for (int i = 0; i < 16; ++i) {
        const int n = i * 4 + (tid >> 6), k = tid & 63;
        dst[(size_t)(tn * 64 + n) * K + tk * 64 + k] = f2bf(T[k * 65 + n]);
      }
    } else if (item < NWT + NADA) {
      const int it = item - NWT; const int l = it / 96, cgp = it - l * 96; const int n0 = cgp * 64;
      float* sc = (float*)smem;
      float* red = sc + 9 * 1024;
      __syncthreads();
      for (int idx = tid; idx < 9 * 1024; idx += 256) {
        const int ci = idx >> 10, k = idx & 1023;
        const float x = ci < 8 ? p.c[ci * 1024 + k] : p.c_ctx[k];
        sc[idx] = x / (1.f + expf(-x));
      }
      __syncthreads();
      const int wave = tid >> 6, lane = tid & 63;
      float acc[9];
#pragma unroll
      for (int ci = 0; ci < 9; ++ci) acc[ci] = 0.f;
      const float* wp = p.ada_w + ((size_t)l * 1024 + wave * 256) * 6144 + n0 + lane;
#pragma unroll 8
      for (int k = 0; k < 256; ++k) {
        const float wv = wp[(size_t)k * 6144];
#pragma unroll
        for (int ci = 0; ci < 9; ++ci) acc[ci] += sc[ci * 1024 + wave * 256 + k] * wv;
      }
#pragma unroll
      for (int ci = 0; ci < 9; ++ci) red[(wave * 9 + ci) * 64 + lane] = acc[ci];
      __syncthreads();
      for (int idx = tid; idx < 576; idx += 256) {
        const int ci = idx >> 6, col = idx & 63;
        const float s = red[(0 * 9 + ci) * 64 + col] + red[(1 * 9 + ci) * 64 + col] + red[(2 * 9 + ci) * 64 + col] + red[(3 * 9 + ci) * 64 + col];
        p.mods[(size_t)(l * 9 + ci) * 6144 + n0 + col] = s + p.ada_b[l * 6144 + n0 + col];
      }
    } else {
      for (int idx = tid; idx < 1024; idx += 256) {
        const int pos = idx >> 4, fi = idx & 15;
        const float inv = powf(10000.f, -(float)fi / 16.f);
        const float ang = (float)pos * inv;
        p.rope[idx * 2] = cosf(ang); p.rope[idx * 2 + 1] = sinf(ang);
      }
    }
  }
}

DI void norm_phase(const P* __restrict__ gp, int l, int which, bool first, bool fin) {
  const P& p = *gp;
  int tid_ = threadIdx.x; asm volatile("" : "+v"(tid_)); const int tid = tid_, lane = tid & 63, wave = tid >> 6;
  for (int item = blockIdx.x; item < NT_ / 4; item += gridDim.x) {
    const int tok = item * 4 + wave;
    const float* src = first ? (tok < NP_ ? p.x_prompt + (size_t)tok * 1024 : p.x_sample + (size_t)(tok - NP_) * 1024) : p.out + (size_t)tok * 1024;
    float4 v[4];
    float ss = 0.f;
#pragma unroll
    for (int i = 0; i < 4; ++i) { v[i] = ((const float4*)src)[lane + 64 * i]; ss += v[i].x * v[i].x + v[i].y * v[i].y + v[i].z * v[i].z + v[i].w * v[i].w; }
#pragma unroll
    for (int o = 32; o >= 1; o >>= 1) ss += __shfl_xor(ss, o);
    const float rstd = rsqrtf(ss * (1.f / 1024.f) + 1e-6f);
    if (fin) {
#pragma unroll
      for (int i = 0; i < 4; ++i) {
        const float4 g = ((const float4*)p.final_g)[lane + 64 * i];
        float4 y; y.x = v[i].x * rstd * g.x; y.y = v[i].y * rstd * g.y; y.z = v[i].z * rstd * g.z; y.w = v[i].w * rstd * g.w;
        ((float4*)(p.out + (size_t)tok * 1024))[lane + 64 * i] = y;
      }
    } else {
      const int ci = tok < NP_ ? 8 : (tok - NP_) >> 12;
      const float* md = p.mods + (size_t)(l * 9 + ci) * 6144 + which * 3072;
      const float* gp = (which ? p.norm2_g : p.norm1_g) + l * 1024;
#pragma unroll
      for (int i = 0; i < 4; ++i) {
        const float4 g = ((const float4*)gp)[lane + 64 * i];
        const float4 sh = ((const float4*)md)[lane + 64 * i];
        const float4 sc = ((const float4*)(md + 1024))[lane + 64 * i];
        ushort4 o;
        o.x = f2bf(v[i].x * rstd * g.x * (1.f + sc.x) + sh.x);
        o.y = f2bf(v[i].y * rstd * g.y * (1.f + sc.y) + sh.y);
        o.z = f2bf(v[i].z * rstd * g.z * (1.f + sc.z) + sh.z);
        o.w = f2bf(v[i].w * rstd * g.w * (1.f + sc.w) + sh.w);
        ((ushort4*)(p.hn + (size_t)tok * 1024))[lane + 64 * i] = o;
        if (first) ((float4*)(p.out + (size_t)tok * 1024))[lane + 64 * i] = v[i];
      }
    }
  }
}

DI uint4 ldsel(const u16* pv, const u16* safe, unsigned ok) {
  uint4 t = *(const uint4*)(ok ? pv : safe);
  if (!ok) { t.x = 0; t.y = 0; t.z = 0; t.w = 0; }
  return t;
}
enum { EPI_PROJ = 0, EPI_RES = 1, EPI_FFN = 2 };

template <int EPI>
DI void gemm_phase(const P* __restrict__ gp, int l, char* smem, const u16* __restrict__ A, int lda, const u16* __restrict__ B, int ldb, int K, int MT,
                   int NTn, int gsel) {
  const P& p = *gp;
  u16* As = (u16*)smem; u16* Bs = As + 128 * 72;
  int tid_ = threadIdx.x; asm volatile("" : "+v"(tid_)); const int tid = tid_, lane = tid & 63, wave = tid >> 6, r = lane & 31, h = lane >> 5;
  const int wm = wave & 1, wn = wave >> 1;
  const int KT = K >> 6;
  const bool even = !(l & 1); const int jj = l >> 1;
  const int ntiles = MT * NTn;
  for (int tile = blockIdx.x; tile < ntiles; tile += gridDim.x) {
    const int mt = tile / NTn, nt = tile - mt * NTn;
    int seqbase = 0, L = 0, tin0 = 0;
    if (EPI == EPI_FFN) {
      if (mt < 48) { const int sq = mt / 3; L = 256; seqbase = sq * 256; tin0 = (mt - sq * 3) * 126; }
      else { const int m2 = mt - 48; const int sq = m2 / 33; L = 4096; seqbase = NP_ + sq * 4096; tin0 = (m2 - sq * 33) * 126; }
    }
    const int row0 = tid >> 3, kc0 = (tid & 7) * 8;
    const long arow0 = (EPI == EPI_FFN) ? (long)seqbase + tin0 - 1 + row0 : (long)mt * 128 + row0;
    const u16* abase = A + arow0 * lda + kc0;
    unsigned avalid = 0;
#pragma unroll
    for (int i = 0; i < 4; ++i) {
      if (EPI == EPI_FFN) { const int ts = tin0 - 1 + row0 + 32 * i; if (ts >= 0 && ts < L) avalid |= 1u << i; }
      else avalid |= 1u << i;
    }
    const u16* bbase = B + (size_t)((EPI == EPI_FFN) ? nt * 64 + row0 : nt * 128 + row0) * ldb + kc0;
#define BOFFR(i) ((EPI == EPI_FFN) ? ((i) < 2 ? 32 * (i) : 2752 + 32 * (i)) : 32 * (i))
    f32x16 acc[2][2];
#pragma unroll
    for (int a = 0; a < 2; ++a)
#pragma unroll
      for (int b = 0; b < 2; ++b) zero16(acc[a][b]);
#define GLD_A(i, ko) ldsel(abase + (size_t)(32 * (i)) * lda + (ko), A, (avalid >> (i)) & 1u)
#define GLD_B(i, ko) (*(const uint4*)(bbase + (size_t)BOFFR(i) * ldb + (ko)))
    uint4 ra0 = GLD_A(0, 0), ra1 = GLD_A(1, 0), ra2 = GLD_A(2, 0), ra3 = GLD_A(3, 0);
    uint4 rb0 = GLD_B(0, 0), rb1 = GLD_B(1, 0), rb2 = GLD_B(2, 0), rb3 = GLD_B(3, 0);
    for (int kt = 0; kt < KT; ++kt) {
      __syncthreads();
      {
        u16* ad = As + row0 * 72 + kc0; u16* bd = Bs + row0 * 72 + kc0;
        *(uint4*)(ad) = ra0; *(uint4*)(ad + 32 * 72) = ra1; *(uint4*)(ad + 64 * 72) = ra2; *(uint4*)(ad + 96 * 72) = ra3;
        *(uint4*)(bd) = rb0; *(uint4*)(bd + 32 * 72) = rb1; *(uint4*)(bd + 64 * 72) = rb2; *(uint4*)(bd + 96 * 72) = rb3;
      }
      __syncthreads();
      if (kt + 1 < KT) {
        const int ko = (kt + 1) * 64;
        ra0 = GLD_A(0, ko); ra1 = GLD_A(1, ko); ra2 = GLD_A(2, ko); ra3 = GLD_A(3, ko);
        rb0 = GLD_B(0, ko); rb1 = GLD_B(1, ko); rb2 = GLD_B(2, ko); rb3 = GLD_B(3, ko);
      }
#pragma unroll
      for (int ks = 0; ks < 4; ++ks) {
        const bf16x8 a0 = *(const bf16x8*)(As + (wm * 64 + r) * 72 + ks * 16 + h * 8);
        const bf16x8 a1 = *(const bf16x8*)(As + (wm * 64 + 32 + r) * 72 + ks * 16 + h * 8);
        const bf16x8 b0 = *(const bf16x8*)(Bs + (wn * 64 + r) * 72 + ks * 16 + h * 8);
        const bf16x8 b1 = *(const bf16x8*)(Bs + (wn * 64 + 32 + r) * 72 + ks * 16 + h * 8);
        acc[0][0] = MFMA(a0, b0, acc[0][0]);
        acc[0][1] = MFMA(a0, b1, acc[0][1]);
        acc[1][0] = MFMA(a1, b0, acc[1][0]);
        acc[1][1] = MFMA(a1, b1, acc[1][1]);
      }
    }
    if (EPI == EPI_PROJ) {
      const int N = even ? EVN : ODN;
#pragma unroll
      for (int tm = 0; tm < 2; ++tm)
#pragma unroll
        for (int tn = 0; tn < 2; ++tn) {
          const int col = nt * 128 + wn * 64 + tn * 32 + r;
          if (col < N) {
#pragma unroll
            for (int i = 0; i < 16; ++i) {
              const int row = mt * 128 + wm * 64 + tm * 32 + crow(i, h);
              const float v = acc[tm][tn][i];
              p.proj[(size_t)row * N + col] = f2bf(v);
              if (row < NP_) {
                const int b = row >> 8, t = row & 255, d = col & 63;
                if (even) {
                  if (col >= 512 && col < 1536) {
                    const int wh = (col - 512) >> 9, hh = ((col - 512) >> 6) & 7;
                    p.out[(wh ? OFF_AV : OFF_AK) + ((size_t)(((b * 2 + jj) * 8 + hh) * 256 + t)) * 64 + d] = v;
                  }
                } else {
                  if (col >= 512 && col < 768) {
                    const int wh = (col - 512) >> 7, kv = ((col - 512) >> 6) & 1;
                    p.out[(wh ? OFF_CV : OFF_CK) + ((size_t)(((b * 2 + jj) * 2 + kv) * 256 + t)) * 64 + d] = v;
                  }
                }
              }
            }
          }
        }
    } else if (EPI == EPI_RES) {
#pragma unroll
      for (int tm = 0; tm < 2; ++tm)
#pragma unroll
        for (int tn = 0; tn < 2; ++tn) {
          const int col = nt * 128 + wn * 64 + tn * 32 + r;
#pragma unroll
          for (int i = 0; i < 16; ++i) {
            const int row = mt * 128 + wm * 64 + tm * 32 + crow(i, h);
            const int ci = row < NP_ ? 8 : (row - NP_) >> 12;
            const float g = p.mods[(size_t)(l * 9 + ci) * 6144 + gsel * 1024 + col];
            float* xp = p.out + (size_t)row * 1024 + col;
            *xp = *xp + g * acc[tm][tn][i];
          }
        }
    } else {
      __syncthreads();
      float* U = (float*)smem;
#pragma unroll
      for (int tm = 0; tm < 2; ++tm)
#pragma unroll
        for (int tn = 0; tn < 2; ++tn)
#pragma unroll
          for (int i = 0; i < 16; ++i) U[(wm * 64 + tm * 32 + crow(i, h)) * 132 + wn * 64 + tn * 32 + r] = acc[tm][tn][i];
      __syncthreads();
      const float* cw = p.ffn_conv + (size_t)l * 3 * 5632;
      const int f = tid & 63, rg = tid >> 6; const int fg = nt * 64 + f;
      const float wa0 = cw[fg], wa1 = cw[5632 + fg], wa2 = cw[2 * 5632 + fg];
      const float wg0 = cw[2816 + fg], wg1 = cw[5632 + 2816 + fg], wg2 = cw[2 * 5632 + 2816 + fg];
      u16* act = p.proj;
      for (int rr = 1 + rg; rr <= 126; rr += 4) {
        const int ts = tin0 - 1 + rr;
        if (ts >= L) break;
        const float a = wa0 * U[(rr - 1) * 132 + f] + wa1 * U[rr * 132 + f] + wa2 * U[(rr + 1) * 132 + f];
        const float g = wg0 * U[(rr - 1) * 132 + 64 + f] + wg1 * U[rr * 132 + 64 + f] + wg2 * U[(rr + 1) * 132 + 64 + f];
        act[(size_t)(seqbase + ts) * 2816 + fg] = f2bf(a * siluf(g));
      }
    }
  }
}

template <int MODE>
DI void attn_item(const P* __restrict__ gp, int jj, int it, char* smem) {
  const P& p = *gp;
  u16* Ks = (u16*)smem; u16* Vt = Ks + 64 * 72; float* rpb_s = (float*)(Vt + 64 * 72);
  int tid_ = threadIdx.x; asm volatile("" : "+v"(tid_)); const int tid = tid_, lane = tid & 63, wave = tid >> 6, r = lane & 31, h = lane >> 5;
  constexpr bool EVENL = (MODE == 0 || MODE == 1);
  constexpr bool LAT = (MODE == 1 || MODE == 3);
  constexpr int PS = EVENL ? EVN : ODN;
  int b, hq, qb, tokbase;
  if (!LAT) { b = it >> 4; hq = (it >> 1) & 7; qb = it & 1; tokbase = b * 256; }
  else { b = it >> 8; hq = (it >> 5) & 7; qb = it & 31; tokbase = NP_ + b * 4096; }
  const int hk = EVENL ? hq : (hq >> 2);
  const int kcol = 512 + hk * 64, vcol = (EVENL ? 1024 : 640) + hk * 64, qcol = hq * 64;
  const int tq = qb * 128 + wave * 32 + r;
  const size_t qtok = (size_t)tokbase + tq;
  __syncthreads();
  if (MODE == 1) { for (int i = tid; i < 465; i += 256) rpb_s[i] = p.a_rpb[(size_t)(jj * 8 + hq) * 465 + i]; }
  bf16x8 qf[4];
#pragma unroll
  for (int s = 0; s < 4; ++s) qf[s] = *(const bf16x8*)(p.proj + qtok * PS + qcol + 16 * s + 8 * h);
  if (MODE == 3) {
    const int prow = tq >> 6, pcol = tq & 63;
#pragma unroll
    for (int half = 0; half < 2; ++half) {
      const int pos = half ? pcol : prow;
#pragma unroll
      for (int j = 0; j < 8; ++j) {
        const float cs = p.rope[(pos * 16 + 8 * h + j) * 2], sn = p.rope[(pos * 16 + 8 * h + j) * 2 + 1];
        const float x1 = bf2f((u16)qf[2 * half][j]), x2 = bf2f((u16)qf[2 * half + 1][j]);
        qf[2 * half][j] = (short)f2bf(x1 * cs - x2 * sn);
        qf[2 * half + 1][j] = (short)f2bf(x1 * sn + x2 * cs);
      }
    }
  }
  float m_run = -1e30f, l_run = 0.f;
  if (MODE == 2 || MODE == 3) { m_run = p.c_sink[jj * 8 + hq]; l_run = h == 0 ? 1.f : 0.f; }
  f32x16 ot[2]; zero16(ot[0]); zero16(ot[1]);
  int loc0 = 0, nloc = 0;
  if (MODE == 1) {
    const int qi0 = 2 * qb;
    const int rlo = min(max(qi0 - 4, 0), 56), rhi = min(max(qi0 + 1 - 4, 0), 56) + 7;
    loc0 = rlo; nloc = rhi - rlo + 1;
  } else if (MODE == 3) {
    loc0 = max(0, 2 * qb - 2); nloc = min(63, 2 * qb + 3) - loc0 + 1;
  }
  const int qi = tq >> 6, qw = tq & 63;
  const int r0w = min(max(qi - 4, 0), 56), c0w = min(max(qw - 8, 0), 48);
  const int key = tid >> 2, seg = tid & 3;
  for (int kb = 0; kb < 4 + nloc; ++kb) {
    const bool isctx = kb < 4;
    const int blk = isctx ? kb : loc0 + kb - 4;
    __syncthreads();
    {
      float kf[16], vf[16];
      if (LAT && isctx) {
        const float* kc = (MODE == 1) ? p.cache_a_k + ((size_t)((b * 2 + jj) * 8 + hk)) * 16384 : p.cache_c_k + ((size_t)((b * 2 + jj) * 2 + hk)) * 16384;
        const float* vc = (MODE == 1) ? p.cache_a_v + ((size_t)((b * 2 + jj) * 8 + hk)) * 16384 : p.cache_c_v + ((size_t)((b * 2 + jj) * 2 + hk)) * 16384;
        const float4* kp4 = (const float4*)(kc + (size_t)(blk * 64 + key) * 64 + seg * 16);
        const float4* vp4 = (const float4*)(vc + (size_t)(blk * 64 + key) * 64 + seg * 16);
#pragma unroll
        for (int e = 0; e < 4; ++e) {
          const float4 a = kp4[e], c = vp4[e];
          kf[4 * e] = a.x; kf[4 * e + 1] = a.y; kf[4 * e + 2] = a.z; kf[4 * e + 3] = a.w;
          vf[4 * e] = c.x; vf[4 * e + 1] = c.y; vf[4 * e + 2] = c.z; vf[4 * e + 3] = c.w;
        }
      } else {
        const u16* rowp = p.proj + ((size_t)tokbase + blk * 64 + key) * PS;
        const bf16x8 k0 = *(const bf16x8*)(rowp + kcol + seg * 16), k1 = *(const bf16x8*)(rowp + kcol + seg * 16 + 8);
        const bf16x8 v0 = *(const bf16x8*)(rowp + vcol + seg * 16), v1 = *(const bf16x8*)(rowp + vcol + seg * 16 + 8);
#pragma unroll
        for (int e = 0; e < 8; ++e) { kf[e] = bf2f((u16)k0[e]); kf[8 + e] = bf2f((u16)k1[e]); vf[e] = bf2f((u16)v0[e]); vf[8 + e] = bf2f((u16)v1[e]); }
        if (MODE == 3) {
          const bf16x8 p0 = *(const bf16x8*)(rowp + kcol + (seg ^ 1) * 16), p1 = *(const bf16x8*)(rowp + kcol + (seg ^ 1) * 16 + 8);
          const int pos = (seg & 2) ? key : blk;
#pragma unroll
          for (int e = 0; e < 16; ++e) {
            const float pr = bf2f((u16)(e < 8 ? p0[e & 7] : p1[e & 7]));
            const float cs = p.rope[(pos * 16 + e) * 2], sn = p.rope[(pos * 16 + e) * 2 + 1];
            kf[e] = (seg & 1) ? (pr * sn + kf[e] * cs) : (kf[e] * cs - pr * sn);
          }
        }
      }
      bf16x8 o0, o1;
#pragma unroll
      for (int e = 0; e < 8; ++e) { o0[e] = (short)f2bf(kf[e]); o1[e] = (short)f2bf(kf[8 + e]); }
      *(bf16x8*)(Ks + key * 72 + seg * 16) = o0;
      *(bf16x8*)(Ks + key * 72 + seg * 16 + 8) = o1;
#pragma unroll
      for (int e = 0; e < 16; ++e) Vt[(seg * 16 + e) * 72 + key] = f2bf(vf[e]);
    }
    __syncthreads();
    bool active = true;
    if (MODE == 1 && !isctx) active = (blk >= r0w && blk < r0w + 8);
    if (active) {
      f32x16 st[2]; zero16(st[0]); zero16(st[1]);
#pragma unroll
      for (int kt = 0; kt < 2; ++kt)
#pragma unroll
        for (int s = 0; s < 4; ++s) {
          const bf16x8 a = *(const bf16x8*)(Ks + (kt * 32 + r) * 72 + 16 * s + 8 * h);
          st[kt] = MFMA(a, qf[s], st[kt]);
        }
      float mx = m_run;
#pragma unroll
      for (int kt = 0; kt < 2; ++kt)
#pragma unroll
        for (int i = 0; i < 16; ++i) {
          float s = st[kt][i] * 0.125f;
          const int kk = kt * 32 + crow(i, h);
          if (MODE == 1 && !isctx) {
            const bool ok = (kk >= c0w && kk < c0w + 16);
            s = ok ? s + rpb_s[(blk - qi + 7) * 31 + (kk - qw + 15)] : -1e30f;
          }
          if (MODE == 3 && !isctx) {
            const int dlt = blk * 64 + kk - tq;
            s = (dlt <= 128 && dlt >= -128) ? s : -1e30f;
          }
          st[kt][i] = s;
          mx = fmaxf(mx, s);
        }
      mx = fmaxf(mx, __shfl_xor(mx, 32));
      const float alpha = __expf(m_run - mx);
      m_run = mx;
      float ps = 0.f;
#pragma unroll
      for (int kt = 0; kt < 2; ++kt)
#pragma unroll
        for (int i = 0; i < 16; ++i) { const float pv = __expf(st[kt][i] - mx); st[kt][i] = pv; ps += pv; }
      l_run = l_run * alpha + ps;
#pragma unroll
      for (int dt = 0; dt < 2; ++dt)
#pragma unroll
        for (int i = 0; i < 16; ++i) ot[dt][i] *= alpha;
#pragma unroll
      for (int kt = 0; kt < 2; ++kt) {
        const bf16x8 pb0 = packs<0>(st[kt]), pb1 = packs<1>(st[kt]);
#pragma unroll
        for (int dt = 0; dt < 2; ++dt) {
          const bf16x8 pa0 = ld2x4(Vt + (dt * 32 + r) * 72 + kt * 32 + 4 * h);
          const bf16x8 pa1 = ld2x4(Vt + (dt * 32 + r) * 72 + kt * 32 + 16 + 4 * h);
          ot[dt] = MFMA(pa0, pb0, ot[dt]);
          ot[dt] = MFMA(pa1, pb1, ot[dt]);
        }
      }
    }
  }
  l_run += __shfl_xor(l_run, 32);
  const float inv = 1.f / l_run;
  u16* dst = p.hn + qtok * 1024 + qcol;
#pragma unroll
  for (int dt = 0; dt < 2; ++dt)
#pragma unroll
    for (int g4 = 0; g4 < 4; ++g4) {
      ushort4 o;
      o.x = f2bf(ot[dt][4 * g4] * inv); o.y = f2bf(ot[dt][4 * g4 + 1] * inv); o.z = f2bf(ot[dt][4 * g4 + 2] * inv); o.w = f2bf(ot[dt][4 * g4 + 3] * inv);
      *(ushort4*)(dst + dt * 32 + 8 * g4 + 4 * h) = o;
    }
}

struct ChainId { int lat, b, h, dir, T, base, nch; };
DI ChainId chain_decode(int it) {
  ChainId c; c.lat = it < 128; const int q = c.lat ? it : it - 128;
  c.b = q >> 4; c.h = (q >> 1) & 7; c.dir = q & 1; c.T = c.lat ? 4096 : 256; c.base = c.lat ? NP_ + c.b * 4096 : c.b * 256; c.nch = c.T >> 6;
  return c;
}
DI int tokof(const ChainId& c, int step, int row) { const int pp = step * 64 + row; return c.base + (c.dir ? c.T - 1 - pp : pp); }

DI void gla_chain(const P* __restrict__ gp, int jj, int it, char* smem) {
  const P& p = *gp;
  const ChainId cid = chain_decode(it);
  int tid_ = threadIdx.x; asm volatile("" : "+v"(tid_)); const int tid = tid_, lane = tid & 63, wave = tid >> 6, r = lane & 31, h = lane >> 5;
  const int hh = cid.h, dir = cid.dir;
  u16* QT = (u16*)smem; u16* KT = QT + 4608; u16* KEt = KT + 4608; u16* Vt = KEt + 4608;
  float* GL = (float*)(Vt + 4608); float* gq = GL + 1024; float* dec = gq + 256; float* Ost = dec + 64;
  const int d = tid & 63, cq = tid >> 6;
  float wg[16];
#pragma unroll
  for (int rr = 0; rr < 16; ++rr) wg[rr] = p.b_w_g2[((size_t)((jj * 2 + dir) * 16 + rr)) * 512 + hh * 64 + d];
  const float bg = p.b_b_g[(jj * 2 + dir) * 512 + hh * 64 + d];
  const int vh = wave & 1;
  f32x16 S[2]; zero16(S[0]); zero16(S[1]);
  const size_t sidx = ((size_t)(((cid.b * 2 + jj) * 2 + dir) * 8 + hh)) * 4096;
  if (wave < 2 && cid.lat) {
#pragma unroll
    for (int dt = 0; dt < 2; ++dt)
#pragma unroll
      for (int i = 0; i < 16; ++i) S[dt][i] = p.state_b[sidx + (dt * 32 + crow(i, h)) * 64 + vh * 32 + r];
  }
  for (int step_ = 0; step_ < cid.nch; ++step_) {
    int step = step_;
    asm volatile("" : "+v"(step));
    __syncthreads();
    {
      const int c = tid >> 2, sg = tid & 3;
      const int tok = tokof(cid, step, c);
      const ushort4 gv = *(const ushort4*)(p.proj + (size_t)tok * EVN + 3072 + dir * 16 + sg * 4);
      GL[c * 16 + sg * 4] = bf2f(gv.x); GL[c * 16 + sg * 4 + 1] = bf2f(gv.y); GL[c * 16 + sg * 4 + 2] = bf2f(gv.z); GL[c * 16 + sg * 4 + 3] = bf2f(gv.w);
    }
    __syncthreads();
    float Gl[16]; float run = 0.f;
#pragma unroll
    for (int i = 0; i < 16; ++i) {
      const int c = cq * 16 + i;
      float z = bg;
#pragma unroll
      for (int rr = 0; rr < 16; ++rr) z += GL[c * 16 + rr] * wg[rr];
      const float g = (fminf(z, 0.f) - log1pf(expf(-fabsf(z)))) * (1.f / 16.f);
      run += g; Gl[i] = run;
    }
    gq[cq * 64 + d] = run;
    __syncthreads();
    float off = 0.f, tot = 0.f;
#pragma unroll
    for (int q2 = 0; q2 < 4; ++q2) { const float t = gq[q2 * 64 + d]; if (q2 < cq) off += t; tot += t; }
#pragma unroll
    for (int i = 0; i < 16; ++i) {
      const int c = cq * 16 + i;
      const int tok = tokof(cid, step, c);
      const float G = Gl[i] + off;
      const u16* rowp = p.proj + (size_t)tok * EVN + hh * 64 + d;
      const float qv = bf2f(rowp[1536]), kv = bf2f(rowp[2048]);
      const u16 vb = rowp[2560];
      QT[c * 72 + d] = f2bf(qv * 0.125f * expf(G));
      KT[c * 72 + d] = f2bf(kv * expf(-G));
      KEt[d * 72 + c] = f2bf(kv * expf(tot - G));
      Vt[d * 72 + c] = vb;
    }
    if (cq == 0) dec[d] = expf(tot);
    __syncthreads();
    if (wave < 2) {
      f32x16 at[2][2];
#pragma unroll
      for (int a = 0; a < 2; ++a)
#pragma unroll
        for (int b2 = 0; b2 < 2; ++b2) zero16(at[a][b2]);
#pragma unroll
      for (int ks = 0; ks < 4; ++ks) {
        const bf16x8 a0 = *(const bf16x8*)(KT + r * 72 + ks * 16 + 8 * h), a1 = *(const bf16x8*)(KT + (32 + r) * 72 + ks * 16 + 8 * h);
        const bf16x8 b0 = *(const bf16x8*)(QT + r * 72 + ks * 16 + 8 * h), b1 = *(const bf16x8*)(QT + (32 + r) * 72 + ks * 16 + 8 * h);
        at[0][0] = MFMA(a0, b0, at[0][0]); at[0][1] = MFMA(a0, b1, at[0][1]);
        at[1][0] = MFMA(a1, b0, at[1][0]); at[1][1] = MFMA(a1, b1, at[1][1]);
      }
#pragma unroll
      for (int st = 0; st < 2; ++st)
#pragma unroll
        for (int ct = 0; ct < 2; ++ct)
#pragma unroll
          for (int i = 0; i < 16; ++i) { if (st * 32 + crow(i, h) > ct * 32 + r) at[st][ct][i] = 0.f; }
      f32x16 o[2]; zero16(o[0]); zero16(o[1]);
#pragma unroll
      for (int ct = 0; ct < 2; ++ct)
#pragma unroll
        for (int st = 0; st < 2; ++st) {
          const bf16x8 x0 = packs<0>(at[st][ct]), x1 = packs<1>(at[st][ct]);
          const bf16x8 pb0 = ld2x4(Vt + (vh * 32 + r) * 72 + st * 32 + 4 * h);
          const bf16x8 pb1 = ld2x4(Vt + (vh * 32 + r) * 72 + st * 32 + 16 + 4 * h);
          o[ct] = MFMA(x0, pb0, o[ct]);
          o[ct] = MFMA(x1, pb1, o[ct]);
        }
#pragma unroll
      for (int dt = 0; dt < 2; ++dt) {
        const bf16x8 xs0 = packs<0>(S[dt]), xs1 = packs<1>(S[dt]);
#pragma unroll
        for (int ct = 0; ct < 2; ++ct) {
          const bf16x8 pa0 = ld2x4(QT + (ct * 32 + r) * 72 + dt * 32 + 4 * h);
          const bf16x8 pa1 = ld2x4(QT + (ct * 32 + r) * 72 + dt * 32 + 16 + 4 * h);
          o[ct] = MFMA(pa0, xs0, o[ct]);
          o[ct] = MFMA(pa1, xs1, o[ct]);
        }
      }
#pragma unroll
      for (int dt = 0; dt < 2; ++dt)
#pragma unroll
        for (int i = 0; i < 16; ++i) S[dt][i] *= dec[dt * 32 + crow(i, h)];
#pragma unroll
      for (int ks = 0; ks < 4; ++ks) {
        const bf16x8 bv = *(const bf16x8*)(Vt + (vh * 32 + r) * 72 + ks * 16 + 8 * h);
#pragma unroll
        for (int dt = 0; dt < 2; ++dt) {
          const bf16x8 a = *(const bf16x8*)(KEt + (dt * 32 + r) * 72 + ks * 16 + 8 * h);
          S[dt] = MFMA(a, bv, S[dt]);
        }
      }
#pragma unroll
      for (int ct = 0; ct < 2; ++ct)
#pragma unroll
        for (int i = 0; i < 16; ++i) Ost[(ct * 32 + crow(i, h)) * 68 + vh * 32 + r] = o[ct][i];
    }
    __syncthreads();
    {
      const int c = tid >> 2, sg = tid & 3;
      const int tok = tokof(cid, step, c);
      u16* dst = (dir ? p.ot1 + (size_t)tok * 512 + hh * 64 : p.hn + (size_t)tok * 1024 + 512 + hh * 64) + sg * 16;
      bf16x8 w0, w1;
#pragma unroll
      for (int e = 0; e < 8; ++e) { w0[e] = (short)f2bf(Ost[c * 68 + sg * 16 + e]); w1[e] = (short)f2bf(Ost[c * 68 + sg * 16 + 8 + e]); }
      *(bf16x8*)dst = w0; *(bf16x8*)(dst + 8) = w1;
    }
  }
  if (wave < 2 && !cid.lat) {
#pragma unroll
    for (int dt = 0; dt < 2; ++dt)
#pragma unroll
      for (int i = 0; i < 16; ++i) p.out[OFF_SB + sidx + (dt * 32 + crow(i, h)) * 64 + vh * 32 + r] = S[dt][i];
  }
}

DI void delta_chain(const P* __restrict__ gp, int jj, int it, char* smem) {
  const P& p = *gp;
  const ChainId cid = chain_decode(it);
  int tid_ = threadIdx.x; asm volatile("" : "+v"(tid_)); const int tid = tid_, lane = tid & 63, wave = tid >> 6, r = lane & 31, h = lane >> 5;
  const int hh = cid.h, dir = cid.dir;
  u16* Qn = (u16*)smem; u16* Kn = Qn + 4608; u16* Kt = Kn + 4608; u16* AQK = Kt + 4608; u16* KC = AQK + 4608;
  float* At = (float*)(KC + 4608); float* Wv = At + 64 * 68; float* Gs = Wv + 64 * 65; float* Bt = Gs + 64;
  const float aexp = expf(p.d_a_log[(jj * 2 + dir) * 8 + hh]);
  const float dtb = p.d_dt_bias[(jj * 2 + dir) * 8 + hh];
  const int vh = wave & 1;
  f32x16 S[2]; zero16(S[0]); zero16(S[1]);
  const size_t sidx = ((size_t)(((cid.b * 2 + jj) * 2 + dir) * 8 + hh)) * 4096;
  if (wave < 2 && cid.lat) {
#pragma unroll
    for (int dt = 0; dt < 2; ++dt)
#pragma unroll
      for (int i = 0; i < 16; ++i) S[dt][i] = p.state_d[sidx + (dt * 32 + crow(i, h)) * 64 + vh * 32 + r];
  }
  const float* cwp = p.d_conv + (size_t)jj * 3 * 1536;
  for (int step_ = 0; step_ < cid.nch; ++step_) {
    int step = step_;
    asm volatile("" : "+v"(step));
    __syncthreads();
    if (wave == 0) {
      const int tok = tokof(cid, step, lane);
      const float da = bf2f(p.proj[(size_t)tok * ODN + 2304 + dir * 8 + hh]);
      const float db = bf2f(p.proj[(size_t)tok * ODN + 2320 + dir * 8 + hh]);
      const float x = da + dtb;
      const float sp = x > 20.f ? x : log1pf(expf(x));
      float G = -aexp * sp;
#pragma unroll
      for (int o = 1; o < 64; o <<= 1) { const float t = __shfl_up(G, o); if (lane >= o) G += t; }
      Gs[lane] = G; Bt[lane] = 1.f / (1.f + expf(-db));
    }
    {
      const int c = tid >> 2, sg = tid & 3;
      const int tok = tokof(cid, step, c);
      const int pos = tok - cid.base;
      const bool hp = pos > 0, hn_ = pos < cid.T - 1;
      for (int wh = 0; wh < 3; ++wh) {
        const int ch0 = wh * 512 + hh * 64 + sg * 16;
        const u16* cur = p.proj + (size_t)tok * ODN + 768 + ch0;
        float y[16];
        float ss = 0.f;
#pragma unroll
        for (int hf = 0; hf < 2; ++hf) {
          const bf16x8 xc = *(const bf16x8*)(cur + hf * 8);
          bf16x8 xp, xn;
#pragma unroll
          for (int e = 0; e < 8; ++e) { xp[e] = 0; xn[e] = 0; }
          if (hp) xp = *(const bf16x8*)(cur - ODN + hf * 8);
          if (hn_) xn = *(const bf16x8*)(cur + ODN + hf * 8);
#pragma unroll
          for (int e = 0; e < 8; ++e) {
            const int ch = ch0 + hf * 8 + e;
            float v = cwp[ch] * bf2f((u16)xp[e]) + cwp[1536 + ch] * bf2f((u16)xc[e]) + cwp[3072 + ch] * bf2f((u16)xn[e]);
            v = v / (1.f + expf(-v));
            y[hf * 8 + e] = v; ss += v * v;
          }
        }
        ss += __shfl_xor(ss, 1); ss += __shfl_xor(ss, 2);
        const float rn = rsqrtf(ss + 1e-6f);
        if (wh == 0) {
#pragma unroll
          for (int e = 0; e < 16; ++e) Qn[c * 72 + sg * 16 + e] = f2bf(y[e] * rn * 0.125f);
        } else if (wh == 1) {
#pragma unroll
          for (int e = 0; e < 16; ++e) { const u16 kb = f2bf(y[e] * rn); Kn[c * 72 + sg * 16 + e] = kb; Kt[(sg * 16 + e) * 72 + c] = kb; }
        } else {
#pragma unroll
          for (int e = 0; e < 16; ++e) Wv[c * 65 + sg * 16 + e] = y[e];
        }
      }
    }
    __syncthreads();
    if (wave < 2) {
      f32x16 akk[2], aqk[2]; zero16(akk[0]); zero16(akk[1]); zero16(aqk[0]); zero16(aqk[1]);
#pragma unroll
      for (int ks = 0; ks < 4; ++ks) {
        const bf16x8 bk = *(const bf16x8*)(Kn + (vh * 32 + r) * 72 + ks * 16 + 8 * h);
#pragma unroll
        for (int ct = 0; ct < 2; ++ct) {
          const bf16x8 ak = *(const bf16x8*)(Kn + (ct * 32 + r) * 72 + ks * 16 + 8 * h);
          const bf16x8 aq = *(const bf16x8*)(Qn + (ct * 32 + r) * 72 + ks * 16 + 8 * h);
          akk[ct] = MFMA(ak, bk, akk[ct]);
          aqk[ct] = MFMA(aq, bk, aqk[ct]);
        }
      }
      const int s = vh * 32 + r;
      const float Gss = Gs[s];
#pragma unroll
      for (int ct = 0; ct < 2; ++ct)
#pragma unroll
        for (int g4 = 0; g4 < 4; ++g4) {
          const int c0 = ct * 32 + 8 * g4 + 4 * h;
          float4 val;
#pragma unroll
          for (int e = 0; e < 4; ++e) {
            const int c = c0 + e;
            const float gam = expf(fminf(Gs[c] - Gss, 0.f));
            const float av = (s < c) ? akk[ct][4 * g4 + e] * Bt[c] * gam : 0.f;
            if (e == 0) val.x = av; else if (e == 1) val.y = av; else if (e == 2) val.z = av; else val.w = av;
            AQK[c * 72 + s] = f2bf((s <= c) ? aqk[ct][4 * g4 + e] * gam : 0.f);
          }
          *(float4*)(At + s * 68 + c0) = val;
        }
    }
    __syncthreads();
    if (wave < 2) {
      const bool isv = wave == 0;
      const int col = lane;
#pragma unroll 1
      for (int bi = 0; bi < 4; ++bi) {
        float acc[16];
#pragma unroll
        for (int ci = 0; ci < 16; ++ci) {
          const int c = 16 * bi + ci;
          acc[ci] = isv ? Wv[c * 65 + col] * Bt[c] : bf2f(Kn[c * 72 + col]) * Bt[c] * expf(Gs[c]);
        }
        for (int s2 = 0; s2 < 16 * bi; ++s2) {
          const float xs = isv ? Wv[s2 * 65 + col] : bf2f(KC[s2 * 72 + col]);
          const float4* a4 = (const float4*)(At + s2 * 68 + 16 * bi);
#pragma unroll
          for (int q = 0; q < 4; ++q) {
            const float4 a = a4[q];
            acc[4 * q] -= a.x * xs; acc[4 * q + 1] -= a.y * xs; acc[4 * q + 2] -= a.z * xs; acc[4 * q + 3] -= a.w * xs;
          }
        }
#pragma unroll
        for (int ci = 0; ci < 16; ++ci) {
          const float x = acc[ci];
          const float* arow = At + (16 * bi + ci) * 68 + 16 * bi;
#pragma unroll
          for (int cj = ci + 1; cj < 16; ++cj) acc[cj] -= arow[cj] * x;
          if (isv) Wv[(16 * bi + ci) * 65 + col] = x; else KC[(16 * bi + ci) * 72 + col] = f2bf(x);
        }
      }
    }
    __syncthreads();
    if (wave < 2) {
      f32x16 kS[2], qS[2]; zero16(kS[0]); zero16(kS[1]); zero16(qS[0]); zero16(qS[1]);
#pragma unroll
      for (int dt = 0; dt < 2; ++dt) {
        const bf16x8 xs0 = packs<0>(S[dt]), xs1 = packs<1>(S[dt]);
#pragma unroll
        for (int ct = 0; ct < 2; ++ct) {
          kS[ct] = MFMA(ld2x4(KC + (ct * 32 + r) * 72 + dt * 32 + 4 * h), xs0, kS[ct]);
          kS[ct] = MFMA(ld2x4(KC + (ct * 32 + r) * 72 + dt * 32 + 16 + 4 * h), xs1, kS[ct]);
          qS[ct] = MFMA(ld2x4(Qn + (ct * 32 + r) * 72 + dt * 32 + 4 * h), xs0, qS[ct]);
          qS[ct] = MFMA(ld2x4(Qn + (ct * 32 + r) * 72 + dt * 32 + 16 + 4 * h), xs1, qS[ct]);
        }
      }
      f32x16 vn[2], o[2];
      const float Glast = Gs[63];
#pragma unroll
      for (int ct = 0; ct < 2; ++ct)
#pragma unroll
        for (int i = 0; i < 16; ++i) {
          const int c = ct * 32 + crow(i, h);
          vn[ct][i] = Wv[c * 65 + vh * 32 + r] - kS[ct][i];
          o[ct][i] = qS[ct][i] * expf(Gs[c]);
        }
#pragma unroll
      for (int st = 0; st < 2; ++st) {
        const bf16x8 xs0 = packs<0>(vn[st]), xs1 = packs<1>(vn[st]);
#pragma unroll
        for (int ct = 0; ct < 2; ++ct) {
          o[ct] = MFMA(ld2x4(AQK + (ct * 32 + r) * 72 + st * 32 + 4 * h), xs0, o[ct]);
          o[ct] = MFMA(ld2x4(AQK + (ct * 32 + r) * 72 + st * 32 + 16 + 4 * h), xs1, o[ct]);
        }
      }
      const float dl = expf(Glast);
#pragma unroll
      for (int st = 0; st < 2; ++st)
#pragma unroll
        for (int i = 0; i < 16; ++i) vn[st][i] *= expf(Glast - Gs[st * 32 + crow(i, h)]);
#pragma unroll
      for (int dt = 0; dt < 2; ++dt)
#pragma unroll
        for (int i = 0; i < 16; ++i) S[dt][i] *= dl;
#pragma unroll
      for (int st = 0; st < 2; ++st) {
        const bf16x8 xs0 = packs<0>(vn[st]), xs1 = packs<1>(vn[st]);
#pragma unroll
        for (int dt = 0; dt < 2; ++dt) {
          S[dt] = MFMA(ld2x4(Kt + (dt * 32 + r) * 72 + st * 32 + 4 * h), xs0, S[dt]);
          S[dt] = MFMA(ld2x4(Kt + (dt * 32 + r) * 72 + st * 32 + 16 + 4 * h), xs1, S[dt]);
        }
      }
#pragma unroll
      for (int ct = 0; ct < 2; ++ct)
#pragma unroll
        for (int i = 0; i < 16; ++i) At[(ct * 32 + crow(i, h)) * 68 + vh * 32 + r] = o[ct][i];
    }
    __syncthreads();
    {
      const int c = tid >> 2, sg = tid & 3;
      const int tok = tokof(cid, step, c);
      u16* dst = (dir ? p.ot1 + (size_t)tok * 512 + hh * 64 : p.hn + (size_t)tok * 1024 + 512 + hh * 64) + sg * 16;
      bf16x8 w0, w1;
#pragma unroll
      for (int e = 0; e < 8; ++e) { w0[e] = (short)f2bf(At[c * 68 + sg * 16 + e]); w1[e] = (short)f2bf(At[c * 68 + sg * 16 + 8 + e]); }
      *(bf16x8*)dst = w0; *(bf16x8*)(dst + 8) = w1;
    }
  }
  if (wave < 2 && !cid.lat) {
#pragma unroll
    for (int dt = 0; dt < 2; ++dt)
#pragma unroll
      for (int i = 0; i < 16; ++i) p.out[OFF_SD + sidx + (dt * 32 + crow(i, h)) * 64 + vh * 32 + r] = S[dt][i];
  }
}

DI void mixer_phase(const P* __restrict__ gp, int l, char* smem) {
  const P& p = *gp;
  const bool even = !(l & 1); const int jj = l >> 1;
  const int total = 384 + 256 + 2048;
  for (int item = blockIdx.x; item < total; item += gridDim.x) {
    if (item < 384) { if (even) gla_chain(gp, jj, item, smem); else delta_chain(gp, jj, item, smem); }
    else if (item < 640) { if (even) attn_item<0>(gp, jj, item - 384, smem); else attn_item<2>(gp, jj, item - 384, smem); }
    else { if (even) attn_item<1>(gp, jj, item - 640, smem); else attn_item<3>(gp, jj, item - 640, smem); }
  }
}

DI void finalize_phase(const P* __restrict__ gp, int l) {
  const P& p = *gp;
  const bool even = !(l & 1); const int jj = l >> 1;
  int tid_ = threadIdx.x; asm volatile("" : "+v"(tid_)); const int tid = tid_;
  const int tk = tid >> 5, hh = (tid >> 2) & 7, sg = tid & 3;
  const int PS = even ? EVN : ODN; const int zcol = even ? 3104 : 2336;
  for (int item = blockIdx.x; item < NT_ / 8; item += gridDim.x) {
    const size_t tok = (size_t)item * 8 + tk;
    u16* a = p.hn + tok * 1024 + 512 + hh * 64 + sg * 16;
    const u16* bsrc = p.ot1 + tok * 512 + hh * 64 + sg * 16;
    const u16* zs = p.proj + tok * PS + zcol + hh * 64 + sg * 16;
    float o[16]; float ss = 0.f;
#pragma unroll
    for (int hf = 0; hf < 2; ++hf) {
      const bf16x8 x0 = *(const bf16x8*)(a + hf * 8), x1 = *(const bf16x8*)(bsrc + hf * 8);
#pragma unroll
      for (int e = 0; e < 8; ++e) { const float v = bf2f((u16)x0[e]) + bf2f((u16)x1[e]); o[hf * 8 + e] = v; ss += v * v; }
    }
    ss += __shfl_xor(ss, 1); ss += __shfl_xor(ss, 2);
    const float rstd = rsqrtf(ss * (1.f / 64.f) + 1e-6f);
    const float* ng = even ? p.b_norm_g + jj * 512 + hh * 64 + sg * 16 : p.d_norm_g + jj * 64 + sg * 16;
#pragma unroll
    for (int hf = 0; hf < 2; ++hf) {
      const bf16x8 z = *(const bf16x8*)(zs + hf * 8);
      bf16x8 w;
#pragma unroll
      for (int e = 0; e < 8; ++e) { const float zz = bf2f((u16)z[e]); w[e] = (short)f2bf(o[hf * 8 + e] * rstd * ng[hf * 8 + e] * siluf(zz)); }
      *(bf16x8*)(a + hf * 8) = w;
    }
  }
}

DI void run_phase(const P* __restrict__ gp, int ph, char* smem) {
  const P& p = *gp;
  if (ph == 0) { prep_phase(gp, smem); return; }
  if (ph == NPH - 1) { norm_phase(gp, 0, 0, false, true); return; }
  const int l = (ph - 1) >> 3, s = (ph - 1) & 7;
  const bool even = !(l & 1);
  const u16* W = p.wt + (size_t)l * LW;
  switch (s) {
    case 0: norm_phase(gp, l, 0, l == 0, false); break;
    case 1: gemm_phase<EPI_PROJ>(gp, l, smem, p.hn, 1024, W + WO_IN, 1024, 1024, 288, even ? 29 : 23, 0); break;
    case 2: mixer_phase(gp, l, smem); break;
    case 3: finalize_phase(gp, l); break;
    case 4: gemm_phase<EPI_RES>(gp, l, smem, p.hn, 1024, W + WO_OUT, 1024, 1024, 288, 8, 2); break;
    case 5: norm_phase(gp, l, 1, false, false); break;
    case 6: gemm_phase<EPI_FFN>(gp, l, smem, p.hn, 1024, W + WO_UP, 1024, 1024, 312, 44, 0); break;
    case 7: gemm_phase<EPI_RES>(gp, l, smem, p.proj, 2816, W + WO_DN, 2816, 2816, 288, 8, 5); break;
  }
}

__global__ void __launch_bounds__(256) mk(P p, P* gp, int ph0, int ph1) {
  __shared__ __attribute__((aligned(16))) char smem[SMEM_BYTES];
  if (threadIdx.x == 0) *gp = p;
  __threadfence();
  __syncthreads();
  if (ph1 - ph0 > 1) {
    cg::grid_group grid = cg::this_grid();
    for (int ph = ph0; ph < ph1; ++ph) {
      run_phase(gp, ph, smem);
      if (ph + 1 < ph1) grid.sync();
    }
  } else {
    run_phase(gp, ph0, smem);
  }
}

extern "C" void kernel_launch(void* const* d_in, const int* in_sizes, int n_in, void* d_out, int out_size, void* d_ws, size_t ws_size,
                              hipStream_t stream) {
  P p{};
  const float** f = (const float**)&p;
  for (int i = 0; i < 31; ++i) f[i] = (const float*)d_in[i];
  p.out = (float*)d_out;
  char* ws = (char*)d_ws;
  size_t off = 0;
  p.hn = (u16*)(ws + off); off += (size_t)NT_ * 1024 * 2;
  p.proj = (u16*)(ws + off); off += (size_t)NT_ * EVN * 2;
  p.ot1 = (u16*)(ws + off); off += (size_t)NT_ * 512 * 2;
  p.wt = (u16*)(ws + off); off += 4 * LW * 2;
  p.mods = (float*)(ws + off); off += 4 * 9 * 6144 * 4;
  p.rope = (float*)(ws + off); off += 64 * 16 * 2 * 4;
  P* gp = (P*)(ws + off); off += 4096;
  static int grid_blocks = 0;
  if (!grid_blocks) {
    int dev = 0, cus = 0, per_cu = 0;
    hipGetDevice(&dev);
    hipDeviceGetAttribute(&cus, hipDeviceAttributeMultiprocessorCount, dev);
    hipOccupancyMaxActiveBlocksPerMultiprocessor(&per_cu, mk, 256, 0);
    if (per_cu < 1) per_cu = 1;
    if (per_cu > 2) per_cu = 2;
    grid_blocks = cus * per_cu;
  }
#if MK_MULTI
  for (int ph = 0; ph < NPH; ++ph) {
    int a = ph, b = ph + 1;
    hipLaunchKernelGGL(mk, dim3(grid_blocks), dim3(256), 0, stream, p, gp, a, b);
  }
#else
  int ph0 = 0, ph1 = NPH;
  void* args[] = {&p, &gp, &ph0, &ph1};
  hipError_t e = hipLaunchCooperativeKernel((void*)mk, dim3(grid_blocks), dim3(256), args, 0, stream);
  if (e != hipSuccess) fprintf(stderr, "cooperative launch failed: %s (grid %d)\n", hipGetErrorString(e), grid_blocks);
#endif
}
```

```cpp
#include <hip/hip_runtime.h>
#include <hip/hip_cooperative_groups.h>
#include <cstdio>
namespace cg = cooperative_groups;

#ifndef MK_MULTI
#define MK_MULTI 0
#endif

#define DI __device__ __forceinline__
#define DN __device__ __noinline__
typedef unsigned short u16;
typedef __attribute__((ext_vector_type(8))) short bf16x8;
typedef __attribute__((ext_vector_type(4))) short s16x4;
typedef __attribute__((ext_vector_type(16))) float f32x16;
#define MFMA(a, b, c) __builtin_amdgcn_mfma_f32_32x32x16_bf16((a), (b), (c), 0, 0, 0)

static constexpr int NP_ = 4096, NT_ = 36864;
static constexpr int EVN = 3616, ODN = 2848;
static constexpr size_t OFF_AK = 37748736, OFF_AV = 41943040, OFF_SB = 46137344, OFF_CK = 48234496, OFF_CV = 49283072, OFF_SD = 50331648;
static constexpr size_t LW = 13500416, WO_UP = 0, WO_DN = 5767168, WO_IN = 8650752, WO_OUT = 12451840;
static constexpr int NPH = 34;
static constexpr int SMEM_BYTES = 80 * 1024;

struct P {
  const float *x_prompt, *x_sample, *cache_a_k, *cache_a_v, *state_b, *cache_c_k, *cache_c_v, *state_d, *c, *c_ctx, *ada_w, *ada_b,
      *norm1_g, *norm2_g, *ffn_up, *ffn_conv, *ffn_down, *ev_w_in, *ev_w_out, *a_rpb, *b_w_g2, *b_b_g, *b_norm_g, *od_w_in, *od_w_out,
      *c_sink, *d_conv, *d_a_log, *d_dt_bias, *d_norm_g, *final_g;
  float* out;
  u16 *hn, *proj, *ot1, *wt;
  float *mods, *rope;
  int* cnt;
};

DI u16 f2bf(float x) { unsigned u = __float_as_uint(x); u += 0x7fffu + ((u >> 16) & 1u); return (u16)(u >> 16); }
DI float bf2f(u16 b) { return __uint_as_float(((unsigned)b) << 16); }
DI int crow(int i, int h) { return (i & 3) + 8 * (i >> 2) + 4 * h; }
template <int S> DI bf16x8 packs(const f32x16& x) {
  bf16x8 v;
#pragma unroll
  for (int j = 0; j < 8; ++j) v[j] = (short)f2bf(x[8 * S + j]);
  return v;
}
DI bf16x8 ld2x4(const u16* p) {
  s16x4 lo = *(const s16x4*)p, hi = *(const s16x4*)(p + 8);
  return __builtin_shufflevector(lo, hi, 0, 1, 2, 3, 4, 5, 6, 7);
}
DI float siluf(float x) { return x / (1.f + __expf(-x)); }
DI void zero16(f32x16& a) {
#pragma unroll
  for (int i = 0; i < 16; ++i) a[i] = 0.f;
}

DI void prep_phase(const P* __restrict__ gp, char* smem) {
  const P& p = *gp;
  int tid_ = threadIdx.x; asm volatile("" : "+v"(tid_)); const int tid = tid_;
  const int NWT = 4 * (1408 + 704 + 256) + 2 * (928 + 736);
  const int NADA = 384;
  const int total = NWT + NADA + 1;
  for (int item = blockIdx.x; item < total; item += gridDim.x) {
    if (item < NWT) {
      int rem = item; const float* src = nullptr; u16* dst = nullptr; int K = 0, N = 0, NPd = 0;
      for (int l = 0; l < 4; ++l) {
        const int jj = l >> 1; const bool ev = !(l & 1);
        const int nin = ev ? 928 : 736;
        if (rem < 1408) { src = p.ffn_up + (size_t)l * 1024 * 5632; dst = p.wt + l * LW + WO_UP; K = 1024; N = 5632; NPd = 5632; break; }
        rem -= 1408;
        if (rem < 704) { src = p.ffn_down + (size_t)l * 2816 * 1024; dst = p.wt + l * LW + WO_DN; K = 2816; N = 1024; NPd = 1024; break; }
        rem -= 704;
        if (rem < nin) { src = ev ? p.ev_w_in + (size_t)jj * 1024 * EVN : p.od_w_in + (size_t)jj * 1024 * ODN; dst = p.wt + l * LW + WO_IN; K = 1024; N = ev ? EVN : ODN; NPd = ev ? 3712 : 2944; break; }
        rem -= nin;
        if (rem < 256) { src = (ev ? p.ev_w_out : p.od_w_out) + (size_t)jj * 1024 * 1024; dst = p.wt + l * LW + WO_OUT; K = 1024; N = 1024; NPd = 1024; break; }
        rem -= 256;
      }
      const int ntn = NPd >> 6;
      const int tk = rem / ntn, tn = rem - tk * ntn;
      float* T = (float*)smem;
      __syncthreads();
#pragma unroll
      for (int i = 0; i < 16; ++i) {
        const int k = i * 4 + (tid >> 6), n = tid & 63;
        const int gn = tn * 64 + n;
        T[k * 65 + n] = (gn < N) ? src[(size_t)(tk * 64 + k) * N + gn] : 0.f;
      }
      __syncthreads();
#pragma unroll
      for (int i = 0; i < 16; ++i) {
        const int n = i * 4 + (tid >> 6), k = tid & 63;
        dst[(size_t)(tn * 64 + n) * K + tk * 64 + k] = f2bf(T[k * 65 + n]);
      }
    } else if (item < NWT + NADA) {
      const int it = item - NWT; const int l = it / 96, cgp = it - l * 96; const int n0 = cgp * 64;
      float* sc = (float*)smem;
      float* red = sc + 9 * 1024;
      __syncthreads();
      for (int idx = tid; idx < 9 * 1024; idx += 256) {
        const int ci = idx >> 10, k = idx & 1023;
        const float x = ci < 8 ? p.c[ci * 1024 + k] : p.c_ctx[k];
        sc[idx] = x / (1.f + expf(-x));
      }
      __syncthreads();
      const int wave = tid >> 6, lane = tid & 63;
      float acc[9];
#pragma unroll
      for (int ci = 0; ci < 9; ++ci) acc[ci] = 0.f;
      const float* wp = p.ada_w + ((size_t)l * 1024 + wave * 256) * 6144 + n0 + lane;
#pragma unroll 8
      for (int k = 0; k < 256; ++k) {
        const float wv = wp[(size_t)k * 6144];
#pragma unroll
        for (int ci = 0; ci < 9; ++ci) acc[ci] += sc[ci * 1024 + wave * 256 + k] * wv;
      }
#pragma unroll
      for (int ci = 0; ci < 9; ++ci) red[(wave * 9 + ci) * 64 + lane] = acc[ci];
      __syncthreads();
      for (int idx = tid; idx < 576; idx += 256) {
        const int ci = idx >> 6, col = idx & 63;
        const float s = red[(0 * 9 + ci) * 64 + col] + red[(1 * 9 + ci) * 64 + col] + red[(2 * 9 + ci) * 64 + col] + red[(3 * 9 + ci) * 64 + col];
        p.mods[(size_t)(l * 9 + ci) * 6144 + n0 + col] = s + p.ada_b[l * 6144 + n0 + col];
      }
    } else {
      if (tid < 8) p.cnt[tid] = 0;
      for (int idx = tid; idx < 1024; idx += 256) {
        const int pos = idx >> 4, fi = idx & 15;
        const float inv = powf(10000.f, -(float)fi / 16.f);
        const float ang = (float)pos * inv;
        p.rope[idx * 2] = cosf(ang); p.rope[idx * 2 + 1] = sinf(ang);
      }
    }
  }
}

DI void norm_phase(const P* __restrict__ gp, int l, int which, bool first, bool fin) {
  const P& p = *gp;
  int tid_ = threadIdx.x; asm volatile("" : "+v"(tid_)); const int tid = tid_, lane = tid & 63, wave = tid >> 6;
  for (int item = blockIdx.x; item < NT_ / 4; item += gridDim.x) {
    const int tok = item * 4 + wave;
    const float* src = first ? (tok < NP_ ? p.x_prompt + (size_t)tok * 1024 : p.x_sample + (size_t)(tok - NP_) * 1024) : p.out + (size_t)tok * 1024;
    float4 v[4];
    float ss = 0.f;
#pragma unroll
    for (int i = 0; i < 4; ++i) { v[i] = ((const float4*)src)[lane + 64 * i]; ss += v[i].x * v[i].x + v[i].y * v[i].y + v[i].z * v[i].z + v[i].w * v[i].w; }
#pragma unroll
    for (int o = 32; o >= 1; o >>= 1) ss += __shfl_xor(ss, o);
    const float rstd = rsqrtf(ss * (1.f / 1024.f) + 1e-6f);
    if (fin) {
#pragma unroll
      for (int i = 0; i < 4; ++i) {
        const float4 g = ((const float4*)p.final_g)[lane + 64 * i];
        float4 y; y.x = v[i].x * rstd * g.x; y.y = v[i].y * rstd * g.y; y.z = v[i].z * rstd * g.z; y.w = v[i].w * rstd * g.w;
        ((float4*)(p.out + (size_t)tok * 1024))[lane + 64 * i] = y;
      }
    } else {
      const int ci = tok < NP_ ? 8 : (tok - NP_) >> 12;
      const float* md = p.mods + (size_t)(l * 9 + ci) * 6144 + which * 3072;
      const float* gp = (which ? p.norm2_g : p.norm1_g) + l * 1024;
#pragma unroll
      for (int i = 0; i < 4; ++i) {
        const float4 g = ((const float4*)gp)[lane + 64 * i];
        const float4 sh = ((const float4*)md)[lane + 64 * i];
        const float4 sc = ((const float4*)(md + 1024))[lane + 64 * i];
        ushort4 o;
        o.x = f2bf(v[i].x * rstd * g.x * (1.f + sc.x) + sh.x);
        o.y = f2bf(v[i].y * rstd * g.y * (1.f + sc.y) + sh.y);
        o.z = f2bf(v[i].z * rstd * g.z * (1.f + sc.z) + sh.z);
        o.w = f2bf(v[i].w * rstd * g.w * (1.f + sc.w) + sh.w);
        ((ushort4*)(p.hn + (size_t)tok * 1024))[lane + 64 * i] = o;
        if (first) ((float4*)(p.out + (size_t)tok * 1024))[lane + 64 * i] = v[i];
      }
    }
  }
}

DI uint4 ldsel(const u16* pv, const u16* safe, unsigned ok) {
  uint4 t = *(const uint4*)(ok ? pv : safe);
  if (!ok) { t.x = 0; t.y = 0; t.z = 0; t.w = 0; }
  return t;
}
enum { EPI_PROJ = 0, EPI_RES = 1, EPI_FFN = 2 };

template <int EPI>
DI void gemm_phase(const P* __restrict__ gp, int l, char* smem, const u16* __restrict__ A, int lda, const u16* __restrict__ B, int ldb, int K, int MT,
                   int NTn, int gsel) {
  const P& p = *gp;
  u16* As = (u16*)smem;
  int tid_ = threadIdx.x; asm volatile("" : "+v"(tid_)); const int tid = tid_, lane = tid & 63, wave = tid >> 6, r = lane & 31, h = lane >> 5;
  const int wm = wave & 1, wn = wave >> 1;
  const int KT = K >> 6;
  const bool even = !(l & 1); const int jj = l >> 1;
  const int ntiles = MT * NTn;
  const int nlb = gridDim.x >> 3, xcd = blockIdx.x & 7, lb = blockIdx.x >> 3;
  for (int it = 0;; ++it) {
    const int g = (it * 8 + xcd) * nlb + lb;
    if (g >= ntiles) break;
    const int band = g / (4 * NTn); const int rem = g - band * 4 * NTn;
    const int nt = rem >> 2, mt = band * 4 + (rem & 3);
    int seqbase = 0, L = 0, tin0 = 0;
    if (EPI == EPI_FFN) {
      if (mt < 48) { const int sq = mt / 3; L = 256; seqbase = sq * 256; tin0 = (mt - sq * 3) * 126; }
      else { const int m2 = mt - 48; const int sq = m2 / 33; L = 4096; seqbase = NP_ + sq * 4096; tin0 = (m2 - sq * 33) * 126; }
    }
    const int row0 = tid >> 3, kc0 = (tid & 7) * 8;
    const long arow0 = (EPI == EPI_FFN) ? (long)seqbase + tin0 - 1 + row0 : (long)mt * 128 + row0;
    const u16* abase = A + arow0 * lda + kc0;
    unsigned avalid = 0;
#pragma unroll
    for (int i = 0; i < 4; ++i) {
      if (EPI == EPI_FFN) { const int ts = tin0 - 1 + row0 + 32 * i; if (ts >= 0 && ts < L) avalid |= 1u << i; }
      else avalid |= 1u << i;
    }
    const u16* bbase = B + (size_t)((EPI == EPI_FFN) ? nt * 64 + row0 : nt * 128 + row0) * ldb + kc0;
#define BOFFR(i) ((EPI == EPI_FFN) ? ((i) < 2 ? 32 * (i) : 2752 + 32 * (i)) : 32 * (i))
    f32x16 acc[2][2];
#pragma unroll
    for (int a = 0; a < 2; ++a)
#pragma unroll
      for (int b = 0; b < 2; ++b) zero16(acc[a][b]);
#define GLD_A(i, ko) ldsel(abase + (size_t)(32 * (i)) * lda + (ko), A, (avalid >> (i)) & 1u)
#define GLD_B(i, ko) (*(const uint4*)(bbase + (size_t)BOFFR(i) * ldb + (ko)))
    uint4 ra0 = GLD_A(0, 0), ra1 = GLD_A(1, 0), ra2 = GLD_A(2, 0), ra3 = GLD_A(3, 0);
    uint4 rb0 = GLD_B(0, 0), rb1 = GLD_B(1, 0), rb2 = GLD_B(2, 0), rb3 = GLD_B(3, 0);
    uint4 sa0 = GLD_A(0, 64), sa1 = GLD_A(1, 64), sa2 = GLD_A(2, 64), sa3 = GLD_A(3, 64);
    uint4 sb0 = GLD_B(0, 64), sb1 = GLD_B(1, 64), sb2 = GLD_B(2, 64), sb3 = GLD_B(3, 64);
#define LSTORE(buf, A0, A1, A2, A3, B0, B1, B2, B3) { \
      u16* ad = As + (buf) * 18432 + row0 * 72 + kc0; u16* bd = ad + 9216; \
      *(uint4*)(ad) = A0; *(uint4*)(ad + 32 * 72) = A1; *(uint4*)(ad + 64 * 72) = A2; *(uint4*)(ad + 96 * 72) = A3; \
      *(uint4*)(bd) = B0; *(uint4*)(bd + 32 * 72) = B1; *(uint4*)(bd + 64 * 72) = B2; *(uint4*)(bd + 96 * 72) = B3; }
#define COMPUTE(buf) { \
      const u16* Ab = As + (buf) * 18432; const u16* Bb = Ab + 9216; \
      _Pragma("unroll") for (int ks = 0; ks < 4; ++ks) { \
        const bf16x8 a0 = *(const bf16x8*)(Ab + (wm * 64 + r) * 72 + ks * 16 + h * 8); \
        const bf16x8 a1 = *(const bf16x8*)(Ab + (wm * 64 + 32 + r) * 72 + ks * 16 + h * 8); \
        const bf16x8 b0 = *(const bf16x8*)(Bb + (wn * 64 + r) * 72 + ks * 16 + h * 8); \
        const bf16x8 b1 = *(const bf16x8*)(Bb + (wn * 64 + 32 + r) * 72 + ks * 16 + h * 8); \
        acc[0][0] = MFMA(a0, b0, acc[0][0]); acc[0][1] = MFMA(a0, b1, acc[0][1]); \
        acc[1][0] = MFMA(a1, b0, acc[1][0]); acc[1][1] = MFMA(a1, b1, acc[1][1]); } }
    LSTORE(0, ra0, ra1, ra2, ra3, rb0, rb1, rb2, rb3);
    ra0 = GLD_A(0, 128); ra1 = GLD_A(1, 128); ra2 = GLD_A(2, 128); ra3 = GLD_A(3, 128);
    rb0 = GLD_B(0, 128); rb1 = GLD_B(1, 128); rb2 = GLD_B(2, 128); rb3 = GLD_B(3, 128);
    __syncthreads();
    for (int kt = 0; kt < KT; kt += 2) {
      COMPUTE(0);
      LSTORE(1, sa0, sa1, sa2, sa3, sb0, sb1, sb2, sb3);
      if (kt + 3 < KT) {
        const int ko = (kt + 3) * 64;
        sa0 = GLD_A(0, ko); sa1 = GLD_A(1, ko); sa2 = GLD_A(2, ko); sa3 = GLD_A(3, ko);
        sb0 = GLD_B(0, ko); sb1 = GLD_B(1, ko); sb2 = GLD_B(2, ko); sb3 = GLD_B(3, ko);
      }
      __syncthreads();
      COMPUTE(1);
      if (kt + 2 < KT) {
        LSTORE(0, ra0, ra1, ra2, ra3, rb0, rb1, rb2, rb3);
        if (kt + 4 < KT) {
          const int ko = (kt + 4) * 64;
          ra0 = GLD_A(0, ko); ra1 = GLD_A(1, ko); ra2 = GLD_A(2, ko); ra3 = GLD_A(3, ko);
          rb0 = GLD_B(0, ko); rb1 = GLD_B(1, ko); rb2 = GLD_B(2, ko); rb3 = GLD_B(3, ko);
        }
      }
      __syncthreads();
    }
    if (EPI == EPI_PROJ) {
      const int N = even ? EVN : ODN;
#pragma unroll
      for (int tm = 0; tm < 2; ++tm)
#pragma unroll
        for (int tn = 0; tn < 2; ++tn) {
          const int col = nt * 128 + wn * 64 + tn * 32 + r;
          if (col < N) {
#pragma unroll
            for (int i = 0; i < 16; ++i) {
              const int row = mt * 128 + wm * 64 + tm * 32 + crow(i, h);
              const float v = acc[tm][tn][i];
              p.proj[(size_t)row * N + col] = f2bf(v);
              if (row < NP_) {
                const int b = row >> 8, t = row & 255, d = col & 63;
                if (even) {
                  if (col >= 512 && col < 1536) {
                    const int wh = (col - 512) >> 9, hh = ((col - 512) >> 6) & 7;
                    p.out[(wh ? OFF_AV : OFF_AK) + ((size_t)(((b * 2 + jj) * 8 + hh) * 256 + t)) * 64 + d] = v;
                  }
                } else {
                  if (col >= 512 && col < 768) {
                    const int wh = (col - 512) >> 7, kv = ((col - 512) >> 6) & 1;
                    p.out[(wh ? OFF_CV : OFF_CK) + ((size_t)(((b * 2 + jj) * 2 + kv) * 256 + t)) * 64 + d] = v;
                  }
                }
              }
            }
          }
        }
    } else if (EPI == EPI_RES) {
#pragma unroll
      for (int tm = 0; tm < 2; ++tm)
#pragma unroll
        for (int tn = 0; tn < 2; ++tn) {
          const int col = nt * 128 + wn * 64 + tn * 32 + r;
#pragma unroll
          for (int i = 0; i < 16; ++i) {
            const int row = mt * 128 + wm * 64 + tm * 32 + crow(i, h);
            const int ci = row < NP_ ? 8 : (row - NP_) >> 12;
            const float g = p.mods[(size_t)(l * 9 + ci) * 6144 + gsel * 1024 + col];
            float* xp = p.out + (size_t)row * 1024 + col;
            *xp = *xp + g * acc[tm][tn][i];
          }
        }
    } else {
      __syncthreads();
      float* U = (float*)smem;
#pragma unroll
      for (int tm = 0; tm < 2; ++tm)
#pragma unroll
        for (int tn = 0; tn < 2; ++tn)
#pragma unroll
          for (int i = 0; i < 16; ++i) U[(wm * 64 + tm * 32 + crow(i, h)) * 132 + wn * 64 + tn * 32 + r] = acc[tm][tn][i];
      __syncthreads();
      const float* cw = p.ffn_conv + (size_t)l * 3 * 5632;
      const int f = tid & 63, rg = tid >> 6; const int fg = nt * 64 + f;
      const float wa0 = cw[fg], wa1 = cw[5632 + fg], wa2 = cw[2 * 5632 + fg];
      const float wg0 = cw[2816 + fg], wg1 = cw[5632 + 2816 + fg], wg2 = cw[2 * 5632 + 2816 + fg];
      u16* act = p.proj;
      for (int rr = 1 + rg; rr <= 126; rr += 4) {
        const int ts = tin0 - 1 + rr;
        if (ts >= L) break;
        const float a = wa0 * U[(rr - 1) * 132 + f] + wa1 * U[rr * 132 + f] + wa2 * U[(rr + 1) * 132 + f];
        const float g = wg0 * U[(rr - 1) * 132 + 64 + f] + wg1 * U[rr * 132 + 64 + f] + wg2 * U[(rr + 1) * 132 + 64 + f];
        act[(size_t)(seqbase + ts) * 2816 + fg] = f2bf(a * siluf(g));
      }
      __syncthreads();
    }
  }
}

template <int MODE>
DI void attn_item(const P* __restrict__ gp, int jj, int it, char* smem) {
  const P& p = *gp;
  u16* Ks = (u16*)smem; u16* Vt = Ks + 64 * 72; float* rpb_s = (float*)(Vt + 64 * 72);
  int tid_ = threadIdx.x; asm volatile("" : "+v"(tid_)); const int tid = tid_, lane = tid & 63, wave = tid >> 6, r = lane & 31, h = lane >> 5;
  constexpr bool EVENL = (MODE == 0 || MODE == 1);
  constexpr bool LAT = (MODE == 1 || MODE == 3);
  constexpr int PS = EVENL ? EVN : ODN;
  int b, hq, qb, tokbase;
  if (!LAT) { b = it >> 4; hq = (it >> 1) & 7; qb = it & 1; tokbase = b * 256; }
  else { b = it >> 8; hq = (it >> 5) & 7; qb = it & 31; tokbase = NP_ + b * 4096; }
  const int hk = EVENL ? hq : (hq >> 2);
  const int kcol = 512 + hk * 64, vcol = (EVENL ? 1024 : 640) + hk * 64, qcol = hq * 64;
  const int tq = qb * 128 + wave * 32 + r;
  const size_t qtok = (size_t)tokbase + tq;
  __syncthreads();
  if (MODE == 1) { for (int i = tid; i < 465; i += 256) rpb_s[i] = p.a_rpb[(size_t)(jj * 8 + hq) * 465 + i]; }
  bf16x8 qf[4];
#pragma unroll
  for (int s = 0; s < 4; ++s) qf[s] = *(const bf16x8*)(p.proj + qtok * PS + qcol + 16 * s + 8 * h);
  if (MODE == 3) {
    const int prow = tq >> 6, pcol = tq & 63;
#pragma unroll
    for (int half = 0; half < 2; ++half) {
      const int pos = half ? pcol : prow;
#pragma unroll
      for (int j = 0; j < 8; ++j) {
        const float cs = p.rope[(pos * 16 + 8 * h + j) * 2], sn = p.rope[(pos * 16 + 8 * h + j) * 2 + 1];
        const float x1 = bf2f((u16)qf[2 * half][j]), x2 = bf2f((u16)qf[2 * half + 1][j]);
        qf[2 * half][j] = (short)f2bf(x1 * cs - x2 * sn);
        qf[2 * half + 1][j] = (short)f2bf(x1 * sn + x2 * cs);
      }
    }
  }
  float m_run = -1e30f, l_run = 0.f;
  if (MODE == 2 || MODE == 3) { m_run = p.c_sink[jj * 8 + hq]; l_run = h == 0 ? 1.f : 0.f; }
  f32x16 ot[2]; zero16(ot[0]); zero16(ot[1]);
  int loc0 = 0, nloc = 0;
  if (MODE == 1) {
    const int qi0 = 2 * qb;
    const int rlo = min(max(qi0 - 4, 0), 56), rhi = min(max(qi0 + 1 - 4, 0), 56) + 7;
    loc0 = rlo; nloc = rhi - rlo + 1;
  } else if (MODE == 3) {
    loc0 = max(0, 2 * qb - 2); nloc = min(63, 2 * qb + 3) - loc0 + 1;
  }
  const int qi = tq >> 6, qw = tq & 63;
  const int r0w = min(max(qi - 4, 0), 56), c0w = min(max(qw - 8, 0), 48);
  const int key = tid >> 2, seg = tid & 3;
  for (int kb = 0; kb < 4 + nloc; ++kb) {
    const bool isctx = kb < 4;
    const int blk = isctx ? kb : loc0 + kb - 4;
    __syncthreads();
    {
      float kf[16], vf[16];
      if (LAT && isctx) {
        const float* kc = (MODE == 1) ? p.cache_a_k + ((size_t)((b * 2 + jj) * 8 + hk)) * 16384 : p.cache_c_k + ((size_t)((b * 2 + jj) * 2 + hk)) * 16384;
        const float* vc = (MODE == 1) ? p.cache_a_v + ((size_t)((b * 2 + jj) * 8 + hk)) * 16384 : p.cache_c_v + ((size_t)((b * 2 + jj) * 2 + hk)) * 16384;
        const float4* kp4 = (const float4*)(kc + (size_t)(blk * 64 + key) * 64 + seg * 16);
        const float4* vp4 = (const float4*)(vc + (size_t)(blk * 64 + key) * 64 + seg * 16);
#pragma unroll
        for (int e = 0; e < 4; ++e) {
          const float4 a = kp4[e], c = vp4[e];
          kf[4 * e] = a.x; kf[4 * e + 1] = a.y; kf[4 * e + 2] = a.z; kf[4 * e + 3] = a.w;
          vf[4 * e] = c.x; vf[4 * e + 1] = c.y; vf[4 * e + 2] = c.z; vf[4 * e + 3] = c.w;
        }
      } else {
        const u16* rowp = p.proj + ((size_t)tokbase + blk * 64 + key) * PS;
        const bf16x8 k0 = *(const bf16x8*)(rowp + kcol + seg * 16), k1 = *(const bf16x8*)(rowp + kcol + seg * 16 + 8);
        const bf16x8 v0 = *(const bf16x8*)(rowp + vcol + seg * 16), v1 = *(const bf16x8*)(rowp + vcol + seg * 16 + 8);
#pragma unroll
        for (int e = 0; e < 8; ++e) { kf[e] = bf2f((u16)k0[e]); kf[8 + e] = bf2f((u16)k1[e]); vf[e] = bf2f((u16)v0[e]); vf[8 + e] = bf2f((u16)v1[e]); }
        if (MODE == 3) {
          const bf16x8 p0 = *(const bf16x8*)(rowp + kcol + (seg ^ 1) * 16), p1 = *(const bf16x8*)(rowp + kcol + (seg ^ 1) * 16 + 8);
          const int pos = (seg & 2) ? key : blk;
#pragma unroll
          for (int e = 0; e < 16; ++e) {
            const float pr = bf2f((u16)(e < 8 ? p0[e & 7] : p1[e & 7]));
            const float cs = p.rope[(pos * 16 + e) * 2], sn = p.rope[(pos * 16 + e) * 2 + 1];
            kf[e] = (seg & 1) ? (pr * sn + kf[e] * cs) : (kf[e] * cs - pr * sn);
          }
        }
      }
      bf16x8 o0, o1;
#pragma unroll
      for (int e = 0; e < 8; ++e) { o0[e] = (short)f2bf(kf[e]); o1[e] = (short)f2bf(kf[8 + e]); }
      *(bf16x8*)(Ks + key * 72 + seg * 16) = o0;
      *(bf16x8*)(Ks + key * 72 + seg * 16 + 8) = o1;
#pragma unroll
      for (int e = 0; e < 16; ++e) Vt[(seg * 16 + e) * 72 + key] = f2bf(vf[e]);
    }
    __syncthreads();
    bool active = true;
    if (MODE == 1 && !isctx) active = (blk >= r0w && blk < r0w + 8);
    if (active) {
      f32x16 st[2]; zero16(st[0]); zero16(st[1]);
#pragma unroll
      for (int kt = 0; kt < 2; ++kt)
#pragma unroll
        for (int s = 0; s < 4; ++s) {
          const bf16x8 a = *(const bf16x8*)(Ks + (kt * 32 + r) * 72 + 16 * s + 8 * h);
          st[kt] = MFMA(a, qf[s], st[kt]);
        }
      float mx = m_run;
#pragma unroll
      for (int kt = 0; kt < 2; ++kt)
#pragma unroll
        for (int i = 0; i < 16; ++i) {
          float s = st[kt][i] * 0.125f;
          const int kk = kt * 32 + crow(i, h);
          if (MODE == 1 && !isctx) {
            const bool ok = (kk >= c0w && kk < c0w + 16);
            s = ok ? s + rpb_s[(blk - qi + 7) * 31 + (kk - qw + 15)] : -1e30f;
          }
          if (MODE == 3 && !isctx) {
            const int dlt = blk * 64 + kk - tq;
            s = (dlt <= 128 && dlt >= -128) ? s : -1e30f;
          }
          st[kt][i] = s;
          mx = fmaxf(mx, s);
        }
      mx = fmaxf(mx, __shfl_xor(mx, 32));
      const float alpha = __expf(m_run - mx);
      m_run = mx;
      float ps = 0.f;
#pragma unroll
      for (int kt = 0; kt < 2; ++kt)
#pragma unroll
        for (int i = 0; i < 16; ++i) { const float pv = __expf(st[kt][i] - mx); st[kt][i] = pv; ps += pv; }
      l_run = l_run * alpha + ps;
#pragma unroll
      for (int dt = 0; dt < 2; ++dt)
#pragma unroll
        for (int i = 0; i < 16; ++i) ot[dt][i] *= alpha;
#pragma unroll
      for (int kt = 0; kt < 2; ++kt) {
        const bf16x8 pb0 = packs<0>(st[kt]), pb1 = packs<1>(st[kt]);
#pragma unroll
        for (int dt = 0; dt < 2; ++dt) {
          const bf16x8 pa0 = ld2x4(Vt + (dt * 32 + r) * 72 + kt * 32 + 4 * h);
          const bf16x8 pa1 = ld2x4(Vt + (dt * 32 + r) * 72 + kt * 32 + 16 + 4 * h);
          ot[dt] = MFMA(pa0, pb0, ot[dt]);
          ot[dt] = MFMA(pa1, pb1, ot[dt]);
        }
      }
    }
  }
  l_run += __shfl_xor(l_run, 32);
  const float inv = 1.f / l_run;
  u16* dst = p.hn + qtok * 1024 + qcol;
#pragma unroll
  for (int dt = 0; dt < 2; ++dt)
#pragma unroll
    for (int g4 = 0; g4 < 4; ++g4) {
      ushort4 o;
      o.x = f2bf(ot[dt][4 * g4] * inv); o.y = f2bf(ot[dt][4 * g4 + 1] * inv); o.z = f2bf(ot[dt][4 * g4 + 2] * inv); o.w = f2bf(ot[dt][4 * g4 + 3] * inv);
      *(ushort4*)(dst + dt * 32 + 8 * g4 + 4 * h) = o;
    }
}

struct ChainId { int lat, b, h, dir, T, base, nch; };
DI ChainId chain_decode(int it) {
  ChainId c; c.lat = it < 128; const int q = c.lat ? it : it - 128;
  c.b = q >> 4; c.h = (q >> 1) & 7; c.dir = q & 1; c.T = c.lat ? 4096 : 256; c.base = c.lat ? NP_ + c.b * 4096 : c.b * 256; c.nch = c.T >> 6;
  return c;
}
DI int tokof(const ChainId& c, int step, int row) { const int pp = step * 64 + row; return c.base + (c.dir ? c.T - 1 - pp : pp); }

DI void gla_chain(const P* __restrict__ gp, int jj, int it, char* smem) {
  const P& p = *gp;
  const ChainId cid = chain_decode(it);
  int tid_ = threadIdx.x; asm volatile("" : "+v"(tid_)); const int tid = tid_, lane = tid & 63, wave = tid >> 6, r = lane & 31, h = lane >> 5;
  const int hh = cid.h, dir = cid.dir;
  u16* QT = (u16*)smem; u16* KT = QT + 4608; u16* KEt = KT + 4608; u16* Vt = KEt + 4608;
  float* GL = (float*)(Vt + 4608); float* gq = GL + 1024; float* dec = gq + 256; float* Ost = dec + 64;
  const int d = tid & 63, cq = tid >> 6;
  float wg[16];
#pragma unroll
  for (int rr = 0; rr < 16; ++rr) wg[rr] = p.b_w_g2[((size_t)((jj * 2 + dir) * 16 + rr)) * 512 + hh * 64 + d];
  const float bg = p.b_b_g[(jj * 2 + dir) * 512 + hh * 64 + d];
  const int vh = wave & 1;
  f32x16 S[2]; zero16(S[0]); zero16(S[1]);
  const size_t sidx = ((size_t)(((cid.b * 2 + jj) * 2 + dir) * 8 + hh)) * 4096;
  if (wave < 2 && cid.lat) {
#pragma unroll
    for (int dt = 0; dt < 2; ++dt)
#pragma unroll
      for (int i = 0; i < 16; ++i) S[dt][i] = p.state_b[sidx + (dt * 32 + crow(i, h)) * 64 + vh * 32 + r];
  }
  for (int step_ = 0; step_ < cid.nch; ++step_) {
    int step = step_;
    asm volatile("" : "+v"(step));
    __syncthreads();
    {
      const int c = tid >> 2, sg = tid & 3;
      const int tok = tokof(cid, step, c);
      const ushort4 gv = *(const ushort4*)(p.proj + (size_t)tok * EVN + 3072 + dir * 16 + sg * 4);
      GL[c * 16 + sg * 4] = bf2f(gv.x); GL[c * 16 + sg * 4 + 1] = bf2f(gv.y); GL[c * 16 + sg * 4 + 2] = bf2f(gv.z); GL[c * 16 + sg * 4 + 3] = bf2f(gv.w);
    }
    __syncthreads();
    float Gl[16]; float run = 0.f;
#pragma unroll
    for (int i = 0; i < 16; ++i) {
      const int c = cq * 16 + i;
      float z = bg;
#pragma unroll
      for (int rr = 0; rr < 16; ++rr) z += GL[c * 16 + rr] * wg[rr];
      const float g = (fminf(z, 0.f) - log1pf(expf(-fabsf(z)))) * (1.f / 16.f);
      run += g; Gl[i] = run;
    }
    gq[cq * 64 + d] = run;
    __syncthreads();
    float off = 0.f, tot = 0.f;
#pragma unroll
    for (int q2 = 0; q2 < 4; ++q2) { const float t = gq[q2 * 64 + d]; if (q2 < cq) off += t; tot += t; }
#pragma unroll
    for (int i = 0; i < 16; ++i) {
      const int c = cq * 16 + i;
      const int tok = tokof(cid, step, c);
      const float G = Gl[i] + off;
      const u16* rowp = p.proj + (size_t)tok * EVN + hh * 64 + d;
      const float qv = bf2f(rowp[1536]), kv = bf2f(rowp[2048]);
      const u16 vb = rowp[2560];
      QT[c * 72 + d] = f2bf(qv * 0.125f * expf(G));
      KT[c * 72 + d] = f2bf(kv * expf(-G));
      KEt[d * 72 + c] = f2bf(kv * expf(tot - G));
      Vt[d * 72 + c] = vb;
    }
    if (cq == 0) dec[d] = expf(tot);
    __syncthreads();
    if (wave < 2) {
      f32x16 at[2][2];
#pragma unroll
      for (int a = 0; a < 2; ++a)
#pragma unroll
        for (int b2 = 0; b2 < 2; ++b2) zero16(at[a][b2]);
#pragma unroll
      for (int ks = 0; ks < 4; ++ks) {
        const bf16x8 a0 = *(const bf16x8*)(KT + r * 72 + ks * 16 + 8 * h), a1 = *(const bf16x8*)(KT + (32 + r) * 72 + ks * 16 + 8 * h);
        const bf16x8 b0 = *(const bf16x8*)(QT + r * 72 + ks * 16 + 8 * h), b1 = *(const bf16x8*)(QT + (32 + r) * 72 + ks * 16 + 8 * h);
        at[0][0] = MFMA(a0, b0, at[0][0]); at[0][1] = MFMA(a0, b1, at[0][1]);
        at[1][0] = MFMA(a1, b0, at[1][0]); at[1][1] = MFMA(a1, b1, at[1][1]);
      }
#pragma unroll
      for (int st = 0; st < 2; ++st)
#pragma unroll
        for (int ct = 0; ct < 2; ++ct)
#pragma unroll
          for (int i = 0; i < 16; ++i) { if (st * 32 + crow(i, h) > ct * 32 + r) at[st][ct][i] = 0.f; }
      f32x16 o[2]; zero16(o[0]); zero16(o[1]);
#pragma unroll
      for (int ct = 0; ct < 2; ++ct)
#pragma unroll
        for (int st = 0; st < 2; ++st) {
          const bf16x8 x0 = packs<0>(at[st][ct]), x1 = packs<1>(at[st][ct]);
          const bf16x8 pb0 = ld2x4(Vt + (vh * 32 + r) * 72 + st * 32 + 4 * h);
          const bf16x8 pb1 = ld2x4(Vt + (vh * 32 + r) * 72 + st * 32 + 16 + 4 * h);
          o[ct] = MFMA(x0, pb0, o[ct]);
          o[ct] = MFMA(x1, pb1, o[ct]);
        }
#pragma unroll
      for (int dt = 0; dt < 2; ++dt) {
        const bf16x8 xs0 = packs<0>(S[dt]), xs1 = packs<1>(S[dt]);
#pragma unroll
        for (int ct = 0; ct < 2; ++ct) {
          const bf16x8 pa0 = ld2x4(QT + (ct * 32 + r) * 72 + dt * 32 + 4 * h);
          const bf16x8 pa1 = ld2x4(QT + (ct * 32 + r) * 72 + dt * 32 + 16 + 4 * h);
          o[ct] = MFMA(pa0, xs0, o[ct]);
          o[ct] = MFMA(pa1, xs1, o[ct]);
        }
      }
#pragma unroll
      for (int dt = 0; dt < 2; ++dt)
#pragma unroll
        for (int i = 0; i < 16; ++i) S[dt][i] *= dec[dt * 32 + crow(i, h)];
#pragma unroll
      for (int ks = 0; ks < 4; ++ks) {
        const bf16x8 bv = *(const bf16x8*)(Vt + (vh * 32 + r) * 72 + ks * 16 + 8 * h);
#pragma unroll
        for (int dt = 0; dt < 2; ++dt) {
          const bf16x8 a = *(const bf16x8*)(KEt + (dt * 32 + r) * 72 + ks * 16 + 8 * h);
          S[dt] = MFMA(a, bv, S[dt]);
        }
      }
#pragma unroll
      for (int ct = 0; ct < 2; ++ct)
#pragma unroll
        for (int i = 0; i < 16; ++i) Ost[(ct * 32 + crow(i, h)) * 68 + vh * 32 + r] = o[ct][i];
    }
    __syncthreads();
    {
      const int c = tid >> 2, sg = tid & 3;
      const int tok = tokof(cid, step, c);
      u16* dst = (dir ? p.ot1 + (size_t)tok * 512 + hh * 64 : p.hn + (size_t)tok * 1024 + 512 + hh * 64) + sg * 16;
      bf16x8 w0, w1;
#pragma unroll
      for (int e = 0; e < 8; ++e) { w0[e] = (short)f2bf(Ost[c * 68 + sg * 16 + e]); w1[e] = (short)f2bf(Ost[c * 68 + sg * 16 + 8 + e]); }
      *(bf16x8*)dst = w0; *(bf16x8*)(dst + 8) = w1;
    }
  }
  if (wave < 2 && !cid.lat) {
#pragma unroll
    for (int dt = 0; dt < 2; ++dt)
#pragma unroll
      for (int i = 0; i < 16; ++i) p.out[OFF_SB + sidx + (dt * 32 + crow(i, h)) * 64 + vh * 32 + r] = S[dt][i];
  }
}

DI void delta_chain(const P* __restrict__ gp, int jj, int it, char* smem) {
  const P& p = *gp;
  const ChainId cid = chain_decode(it);
  int tid_ = threadIdx.x; asm volatile("" : "+v"(tid_)); const int tid = tid_, lane = tid & 63, wave = tid >> 6, r = lane & 31, h = lane >> 5;
  const int hh = cid.h, dir = cid.dir;
  u16* Qn = (u16*)smem; u16* Kn = Qn + 4608; u16* Kt = Kn + 4608; u16* AQK = Kt + 4608; u16* KC = AQK + 4608;
  float* At = (float*)(KC + 4608); float* Wv = At + 64 * 68; float* Gs = Wv + 64 * 65; float* Bt = Gs + 64;
  const float aexp = expf(p.d_a_log[(jj * 2 + dir) * 8 + hh]);
  const float dtb = p.d_dt_bias[(jj * 2 + dir) * 8 + hh];
  const int vh = wave & 1;
  f32x16 S[2]; zero16(S[0]); zero16(S[1]);
  const size_t sidx = ((size_t)(((cid.b * 2 + jj) * 2 + dir) * 8 + hh)) * 4096;
  if (wave < 2 && cid.lat) {
#pragma unroll
    for (int dt = 0; dt < 2; ++dt)
#pragma unroll
      for (int i = 0; i < 16; ++i) S[dt][i] = p.state_d[sidx + (dt * 32 + crow(i, h)) * 64 + vh * 32 + r];
  }
  const float* cwp = p.d_conv + (size_t)jj * 3 * 1536;
  for (int step_ = 0; step_ < cid.nch; ++step_) {
    int step = step_;
    asm volatile("" : "+v"(step));
    __syncthreads();
    if (wave == 0) {
      const int tok = tokof(cid, step, lane);
      const float da = bf2f(p.proj[(size_t)tok * ODN + 2304 + dir * 8 + hh]);
      const float db = bf2f(p.proj[(size_t)tok * ODN + 2320 + dir * 8 + hh]);
      const float x = da + dtb;
      const float sp = x > 20.f ? x : log1pf(expf(x));
      float G = -aexp * sp;
#pragma unroll
      for (int o = 1; o < 64; o <<= 1) { const float t = __shfl_up(G, o); if (lane >= o) G += t; }
      Gs[lane] = G; Bt[lane] = 1.f / (1.f + expf(-db));
    }
    {
      const int c = tid >> 2, sg = tid & 3;
      const int tok = tokof(cid, step, c);
      const int pos = tok - cid.base;
      const bool hp = pos > 0, hn_ = pos < cid.T - 1;
      for (int wh = 0; wh < 3; ++wh) {
        const int ch0 = wh * 512 + hh * 64 + sg * 16;
        const u16* cur = p.proj + (size_t)tok * ODN + 768 + ch0;
        float y[16];
        float ss = 0.f;
#pragma unroll
        for (int hf = 0; hf < 2; ++hf) {
          const bf16x8 xc = *(const bf16x8*)(cur + hf * 8);
          bf16x8 xp, xn;
#pragma unroll
          for (int e = 0; e < 8; ++e) { xp[e] = 0; xn[e] = 0; }
          if (hp) xp = *(const bf16x8*)(cur - ODN + hf * 8);
          if (hn_) xn = *(const bf16x8*)(cur + ODN + hf * 8);
#pragma unroll
          for (int e = 0; e < 8; ++e) {
            const int ch = ch0 + hf * 8 + e;
            float v = cwp[ch] * bf2f((u16)xp[e]) + cwp[1536 + ch] * bf2f((u16)xc[e]) + cwp[3072 + ch] * bf2f((u16)xn[e]);
            v = v / (1.f + expf(-v));
            y[hf * 8 + e] = v; ss += v * v;
          }
        }
        ss += __shfl_xor(ss, 1); ss += __shfl_xor(ss, 2);
        const float rn = rsqrtf(ss + 1e-6f);
        if (wh == 0) {
#pragma unroll
          for (int e = 0; e < 16; ++e) Qn[c * 72 + sg * 16 + e] = f2bf(y[e] * rn * 0.125f);
        } else if (wh == 1) {
#pragma unroll
          for (int e = 0; e < 16; ++e) { const u16 kb = f2bf(y[e] * rn); Kn[c * 72 + sg * 16 + e] = kb; Kt[(sg * 16 + e) * 72 + c] = kb; }
        } else {
#pragma unroll
          for (int e = 0; e < 16; ++e) Wv[c * 65 + sg * 16 + e] = y[e];
        }
      }
    }
    __syncthreads();
    if (wave < 2) {
      f32x16 akk[2], aqk[2]; zero16(akk[0]); zero16(akk[1]); zero16(aqk[0]); zero16(aqk[1]);
#pragma unroll
      for (int ks = 0; ks < 4; ++ks) {
        const bf16x8 bk = *(const bf16x8*)(Kn + (vh * 32 + r) * 72 + ks * 16 + 8 * h);
#pragma unroll
        for (int ct = 0; ct < 2; ++ct) {
          const bf16x8 ak = *(const bf16x8*)(Kn + (ct * 32 + r) * 72 + ks * 16 + 8 * h);
          const bf16x8 aq = *(const bf16x8*)(Qn + (ct * 32 + r) * 72 + ks * 16 + 8 * h);
          akk[ct] = MFMA(ak, bk, akk[ct]);
          aqk[ct] = MFMA(aq, bk, aqk[ct]);
        }
      }
      const int s = vh * 32 + r;
      const float Gss = Gs[s];
#pragma unroll
      for (int ct = 0; ct < 2; ++ct)
#pragma unroll
        for (int g4 = 0; g4 < 4; ++g4) {
          const int c0 = ct * 32 + 8 * g4 + 4 * h;
          float4 val;
#pragma unroll
          for (int e = 0; e < 4; ++e) {
            const int c = c0 + e;
            const float gam = expf(fminf(Gs[c] - Gss, 0.f));
            const float av = (s < c) ? akk[ct][4 * g4 + e] * Bt[c] * gam : 0.f;
            if (e == 0) val.x = av; else if (e == 1) val.y = av; else if (e == 2) val.z = av; else val.w = av;
            AQK[c * 72 + s] = f2bf((s <= c) ? aqk[ct][4 * g4 + e] * gam : 0.f);
          }
          *(float4*)(At + s * 68 + c0) = val;
        }
    }
    __syncthreads();
    if (wave < 2) {
      const bool isv = wave == 0;
      const int col = lane;
#pragma unroll 1
      for (int bi = 0; bi < 4; ++bi) {
        float acc[16];
#pragma unroll
        for (int ci = 0; ci < 16; ++ci) {
          const int c = 16 * bi + ci;
          acc[ci] = isv ? Wv[c * 65 + col] * Bt[c] : bf2f(Kn[c * 72 + col]) * Bt[c] * expf(Gs[c]);
        }
        for (int s2 = 0; s2 < 16 * bi; ++s2) {
          const float xs = isv ? Wv[s2 * 65 + col] : bf2f(KC[s2 * 72 + col]);
          const float4* a4 = (const float4*)(At + s2 * 68 + 16 * bi);
#pragma unroll
          for (int q = 0; q < 4; ++q) {
            const float4 a = a4[q];
            acc[4 * q] -= a.x * xs; acc[4 * q + 1] -= a.y * xs; acc[4 * q + 2] -= a.z * xs; acc[4 * q + 3] -= a.w * xs;
          }
        }
#pragma unroll
        for (int ci = 0; ci < 16; ++ci) {
          const float x = acc[ci];
          const float* arow = At + (16 * bi + ci) * 68 + 16 * bi;
#pragma unroll
          for (int cj = ci + 1; cj < 16; ++cj) acc[cj] -= arow[cj] * x;
          if (isv) Wv[(16 * bi + ci) * 65 + col] = x; else KC[(16 * bi + ci) * 72 + col] = f2bf(x);
        }
      }
    }
    __syncthreads();
    if (wave < 2) {
      f32x16 kS[2], qS[2]; zero16(kS[0]); zero16(kS[1]); zero16(qS[0]); zero16(qS[1]);
#pragma unroll
      for (int dt = 0; dt < 2; ++dt) {
        const bf16x8 xs0 = packs<0>(S[dt]), xs1 = packs<1>(S[dt]);
#pragma unroll
        for (int ct = 0; ct < 2; ++ct) {
          kS[ct] = MFMA(ld2x4(KC + (ct * 32 + r) * 72 + dt * 32 + 4 * h), xs0, kS[ct]);
          kS[ct] = MFMA(ld2x4(KC + (ct * 32 + r) * 72 + dt * 32 + 16 + 4 * h), xs1, kS[ct]);
          qS[ct] = MFMA(ld2x4(Qn + (ct * 32 + r) * 72 + dt * 32 + 4 * h), xs0, qS[ct]);
          qS[ct] = MFMA(ld2x4(Qn + (ct * 32 + r) * 72 + dt * 32 + 16 + 4 * h), xs1, qS[ct]);
        }
      }
      f32x16 vn[2], o[2];
      const float Glast = Gs[63];
#pragma unroll
      for (int ct = 0; ct < 2; ++ct)
#pragma unroll
        for (int i = 0; i < 16; ++i) {
          const int c = ct * 32 + crow(i, h);
          vn[ct][i] = Wv[c * 65 + vh * 32 + r] - kS[ct][i];
          o[ct][i] = qS[ct][i] * expf(Gs[c]);
        }
#pragma unroll
      for (int st = 0; st < 2; ++st) {
        const bf16x8 xs0 = packs<0>(vn[st]), xs1 = packs<1>(vn[st]);
#pragma unroll
        for (int ct = 0; ct < 2; ++ct) {
          o[ct] = MFMA(ld2x4(AQK + (ct * 32 + r) * 72 + st * 32 + 4 * h), xs0, o[ct]);
          o[ct] = MFMA(ld2x4(AQK + (ct * 32 + r) * 72 + st * 32 + 16 + 4 * h), xs1, o[ct]);
        }
      }
      const float dl = expf(Glast);
#pragma unroll
      for (int st = 0; st < 2; ++st)
#pragma unroll
        for (int i = 0; i < 16; ++i) vn[st][i] *= expf(Glast - Gs[st * 32 + crow(i, h)]);
#pragma unroll
      for (int dt = 0; dt < 2; ++dt)
#pragma unroll
        for (int i = 0; i < 16; ++i) S[dt][i] *= dl;
#pragma unroll
      for (int st = 0; st < 2; ++st) {
        const bf16x8 xs0 = packs<0>(vn[st]), xs1 = packs<1>(vn[st]);
#pragma unroll
        for (int dt = 0; dt < 2; ++dt) {
          S[dt] = MFMA(ld2x4(Kt + (dt * 32 + r) * 72 + st * 32 + 4 * h), xs0, S[dt]);
          S[dt] = MFMA(ld2x4(Kt + (dt * 32 + r) * 72 + st * 32 + 16 + 4 * h), xs1, S[dt]);
        }
      }
#pragma unroll
      for (int ct = 0; ct < 2; ++ct)
#pragma unroll
        for (int i = 0; i < 16; ++i) At[(ct * 32 + crow(i, h)) * 68 + vh * 32 + r] = o[ct][i];
    }
    __syncthreads();
    {
      const int c = tid >> 2, sg = tid & 3;
      const int tok = tokof(cid, step, c);
      u16* dst = (dir ? p.ot1 + (size_t)tok * 512 + hh * 64 : p.hn + (size_t)tok * 1024 + 512 + hh * 64) + sg * 16;
      bf16x8 w0, w1;
#pragma unroll
      for (int e = 0; e < 8; ++e) { w0[e] = (short)f2bf(At[c * 68 + sg * 16 + e]); w1[e] = (short)f2bf(At[c * 68 + sg * 16 + 8 + e]); }
      *(bf16x8*)dst = w0; *(bf16x8*)(dst + 8) = w1;
    }
  }
  if (wave < 2 && !cid.lat) {
#pragma unroll
    for (int dt = 0; dt < 2; ++dt)
#pragma unroll
      for (int i = 0; i < 16; ++i) p.out[OFF_SD + sidx + (dt * 32 + crow(i, h)) * 64 + vh * 32 + r] = S[dt][i];
  }
}

DI void mixer_phase(const P* __restrict__ gp, int l, char* smem) {
  const P& p = *gp;
  const bool even = !(l & 1); const int jj = l >> 1;
  const int total = 384 + 2048 + 256;
  int* s_item = (int*)(smem + SMEM_BYTES - 16);
  for (;;) {
    __syncthreads();
    if (threadIdx.x == 0) *s_item = atomicAdd(p.cnt + l, 1);
    __syncthreads();
    const int item = *s_item;
    if (item >= total) break;
    if (item < 384) { if (even) gla_chain(gp, jj, item, smem); else delta_chain(gp, jj, item, smem); }
    else if (item < 384 + 2048) { if (even) attn_item<1>(gp, jj, item - 384, smem); else attn_item<3>(gp, jj, item - 384, smem); }
    else { if (even) attn_item<0>(gp, jj, item - 384 - 2048, smem); else attn_item<2>(gp, jj, item - 384 - 2048, smem); }
  }
}

DI void finalize_phase(const P* __restrict__ gp, int l) {
  const P& p = *gp;
  const bool even = !(l & 1); const int jj = l >> 1;
  int tid_ = threadIdx.x; asm volatile("" : "+v"(tid_)); const int tid = tid_;
  const int tk = tid >> 5, hh = (tid >> 2) & 7, sg = tid & 3;
  const int PS = even ? EVN : ODN; const int zcol = even ? 3104 : 2336;
  for (int item = blockIdx.x; item < NT_ / 8; item += gridDim.x) {
    const size_t tok = (size_t)item * 8 + tk;
    u16* a = p.hn + tok * 1024 + 512 + hh * 64 + sg * 16;
    const u16* bsrc = p.ot1 + tok * 512 + hh * 64 + sg * 16;
    const u16* zs = p.proj + tok * PS + zcol + hh * 64 + sg * 16;
    float o[16]; float ss = 0.f;
#pragma unroll
    for (int hf = 0; hf < 2; ++hf) {
      const bf16x8 x0 = *(const bf16x8*)(a + hf * 8), x1 = *(const bf16x8*)(bsrc + hf * 8);
#pragma unroll
      for (int e = 0; e < 8; ++e) { const float v = bf2f((u16)x0[e]) + bf2f((u16)x1[e]); o[hf * 8 + e] = v; ss += v * v; }
    }
    ss += __shfl_xor(ss, 1); ss += __shfl_xor(ss, 2);
    const float rstd = rsqrtf(ss * (1.f / 64.f) + 1e-6f);
    const float* ng = even ? p.b_norm_g + jj * 512 + hh * 64 + sg * 16 : p.d_norm_g + jj * 64 + sg * 16;
#pragma unroll
    for (int hf = 0; hf < 2; ++hf) {
      const bf16x8 z = *(const bf16x8*)(zs + hf * 8);
      bf16x8 w;
#pragma unroll
      for (int e = 0; e < 8; ++e) { const float zz = bf2f((u16)z[e]); w[e] = (short)f2bf(o[hf * 8 + e] * rstd * ng[hf * 8 + e] * siluf(zz)); }
      *(bf16x8*)(a + hf * 8) = w;
    }
  }
}

DI void run_phase(const P* __restrict__ gp, int ph, char* smem) {
  const P& p = *gp;
  if (ph == 0) { prep_phase(gp, smem); return; }
  if (ph == NPH - 1) { norm_phase(gp, 0, 0, false, true); return; }
  const int l = (ph - 1) >> 3, s = (ph - 1) & 7;
  const bool even = !(l & 1);
  const u16* W = p.wt + (size_t)l * LW;
  switch (s) {
    case 0: norm_phase(gp, l, 0, l == 0, false); break;
    case 1: gemm_phase<EPI_PROJ>(gp, l, smem, p.hn, 1024, W + WO_IN, 1024, 1024, 288, even ? 29 : 23, 0); break;
    case 2: mixer_phase(gp, l, smem); break;
    case 3: finalize_phase(gp, l); break;
    case 4: gemm_phase<EPI_RES>(gp, l, smem, p.hn, 1024, W + WO_OUT, 1024, 1024, 288, 8, 2); break;
    case 5: norm_phase(gp, l, 1, false, false); break;
    case 6: gemm_phase<EPI_FFN>(gp, l, smem, p.hn, 1024, W + WO_UP, 1024, 1024, 312, 44, 0); break;
    case 7: gemm_phase<EPI_RES>(gp, l, smem, p.proj, 2816, W + WO_DN, 2816, 2816, 288, 8, 5); break;
  }
}

__global__ void __launch_bounds__(256) mk(P p, P* gp, int ph0, int ph1) {
  __shared__ __attribute__((aligned(16))) char smem[SMEM_BYTES];
  if (threadIdx.x == 0) *gp = p;
  __threadfence();
  __syncthreads();
  if (ph1 - ph0 > 1) {
    cg::grid_group grid = cg::this_grid();
    for (int ph = ph0; ph < ph1; ++ph) {
      run_phase(gp, ph, smem);
      if (ph + 1 < ph1) grid.sync();
    }
  } else {
    run_phase(gp, ph0, smem);
  }
}

extern "C" void kernel_launch(void* const* d_in, const int* in_sizes, int n_in, void* d_out, int out_size, void* d_ws, size_t ws_size,
                              hipStream_t stream) {
  P p{};
  const float** f = (const float**)&p;
  for (int i = 0; i < 31; ++i) f[i] = (const float*)d_in[i];
  p.out = (float*)d_out;
  char* ws = (char*)d_ws;
  size_t off = 0;
  p.hn = (u16*)(ws + off); off += (size_t)NT_ * 1024 * 2;
  p.proj = (u16*)(ws + off); off += (size_t)NT_ * EVN * 2;
  p.ot1 = (u16*)(ws + off); off += (size_t)NT_ * 512 * 2;
  p.wt = (u16*)(ws + off); off += 4 * LW * 2;
  p.mods = (float*)(ws + off); off += 4 * 9 * 6144 * 4;
  p.rope = (float*)(ws + off); off += 64 * 16 * 2 * 4;
  P* gp = (P*)(ws + off); off += 4096;
  p.cnt = (int*)(ws + off); off += 256;
  static int grid_blocks = 0;
  if (!grid_blocks) {
    int dev = 0, cus = 0, per_cu = 0;
    hipGetDevice(&dev);
    hipDeviceGetAttribute(&cus, hipDeviceAttributeMultiprocessorCount, dev);
    hipOccupancyMaxActiveBlocksPerMultiprocessor(&per_cu, mk, 256, 0);
    if (per_cu < 1) per_cu = 1;
    if (per_cu > 2) per_cu = 2;
    grid_blocks = cus * per_cu;
  }
#if MK_MULTI
  for (int ph = 0; ph < NPH; ++ph) {
    int a = ph, b = ph + 1;
    hipLaunchKernelGGL(mk, dim3(grid_blocks), dim3(256), 0, stream, p, gp, a, b);
  }
#else
  int ph0 = 0, ph1 = NPH;
  void* args[] = {&p, &gp, &ph0, &ph1};
  hipError_t e = hipLaunchCooperativeKernel((void*)mk, dim3(grid_blocks), dim3(256), args, 0, stream);
  if (e != hipSuccess) fprintf(stderr, "cooperative launch failed: %s (grid %d)\n", hipGetErrorString(e), grid_blocks);
#endif
}
```

```cpp
#include <hip/hip_runtime.h>
#include <hip/hip_cooperative_groups.h>
#include <cstdio>
namespace cg = cooperative_groups;

#ifndef MK_MULTI
#define MK_MULTI 0
#endif

#define DI __device__ __forceinline__
#define DN __device__ __noinline__
typedef unsigned short u16;
typedef __attribute__((ext_vector_type(8))) short bf16x8;
typedef __attribute__((ext_vector_type(4))) short s16x4;
typedef __attribute__((ext_vector_type(16))) float f32x16;
#define MFMA(a, b, c) __builtin_amdgcn_mfma_f32_32x32x16_bf16((a), (b), (c), 0, 0, 0)

static constexpr int NP_ = 4096, NT_ = 36864;
static constexpr int EVN = 3616, ODN = 2848;
static constexpr size_t OFF_AK = 37748736, OFF_AV = 41943040, OFF_SB = 46137344, OFF_CK = 48234496, OFF_CV = 49283072, OFF_SD = 50331648;
static constexpr size_t LW = 13500416, WO_UP = 0, WO_DN = 5767168, WO_IN = 8650752, WO_OUT = 12451840;
static constexpr int NPH = 34;
static constexpr int SMEM_BYTES = 80 * 1024;

struct P {
  const float *x_prompt, *x_sample, *cache_a_k, *cache_a_v, *state_b, *cache_c_k, *cache_c_v, *state_d, *c, *c_ctx, *ada_w, *ada_b,
      *norm1_g, *norm2_g, *ffn_up, *ffn_conv, *ffn_down, *ev_w_in, *ev_w_out, *a_rpb, *b_w_g2, *b_b_g, *b_norm_g, *od_w_in, *od_w_out,
      *c_sink, *d_conv, *d_a_log, *d_dt_bias, *d_norm_g, *final_g;
  float* out;
  u16 *hn, *proj, *ot1, *wt;
  float *mods, *rope;
  int* cnt;
};

DI u16 f2bf(float x) { unsigned u = __float_as_uint(x); u += 0x7fffu + ((u >> 16) & 1u); return (u16)(u >> 16); }
DI float bf2f(u16 b) { return __uint_as_float(((unsigned)b) << 16); }
DI int crow(int i, int h) { return (i & 3) + 8 * (i >> 2) + 4 * h; }
template <int S> DI bf16x8 packs(const f32x16& x) {
  bf16x8 v;
#pragma unroll
  for (int j = 0; j < 8; ++j) v[j] = (short)f2bf(x[8 * S + j]);
  return v;
}
DI bf16x8 ld2x4(const u16* p) {
  s16x4 lo = *(const s16x4*)p, hi = *(const s16x4*)(p + 8);
  return __builtin_shufflevector(lo, hi, 0, 1, 2, 3, 4, 5, 6, 7);
}
DI float siluf(float x) { return x / (1.f + __expf(-x)); }
DI int opq(int x) { asm volatile("" : "+v"(x)); return x; }
DI void zero16(f32x16& a) {
#pragma unroll
  for (int i = 0; i < 16; ++i) a[i] = 0.f;
}

DI void prep_phase(const P* __restrict__ gp, char* smem) {
  const P& p = *gp;
  int tid_ = threadIdx.x; asm volatile("" : "+v"(tid_)); const int tid = tid_;
  const int NWT = 4 * (1408 + 704 + 256) + 2 * (928 + 736);
  const int NADA = 384;
  const int total = NWT + NADA + 1;
  for (int item = blockIdx.x; item < total; item += gridDim.x) {
    if (item < NWT) {
      int rem = item; const float* src = nullptr; u16* dst = nullptr; int K = 0, N = 0, NPd = 0;
      for (int l = 0; l < 4; ++l) {
        const int jj = l >> 1; const bool ev = !(l & 1);
        const int nin = ev ? 928 : 736;
        if (rem < 1408) { src = p.ffn_up + (size_t)l * 1024 * 5632; dst = p.wt + l * LW + WO_UP; K = 1024; N = 5632; NPd = 5632; break; }
        rem -= 1408;
        if (rem < 704) { src = p.ffn_down + (size_t)l * 2816 * 1024; dst = p.wt + l * LW + WO_DN; K = 2816; N = 1024; NPd = 1024; break; }
        rem -= 704;
        if (rem < nin) { src = ev ? p.ev_w_in + (size_t)jj * 1024 * EVN : p.od_w_in + (size_t)jj * 1024 * ODN; dst = p.wt + l * LW + WO_IN; K = 1024; N = ev ? EVN : ODN; NPd = ev ? 3712 : 2944; break; }
        rem -= nin;
        if (rem < 256) { src = (ev ? p.ev_w_out : p.od_w_out) + (size_t)jj * 1024 * 1024; dst = p.wt + l * LW + WO_OUT; K = 1024; N = 1024; NPd = 1024; break; }
        rem -= 256;
      }
      const int ntn = NPd >> 6;
      const int tk = rem / ntn, tn = rem - tk * ntn;
      float* T = (float*)smem;
      __syncthreads();
#pragma unroll
      for (int i = 0; i < 16; ++i) {
        const int k = i * 4 + (tid >> 6), n = tid & 63;
        const int gn = tn * 64 + n;
        T[k * 65 + n] = (gn < N) ? src[(size_t)(tk * 64 + k) * N + gn] : 0.f;
      }
      __syncthreads();
#pragma unroll
      for (int i = 0; i < 16; ++i) {
        const int n = i * 4 + (tid >> 6), k = tid & 63;
        dst[(size_t)(tn * 64 + n) * K + tk * 64 + k] = f2bf(T[k * 65 + n]);
      }
    } else if (item < NWT + NADA) {
      const int it = item - NWT; const int l = it / 96, cgp = it - l * 96; const int n0 = cgp * 64;
      float* sc = (float*)smem;
      float* red = sc + 9 * 1024;
      __syncthreads();
      for (int idx = tid; idx < 9 * 1024; idx += 256) {
        const int ci = idx >> 10, k = idx & 1023;
        const float x = ci < 8 ? p.c[ci * 1024 + k] : p.c_ctx[k];
        sc[idx] = x / (1.f + expf(-x));
      }
      __syncthreads();
      const int wave = tid >> 6, lane = tid & 63;
      float acc[9];
#pragma unroll
      for (int ci = 0; ci < 9; ++ci) acc[ci] = 0.f;
      const float* wp = p.ada_w + ((size_t)l * 1024 + wave * 256) * 6144 + n0 + lane;
#pragma unroll 8
      for (int k = 0; k < 256; ++k) {
        const float wv = wp[(size_t)k * 6144];
#pragma unroll
        for (int ci = 0; ci < 9; ++ci) acc[ci] += sc[ci * 1024 + wave * 256 + k] * wv;
      }
#pragma unroll
      for (int ci = 0; ci < 9; ++ci) red[(wave * 9 + ci) * 64 + lane] = acc[ci];
      __syncthreads();
      for (int idx = tid; idx < 576; idx += 256) {
        const int ci = idx >> 6, col = idx & 63;
        const float s = red[(0 * 9 + ci) * 64 + col] + red[(1 * 9 + ci) * 64 + col] + red[(2 * 9 + ci) * 64 + col] + red[(3 * 9 + ci) * 64 + col];
        p.mods[(size_t)(l * 9 + ci) * 6144 + n0 + col] = s + p.ada_b[l * 6144 + n0 + col];
      }
    } else {
      if (tid < 8) p.cnt[tid] = 0;
      for (int idx = tid; idx < 1024; idx += 256) {
        const int pos = idx >> 4, fi = idx & 15;
        const float inv = powf(10000.f, -(float)fi / 16.f);
        const float ang = (float)pos * inv;
        p.rope[idx * 2] = cosf(ang); p.rope[idx * 2 + 1] = sinf(ang);
      }
    }
  }
}

DI void norm_phase(const P* __restrict__ gp, int l, int which, bool first, bool fin) {
  const P& p = *gp;
  int tid_ = threadIdx.x; asm volatile("" : "+v"(tid_)); const int tid = tid_, lane = tid & 63, wave = tid >> 6;
  for (int item = blockIdx.x; item < NT_ / 4; item += gridDim.x) {
    const int tok = item * 4 + wave;
    const float* src = first ? (tok < NP_ ? p.x_prompt + (size_t)tok * 1024 : p.x_sample + (size_t)(tok - NP_) * 1024) : p.out + (size_t)tok * 1024;
    float4 v[4];
    float ss = 0.f;
#pragma unroll
    for (int i = 0; i < 4; ++i) { v[i] = ((const float4*)src)[lane + 64 * i]; ss += v[i].x * v[i].x + v[i].y * v[i].y + v[i].z * v[i].z + v[i].w * v[i].w; }
#pragma unroll
    for (int o = 32; o >= 1; o >>= 1) ss += __shfl_xor(ss, o);
    const float rstd = rsqrtf(ss * (1.f / 1024.f) + 1e-6f);
    if (fin) {
#pragma unroll
      for (int i = 0; i < 4; ++i) {
        const float4 g = ((const float4*)p.final_g)[lane + 64 * i];
        float4 y; y.x = v[i].x * rstd * g.x; y.y = v[i].y * rstd * g.y; y.z = v[i].z * rstd * g.z; y.w = v[i].w * rstd * g.w;
        ((float4*)(p.out + (size_t)tok * 1024))[lane + 64 * i] = y;
      }
    } else {
      const int ci = tok < NP_ ? 8 : (tok - NP_) >> 12;
      const float* md = p.mods + (size_t)(l * 9 + ci) * 6144 + which * 3072;
      const float* gp = (which ? p.norm2_g : p.norm1_g) + l * 1024;
#pragma unroll
      for (int i = 0; i < 4; ++i) {
        const float4 g = ((const float4*)gp)[lane + 64 * i];
        const float4 sh = ((const float4*)md)[lane + 64 * i];
        const float4 sc = ((const float4*)(md + 1024))[lane + 64 * i];
        ushort4 o;
        o.x = f2bf(v[i].x * rstd * g.x * (1.f + sc.x) + sh.x);
        o.y = f2bf(v[i].y * rstd * g.y * (1.f + sc.y) + sh.y);
        o.z = f2bf(v[i].z * rstd * g.z * (1.f + sc.z) + sh.z);
        o.w = f2bf(v[i].w * rstd * g.w * (1.f + sc.w) + sh.w);
        ((ushort4*)(p.hn + (size_t)tok * 1024))[lane + 64 * i] = o;
        if (first) ((float4*)(p.out + (size_t)tok * 1024))[lane + 64 * i] = v[i];
      }
    }
  }
}

DI uint4 ldsel(const u16* pv, const u16* safe, unsigned ok) {
  uint4 t = *(const uint4*)(ok ? pv : safe);
  if (!ok) { t.x = 0; t.y = 0; t.z = 0; t.w = 0; }
  return t;
}
enum { EPI_PROJ = 0, EPI_RES = 1, EPI_FFN = 2 };

template <int EPI>
DI void gemm_phase(const P* __restrict__ gp, int l, char* smem, const u16* __restrict__ A, int lda, const u16* __restrict__ B, int ldb, int K, int MT,
                   int NTn, int gsel) {
  const P& p = *gp;
  u16* As = (u16*)smem;
  int tid_ = threadIdx.x; asm volatile("" : "+v"(tid_)); const int tid = tid_, lane = tid & 63, wave = tid >> 6, r = lane & 31, h = lane >> 5;
  const int wm = wave & 1, wn = wave >> 1;
  const int KT = K >> 6;
  const bool even = !(l & 1); const int jj = l >> 1;
  const int ntiles = MT * NTn;
  const int nlb = gridDim.x >> 3, xcd = blockIdx.x & 7, lb = blockIdx.x >> 3;
  for (int it = 0;; ++it) {
    const int g = (it * 8 + xcd) * nlb + lb;
    if (g >= ntiles) break;
    const int SM = nlb >> 3;
    const int band = g / (SM * NTn); const int rem = g - band * SM * NTn;
    const int nt = rem / SM, mt = band * SM + (rem - nt * SM);
    int seqbase = 0, L = 0, tin0 = 0;
    if (EPI == EPI_FFN) {
      if (mt < 48) { const int sq = mt / 3; L = 256; seqbase = sq * 256; tin0 = (mt - sq * 3) * 126; }
      else { const int m2 = mt - 48; const int sq = m2 / 33; L = 4096; seqbase = NP_ + sq * 4096; tin0 = (m2 - sq * 33) * 126; }
    }
    const int row0 = tid >> 3, kc0 = (tid & 7) * 8;
    const long arow0 = (EPI == EPI_FFN) ? (long)seqbase + tin0 - 1 + row0 : (long)mt * 128 + row0;
    const u16* abase = A + arow0 * lda + kc0;
    unsigned avalid = 0;
#pragma unroll
    for (int i = 0; i < 4; ++i) {
      if (EPI == EPI_FFN) { const int ts = tin0 - 1 + row0 + 32 * i; if (ts >= 0 && ts < L) avalid |= 1u << i; }
      else avalid |= 1u << i;
    }
    const u16* bbase = B + (size_t)((EPI == EPI_FFN) ? nt * 64 + row0 : nt * 128 + row0) * ldb + kc0;
#define BOFFR(i) ((EPI == EPI_FFN) ? ((i) < 2 ? 32 * (i) : 2752 + 32 * (i)) : 32 * (i))
    f32x16 acc[2][2];
#pragma unroll
    for (int a = 0; a < 2; ++a)
#pragma unroll
      for (int b = 0; b < 2; ++b) zero16(acc[a][b]);
#define GLD_A(i, ko) ldsel(abase + (size_t)(32 * (i)) * lda + (ko), A, (avalid >> (i)) & 1u)
#define GLD_B(i, ko) (*(const uint4*)(bbase + (size_t)BOFFR(i) * ldb + (ko)))
    uint4 ra0 = GLD_A(0, 0), ra1 = GLD_A(1, 0), ra2 = GLD_A(2, 0), ra3 = GLD_A(3, 0);
    uint4 rb0 = GLD_B(0, 0), rb1 = GLD_B(1, 0), rb2 = GLD_B(2, 0), rb3 = GLD_B(3, 0);
    uint4 sa0 = GLD_A(0, 64), sa1 = GLD_A(1, 64), sa2 = GLD_A(2, 64), sa3 = GLD_A(3, 64);
    uint4 sb0 = GLD_B(0, 64), sb1 = GLD_B(1, 64), sb2 = GLD_B(2, 64), sb3 = GLD_B(3, 64);
#define LSTORE(buf, A0, A1, A2, A3, B0, B1, B2, B3) { \
      u16* ad = As + (buf) * 18432 + row0 * 72 + kc0; u16* bd = ad + 9216; \
      *(uint4*)(ad) = A0; *(uint4*)(ad + 32 * 72) = A1; *(uint4*)(ad + 64 * 72) = A2; *(uint4*)(ad + 96 * 72) = A3; \
      *(uint4*)(bd) = B0; *(uint4*)(bd + 32 * 72) = B1; *(uint4*)(bd + 64 * 72) = B2; *(uint4*)(bd + 96 * 72) = B3; }
#define COMPUTE(buf) { \
      const u16* Ab = As + (buf) * 18432; const u16* Bb = Ab + 9216; \
      _Pragma("unroll") for (int ks = 0; ks < 4; ++ks) { \
        const bf16x8 a0 = *(const bf16x8*)(Ab + (wm * 64 + r) * 72 + ks * 16 + h * 8); \
        const bf16x8 a1 = *(const bf16x8*)(Ab + (wm * 64 + 32 + r) * 72 + ks * 16 + h * 8); \
        const bf16x8 b0 = *(const bf16x8*)(Bb + (wn * 64 + r) * 72 + ks * 16 + h * 8); \
        const bf16x8 b1 = *(const bf16x8*)(Bb + (wn * 64 + 32 + r) * 72 + ks * 16 + h * 8); \
        acc[0][0] = MFMA(a0, b0, acc[0][0]); acc[0][1] = MFMA(a0, b1, acc[0][1]); \
        acc[1][0] = MFMA(a1, b0, acc[1][0]); acc[1][1] = MFMA(a1, b1, acc[1][1]); } }
    LSTORE(0, ra0, ra1, ra2, ra3, rb0, rb1, rb2, rb3);
    ra0 = GLD_A(0, 128); ra1 = GLD_A(1, 128); ra2 = GLD_A(2, 128); ra3 = GLD_A(3, 128);
    rb0 = GLD_B(0, 128); rb1 = GLD_B(1, 128); rb2 = GLD_B(2, 128); rb3 = GLD_B(3, 128);
    __syncthreads();
    for (int kt = 0; kt < KT; kt += 2) {
      COMPUTE(0);
      LSTORE(1, sa0, sa1, sa2, sa3, sb0, sb1, sb2, sb3);
      if (kt + 3 < KT) {
        const int ko = (kt + 3) * 64;
        sa0 = GLD_A(0, ko); sa1 = GLD_A(1, ko); sa2 = GLD_A(2, ko); sa3 = GLD_A(3, ko);
        sb0 = GLD_B(0, ko); sb1 = GLD_B(1, ko); sb2 = GLD_B(2, ko); sb3 = GLD_B(3, ko);
      }
      __syncthreads();
      COMPUTE(1);
      if (kt + 2 < KT) {
        LSTORE(0, ra0, ra1, ra2, ra3, rb0, rb1, rb2, rb3);
        if (kt + 4 < KT) {
          const int ko = (kt + 4) * 64;
          ra0 = GLD_A(0, ko); ra1 = GLD_A(1, ko); ra2 = GLD_A(2, ko); ra3 = GLD_A(3, ko);
          rb0 = GLD_B(0, ko); rb1 = GLD_B(1, ko); rb2 = GLD_B(2, ko); rb3 = GLD_B(3, ko);
        }
      }
      __syncthreads();
    }
    if (EPI == EPI_PROJ) {
      const int N = even ? EVN : ODN;
#pragma unroll
      for (int tm = 0; tm < 2; ++tm)
#pragma unroll
        for (int tn = 0; tn < 2; ++tn) {
          const int col = nt * 128 + wn * 64 + tn * 32 + r;
          if (col < N) {
#pragma unroll
            for (int i = 0; i < 16; ++i) {
              const int row = mt * 128 + wm * 64 + tm * 32 + crow(i, h);
              const float v = acc[tm][tn][i];
              p.proj[(size_t)row * N + col] = f2bf(v);
              if (row < NP_) {
                const int b = row >> 8, t = row & 255, d = col & 63;
                if (even) {
                  if (col >= 512 && col < 1536) {
                    const int wh = (col - 512) >> 9, hh = ((col - 512) >> 6) & 7;
                    p.out[(wh ? OFF_AV : OFF_AK) + ((size_t)(((b * 2 + jj) * 8 + hh) * 256 + t)) * 64 + d] = v;
                  }
                } else {
                  if (col >= 512 && col < 768) {
                    const int wh = (col - 512) >> 7, kv = ((col - 512) >> 6) & 1;
                    p.out[(wh ? OFF_CV : OFF_CK) + ((size_t)(((b * 2 + jj) * 2 + kv) * 256 + t)) * 64 + d] = v;
                  }
                }
              }
            }
          }
        }
    } else if (EPI == EPI_RES) {
#pragma unroll
      for (int tm = 0; tm < 2; ++tm)
#pragma unroll
        for (int tn = 0; tn < 2; ++tn) {
          const int col = nt * 128 + wn * 64 + tn * 32 + r;
#pragma unroll
          for (int i = 0; i < 16; ++i) {
            const int row = mt * 128 + wm * 64 + tm * 32 + crow(i, h);
            const int ci = row < NP_ ? 8 : (row - NP_) >> 12;
            const float g = p.mods[(size_t)(l * 9 + ci) * 6144 + gsel * 1024 + col];
            float* xp = p.out + (size_t)row * 1024 + col;
            *xp = *xp + g * acc[tm][tn][i];
          }
        }
    } else {
      __syncthreads();
      float* U = (float*)smem;
#pragma unroll
      for (int tm = 0; tm < 2; ++tm)
#pragma unroll
        for (int tn = 0; tn < 2; ++tn)
#pragma unroll
          for (int i = 0; i < 16; ++i) U[(wm * 64 + tm * 32 + crow(i, h)) * 132 + wn * 64 + tn * 32 + r] = acc[tm][tn][i];
      __syncthreads();
      const float* cw = p.ffn_conv + (size_t)l * 3 * 5632;
      const int f = tid & 63, rg = tid >> 6; const int fg = nt * 64 + f;
      const float wa0 = cw[fg], wa1 = cw[5632 + fg], wa2 = cw[2 * 5632 + fg];
      const float wg0 = cw[2816 + fg], wg1 = cw[5632 + 2816 + fg], wg2 = cw[2 * 5632 + 2816 + fg];
      u16* act = p.proj;
      for (int rr = 1 + rg; rr <= 126; rr += 4) {
        const int ts = tin0 - 1 + rr;
        if (ts >= L) break;
        const float a = wa0 * U[(rr - 1) * 132 + f] + wa1 * U[rr * 132 + f] + wa2 * U[(rr + 1) * 132 + f];
        const float g = wg0 * U[(rr - 1) * 132 + 64 + f] + wg1 * U[rr * 132 + 64 + f] + wg2 * U[(rr + 1) * 132 + 64 + f];
        act[(size_t)(seqbase + ts) * 2816 + fg] = f2bf(a * siluf(g));
      }
      __syncthreads();
    }
  }
}

template <int MODE>
DI void attn_item(const P* __restrict__ gp, int jj, int it, char* smem) {
  const P& p = *gp;
  u16* Ks = (u16*)smem; u16* Vt = Ks + 64 * 72; float* rpb_s = (float*)(Vt + 64 * 72);
  int tid_ = threadIdx.x; asm volatile("" : "+v"(tid_)); const int tid = tid_, lane = tid & 63, wave = tid >> 6, r = lane & 31, h = lane >> 5;
  constexpr bool EVENL = (MODE == 0 || MODE == 1);
  constexpr bool LAT = (MODE == 1 || MODE == 3);
  constexpr int PS = EVENL ? EVN : ODN;
  int b, hq, qb, tokbase;
  if (!LAT) { b = it >> 4; hq = (it >> 1) & 7; qb = it & 1; tokbase = b * 256; }
  else { b = it >> 8; hq = (it >> 5) & 7; qb = it & 31; tokbase = NP_ + b * 4096; }
  const int hk = EVENL ? hq : (hq >> 2);
  const int kcol = 512 + hk * 64, vcol = (EVENL ? 1024 : 640) + hk * 64, qcol = hq * 64;
  const int tq = qb * 128 + wave * 32 + r;
  const size_t qtok = (size_t)tokbase + tq;
  __syncthreads();
  if (MODE == 1) { for (int i = tid; i < 465; i += 256) rpb_s[i] = p.a_rpb[(size_t)(jj * 8 + hq) * 465 + i]; }
  bf16x8 qf[4];
#pragma unroll
  for (int s = 0; s < 4; ++s) qf[s] = *(const bf16x8*)(p.proj + qtok * PS + qcol + 16 * s + 8 * h);
  if (MODE == 3) {
    const int prow = tq >> 6, pcol = tq & 63;
#pragma unroll
    for (int half = 0; half < 2; ++half) {
      const int pos = half ? pcol : prow;
#pragma unroll
      for (int j = 0; j < 8; ++j) {
        const float cs = p.rope[(pos * 16 + 8 * h + j) * 2], sn = p.rope[(pos * 16 + 8 * h + j) * 2 + 1];
        const float x1 = bf2f((u16)qf[2 * half][j]), x2 = bf2f((u16)qf[2 * half + 1][j]);
        qf[2 * half][j] = (short)f2bf(x1 * cs - x2 * sn);
        qf[2 * half + 1][j] = (short)f2bf(x1 * sn + x2 * cs);
      }
    }
  }
  float m_run = -1e30f, l_run = 0.f;
  if (MODE == 2 || MODE == 3) { m_run = p.c_sink[jj * 8 + hq]; l_run = h == 0 ? 1.f : 0.f; }
  f32x16 ot[2]; zero16(ot[0]); zero16(ot[1]);
  int loc0 = 0, nloc = 0;
  if (MODE == 1) {
    const int qi0 = 2 * qb;
    const int rlo = min(max(qi0 - 4, 0), 56), rhi = min(max(qi0 + 1 - 4, 0), 56) + 7;
    loc0 = rlo; nloc = rhi - rlo + 1;
  } else if (MODE == 3) {
    loc0 = max(0, 2 * qb - 2); nloc = min(63, 2 * qb + 3) - loc0 + 1;
  }
  const int qi = tq >> 6, qw = tq & 63;
  const int r0w = min(max(qi - 4, 0), 56), c0w = min(max(qw - 8, 0), 48);
  const int key = tid >> 2, seg = tid & 3;
  for (int kb = 0; kb < 4 + nloc; ++kb) {
    const bool isctx = kb < 4;
    const int blk = isctx ? kb : loc0 + kb - 4;
    __syncthreads();
    {
      float kf[16], vf[16];
      if (LAT && isctx) {
        const float* kc = (MODE == 1) ? p.cache_a_k + ((size_t)((b * 2 + jj) * 8 + hk)) * 16384 : p.cache_c_k + ((size_t)((b * 2 + jj) * 2 + hk)) * 16384;
        const float* vc = (MODE == 1) ? p.cache_a_v + ((size_t)((b * 2 + jj) * 8 + hk)) * 16384 : p.cache_c_v + ((size_t)((b * 2 + jj) * 2 + hk)) * 16384;
        const float4* kp4 = (const float4*)(kc + (size_t)(blk * 64 + key) * 64 + seg * 16);
        const float4* vp4 = (const float4*)(vc + (size_t)(blk * 64 + key) * 64 + seg * 16);
#pragma unroll
        for (int e = 0; e < 4; ++e) {
          const float4 a = kp4[e], c = vp4[e];
          kf[4 * e] = a.x; kf[4 * e + 1] = a.y; kf[4 * e + 2] = a.z; kf[4 * e + 3] = a.w;
          vf[4 * e] = c.x; vf[4 * e + 1] = c.y; vf[4 * e + 2] = c.z; vf[4 * e + 3] = c.w;
        }
      } else {
        const u16* rowp = p.proj + ((size_t)tokbase + blk * 64 + key) * PS;
        const bf16x8 k0 = *(const bf16x8*)(rowp + kcol + seg * 16), k1 = *(const bf16x8*)(rowp + kcol + seg * 16 + 8);
        const bf16x8 v0 = *(const bf16x8*)(rowp + vcol + seg * 16), v1 = *(const bf16x8*)(rowp + vcol + seg * 16 + 8);
#pragma unroll
        for (int e = 0; e < 8; ++e) { kf[e] = bf2f((u16)k0[e]); kf[8 + e] = bf2f((u16)k1[e]); vf[e] = bf2f((u16)v0[e]); vf[8 + e] = bf2f((u16)v1[e]); }
        if (MODE == 3) {
          const bf16x8 p0 = *(const bf16x8*)(rowp + kcol + (seg ^ 1) * 16), p1 = *(const bf16x8*)(rowp + kcol + (seg ^ 1) * 16 + 8);
          const int pos = (seg & 2) ? key : blk;
#pragma unroll
          for (int e = 0; e < 16; ++e) {
            const float pr = bf2f((u16)(e < 8 ? p0[e & 7] : p1[e & 7]));
            const float cs = p.rope[(pos * 16 + e) * 2], sn = p.rope[(pos * 16 + e) * 2 + 1];
            kf[e] = (seg & 1) ? (pr * sn + kf[e] * cs) : (kf[e] * cs - pr * sn);
          }
        }
      }
      bf16x8 o0, o1;
#pragma unroll
      for (int e = 0; e < 8; ++e) { o0[e] = (short)f2bf(kf[e]); o1[e] = (short)f2bf(kf[8 + e]); }
      *(bf16x8*)(Ks + key * 72 + seg * 16) = o0;
      *(bf16x8*)(Ks + key * 72 + seg * 16 + 8) = o1;
#pragma unroll
      for (int e = 0; e < 16; ++e) Vt[(seg * 16 + e) * 72 + key] = f2bf(vf[e]);
    }
    __syncthreads();
    bool active = true;
    if (MODE == 1 && !isctx) active = (blk >= r0w && blk < r0w + 8);
    if (active) {
      f32x16 st[2]; zero16(st[0]); zero16(st[1]);
#pragma unroll
      for (int kt = 0; kt < 2; ++kt)
#pragma unroll
        for (int s = 0; s < 4; ++s) {
          const bf16x8 a = *(const bf16x8*)(Ks + (kt * 32 + r) * 72 + 16 * s + 8 * h);
          st[kt] = MFMA(a, qf[s], st[kt]);
        }
      float mx = m_run;
#pragma unroll
      for (int kt = 0; kt < 2; ++kt)
#pragma unroll
        for (int i = 0; i < 16; ++i) {
          float s = st[kt][i] * 0.125f;
          const int kk = kt * 32 + crow(i, h);
          if (MODE == 1 && !isctx) {
            const bool ok = (kk >= c0w && kk < c0w + 16);
            s = ok ? s + rpb_s[(blk - qi + 7) * 31 + (kk - qw + 15)] : -1e30f;
          }
          if (MODE == 3 && !isctx) {
            const int dlt = blk * 64 + kk - tq;
            s = (dlt <= 128 && dlt >= -128) ? s : -1e30f;
          }
          st[kt][i] = s;
          mx = fmaxf(mx, s);
        }
      mx = fmaxf(mx, __shfl_xor(mx, 32));
      const float alpha = __expf(m_run - mx);
      m_run = mx;
      float ps = 0.f;
#pragma unroll
      for (int kt = 0; kt < 2; ++kt)
#pragma unroll
        for (int i = 0; i < 16; ++i) { const float pv = __expf(st[kt][i] - mx); st[kt][i] = pv; ps += pv; }
      l_run = l_run * alpha + ps;
#pragma unroll
      for (int dt = 0; dt < 2; ++dt)
#pragma unroll
        for (int i = 0; i < 16; ++i) ot[dt][i] *= alpha;
#pragma unroll
      for (int kt = 0; kt < 2; ++kt) {
        const bf16x8 pb0 = packs<0>(st[kt]), pb1 = packs<1>(st[kt]);
#pragma unroll
        for (int dt = 0; dt < 2; ++dt) {
          const bf16x8 pa0 = ld2x4(Vt + (dt * 32 + r) * 72 + kt * 32 + 4 * h);
          const bf16x8 pa1 = ld2x4(Vt + (dt * 32 + r) * 72 + kt * 32 + 16 + 4 * h);
          ot[dt] = MFMA(pa0, pb0, ot[dt]);
          ot[dt] = MFMA(pa1, pb1, ot[dt]);
        }
      }
    }
  }
  l_run += __shfl_xor(l_run, 32);
  const float inv = 1.f / l_run;
  u16* dst = p.hn + qtok * 1024 + qcol;
#pragma unroll
  for (int dt = 0; dt < 2; ++dt)
#pragma unroll
    for (int g4 = 0; g4 < 4; ++g4) {
      ushort4 o;
      o.x = f2bf(ot[dt][4 * g4] * inv); o.y = f2bf(ot[dt][4 * g4 + 1] * inv); o.z = f2bf(ot[dt][4 * g4 + 2] * inv); o.w = f2bf(ot[dt][4 * g4 + 3] * inv);
      *(ushort4*)(dst + dt * 32 + 8 * g4 + 4 * h) = o;
    }
}

struct ChainId { int lat, b, h, dir, T, base, nch; };
DI ChainId chain_decode(int it) {
  ChainId c; c.lat = it < 128; const int q = c.lat ? it : it - 128;
  c.b = q >> 4; c.h = (q >> 1) & 7; c.dir = q & 1; c.T = c.lat ? 4096 : 256; c.base = c.lat ? NP_ + c.b * 4096 : c.b * 256; c.nch = c.T >> 6;
  return c;
}
DI int tokof(const ChainId& c, int step, int row) { const int pp = step * 64 + row; return c.base + (c.dir ? c.T - 1 - pp : pp); }

DI void gla_chain(const P* __restrict__ gp, int jj, int it, char* smem) {
  const P& p = *gp;
  const ChainId cid = chain_decode(it);
  int tid_ = threadIdx.x; asm volatile("" : "+v"(tid_)); const int tid = tid_, lane = tid & 63, wave = tid >> 6, r = lane & 31, h = lane >> 5;
  const int hh = cid.h, dir = cid.dir;
  u16* QT = (u16*)smem; u16* KT = QT + 4608; u16* KEt = KT + 4608; u16* Vt = KEt + 4608;
  float* GL = (float*)(Vt + 4608); float* gq = GL + 1024; float* dec = gq + 256; float* Ost = dec + 64;
  const int d = tid & 63, cq = tid >> 6;
  float wg[16];
#pragma unroll
  for (int rr = 0; rr < 16; ++rr) wg[rr] = p.b_w_g2[((size_t)((jj * 2 + dir) * 16 + rr)) * 512 + hh * 64 + d];
  const float bg = p.b_b_g[(jj * 2 + dir) * 512 + hh * 64 + d];
  const int vh = wave & 1;
  f32x16 S[2]; zero16(S[0]); zero16(S[1]);
  const size_t sidx = ((size_t)(((cid.b * 2 + jj) * 2 + dir) * 8 + hh)) * 4096;
  if (wave < 2 && cid.lat) {
#pragma unroll
    for (int dt = 0; dt < 2; ++dt)
#pragma unroll
      for (int i = 0; i < 16; ++i) S[dt][i] = p.state_b[sidx + (dt * 32 + crow(i, h)) * 64 + vh * 32 + r];
  }
  for (int step_ = 0; step_ < cid.nch; ++step_) {
    int step = step_;
    asm volatile("" : "+v"(step));
    __syncthreads();
    {
      const int c = tid >> 2, sg = tid & 3;
      const int tok = tokof(cid, step, c);
      const ushort4 gv = *(const ushort4*)(p.proj + (size_t)tok * EVN + 3072 + dir * 16 + sg * 4);
      GL[c * 16 + sg * 4] = bf2f(gv.x); GL[c * 16 + sg * 4 + 1] = bf2f(gv.y); GL[c * 16 + sg * 4 + 2] = bf2f(gv.z); GL[c * 16 + sg * 4 + 3] = bf2f(gv.w);
    }
    __syncthreads();
    float Gl[16]; float run = 0.f;
#pragma unroll
    for (int i = 0; i < 16; ++i) {
      const int c = cq * 16 + i;
      float z = bg;
#pragma unroll
      for (int rr = 0; rr < 16; ++rr) z += GL[c * 16 + rr] * wg[rr];
      const float g = (fminf(z, 0.f) - log1pf(expf(-fabsf(z)))) * (1.f / 16.f);
      run += g; Gl[i] = run;
    }
    gq[cq * 64 + d] = run;
    __syncthreads();
    float off = 0.f, tot = 0.f;
#pragma unroll
    for (int q2 = 0; q2 < 4; ++q2) { const float t = gq[q2 * 64 + d]; if (q2 < cq) off += t; tot += t; }
#pragma unroll
    for (int i = 0; i < 16; ++i) {
      const int c = cq * 16 + i;
      const int tok = tokof(cid, step, c);
      const float G = Gl[i] + off;
      const u16* rowp = p.proj + (size_t)tok * EVN + hh * 64 + d;
      const float qv = bf2f(rowp[1536]), kv = bf2f(rowp[2048]);
      const u16 vb = rowp[2560];
      QT[c * 72 + d] = f2bf(qv * 0.125f * expf(G));
      KT[c * 72 + d] = f2bf(kv * expf(-G));
      KEt[d * 72 + c] = f2bf(kv * expf(tot - G));
      Vt[d * 72 + c] = vb;
    }
    if (cq == 0) dec[d] = expf(tot);
    __syncthreads();
    if (wave < 2) {
      f32x16 at[2][2];
#pragma unroll
      for (int a = 0; a < 2; ++a)
#pragma unroll
        for (int b2 = 0; b2 < 2; ++b2) zero16(at[a][b2]);
#pragma unroll
      for (int ks = 0; ks < 4; ++ks) {
        const bf16x8 a0 = *(const bf16x8*)(KT + r * 72 + ks * 16 + 8 * h), a1 = *(const bf16x8*)(KT + (32 + r) * 72 + ks * 16 + 8 * h);
        const bf16x8 b0 = *(const bf16x8*)(QT + r * 72 + ks * 16 + 8 * h), b1 = *(const bf16x8*)(QT + (32 + r) * 72 + ks * 16 + 8 * h);
        at[0][0] = MFMA(a0, b0, at[0][0]); at[0][1] = MFMA(a0, b1, at[0][1]);
        at[1][0] = MFMA(a1, b0, at[1][0]); at[1][1] = MFMA(a1, b1, at[1][1]);
      }
#pragma unroll
      for (int st = 0; st < 2; ++st)
#pragma unroll
        for (int ct = 0; ct < 2; ++ct)
#pragma unroll
          for (int i = 0; i < 16; ++i) { if (st * 32 + crow(i, h) > ct * 32 + r) at[st][ct][i] = 0.f; }
      f32x16 o[2]; zero16(o[0]); zero16(o[1]);
#pragma unroll
      for (int ct = 0; ct < 2; ++ct)
#pragma unroll
        for (int st = 0; st < 2; ++st) {
          const bf16x8 x0 = packs<0>(at[st][ct]), x1 = packs<1>(at[st][ct]);
          const bf16x8 pb0 = ld2x4(Vt + (vh * 32 + r) * 72 + st * 32 + 4 * h);
          const bf16x8 pb1 = ld2x4(Vt + (vh * 32 + r) * 72 + st * 32 + 16 + 4 * h);
          o[ct] = MFMA(x0, pb0, o[ct]);
          o[ct] = MFMA(x1, pb1, o[ct]);
        }
#pragma unroll
      for (int dt = 0; dt < 2; ++dt) {
        const bf16x8 xs0 = packs<0>(S[dt]), xs1 = packs<1>(S[dt]);
#pragma unroll
        for (int ct = 0; ct < 2; ++ct) {
          const bf16x8 pa0 = ld2x4(QT + (ct * 32 + r) * 72 + dt * 32 + 4 * h);
          const bf16x8 pa1 = ld2x4(QT + (ct * 32 + r) * 72 + dt * 32 + 16 + 4 * h);
          o[ct] = MFMA(pa0, xs0, o[ct]);
          o[ct] = MFMA(pa1, xs1, o[ct]);
        }
      }
#pragma unroll
      for (int dt = 0; dt < 2; ++dt)
#pragma unroll
        for (int i = 0; i < 16; ++i) S[dt][i] *= dec[dt * 32 + crow(i, h)];
#pragma unroll
      for (int ks = 0; ks < 4; ++ks) {
        const bf16x8 bv = *(const bf16x8*)(Vt + (vh * 32 + r) * 72 + ks * 16 + 8 * h);
#pragma unroll
        for (int dt = 0; dt < 2; ++dt) {
          const bf16x8 a = *(const bf16x8*)(KEt + (dt * 32 + r) * 72 + ks * 16 + 8 * h);
          S[dt] = MFMA(a, bv, S[dt]);
        }
      }
#pragma unroll
      for (int ct = 0; ct < 2; ++ct)
#pragma unroll
        for (int i = 0; i < 16; ++i) Ost[(ct * 32 + crow(i, h)) * 68 + vh * 32 + r] = o[ct][i];
    }
    __syncthreads();
    {
      const int c = tid >> 2, sg = tid & 3;
      const int tok = tokof(cid, step, c);
      u16* dst = (dir ? p.ot1 + (size_t)tok * 512 + hh * 64 : p.hn + (size_t)tok * 1024 + 512 + hh * 64) + sg * 16;
      bf16x8 w0, w1;
#pragma unroll
      for (int e = 0; e < 8; ++e) { w0[e] = (short)f2bf(Ost[c * 68 + sg * 16 + e]); w1[e] = (short)f2bf(Ost[c * 68 + sg * 16 + 8 + e]); }
      *(bf16x8*)dst = w0; *(bf16x8*)(dst + 8) = w1;
    }
  }
  if (wave < 2 && !cid.lat) {
#pragma unroll
    for (int dt = 0; dt < 2; ++dt)
#pragma unroll
      for (int i = 0; i < 16; ++i) p.out[OFF_SB + sidx + (dt * 32 + crow(i, h)) * 64 + vh * 32 + r] = S[dt][i];
  }
}

DI void delta_chain(const P* __restrict__ gp, int jj, int it, char* smem) {
  const P& p = *gp;
  const ChainId cid = chain_decode(it);
  int tid_ = threadIdx.x; asm volatile("" : "+v"(tid_)); const int tid0 = tid_;
  const int hh = cid.h, dir = cid.dir;
  u16* Qn = (u16*)smem; u16* Kn = Qn + 4608; u16* Kt = Kn + 4608; u16* AQK = Kt + 4608; u16* KC = AQK + 4608;
  float* At = (float*)(KC + 4608); float* Wv = At + 64 * 68; float* Gs = Wv + 64 * 65; float* Bt = Gs + 64;
  const float aexp = expf(p.d_a_log[(jj * 2 + dir) * 8 + hh]);
  const float dtb = p.d_dt_bias[(jj * 2 + dir) * 8 + hh];
  f32x16 S[2]; zero16(S[0]); zero16(S[1]);
  const size_t sidx = ((size_t)(((cid.b * 2 + jj) * 2 + dir) * 8 + hh)) * 4096;
  { const int tid = tid0, lane = tid & 63, wave = tid >> 6, r = lane & 31, h = lane >> 5;
  if (wave < 2 && cid.lat) {
    const int vh = wave & 1;
#pragma unroll
    for (int dt = 0; dt < 2; ++dt)
#pragma unroll
      for (int i = 0; i < 16; ++i) S[dt][i] = p.state_d[sidx + (dt * 32 + crow(i, h)) * 64 + vh * 32 + r];
  }
  }
  const float* cwp = p.d_conv + (size_t)jj * 3 * 1536;
  for (int step_ = 0; step_ < cid.nch; ++step_) {
    int step = step_;
    asm volatile("" : "+v"(step));
    __syncthreads();
    {const int tid = opq(tid0), lane = tid & 63, wave = tid >> 6, r = lane & 31, h = lane >> 5, vh = wave & 1; (void)r; (void)h; (void)vh; (void)lane;
    if (wave == 0) {
      const int tok = tokof(cid, step, lane);
      const float da = bf2f(p.proj[(size_t)tok * ODN + 2304 + dir * 8 + hh]);
      const float db = bf2f(p.proj[(size_t)tok * ODN + 2320 + dir * 8 + hh]);
      const float x = da + dtb;
      const float sp = x > 20.f ? x : log1pf(expf(x));
      float G = -aexp * sp;
#pragma unroll
      for (int o = 1; o < 64; o <<= 1) { const float t = __shfl_up(G, o); if (lane >= o) G += t; }
      Gs[lane] = G; Bt[lane] = 1.f / (1.f + expf(-db));
    }
    {
      const int c = tid >> 2, sg = tid & 3;
      const int tok = tokof(cid, step, c);
      const int pos = tok - cid.base;
      const bool hp = pos > 0, hn_ = pos < cid.T - 1;
#pragma unroll 1
      for (int wh = 0; wh < 3; ++wh) {
        const int ch0 = wh * 512 + hh * 64 + sg * 16;
        const u16* cur = p.proj + (size_t)tok * ODN + 768 + ch0;
        float y[16];
        float ss = 0.f;
#pragma unroll
        for (int hf = 0; hf < 2; ++hf) {
          const bf16x8 xc = *(const bf16x8*)(cur + hf * 8);
          bf16x8 xp, xn;
#pragma unroll
          for (int e = 0; e < 8; ++e) { xp[e] = 0; xn[e] = 0; }
          if (hp) xp = *(const bf16x8*)(cur - ODN + hf * 8);
          if (hn_) xn = *(const bf16x8*)(cur + ODN + hf * 8);
#pragma unroll
          for (int e = 0; e < 8; ++e) {
            const int ch = ch0 + hf * 8 + e;
            float v = cwp[ch] * bf2f((u16)xp[e]) + cwp[1536 + ch] * bf2f((u16)xc[e]) + cwp[3072 + ch] * bf2f((u16)xn[e]);
            v = v / (1.f + expf(-v));
            y[hf * 8 + e] = v; ss += v * v;
          }
        }
        ss += __shfl_xor(ss, 1); ss += __shfl_xor(ss, 2);
        const float rn = rsqrtf(ss + 1e-6f);
        if (wh == 0) {
#pragma unroll
          for (int e = 0; e < 16; ++e) Qn[c * 72 + sg * 16 + e] = f2bf(y[e] * rn * 0.125f);
        } else if (wh == 1) {
#pragma unroll
          for (int e = 0; e < 16; ++e) { const u16 kb = f2bf(y[e] * rn); Kn[c * 72 + sg * 16 + e] = kb; Kt[(sg * 16 + e) * 72 + c] = kb; }
        } else {
#pragma unroll
          for (int e = 0; e < 16; ++e) Wv[c * 65 + sg * 16 + e] = y[e];
        }
      }
    }
    }
    __syncthreads();
    {const int tid = opq(tid0), lane = tid & 63, wave = tid >> 6, r = lane & 31, h = lane >> 5, vh = wave & 1; (void)r; (void)h; (void)vh; (void)lane;
    if (wave < 2) {
      f32x16 akk[2], aqk[2]; zero16(akk[0]); zero16(akk[1]); zero16(aqk[0]); zero16(aqk[1]);
#pragma unroll
      for (int ks = 0; ks < 4; ++ks) {
        const bf16x8 bk = *(const bf16x8*)(Kn + (vh * 32 + r) * 72 + ks * 16 + 8 * h);
#pragma unroll
        for (int ct = 0; ct < 2; ++ct) {
          const bf16x8 ak = *(const bf16x8*)(Kn + (ct * 32 + r) * 72 + ks * 16 + 8 * h);
          const bf16x8 aq = *(const bf16x8*)(Qn + (ct * 32 + r) * 72 + ks * 16 + 8 * h);
          akk[ct] = MFMA(ak, bk, akk[ct]);
          aqk[ct] = MFMA(aq, bk, aqk[ct]);
        }
      }
      const int s = vh * 32 + r;
      const float Gss = Gs[s];
#pragma unroll
      for (int ct = 0; ct < 2; ++ct)
#pragma unroll
        for (int g4 = 0; g4 < 4; ++g4) {
          const int c0 = ct * 32 + 8 * g4 + 4 * h;
          float4 val;
#pragma unroll
          for (int e = 0; e < 4; ++e) {
            const int c = c0 + e;
            const float gam = expf(fminf(Gs[c] - Gss, 0.f));
            const float av = (s < c) ? akk[ct][4 * g4 + e] * Bt[c] * gam : 0.f;
            if (e == 0) val.x = av; else if (e == 1) val.y = av; else if (e == 2) val.z = av; else val.w = av;
            AQK[c * 72 + s] = f2bf((s <= c) ? aqk[ct][4 * g4 + e] * gam : 0.f);
          }
          *(float4*)(At + s * 68 + c0) = val;
        }
    }
    }
    __syncthreads();
    {const int tid = opq(tid0), lane = tid & 63, wave = tid >> 6, r = lane & 31, h = lane >> 5, vh = wave & 1; (void)r; (void)h; (void)vh; (void)lane;
    if (wave < 2) {
      const bool isv = wave == 0;
      const int col = lane;
#pragma unroll 1
      for (int bi = 0; bi < 4; ++bi) {
        float acc[16];
#pragma unroll
        for (int ci = 0; ci < 16; ++ci) {
          const int c = 16 * bi + ci;
          acc[ci] = isv ? Wv[c * 65 + col] * Bt[c] : bf2f(Kn[c * 72 + col]) * Bt[c] * expf(Gs[c]);
        }
        for (int s2 = 0; s2 < 16 * bi; ++s2) {
          const float xs = isv ? Wv[s2 * 65 + col] : bf2f(KC[s2 * 72 + col]);
          const float4* a4 = (const float4*)(At + s2 * 68 + 16 * bi);
#pragma unroll
          for (int q = 0; q < 4; ++q) {
            const float4 a = a4[q];
            acc[4 * q] -= a.x * xs; acc[4 * q + 1] -= a.y * xs; acc[4 * q + 2] -= a.z * xs; acc[4 * q + 3] -= a.w * xs;
          }
        }
#pragma unroll
        for (int ci = 0; ci < 16; ++ci) {
          const float x = acc[ci];
          const float* arow = At + (16 * bi + ci) * 68 + 16 * bi;
#pragma unroll
          for (int cj = ci + 1; cj < 16; ++cj) acc[cj] -= arow[cj] * x;
          if (isv) Wv[(16 * bi + ci) * 65 + col] = x; else KC[(16 * bi + ci) * 72 + col] = f2bf(x);
        }
      }
    }
    }
    __syncthreads();
    {const int tid = opq(tid0), lane = tid & 63, wave = tid >> 6, r = lane & 31, h = lane >> 5, vh = wave & 1; (void)r; (void)h; (void)vh; (void)lane;
    if (wave < 2) {
      f32x16 kS[2], qS[2]; zero16(kS[0]); zero16(kS[1]); zero16(qS[0]); zero16(qS[1]);
#pragma unroll
      for (int dt = 0; dt < 2; ++dt) {
        const bf16x8 xs0 = packs<0>(S[dt]), xs1 = packs<1>(S[dt]);
#pragma unroll
        for (int ct = 0; ct < 2; ++ct) {
          kS[ct] = MFMA(ld2x4(KC + (ct * 32 + r) * 72 + dt * 32 + 4 * h), xs0, kS[ct]);
          kS[ct] = MFMA(ld2x4(KC + (ct * 32 + r) * 72 + dt * 32 + 16 + 4 * h), xs1, kS[ct]);
          qS[ct] = MFMA(ld2x4(Qn + (ct * 32 + r) * 72 + dt * 32 + 4 * h), xs0, qS[ct]);
          qS[ct] = MFMA(ld2x4(Qn + (ct * 32 + r) * 72 + dt * 32 + 16 + 4 * h), xs1, qS[ct]);
        }
      }
      f32x16 vn[2], o[2];
      const float Glast = Gs[63];
#pragma unroll
      for (int ct = 0; ct < 2; ++ct)
#pragma unroll
        for (int i = 0; i < 16; ++i) {
          const int c = ct * 32 + crow(i, h);
          vn[ct][i] = Wv[c * 65 + vh * 32 + r] - kS[ct][i];
          o[ct][i] = qS[ct][i] * expf(Gs[c]);
        }
#pragma unroll
      for (int st = 0; st < 2; ++st) {
        const bf16x8 xs0 = packs<0>(vn[st]), xs1 = packs<1>(vn[st]);
#pragma unroll
        for (int ct = 0; ct < 2; ++ct) {
          o[ct] = MFMA(ld2x4(AQK + (ct * 32 + r) * 72 + st * 32 + 4 * h), xs0, o[ct]);
          o[ct] = MFMA(ld2x4(AQK + (ct * 32 + r) * 72 + st * 32 + 16 + 4 * h), xs1, o[ct]);
        }
      }
      const float dl = expf(Glast);
#pragma unroll
      for (int st = 0; st < 2; ++st)
#pragma unroll
        for (int i = 0; i < 16; ++i) vn[st][i] *= expf(Glast - Gs[st * 32 + crow(i, h)]);
#pragma unroll
      for (int dt = 0; dt < 2; ++dt)
#pragma unroll
        for (int i = 0; i < 16; ++i) S[dt][i] *= dl;
#pragma unroll
      for (int st = 0; st < 2; ++st) {
        const bf16x8 xs0 = packs<0>(vn[st]), xs1 = packs<1>(vn[st]);
#pragma unroll
        for (int dt = 0; dt < 2; ++dt) {
          S[dt] = MFMA(ld2x4(Kt + (dt * 32 + r) * 72 + st * 32 + 4 * h), xs0, S[dt]);
          S[dt] = MFMA(ld2x4(Kt + (dt * 32 + r) * 72 + st * 32 + 16 + 4 * h), xs1, S[dt]);
        }
      }
#pragma unroll
      for (int ct = 0; ct < 2; ++ct)
#pragma unroll
        for (int i = 0; i < 16; ++i) At[(ct * 32 + crow(i, h)) * 68 + vh * 32 + r] = o[ct][i];
    }
    }
    __syncthreads();
    {
      const int tid = opq(tid0);
      const int c = tid >> 2, sg = tid & 3;
      const int tok = tokof(cid, step, c);
      u16* dst = (dir ? p.ot1 + (size_t)tok * 512 + hh * 64 : p.hn + (size_t)tok * 1024 + 512 + hh * 64) + sg * 16;
      bf16x8 w0, w1;
#pragma unroll
      for (int e = 0; e < 8; ++e) { w0[e] = (short)f2bf(At[c * 68 + sg * 16 + e]); w1[e] = (short)f2bf(At[c * 68 + sg * 16 + 8 + e]); }
      *(bf16x8*)dst = w0; *(bf16x8*)(dst + 8) = w1;
    }
  }
  {const int tid = opq(tid0), lane = tid & 63, wave = tid >> 6, r = lane & 31, h = lane >> 5, vh = wave & 1; (void)r; (void)h; (void)vh; (void)lane;
  if (wave < 2 && !cid.lat) {
#pragma unroll
    for (int dt = 0; dt < 2; ++dt)
#pragma unroll
      for (int i = 0; i < 16; ++i) p.out[OFF_SD + sidx + (dt * 32 + crow(i, h)) * 64 + vh * 32 + r] = S[dt][i];
  }
}
}

DI void mixer_phase(const P* __restrict__ gp, int l, char* smem) {
  const P& p = *gp;
  const bool even = !(l & 1); const int jj = l >> 1;
  const int total = 384 + 2048 + 256;
  int* s_item = (int*)(smem + SMEM_BYTES - 16);
  for (;;) {
    __syncthreads();
    if (threadIdx.x == 0) *s_item = atomicAdd(p.cnt + l, 1);
    __syncthreads();
    const int item = *s_item;
    if (item >= total) break;
    if (item < 384) { if (even) gla_chain(gp, jj, item, smem); else delta_chain(gp, jj, item, smem); }
    else if (item < 384 + 2048) { if (even) attn_item<1>(gp, jj, item - 384, smem); else attn_item<3>(gp, jj, item - 384, smem); }
    else { if (even) attn_item<0>(gp, jj, item - 384 - 2048, smem); else attn_item<2>(gp, jj, item - 384 - 2048, smem); }
  }
}

DI void finalize_phase(const P* __restrict__ gp, int l) {
  const P& p = *gp;
  const bool even = !(l & 1); const int jj = l >> 1;
  int tid_ = threadIdx.x; asm volatile("" : "+v"(tid_)); const int tid = tid_;
  const int tk = tid >> 5, hh = (tid >> 2) & 7, sg = tid & 3;
  const int PS = even ? EVN : ODN; const int zcol = even ? 3104 : 2336;
  for (int item = blockIdx.x; item < NT_ / 8; item += gridDim.x) {
    const size_t tok = (size_t)item * 8 + tk;
    u16* a = p.hn + tok * 1024 + 512 + hh * 64 + sg * 16;
    const u16* bsrc = p.ot1 + tok * 512 + hh * 64 + sg * 16;
    const u16* zs = p.proj + tok * PS + zcol + hh * 64 + sg * 16;
    float o[16]; float ss = 0.f;
#pragma unroll
    for (int hf = 0; hf < 2; ++hf) {
      const bf16x8 x0 = *(const bf16x8*)(a + hf * 8), x1 = *(const bf16x8*)(bsrc + hf * 8);
#pragma unroll
      for (int e = 0; e < 8; ++e) { const float v = bf2f((u16)x0[e]) + bf2f((u16)x1[e]); o[hf * 8 + e] = v; ss += v * v; }
    }
    ss += __shfl_xor(ss, 1); ss += __shfl_xor(ss, 2);
    const float rstd = rsqrtf(ss * (1.f / 64.f) + 1e-6f);
    const float* ng = even ? p.b_norm_g + jj * 512 + hh * 64 + sg * 16 : p.d_norm_g + jj * 64 + sg * 16;
#pragma unroll
    for (int hf = 0; hf < 2; ++hf) {
      const bf16x8 z = *(const bf16x8*)(zs + hf * 8);
      bf16x8 w;
#pragma unroll
      for (int e = 0; e < 8; ++e) { const float zz = bf2f((u16)z[e]); w[e] = (short)f2bf(o[hf * 8 + e] * rstd * ng[hf * 8 + e] * siluf(zz)); }
      *(bf16x8*)(a + hf * 8) = w;
    }
  }
}

DI void run_phase(const P* __restrict__ gp, int ph, char* smem) {
  const P& p = *gp;
  if (ph == 0) { prep_phase(gp, smem); return; }
  if (ph == NPH - 1) { norm_phase(gp, 0, 0, false, true); return; }
  const int l = (ph - 1) >> 3, s = (ph - 1) & 7;
  const bool even = !(l & 1);
  const u16* W = p.wt + (size_t)l * LW;
  switch (s) {
    case 0: norm_phase(gp, l, 0, l == 0, false); break;
    case 1: gemm_phase<EPI_PROJ>(gp, l, smem, p.hn, 1024, W + WO_IN, 1024, 1024, 288, even ? 29 : 23, 0); break;
    case 2: mixer_phase(gp, l, smem); break;
    case 3: finalize_phase(gp, l); break;
    case 4: gemm_phase<EPI_RES>(gp, l, smem, p.hn, 1024, W + WO_OUT, 1024, 1024, 288, 8, 2); break;
    case 5: norm_phase(gp, l, 1, false, false); break;
    case 6: gemm_phase<EPI_FFN>(gp, l, smem, p.hn, 1024, W + WO_UP, 1024, 1024, 312, 44, 0); break;
    case 7: gemm_phase<EPI_RES>(gp, l, smem, p.proj, 2816, W + WO_DN, 2816, 2816, 288, 8, 5); break;
  }
}

__global__ void __launch_bounds__(256, 2) mk(P p, P* gp, int ph0, int ph1) {
  __shared__ __attribute__((aligned(16))) char smem[SMEM_BYTES];
  if (threadIdx.x == 0) *gp = p;
  __threadfence();
  __syncthreads();
  if (ph1 - ph0 > 1) {
    cg::grid_group grid = cg::this_grid();
    for (int ph = ph0; ph < ph1; ++ph) {
      run_phase(gp, ph, smem);
      if (ph + 1 < ph1) grid.sync();
    }
  } else {
    run_phase(gp, ph0, smem);
  }
}

extern "C" void kernel_launch(void* const* d_in, const int* in_sizes, int n_in, void* d_out, int out_size, void* d_ws, size_t ws_size,
                              hipStream_t stream) {
  P p{};
  const float** f = (const float**)&p;
  for (int i = 0; i < 31; ++i) f[i] = (const float*)d_in[i];
  p.out = (float*)d_out;
  char* ws = (char*)d_ws;
  size_t off = 0;
  p.hn = (u16*)(ws + off); off += (size_t)NT_ * 1024 * 2;
  p.proj = (u16*)(ws + off); off += (size_t)NT_ * EVN * 2;
  p.ot1 = (u16*)(ws + off); off += (size_t)NT_ * 512 * 2;
  p.wt = (u16*)(ws + off); off += 4 * LW * 2;
  p.mods = (float*)(ws + off); off += 4 * 9 * 6144 * 4;
  p.rope = (float*)(ws + off); off += 64 * 16 * 2 * 4;
  P* gp = (P*)(ws + off); off += 4096;
  p.cnt = (int*)(ws + off); off += 256;
  static int grid_blocks = 0;
  if (!grid_blocks) {
    int dev = 0, cus = 0, per_cu = 0;
    hipGetDevice(&dev);
    hipDeviceGetAttribute(&cus, hipDeviceAttributeMultiprocessorCount, dev);
    hipOccupancyMaxActiveBlocksPerMultiprocessor(&per_cu, mk, 256, 0);
    if (per_cu < 1) per_cu = 1;
    if (per_cu > 2) per_cu = 2;
    grid_blocks = cus * per_cu;
  }
#if MK_MULTI
  for (int ph = 0; ph < NPH; ++ph) {
    int a = ph, b = ph + 1;
    hipLaunchKernelGGL(mk, dim3(grid_blocks), dim3(256), 0, stream, p, gp, a, b);
  }
#else
  int ph0 = 0, ph1 = NPH;
  void* args[] = {&p, &gp, &ph0, &ph1};
  hipError_t e = hipLaunchCooperativeKernel((void*)mk, dim3(grid_blocks), dim3(256), args, 0, stream);
  if (e != hipSuccess) fprintf(stderr, "cooperative launch failed: %s (grid %d)\n", hipGetErrorString(e), grid_blocks);
#endif
}
```

```cpp
#include <hip/hip_runtime.h>
#include <hip/hip_cooperative_groups.h>
#include <cstdio>
namespace cg = cooperative_groups;

#ifndef MK_MULTI
#define MK_MULTI 0
#endif

#define DI __device__ __forceinline__
#define DN __device__ __noinline__
typedef unsigned short u16;
typedef __attribute__((ext_vector_type(8))) short bf16x8;
typedef __attribute__((ext_vector_type(4))) short s16x4;
typedef __attribute__((ext_vector_type(16))) float f32x16;
#define MFMA(a, b, c) __builtin_amdgcn_mfma_f32_32x32x16_bf16((a), (b), (c), 0, 0, 0)

static constexpr int NP_ = 4096, NT_ = 36864;
static constexpr int EVN = 3616, ODN = 2848;
static constexpr size_t OFF_AK = 37748736, OFF_AV = 41943040, OFF_SB = 46137344, OFF_CK = 48234496, OFF_CV = 49283072, OFF_SD = 50331648;
static constexpr size_t LW = 13500416, WO_UP = 0, WO_DN = 5767168, WO_IN = 8650752, WO_OUT = 12451840;
static constexpr int NPH = 34;
static constexpr int SMEM_BYTES = 80 * 1024;

struct P {
  const float *x_prompt, *x_sample, *cache_a_k, *cache_a_v, *state_b, *cache_c_k, *cache_c_v, *state_d, *c, *c_ctx, *ada_w, *ada_b,
      *norm1_g, *norm2_g, *ffn_up, *ffn_conv, *ffn_down, *ev_w_in, *ev_w_out, *a_rpb, *b_w_g2, *b_b_g, *b_norm_g, *od_w_in, *od_w_out,
      *c_sink, *d_conv, *d_a_log, *d_dt_bias, *d_norm_g, *final_g;
  float* out;
  u16 *hn, *proj, *ot1, *wt;
  float *mods, *rope;
  int* cnt;
};

DI u16 f2bf(float x) { unsigned u = __float_as_uint(x); u += 0x7fffu + ((u >> 16) & 1u); return (u16)(u >> 16); }
DI float bf2f(u16 b) { return __uint_as_float(((unsigned)b) << 16); }
DI int crow(int i, int h) { return (i & 3) + 8 * (i >> 2) + 4 * h; }
template <int S> DI bf16x8 packs(const f32x16& x) {
  bf16x8 v;
#pragma unroll
  for (int j = 0; j < 8; ++j) v[j] = (short)f2bf(x[8 * S + j]);
  return v;
}
DI bf16x8 ld2x4(const u16* p) {
  s16x4 lo = *(const s16x4*)p, hi = *(const s16x4*)(p + 8);
  return __builtin_shufflevector(lo, hi, 0, 1, 2, 3, 4, 5, 6, 7);
}
DI float siluf(float x) { return x / (1.f + __expf(-x)); }
DI int opq(int x) { asm volatile("" : "+v"(x)); return x; }
DI void zero16(f32x16& a) {
#pragma unroll
  for (int i = 0; i < 16; ++i) a[i] = 0.f;
}

DI void prep_phase(const P* __restrict__ gp, char* smem) {
  const P& p = *gp;
  int tid_ = threadIdx.x; asm volatile("" : "+v"(tid_)); const int tid = tid_;
  const int NWT = 4 * (1408 + 704 + 256) + 2 * (928 + 736);
  const int NADA = 384;
  const int total = NWT + NADA + 1;
  for (int item = blockIdx.x; item < total; item += gridDim.x) {
    if (item < NWT) {
      int rem = item; const float* src = nullptr; u16* dst = nullptr; int K = 0, N = 0, NPd = 0;
      for (int l = 0; l < 4; ++l) {
        const int jj = l >> 1; const bool ev = !(l & 1);
        const int nin = ev ? 928 : 736;
        if (rem < 1408) { src = p.ffn_up + (size_t)l * 1024 * 5632; dst = p.wt + l * LW + WO_UP; K = 1024; N = 5632; NPd = 5632; break; }
        rem -= 1408;
        if (rem < 704) { src = p.ffn_down + (size_t)l * 2816 * 1024; dst = p.wt + l * LW + WO_DN; K = 2816; N = 1024; NPd = 1024; break; }
        rem -= 704;
        if (rem < nin) { src = ev ? p.ev_w_in + (size_t)jj * 1024 * EVN : p.od_w_in + (size_t)jj * 1024 * ODN; dst = p.wt + l * LW + WO_IN; K = 1024; N = ev ? EVN : ODN; NPd = ev ? 3712 : 2944; break; }
        rem -= nin;
        if (rem < 256) { src = (ev ? p.ev_w_out : p.od_w_out) + (size_t)jj * 1024 * 1024; dst = p.wt + l * LW + WO_OUT; K = 1024; N = 1024; NPd = 1024; break; }
        rem -= 256;
      }
      const int ntn = NPd >> 6;
      const int tk = rem / ntn, tn = rem - tk * ntn;
      float* T = (float*)smem;
      __syncthreads();
#pragma unroll
      for (int i = 0; i < 16; ++i) {
        const int k = i * 4 + (tid >> 6), n = tid & 63;
        const int gn = tn * 64 + n;
        T[k * 65 + n] = (gn < N) ? src[(size_t)(tk * 64 + k) * N + gn] : 0.f;
      }
      __syncthreads();
#pragma unroll
      for (int i = 0; i < 16; ++i) {
        const int n = i * 4 + (tid >> 6), k = tid & 63;
        dst[(size_t)(tn * 64 + n) * K + tk * 64 + k] = f2bf(T[k * 65 + n]);
      }
    } else if (item < NWT + NADA) {
      const int it = item - NWT; const int l = it / 96, cgp = it - l * 96; const int n0 = cgp * 64;
      float* sc = (float*)smem;
      float* red = sc + 9 * 1024;
      __syncthreads();
      for (int idx = tid; idx < 9 * 1024; idx += 256) {
        const int ci = idx >> 10, k = idx & 1023;
        const float x = ci < 8 ? p.c[ci * 1024 + k] : p.c_ctx[k];
        sc[idx] = x / (1.f + expf(-x));
      }
      __syncthreads();
      const int wave = tid >> 6, lane = tid & 63;
      float acc[9];
#pragma unroll
      for (int ci = 0; ci < 9; ++ci) acc[ci] = 0.f;
      const float* wp = p.ada_w + ((size_t)l * 1024 + wave * 256) * 6144 + n0 + lane;
#pragma unroll 8
      for (int k = 0; k < 256; ++k) {
        const float wv = wp[(size_t)k * 6144];
#pragma unroll
        for (int ci = 0; ci < 9; ++ci) acc[ci] += sc[ci * 1024 + wave * 256 + k] * wv;
      }
#pragma unroll
      for (int ci = 0; ci < 9; ++ci) red[(wave * 9 + ci) * 64 + lane] = acc[ci];
      __syncthreads();
      for (int idx = tid; idx < 576; idx += 256) {
        const int ci = idx >> 6, col = idx & 63;
        const float s = red[(0 * 9 + ci) * 64 + col] + red[(1 * 9 + ci) * 64 + col] + red[(2 * 9 + ci) * 64 + col] + red[(3 * 9 + ci) * 64 + col];
        p.mods[(size_t)(l * 9 + ci) * 6144 + n0 + col] = s + p.ada_b[l * 6144 + n0 + col];
      }
    } else {
      if (tid < 8) p.cnt[tid] = 0;
      for (int idx = tid; idx < 1024; idx += 256) {
        const int pos = idx >> 4, fi = idx & 15;
        const float inv = powf(10000.f, -(float)fi / 16.f);
        const float ang = (float)pos * inv;
        p.rope[idx * 2] = cosf(ang); p.rope[idx * 2 + 1] = sinf(ang);
      }
    }
  }
}

DI void norm_phase(const P* __restrict__ gp, int l, int which, bool first, bool fin) {
  const P& p = *gp;
  int tid_ = threadIdx.x; asm volatile("" : "+v"(tid_)); const int tid = tid_, lane = tid & 63, wave = tid >> 6;
  for (int item = blockIdx.x; item < NT_ / 4; item += gridDim.x) {
    const int tok = item * 4 + wave;
    const float* src = first ? (tok < NP_ ? p.x_prompt + (size_t)tok * 1024 : p.x_sample + (size_t)(tok - NP_) * 1024) : p.out + (size_t)tok * 1024;
    float4 v[4];
    float ss = 0.f;
#pragma unroll
    for (int i = 0; i < 4; ++i) { v[i] = ((const float4*)src)[lane + 64 * i]; ss += v[i].x * v[i].x + v[i].y * v[i].y + v[i].z * v[i].z + v[i].w * v[i].w; }
#pragma unroll
    for (int o = 32; o >= 1; o >>= 1) ss += __shfl_xor(ss, o);
    const float rstd = rsqrtf(ss * (1.f / 1024.f) + 1e-6f);
    if (fin) {
#pragma unroll
      for (int i = 0; i < 4; ++i) {
        const float4 g = ((const float4*)p.final_g)[lane + 64 * i];
        float4 y; y.x = v[i].x * rstd * g.x; y.y = v[i].y * rstd * g.y; y.z = v[i].z * rstd * g.z; y.w = v[i].w * rstd * g.w;
        ((float4*)(p.out + (size_t)tok * 1024))[lane + 64 * i] = y;
      }
    } else {
      const int ci = tok < NP_ ? 8 : (tok - NP_) >> 12;
      const float* md = p.mods + (size_t)(l * 9 + ci) * 6144 + which * 3072;
      const float* gp = (which ? p.norm2_g : p.norm1_g) + l * 1024;
#pragma unroll
      for (int i = 0; i < 4; ++i) {
        const float4 g = ((const float4*)gp)[lane + 64 * i];
        const float4 sh = ((const float4*)md)[lane + 64 * i];
        const float4 sc = ((const float4*)(md + 1024))[lane + 64 * i];
        ushort4 o;
        o.x = f2bf(v[i].x * rstd * g.x * (1.f + sc.x) + sh.x);
        o.y = f2bf(v[i].y * rstd * g.y * (1.f + sc.y) + sh.y);
        o.z = f2bf(v[i].z * rstd * g.z * (1.f + sc.z) + sh.z);
        o.w = f2bf(v[i].w * rstd * g.w * (1.f + sc.w) + sh.w);
        ((ushort4*)(p.hn + (size_t)tok * 1024))[lane + 64 * i] = o;
        if (first) ((float4*)(p.out + (size_t)tok * 1024))[lane + 64 * i] = v[i];
      }
    }
  }
}

DI uint4 ldsel(const u16* pv, const u16* safe, unsigned ok) {
  uint4 t = *(const uint4*)(ok ? pv : safe);
  if (!ok) { t.x = 0; t.y = 0; t.z = 0; t.w = 0; }
  return t;
}
enum { EPI_PROJ = 0, EPI_RES = 1, EPI_FFN = 2 };

template <int EPI>
DI void gemm_phase(const P* __restrict__ gp, int l, char* smem, const u16* __restrict__ A, int lda, const u16* __restrict__ B, int ldb, int K, int MT,
                   int NTn, int gsel) {
  const P& p = *gp;
  u16* As = (u16*)smem;
  int tid_ = threadIdx.x; asm volatile("" : "+v"(tid_)); const int tid = tid_, lane = tid & 63, wave = tid >> 6, r = lane & 31, h = lane >> 5;
  const int wm = wave & 1, wn = wave >> 1;
  const int KT = K >> 6;
  const bool even = !(l & 1); const int jj = l >> 1;
  const int ntiles = MT * NTn;
  const int nlb = gridDim.x >> 3, xcd = blockIdx.x & 7, lb = blockIdx.x >> 3;
  for (int it = 0;; ++it) {
    const int g = (it * 8 + xcd) * nlb + lb;
    if (g >= ntiles) break;
    const int SM = nlb >> 3;
    const int band = g / (SM * NTn); const int rem = g - band * SM * NTn;
    const int nt = rem / SM, mt = band * SM + (rem - nt * SM);
    int seqbase = 0, L = 0, tin0 = 0;
    if (EPI == EPI_FFN) {
      if (mt < 48) { const int sq = mt / 3; L = 256; seqbase = sq * 256; tin0 = (mt - sq * 3) * 126; }
      else { const int m2 = mt - 48; const int sq = m2 / 33; L = 4096; seqbase = NP_ + sq * 4096; tin0 = (m2 - sq * 33) * 126; }
    }
    const int row0 = tid >> 3, kc0 = (tid & 7) * 8;
    const long arow0 = (EPI == EPI_FFN) ? (long)seqbase + tin0 - 1 + row0 : (long)mt * 128 + row0;
    const u16* abase = A + arow0 * lda + kc0;
    unsigned avalid = 0;
#pragma unroll
    for (int i = 0; i < 4; ++i) {
      if (EPI == EPI_FFN) { const int ts = tin0 - 1 + row0 + 32 * i; if (ts >= 0 && ts < L) avalid |= 1u << i; }
      else avalid |= 1u << i;
    }
    const u16* bbase = B + (size_t)((EPI == EPI_FFN) ? nt * 64 + row0 : nt * 128 + row0) * ldb + kc0;
#define BOFFR(i) ((EPI == EPI_FFN) ? ((i) < 2 ? 32 * (i) : 2752 + 32 * (i)) : 32 * (i))
    f32x16 acc[2][2];
#pragma unroll
    for (int a = 0; a < 2; ++a)
#pragma unroll
      for (int b = 0; b < 2; ++b) zero16(acc[a][b]);
#define GLD_A(i, ko) ldsel(abase + (size_t)(32 * (i)) * lda + (ko), A, (avalid >> (i)) & 1u)
#define GLD_B(i, ko) (*(const uint4*)(bbase + (size_t)BOFFR(i) * ldb + (ko)))
    uint4 ra0 = GLD_A(0, 0), ra1 = GLD_A(1, 0), ra2 = GLD_A(2, 0), ra3 = GLD_A(3, 0);
    uint4 rb0 = GLD_B(0, 0), rb1 = GLD_B(1, 0), rb2 = GLD_B(2, 0), rb3 = GLD_B(3, 0);
    uint4 sa0 = GLD_A(0, 64), sa1 = GLD_A(1, 64), sa2 = GLD_A(2, 64), sa3 = GLD_A(3, 64);
    uint4 sb0 = GLD_B(0, 64), sb1 = GLD_B(1, 64), sb2 = GLD_B(2, 64), sb3 = GLD_B(3, 64);
#define LSTORE(buf, A0, A1, A2, A3, B0, B1, B2, B3) { \
      u16* ad = As + (buf) * 18432 + row0 * 72 + kc0; u16* bd = ad + 9216; \
      *(uint4*)(ad) = A0; *(uint4*)(ad + 32 * 72) = A1; *(uint4*)(ad + 64 * 72) = A2; *(uint4*)(ad + 96 * 72) = A3; \
      *(uint4*)(bd) = B0; *(uint4*)(bd + 32 * 72) = B1; *(uint4*)(bd + 64 * 72) = B2; *(uint4*)(bd + 96 * 72) = B3; }
#define COMPUTE(buf) { \
      const u16* Ab = As + (buf) * 18432; const u16* Bb = Ab + 9216; \
      _Pragma("unroll") for (int ks = 0; ks < 4; ++ks) { \
        const bf16x8 a0 = *(const bf16x8*)(Ab + (wm * 64 + r) * 72 + ks * 16 + h * 8); \
        const bf16x8 a1 = *(const bf16x8*)(Ab + (wm * 64 + 32 + r) * 72 + ks * 16 + h * 8); \
        const bf16x8 b0 = *(const bf16x8*)(Bb + (wn * 64 + r) * 72 + ks * 16 + h * 8); \
        const bf16x8 b1 = *(const bf16x8*)(Bb + (wn * 64 + 32 + r) * 72 + ks * 16 + h * 8); \
        acc[0][0] = MFMA(a0, b0, acc[0][0]); acc[0][1] = MFMA(a0, b1, acc[0][1]); \
        acc[1][0] = MFMA(a1, b0, acc[1][0]); acc[1][1] = MFMA(a1, b1, acc[1][1]); } }
    LSTORE(0, ra0, ra1, ra2, ra3, rb0, rb1, rb2, rb3);
    ra0 = GLD_A(0, 128); ra1 = GLD_A(1, 128); ra2 = GLD_A(2, 128); ra3 = GLD_A(3, 128);
    rb0 = GLD_B(0, 128); rb1 = GLD_B(1, 128); rb2 = GLD_B(2, 128); rb3 = GLD_B(3, 128);
    __syncthreads();
    for (int kt = 0; kt < KT; kt += 2) {
      COMPUTE(0);
      LSTORE(1, sa0, sa1, sa2, sa3, sb0, sb1, sb2, sb3);
      if (kt + 3 < KT) {
        const int ko = (kt + 3) * 64;
        sa0 = GLD_A(0, ko); sa1 = GLD_A(1, ko); sa2 = GLD_A(2, ko); sa3 = GLD_A(3, ko);
        sb0 = GLD_B(0, ko); sb1 = GLD_B(1, ko); sb2 = GLD_B(2, ko); sb3 = GLD_B(3, ko);
      }
      __syncthreads();
      COMPUTE(1);
      if (kt + 2 < KT) {
        LSTORE(0, ra0, ra1, ra2, ra3, rb0, rb1, rb2, rb3);
        if (kt + 4 < KT) {
          const int ko = (kt + 4) * 64;
          ra0 = GLD_A(0, ko); ra1 = GLD_A(1, ko); ra2 = GLD_A(2, ko); ra3 = GLD_A(3, ko);
          rb0 = GLD_B(0, ko); rb1 = GLD_B(1, ko); rb2 = GLD_B(2, ko); rb3 = GLD_B(3, ko);
        }
      }
      __syncthreads();
    }
    if (EPI == EPI_PROJ) {
      const int N = even ? EVN : ODN;
#pragma unroll
      for (int tm = 0; tm < 2; ++tm)
#pragma unroll
        for (int tn = 0; tn < 2; ++tn) {
          const int col = nt * 128 + wn * 64 + tn * 32 + r;
          if (col < N) {
#pragma unroll
            for (int i = 0; i < 16; ++i) {
              const int row = mt * 128 + wm * 64 + tm * 32 + crow(i, h);
              const float v = acc[tm][tn][i];
              p.proj[(size_t)row * N + col] = f2bf(v);
              if (row < NP_) {
                const int b = row >> 8, t = row & 255, d = col & 63;
                if (even) {
                  if (col >= 512 && col < 1536) {
                    const int wh = (col - 512) >> 9, hh = ((col - 512) >> 6) & 7;
                    p.out[(wh ? OFF_AV : OFF_AK) + ((size_t)(((b * 2 + jj) * 8 + hh) * 256 + t)) * 64 + d] = v;
                  }
                } else {
                  if (col >= 512 && col < 768) {
                    const int wh = (col - 512) >> 7, kv = ((col - 512) >> 6) & 1;
                    p.out[(wh ? OFF_CV : OFF_CK) + ((size_t)(((b * 2 + jj) * 2 + kv) * 256 + t)) * 64 + d] = v;
                  }
                }
              }
            }
          }
        }
    } else if (EPI == EPI_RES) {
#pragma unroll
      for (int tm = 0; tm < 2; ++tm)
#pragma unroll
        for (int tn = 0; tn < 2; ++tn) {
          const int col = nt * 128 + wn * 64 + tn * 32 + r;
#pragma unroll
          for (int i = 0; i < 16; ++i) {
            const int row = mt * 128 + wm * 64 + tm * 32 + crow(i, h);
            const int ci = row < NP_ ? 8 : (row - NP_) >> 12;
            const float g = p.mods[(size_t)(l * 9 + ci) * 6144 + gsel * 1024 + col];
            float* xp = p.out + (size_t)row * 1024 + col;
            *xp = *xp + g * acc[tm][tn][i];
          }
        }
    } else {
      __syncthreads();
      float* U = (float*)smem;
#pragma unroll
      for (int tm = 0; tm < 2; ++tm)
#pragma unroll
        for (int tn = 0; tn < 2; ++tn)
#pragma unroll
          for (int i = 0; i < 16; ++i) U[(wm * 64 + tm * 32 + crow(i, h)) * 132 + wn * 64 + tn * 32 + r] = acc[tm][tn][i];
      __syncthreads();
      const float* cw = p.ffn_conv + (size_t)l * 3 * 5632;
      const int f = tid & 63, rg = tid >> 6; const int fg = nt * 64 + f;
      const float wa0 = cw[fg], wa1 = cw[5632 + fg], wa2 = cw[2 * 5632 + fg];
      const float wg0 = cw[2816 + fg], wg1 = cw[5632 + 2816 + fg], wg2 = cw[2 * 5632 + 2816 + fg];
      u16* act = p.proj;
      for (int rr = 1 + rg; rr <= 126; rr += 4) {
        const int ts = tin0 - 1 + rr;
        if (ts >= L) break;
        const float a = wa0 * U[(rr - 1) * 132 + f] + wa1 * U[rr * 132 + f] + wa2 * U[(rr + 1) * 132 + f];
        const float g = wg0 * U[(rr - 1) * 132 + 64 + f] + wg1 * U[rr * 132 + 64 + f] + wg2 * U[(rr + 1) * 132 + 64 + f];
        act[(size_t)(seqbase + ts) * 2816 + fg] = f2bf(a * siluf(g));
      }
      __syncthreads();
    }
  }
}

template <int MODE>
DI void attn_item(const P* __restrict__ gp, int jj, int it, char* smem) {
  const P& p = *gp;
  u16* Ks = (u16*)smem; u16* Vt = Ks + 64 * 72; float* rpb_s = (float*)(Vt + 64 * 72);
  int tid_ = threadIdx.x; asm volatile("" : "+v"(tid_)); const int tid = tid_, lane = tid & 63, wave = tid >> 6, r = lane & 31, h = lane >> 5;
  constexpr bool EVENL = (MODE == 0 || MODE == 1);
  constexpr bool LAT = (MODE == 1 || MODE == 3);
  constexpr int PS = EVENL ? EVN : ODN;
  int b, hq, qb, tokbase;
  if (!LAT) { b = it >> 4; hq = (it >> 1) & 7; qb = it & 1; tokbase = b * 256; }
  else { b = it >> 8; hq = (it >> 5) & 7; qb = it & 31; tokbase = NP_ + b * 4096; }
  const int hk = EVENL ? hq : (hq >> 2);
  const int kcol = 512 + hk * 64, vcol = (EVENL ? 1024 : 640) + hk * 64, qcol = hq * 64;
  const int tq = qb * 128 + wave * 32 + r;
  const size_t qtok = (size_t)tokbase + tq;
  __syncthreads();
  if (MODE == 1) { for (int i = tid; i < 465; i += 256) rpb_s[i] = p.a_rpb[(size_t)(jj * 8 + hq) * 465 + i]; }
  bf16x8 qf[4];
#pragma unroll
  for (int s = 0; s < 4; ++s) qf[s] = *(const bf16x8*)(p.proj + qtok * PS + qcol + 16 * s + 8 * h);
  if (MODE == 3) {
    const int prow = tq >> 6, pcol = tq & 63;
#pragma unroll
    for (int half = 0; half < 2; ++half) {
      const int pos = half ? pcol : prow;
#pragma unroll
      for (int j = 0; j < 8; ++j) {
        const float cs = p.rope[(pos * 16 + 8 * h + j) * 2], sn = p.rope[(pos * 16 + 8 * h + j) * 2 + 1];
        const float x1 = bf2f((u16)qf[2 * half][j]), x2 = bf2f((u16)qf[2 * half + 1][j]);
        qf[2 * half][j] = (short)f2bf(x1 * cs - x2 * sn);
        qf[2 * half + 1][j] = (short)f2bf(x1 * sn + x2 * cs);
      }
    }
  }
  float m_run = -1e30f, l_run = 0.f;
  if (MODE == 2 || MODE == 3) { m_run = p.c_sink[jj * 8 + hq]; l_run = h == 0 ? 1.f : 0.f; }
  f32x16 ot[2]; zero16(ot[0]); zero16(ot[1]);
  int loc0 = 0, nloc = 0;
  if (MODE == 1) {
    const int qi0 = 2 * qb;
    const int rlo = min(max(qi0 - 4, 0), 56), rhi = min(max(qi0 + 1 - 4, 0), 56) + 7;
    loc0 = rlo; nloc = rhi - rlo + 1;
  } else if (MODE == 3) {
    loc0 = max(0, 2 * qb - 2); nloc = min(63, 2 * qb + 3) - loc0 + 1;
  }
  const int qi = tq >> 6, qw = tq & 63;
  const int r0w = min(max(qi - 4, 0), 56), c0w = min(max(qw - 8, 0), 48);
  const int key = tid >> 2, seg = tid & 3;
  for (int kb = 0; kb < 4 + nloc; ++kb) {
    const bool isctx = kb < 4;
    const int blk = isctx ? kb : loc0 + kb - 4;
    __syncthreads();
    {
      float kf[16], vf[16];
      if (LAT && isctx) {
        const float* kc = (MODE == 1) ? p.cache_a_k + ((size_t)((b * 2 + jj) * 8 + hk)) * 16384 : p.cache_c_k + ((size_t)((b * 2 + jj) * 2 + hk)) * 16384;
        const float* vc = (MODE == 1) ? p.cache_a_v + ((size_t)((b * 2 + jj) * 8 + hk)) * 16384 : p.cache_c_v + ((size_t)((b * 2 + jj) * 2 + hk)) * 16384;
        const float4* kp4 = (const float4*)(kc + (size_t)(blk * 64 + key) * 64 + seg * 16);
        const float4* vp4 = (const float4*)(vc + (size_t)(blk * 64 + key) * 64 + seg * 16);
#pragma unroll
        for (int e = 0; e < 4; ++e) {
          const float4 a = kp4[e], c = vp4[e];
          kf[4 * e] = a.x; kf[4 * e + 1] = a.y; kf[4 * e + 2] = a.z; kf[4 * e + 3] = a.w;
          vf[4 * e] = c.x; vf[4 * e + 1] = c.y; vf[4 * e + 2] = c.z; vf[4 * e + 3] = c.w;
        }
      } else {
        const u16* rowp = p.proj + ((size_t)tokbase + blk * 64 + key) * PS;
        const bf16x8 k0 = *(const bf16x8*)(rowp + kcol + seg * 16), k1 = *(const bf16x8*)(rowp + kcol + seg * 16 + 8);
        const bf16x8 v0 = *(const bf16x8*)(rowp + vcol + seg * 16), v1 = *(const bf16x8*)(rowp + vcol + seg * 16 + 8);
#pragma unroll
        for (int e = 0; e < 8; ++e) { kf[e] = bf2f((u16)k0[e]); kf[8 + e] = bf2f((u16)k1[e]); vf[e] = bf2f((u16)v0[e]); vf[8 + e] = bf2f((u16)v1[e]); }
        if (MODE == 3) {
          const bf16x8 p0 = *(const bf16x8*)(rowp + kcol + (seg ^ 1) * 16), p1 = *(const bf16x8*)(rowp + kcol + (seg ^ 1) * 16 + 8);
          const int pos = (seg & 2) ? key : blk;
#pragma unroll
          for (int e = 0; e < 16; ++e) {
            const float pr = bf2f((u16)(e < 8 ? p0[e & 7] : p1[e & 7]));
            const float cs = p.rope[(pos * 16 + e) * 2], sn = p.rope[(pos * 16 + e) * 2 + 1];
            kf[e] = (seg & 1) ? (pr * sn + kf[e] * cs) : (kf[e] * cs - pr * sn);
          }
        }
      }
      bf16x8 o0, o1;
#pragma unroll
      for (int e = 0; e < 8; ++e) { o0[e] = (short)f2bf(kf[e]); o1[e] = (short)f2bf(kf[8 + e]); }
      *(bf16x8*)(Ks + key * 72 + seg * 16) = o0;
      *(bf16x8*)(Ks + key * 72 + seg * 16 + 8) = o1;
#pragma unroll
      for (int e = 0; e < 16; ++e) Vt[(seg * 16 + e) * 72 + key] = f2bf(vf[e]);
    }
    __syncthreads();
    bool active = true;
    if (MODE == 1 && !isctx) active = (blk >= r0w && blk < r0w + 8);
    if (active) {
      f32x16 st[2]; zero16(st[0]); zero16(st[1]);
#pragma unroll
      for (int kt = 0; kt < 2; ++kt)
#pragma unroll
        for (int s = 0; s < 4; ++s) {
          const bf16x8 a = *(const bf16x8*)(Ks + (kt * 32 + r) * 72 + 16 * s + 8 * h);
          st[kt] = MFMA(a, qf[s], st[kt]);
        }
      float mx = m_run;
#pragma unroll
      for (int kt = 0; kt < 2; ++kt)
#pragma unroll
        for (int i = 0; i < 16; ++i) {
          float s = st[kt][i] * 0.125f;
          const int kk = kt * 32 + crow(i, h);
          if (MODE == 1 && !isctx) {
            const bool ok = (kk >= c0w && kk < c0w + 16);
            s = ok ? s + rpb_s[(blk - qi + 7) * 31 + (kk - qw + 15)] : -1e30f;
          }
          if (MODE == 3 && !isctx) {
            const int dlt = blk * 64 + kk - tq;
            s = (dlt <= 128 && dlt >= -128) ? s : -1e30f;
          }
          st[kt][i] = s;
          mx = fmaxf(mx, s);
        }
      mx = fmaxf(mx, __shfl_xor(mx, 32));
      const float alpha = __expf(m_run - mx);
      m_run = mx;
      float ps = 0.f;
#pragma unroll
      for (int kt = 0; kt < 2; ++kt)
#pragma unroll
        for (int i = 0; i < 16; ++i) { const float pv = __expf(st[kt][i] - mx); st[kt][i] = pv; ps += pv; }
      l_run = l_run * alpha + ps;
#pragma unroll
      for (int dt = 0; dt < 2; ++dt)
#pragma unroll
        for (int i = 0; i < 16; ++i) ot[dt][i] *= alpha;
#pragma unroll
      for (int kt = 0; kt < 2; ++kt) {
        const bf16x8 pb0 = packs<0>(st[kt]), pb1 = packs<1>(st[kt]);
#pragma unroll
        for (int dt = 0; dt < 2; ++dt) {
          const bf16x8 pa0 = ld2x4(Vt + (dt * 32 + r) * 72 + kt * 32 + 4 * h);
          const bf16x8 pa1 = ld2x4(Vt + (dt * 32 + r) * 72 + kt * 32 + 16 + 4 * h);
          ot[dt] = MFMA(pa0, pb0, ot[dt]);
          ot[dt] = MFMA(pa1, pb1, ot[dt]);
        }
      }
    }
  }
  l_run += __shfl_xor(l_run, 32);
  const float inv = 1.f / l_run;
  u16* dst = p.hn + qtok * 1024 + qcol;
#pragma unroll
  for (int dt = 0; dt < 2; ++dt)
#pragma unroll
    for (int g4 = 0; g4 < 4; ++g4) {
      ushort4 o;
      o.x = f2bf(ot[dt][4 * g4] * inv); o.y = f2bf(ot[dt][4 * g4 + 1] * inv); o.z = f2bf(ot[dt][4 * g4 + 2] * inv); o.w = f2bf(ot[dt][4 * g4 + 3] * inv);
      *(ushort4*)(dst + dt * 32 + 8 * g4 + 4 * h) = o;
    }
}

struct ChainId { int lat, b, h, dir, T, base, nch; };
DI ChainId chain_decode(int it) {
  ChainId c; c.lat = it < 128; const int q = c.lat ? it : it - 128;
  c.b = q >> 4; c.h = (q >> 1) & 7; c.dir = q & 1; c.T = c.lat ? 4096 : 256; c.base = c.lat ? NP_ + c.b * 4096 : c.b * 256; c.nch = c.T >> 6;
  return c;
}
DI int tokof(const ChainId& c, int step, int row) { const int pp = step * 64 + row; return c.base + (c.dir ? c.T - 1 - pp : pp); }

DI void gla_chain(const P* __restrict__ gp, int jj, int it, char* smem) {
  const P& p = *gp;
  const ChainId cid = chain_decode(it);
  int tid_ = threadIdx.x; asm volatile("" : "+v"(tid_)); const int tid = tid_, lane = tid & 63, wave = tid >> 6, r = lane & 31, h = lane >> 5;
  const int hh = cid.h, dir = cid.dir;
  u16* QT = (u16*)smem; u16* KT = QT + 4608; u16* KEt = KT + 4608; u16* Vt = KEt + 4608;
  float* GL = (float*)(Vt + 4608); float* gq = GL + 1024; float* dec = gq + 256; float* Ost = dec + 64;
  const int d = tid & 63, cq = tid >> 6;
  float wg[16];
#pragma unroll
  for (int rr = 0; rr < 16; ++rr) wg[rr] = p.b_w_g2[((size_t)((jj * 2 + dir) * 16 + rr)) * 512 + hh * 64 + d];
  const float bg = p.b_b_g[(jj * 2 + dir) * 512 + hh * 64 + d];
  const int vh = wave & 1;
  f32x16 S[2]; zero16(S[0]); zero16(S[1]);
  const size_t sidx = ((size_t)(((cid.b * 2 + jj) * 2 + dir) * 8 + hh)) * 4096;
  if (wave < 2 && cid.lat) {
#pragma unroll
    for (int dt = 0; dt < 2; ++dt)
#pragma unroll
      for (int i = 0; i < 16; ++i) S[dt][i] = p.state_b[sidx + (dt * 32 + crow(i, h)) * 64 + vh * 32 + r];
  }
  for (int step_ = 0; step_ < cid.nch; ++step_) {
    int step = step_;
    asm volatile("" : "+v"(step));
    __syncthreads();
    {
      const int c = tid >> 2, sg = tid & 3;
      const int tok = tokof(cid, step, c);
      const ushort4 gv = *(const ushort4*)(p.proj + (size_t)tok * EVN + 3072 + dir * 16 + sg * 4);
      GL[c * 16 + sg * 4] = bf2f(gv.x); GL[c * 16 + sg * 4 + 1] = bf2f(gv.y); GL[c * 16 + sg * 4 + 2] = bf2f(gv.z); GL[c * 16 + sg * 4 + 3] = bf2f(gv.w);
    }
    __syncthreads();
    float Gl[16]; float run = 0.f;
#pragma unroll
    for (int i = 0; i < 16; ++i) {
      const int c = cq * 16 + i;
      float z = bg;
#pragma unroll
      for (int rr = 0; rr < 16; ++rr) z += GL[c * 16 + rr] * wg[rr];
      const float g = (fminf(z, 0.f) - __logf(1.f + __expf(-fabsf(z)))) * (1.f / 16.f);
      run += g; Gl[i] = run;
    }
    gq[cq * 64 + d] = run;
    __syncthreads();
    float off = 0.f, tot = 0.f;
#pragma unroll
    for (int q2 = 0; q2 < 4; ++q2) { const float t = gq[q2 * 64 + d]; if (q2 < cq) off += t; tot += t; }
#pragma unroll
    for (int i = 0; i < 16; ++i) {
      const int c = cq * 16 + i;
      const int tok = tokof(cid, step, c);
      const float G = Gl[i] + off;
      const u16* rowp = p.proj + (size_t)tok * EVN + hh * 64 + d;
      const float qv = bf2f(rowp[1536]), kv = bf2f(rowp[2048]);
      const u16 vb = rowp[2560];
      QT[c * 72 + d] = f2bf(qv * 0.125f * __expf(G));
      KT[c * 72 + d] = f2bf(kv * __expf(-G));
      KEt[d * 72 + c] = f2bf(kv * __expf(tot - G));
      Vt[d * 72 + c] = vb;
    }
    if (cq == 0) dec[d] = __expf(tot);
    __syncthreads();
    if (wave < 2) {
      f32x16 at[2][2];
#pragma unroll
      for (int a = 0; a < 2; ++a)
#pragma unroll
        for (int b2 = 0; b2 < 2; ++b2) zero16(at[a][b2]);
#pragma unroll
      for (int ks = 0; ks < 4; ++ks) {
        const bf16x8 a0 = *(const bf16x8*)(KT + r * 72 + ks * 16 + 8 * h), a1 = *(const bf16x8*)(KT + (32 + r) * 72 + ks * 16 + 8 * h);
        const bf16x8 b0 = *(const bf16x8*)(QT + r * 72 + ks * 16 + 8 * h), b1 = *(const bf16x8*)(QT + (32 + r) * 72 + ks * 16 + 8 * h);
        at[0][0] = MFMA(a0, b0, at[0][0]); at[0][1] = MFMA(a0, b1, at[0][1]);
        at[1][0] = MFMA(a1, b0, at[1][0]); at[1][1] = MFMA(a1, b1, at[1][1]);
      }
#pragma unroll
      for (int st = 0; st < 2; ++st)
#pragma unroll
        for (int ct = 0; ct < 2; ++ct)
#pragma unroll
          for (int i = 0; i < 16; ++i) { if (st * 32 + crow(i, h) > ct * 32 + r) at[st][ct][i] = 0.f; }
      f32x16 o[2]; zero16(o[0]); zero16(o[1]);
#pragma unroll
      for (int ct = 0; ct < 2; ++ct)
#pragma unroll
        for (int st = 0; st < 2; ++st) {
          const bf16x8 x0 = packs<0>(at[st][ct]), x1 = packs<1>(at[st][ct]);
          const bf16x8 pb0 = ld2x4(Vt + (vh * 32 + r) * 72 + st * 32 + 4 * h);
          const bf16x8 pb1 = ld2x4(Vt + (vh * 32 + r) * 72 + st * 32 + 16 + 4 * h);
          o[ct] = MFMA(x0, pb0, o[ct]);
          o[ct] = MFMA(x1, pb1, o[ct]);
        }
#pragma unroll
      for (int dt = 0; dt < 2; ++dt) {
        const bf16x8 xs0 = packs<0>(S[dt]), xs1 = packs<1>(S[dt]);
#pragma unroll
        for (int ct = 0; ct < 2; ++ct) {
          const bf16x8 pa0 = ld2x4(QT + (ct * 32 + r) * 72 + dt * 32 + 4 * h);
          const bf16x8 pa1 = ld2x4(QT + (ct * 32 + r) * 72 + dt * 32 + 16 + 4 * h);
          o[ct] = MFMA(pa0, xs0, o[ct]);
          o[ct] = MFMA(pa1, xs1, o[ct]);
        }
      }
#pragma unroll
      for (int dt = 0; dt < 2; ++dt)
#pragma unroll
        for (int i = 0; i < 16; ++i) S[dt][i] *= dec[dt * 32 + crow(i, h)];
#pragma unroll
      for (int ks = 0; ks < 4; ++ks) {
        const bf16x8 bv = *(const bf16x8*)(Vt + (vh * 32 + r) * 72 + ks * 16 + 8 * h);
#pragma unroll
        for (int dt = 0; dt < 2; ++dt) {
          const bf16x8 a = *(const bf16x8*)(KEt + (dt * 32 + r) * 72 + ks * 16 + 8 * h);
          S[dt] = MFMA(a, bv, S[dt]);
        }
      }
#pragma unroll
      for (int ct = 0; ct < 2; ++ct)
#pragma unroll
        for (int i = 0; i < 16; ++i) Ost[(ct * 32 + crow(i, h)) * 68 + vh * 32 + r] = o[ct][i];
    }
    __syncthreads();
    {
      const int c = tid >> 2, sg = tid & 3;
      const int tok = tokof(cid, step, c);
      u16* dst = (dir ? p.ot1 + (size_t)tok * 512 + hh * 64 : p.hn + (size_t)tok * 1024 + 512 + hh * 64) + sg * 16;
      bf16x8 w0, w1;
#pragma unroll
      for (int e = 0; e < 8; ++e) { w0[e] = (short)f2bf(Ost[c * 68 + sg * 16 + e]); w1[e] = (short)f2bf(Ost[c * 68 + sg * 16 + 8 + e]); }
      *(bf16x8*)dst = w0; *(bf16x8*)(dst + 8) = w1;
    }
  }
  if (wave < 2 && !cid.lat) {
#pragma unroll
    for (int dt = 0; dt < 2; ++dt)
#pragma unroll
      for (int i = 0; i < 16; ++i) p.out[OFF_SB + sidx + (dt * 32 + crow(i, h)) * 64 + vh * 32 + r] = S[dt][i];
  }
}

DI void delta_chain(const P* __restrict__ gp, int jj, int it, char* smem) {
  const P& p = *gp;
  const ChainId cid = chain_decode(it);
  int tid_ = threadIdx.x; asm volatile("" : "+v"(tid_)); const int tid0 = tid_;
  const int hh = cid.h, dir = cid.dir;
  u16* Qn = (u16*)smem; u16* Kn = Qn + 4608; u16* Kt = Kn + 4608; u16* AQK = Kt + 4608; u16* KC = AQK + 4608;
  float* At = (float*)(KC + 4608); float* Wv = At + 64 * 68; float* Gs = Wv + 64 * 65; float* Bt = Gs + 64;
  const float aexp = __expf(p.d_a_log[(jj * 2 + dir) * 8 + hh]);
  const float dtb = p.d_dt_bias[(jj * 2 + dir) * 8 + hh];
  f32x16 S[2]; zero16(S[0]); zero16(S[1]);
  const size_t sidx = ((size_t)(((cid.b * 2 + jj) * 2 + dir) * 8 + hh)) * 4096;
  { const int tid = tid0, lane = tid & 63, wave = tid >> 6, r = lane & 31, h = lane >> 5;
  if (wave < 2 && cid.lat) {
    const int vh = wave & 1;
#pragma unroll
    for (int dt = 0; dt < 2; ++dt)
#pragma unroll
      for (int i = 0; i < 16; ++i) S[dt][i] = p.state_d[sidx + (dt * 32 + crow(i, h)) * 64 + vh * 32 + r];
  }
  }
  u16* CW = (u16*)(smem + 80640);
  __syncthreads();
  for (int i = tid0; i < 576; i += 256) { const int tap = i / 192, c2 = i - tap * 192; const int wh = c2 >> 6, dd = c2 & 63;
    CW[i] = f2bf(p.d_conv[(size_t)jj * 3 * 1536 + tap * 1536 + wh * 512 + hh * 64 + dd]); }
  for (int step_ = 0; step_ < cid.nch; ++step_) {
    int step = step_;
    asm volatile("" : "+v"(step));
    __syncthreads();
    {const int tid = opq(tid0), lane = tid & 63, wave = __builtin_amdgcn_readfirstlane(tid >> 6), r = lane & 31, h = lane >> 5, vh = wave & 1; (void)r; (void)h; (void)vh; (void)lane;
    if (wave == 0) {
      const int tok = tokof(cid, step, lane);
      const float da = bf2f(p.proj[(size_t)tok * ODN + 2304 + dir * 8 + hh]);
      const float db = bf2f(p.proj[(size_t)tok * ODN + 2320 + dir * 8 + hh]);
      const float x = da + dtb;
      const float sp = x > 20.f ? x : log1pf(__expf(x));
      float G = -aexp * sp;
#pragma unroll
      for (int o = 1; o < 64; o <<= 1) { const float t = __shfl_up(G, o); if (lane >= o) G += t; }
      Gs[lane] = G; Bt[lane] = 1.f / (1.f + __expf(-db));
    }
    {
      const int c = tid >> 2, sg = tid & 3;
      const int tok = tokof(cid, step, c);
      const int pos = tok - cid.base;
      const bool hp = pos > 0, hn_ = pos < cid.T - 1;
#pragma unroll 1
      for (int wh = 0; wh < 3; ++wh) {
        const int ch0 = wh * 512 + hh * 64 + sg * 16;
        const u16* cur = p.proj + (size_t)tok * ODN + 768 + ch0;
        float y[16];
        float ss = 0.f;
#pragma unroll
        for (int hf = 0; hf < 2; ++hf) {
          const bf16x8 xc = *(const bf16x8*)(cur + hf * 8);
          bf16x8 xp, xn;
#pragma unroll
          for (int e = 0; e < 8; ++e) { xp[e] = 0; xn[e] = 0; }
          if (hp) xp = *(const bf16x8*)(cur - ODN + hf * 8);
          if (hn_) xn = *(const bf16x8*)(cur + ODN + hf * 8);
#pragma unroll
          for (int e = 0; e < 8; ++e) {
            const int ch = wh * 64 + sg * 16 + hf * 8 + e;
            float v = bf2f(CW[ch]) * bf2f((u16)xp[e]) + bf2f(CW[192 + ch]) * bf2f((u16)xc[e]) + bf2f(CW[384 + ch]) * bf2f((u16)xn[e]);
            v = v / (1.f + __expf(-v));
            y[hf * 8 + e] = v; ss += v * v;
          }
        }
        ss += __shfl_xor(ss, 1); ss += __shfl_xor(ss, 2);
        const float rn = rsqrtf(ss + 1e-6f);
        if (wh == 0) {
#pragma unroll
          for (int e = 0; e < 16; ++e) Qn[c * 72 + sg * 16 + e] = f2bf(y[e] * rn * 0.125f);
        } else if (wh == 1) {
#pragma unroll
          for (int e = 0; e < 16; ++e) { const u16 kb = f2bf(y[e] * rn); Kn[c * 72 + sg * 16 + e] = kb; Kt[(sg * 16 + e) * 72 + c] = kb; }
        } else {
#pragma unroll
          for (int e = 0; e < 16; ++e) Wv[c * 65 + sg * 16 + e] = y[e];
        }
      }
    }
    }
    __syncthreads();
    {const int tid = opq(tid0), lane = tid & 63, wave = __builtin_amdgcn_readfirstlane(tid >> 6), r = lane & 31, h = lane >> 5, vh = wave & 1; (void)r; (void)h; (void)vh; (void)lane;
    if (wave < 2) {
      f32x16 akk[2], aqk[2]; zero16(akk[0]); zero16(akk[1]); zero16(aqk[0]); zero16(aqk[1]);
#pragma unroll
      for (int ks = 0; ks < 4; ++ks) {
        const bf16x8 bk = *(const bf16x8*)(Kn + (vh * 32 + r) * 72 + ks * 16 + 8 * h);
#pragma unroll
        for (int ct = 0; ct < 2; ++ct) {
          const bf16x8 ak = *(const bf16x8*)(Kn + (ct * 32 + r) * 72 + ks * 16 + 8 * h);
          const bf16x8 aq = *(const bf16x8*)(Qn + (ct * 32 + r) * 72 + ks * 16 + 8 * h);
          akk[ct] = MFMA(ak, bk, akk[ct]);
          aqk[ct] = MFMA(aq, bk, aqk[ct]);
        }
      }
      const int s = vh * 32 + r;
      const float Gss = Gs[s];
      float4 gv[2][4], bv[2][4];
#pragma unroll
      for (int ct = 0; ct < 2; ++ct)
#pragma unroll
        for (int g4 = 0; g4 < 4; ++g4) { gv[ct][g4] = *(const float4*)(Gs + ct * 32 + 8 * g4 + 4 * h); bv[ct][g4] = *(const float4*)(Bt + ct * 32 + 8 * g4 + 4 * h); }
#pragma unroll
      for (int ct = 0; ct < 2; ++ct)
#pragma unroll
        for (int g4 = 0; g4 < 4; ++g4) {
          const int c0 = ct * 32 + 8 * g4 + 4 * h;
          float4 val;
#pragma unroll
          for (int e = 0; e < 4; ++e) {
            const int c = c0 + e;
            const float Gc = e == 0 ? gv[ct][g4].x : e == 1 ? gv[ct][g4].y : e == 2 ? gv[ct][g4].z : gv[ct][g4].w;
            const float Bc = e == 0 ? bv[ct][g4].x : e == 1 ? bv[ct][g4].y : e == 2 ? bv[ct][g4].z : bv[ct][g4].w;
            const float gam = __expf(fminf(Gc - Gss, 0.f));
            const float av = (s < c) ? akk[ct][4 * g4 + e] * Bc * gam : 0.f;
            if (e == 0) val.x = av; else if (e == 1) val.y = av; else if (e == 2) val.z = av; else val.w = av;
            AQK[c * 72 + s] = f2bf((s <= c) ? aqk[ct][4 * g4 + e] * gam : 0.f);
          }
          *(float4*)(At + s * 68 + c0) = val;
        }
    }
    }
    __syncthreads();
    {const int tid = opq(tid0), lane = tid & 63, wave = __builtin_amdgcn_readfirstlane(tid >> 6), r = lane & 31, h = lane >> 5, vh = wave & 1; (void)r; (void)h; (void)vh; (void)lane;
    if (wave < 2) {
      const bool isv = wave == 0;
      const int col = lane;
#pragma unroll 1
      for (int bi = 0; bi < 4; ++bi) {
        float acc[16];
#pragma unroll
        for (int ci = 0; ci < 16; ++ci) {
          const int c = 16 * bi + ci;
          acc[ci] = isv ? Wv[c * 65 + col] * Bt[c] : bf2f(Kn[c * 72 + col]) * Bt[c] * __expf(Gs[c]);
        }
#pragma unroll 8
        for (int s2 = 0; s2 < 16 * bi; ++s2) {
          const float xs = isv ? Wv[s2 * 65 + col] : bf2f(KC[s2 * 72 + col]);
          const float4* a4 = (const float4*)(At + s2 * 68 + 16 * bi);
#pragma unroll
          for (int q = 0; q < 4; ++q) {
            const float4 a = a4[q];
            acc[4 * q] -= a.x * xs; acc[4 * q + 1] -= a.y * xs; acc[4 * q + 2] -= a.z * xs; acc[4 * q + 3] -= a.w * xs;
          }
        }
#pragma unroll
        for (int ci = 0; ci < 16; ++ci) {
          const float x = acc[ci];
          const float* arow = At + (16 * bi + ci) * 68 + 16 * bi;
#pragma unroll
          for (int cj = ci + 1; cj < 16; ++cj) acc[cj] -= arow[cj] * x;
          if (isv) Wv[(16 * bi + ci) * 65 + col] = x; else KC[(16 * bi + ci) * 72 + col] = f2bf(x);
        }
      }
    }
    }
    __syncthreads();
    {const int tid = opq(tid0), lane = tid & 63, wave = __builtin_amdgcn_readfirstlane(tid >> 6), r = lane & 31, h = lane >> 5, vh = wave & 1; (void)r; (void)h; (void)vh; (void)lane;
    if (wave < 2) {
      f32x16 kS[2], qS[2]; zero16(kS[0]); zero16(kS[1]); zero16(qS[0]); zero16(qS[1]);
#pragma unroll
      for (int dt = 0; dt < 2; ++dt) {
        const bf16x8 xs0 = packs<0>(S[dt]), xs1 = packs<1>(S[dt]);
#pragma unroll
        for (int ct = 0; ct < 2; ++ct) {
          kS[ct] = MFMA(ld2x4(KC + (ct * 32 + r) * 72 + dt * 32 + 4 * h), xs0, kS[ct]);
          kS[ct] = MFMA(ld2x4(KC + (ct * 32 + r) * 72 + dt * 32 + 16 + 4 * h), xs1, kS[ct]);
          qS[ct] = MFMA(ld2x4(Qn + (ct * 32 + r) * 72 + dt * 32 + 4 * h), xs0, qS[ct]);
          qS[ct] = MFMA(ld2x4(Qn + (ct * 32 + r) * 72 + dt * 32 + 16 + 4 * h), xs1, qS[ct]);
        }
      }
      f32x16 vn[2], o[2];
      const float Glast = Gs[63];
#pragma unroll
      for (int ct = 0; ct < 2; ++ct)
#pragma unroll
        for (int i = 0; i < 16; ++i) {
          const int c = ct * 32 + crow(i, h);
          vn[ct][i] = Wv[c * 65 + vh * 32 + r] - kS[ct][i];
          o[ct][i] = qS[ct][i] * __expf(Gs[c]);
        }
#pragma unroll
      for (int st = 0; st < 2; ++st) {
        const bf16x8 xs0 = packs<0>(vn[st]), xs1 = packs<1>(vn[st]);
#pragma unroll
        for (int ct = 0; ct < 2; ++ct) {
          o[ct] = MFMA(ld2x4(AQK + (ct * 32 + r) * 72 + st * 32 + 4 * h), xs0, o[ct]);
          o[ct] = MFMA(ld2x4(AQK + (ct * 32 + r) * 72 + st * 32 + 16 + 4 * h), xs1, o[ct]);
        }
      }
      const float dl = __expf(Glast);
#pragma unroll
      for (int st = 0; st < 2; ++st)
#pragma unroll
        for (int i = 0; i < 16; ++i) vn[st][i] *= __expf(Glast - Gs[st * 32 + crow(i, h)]);
#pragma unroll
      for (int dt = 0; dt < 2; ++dt)
#pragma unroll
        for (int i = 0; i < 16; ++i) S[dt][i] *= dl;
#pragma unroll
      for (int st = 0; st < 2; ++st) {
        const bf16x8 xs0 = packs<0>(vn[st]), xs1 = packs<1>(vn[st]);
#pragma unroll
        for (int dt = 0; dt < 2; ++dt) {
          S[dt] = MFMA(ld2x4(Kt + (dt * 32 + r) * 72 + st * 32 + 4 * h), xs0, S[dt]);
          S[dt] = MFMA(ld2x4(Kt + (dt * 32 + r) * 72 + st * 32 + 16 + 4 * h), xs1, S[dt]);
        }
      }
#pragma unroll
      for (int ct = 0; ct < 2; ++ct)
#pragma unroll
        for (int i = 0; i < 16; ++i) At[(ct * 32 + crow(i, h)) * 68 + vh * 32 + r] = o[ct][i];
    }
    }
    __syncthreads();
    {
      const int tid = opq(tid0);
      const int c = tid >> 2, sg = tid & 3;
      const int tok = tokof(cid, step, c);
      u16* dst = (dir ? p.ot1 + (size_t)tok * 512 + hh * 64 : p.hn + (size_t)tok * 1024 + 512 + hh * 64) + sg * 16;
      bf16x8 w0, w1;
#pragma unroll
      for (int e = 0; e < 8; ++e) { w0[e] = (short)f2bf(At[c * 68 + sg * 16 + e]); w1[e] = (short)f2bf(At[c * 68 + sg * 16 + 8 + e]); }
      *(bf16x8*)dst = w0; *(bf16x8*)(dst + 8) = w1;
    }
  }
  {const int tid = opq(tid0), lane = tid & 63, wave = __builtin_amdgcn_readfirstlane(tid >> 6), r = lane & 31, h = lane >> 5, vh = wave & 1; (void)r; (void)h; (void)vh; (void)lane;
  if (wave < 2 && !cid.lat) {
#pragma unroll
    for (int dt = 0; dt < 2; ++dt)
#pragma unroll
      for (int i = 0; i < 16; ++i) p.out[OFF_SD + sidx + (dt * 32 + crow(i, h)) * 64 + vh * 32 + r] = S[dt][i];
  }
}
}

DI void mixer_phase(const P* __restrict__ gp, int l, char* smem) {
  const P& p = *gp;
  const bool even = !(l & 1); const int jj = l >> 1;
  const int total = 384 + 2048 + 256;
  int* s_item = (int*)(smem + SMEM_BYTES - 16);
  for (;;) {
    __syncthreads();
    if (threadIdx.x == 0) *s_item = atomicAdd(p.cnt + l, 1);
    __syncthreads();
    const int item = *s_item;
    if (item >= total) break;
    if (item < 384) { if (even) gla_chain(gp, jj, item, smem); else delta_chain(gp, jj, item, smem); }
    else if (item < 384 + 2048) { if (even) attn_item<1>(gp, jj, item - 384, smem); else attn_item<3>(gp, jj, item - 384, smem); }
    else { if (even) attn_item<0>(gp, jj, item - 384 - 2048, smem); else attn_item<2>(gp, jj, item - 384 - 2048, smem); }
  }
}

DI void finalize_phase(const P* __restrict__ gp, int l) {
  const P& p = *gp;
  const bool even = !(l & 1); const int jj = l >> 1;
  int tid_ = threadIdx.x; asm volatile("" : "+v"(tid_)); const int tid = tid_;
  const int tk = tid >> 5, hh = (tid >> 2) & 7, sg = tid & 3;
  const int PS = even ? EVN : ODN; const int zcol = even ? 3104 : 2336;
  for (int item = blockIdx.x; item < NT_ / 8; item += gridDim.x) {
    const size_t tok = (size_t)item * 8 + tk;
    u16* a = p.hn + tok * 1024 + 512 + hh * 64 + sg * 16;
    const u16* bsrc = p.ot1 + tok * 512 + hh * 64 + sg * 16;
    const u16* zs = p.proj + tok * PS + zcol + hh * 64 + sg * 16;
    float o[16]; float ss = 0.f;
#pragma unroll
    for (int hf = 0; hf < 2; ++hf) {
      const bf16x8 x0 = *(const bf16x8*)(a + hf * 8), x1 = *(const bf16x8*)(bsrc + hf * 8);
#pragma unroll
      for (int e = 0; e < 8; ++e) { const float v = bf2f((u16)x0[e]) + bf2f((u16)x1[e]); o[hf * 8 + e] = v; ss += v * v; }
    }
    ss += __shfl_xor(ss, 1); ss += __shfl_xor(ss, 2);
    const float rstd = rsqrtf(ss * (1.f / 64.f) + 1e-6f);
    const float* ng = even ? p.b_norm_g + jj * 512 + hh * 64 + sg * 16 : p.d_norm_g + jj * 64 + sg * 16;
#pragma unroll
    for (int hf = 0; hf < 2; ++hf) {
      const bf16x8 z = *(const bf16x8*)(zs + hf * 8);
      bf16x8 w;
#pragma unroll
      for (int e = 0; e < 8; ++e) { const float zz = bf2f((u16)z[e]); w[e] = (short)f2bf(o[hf * 8 + e] * rstd * ng[hf * 8 + e] * siluf(zz)); }
      *(bf16x8*)(a + hf * 8) = w;
    }
  }
}

DI void run_phase(const P* __restrict__ gp, int ph, char* smem) {
  const P& p = *gp;
  if (ph == 0) { prep_phase(gp, smem); return; }
  if (ph == NPH - 1) { norm_phase(gp, 0, 0, false, true); return; }
  const int l = (ph - 1) >> 3, s = (ph - 1) & 7;
  const bool even = !(l & 1);
  const u16* W = p.wt + (size_t)l * LW;
  switch (s) {
    case 0: norm_phase(gp, l, 0, l == 0, false); break;
    case 1: gemm_phase<EPI_PROJ>(gp, l, smem, p.hn, 1024, W + WO_IN, 1024, 1024, 288, even ? 29 : 23, 0); break;
    case 2: mixer_phase(gp, l, smem); break;
    case 3: finalize_phase(gp, l); break;
    case 4: gemm_phase<EPI_RES>(gp, l, smem, p.hn, 1024, W + WO_OUT, 1024, 1024, 288, 8, 2); break;
    case 5: norm_phase(gp, l, 1, false, false); break;
    case 6: gemm_phase<EPI_FFN>(gp, l, smem, p.hn, 1024, W + WO_UP, 1024, 1024, 312, 44, 0); break;
    case 7: gemm_phase<EPI_RES>(gp, l, smem, p.proj, 2816, W + WO_DN, 2816, 2816, 288, 8, 5); break;
  }
}

__global__ void __launch_bounds__(256, 2) mk(P p, P* gp, int ph0, int ph1) {
  __shared__ __attribute__((aligned(16))) char smem[SMEM_BYTES];
  if (threadIdx.x == 0) *gp = p;
  __threadfence();
  __syncthreads();
  if (ph1 - ph0 > 1) {
    cg::grid_group grid = cg::this_grid();
    for (int ph = ph0; ph < ph1; ++ph) {
      run_phase(gp, ph, smem);
      if (ph + 1 < ph1) grid.sync();
    }
  } else {
    run_phase(gp, ph0, smem);
  }
}

extern "C" void kernel_launch(void* const* d_in, const int* in_sizes, int n_in, void* d_out, int out_size, void* d_ws, size_t ws_size,
                              hipStream_t stream) {
  P p{};
  const float** f = (const float**)&p;
  for (int i = 0; i < 31; ++i) f[i] = (const float*)d_in[i];
  p.out = (float*)d_out;
  char* ws = (char*)d_ws;
  size_t off = 0;
  p.hn = (u16*)(ws + off); off += (size_t)NT_ * 1024 * 2;
  p.proj = (u16*)(ws + off); off += (size_t)NT_ * EVN * 2;
  p.ot1 = (u16*)(ws + off); off += (size_t)NT_ * 512 * 2;
  p.wt = (u16*)(ws + off); off += 4 * LW * 2;
  p.mods = (float*)(ws + off); off += 4 * 9 * 6144 * 4;
  p.rope = (float*)(ws + off); off += 64 * 16 * 2 * 4;
  P* gp = (P*)(ws + off); off += 4096;
  p.cnt = (int*)(ws + off); off += 256;
  static int grid_blocks = 0;
  if (!grid_blocks) {
    int dev = 0, cus = 0, per_cu = 0;
    hipGetDevice(&dev);
    hipDeviceGetAttribute(&cus, hipDeviceAttributeMultiprocessorCount, dev);
    hipOccupancyMaxActiveBlocksPerMultiprocessor(&per_cu, mk, 256, 0);
    if (per_cu < 1) per_cu = 1;
    if (per_cu > 2) per_cu = 2;
    grid_blocks = cus * per_cu;
  }
#if MK_MULTI
  for (int ph = 0; ph < NPH; ++ph) {
    int a = ph, b = ph + 1;
    hipLaunchKernelGGL(mk, dim3(grid_blocks), dim3(256), 0, stream, p, gp, a, b);
  }
#else
  int ph0 = 0, ph1 = NPH;
  void* args[] = {&p, &gp, &ph0, &ph1};
  hipError_t e = hipLaunchCooperativeKernel((void*)mk, dim3(grid_blocks), dim3(256), args, 0, stream);
  if (e != hipSuccess) fprintf(stderr, "cooperative launch failed: %s (grid %d)\n", hipGetErrorString(e), grid_blocks);
#endif
}
```

```cpp
#include <hip/hip_runtime.h>
#include <hip/hip_cooperative_groups.h>
#include <cstdio>
namespace cg = cooperative_groups;

#ifndef MK_MULTI
#define MK_MULTI 0
#endif

#define DI __device__ __forceinline__
#define DN __device__ __noinline__
typedef unsigned short u16;
typedef __attribute__((ext_vector_type(8))) short bf16x8;
typedef __attribute__((ext_vector_type(4))) short s16x4;
typedef __attribute__((ext_vector_type(16))) float f32x16;
#define MFMA(a, b, c) __builtin_amdgcn_mfma_f32_32x32x16_bf16((a), (b), (c), 0, 0, 0)

static constexpr int NP_ = 4096, NT_ = 36864;
static constexpr int EVN = 3616, ODN = 2848;
static constexpr size_t OFF_AK = 37748736, OFF_AV = 41943040, OFF_SB = 46137344, OFF_CK = 48234496, OFF_CV = 49283072, OFF_SD = 50331648;
static constexpr size_t LW = 13500416, WO_UP = 0, WO_DN = 5767168, WO_IN = 8650752, WO_OUT = 12451840;
static constexpr int NPH = 34;
static constexpr int SMEM_BYTES = 80 * 1024;

struct P {
  const float *x_prompt, *x_sample, *cache_a_k, *cache_a_v, *state_b, *cache_c_k, *cache_c_v, *state_d, *c, *c_ctx, *ada_w, *ada_b,
      *norm1_g, *norm2_g, *ffn_up, *ffn_conv, *ffn_down, *ev_w_in, *ev_w_out, *a_rpb, *b_w_g2, *b_b_g, *b_norm_g, *od_w_in, *od_w_out,
      *c_sink, *d_conv, *d_a_log, *d_dt_bias, *d_norm_g, *final_g;
  float* out;
  u16 *hn, *proj, *ot1, *wt;
  float *mods, *rope;
  int* cnt;
  int* flags;
  char* ring;
};

DI u16 f2bf(float x) { unsigned u = __float_as_uint(x); u += 0x7fffu + ((u >> 16) & 1u); return (u16)(u >> 16); }
DI float bf2f(u16 b) { return __uint_as_float(((unsigned)b) << 16); }
DI int crow(int i, int h) { return (i & 3) + 8 * (i >> 2) + 4 * h; }
template <int S> DI bf16x8 packs(const f32x16& x) {
  bf16x8 v;
#pragma unroll
  for (int j = 0; j < 8; ++j) v[j] = (short)f2bf(x[8 * S + j]);
  return v;
}
DI bf16x8 ld2x4(const u16* p) {
  s16x4 lo = *(const s16x4*)p, hi = *(const s16x4*)(p + 8);
  return __builtin_shufflevector(lo, hi, 0, 1, 2, 3, 4, 5, 6, 7);
}
DI float siluf(float x) { return x / (1.f + __expf(-x)); }
DI int opq(int x) { asm volatile("" : "+v"(x)); return x; }
DI float shx(float v, int lane, int o) { return __int_as_float(__builtin_amdgcn_ds_bpermute((lane ^ o) << 2, __float_as_int(v))); }
template <class T> DI T* uni(T* q) {
  const unsigned long long v = (unsigned long long)q;
  const unsigned lo = __builtin_amdgcn_readfirstlane((unsigned)v), hi = __builtin_amdgcn_readfirstlane((unsigned)(v >> 32));
  return (T*)(((unsigned long long)hi << 32) | lo);
}
DI void zero16(f32x16& a) {
#pragma unroll
  for (int i = 0; i < 16; ++i) a[i] = 0.f;
}

DI void prep_phase(const P* __restrict__ gp, char* smem) {
  const P& p = *gp;
  int tid_ = threadIdx.x; asm volatile("" : "+v"(tid_)); const int tid = tid_;
  const int NWT = 4 * (1408 + 704 + 256) + 2 * (928 + 736);
  const int NADA = 384;
  const int total = NWT + NADA + 1;
  for (int item = blockIdx.x; item < total; item += gridDim.x) {
    if (item < NWT) {
      int rem = item; const float* src = nullptr; u16* dst = nullptr; int K = 0, N = 0, NPd = 0;
      for (int l = 0; l < 4; ++l) {
        const int jj = l >> 1; const bool ev = !(l & 1);
        const int nin = ev ? 928 : 736;
        if (rem < 1408) { src = p.ffn_up + (size_t)l * 1024 * 5632; dst = p.wt + l * LW + WO_UP; K = 1024; N = 5632; NPd = 5632; break; }
        rem -= 1408;
        if (rem < 704) { src = p.ffn_down + (size_t)l * 2816 * 1024; dst = p.wt + l * LW + WO_DN; K = 2816; N = 1024; NPd = 1024; break; }
        rem -= 704;
        if (rem < nin) { src = ev ? p.ev_w_in + (size_t)jj * 1024 * EVN : p.od_w_in + (size_t)jj * 1024 * ODN; dst = p.wt + l * LW + WO_IN; K = 1024; N = ev ? EVN : ODN; NPd = ev ? 3712 : 2944; break; }
        rem -= nin;
        if (rem < 256) { src = (ev ? p.ev_w_out : p.od_w_out) + (size_t)jj * 1024 * 1024; dst = p.wt + l * LW + WO_OUT; K = 1024; N = 1024; NPd = 1024; break; }
        rem -= 256;
      }
      const int ntn = NPd >> 6;
      const int tk = rem / ntn, tn = rem - tk * ntn;
      float* T = (float*)smem;
      __syncthreads();
#pragma unroll
      for (int i = 0; i < 16; ++i) {
        const int k = i * 4 + (tid >> 6), n = tid & 63;
        const int gn = tn * 64 + n;
        T[k * 65 + n] = (gn < N) ? src[(size_t)(tk * 64 + k) * N + gn] : 0.f;
      }
      __syncthreads();
#pragma unroll
      for (int i = 0; i < 16; ++i) {
        const int n = i * 4 + (tid >> 6), k = tid & 63;
        dst[(size_t)(tn * 64 + n) * K + tk * 64 + k] = f2bf(T[k * 65 + n]);
      }
    } else if (item < NWT + NADA) {
      const int it = item - NWT; const int l = it / 96, cgp = it - l * 96; const int n0 = cgp * 64;
      float* sc = (float*)smem;
      float* red = sc + 9 * 1024;
      __syncthreads();
      for (int idx = tid; idx < 9 * 1024; idx += 256) {
        const int ci = idx >> 10, k = idx & 1023;
        const float x = ci < 8 ? p.c[ci * 1024 + k] : p.c_ctx[k];
        sc[idx] = x / (1.f + expf(-x));
      }
      __syncthreads();
      const int wave = tid >> 6, lane = tid & 63;
      float acc[9];
#pragma unroll
      for (int ci = 0; ci < 9; ++ci) acc[ci] = 0.f;
      const float* wp = p.ada_w + ((size_t)l * 1024 + wave * 256) * 6144 + n0 + lane;
#pragma unroll 8
      for (int k = 0; k < 256; ++k) {
        const float wv = wp[(size_t)k * 6144];
#pragma unroll
        for (int ci = 0; ci < 9; ++ci) acc[ci] += sc[ci * 1024 + wave * 256 + k] * wv;
      }
#pragma unroll
      for (int ci = 0; ci < 9; ++ci) red[(wave * 9 + ci) * 64 + lane] = acc[ci];
      __syncthreads();
      for (int idx = tid; idx < 576; idx += 256) {
        const int ci = idx >> 6, col = idx & 63;
        const float s = red[(0 * 9 + ci) * 64 + col] + red[(1 * 9 + ci) * 64 + col] + red[(2 * 9 + ci) * 64 + col] + red[(3 * 9 + ci) * 64 + col];
        p.mods[(size_t)(l * 9 + ci) * 6144 + n0 + col] = s + p.ada_b[l * 6144 + n0 + col];
      }
    } else {
      if (tid < 8) p.cnt[tid] = 0;
      for (int i = tid; i < 4 * 8320; i += 256) p.flags[i] = 0;
      for (int idx = tid; idx < 1024; idx += 256) {
        const int pos = idx >> 4, fi = idx & 15;
        const float inv = powf(10000.f, -(float)fi / 16.f);
        const float ang = (float)pos * inv;
        p.rope[idx * 2] = cosf(ang); p.rope[idx * 2 + 1] = sinf(ang);
      }
    }
  }
}

DI void norm_phase(const P* __restrict__ gp, int l, int which, bool first, bool fin) {
  const P& p = *gp;
  int tid_ = threadIdx.x; asm volatile("" : "+v"(tid_)); const int tid = tid_, lane = tid & 63, wave = tid >> 6;
  for (int item = blockIdx.x; item < NT_ / 4; item += gridDim.x) {
    const int tok = item * 4 + wave;
    const float* src = first ? (tok < NP_ ? p.x_prompt + (size_t)tok * 1024 : p.x_sample + (size_t)(tok - NP_) * 1024) : p.out + (size_t)tok * 1024;
    float4 v[4];
    float ss = 0.f;
#pragma unroll
    for (int i = 0; i < 4; ++i) { v[i] = ((const float4*)src)[lane + 64 * i]; ss += v[i].x * v[i].x + v[i].y * v[i].y + v[i].z * v[i].z + v[i].w * v[i].w; }
#pragma unroll
    for (int o = 32; o >= 1; o >>= 1) ss += shx(ss, lane, o);
    const float rstd = rsqrtf(ss * (1.f / 1024.f) + 1e-6f);
    if (fin) {
#pragma unroll
      for (int i = 0; i < 4; ++i) {
        const float4 g = ((const float4*)p.final_g)[lane + 64 * i];
        float4 y; y.x = v[i].x * rstd * g.x; y.y = v[i].y * rstd * g.y; y.z = v[i].z * rstd * g.z; y.w = v[i].w * rstd * g.w;
        ((float4*)(p.out + (size_t)tok * 1024))[lane + 64 * i] = y;
      }
    } else {
      const int ci = tok < NP_ ? 8 : (tok - NP_) >> 12;
      const float* md = p.mods + (size_t)(l * 9 + ci) * 6144 + which * 3072;
      const float* gp = (which ? p.norm2_g : p.norm1_g) + l * 1024;
#pragma unroll
      for (int i = 0; i < 4; ++i) {
        const float4 g = ((const float4*)gp)[lane + 64 * i];
        const float4 sh = ((const float4*)md)[lane + 64 * i];
        const float4 sc = ((const float4*)(md + 1024))[lane + 64 * i];
        ushort4 o;
        o.x = f2bf(v[i].x * rstd * g.x * (1.f + sc.x) + sh.x);
        o.y = f2bf(v[i].y * rstd * g.y * (1.f + sc.y) + sh.y);
        o.z = f2bf(v[i].z * rstd * g.z * (1.f + sc.z) + sh.z);
        o.w = f2bf(v[i].w * rstd * g.w * (1.f + sc.w) + sh.w);
        ((ushort4*)(p.hn + (size_t)tok * 1024))[lane + 64 * i] = o;
        if (first) ((float4*)(p.out + (size_t)tok * 1024))[lane + 64 * i] = v[i];
      }
    }
  }
}

DI uint4 ldsel(const u16* pv, const u16* safe, unsigned ok) {
  uint4 t = *(const uint4*)(ok ? pv : safe);
  if (!ok) { t.x = 0; t.y = 0; t.z = 0; t.w = 0; }
  return t;
}
enum { EPI_PROJ = 0, EPI_RES = 1, EPI_FFN = 2 };

template <int EPI>
DI void gemm_phase(const P* __restrict__ gp, int l, char* smem, const u16* __restrict__ A, int lda, const u16* __restrict__ B, int ldb, int K, int MT,
                   int NTn, int gsel) {
  const P& p = *gp;
  u16* As = (u16*)smem;
  int tid_ = threadIdx.x; asm volatile("" : "+v"(tid_)); const int tid = tid_, lane = tid & 63, wave = tid >> 6, r = lane & 31, h = lane >> 5;
  const int wm = wave & 1, wn = wave >> 1;
  const int KT = K >> 6;
  const bool even = !(l & 1); const int jj = l >> 1;
  const int ntiles = MT * NTn;
  const int nlb = gridDim.x >> 3, xcd = blockIdx.x & 7, lb = blockIdx.x >> 3;
  for (int it = 0;; ++it) {
    const int g = (it * 8 + xcd) * nlb + lb;
    if (g >= ntiles) break;
    const int SM = nlb >> 3;
    const int band = g / (SM * NTn); const int rem = g - band * SM * NTn;
    const int nt = rem / SM, mt = band * SM + (rem - nt * SM);
    int seqbase = 0, L = 0, tin0 = 0;
    if (EPI == EPI_FFN) {
      if (mt < 48) { const int sq = mt / 3; L = 256; seqbase = sq * 256; tin0 = (mt - sq * 3) * 126; }
      else { const int m2 = mt - 48; const int sq = m2 / 33; L = 4096; seqbase = NP_ + sq * 4096; tin0 = (m2 - sq * 33) * 126; }
    }
    const int row0 = tid >> 3, kc0 = (tid & 7) * 8;
    const long arow0 = (EPI == EPI_FFN) ? (long)seqbase + tin0 - 1 + row0 : (long)mt * 128 + row0;
    const u16* abase = A + arow0 * lda + kc0;
    unsigned avalid = 0;
#pragma unroll
    for (int i = 0; i < 4; ++i) {
      if (EPI == EPI_FFN) { const int ts = tin0 - 1 + row0 + 32 * i; if (ts >= 0 && ts < L) avalid |= 1u << i; }
      else avalid |= 1u << i;
    }
    const u16* bbase = B + (size_t)((EPI == EPI_FFN) ? nt * 64 + row0 : nt * 128 + row0) * ldb + kc0;
#define BOFFR(i) ((EPI == EPI_FFN) ? ((i) < 2 ? 32 * (i) : 2752 + 32 * (i)) : 32 * (i))
    f32x16 acc[2][2];
#pragma unroll
    for (int a = 0; a < 2; ++a)
#pragma unroll
      for (int b = 0; b < 2; ++b) zero16(acc[a][b]);
#define GLD_A(i, ko) ldsel(abase + (size_t)(32 * (i)) * lda + (ko), A, (avalid >> (i)) & 1u)
#define GLD_B(i, ko) (*(const uint4*)(bbase + (size_t)BOFFR(i) * ldb + (ko)))
    uint4 ra0 = GLD_A(0, 0), ra1 = GLD_A(1, 0), ra2 = GLD_A(2, 0), ra3 = GLD_A(3, 0);
    uint4 rb0 = GLD_B(0, 0), rb1 = GLD_B(1, 0), rb2 = GLD_B(2, 0), rb3 = GLD_B(3, 0);
    uint4 sa0 = GLD_A(0, 64), sa1 = GLD_A(1, 64), sa2 = GLD_A(2, 64), sa3 = GLD_A(3, 64);
    uint4 sb0 = GLD_B(0, 64), sb1 = GLD_B(1, 64), sb2 = GLD_B(2, 64), sb3 = GLD_B(3, 64);
#define LSTORE(buf, A0, A1, A2, A3, B0, B1, B2, B3) { \
      u16* ad = As + (buf) * 18432 + row0 * 72 + kc0; u16* bd = ad + 9216; \
      *(uint4*)(ad) = A0; *(uint4*)(ad + 32 * 72) = A1; *(uint4*)(ad + 64 * 72) = A2; *(uint4*)(ad + 96 * 72) = A3; \
      *(uint4*)(bd) = B0; *(uint4*)(bd + 32 * 72) = B1; *(uint4*)(bd + 64 * 72) = B2; *(uint4*)(bd + 96 * 72) = B3; }
#define COMPUTE(buf) { \
      const u16* Ab = As + (buf) * 18432; const u16* Bb = Ab + 9216; \
      _Pragma("unroll") for (int ks = 0; ks < 4; ++ks) { \
        const bf16x8 a0 = *(const bf16x8*)(Ab + (wm * 64 + r) * 72 + ks * 16 + h * 8); \
        const bf16x8 a1 = *(const bf16x8*)(Ab + (wm * 64 + 32 + r) * 72 + ks * 16 + h * 8); \
        const bf16x8 b0 = *(const bf16x8*)(Bb + (wn * 64 + r) * 72 + ks * 16 + h * 8); \
        const bf16x8 b1 = *(const bf16x8*)(Bb + (wn * 64 + 32 + r) * 72 + ks * 16 + h * 8); \
        acc[0][0] = MFMA(a0, b0, acc[0][0]); acc[0][1] = MFMA(a0, b1, acc[0][1]); \
        acc[1][0] = MFMA(a1, b0, acc[1][0]); acc[1][1] = MFMA(a1, b1, acc[1][1]); } }
    LSTORE(0, ra0, ra1, ra2, ra3, rb0, rb1, rb2, rb3);
    ra0 = GLD_A(0, 128); ra1 = GLD_A(1, 128); ra2 = GLD_A(2, 128); ra3 = GLD_A(3, 128);
    rb0 = GLD_B(0, 128); rb1 = GLD_B(1, 128); rb2 = GLD_B(2, 128); rb3 = GLD_B(3, 128);
    __syncthreads();
    for (int kt = 0; kt < KT; kt += 2) {
      COMPUTE(0);
      LSTORE(1, sa0, sa1, sa2, sa3, sb0, sb1, sb2, sb3);
      if (kt + 3 < KT) {
        const int ko = (kt + 3) * 64;
        sa0 = GLD_A(0, ko); sa1 = GLD_A(1, ko); sa2 = GLD_A(2, ko); sa3 = GLD_A(3, ko);
        sb0 = GLD_B(0, ko); sb1 = GLD_B(1, ko); sb2 = GLD_B(2, ko); sb3 = GLD_B(3, ko);
      }
      __syncthreads();
      COMPUTE(1);
      if (kt + 2 < KT) {
        LSTORE(0, ra0, ra1, ra2, ra3, rb0, rb1, rb2, rb3);
        if (kt + 4 < KT) {
          const int ko = (kt + 4) * 64;
          ra0 = GLD_A(0, ko); ra1 = GLD_A(1, ko); ra2 = GLD_A(2, ko); ra3 = GLD_A(3, ko);
          rb0 = GLD_B(0, ko); rb1 = GLD_B(1, ko); rb2 = GLD_B(2, ko); rb3 = GLD_B(3, ko);
        }
      }
      __syncthreads();
    }
    if (EPI == EPI_PROJ) {
      const int N = even ? EVN : ODN;
#pragma unroll
      for (int tm = 0; tm < 2; ++tm)
#pragma unroll
        for (int tn = 0; tn < 2; ++tn) {
          const int col = nt * 128 + wn * 64 + tn * 32 + r;
          if (col < N) {
#pragma unroll
            for (int i = 0; i < 16; ++i) {
              const int row = mt * 128 + wm * 64 + tm * 32 + crow(i, h);
              const float v = acc[tm][tn][i];
              p.proj[(size_t)row * N + col] = f2bf(v);
              if (row < NP_) {
                const int b = row >> 8, t = row & 255, d = col & 63;
                if (even) {
                  if (col >= 512 && col < 1536) {
                    const int wh = (col - 512) >> 9, hh = ((col - 512) >> 6) & 7;
                    p.out[(wh ? OFF_AV : OFF_AK) + ((size_t)(((b * 2 + jj) * 8 + hh) * 256 + t)) * 64 + d] = v;
                  }
                } else {
                  if (col >= 512 && col < 768) {
                    const int wh = (col - 512) >> 7, kv = ((col - 512) >> 6) & 1;
                    p.out[(wh ? OFF_CV : OFF_CK) + ((size_t)(((b * 2 + jj) * 2 + kv) * 256 + t)) * 64 + d] = v;
                  }
                }
              }
            }
          }
        }
    } else if (EPI == EPI_RES) {
#pragma unroll
      for (int tm = 0; tm < 2; ++tm)
#pragma unroll
        for (int tn = 0; tn < 2; ++tn) {
          const int col = nt * 128 + wn * 64 + tn * 32 + r;
#pragma unroll
          for (int i = 0; i < 16; ++i) {
            const int row = mt * 128 + wm * 64 + tm * 32 + crow(i, h);
            const int ci = row < NP_ ? 8 : (row - NP_) >> 12;
            const float g = p.mods[(size_t)(l * 9 + ci) * 6144 + gsel * 1024 + col];
            float* xp = p.out + (size_t)row * 1024 + col;
            *xp = *xp + g * acc[tm][tn][i];
          }
        }
    } else {
      __syncthreads();
      float* U = (float*)smem;
#pragma unroll
      for (int tm = 0; tm < 2; ++tm)
#pragma unroll
        for (int tn = 0; tn < 2; ++tn)
#pragma unroll
          for (int i = 0; i < 16; ++i) U[(wm * 64 + tm * 32 + crow(i, h)) * 132 + wn * 64 + tn * 32 + r] = acc[tm][tn][i];
      __syncthreads();
      const float* cw = p.ffn_conv + (size_t)l * 3 * 5632;
      const int f = tid & 63, rg = tid >> 6; const int fg = nt * 64 + f;
      const float wa0 = cw[fg], wa1 = cw[5632 + fg], wa2 = cw[2 * 5632 + fg];
      const float wg0 = cw[2816 + fg], wg1 = cw[5632 + 2816 + fg], wg2 = cw[2 * 5632 + 2816 + fg];
      u16* act = p.proj;
      for (int rr = 1 + rg; rr <= 126; rr += 4) {
        const int ts = tin0 - 1 + rr;
        if (ts >= L) break;
        const float a = wa0 * U[(rr - 1) * 132 + f] + wa1 * U[rr * 132 + f] + wa2 * U[(rr + 1) * 132 + f];
        const float g = wg0 * U[(rr - 1) * 132 + 64 + f] + wg1 * U[rr * 132 + 64 + f] + wg2 * U[(rr + 1) * 132 + 64 + f];
        act[(size_t)(seqbase + ts) * 2816 + fg] = f2bf(a * siluf(g));
      }
      __syncthreads();
    }
  }
}

template <int MODE>
DI void attn_item(const P* __restrict__ gp, int jj, int it, char* smem) {
  const P& p = *gp;
  const u16* projp = uni(p.proj); u16* hnp = uni(p.hn); const float* ropep = uni(p.rope);
  u16* Ks = (u16*)smem; u16* Vt = Ks + 64 * 72; float* rpb_s = (float*)(Vt + 64 * 72);
  int tid_ = threadIdx.x; asm volatile("" : "+v"(tid_)); const int tid = tid_, lane = tid & 63, wave = tid >> 6, r = lane & 31, h = lane >> 5;
  constexpr bool EVENL = (MODE == 0 || MODE == 1);
  constexpr bool LAT = (MODE == 1 || MODE == 3);
  constexpr int PS = EVENL ? EVN : ODN;
  int b, hq, qb, tokbase;
  if (!LAT) { b = it >> 4; hq = (it >> 1) & 7; qb = it & 1; tokbase = b * 256; }
  else { b = it >> 8; hq = (it >> 5) & 7; qb = it & 31; tokbase = NP_ + b * 4096; }
  const int hk = EVENL ? hq : (hq >> 2);
  const int kcol = 512 + hk * 64, vcol = (EVENL ? 1024 : 640) + hk * 64, qcol = hq * 64;
  const int tq = qb * 128 + wave * 32 + r;
  const size_t qtok = (size_t)tokbase + tq;
  __syncthreads();
  if (MODE == 1) { for (int i = tid; i < 465; i += 256) rpb_s[i] = p.a_rpb[(size_t)(jj * 8 + hq) * 465 + i]; }
  bf16x8 qf[4];
#pragma unroll
  for (int s = 0; s < 4; ++s) qf[s] = *(const bf16x8*)(projp + qtok * PS + qcol + 16 * s + 8 * h);
  if (MODE == 3) {
    const int prow = tq >> 6, pcol = tq & 63;
#pragma unroll
    for (int half = 0; half < 2; ++half) {
      const int pos = half ? pcol : prow;
#pragma unroll
      for (int j = 0; j < 8; ++j) {
        const float cs = ropep[(pos * 16 + 8 * h + j) * 2], sn = ropep[(pos * 16 + 8 * h + j) * 2 + 1];
        const float x1 = bf2f((u16)qf[2 * half][j]), x2 = bf2f((u16)qf[2 * half + 1][j]);
        qf[2 * half][j] = (short)f2bf(x1 * cs - x2 * sn);
        qf[2 * half + 1][j] = (short)f2bf(x1 * sn + x2 * cs);
      }
    }
  }
  float m_run = -1e30f, l_run = 0.f;
  if (MODE == 2 || MODE == 3) { m_run = p.c_sink[jj * 8 + hq]; l_run = h == 0 ? 1.f : 0.f; }
  f32x16 ot[2]; zero16(ot[0]); zero16(ot[1]);
  int loc0 = 0, nloc = 0;
  if (MODE == 1) {
    const int qi0 = 2 * qb;
    const int rlo = min(max(qi0 - 4, 0), 56), rhi = min(max(qi0 + 1 - 4, 0), 56) + 7;
    loc0 = rlo; nloc = rhi - rlo + 1;
  } else if (MODE == 3) {
    loc0 = max(0, 2 * qb - 2); nloc = min(63, 2 * qb + 3) - loc0 + 1;
  }
  const int qi = tq >> 6, qw = tq & 63;
  const int r0w = min(max(qi - 4, 0), 56), c0w = min(max(qw - 8, 0), 48);
  const int key = tid >> 2, seg = tid & 3;
  for (int kb = 0; kb < 4 + nloc; ++kb) {
    const bool isctx = kb < 4;
    const int blk = isctx ? kb : loc0 + kb - 4;
    __syncthreads();
    {
      float kf[16], vf[16];
      if (LAT && isctx) {
        const float* kc = (MODE == 1) ? p.cache_a_k + ((size_t)((b * 2 + jj) * 8 + hk)) * 16384 : p.cache_c_k + ((size_t)((b * 2 + jj) * 2 + hk)) * 16384;
        const float* vc = (MODE == 1) ? p.cache_a_v + ((size_t)((b * 2 + jj) * 8 + hk)) * 16384 : p.cache_c_v + ((size_t)((b * 2 + jj) * 2 + hk)) * 16384;
        const float4* kp4 = (const float4*)(kc + (size_t)(blk * 64 + key) * 64 + seg * 16);
        const float4* vp4 = (const float4*)(vc + (size_t)(blk * 64 + key) * 64 + seg * 16);
#pragma unroll
        for (int e = 0; e < 4; ++e) {
          const float4 a = kp4[e], c = vp4[e];
          kf[4 * e] = a.x; kf[4 * e + 1] = a.y; kf[4 * e + 2] = a.z; kf[4 * e + 3] = a.w;
          vf[4 * e] = c.x; vf[4 * e + 1] = c.y; vf[4 * e + 2] = c.z; vf[4 * e + 3] = c.w;
        }
      } else {
        const u16* rowp = projp + ((size_t)tokbase + blk * 64 + key) * PS;
        const bf16x8 k0 = *(const bf16x8*)(rowp + kcol + seg * 16), k1 = *(const bf16x8*)(rowp + kcol + seg * 16 + 8);
        const bf16x8 v0 = *(const bf16x8*)(rowp + vcol + seg * 16), v1 = *(const bf16x8*)(rowp + vcol + seg * 16 + 8);
#pragma unroll
        for (int e = 0; e < 8; ++e) { kf[e] = bf2f((u16)k0[e]); kf[8 + e] = bf2f((u16)k1[e]); vf[e] = bf2f((u16)v0[e]); vf[8 + e] = bf2f((u16)v1[e]); }
        if (MODE == 3) {
          const bf16x8 p0 = *(const bf16x8*)(rowp + kcol + (seg ^ 1) * 16), p1 = *(const bf16x8*)(rowp + kcol + (seg ^ 1) * 16 + 8);
          const int pos = (seg & 2) ? key : blk;
#pragma unroll
          for (int e = 0; e < 16; ++e) {
            const float pr = bf2f((u16)(e < 8 ? p0[e & 7] : p1[e & 7]));
            const float cs = ropep[(pos * 16 + e) * 2], sn = ropep[(pos * 16 + e) * 2 + 1];
            kf[e] = (seg & 1) ? (pr * sn + kf[e] * cs) : (kf[e] * cs - pr * sn);
          }
        }
      }
      bf16x8 o0, o1;
#pragma unroll
      for (int e = 0; e < 8; ++e) { o0[e] = (short)f2bf(kf[e]); o1[e] = (short)f2bf(kf[8 + e]); }
      *(bf16x8*)(Ks + key * 72 + seg * 16) = o0;
      *(bf16x8*)(Ks + key * 72 + seg * 16 + 8) = o1;
#pragma unroll
      for (int e = 0; e < 16; ++e) Vt[(seg * 16 + e) * 72 + key] = f2bf(vf[e]);
    }
    __syncthreads();
    bool active = true;
    if (MODE == 1 && !isctx) active = (blk >= r0w && blk < r0w + 8);
    if (active) {
      f32x16 st[2]; zero16(st[0]); zero16(st[1]);
#pragma unroll
      for (int kt = 0; kt < 2; ++kt)
#pragma unroll
        for (int s = 0; s < 4; ++s) {
          const bf16x8 a = *(const bf16x8*)(Ks + (kt * 32 + r) * 72 + 16 * s + 8 * h);
          st[kt] = MFMA(a, qf[s], st[kt]);
        }
      float mx = m_run;
#pragma unroll
      for (int kt = 0; kt < 2; ++kt)
#pragma unroll
        for (int i = 0; i < 16; ++i) {
          float s = st[kt][i] * 0.125f;
          const int kk = kt * 32 + crow(i, h);
          if (MODE == 1 && !isctx) {
            const bool ok = (kk >= c0w && kk < c0w + 16);
            s = ok ? s + rpb_s[(blk - qi + 7) * 31 + (kk - qw + 15)] : -1e30f;
          }
          if (MODE == 3 && !isctx) {
            const int dlt = blk * 64 + kk - tq;
            s = (dlt <= 128 && dlt >= -128) ? s : -1e30f;
          }
          st[kt][i] = s;
          mx = fmaxf(mx, s);
        }
      mx = fmaxf(mx, shx(mx, lane, 32));
      const float alpha = __expf(m_run - mx);
      m_run = mx;
      float ps = 0.f;
#pragma unroll
      for (int kt = 0; kt < 2; ++kt)
#pragma unroll
        for (int i = 0; i < 16; ++i) { const float pv = __expf(st[kt][i] - mx); st[kt][i] = pv; ps += pv; }
      l_run = l_run * alpha + ps;
#pragma unroll
      for (int dt = 0; dt < 2; ++dt)
#pragma unroll
        for (int i = 0; i < 16; ++i) ot[dt][i] *= alpha;
#pragma unroll
      for (int kt = 0; kt < 2; ++kt) {
        const bf16x8 pb0 = packs<0>(st[kt]), pb1 = packs<1>(st[kt]);
#pragma unroll
        for (int dt = 0; dt < 2; ++dt) {
          const bf16x8 pa0 = ld2x4(Vt + (dt * 32 + r) * 72 + kt * 32 + 4 * h);
          const bf16x8 pa1 = ld2x4(Vt + (dt * 32 + r) * 72 + kt * 32 + 16 + 4 * h);
          ot[dt] = MFMA(pa0, pb0, ot[dt]);
          ot[dt] = MFMA(pa1, pb1, ot[dt]);
        }
      }
    }
  }
  l_run += shx(l_run, lane, 32);
  const float inv = 1.f / l_run;
  u16* dst = hnp + qtok * 1024 + qcol;
#pragma unroll
  for (int dt = 0; dt < 2; ++dt)
#pragma unroll
    for (int g4 = 0; g4 < 4; ++g4) {
      ushort4 o;
      o.x = f2bf(ot[dt][4 * g4] * inv); o.y = f2bf(ot[dt][4 * g4 + 1] * inv); o.z = f2bf(ot[dt][4 * g4 + 2] * inv); o.w = f2bf(ot[dt][4 * g4 + 3] * inv);
      *(ushort4*)(dst + dt * 32 + 8 * g4 + 4 * h) = o;
    }
}

struct ChainId { int lat, b, h, dir, T, base, nch; };
DI ChainId chain_decode(int it) {
  ChainId c; c.lat = it < 128; const int q = c.lat ? it : it - 128;
  c.b = q >> 4; c.h = (q >> 1) & 7; c.dir = q & 1; c.T = c.lat ? 4096 : 256; c.base = c.lat ? NP_ + c.b * 4096 : c.b * 256; c.nch = c.T >> 6;
  return c;
}
DI int tokof(const ChainId& c, int step, int row) { const int pp = step * 64 + row; return c.base + (c.dir ? c.T - 1 - pp : pp); }


static constexpr int RING = 4;
static constexpr int SLOT_BYTES = 53760;
DI void wait_ge(int* flag, int val, int tid) {
  if (tid < 64) {
    if (tid == 0) { while (__hip_atomic_load(flag, __ATOMIC_RELAXED, __HIP_MEMORY_SCOPE_AGENT) < val) __builtin_amdgcn_s_sleep(1); }
    __builtin_amdgcn_fence(__ATOMIC_ACQUIRE, "agent");
  }
  __syncthreads();
}
DI void publish(int* flag, int val, int tid) {
  asm volatile("s_waitcnt vmcnt(0)" ::: "memory");
  __syncthreads();
  if (tid == 0) __hip_atomic_store(flag, val, __ATOMIC_RELAXED, __HIP_MEMORY_SCOPE_AGENT);
}
typedef __attribute__((ext_vector_type(4))) unsigned u32x4;
DI void copy_out(const char* lds, char* g, int bytes, int tid) {
  for (int i = opq(tid) * 16; i < bytes; i += 256 * 16) {
    const u32x4 v = *(const u32x4*)(lds + i);
    char* dst = g + i;
    asm volatile("global_store_dwordx4 %0, %1, off sc0 sc1" :: "v"(dst), "v"(v) : "memory");
  }
}
DI void copy_in(char* lds, const char* g, int bytes, int tid) {
  for (int i = opq(tid) * 16; i < bytes; i += 256 * 16) *(uint4*)(lds + i) = *(const uint4*)(g + i);
}

template <int ROLE>
DI void gla_chain(const P* __restrict__ gp, int jj, int it, char* smem, int k0, int kstep) {
  const P& p = *gp;
  const ChainId cid = chain_decode(it);
  int tid_ = threadIdx.x; asm volatile("" : "+v"(tid_)); const int tid = tid_, lane = tid & 63, wave = tid >> 6, r = lane & 31, h = lane >> 5;
  const int hh = cid.h, dir = cid.dir;
  u16* QT = (u16*)smem; u16* KT = QT + 4608; u16* KEt = KT + 4608; u16* Vt = KEt + 4608;
  float* dec = (float*)(Vt + 4608); float* GL = dec + 64; float* gq = GL + 1024; float* Ost = gq + 256;
  constexpr int IMG = 4 * 9216 + 256;
  char* slots = uni(p.ring) + (size_t)it * RING * SLOT_BYTES; int* ready = uni(p.flags) + (jj * 2) * 8320 + it * 64; int* done = uni(p.flags) + (jj * 2) * 8320 + 8192 + it;
  const int d = tid & 63, cq = tid >> 6;
  float wg[16];
#pragma unroll
  for (int rr = 0; rr < 16; ++rr) wg[rr] = p.b_w_g2[((size_t)((jj * 2 + dir) * 16 + rr)) * 512 + hh * 64 + d];
  const float bg = p.b_b_g[(jj * 2 + dir) * 512 + hh * 64 + d];
  const int vh = wave & 1;
  f32x16 S[2]; zero16(S[0]); zero16(S[1]);
  const size_t sidx = ((size_t)(((cid.b * 2 + jj) * 2 + dir) * 8 + hh)) * 4096;
  if (ROLE != 1 && wave < 2 && cid.lat) {
#pragma unroll
    for (int dt = 0; dt < 2; ++dt)
#pragma unroll
      for (int i = 0; i < 16; ++i) S[dt][i] = p.state_b[sidx + (dt * 32 + crow(i, h)) * 64 + vh * 32 + r];
  }
  for (int step_ = k0; step_ < cid.nch; step_ += kstep) {
    int step = step_;
    asm volatile("" : "+v"(step));
    if (ROLE == 1) wait_ge(done, step_ - RING + 1, tid);
    if (ROLE == 2) wait_ge(ready + step_, 1, tid);
    __syncthreads();
    if (ROLE == 2) { copy_in(smem, slots + (size_t)(step_ % RING) * SLOT_BYTES, IMG, tid); __syncthreads(); if (tid == 0) __hip_atomic_store(done, step_ + 1, __ATOMIC_RELAXED, __HIP_MEMORY_SCOPE_AGENT); }
    if (ROLE != 2) {
    {
      const int c = tid >> 2, sg = tid & 3;
      const int tok = tokof(cid, step, c);
      const ushort4 gv = *(const ushort4*)(p.proj + (size_t)tok * EVN + 3072 + dir * 16 + sg * 4);
      GL[c * 16 + sg * 4] = bf2f(gv.x); GL[c * 16 + sg * 4 + 1] = bf2f(gv.y); GL[c * 16 + sg * 4 + 2] = bf2f(gv.z); GL[c * 16 + sg * 4 + 3] = bf2f(gv.w);
    }
    __syncthreads();
    float Gl[16]; float run = 0.f;
#pragma unroll
    for (int i = 0; i < 16; ++i) {
      const int c = cq * 16 + i;
      float z = bg;
#pragma unroll
      for (int rr = 0; rr < 16; ++rr) z += GL[c * 16 + rr] * wg[rr];
      const float g = (fminf(z, 0.f) - __logf(1.f + __expf(-fabsf(z)))) * (1.f / 16.f);
      run += g; Gl[i] = run;
    }
    gq[cq * 64 + d] = run;
    __syncthreads();
    float off = 0.f, tot = 0.f;
#pragma unroll
    for (int q2 = 0; q2 < 4; ++q2) { const float t = gq[q2 * 64 + d]; if (q2 < cq) off += t; tot += t; }
#pragma unroll
    for (int i = 0; i < 16; ++i) {
      const int c = cq * 16 + i;
      const int tok = tokof(cid, step, c);
      const float G = Gl[i] + off;
      const u16* rowp = p.proj + (size_t)tok * EVN + hh * 64 + d;
      const float qv = bf2f(rowp[1536]), kv = bf2f(rowp[2048]);
      const u16 vb = rowp[2560];
      QT[c * 72 + d] = f2bf(qv * 0.125f * __expf(G));
      KT[c * 72 + d] = f2bf(kv * __expf(-G));
      KEt[d * 72 + c] = f2bf(kv * __expf(tot - G));
      Vt[d * 72 + c] = vb;
    }
    if (cq == 0) dec[d] = __expf(tot);
    __syncthreads();
    }
    if (ROLE == 1) { copy_out(smem, slots + (size_t)(step_ % RING) * SLOT_BYTES, IMG, tid); publish(ready + step_, 1, tid); continue; }
    if (wave < 2) {
      f32x16 at[2][2];
#pragma unroll
      for (int a = 0; a < 2; ++a)
#pragma unroll
        for (int b2 = 0; b2 < 2; ++b2) zero16(at[a][b2]);
#pragma unroll
      for (int ks = 0; ks < 4; ++ks) {
        const bf16x8 a0 = *(const bf16x8*)(KT + r * 72 + ks * 16 + 8 * h), a1 = *(const bf16x8*)(KT + (32 + r) * 72 + ks * 16 + 8 * h);
        const bf16x8 b0 = *(const bf16x8*)(QT + r * 72 + ks * 16 + 8 * h), b1 = *(const bf16x8*)(QT + (32 + r) * 72 + ks * 16 + 8 * h);
        at[0][0] = MFMA(a0, b0, at[0][0]); at[0][1] = MFMA(a0, b1, at[0][1]);
        at[1][0] = MFMA(a1, b0, at[1][0]); at[1][1] = MFMA(a1, b1, at[1][1]);
      }
#pragma unroll
      for (int st = 0; st < 2; ++st)
#pragma unroll
        for (int ct = 0; ct < 2; ++ct)
#pragma unroll
          for (int i = 0; i < 16; ++i) { if (st * 32 + crow(i, h) > ct * 32 + r) at[st][ct][i] = 0.f; }
      f32x16 o[2]; zero16(o[0]); zero16(o[1]);
#pragma unroll
      for (int ct = 0; ct < 2; ++ct)
#pragma unroll
        for (int st = 0; st < 2; ++st) {
          const bf16x8 x0 = packs<0>(at[st][ct]), x1 = packs<1>(at[st][ct]);
          const bf16x8 pb0 = ld2x4(Vt + (vh * 32 + r) * 72 + st * 32 + 4 * h);
          const bf16x8 pb1 = ld2x4(Vt + (vh * 32 + r) * 72 + st * 32 + 16 + 4 * h);
          o[ct] = MFMA(x0, pb0, o[ct]);
          o[ct] = MFMA(x1, pb1, o[ct]);
        }
#pragma unroll
      for (int dt = 0; dt < 2; ++dt) {
        const bf16x8 xs0 = packs<0>(S[dt]), xs1 = packs<1>(S[dt]);
#pragma unroll
        for (int ct = 0; ct < 2; ++ct) {
          const bf16x8 pa0 = ld2x4(QT + (ct * 32 + r) * 72 + dt * 32 + 4 * h);
          const bf16x8 pa1 = ld2x4(QT + (ct * 32 + r) * 72 + dt * 32 + 16 + 4 * h);
          o[ct] = MFMA(pa0, xs0, o[ct]);
          o[ct] = MFMA(pa1, xs1, o[ct]);
        }
      }
#pragma unroll
      for (int dt = 0; dt < 2; ++dt)
#pragma unroll
        for (int i = 0; i < 16; ++i) S[dt][i] *= dec[dt * 32 + crow(i, h)];
#pragma unroll
      for (int ks = 0; ks < 4; ++ks) {
        const bf16x8 bv = *(const bf16x8*)(Vt + (vh * 32 + r) * 72 + ks * 16 + 8 * h);
#pragma unroll
        for (int dt = 0; dt < 2; ++dt) {
          const bf16x8 a = *(const bf16x8*)(KEt + (dt * 32 + r) * 72 + ks * 16 + 8 * h);
          S[dt] = MFMA(a, bv, S[dt]);
        }
      }
#pragma unroll
      for (int ct = 0; ct < 2; ++ct)
#pragma unroll
        for (int i = 0; i < 16; ++i) Ost[(ct * 32 + crow(i, h)) * 68 + vh * 32 + r] = o[ct][i];
    }
    __syncthreads();
    {
      const int c = tid >> 2, sg = tid & 3;
      const int tok = tokof(cid, step, c);
      u16* dst = (dir ? p.ot1 + (size_t)tok * 512 + hh * 64 : p.hn + (size_t)tok * 1024 + 512 + hh * 64) + sg * 16;
      bf16x8 w0, w1;
#pragma unroll
      for (int e = 0; e < 8; ++e) { w0[e] = (short)f2bf(Ost[c * 68 + sg * 16 + e]); w1[e] = (short)f2bf(Ost[c * 68 + sg * 16 + 8 + e]); }
      *(bf16x8*)dst = w0; *(bf16x8*)(dst + 8) = w1;
    }
  }
  if (wave < 2 && !cid.lat) {
#pragma unroll
    for (int dt = 0; dt < 2; ++dt)
#pragma unroll
      for (int i = 0; i < 16; ++i) p.out[OFF_SB + sidx + (dt * 32 + crow(i, h)) * 64 + vh * 32 + r] = S[dt][i];
  }
}

template <int ROLE>
DI void delta_chain(const P* __restrict__ gp, int jj, int it, char* smem, int k0, int kstep) {
  const P& p = *gp;
  const ChainId cid = chain_decode(it);
  int tid_ = threadIdx.x; asm volatile("" : "+v"(tid_)); const int tid0 = tid_;
  const int hh = cid.h, dir = cid.dir;
  u16* Qn = (u16*)smem; u16* Kt = Qn + 4608; u16* AQK = Kt + 4608; u16* KC = AQK + 4608;
  float* Wv = (float*)(KC + 4608); float* Gs = Wv + 64 * 65; u16* Kn = (u16*)(Gs + 64); float* At = (float*)(Kn + 4608); float* Bt = At + 64 * 68;
  constexpr int IMG = 4 * 9216 + 16640 + 256;
  char* slots = uni(p.ring) + (size_t)it * RING * SLOT_BYTES; int* ready = uni(p.flags) + (jj * 2 + 1) * 8320 + it * 64; int* done = uni(p.flags) + (jj * 2 + 1) * 8320 + 8192 + it;
  const float aexp = __expf(p.d_a_log[(jj * 2 + dir) * 8 + hh]);
  const float dtb = p.d_dt_bias[(jj * 2 + dir) * 8 + hh];
  f32x16 S[2]; zero16(S[0]); zero16(S[1]);
  const size_t sidx = ((size_t)(((cid.b * 2 + jj) * 2 + dir) * 8 + hh)) * 4096;
  { const int tid = tid0, lane = tid & 63, wave = tid >> 6, r = lane & 31, h = lane >> 5;
  if (ROLE != 1 && wave < 2 && cid.lat) {
    const int vh = wave & 1;
#pragma unroll
    for (int dt = 0; dt < 2; ++dt)
#pragma unroll
      for (int i = 0; i < 16; ++i) S[dt][i] = p.state_d[sidx + (dt * 32 + crow(i, h)) * 64 + vh * 32 + r];
  }
  }
  u16* CW = (u16*)(smem + 80640);
  __syncthreads();
  for (int i = tid0; i < 576; i += 256) { const int tap = i / 192, c2 = i - tap * 192; const int wh = c2 >> 6, dd = c2 & 63;
    CW[i] = f2bf(p.d_conv[(size_t)jj * 3 * 1536 + tap * 1536 + wh * 512 + hh * 64 + dd]); }
  for (int step_ = k0; step_ < cid.nch; step_ += kstep) {
    int step = step_;
    asm volatile("" : "+v"(step));
    if (ROLE == 1) wait_ge(done, step_ - RING + 1, tid0);
    if (ROLE == 2) wait_ge(ready + step_, 1, tid0);
    __syncthreads();
    if (ROLE == 2) { copy_in(smem, slots + (size_t)(step_ % RING) * SLOT_BYTES, IMG, tid0); __syncthreads(); if (tid0 == 0) __hip_atomic_store(done, step_ + 1, __ATOMIC_RELAXED, __HIP_MEMORY_SCOPE_AGENT); }
    if (ROLE != 2) {
    {const int tid = opq(tid0), lane = tid & 63, wave = __builtin_amdgcn_readfirstlane(tid >> 6), r = lane & 31, h = lane >> 5, vh = wave & 1; (void)r; (void)h; (void)vh; (void)lane;
    if (wave == 0) {
      const int tok = tokof(cid, step, lane);
      const float da = bf2f(p.proj[(size_t)tok * ODN + 2304 + dir * 8 + hh]);
      const float db = bf2f(p.proj[(size_t)tok * ODN + 2320 + dir * 8 + hh]);
      const float x = da + dtb;
      const float sp = x > 20.f ? x : __logf(1.f + __expf(x));
      float G = -aexp * sp;
#pragma unroll
      for (int o = 1; o < 64; o <<= 1) { const float t = __int_as_float(__builtin_amdgcn_ds_bpermute((lane - o) << 2, __float_as_int(G))); if (lane >= o) G += t; }
      Gs[lane] = G; Bt[lane] = 1.f / (1.f + __expf(-db));
    }
    {
      const int c = tid >> 2, sg = tid & 3;
      const int tok = tokof(cid, step, c);
      const int pos = tok - cid.base;
      const bool hp = pos > 0, hn_ = pos < cid.T - 1;
#pragma unroll 1
      for (int wh = 0; wh < 3; ++wh) {
        const int ch0 = wh * 512 + hh * 64 + sg * 16;
        const u16* cur = p.proj + (size_t)tok * ODN + 768 + ch0;
        float y[16];
        float ss = 0.f;
#pragma unroll
        for (int hf = 0; hf < 2; ++hf) {
          const bf16x8 xc = *(const bf16x8*)(cur + hf * 8);
          bf16x8 xp, xn;
#pragma unroll
          for (int e = 0; e < 8; ++e) { xp[e] = 0; xn[e] = 0; }
          if (hp) xp = *(const bf16x8*)(cur - ODN + hf * 8);
          if (hn_) xn = *(const bf16x8*)(cur + ODN + hf * 8);
#pragma unroll
          for (int e = 0; e < 8; ++e) {
            const int ch = wh * 64 + sg * 16 + hf * 8 + e;
            float v = bf2f(CW[ch]) * bf2f((u16)xp[e]) + bf2f(CW[192 + ch]) * bf2f((u16)xc[e]) + bf2f(CW[384 + ch]) * bf2f((u16)xn[e]);
            v = v / (1.f + __expf(-v));
            y[hf * 8 + e] = v; ss += v * v;
          }
        }
        ss += shx(ss, lane, 1); ss += shx(ss, lane, 2);
        const float rn = rsqrtf(ss + 1e-6f);
        if (wh == 0) {
#pragma unroll
          for (int e = 0; e < 16; ++e) Qn[c * 72 + sg * 16 + e] = f2bf(y[e] * rn * 0.125f);
        } else if (wh == 1) {
#pragma unroll
          for (int e = 0; e < 16; ++e) { const u16 kb = f2bf(y[e] * rn); Kn[c * 72 + sg * 16 + e] = kb; Kt[(sg * 16 + e) * 72 + c] = kb; }
        } else {
#pragma unroll
          for (int e = 0; e < 16; ++e) Wv[c * 65 + sg * 16 + e] = y[e];
        }
      }
    }
    }
    __syncthreads();
    {const int tid = opq(tid0), lane = tid & 63, wave = __builtin_amdgcn_readfirstlane(tid >> 6), r = lane & 31, h = lane >> 5, vh = wave & 1; (void)r; (void)h; (void)vh; (void)lane;
    if (wave < 2) {
      f32x16 akk[2], aqk[2]; zero16(akk[0]); zero16(akk[1]); zero16(aqk[0]); zero16(aqk[1]);
#pragma unroll
      for (int ks = 0; ks < 4; ++ks) {
        const bf16x8 bk = *(const bf16x8*)(Kn + (vh * 32 + r) * 72 + ks * 16 + 8 * h);
#pragma unroll
        for (int ct = 0; ct < 2; ++ct) {
          const bf16x8 ak = *(const bf16x8*)(Kn + (ct * 32 + r) * 72 + ks * 16 + 8 * h);
          const bf16x8 aq = *(const bf16x8*)(Qn + (ct * 32 + r) * 72 + ks * 16 + 8 * h);
          akk[ct] = MFMA(ak, bk, akk[ct]);
          aqk[ct] = MFMA(aq, bk, aqk[ct]);
        }
      }
      const int s = vh * 32 + r;
      const float Gss = Gs[s];
#pragma unroll
      for (int ct = 0; ct < 2; ++ct)
#pragma unroll
        for (int g4 = 0; g4 < 4; ++g4) {
          const int c0 = ct * 32 + 8 * g4 + 4 * h;
          const float4 gv4 = *(const float4*)(Gs + c0), bv4 = *(const float4*)(Bt + c0);
          float4 val;
#pragma unroll
          for (int e = 0; e < 4; ++e) {
            const int c = c0 + e;
            const float Gc = e == 0 ? gv4.x : e == 1 ? gv4.y : e == 2 ? gv4.z : gv4.w;
            const float Bc = e == 0 ? bv4.x : e == 1 ? bv4.y : e == 2 ? bv4.z : bv4.w;
            const float gam = __expf(fminf(Gc - Gss, 0.f));
            const float av = (s < c) ? akk[ct][4 * g4 + e] * Bc * gam : 0.f;
            if (e == 0) val.x = av; else if (e == 1) val.y = av; else if (e == 2) val.z = av; else val.w = av;
            AQK[c * 72 + s] = f2bf((s <= c) ? aqk[ct][4 * g4 + e] * gam : 0.f);
          }
          *(float4*)(At + s * 68 + c0) = val;
        }
    }
    }
    __syncthreads();
    {const int tid = opq(tid0), lane = tid & 63, wave = __builtin_amdgcn_readfirstlane(tid >> 6), r = lane & 31, h = lane >> 5, vh = wave & 1; (void)r; (void)h; (void)vh; (void)lane;
    if (wave < 2) {
      const bool isv = wave == 0;
      const int col = lane;
#pragma unroll 1
      for (int bi = 0; bi < 4; ++bi) {
        float acc[16];
#pragma unroll
        for (int ci = 0; ci < 16; ++ci) {
          const int c = 16 * bi + ci;
          acc[ci] = isv ? Wv[c * 65 + col] * Bt[c] : bf2f(Kn[c * 72 + col]) * Bt[c] * __expf(Gs[c]);
        }
#pragma unroll 8
        for (int s2 = 0; s2 < 16 * bi; ++s2) {
          const float xs = isv ? Wv[s2 * 65 + col] : bf2f(KC[s2 * 72 + col]);
          const float4* a4 = (const float4*)(At + s2 * 68 + 16 * bi);
#pragma unroll
          for (int q = 0; q < 4; ++q) {
            const float4 a = a4[q];
            acc[4 * q] -= a.x * xs; acc[4 * q + 1] -= a.y * xs; acc[4 * q + 2] -= a.z * xs; acc[4 * q + 3] -= a.w * xs;
          }
        }
#pragma unroll
        for (int ci = 0; ci < 16; ++ci) {
          const float x = acc[ci];
          const float* arow = At + (16 * bi + ci) * 68 + 16 * bi;
#pragma unroll
          for (int cj = ci + 1; cj < 16; ++cj) acc[cj] -= arow[cj] * x;
          if (isv) Wv[(16 * bi + ci) * 65 + col] = x; else KC[(16 * bi + ci) * 72 + col] = f2bf(x);
        }
      }
    }
    }
    __syncthreads();
    }
    if (ROLE == 1) { copy_out(smem, slots + (size_t)(step_ % RING) * SLOT_BYTES, IMG, tid0); publish(ready + step_, 1, tid0); continue; }
    {const int tid = opq(tid0), lane = tid & 63, wave = __builtin_amdgcn_readfirstlane(tid >> 6), r = lane & 31, h = lane >> 5, vh = wave & 1; (void)r; (void)h; (void)vh; (void)lane;
    if (wave < 2) {
      f32x16 kS[2], qS[2]; zero16(kS[0]); zero16(kS[1]); zero16(qS[0]); zero16(qS[1]);
#pragma unroll
      for (int dt = 0; dt < 2; ++dt) {
        const bf16x8 xs0 = packs<0>(S[dt]), xs1 = packs<1>(S[dt]);
#pragma unroll
        for (int ct = 0; ct < 2; ++ct) {
          kS[ct] = MFMA(ld2x4(KC + (ct * 32 + r) * 72 + dt * 32 + 4 * h), xs0, kS[ct]);
          kS[ct] = MFMA(ld2x4(KC + (ct * 32 + r) * 72 + dt * 32 + 16 + 4 * h), xs1, kS[ct]);
          qS[ct] = MFMA(ld2x4(Qn + (ct * 32 + r) * 72 + dt * 32 + 4 * h), xs0, qS[ct]);
          qS[ct] = MFMA(ld2x4(Qn + (ct * 32 + r) * 72 + dt * 32 + 16 + 4 * h), xs1, qS[ct]);
        }
      }
      f32x16 vn[2], o[2];
      const float Glast = Gs[63];
#pragma unroll
      for (int ct = 0; ct < 2; ++ct)
#pragma unroll
        for (int i = 0; i < 16; ++i) {
          const int c = ct * 32 + crow(i, h);
          vn[ct][i] = Wv[c * 65 + vh * 32 + r] - kS[ct][i];
          o[ct][i] = qS[ct][i] * __expf(Gs[c]);
        }
#pragma unroll
      for (int st = 0; st < 2; ++st) {
        const bf16x8 xs0 = packs<0>(vn[st]), xs1 = packs<1>(vn[st]);
#pragma unroll
        for (int ct = 0; ct < 2; ++ct) {
          o[ct] = MFMA(ld2x4(AQK + (ct * 32 + r) * 72 + st * 32 + 4 * h), xs0, o[ct]);
          o[ct] = MFMA(ld2x4(AQK + (ct * 32 + r) * 72 + st * 32 + 16 + 4 * h), xs1, o[ct]);
        }
      }
      const float dl = __expf(Glast);
#pragma unroll
      for (int st = 0; st < 2; ++st) {
        asm volatile("" ::: "memory");
#pragma unroll
        for (int i = 0; i < 16; ++i) vn[st][i] *= __expf(Glast - Gs[st * 32 + crow(i, h)]);
      }
      asm volatile("" ::: "memory");
#pragma unroll
      for (int dt = 0; dt < 2; ++dt)
#pragma unroll
        for (int i = 0; i < 16; ++i) S[dt][i] *= dl;
#pragma unroll
      for (int st = 0; st < 2; ++st) {
        const bf16x8 xs0 = packs<0>(vn[st]), xs1 = packs<1>(vn[st]);
#pragma unroll
        for (int dt = 0; dt < 2; ++dt) {
          S[dt] = MFMA(ld2x4(Kt + (dt * 32 + r) * 72 + st * 32 + 4 * h), xs0, S[dt]);
          S[dt] = MFMA(ld2x4(Kt + (dt * 32 + r) * 72 + st * 32 + 16 + 4 * h), xs1, S[dt]);
        }
      }
#pragma unroll
      for (int ct = 0; ct < 2; ++ct)
#pragma unroll
        for (int i = 0; i < 16; ++i) At[(ct * 32 + crow(i, h)) * 68 + vh * 32 + r] = o[ct][i];
    }
    }
    __syncthreads();
    {
      const int tid = opq(tid0);
      const int c = tid >> 2, sg = tid & 3;
      const int tok = tokof(cid, step, c);
      u16* dst = (dir ? p.ot1 + (size_t)tok * 512 + hh * 64 : p.hn + (size_t)tok * 1024 + 512 + hh * 64) + sg * 16;
      bf16x8 w0, w1;
#pragma unroll
      for (int e = 0; e < 8; ++e) { w0[e] = (short)f2bf(At[c * 68 + sg * 16 + e]); w1[e] = (short)f2bf(At[c * 68 + sg * 16 + 8 + e]); }
      *(bf16x8*)dst = w0; *(bf16x8*)(dst + 8) = w1;
    }
  }
  {const int tid = opq(tid0), lane = tid & 63, wave = __builtin_amdgcn_readfirstlane(tid >> 6), r = lane & 31, h = lane >> 5, vh = wave & 1; (void)r; (void)h; (void)vh; (void)lane;
  if (wave < 2 && !cid.lat) {
#pragma unroll
    for (int dt = 0; dt < 2; ++dt)
#pragma unroll
      for (int i = 0; i < 16; ++i) p.out[OFF_SD + sidx + (dt * 32 + crow(i, h)) * 64 + vh * 32 + r] = S[dt][i];
  }
}
}

DI void mixer_phase(const P* __restrict__ gp, int l, char* smem) {
  const P& p = *gp;
  const bool even = !(l & 1); const int jj = l >> 1;
  const bool teams = gridDim.x >= 512;
  if (teams) {
    const int bid = blockIdx.x;
    if (bid < 384) {
      if (bid < 128) { if (even) gla_chain<2>(gp, jj, bid, smem, 0, 1); else delta_chain<2>(gp, jj, bid, smem, 0, 1); }
      else { const int ch = (bid - 128) & 127, k = (bid - 128) >> 7; if (even) gla_chain<1>(gp, jj, ch, smem, k, 2); else delta_chain<1>(gp, jj, ch, smem, k, 2); }
    }
  }
  const int first = teams ? 128 : 0;
  const int total = 384 + 2048 + 256;
  int* s_item = (int*)(smem + SMEM_BYTES - 16);
  int* cntp = uni(p.cnt) + l;
  for (;;) {
    __syncthreads();
    if (opq(threadIdx.x) == 0) *s_item = atomicAdd(cntp, 1) + first;
    __syncthreads();
    const int item = __builtin_amdgcn_readfirstlane(*s_item);
    if (item >= total) break;
    if (item < 384) { if (even) gla_chain<0>(gp, jj, item, smem, 0, 1); else delta_chain<0>(gp, jj, item, smem, 0, 1); }
    else if (item < 384 + 2048) { if (even) attn_item<1>(gp, jj, item - 384, smem); else attn_item<3>(gp, jj, item - 384, smem); }
    else { if (even) attn_item<0>(gp, jj, item - 384 - 2048, smem); else attn_item<2>(gp, jj, item - 384 - 2048, smem); }
  }
}

DI void finalize_phase(const P* __restrict__ gp, int l) {
  const P& p = *gp;
  const bool even = !(l & 1); const int jj = l >> 1;
  int tid_ = threadIdx.x; asm volatile("" : "+v"(tid_)); const int tid = tid_;
  const int tk = tid >> 5, hh = (tid >> 2) & 7, sg = tid & 3;
  const int PS = even ? EVN : ODN; const int zcol = even ? 3104 : 2336;
  for (int item = blockIdx.x; item < NT_ / 8; item += gridDim.x) {
    const size_t tok = (size_t)item * 8 + tk;
    u16* a = p.hn + tok * 1024 + 512 + hh * 64 + sg * 16;
    const u16* bsrc = p.ot1 + tok * 512 + hh * 64 + sg * 16;
    const u16* zs = p.proj + tok * PS + zcol + hh * 64 + sg * 16;
    float o[16]; float ss = 0.f;
#pragma unroll
    for (int hf = 0; hf < 2; ++hf) {
      const bf16x8 x0 = *(const bf16x8*)(a + hf * 8), x1 = *(const bf16x8*)(bsrc + hf * 8);
#pragma unroll
      for (int e = 0; e < 8; ++e) { const float v = bf2f((u16)x0[e]) + bf2f((u16)x1[e]); o[hf * 8 + e] = v; ss += v * v; }
    }
    ss += shx(ss, tid & 63, 1); ss += shx(ss, tid & 63, 2);
    const float rstd = rsqrtf(ss * (1.f / 64.f) + 1e-6f);
    const float* ng = even ? p.b_norm_g + jj * 512 + hh * 64 + sg * 16 : p.d_norm_g + jj * 64 + sg * 16;
#pragma unroll
    for (int hf = 0; hf < 2; ++hf) {
      const bf16x8 z = *(const bf16x8*)(zs + hf * 8);
      bf16x8 w;
#pragma unroll
      for (int e = 0; e < 8; ++e) { const float zz = bf2f((u16)z[e]); w[e] = (short)f2bf(o[hf * 8 + e] * rstd * ng[hf * 8 + e] * siluf(zz)); }
      *(bf16x8*)(a + hf * 8) = w;
    }
  }
}

DI void run_phase(const P* __restrict__ gp, int ph, char* smem) {
  const P& p = *gp;
  if (ph == 0) { prep_phase(gp, smem); return; }
  if (ph == NPH - 1) { norm_phase(gp, 0, 0, false, true); return; }
  const int l = (ph - 1) >> 3, s = (ph - 1) & 7;
  const bool even = !(l & 1);
  const u16* W = uni(p.wt) + (size_t)l * LW;
  const u16* hnp = uni(p.hn); const u16* projp = uni(p.proj);
  switch (s) {
    case 0: norm_phase(gp, l, 0, l == 0, false); break;
    case 1: gemm_phase<EPI_PROJ>(gp, l, smem, hnp, 1024, W + WO_IN, 1024, 1024, 288, even ? 29 : 23, 0); break;
    case 2: mixer_phase(gp, l, smem); break;
    case 3: finalize_phase(gp, l); break;
    case 4: gemm_phase<EPI_RES>(gp, l, smem, hnp, 1024, W + WO_OUT, 1024, 1024, 288, 8, 2); break;
    case 5: norm_phase(gp, l, 1, false, false); break;
    case 6: gemm_phase<EPI_FFN>(gp, l, smem, hnp, 1024, W + WO_UP, 1024, 1024, 312, 44, 0); break;
    case 7: gemm_phase<EPI_RES>(gp, l, smem, projp, 2816, W + WO_DN, 2816, 2816, 288, 8, 5); break;
  }
}

__global__ void __launch_bounds__(256, 2) mk(P p, P* gp, int ph0, int ph1) {
  __shared__ __attribute__((aligned(16))) char smem[SMEM_BYTES];
  if (threadIdx.x == 0) *gp = p;
  __threadfence();
  __syncthreads();
  if (ph1 - ph0 > 1) {
    cg::grid_group grid = cg::this_grid();
    for (int ph = ph0; ph < ph1; ++ph) {
      run_phase(gp, ph, smem);
      if (ph + 1 < ph1) grid.sync();
    }
  } else {
    run_phase(gp, ph0, smem);
  }
}

extern "C" void kernel_launch(void* const* d_in, const int* in_sizes, int n_in, void* d_out, int out_size, void* d_ws, size_t ws_size,
                              hipStream_t stream) {
  P p{};
  const float** f = (const float**)&p;
  for (int i = 0; i < 31; ++i) f[i] = (const float*)d_in[i];
  p.out = (float*)d_out;
  char* ws = (char*)d_ws;
  size_t off = 0;
  p.hn = (u16*)(ws + off); off += (size_t)NT_ * 1024 * 2;
  p.proj = (u16*)(ws + off); off += (size_t)NT_ * EVN * 2;
  p.ot1 = (u16*)(ws + off); off += (size_t)NT_ * 512 * 2;
  p.wt = (u16*)(ws + off); off += 4 * LW * 2;
  p.mods = (float*)(ws + off); off += 4 * 9 * 6144 * 4;
  p.rope = (float*)(ws + off); off += 64 * 16 * 2 * 4;
  P* gp = (P*)(ws + off); off += 4096;
  p.cnt = (int*)(ws + off); off += 256;
  p.flags = (int*)(ws + off); off += 4 * 8320 * 4;
  off = (off + 255) & ~(size_t)255;
  p.ring = ws + off; off += (size_t)128 * RING * SLOT_BYTES;
  static int grid_blocks = 0;
  if (!grid_blocks) {
    int dev = 0, cus = 0, per_cu = 0;
    hipGetDevice(&dev);
    hipDeviceGetAttribute(&cus, hipDeviceAttributeMultiprocessorCount, dev);
    hipOccupancyMaxActiveBlocksPerMultiprocessor(&per_cu, mk, 256, 0);
    if (per_cu < 1) per_cu = 1;
    if (per_cu > 2) per_cu = 2;
    grid_blocks = cus * per_cu;
  }
#if MK_MULTI
  for (int ph = 0; ph < NPH; ++ph) {
    int a = ph, b = ph + 1;
    hipLaunchKernelGGL(mk, dim3(grid_blocks), dim3(256), 0, stream, p, gp, a, b);
  }
#else
  int ph0 = 0, ph1 = NPH;
  void* args[] = {&p, &gp, &ph0, &ph1};
  hipError_t e = hipLaunchCooperativeKernel((void*)mk, dim3(grid_blocks), dim3(256), args, 0, stream);
  if (e != hipSuccess) fprintf(stderr, "cooperative launch failed: %s (grid %d)\n", hipGetErrorString(e), grid_blocks);
#endif
}
```

```cpp
#include <hip/hip_runtime.h>
#include <hip/hip_cooperative_groups.h>
#include <cstdio>
namespace cg = cooperative_groups;

#ifndef MK_MULTI
#define MK_MULTI 0
#endif

#define DI __device__ __forceinline__
#define DN __device__ __noinline__
typedef unsigned short u16;
typedef __attribute__((ext_vector_type(8))) short bf16x8;
typedef __attribute__((ext_vector_type(4))) short s16x4;
typedef __attribute__((ext_vector_type(16))) float f32x16;
#define MFMA(a, b, c) __builtin_amdgcn_mfma_f32_32x32x16_bf16((a), (b), (c), 0, 0, 0)

static constexpr int NP_ = 4096, NT_ = 36864;
static constexpr int EVN = 3616, ODN = 2848;
static constexpr size_t OFF_AK = 37748736, OFF_AV = 41943040, OFF_SB = 46137344, OFF_CK = 48234496, OFF_CV = 49283072, OFF_SD = 50331648;
static constexpr size_t LW = 13500416, WO_UP = 0, WO_DN = 5767168, WO_IN = 8650752, WO_OUT = 12451840;
static constexpr int NPH = 34;
static constexpr int SMEM_BYTES = 80 * 1024;

struct P {
  const float *x_prompt, *x_sample, *cache_a_k, *cache_a_v, *state_b, *cache_c_k, *cache_c_v, *state_d, *c, *c_ctx, *ada_w, *ada_b,
      *norm1_g, *norm2_g, *ffn_up, *ffn_conv, *ffn_down, *ev_w_in, *ev_w_out, *a_rpb, *b_w_g2, *b_b_g, *b_norm_g, *od_w_in, *od_w_out,
      *c_sink, *d_conv, *d_a_log, *d_dt_bias, *d_norm_g, *final_g;
  float* out;
  u16 *hn, *proj, *ot1, *wt;
  float *mods, *rope;
  int* cnt;
  int* flags;
  char* ring;
};

DI u16 f2bf(float x) { unsigned u = __float_as_uint(x); u += 0x7fffu + ((u >> 16) & 1u); return (u16)(u >> 16); }
DI float bf2f(u16 b) { return __uint_as_float(((unsigned)b) << 16); }
DI int crow(int i, int h) { return (i & 3) + 8 * (i >> 2) + 4 * h; }
template <int S> DI bf16x8 packs(const f32x16& x) {
  bf16x8 v;
#pragma unroll
  for (int j = 0; j < 8; ++j) v[j] = (short)f2bf(x[8 * S + j]);
  return v;
}
DI bf16x8 ld2x4(const u16* p) {
  s16x4 lo = *(const s16x4*)p, hi = *(const s16x4*)(p + 8);
  return __builtin_shufflevector(lo, hi, 0, 1, 2, 3, 4, 5, 6, 7);
}
DI float siluf(float x) { return x / (1.f + __expf(-x)); }
DI int opq(int x) { asm volatile("" : "+v"(x)); return x; }
DI float shx(float v, int lane, int o) { return __int_as_float(__builtin_amdgcn_ds_bpermute((lane ^ o) << 2, __float_as_int(v))); }
template <class T> DI T* uni(T* q) {
  const unsigned long long v = (unsigned long long)q;
  const unsigned lo = __builtin_amdgcn_readfirstlane((unsigned)v), hi = __builtin_amdgcn_readfirstlane((unsigned)(v >> 32));
  return (T*)(((unsigned long long)hi << 32) | lo);
}
DI void zero16(f32x16& a) {
#pragma unroll
  for (int i = 0; i < 16; ++i) a[i] = 0.f;
}

DI void prep_phase(const P* __restrict__ gp, char* smem) {
  const P& p = *gp;
  int tid_ = threadIdx.x; asm volatile("" : "+v"(tid_)); const int tid = tid_;
  const int NWT = 4 * (1408 + 704 + 256) + 2 * (928 + 736);
  const int NADA = 384;
  const int total = NWT + NADA + 1;
  for (int item = blockIdx.x; item < total; item += gridDim.x) {
    if (item < NWT) {
      int rem = item; const float* src = nullptr; u16* dst = nullptr; int K = 0, N = 0, NPd = 0;
      for (int l = 0; l < 4; ++l) {
        const int jj = l >> 1; const bool ev = !(l & 1);
        const int nin = ev ? 928 : 736;
        if (rem < 1408) { src = p.ffn_up + (size_t)l * 1024 * 5632; dst = p.wt + l * LW + WO_UP; K = 1024; N = 5632; NPd = 5632; break; }
        rem -= 1408;
        if (rem < 704) { src = p.ffn_down + (size_t)l * 2816 * 1024; dst = p.wt + l * LW + WO_DN; K = 2816; N = 1024; NPd = 1024; break; }
        rem -= 704;
        if (rem < nin) { src = ev ? p.ev_w_in + (size_t)jj * 1024 * EVN : p.od_w_in + (size_t)jj * 1024 * ODN; dst = p.wt + l * LW + WO_IN; K = 1024; N = ev ? EVN : ODN; NPd = ev ? 3712 : 2944; break; }
        rem -= nin;
        if (rem < 256) { src = (ev ? p.ev_w_out : p.od_w_out) + (size_t)jj * 1024 * 1024; dst = p.wt + l * LW + WO_OUT; K = 1024; N = 1024; NPd = 1024; break; }
        rem -= 256;
      }
      const int ntn = NPd >> 6;
      const int tk = rem / ntn, tn = rem - tk * ntn;
      const int scol0 = (N == 5632) ? ((tn & 1) * 2816 + (tn >> 1) * 64) : tn * 64;
      float* T = (float*)smem;
      __syncthreads();
#pragma unroll
      for (int i = 0; i < 16; ++i) {
        const int k = i * 4 + (tid >> 6), n = tid & 63;
        const int gn = scol0 + n;
        T[k * 65 + n] = (gn < N) ? src[(size_t)(tk * 64 + k) * N + gn] : 0.f;
      }
      __syncthreads();
#pragma unroll
      for (int i = 0; i < 2; ++i) {
        const int q = tid + 256 * i; const int n = q & 63, kc = q >> 6;
        const int pn = tn * 64 + n; const int nt32 = pn >> 5, rr = pn & 31;
        const int kstep = tk * 4 + (kc >> 1), hh = kc & 1;
        bf16x8 w;
#pragma unroll
        for (int j = 0; j < 8; ++j) w[j] = (short)f2bf(T[(kc * 8 + j) * 65 + n]);
        *(bf16x8*)(dst + ((size_t)(nt32 * (K >> 4) + kstep) * 64 + hh * 32 + rr) * 8) = w;
      }
    } else if (item < NWT + NADA) {
      const int it = item - NWT; const int l = it / 96, cgp = it - l * 96; const int n0 = cgp * 64;
      float* sc = (float*)smem;
      float* red = sc + 9 * 1024;
      __syncthreads();
      for (int idx = tid; idx < 9 * 1024; idx += 256) {
        const int ci = idx >> 10, k = idx & 1023;
        const float x = ci < 8 ? p.c[ci * 1024 + k] : p.c_ctx[k];
        sc[idx] = x / (1.f + expf(-x));
      }
      __syncthreads();
      const int wave = tid >> 6, lane = tid & 63;
      float acc[9];
#pragma unroll
      for (int ci = 0; ci < 9; ++ci) acc[ci] = 0.f;
      const float* wp = p.ada_w + ((size_t)l * 1024 + wave * 256) * 6144 + n0 + lane;
#pragma unroll 8
      for (int k = 0; k < 256; ++k) {
        const float wv = wp[(size_t)k * 6144];
#pragma unroll
        for (int ci = 0; ci < 9; ++ci) acc[ci] += sc[ci * 1024 + wave * 256 + k] * wv;
      }
#pragma unroll
      for (int ci = 0; ci < 9; ++ci) red[(wave * 9 + ci) * 64 + lane] = acc[ci];
      __syncthreads();
      for (int idx = tid; idx < 576; idx += 256) {
        const int ci = idx >> 6, col = idx & 63;
        const float s = red[(0 * 9 + ci) * 64 + col] + red[(1 * 9 + ci) * 64 + col] + red[(2 * 9 + ci) * 64 + col] + red[(3 * 9 + ci) * 64 + col];
        p.mods[(size_t)(l * 9 + ci) * 6144 + n0 + col] = s + p.ada_b[l * 6144 + n0 + col];
      }
    } else {
      if (tid < 8) p.cnt[tid] = 0;
      for (int i = tid; i < 4 * 8320; i += 256) p.flags[i] = 0;
      for (int idx = tid; idx < 1024; idx += 256) {
        const int pos = idx >> 4, fi = idx & 15;
        const float inv = powf(10000.f, -(float)fi / 16.f);
        const float ang = (float)pos * inv;
        p.rope[idx * 2] = cosf(ang); p.rope[idx * 2 + 1] = sinf(ang);
      }
    }
  }
}

DI void norm_phase(const P* __restrict__ gp, int l, int which, bool first, bool fin) {
  const P& p = *gp;
  int tid_ = threadIdx.x; asm volatile("" : "+v"(tid_)); const int tid = tid_, lane = tid & 63, wave = tid >> 6;
  for (int item = blockIdx.x; item < NT_ / 4; item += gridDim.x) {
    const int tok = item * 4 + wave;
    const float* src = first ? (tok < NP_ ? p.x_prompt + (size_t)tok * 1024 : p.x_sample + (size_t)(tok - NP_) * 1024) : p.out + (size_t)tok * 1024;
    float4 v[4];
    float ss = 0.f;
#pragma unroll
    for (int i = 0; i < 4; ++i) { v[i] = ((const float4*)src)[lane + 64 * i]; ss += v[i].x * v[i].x + v[i].y * v[i].y + v[i].z * v[i].z + v[i].w * v[i].w; }
#pragma unroll
    for (int o = 32; o >= 1; o >>= 1) ss += shx(ss, lane, o);
    const float rstd = rsqrtf(ss * (1.f / 1024.f) + 1e-6f);
    if (fin) {
#pragma unroll
      for (int i = 0; i < 4; ++i) {
        const float4 g = ((const float4*)p.final_g)[lane + 64 * i];
        float4 y; y.x = v[i].x * rstd * g.x; y.y = v[i].y * rstd * g.y; y.z = v[i].z * rstd * g.z; y.w = v[i].w * rstd * g.w;
        ((float4*)(p.out + (size_t)tok * 1024))[lane + 64 * i] = y;
      }
    } else {
      const int ci = tok < NP_ ? 8 : (tok - NP_) >> 12;
      const float* md = p.mods + (size_t)(l * 9 + ci) * 6144 + which * 3072;
      const float* gp = (which ? p.norm2_g : p.norm1_g) + l * 1024;
#pragma unroll
      for (int i = 0; i < 4; ++i) {
        const float4 g = ((const float4*)gp)[lane + 64 * i];
        const float4 sh = ((const float4*)md)[lane + 64 * i];
        const float4 sc = ((const float4*)(md + 1024))[lane + 64 * i];
        ushort4 o;
        o.x = f2bf(v[i].x * rstd * g.x * (1.f + sc.x) + sh.x);
        o.y = f2bf(v[i].y * rstd * g.y * (1.f + sc.y) + sh.y);
        o.z = f2bf(v[i].z * rstd * g.z * (1.f + sc.z) + sh.z);
        o.w = f2bf(v[i].w * rstd * g.w * (1.f + sc.w) + sh.w);
        ((ushort4*)(p.hn + (size_t)tok * 1024))[lane + 64 * i] = o;
        if (first) ((float4*)(p.out + (size_t)tok * 1024))[lane + 64 * i] = v[i];
      }
    }
  }
}

DI uint4 ldsel(const u16* pv, const u16* safe, unsigned ok) {
  uint4 t = *(const uint4*)(ok ? pv : safe);
  if (!ok) { t.x = 0; t.y = 0; t.z = 0; t.w = 0; }
  return t;
}
enum { EPI_PROJ = 0, EPI_RES = 1, EPI_FFN = 2 };

template <int EPI>
DI void gemm_phase(const P* __restrict__ gp, int l, char* smem, const u16* __restrict__ A, int lda, const u16* __restrict__ B, int ldb, int K, int MT,
                   int NTn, int gsel) {
  const P& p = *gp;
  u16* As = (u16*)smem;
  int tid_ = threadIdx.x; asm volatile("" : "+v"(tid_)); const int tid = tid_, lane = tid & 63, wave = tid >> 6, r = lane & 31, h = lane >> 5;
  const int wm = wave & 1, wn = wave >> 1;
  const int KT = K >> 6;
  const bool even = !(l & 1); const int jj = l >> 1;
  const int ntiles = MT * NTn;
  const int nlb = gridDim.x >> 3, xcd = blockIdx.x & 7, lb = blockIdx.x >> 3;
  for (int it = 0;; ++it) {
    const int g = (it * 8 + xcd) * nlb + lb;
    if (g >= ntiles) break;
    const int SM = nlb >> 3;
    const int band = g / (SM * NTn); const int rem = g - band * SM * NTn;
    const int nt = rem / SM, mt = band * SM + (rem - nt * SM);
    int seqbase = 0, L = 0, tin0 = 0;
    if (EPI == EPI_FFN) {
      if (mt < 48) { const int sq = mt / 3; L = 256; seqbase = sq * 256; tin0 = (mt - sq * 3) * 126; }
      else { const int m2 = mt - 48; const int sq = m2 / 33; L = 4096; seqbase = NP_ + sq * 4096; tin0 = (m2 - sq * 33) * 126; }
    }
    const int row0 = tid >> 3, kc0 = (tid & 7) * 8;
    const long arow0 = (EPI == EPI_FFN) ? (long)seqbase + tin0 - 1 + row0 : (long)mt * 128 + row0;
    const u16* abase = A + arow0 * lda + kc0;
    unsigned avalid = 0;
#pragma unroll
    for (int i = 0; i < 4; ++i) {
      if (EPI == EPI_FFN) { const int ts = tin0 - 1 + row0 + 32 * i; if (ts >= 0 && ts < L) avalid |= 1u << i; }
      else avalid |= 1u << i;
    }
    const u16* bb0 = B + ((size_t)((nt * 4 + wn * 2) * (K >> 4)) * 64 + lane) * 8;
    const size_t bts = (size_t)(K >> 4) * 512;
    f32x16 acc[2][2];
#pragma unroll
    for (int a = 0; a < 2; ++a)
#pragma unroll
      for (int b = 0; b < 2; ++b) zero16(acc[a][b]);
#define GLD_A(i, ko) ldsel(abase + (size_t)(32 * (i)) * lda + (ko), A, (avalid >> (i)) & 1u)
#define GLD_BF(dst, kt_) { const u16* q_ = bb0 + (size_t)(kt_) * 2048; \
      dst[0][0] = *(const bf16x8*)(q_); dst[0][1] = *(const bf16x8*)(q_ + 512); dst[0][2] = *(const bf16x8*)(q_ + 1024); dst[0][3] = *(const bf16x8*)(q_ + 1536); \
      dst[1][0] = *(const bf16x8*)(q_ + bts); dst[1][1] = *(const bf16x8*)(q_ + bts + 512); dst[1][2] = *(const bf16x8*)(q_ + bts + 1024); dst[1][3] = *(const bf16x8*)(q_ + bts + 1536); }
    uint4 ra0 = GLD_A(0, 0), ra1 = GLD_A(1, 0), ra2 = GLD_A(2, 0), ra3 = GLD_A(3, 0);
    uint4 sa0 = GLD_A(0, 64), sa1 = GLD_A(1, 64), sa2 = GLD_A(2, 64), sa3 = GLD_A(3, 64);
    bf16x8 bc[2][4], bn[2][4];
    GLD_BF(bc, 0);
    GLD_BF(bn, 1);
#define LSTORE(buf, A0, A1, A2, A3) { \
      u16* ad = As + (buf) * 9216 + row0 * 72 + kc0; \
      *(uint4*)(ad) = A0; *(uint4*)(ad + 32 * 72) = A1; *(uint4*)(ad + 64 * 72) = A2; *(uint4*)(ad + 96 * 72) = A3; }
#define COMPUTE(buf, BF) { \
      const u16* Ab = As + (buf) * 9216; \
      _Pragma("unroll") for (int ks = 0; ks < 4; ++ks) { \
        const bf16x8 a0 = *(const bf16x8*)(Ab + (wm * 64 + r) * 72 + ks * 16 + h * 8); \
        const bf16x8 a1 = *(const bf16x8*)(Ab + (wm * 64 + 32 + r) * 72 + ks * 16 + h * 8); \
        acc[0][0] = MFMA(a0, BF[0][ks], acc[0][0]); acc[0][1] = MFMA(a0, BF[1][ks], acc[0][1]); \
        acc[1][0] = MFMA(a1, BF[0][ks], acc[1][0]); acc[1][1] = MFMA(a1, BF[1][ks], acc[1][1]); } }
    LSTORE(0, ra0, ra1, ra2, ra3);
    ra0 = GLD_A(0, 128); ra1 = GLD_A(1, 128); ra2 = GLD_A(2, 128); ra3 = GLD_A(3, 128);
    __syncthreads();
    for (int kt = 0; kt < KT; kt += 2) {
      COMPUTE(0, bc);
      if (kt + 2 < KT) GLD_BF(bc, kt + 2);
      LSTORE(1, sa0, sa1, sa2, sa3);
      if (kt + 3 < KT) {
        const int ko = (kt + 3) * 64;
        sa0 = GLD_A(0, ko); sa1 = GLD_A(1, ko); sa2 = GLD_A(2, ko); sa3 = GLD_A(3, ko);
      }
      __syncthreads();
      COMPUTE(1, bn);
      if (kt + 3 < KT) GLD_BF(bn, kt + 3);
      if (kt + 2 < KT) {
        LSTORE(0, ra0, ra1, ra2, ra3);
        if (kt + 4 < KT) {
          const int ko = (kt + 4) * 64;
          ra0 = GLD_A(0, ko); ra1 = GLD_A(1, ko); ra2 = GLD_A(2, ko); ra3 = GLD_A(3, ko);
        }
      }
      __syncthreads();
    }
    if (EPI == EPI_PROJ) {
      const int N = even ? EVN : ODN;
#pragma unroll
      for (int tm = 0; tm < 2; ++tm)
#pragma unroll
        for (int tn = 0; tn < 2; ++tn) {
          const int col = nt * 128 + wn * 64 + tn * 32 + r;
          if (col < N) {
#pragma unroll
            for (int i = 0; i < 16; ++i) {
              const int row = mt * 128 + wm * 64 + tm * 32 + crow(i, h);
              const float v = acc[tm][tn][i];
              p.proj[(size_t)row * N + col] = f2bf(v);
              if (row < NP_) {
                const int b = row >> 8, t = row & 255, d = col & 63;
                if (even) {
                  if (col >= 512 && col < 1536) {
                    const int wh = (col - 512) >> 9, hh = ((col - 512) >> 6) & 7;
                    p.out[(wh ? OFF_AV : OFF_AK) + ((size_t)(((b * 2 + jj) * 8 + hh) * 256 + t)) * 64 + d] = v;
                  }
                } else {
                  if (col >= 512 && col < 768) {
                    const int wh = (col - 512) >> 7, kv = ((col - 512) >> 6) & 1;
                    p.out[(wh ? OFF_CV : OFF_CK) + ((size_t)(((b * 2 + jj) * 2 + kv) * 256 + t)) * 64 + d] = v;
                  }
                }
              }
            }
          }
        }
    } else if (EPI == EPI_RES) {
#pragma unroll
      for (int tm = 0; tm < 2; ++tm)
#pragma unroll
        for (int tn = 0; tn < 2; ++tn) {
          const int col = nt * 128 + wn * 64 + tn * 32 + r;
#pragma unroll
          for (int i = 0; i < 16; ++i) {
            const int row = mt * 128 + wm * 64 + tm * 32 + crow(i, h);
            const int ci = row < NP_ ? 8 : (row - NP_) >> 12;
            const float g = p.mods[(size_t)(l * 9 + ci) * 6144 + gsel * 1024 + col];
            float* xp = p.out + (size_t)row * 1024 + col;
            *xp = *xp + g * acc[tm][tn][i];
          }
        }
    } else {
      __syncthreads();
      float* U = (float*)smem;
#pragma unroll
      for (int tm = 0; tm < 2; ++tm)
#pragma unroll
        for (int tn = 0; tn < 2; ++tn)
#pragma unroll
          for (int i = 0; i < 16; ++i) U[(wm * 64 + tm * 32 + crow(i, h)) * 132 + wn * 64 + tn * 32 + r] = acc[tm][tn][i];
      __syncthreads();
      const float* cw = p.ffn_conv + (size_t)l * 3 * 5632;
      const int f = tid & 63, rg = tid >> 6; const int fg = nt * 64 + f;
      const float wa0 = cw[fg], wa1 = cw[5632 + fg], wa2 = cw[2 * 5632 + fg];
      const float wg0 = cw[2816 + fg], wg1 = cw[5632 + 2816 + fg], wg2 = cw[2 * 5632 + 2816 + fg];
      u16* act = p.proj;
      for (int rr = 1 + rg; rr <= 126; rr += 4) {
        const int ts = tin0 - 1 + rr;
        if (ts >= L) break;
        const float a = wa0 * U[(rr - 1) * 132 + f] + wa1 * U[rr * 132 + f] + wa2 * U[(rr + 1) * 132 + f];
        const float g = wg0 * U[(rr - 1) * 132 + 64 + f] + wg1 * U[rr * 132 + 64 + f] + wg2 * U[(rr + 1) * 132 + 64 + f];
        act[(size_t)(seqbase + ts) * 2816 + fg] = f2bf(a * siluf(g));
      }
      __syncthreads();
    }
  }
}

template <int MODE>
DI void attn_item(const P* __restrict__ gp, int jj, int it, char* smem) {
  const P& p = *gp;
  const u16* projp = uni(p.proj); u16* hnp = uni(p.hn); const float* ropep = uni(p.rope);
  u16* Ks = (u16*)smem; u16* Vt = Ks + 64 * 72; float* rpb_s = (float*)(Vt + 64 * 72);
  int tid_ = threadIdx.x; asm volatile("" : "+v"(tid_)); const int tid = tid_, lane = tid & 63, wave = tid >> 6, r = lane & 31, h = lane >> 5;
  constexpr bool EVENL = (MODE == 0 || MODE == 1);
  constexpr bool LAT = (MODE == 1 || MODE == 3);
  constexpr int PS = EVENL ? EVN : ODN;
  int b, hq, qb, tokbase;
  if (!LAT) { b = it >> 4; hq = (it >> 1) & 7; qb = it & 1; tokbase = b * 256; }
  else { b = it >> 8; hq = (it >> 5) & 7; qb = it & 31; tokbase = NP_ + b * 4096; }
  const int hk = EVENL ? hq : (hq >> 2);
  const int kcol = 512 + hk * 64, vcol = (EVENL ? 1024 : 640) + hk * 64, qcol = hq * 64;
  const int tq = qb * 128 + wave * 32 + r;
  const size_t qtok = (size_t)tokbase + tq;
  __syncthreads();
  if (MODE == 1) { for (int i = tid; i < 465; i += 256) rpb_s[i] = p.a_rpb[(size_t)(jj * 8 + hq) * 465 + i]; }
  bf16x8 qf[4];
#pragma unroll
  for (int s = 0; s < 4; ++s) qf[s] = *(const bf16x8*)(projp + qtok * PS + qcol + 16 * s + 8 * h);
  if (MODE == 3) {
    const int prow = tq >> 6, pcol = tq & 63;
#pragma unroll
    for (int half = 0; half < 2; ++half) {
      const int pos = half ? pcol : prow;
#pragma unroll
      for (int j = 0; j < 8; ++j) {
        const float cs = ropep[(pos * 16 + 8 * h + j) * 2], sn = ropep[(pos * 16 + 8 * h + j) * 2 + 1];
        const float x1 = bf2f((u16)qf[2 * half][j]), x2 = bf2f((u16)qf[2 * half + 1][j]);
        qf[2 * half][j] = (short)f2bf(x1 * cs - x2 * sn);
        qf[2 * half + 1][j] = (short)f2bf(x1 * sn + x2 * cs);
      }
    }
  }
  float m_run = -1e30f, l_run = 0.f;
  if (MODE == 2 || MODE == 3) { m_run = p.c_sink[jj * 8 + hq]; l_run = h == 0 ? 1.f : 0.f; }
  f32x16 ot[2]; zero16(ot[0]); zero16(ot[1]);
  int loc0 = 0, nloc = 0;
  if (MODE == 1) {
    const int qi0 = 2 * qb;
    const int rlo = min(max(qi0 - 4, 0), 56), rhi = min(max(qi0 + 1 - 4, 0), 56) + 7;
    loc0 = rlo; nloc = rhi - rlo + 1;
  } else if (MODE == 3) {
    loc0 = max(0, 2 * qb - 2); nloc = min(63, 2 * qb + 3) - loc0 + 1;
  }
  const int qi = tq >> 6, qw = tq & 63;
  const int r0w = min(max(qi - 4, 0), 56), c0w = min(max(qw - 8, 0), 48);
  const int key = tid >> 2, seg = tid & 3;
  for (int kb = 0; kb < 4 + nloc; ++kb) {
    const bool isctx = kb < 4;
    const int blk = isctx ? kb : loc0 + kb - 4;
    __syncthreads();
    {
      float kf[16], vf[16];
      if (LAT && isctx) {
        const float* kc = (MODE == 1) ? p.cache_a_k + ((size_t)((b * 2 + jj) * 8 + hk)) * 16384 : p.cache_c_k + ((size_t)((b * 2 + jj) * 2 + hk)) * 16384;
        const float* vc = (MODE == 1) ? p.cache_a_v + ((size_t)((b * 2 + jj) * 8 + hk)) * 16384 : p.cache_c_v + ((size_t)((b * 2 + jj) * 2 + hk)) * 16384;
        const float4* kp4 = (const float4*)(kc + (size_t)(blk * 64 + key) * 64 + seg * 16);
        const float4* vp4 = (const float4*)(vc + (size_t)(blk * 64 + key) * 64 + seg * 16);
#pragma unroll
        for (int e = 0; e < 4; ++e) {
          const float4 a = kp4[e], c = vp4[e];
          kf[4 * e] = a.x; kf[4 * e + 1] = a.y; kf[4 * e + 2] = a.z; kf[4 * e + 3] = a.w;
          vf[4 * e] = c.x; vf[4 * e + 1] = c.y; vf[4 * e + 2] = c.z; vf[4 * e + 3] = c.w;
        }
      } else {
        const u16* rowp = projp + ((size_t)tokbase + blk * 64 + key) * PS;
        const bf16x8 k0 = *(const bf16x8*)(rowp + kcol + seg * 16), k1 = *(const bf16x8*)(rowp + kcol + seg * 16 + 8);
        const bf16x8 v0 = *(const bf16x8*)(rowp + vcol + seg * 16), v1 = *(const bf16x8*)(rowp + vcol + seg * 16 + 8);
#pragma unroll
        for (int e = 0; e < 8; ++e) { kf[e] = bf2f((u16)k0[e]); kf[8 + e] = bf2f((u16)k1[e]); vf[e] = bf2f((u16)v0[e]); vf[8 + e] = bf2f((u16)v1[e]); }
        if (MODE == 3) {
          const bf16x8 p0 = *(const bf16x8*)(rowp + kcol + (seg ^ 1) * 16), p1 = *(const bf16x8*)(rowp + kcol + (seg ^ 1) * 16 + 8);
          const int pos = (seg & 2) ? key : blk;
#pragma unroll
          for (int e = 0; e < 16; ++e) {
            const float pr = bf2f((u16)(e < 8 ? p0[e & 7] : p1[e & 7]));
            const float cs = ropep[(pos * 16 + e) * 2], sn = ropep[(pos * 16 + e) * 2 + 1];
            kf[e] = (seg & 1) ? (pr * sn + kf[e] * cs) : (kf[e] * cs - pr * sn);
          }
        }
      }
      bf16x8 o0, o1;
#pragma unroll
      for (int e = 0; e < 8; ++e) { o0[e] = (short)f2bf(kf[e]); o1[e] = (short)f2bf(kf[8 + e]); }
      *(bf16x8*)(Ks + key * 72 + seg * 16) = o0;
      *(bf16x8*)(Ks + key * 72 + seg * 16 + 8) = o1;
#pragma unroll
      for (int e = 0; e < 16; ++e) Vt[(seg * 16 + e) * 72 + key] = f2bf(vf[e]);
    }
    __syncthreads();
    bool active = true;
    if (MODE == 1 && !isctx) active = (blk >= r0w && blk < r0w + 8);
    if (active) {
      f32x16 st[2]; zero16(st[0]); zero16(st[1]);
#pragma unroll
      for (int kt = 0; kt < 2; ++kt)
#pragma unroll
        for (int s = 0; s < 4; ++s) {
          const bf16x8 a = *(const bf16x8*)(Ks + (kt * 32 + r) * 72 + 16 * s + 8 * h);
          st[kt] = MFMA(a, qf[s], st[kt]);
        }
      float mx = m_run;
#pragma unroll
      for (int kt = 0; kt < 2; ++kt)
#pragma unroll
        for (int i = 0; i < 16; ++i) {
          float s = st[kt][i] * 0.125f;
          const int kk = kt * 32 + crow(i, h);
          if (MODE == 1 && !isctx) {
            const bool ok = (kk >= c0w && kk < c0w + 16);
            s = ok ? s + rpb_s[(blk - qi + 7) * 31 + (kk - qw + 15)] : -1e30f;
          }
          if (MODE == 3 && !isctx) {
            const int dlt = blk * 64 + kk - tq;
            s = (dlt <= 128 && dlt >= -128) ? s : -1e30f;
          }
          st[kt][i] = s;
          mx = fmaxf(mx, s);
        }
      mx = fmaxf(mx, shx(mx, lane, 32));
      const float alpha = __expf(m_run - mx);
      m_run = mx;
      float ps = 0.f;
#pragma unroll
      for (int kt = 0; kt < 2; ++kt)
#pragma unroll
        for (int i = 0; i < 16; ++i) { const float pv = __expf(st[kt][i] - mx); st[kt][i] = pv; ps += pv; }
      l_run = l_run * alpha + ps;
#pragma unroll
      for (int dt = 0; dt < 2; ++dt)
#pragma unroll
        for (int i = 0; i < 16; ++i) ot[dt][i] *= alpha;
#pragma unroll
      for (int kt = 0; kt < 2; ++kt) {
        const bf16x8 pb0 = packs<0>(st[kt]), pb1 = packs<1>(st[kt]);
#pragma unroll
        for (int dt = 0; dt < 2; ++dt) {
          const bf16x8 pa0 = ld2x4(Vt + (dt * 32 + r) * 72 + kt * 32 + 4 * h);
          const bf16x8 pa1 = ld2x4(Vt + (dt * 32 + r) * 72 + kt * 32 + 16 + 4 * h);
          ot[dt] = MFMA(pa0, pb0, ot[dt]);
          ot[dt] = MFMA(pa1, pb1, ot[dt]);
        }
      }
    }
  }
  l_run += shx(l_run, lane, 32);
  const float inv = 1.f / l_run;
  u16* dst = hnp + qtok * 1024 + qcol;
#pragma unroll
  for (int dt = 0; dt < 2; ++dt)
#pragma unroll
    for (int g4 = 0; g4 < 4; ++g4) {
      ushort4 o;
      o.x = f2bf(ot[dt][4 * g4] * inv); o.y = f2bf(ot[dt][4 * g4 + 1] * inv); o.z = f2bf(ot[dt][4 * g4 + 2] * inv); o.w = f2bf(ot[dt][4 * g4 + 3] * inv);
      *(ushort4*)(dst + dt * 32 + 8 * g4 + 4 * h) = o;
    }
}

struct ChainId { int lat, b, h, dir, T, base, nch; };
DI ChainId chain_decode(int it) {
  ChainId c; c.lat = it < 128; const int q = c.lat ? it : it - 128;
  c.b = q >> 4; c.h = (q >> 1) & 7; c.dir = q & 1; c.T = c.lat ? 4096 : 256; c.base = c.lat ? NP_ + c.b * 4096 : c.b * 256; c.nch = c.T >> 6;
  return c;
}
DI int tokof(const ChainId& c, int step, int row) { const int pp = step * 64 + row; return c.base + (c.dir ? c.T - 1 - pp : pp); }


static constexpr int RING = 4;
static constexpr int SLOT_BYTES = 53760;
DI void wait_ge(int* flag, int val, int tid) {
  if (tid < 64) {
    if (tid == 0) { while (__hip_atomic_load(flag, __ATOMIC_RELAXED, __HIP_MEMORY_SCOPE_AGENT) < val) __builtin_amdgcn_s_sleep(1); }
    __builtin_amdgcn_fence(__ATOMIC_ACQUIRE, "agent");
  }
  __syncthreads();
}
DI void publish(int* flag, int val, int tid) {
  asm volatile("s_waitcnt vmcnt(0)" ::: "memory");
  __syncthreads();
  if (tid == 0) __hip_atomic_store(flag, val, __ATOMIC_RELAXED, __HIP_MEMORY_SCOPE_AGENT);
}
typedef __attribute__((ext_vector_type(4))) unsigned u32x4;
DI void copy_out(const char* lds, char* g, int bytes, int tid) {
  for (int i = opq(tid) * 16; i < bytes; i += 256 * 16) {
    const u32x4 v = *(const u32x4*)(lds + i);
    char* dst = g + i;
    asm volatile("global_store_dwordx4 %0, %1, off sc0 sc1" :: "v"(dst), "v"(v) : "memory");
  }
}
DI void copy_in(char* lds, const char* g, int bytes, int tid) {
  for (int i = opq(tid) * 16; i < bytes; i += 256 * 16) *(uint4*)(lds + i) = *(const uint4*)(g + i);
}

template <int ROLE>
DI void gla_chain(const P* __restrict__ gp, int jj, int it, char* smem, int k0, int kstep) {
  const P& p = *gp;
  const ChainId cid = chain_decode(it);
  int tid_ = threadIdx.x; asm volatile("" : "+v"(tid_)); const int tid = tid_, lane = tid & 63, wave = tid >> 6, r = lane & 31, h = lane >> 5;
  const int hh = cid.h, dir = cid.dir;
  u16* QT = (u16*)smem; u16* KT = QT + 4608; u16* KEt = KT + 4608; u16* Vt = KEt + 4608;
  float* dec = (float*)(Vt + 4608); float* GL = dec + 64; float* gq = GL + 1024; float* Ost = gq + 256;
  constexpr int IMG = 4 * 9216 + 256;
  char* slots = uni(p.ring) + (size_t)it * RING * SLOT_BYTES; int* ready = uni(p.flags) + (jj * 2) * 8320 + it * 64; int* done = uni(p.flags) + (jj * 2) * 8320 + 8192 + it;
  const int d = tid & 63, cq = tid >> 6;
  float wg[16];
#pragma unroll
  for (int rr = 0; rr < 16; ++rr) wg[rr] = p.b_w_g2[((size_t)((jj * 2 + dir) * 16 + rr)) * 512 + hh * 64 + d];
  const float bg = p.b_b_g[(jj * 2 + dir) * 512 + hh * 64 + d];
  const int vh = wave & 1;
  f32x16 S[2]; zero16(S[0]); zero16(S[1]);
  const size_t sidx = ((size_t)(((cid.b * 2 + jj) * 2 + dir) * 8 + hh)) * 4096;
  if (ROLE != 1 && wave < 2 && cid.lat) {
#pragma unroll
    for (int dt = 0; dt < 2; ++dt)
#pragma unroll
      for (int i = 0; i < 16; ++i) S[dt][i] = p.state_b[sidx + (dt * 32 + crow(i, h)) * 64 + vh * 32 + r];
  }
  for (int step_ = k0; step_ < cid.nch; step_ += kstep) {
    int step = step_;
    asm volatile("" : "+v"(step));
    if (ROLE == 1) wait_ge(done, step_ - RING + 1, tid);
    if (ROLE == 2) wait_ge(ready + step_, 1, tid);
    __syncthreads();
    if (ROLE == 2) { copy_in(smem, slots + (size_t)(step_ % RING) * SLOT_BYTES, IMG, tid); __syncthreads(); if (tid == 0) __hip_atomic_store(done, step_ + 1, __ATOMIC_RELAXED, __HIP_MEMORY_SCOPE_AGENT); }
    if (ROLE != 2) {
    {
      const int c = tid >> 2, sg = tid & 3;
      const int tok = tokof(cid, step, c);
      const ushort4 gv = *(const ushort4*)(p.proj + (size_t)tok * EVN + 3072 + dir * 16 + sg * 4);
      GL[c * 16 + sg * 4] = bf2f(gv.x); GL[c * 16 + sg * 4 + 1] = bf2f(gv.y); GL[c * 16 + sg * 4 + 2] = bf2f(gv.z); GL[c * 16 + sg * 4 + 3] = bf2f(gv.w);
    }
    __syncthreads();
    float Gl[16]; float run = 0.f;
#pragma unroll
    for (int i = 0; i < 16; ++i) {
      const int c = cq * 16 + i;
      float z = bg;
#pragma unroll
      for (int rr = 0; rr < 16; ++rr) z += GL[c * 16 + rr] * wg[rr];
      const float g = (fminf(z, 0.f) - __logf(1.f + __expf(-fabsf(z)))) * (1.f / 16.f);
      run += g; Gl[i] = run;
    }
    gq[cq * 64 + d] = run;
    __syncthreads();
    float off = 0.f, tot = 0.f;
#pragma unroll
    for (int q2 = 0; q2 < 4; ++q2) { const float t = gq[q2 * 64 + d]; if (q2 < cq) off += t; tot += t; }
#pragma unroll
    for (int i = 0; i < 16; ++i) {
      const int c = cq * 16 + i;
      const int tok = tokof(cid, step, c);
      const float G = Gl[i] + off;
      const u16* rowp = p.proj + (size_t)tok * EVN + hh * 64 + d;
      const float qv = bf2f(rowp[1536]), kv = bf2f(rowp[2048]);
      const u16 vb = rowp[2560];
      QT[c * 72 + d] = f2bf(qv * 0.125f * __expf(G));
      KT[c * 72 + d] = f2bf(kv * __expf(-G));
      KEt[d * 72 + c] = f2bf(kv * __expf(tot - G));
      Vt[d * 72 + c] = vb;
    }
    if (cq == 0) dec[d] = __expf(tot);
    __syncthreads();
    }
    if (ROLE == 1) { copy_out(smem, slots + (size_t)(step_ % RING) * SLOT_BYTES, IMG, tid); publish(ready + step_, 1, tid); continue; }
    if (wave < 2) {
      f32x16 at[2][2];
#pragma unroll
      for (int a = 0; a < 2; ++a)
#pragma unroll
        for (int b2 = 0; b2 < 2; ++b2) zero16(at[a][b2]);
#pragma unroll
      for (int ks = 0; ks < 4; ++ks) {
        const bf16x8 a0 = *(const bf16x8*)(KT + r * 72 + ks * 16 + 8 * h), a1 = *(const bf16x8*)(KT + (32 + r) * 72 + ks * 16 + 8 * h);
        const bf16x8 b0 = *(const bf16x8*)(QT + r * 72 + ks * 16 + 8 * h), b1 = *(const bf16x8*)(QT + (32 + r) * 72 + ks * 16 + 8 * h);
        at[0][0] = MFMA(a0, b0, at[0][0]); at[0][1] = MFMA(a0, b1, at[0][1]);
        at[1][0] = MFMA(a1, b0, at[1][0]); at[1][1] = MFMA(a1, b1, at[1][1]);
      }
#pragma unroll
      for (int st = 0; st < 2; ++st)
#pragma unroll
        for (int ct = 0; ct < 2; ++ct)
#pragma unroll
          for (int i = 0; i < 16; ++i) { if (st * 32 + crow(i, h) > ct * 32 + r) at[st][ct][i] = 0.f; }
      f32x16 o[2]; zero16(o[0]); zero16(o[1]);
#pragma unroll
      for (int ct = 0; ct < 2; ++ct)
#pragma unroll
        for (int st = 0; st < 2; ++st) {
          const bf16x8 x0 = packs<0>(at[st][ct]), x1 = packs<1>(at[st][ct]);
          const bf16x8 pb0 = ld2x4(Vt + (vh * 32 + r) * 72 + st * 32 + 4 * h);
          const bf16x8 pb1 = ld2x4(Vt + (vh * 32 + r) * 72 + st * 32 + 16 + 4 * h);
          o[ct] = MFMA(x0, pb0, o[ct]);
          o[ct] = MFMA(x1, pb1, o[ct]);
        }
#pragma unroll
      for (int dt = 0; dt < 2; ++dt) {
        const bf16x8 xs0 = packs<0>(S[dt]), xs1 = packs<1>(S[dt]);
#pragma unroll
        for (int ct = 0; ct < 2; ++ct) {
          const bf16x8 pa0 = ld2x4(QT + (ct * 32 + r) * 72 + dt * 32 + 4 * h);
          const bf16x8 pa1 = ld2x4(QT + (ct * 32 + r) * 72 + dt * 32 + 16 + 4 * h);
          o[ct] = MFMA(pa0, xs0, o[ct]);
          o[ct] = MFMA(pa1, xs1, o[ct]);
        }
      }
#pragma unroll
      for (int dt = 0; dt < 2; ++dt)
#pragma unroll
        for (int i = 0; i < 16; ++i) S[dt][i] *= dec[dt * 32 + crow(i, h)];
#pragma unroll
      for (int ks = 0; ks < 4; ++ks) {
        const bf16x8 bv = *(const bf16x8*)(Vt + (vh * 32 + r) * 72 + ks * 16 + 8 * h);
#pragma unroll
        for (int dt = 0; dt < 2; ++dt) {
          const bf16x8 a = *(const bf16x8*)(KEt + (dt * 32 + r) * 72 + ks * 16 + 8 * h);
          S[dt] = MFMA(a, bv, S[dt]);
        }
      }
#pragma unroll
      for (int ct = 0; ct < 2; ++ct)
#pragma unroll
        for (int i = 0; i < 16; ++i) Ost[(ct * 32 + crow(i, h)) * 68 + vh * 32 + r] = o[ct][i];
    }
    __syncthreads();
    {
      const int c = tid >> 2, sg = tid & 3;
      const int tok = tokof(cid, step, c);
      u16* dst = (dir ? p.ot1 + (size_t)tok * 512 + hh * 64 : p.hn + (size_t)tok * 1024 + 512 + hh * 64) + sg * 16;
      bf16x8 w0, w1;
#pragma unroll
      for (int e = 0; e < 8; ++e) { w0[e] = (short)f2bf(Ost[c * 68 + sg * 16 + e]); w1[e] = (short)f2bf(Ost[c * 68 + sg * 16 + 8 + e]); }
      *(bf16x8*)dst = w0; *(bf16x8*)(dst + 8) = w1;
    }
  }
  if (wave < 2 && !cid.lat) {
#pragma unroll
    for (int dt = 0; dt < 2; ++dt)
#pragma unroll
      for (int i = 0; i < 16; ++i) p.out[OFF_SB + sidx + (dt * 32 + crow(i, h)) * 64 + vh * 32 + r] = S[dt][i];
  }
}

template <int ROLE>
DI void delta_chain(const P* __restrict__ gp, int jj, int it, char* smem, int k0, int kstep) {
  const P& p = *gp;
  const ChainId cid = chain_decode(it);
  int tid_ = threadIdx.x; asm volatile("" : "+v"(tid_)); const int tid0 = tid_;
  const int hh = cid.h, dir = cid.dir;
  u16* Qn = (u16*)smem; u16* Kt = Qn + 4608; u16* AQK = Kt + 4608; u16* KC = AQK + 4608;
  float* Wv = (float*)(KC + 4608); float* Gs = Wv + 64 * 65; u16* Kn = (u16*)(Gs + 64); float* At = (float*)(Kn + 4608); float* Bt = At + 64 * 68;
  constexpr int IMG = 4 * 9216 + 16640 + 256;
  char* slots = uni(p.ring) + (size_t)it * RING * SLOT_BYTES; int* ready = uni(p.flags) + (jj * 2 + 1) * 8320 + it * 64; int* done = uni(p.flags) + (jj * 2 + 1) * 8320 + 8192 + it;
  const float aexp = __expf(p.d_a_log[(jj * 2 + dir) * 8 + hh]);
  const float dtb = p.d_dt_bias[(jj * 2 + dir) * 8 + hh];
  f32x16 S[2]; zero16(S[0]); zero16(S[1]);
  const size_t sidx = ((size_t)(((cid.b * 2 + jj) * 2 + dir) * 8 + hh)) * 4096;
  { const int tid = tid0, lane = tid & 63, wave = tid >> 6, r = lane & 31, h = lane >> 5;
  if (ROLE != 1 && wave < 2 && cid.lat) {
    const int vh = wave & 1;
#pragma unroll
    for (int dt = 0; dt < 2; ++dt)
#pragma unroll
      for (int i = 0; i < 16; ++i) S[dt][i] = p.state_d[sidx + (dt * 32 + crow(i, h)) * 64 + vh * 32 + r];
  }
  }
  u16* CW = (u16*)(smem + 80640);
  __syncthreads();
  for (int i = tid0; i < 576; i += 256) { const int tap = i / 192, c2 = i - tap * 192; const int wh = c2 >> 6, dd = c2 & 63;
    CW[i] = f2bf(p.d_conv[(size_t)jj * 3 * 1536 + tap * 1536 + wh * 512 + hh * 64 + dd]); }
  for (int step_ = k0; step_ < cid.nch; step_ += kstep) {
    int step = step_;
    asm volatile("" : "+v"(step));
    if (ROLE == 1) wait_ge(done, step_ - RING + 1, tid0);
    if (ROLE == 2) wait_ge(ready + step_, 1, tid0);
    __syncthreads();
    if (ROLE == 2) { copy_in(smem, slots + (size_t)(step_ % RING) * SLOT_BYTES, IMG, tid0); __syncthreads(); if (tid0 == 0) __hip_atomic_store(done, step_ + 1, __ATOMIC_RELAXED, __HIP_MEMORY_SCOPE_AGENT); }
    if (ROLE != 2) {
    {const int tid = opq(tid0), lane = tid & 63, wave = __builtin_amdgcn_readfirstlane(tid >> 6), r = lane & 31, h = lane >> 5, vh = wave & 1; (void)r; (void)h; (void)vh; (void)lane;
    if (wave == 0) {
      const int tok = tokof(cid, step, lane);
      const float da = bf2f(p.proj[(size_t)tok * ODN + 2304 + dir * 8 + hh]);
      const float db = bf2f(p.proj[(size_t)tok * ODN + 2320 + dir * 8 + hh]);
      const float x = da + dtb;
      const float sp = x > 20.f ? x : __logf(1.f + __expf(x));
      float G = -aexp * sp;
#pragma unroll
      for (int o = 1; o < 64; o <<= 1) { const float t = __int_as_float(__builtin_amdgcn_ds_bpermute((lane - o) << 2, __float_as_int(G))); if (lane >= o) G += t; }
      Gs[lane] = G; Bt[lane] = 1.f / (1.f + __expf(-db));
    }
    {
      const int c = tid >> 2, sg = tid & 3;
      const int tok = tokof(cid, step, c);
      const int pos = tok - cid.base;
      const bool hp = pos > 0, hn_ = pos < cid.T - 1;
#pragma unroll 1
      for (int wh = 0; wh < 3; ++wh) {
        const int ch0 = wh * 512 + hh * 64 + sg * 16;
        const u16* cur = p.proj + (size_t)tok * ODN + 768 + ch0;
        float y[16];
        float ss = 0.f;
#pragma unroll
        for (int hf = 0; hf < 2; ++hf) {
          const bf16x8 xc = *(const bf16x8*)(cur + hf * 8);
          bf16x8 xp, xn;
#pragma unroll
          for (int e = 0; e < 8; ++e) { xp[e] = 0; xn[e] = 0; }
          if (hp) xp = *(const bf16x8*)(cur - ODN + hf * 8);
          if (hn_) xn = *(const bf16x8*)(cur + ODN + hf * 8);
#pragma unroll
          for (int e = 0; e < 8; ++e) {
            const int ch = wh * 64 + sg * 16 + hf * 8 + e;
            float v = bf2f(CW[ch]) * bf2f((u16)xp[e]) + bf2f(CW[192 + ch]) * bf2f((u16)xc[e]) + bf2f(CW[384 + ch]) * bf2f((u16)xn[e]);
            v = v / (1.f + __expf(-v));
            y[hf * 8 + e] = v; ss += v * v;
          }
        }
        ss += shx(ss, lane, 1); ss += shx(ss, lane, 2);
        const float rn = rsqrtf(ss + 1e-6f);
        if (wh == 0) {
#pragma unroll
          for (int e = 0; e < 16; ++e) Qn[c * 72 + sg * 16 + e] = f2bf(y[e] * rn * 0.125f);
        } else if (wh == 1) {
#pragma unroll
          for (int e = 0; e < 16; ++e) { const u16 kb = f2bf(y[e] * rn); Kn[c * 72 + sg * 16 + e] = kb; Kt[(sg * 16 + e) * 72 + c] = kb; }
        } else {
#pragma unroll
          for (int e = 0; e < 16; ++e) Wv[c * 65 + sg * 16 + e] = y[e];
        }
      }
    }
    }
    __syncthreads();
    {const int tid = opq(tid0), lane = tid & 63, wave = __builtin_amdgcn_readfirstlane(tid >> 6), r = lane & 31, h = lane >> 5, vh = wave & 1; (void)r; (void)h; (void)vh; (void)lane;
    if (wave < 2) {
      f32x16 akk[2], aqk[2]; zero16(akk[0]); zero16(akk[1]); zero16(aqk[0]); zero16(aqk[1]);
#pragma unroll
      for (int ks = 0; ks < 4; ++ks) {
        const bf16x8 bk = *(const bf16x8*)(Kn + (vh * 32 + r) * 72 + ks * 16 + 8 * h);
#pragma unroll
        for (int ct = 0; ct < 2; ++ct) {
          const bf16x8 ak = *(const bf16x8*)(Kn + (ct * 32 + r) * 72 + ks * 16 + 8 * h);
          const bf16x8 aq = *(const bf16x8*)(Qn + (ct * 32 + r) * 72 + ks * 16 + 8 * h);
          akk[ct] = MFMA(ak, bk, akk[ct]);
          aqk[ct] = MFMA(aq, bk, aqk[ct]);
        }
      }
      const int s = vh * 32 + r;
      const float Gss = Gs[s];
#pragma unroll
      for (int ct = 0; ct < 2; ++ct)
#pragma unroll
        for (int g4 = 0; g4 < 4; ++g4) {
          const int c0 = ct * 32 + 8 * g4 + 4 * h;
          const float4 gv4 = *(const float4*)(Gs + c0), bv4 = *(const float4*)(Bt + c0);
          float4 val;
#pragma unroll
          for (int e = 0; e < 4; ++e) {
            const int c = c0 + e;
            const float Gc = e == 0 ? gv4.x : e == 1 ? gv4.y : e == 2 ? gv4.z : gv4.w;
            const float Bc = e == 0 ? bv4.x : e == 1 ? bv4.y : e == 2 ? bv4.z : bv4.w;
            const float gam = __expf(fminf(Gc - Gss, 0.f));
            const float av = (s < c) ? akk[ct][4 * g4 + e] * Bc * gam : 0.f;
            if (e == 0) val.x = av; else if (e == 1) val.y = av; else if (e == 2) val.z = av; else val.w = av;
            AQK[c * 72 + s] = f2bf((s <= c) ? aqk[ct][4 * g4 + e] * gam : 0.f);
          }
          *(float4*)(At + s * 68 + c0) = val;
        }
    }
    }
    __syncthreads();
    {const int tid = opq(tid0), lane = tid & 63, wave = __builtin_amdgcn_readfirstlane(tid >> 6), r = lane & 31, h = lane >> 5, vh = wave & 1; (void)r; (void)h; (void)vh; (void)lane;
    if (wave < 2) {
      const bool isv = wave == 0;
      const int col = lane;
#pragma unroll 1
      for (int bi = 0; bi < 4; ++bi) {
        float acc[16];
#pragma unroll
        for (int ci = 0; ci < 16; ++ci) {
          const int c = 16 * bi + ci;
          acc[ci] = isv ? Wv[c * 65 + col] * Bt[c] : bf2f(Kn[c * 72 + col]) * Bt[c] * __expf(Gs[c]);
        }
#pragma unroll 8
        for (int s2 = 0; s2 < 16 * bi; ++s2) {
          const float xs = isv ? Wv[s2 * 65 + col] : bf2f(KC[s2 * 72 + col]);
          const float4* a4 = (const float4*)(At + s2 * 68 + 16 * bi);
#pragma unroll
          for (int q = 0; q < 4; ++q) {
            const float4 a = a4[q];
            acc[4 * q] -= a.x * xs; acc[4 * q + 1] -= a.y * xs; acc[4 * q + 2] -= a.z * xs; acc[4 * q + 3] -= a.w * xs;
          }
        }
#pragma unroll
        for (int ci = 0; ci < 16; ++ci) {
          const float x = acc[ci];
          const float* arow = At + (16 * bi + ci) * 68 + 16 * bi;
#pragma unroll
          for (int cj = ci + 1; cj < 16; ++cj) acc[cj] -= arow[cj] * x;
          if (isv) Wv[(16 * bi + ci) * 65 + col] = x; else KC[(16 * bi + ci) * 72 + col] = f2bf(x);
        }
      }
    }
    }
    __syncthreads();
    }
    if (ROLE == 1) { copy_out(smem, slots + (size_t)(step_ % RING) * SLOT_BYTES, IMG, tid0); publish(ready + step_, 1, tid0); continue; }
    {const int tid = opq(tid0), lane = tid & 63, wave = __builtin_amdgcn_readfirstlane(tid >> 6), r = lane & 31, h = lane >> 5, vh = wave & 1; (void)r; (void)h; (void)vh; (void)lane;
    if (wave < 2) {
      f32x16 kS[2], qS[2]; zero16(kS[0]); zero16(kS[1]); zero16(qS[0]); zero16(qS[1]);
#pragma unroll
      for (int dt = 0; dt < 2; ++dt) {
        const bf16x8 xs0 = packs<0>(S[dt]), xs1 = packs<1>(S[dt]);
#pragma unroll
        for (int ct = 0; ct < 2; ++ct) {
          kS[ct] = MFMA(ld2x4(KC + (ct * 32 + r) * 72 + dt * 32 + 4 * h), xs0, kS[ct]);
          kS[ct] = MFMA(ld2x4(KC + (ct * 32 + r) * 72 + dt * 32 + 16 + 4 * h), xs1, kS[ct]);
          qS[ct] = MFMA(ld2x4(Qn + (ct * 32 + r) * 72 + dt * 32 + 4 * h), xs0, qS[ct]);
          qS[ct] = MFMA(ld2x4(Qn + (ct * 32 + r) * 72 + dt * 32 + 16 + 4 * h), xs1, qS[ct]);
        }
      }
      f32x16 vn[2], o[2];
      const float Glast = Gs[63];
#pragma unroll
      for (int ct = 0; ct < 2; ++ct)
#pragma unroll
        for (int i = 0; i < 16; ++i) {
          const int c = ct * 32 + crow(i, h);
          vn[ct][i] = Wv[c * 65 + vh * 32 + r] - kS[ct][i];
          o[ct][i] = qS[ct][i] * __expf(Gs[c]);
        }
#pragma unroll
      for (int st = 0; st < 2; ++st) {
        const bf16x8 xs0 = packs<0>(vn[st]), xs1 = packs<1>(vn[st]);
#pragma unroll
        for (int ct = 0; ct < 2; ++ct) {
          o[ct] = MFMA(ld2x4(AQK + (ct * 32 + r) * 72 + st * 32 + 4 * h), xs0, o[ct]);
          o[ct] = MFMA(ld2x4(AQK + (ct * 32 + r) * 72 + st * 32 + 16 + 4 * h), xs1, o[ct]);
        }
      }
      const float dl = __expf(Glast);
#pragma unroll
      for (int st = 0; st < 2; ++st) {
        asm volatile("" ::: "memory");
#pragma unroll
        for (int i = 0; i < 16; ++i) vn[st][i] *= __expf(Glast - Gs[st * 32 + crow(i, h)]);
      }
      asm volatile("" ::: "memory");
#pragma unroll
      for (int dt = 0; dt < 2; ++dt)
#pragma unroll
        for (int i = 0; i < 16; ++i) S[dt][i] *= dl;
#pragma unroll
      for (int st = 0; st < 2; ++st) {
        const bf16x8 xs0 = packs<0>(vn[st]), xs1 = packs<1>(vn[st]);
#pragma unroll
        for (int dt = 0; dt < 2; ++dt) {
          S[dt] = MFMA(ld2x4(Kt + (dt * 32 + r) * 72 + st * 32 + 4 * h), xs0, S[dt]);
          S[dt] = MFMA(ld2x4(Kt + (dt * 32 + r) * 72 + st * 32 + 16 + 4 * h), xs1, S[dt]);
        }
      }
#pragma unroll
      for (int ct = 0; ct < 2; ++ct)
#pragma unroll
        for (int i = 0; i < 16; ++i) At[(ct * 32 + crow(i, h)) * 68 + vh * 32 + r] = o[ct][i];
    }
    }
    __syncthreads();
    {
      const int tid = opq(tid0);
      const int c = tid >> 2, sg = tid & 3;
      const int tok = tokof(cid, step, c);
      u16* dst = (dir ? p.ot1 + (size_t)tok * 512 + hh * 64 : p.hn + (size_t)tok * 1024 + 512 + hh * 64) + sg * 16;
      bf16x8 w0, w1;
#pragma unroll
      for (int e = 0; e < 8; ++e) { w0[e] = (short)f2bf(At[c * 68 + sg * 16 + e]); w1[e] = (short)f2bf(At[c * 68 + sg * 16 + 8 + e]); }
      *(bf16x8*)dst = w0; *(bf16x8*)(dst + 8) = w1;
    }
  }
  {const int tid = opq(tid0), lane = tid & 63, wave = __builtin_amdgcn_readfirstlane(tid >> 6), r = lane & 31, h = lane >> 5, vh = wave & 1; (void)r; (void)h; (void)vh; (void)lane;
  if (wave < 2 && !cid.lat) {
#pragma unroll
    for (int dt = 0; dt < 2; ++dt)
#pragma unroll
      for (int i = 0; i < 16; ++i) p.out[OFF_SD + sidx + (dt * 32 + crow(i, h)) * 64 + vh * 32 + r] = S[dt][i];
  }
}
}

DI void mixer_phase(const P* __restrict__ gp, int l, char* smem) {
  const P& p = *gp;
  const bool even = !(l & 1); const int jj = l >> 1;
  const bool teams = gridDim.x >= 512;
  if (teams) {
    const int bid = blockIdx.x;
    const int K = even ? 2 : 3;
    if (bid < 128 * (K + 1)) {
      if (bid < 128) { if (even) gla_chain<2>(gp, jj, bid, smem, 0, 1); else delta_chain<2>(gp, jj, bid, smem, 0, 1); }
      else { const int ch = (bid - 128) & 127, k = (bid - 128) >> 7; if (even) gla_chain<1>(gp, jj, ch, smem, k, K); else delta_chain<1>(gp, jj, ch, smem, k, K); }
    }
  }
  const int first = teams ? 128 : 0;
  const int total = 384 + 2048 + 256;
  int* s_item = (int*)(smem + SMEM_BYTES - 16);
  int* cntp = uni(p.cnt) + l;
  for (;;) {
    __syncthreads();
    if (opq(threadIdx.x) == 0) *s_item = atomicAdd(cntp, 1) + first;
    __syncthreads();
    const int item = __builtin_amdgcn_readfirstlane(*s_item);
    if (item >= total) break;
    if (item < 384) { if (even) gla_chain<0>(gp, jj, item, smem, 0, 1); else delta_chain<0>(gp, jj, item, smem, 0, 1); }
    else if (item < 384 + 2048) { if (even) attn_item<1>(gp, jj, item - 384, smem); else attn_item<3>(gp, jj, item - 384, smem); }
    else { if (even) attn_item<0>(gp, jj, item - 384 - 2048, smem); else attn_item<2>(gp, jj, item - 384 - 2048, smem); }
  }
}

DI void finalize_phase(const P* __restrict__ gp, int l) {
  const P& p = *gp;
  const bool even = !(l & 1); const int jj = l >> 1;
  int tid_ = threadIdx.x; asm volatile("" : "+v"(tid_)); const int tid = tid_;
  const int tk = tid >> 5, hh = (tid >> 2) & 7, sg = tid & 3;
  const int PS = even ? EVN : ODN; const int zcol = even ? 3104 : 2336;
  for (int item = blockIdx.x; item < NT_ / 8; item += gridDim.x) {
    const size_t tok = (size_t)item * 8 + tk;
    u16* a = p.hn + tok * 1024 + 512 + hh * 64 + sg * 16;
    const u16* bsrc = p.ot1 + tok * 512 + hh * 64 + sg * 16;
    const u16* zs = p.proj + tok * PS + zcol + hh * 64 + sg * 16;
    float o[16]; float ss = 0.f;
#pragma unroll
    for (int hf = 0; hf < 2; ++hf) {
      const bf16x8 x0 = *(const bf16x8*)(a + hf * 8), x1 = *(const bf16x8*)(bsrc + hf * 8);
#pragma unroll
      for (int e = 0; e < 8; ++e) { const float v = bf2f((u16)x0[e]) + bf2f((u16)x1[e]); o[hf * 8 + e] = v; ss += v * v; }
    }
    ss += shx(ss, tid & 63, 1); ss += shx(ss, tid & 63, 2);
    const float rstd = rsqrtf(ss * (1.f / 64.f) + 1e-6f);
    const float* ng = even ? p.b_norm_g + jj * 512 + hh * 64 + sg * 16 : p.d_norm_g + jj * 64 + sg * 16;
#pragma unroll
    for (int hf = 0; hf < 2; ++hf) {
      const bf16x8 z = *(const bf16x8*)(zs + hf * 8);
      bf16x8 w;
#pragma unroll
      for (int e = 0; e < 8; ++e) { const float zz = bf2f((u16)z[e]); w[e] = (short)f2bf(o[hf * 8 + e] * rstd * ng[hf * 8 + e] * siluf(zz)); }
      *(bf16x8*)(a + hf * 8) = w;
    }
  }
}

DI void run_phase(const P* __restrict__ gp, int ph, char* smem) {
  const P& p = *gp;
  if (ph == 0) { prep_phase(gp, smem); return; }
  if (ph == NPH - 1) { norm_phase(gp, 0, 0, false, true); return; }
  const int l = (ph - 1) >> 3, s = (ph - 1) & 7;
  const bool even = !(l & 1);
  const u16* W = uni(p.wt) + (size_t)l * LW;
  const u16* hnp = uni(p.hn); const u16* projp = uni(p.proj);
  switch (s) {
    case 0: norm_phase(gp, l, 0, l == 0, false); break;
    case 1: gemm_phase<EPI_PROJ>(gp, l, smem, hnp, 1024, W + WO_IN, 1024, 1024, 288, even ? 29 : 23, 0); break;
    case 2: mixer_phase(gp, l, smem); break;
    case 3: finalize_phase(gp, l); break;
    case 4: gemm_phase<EPI_RES>(gp, l, smem, hnp, 1024, W + WO_OUT, 1024, 1024, 288, 8, 2); break;
    case 5: norm_phase(gp, l, 1, false, false); break;
    case 6: gemm_phase<EPI_FFN>(gp, l, smem, hnp, 1024, W + WO_UP, 1024, 1024, 312, 44, 0); break;
    case 7: gemm_phase<EPI_RES>(gp, l, smem, projp, 2816, W + WO_DN, 2816, 2816, 288, 8, 5); break;
  }
}

__global__ void __launch_bounds__(256, 2) mk(P p, P* gp, int ph0, int ph1) {
  __shared__ __attribute__((aligned(16))) char smem[SMEM_BYTES];
  if (threadIdx.x == 0) *gp = p;
  __threadfence();
  __syncthreads();
  if (ph1 - ph0 > 1) {
    cg::grid_group grid = cg::this_grid();
    for (int ph = ph0; ph < ph1; ++ph) {
      run_phase(gp, ph, smem);
      if (ph + 1 < ph1) grid.sync();
    }
  } else {
    run_phase(gp, ph0, smem);
  }
}

extern "C" void kernel_launch(void* const* d_in, const int* in_sizes, int n_in, void* d_out, int out_size, void* d_ws, size_t ws_size,
                              hipStream_t stream) {
  P p{};
  const float** f = (const float**)&p;
  for (int i = 0; i < 31; ++i) f[i] = (const float*)d_in[i];
  p.out = (float*)d_out;
  char* ws = (char*)d_ws;
  size_t off = 0;
  p.hn = (u16*)(ws + off); off += (size_t)NT_ * 1024 * 2;
  p.proj = (u16*)(ws + off); off += (size_t)NT_ * EVN * 2;
  p.ot1 = (u16*)(ws + off); off += (size_t)NT_ * 512 * 2;
  p.wt = (u16*)(ws + off); off += 4 * LW * 2;
  p.mods = (float*)(ws + off); off += 4 * 9 * 6144 * 4;
  p.rope = (float*)(ws + off); off += 64 * 16 * 2 * 4;
  P* gp = (P*)(ws + off); off += 4096;
  p.cnt = (int*)(ws + off); off += 256;
  p.flags = (int*)(ws + off); off += 4 * 8320 * 4;
  off = (off + 255) & ~(size_t)255;
  p.ring = ws + off; off += (size_t)128 * RING * SLOT_BYTES;
  static int grid_blocks = 0;
  if (!grid_blocks) {
    int dev = 0, cus = 0, per_cu = 0;
    hipGetDevice(&dev);
    hipDeviceGetAttribute(&cus, hipDeviceAttributeMultiprocessorCount, dev);
    hipOccupancyMaxActiveBlocksPerMultiprocessor(&per_cu, mk, 256, 0);
    if (per_cu < 1) per_cu = 1;
    if (per_cu > 2) per_cu = 2;
    grid_blocks = cus * per_cu;
  }
#if MK_MULTI
  for (int ph = 0; ph < NPH; ++ph) {
    int a = ph, b = ph + 1;
    hipLaunchKernelGGL(mk, dim3(grid_blocks), dim3(256), 0, stream, p, gp, a, b);
  }
#else
  int ph0 = 0, ph1 = NPH;
  void* args[] = {&p, &gp, &ph0, &ph1};
  hipError_t e = hipLaunchCooperativeKernel((void*)mk, dim3(grid_blocks), dim3(256), args, 0, stream);
  if (e != hipSuccess) fprintf(stderr, "cooperative launch failed: %s (grid %d)\n", hipGetErrorString(e), grid_blocks);
#endif
}
```

```cpp
#include <hip/hip_runtime.h>
#include <hip/hip_cooperative_groups.h>
#include <cstdio>
namespace cg = cooperative_groups;

#ifndef MK_MULTI
#define MK_MULTI 0
#endif

#define DI __device__ __forceinline__
#define DN __device__ __noinline__
typedef unsigned short u16;
typedef __attribute__((ext_vector_type(8))) short bf16x8;
typedef __attribute__((ext_vector_type(4))) short s16x4;
typedef __attribute__((ext_vector_type(16))) float f32x16;
#define MFMA(a, b, c) __builtin_amdgcn_mfma_f32_32x32x16_bf16((a), (b), (c), 0, 0, 0)

static constexpr int NP_ = 4096, NT_ = 36864;
static constexpr int EVN = 3616, ODN = 2848;
static constexpr size_t OFF_AK = 37748736, OFF_AV = 41943040, OFF_SB = 46137344, OFF_CK = 48234496, OFF_CV = 49283072, OFF_SD = 50331648;
static constexpr size_t LW = 13500416, WO_UP = 0, WO_DN = 5767168, WO_IN = 8650752, WO_OUT = 12451840;
static constexpr int NPH = 34;
static constexpr int SMEM_BYTES = 80 * 1024;

struct P {
  const float *x_prompt, *x_sample, *cache_a_k, *cache_a_v, *state_b, *cache_c_k, *cache_c_v, *state_d, *c, *c_ctx, *ada_w, *ada_b,
      *norm1_g, *norm2_g, *ffn_up, *ffn_conv, *ffn_down, *ev_w_in, *ev_w_out, *a_rpb, *b_w_g2, *b_b_g, *b_norm_g, *od_w_in, *od_w_out,
      *c_sink, *d_conv, *d_a_log, *d_dt_bias, *d_norm_g, *final_g;
  float* out;
  u16 *hn, *proj, *ot1, *wt;
  float *mods, *rope;
  int* cnt;
  int* flags;
  char* ring;
};

DI u16 f2bf(float x) { unsigned u = __float_as_uint(x); u += 0x7fffu + ((u >> 16) & 1u); return (u16)(u >> 16); }
DI float bf2f(u16 b) { return __uint_as_float(((unsigned)b) << 16); }
DI int crow(int i, int h) { return (i & 3) + 8 * (i >> 2) + 4 * h; }
template <int S> DI bf16x8 packs(const f32x16& x) {
  bf16x8 v;
#pragma unroll
  for (int j = 0; j < 8; ++j) v[j] = (short)f2bf(x[8 * S + j]);
  return v;
}
DI bf16x8 ld2x4(const u16* p) {
  s16x4 lo = *(const s16x4*)p, hi = *(const s16x4*)(p + 8);
  return __builtin_shufflevector(lo, hi, 0, 1, 2, 3, 4, 5, 6, 7);
}
DI float siluf(float x) { return x / (1.f + __expf(-x)); }
DI int opq(int x) { asm volatile("" : "+v"(x)); return x; }
DI float shx(float v, int lane, int o) { return __int_as_float(__builtin_amdgcn_ds_bpermute((lane ^ o) << 2, __float_as_int(v))); }
template <class T> DI T* uni(T* q) { return q; }
DI void zero16(f32x16& a) {
#pragma unroll
  for (int i = 0; i < 16; ++i) a[i] = 0.f;
}

DI void prep_phase(const P* __restrict__ gp, char* smem) {
  const P& p = *gp;
  int tid_ = threadIdx.x; asm volatile("" : "+v"(tid_)); const int tid = tid_;
  const int NWT = 4 * (1408 + 704 + 256) + 2 * (928 + 736);
  const int NADA = 384;
  const int total = NWT + NADA + 1;
  for (int item = blockIdx.x; item < total; item += gridDim.x) {
    if (item < NWT) {
      int rem = item; const float* src = nullptr; u16* dst = nullptr; int K = 0, N = 0, NPd = 0;
      for (int l = 0; l < 4; ++l) {
        const int jj = l >> 1; const bool ev = !(l & 1);
        const int nin = ev ? 928 : 736;
        if (rem < 1408) { src = p.ffn_up + (size_t)l * 1024 * 5632; dst = p.wt + l * LW + WO_UP; K = 1024; N = 5632; NPd = 5632; break; }
        rem -= 1408;
        if (rem < 704) { src = p.ffn_down + (size_t)l * 2816 * 1024; dst = p.wt + l * LW + WO_DN; K = 2816; N = 1024; NPd = 1024; break; }
        rem -= 704;
        if (rem < nin) { src = ev ? p.ev_w_in + (size_t)jj * 1024 * EVN : p.od_w_in + (size_t)jj * 1024 * ODN; dst = p.wt + l * LW + WO_IN; K = 1024; N = ev ? EVN : ODN; NPd = ev ? 3712 : 2944; break; }
        rem -= nin;
        if (rem < 256) { src = (ev ? p.ev_w_out : p.od_w_out) + (size_t)jj * 1024 * 1024; dst = p.wt + l * LW + WO_OUT; K = 1024; N = 1024; NPd = 1024; break; }
        rem -= 256;
      }
      const int ntn = NPd >> 6;
      const int tk = rem / ntn, tn = rem - tk * ntn;
      const int scol0 = (N == 5632) ? ((tn & 1) * 2816 + (tn >> 1) * 64) : tn * 64;
      float* T = (float*)smem;
      __syncthreads();
#pragma unroll
      for (int i = 0; i < 16; ++i) {
        const int k = i * 4 + (tid >> 6), n = tid & 63;
        const int gn = scol0 + n;
        T[k * 65 + n] = (gn < N) ? src[(size_t)(tk * 64 + k) * N + gn] : 0.f;
      }
      __syncthreads();
#pragma unroll
      for (int i = 0; i < 2; ++i) {
        const int q = tid + 256 * i; const int n = q & 63, kc = q >> 6;
        const int pn = tn * 64 + n; const int nt32 = pn >> 5, rr = pn & 31;
        const int kstep = tk * 4 + (kc >> 1), hh = kc & 1;
        bf16x8 w;
#pragma unroll
        for (int j = 0; j < 8; ++j) w[j] = (short)f2bf(T[(kc * 8 + j) * 65 + n]);
        *(bf16x8*)(dst + ((size_t)(nt32 * (K >> 4) + kstep) * 64 + hh * 32 + rr) * 8) = w;
      }
    } else if (item < NWT + NADA) {
      const int it = item - NWT; const int l = it / 96, cgp = it - l * 96; const int n0 = cgp * 64;
      float* sc = (float*)smem;
      float* red = sc + 9 * 1024;
      __syncthreads();
      for (int idx = tid; idx < 9 * 1024; idx += 256) {
        const int ci = idx >> 10, k = idx & 1023;
        const float x = ci < 8 ? p.c[ci * 1024 + k] : p.c_ctx[k];
        sc[idx] = x / (1.f + expf(-x));
      }
      __syncthreads();
      const int wave = tid >> 6, lane = tid & 63;
      float acc[9];
#pragma unroll
      for (int ci = 0; ci < 9; ++ci) acc[ci] = 0.f;
      const float* wp = p.ada_w + ((size_t)l * 1024 + wave * 256) * 6144 + n0 + lane;
#pragma unroll 8
      for (int k = 0; k < 256; ++k) {
        const float wv = wp[(size_t)k * 6144];
#pragma unroll
        for (int ci = 0; ci < 9; ++ci) acc[ci] += sc[ci * 1024 + wave * 256 + k] * wv;
      }
#pragma unroll
      for (int ci = 0; ci < 9; ++ci) red[(wave * 9 + ci) * 64 + lane] = acc[ci];
      __syncthreads();
      for (int idx = tid; idx < 576; idx += 256) {
        const int ci = idx >> 6, col = idx & 63;
        const float s = red[(0 * 9 + ci) * 64 + col] + red[(1 * 9 + ci) * 64 + col] + red[(2 * 9 + ci) * 64 + col] + red[(3 * 9 + ci) * 64 + col];
        p.mods[(size_t)(l * 9 + ci) * 6144 + n0 + col] = s + p.ada_b[l * 6144 + n0 + col];
      }
    } else {
      if (tid < 8) p.cnt[tid] = 0;
      for (int i = tid; i < 4 * 8320; i += 256) p.flags[i] = 0;
      for (int idx = tid; idx < 1024; idx += 256) {
        const int pos = idx >> 4, fi = idx & 15;
        const float inv = powf(10000.f, -(float)fi / 16.f);
        const float ang = (float)pos * inv;
        p.rope[idx * 2] = cosf(ang); p.rope[idx * 2 + 1] = sinf(ang);
      }
    }
  }
}

DI void norm_phase(const P* __restrict__ gp, int l, int which, bool first, bool fin) {
  const P& p = *gp;
  int tid_ = threadIdx.x; asm volatile("" : "+v"(tid_)); const int tid = tid_, lane = tid & 63, wave = tid >> 6;
  for (int item = blockIdx.x; item < NT_ / 4; item += gridDim.x) {
    const int tok = item * 4 + wave;
    const float* src = first ? (tok < NP_ ? p.x_prompt + (size_t)tok * 1024 : p.x_sample + (size_t)(tok - NP_) * 1024) : p.out + (size_t)tok * 1024;
    float4 v[4];
    float ss = 0.f;
#pragma unroll
    for (int i = 0; i < 4; ++i) { v[i] = ((const float4*)src)[lane + 64 * i]; ss += v[i].x * v[i].x + v[i].y * v[i].y + v[i].z * v[i].z + v[i].w * v[i].w; }
#pragma unroll
    for (int o = 32; o >= 1; o >>= 1) ss += shx(ss, lane, o);
    const float rstd = rsqrtf(ss * (1.f / 1024.f) + 1e-6f);
    if (fin) {
#pragma unroll
      for (int i = 0; i < 4; ++i) {
        const float4 g = ((const float4*)p.final_g)[lane + 64 * i];
        float4 y; y.x = v[i].x * rstd * g.x; y.y = v[i].y * rstd * g.y; y.z = v[i].z * rstd * g.z; y.w = v[i].w * rstd * g.w;
        ((float4*)(p.out + (size_t)tok * 1024))[lane + 64 * i] = y;
      }
    } else {
      const int ci = tok < NP_ ? 8 : (tok - NP_) >> 12;
      const float* md = p.mods + (size_t)(l * 9 + ci) * 6144 + which * 3072;
      const float* gp = (which ? p.norm2_g : p.norm1_g) + l * 1024;
#pragma unroll
      for (int i = 0; i < 4; ++i) {
        const float4 g = ((const float4*)gp)[lane + 64 * i];
        const float4 sh = ((const float4*)md)[lane + 64 * i];
        const float4 sc = ((const float4*)(md + 1024))[lane + 64 * i];
        ushort4 o;
        o.x = f2bf(v[i].x * rstd * g.x * (1.f + sc.x) + sh.x);
        o.y = f2bf(v[i].y * rstd * g.y * (1.f + sc.y) + sh.y);
        o.z = f2bf(v[i].z * rstd * g.z * (1.f + sc.z) + sh.z);
        o.w = f2bf(v[i].w * rstd * g.w * (1.f + sc.w) + sh.w);
        ((ushort4*)(p.hn + (size_t)tok * 1024))[lane + 64 * i] = o;
        if (first) ((float4*)(p.out + (size_t)tok * 1024))[lane + 64 * i] = v[i];
      }
    }
  }
}

DI uint4 ldsel(const u16* pv, const u16* safe, unsigned ok) {
  uint4 t = *(const uint4*)(ok ? pv : safe);
  if (!ok) { t.x = 0; t.y = 0; t.z = 0; t.w = 0; }
  return t;
}
enum { EPI_PROJ = 0, EPI_RES = 1, EPI_FFN = 2 };

template <int EPI>
DI void gemm_phase(const P* __restrict__ gp, int l, char* smem, const u16* __restrict__ A, int lda, const u16* __restrict__ B, int ldb, int K, int MT,
                   int NTn, int gsel) {
  const P& p = *gp;
  u16* As = (u16*)smem;
  int tid_ = threadIdx.x; asm volatile("" : "+v"(tid_)); const int tid = tid_, lane = tid & 63, wave = tid >> 6, r = lane & 31, h = lane >> 5;
  const int wm = wave & 1, wn = wave >> 1;
  const int KT = K >> 6;
  const bool even = !(l & 1); const int jj = l >> 1;
  const int ntiles = MT * NTn;
  const int nlb = gridDim.x >> 3, xcd = blockIdx.x & 7, lb = blockIdx.x >> 3;
  for (int it = 0;; ++it) {
    const int g = (it * 8 + xcd) * nlb + lb;
    if (g >= ntiles) break;
    const int SM = nlb >> 3;
    const int band = g / (SM * NTn); const int rem = g - band * SM * NTn;
    const int nt = rem / SM, mt = band * SM + (rem - nt * SM);
    int seqbase = 0, L = 0, tin0 = 0;
    if (EPI == EPI_FFN) {
      if (mt < 48) { const int sq = mt / 3; L = 256; seqbase = sq * 256; tin0 = (mt - sq * 3) * 126; }
      else { const int m2 = mt - 48; const int sq = m2 / 33; L = 4096; seqbase = NP_ + sq * 4096; tin0 = (m2 - sq * 33) * 126; }
    }
    const int row0 = tid >> 3, kc0 = (tid & 7) * 8;
    const long arow0 = (EPI == EPI_FFN) ? (long)seqbase + tin0 - 1 + row0 : (long)mt * 128 + row0;
    const u16* abase = A + arow0 * lda + kc0;
    unsigned avalid = 0;
#pragma unroll
    for (int i = 0; i < 4; ++i) {
      if (EPI == EPI_FFN) { const int ts = tin0 - 1 + row0 + 32 * i; if (ts >= 0 && ts < L) avalid |= 1u << i; }
      else avalid |= 1u << i;
    }
    const u16* bb0 = B + ((size_t)((nt * 4 + wn * 2) * (K >> 4)) * 64 + lane) * 8;
    const size_t bts = (size_t)(K >> 4) * 512;
    f32x16 acc[2][2];
#pragma unroll
    for (int a = 0; a < 2; ++a)
#pragma unroll
      for (int b = 0; b < 2; ++b) zero16(acc[a][b]);
#define GLD_A(i, ko) ldsel(abase + (size_t)(32 * (i)) * lda + (ko), A, (avalid >> (i)) & 1u)
#define GLD_BF(dst, kt_) { const u16* q_ = bb0 + (size_t)(kt_) * 2048; \
      dst[0][0] = *(const bf16x8*)(q_); dst[0][1] = *(const bf16x8*)(q_ + 512); dst[0][2] = *(const bf16x8*)(q_ + 1024); dst[0][3] = *(const bf16x8*)(q_ + 1536); \
      dst[1][0] = *(const bf16x8*)(q_ + bts); dst[1][1] = *(const bf16x8*)(q_ + bts + 512); dst[1][2] = *(const bf16x8*)(q_ + bts + 1024); dst[1][3] = *(const bf16x8*)(q_ + bts + 1536); }
    uint4 ra0 = GLD_A(0, 0), ra1 = GLD_A(1, 0), ra2 = GLD_A(2, 0), ra3 = GLD_A(3, 0);
    uint4 sa0 = GLD_A(0, 64), sa1 = GLD_A(1, 64), sa2 = GLD_A(2, 64), sa3 = GLD_A(3, 64);
    bf16x8 bc[2][4], bn[2][4];
    GLD_BF(bc, 0);
    GLD_BF(bn, 1);
#define LSTORE(buf, A0, A1, A2, A3) { \
      u16* ad = As + (buf) * 9216 + row0 * 72 + kc0; \
      *(uint4*)(ad) = A0; *(uint4*)(ad + 32 * 72) = A1; *(uint4*)(ad + 64 * 72) = A2; *(uint4*)(ad + 96 * 72) = A3; }
#define COMPUTE(buf, BF) { \
      const u16* Ab = As + (buf) * 9216; \
      _Pragma("unroll") for (int ks = 0; ks < 4; ++ks) { \
        const bf16x8 a0 = *(const bf16x8*)(Ab + (wm * 64 + r) * 72 + ks * 16 + h * 8); \
        const bf16x8 a1 = *(const bf16x8*)(Ab + (wm * 64 + 32 + r) * 72 + ks * 16 + h * 8); \
        acc[0][0] = MFMA(a0, BF[0][ks], acc[0][0]); acc[0][1] = MFMA(a0, BF[1][ks], acc[0][1]); \
        acc[1][0] = MFMA(a1, BF[0][ks], acc[1][0]); acc[1][1] = MFMA(a1, BF[1][ks], acc[1][1]); } }
    LSTORE(0, ra0, ra1, ra2, ra3);
    ra0 = GLD_A(0, 128); ra1 = GLD_A(1, 128); ra2 = GLD_A(2, 128); ra3 = GLD_A(3, 128);
    __syncthreads();
    for (int kt = 0; kt < KT; kt += 2) {
      COMPUTE(0, bc);
      if (kt + 2 < KT) GLD_BF(bc, kt + 2);
      LSTORE(1, sa0, sa1, sa2, sa3);
      if (kt + 3 < KT) {
        const int ko = (kt + 3) * 64;
        sa0 = GLD_A(0, ko); sa1 = GLD_A(1, ko); sa2 = GLD_A(2, ko); sa3 = GLD_A(3, ko);
      }
      __syncthreads();
      COMPUTE(1, bn);
      if (kt + 3 < KT) GLD_BF(bn, kt + 3);
      if (kt + 2 < KT) {
        LSTORE(0, ra0, ra1, ra2, ra3);
        if (kt + 4 < KT) {
          const int ko = (kt + 4) * 64;
          ra0 = GLD_A(0, ko); ra1 = GLD_A(1, ko); ra2 = GLD_A(2, ko); ra3 = GLD_A(3, ko);
        }
      }
      __syncthreads();
    }
    if (EPI == EPI_PROJ) {
      const int N = even ? EVN : ODN;
#pragma unroll
      for (int tm = 0; tm < 2; ++tm)
#pragma unroll
        for (int tn = 0; tn < 2; ++tn) {
          const int col = nt * 128 + wn * 64 + tn * 32 + r;
          if (col < N) {
#pragma unroll
            for (int i = 0; i < 16; ++i) {
              const int row = mt * 128 + wm * 64 + tm * 32 + crow(i, h);
              const float v = acc[tm][tn][i];
              p.proj[(size_t)row * N + col] = f2bf(v);
              if (row < NP_) {
                const int b = row >> 8, t = row & 255, d = col & 63;
                if (even) {
                  if (col >= 512 && col < 1536) {
                    const int wh = (col - 512) >> 9, hh = ((col - 512) >> 6) & 7;
                    p.out[(wh ? OFF_AV : OFF_AK) + ((size_t)(((b * 2 + jj) * 8 + hh) * 256 + t)) * 64 + d] = v;
                  }
                } else {
                  if (col >= 512 && col < 768) {
                    const int wh = (col - 512) >> 7, kv = ((col - 512) >> 6) & 1;
                    p.out[(wh ? OFF_CV : OFF_CK) + ((size_t)(((b * 2 + jj) * 2 + kv) * 256 + t)) * 64 + d] = v;
                  }
                }
              }
            }
          }
        }
    } else if (EPI == EPI_RES) {
#pragma unroll
      for (int tm = 0; tm < 2; ++tm)
#pragma unroll
        for (int tn = 0; tn < 2; ++tn) {
          const int col = nt * 128 + wn * 64 + tn * 32 + r;
#pragma unroll
          for (int i = 0; i < 16; ++i) {
            const int row = mt * 128 + wm * 64 + tm * 32 + crow(i, h);
            const int ci = row < NP_ ? 8 : (row - NP_) >> 12;
            const float g = p.mods[(size_t)(l * 9 + ci) * 6144 + gsel * 1024 + col];
            float* xp = p.out + (size_t)row * 1024 + col;
            *xp = *xp + g * acc[tm][tn][i];
          }
        }
    } else {
      __syncthreads();
      float* U = (float*)smem;
#pragma unroll
      for (int tm = 0; tm < 2; ++tm)
#pragma unroll
        for (int tn = 0; tn < 2; ++tn)
#pragma unroll
          for (int i = 0; i < 16; ++i) U[(wm * 64 + tm * 32 + crow(i, h)) * 132 + wn * 64 + tn * 32 + r] = acc[tm][tn][i];
      __syncthreads();
      const float* cw = p.ffn_conv + (size_t)l * 3 * 5632;
      const int f = tid & 63, rg = tid >> 6; const int fg = nt * 64 + f;
      const float wa0 = cw[fg], wa1 = cw[5632 + fg], wa2 = cw[2 * 5632 + fg];
      const float wg0 = cw[2816 + fg], wg1 = cw[5632 + 2816 + fg], wg2 = cw[2 * 5632 + 2816 + fg];
      u16* act = p.proj;
      for (int rr = 1 + rg; rr <= 126; rr += 4) {
        const int ts = tin0 - 1 + rr;
        if (ts >= L) break;
        const float a = wa0 * U[(rr - 1) * 132 + f] + wa1 * U[rr * 132 + f] + wa2 * U[(rr + 1) * 132 + f];
        const float g = wg0 * U[(rr - 1) * 132 + 64 + f] + wg1 * U[rr * 132 + 64 + f] + wg2 * U[(rr + 1) * 132 + 64 + f];
        act[(size_t)(seqbase + ts) * 2816 + fg] = f2bf(a * siluf(g));
      }
      __syncthreads();
    }
  }
}

template <int MODE>
DI void attn_item(const P* __restrict__ gp, int jj, int it, char* smem) {
  const P& p = *gp;
  const u16* projp = uni(p.proj); u16* hnp = uni(p.hn); const float* ropep = uni(p.rope);
  u16* Ks = (u16*)smem; u16* Vt = Ks + 64 * 72; float* rpb_s = (float*)(Vt + 64 * 72);
  int tid_ = threadIdx.x; asm volatile("" : "+v"(tid_)); const int tid = tid_, lane = tid & 63, wave = tid >> 6, r = lane & 31, h = lane >> 5;
  constexpr bool EVENL = (MODE == 0 || MODE == 1);
  constexpr bool LAT = (MODE == 1 || MODE == 3);
  constexpr int PS = EVENL ? EVN : ODN;
  int b, hq, qb, tokbase;
  if (!LAT) { b = it >> 4; hq = (it >> 1) & 7; qb = it & 1; tokbase = b * 256; }
  else { b = it >> 8; hq = (it >> 5) & 7; qb = it & 31; tokbase = NP_ + b * 4096; }
  const int hk = EVENL ? hq : (hq >> 2);
  const int kcol = 512 + hk * 64, vcol = (EVENL ? 1024 : 640) + hk * 64, qcol = hq * 64;
  const int tq = qb * 128 + wave * 32 + r;
  const size_t qtok = (size_t)tokbase + tq;
  __syncthreads();
  if (MODE == 1) { for (int i = tid; i < 465; i += 256) rpb_s[i] = p.a_rpb[(size_t)(jj * 8 + hq) * 465 + i]; }
  bf16x8 qf[4];
#pragma unroll
  for (int s = 0; s < 4; ++s) qf[s] = *(const bf16x8*)(projp + qtok * PS + qcol + 16 * s + 8 * h);
  if (MODE == 3) {
    const int prow = tq >> 6, pcol = tq & 63;
#pragma unroll
    for (int half = 0; half < 2; ++half) {
      const int pos = half ? pcol : prow;
#pragma unroll
      for (int j = 0; j < 8; ++j) {
        const float cs = ropep[(pos * 16 + 8 * h + j) * 2], sn = ropep[(pos * 16 + 8 * h + j) * 2 + 1];
        const float x1 = bf2f((u16)qf[2 * half][j]), x2 = bf2f((u16)qf[2 * half + 1][j]);
        qf[2 * half][j] = (short)f2bf(x1 * cs - x2 * sn);
        qf[2 * half + 1][j] = (short)f2bf(x1 * sn + x2 * cs);
      }
    }
  }
  float m_run = -1e30f, l_run = 0.f;
  if (MODE == 2 || MODE == 3) { m_run = p.c_sink[jj * 8 + hq]; l_run = h == 0 ? 1.f : 0.f; }
  f32x16 ot[2]; zero16(ot[0]); zero16(ot[1]);
  int loc0 = 0, nloc = 0;
  if (MODE == 1) {
    const int qi0 = 2 * qb;
    const int rlo = min(max(qi0 - 4, 0), 56), rhi = min(max(qi0 + 1 - 4, 0), 56) + 7;
    loc0 = rlo; nloc = rhi - rlo + 1;
  } else if (MODE == 3) {
    loc0 = max(0, 2 * qb - 2); nloc = min(63, 2 * qb + 3) - loc0 + 1;
  }
  const int qi = tq >> 6, qw = tq & 63;
  const int r0w = min(max(qi - 4, 0), 56), c0w = min(max(qw - 8, 0), 48);
  const int key = tid >> 2, seg = tid & 3;
  for (int kb = 0; kb < 4 + nloc; ++kb) {
    const bool isctx = kb < 4;
    const int blk = isctx ? kb : loc0 + kb - 4;
    __syncthreads();
    {
      float kf[16], vf[16];
      if (LAT && isctx) {
        const float* kc = (MODE == 1) ? p.cache_a_k + ((size_t)((b * 2 + jj) * 8 + hk)) * 16384 : p.cache_c_k + ((size_t)((b * 2 + jj) * 2 + hk)) * 16384;
        const float* vc = (MODE == 1) ? p.cache_a_v + ((size_t)((b * 2 + jj) * 8 + hk)) * 16384 : p.cache_c_v + ((size_t)((b * 2 + jj) * 2 + hk)) * 16384;
        const float4* kp4 = (const float4*)(kc + (size_t)(blk * 64 + key) * 64 + seg * 16);
        const float4* vp4 = (const float4*)(vc + (size_t)(blk * 64 + key) * 64 + seg * 16);
#pragma unroll
        for (int e = 0; e < 4; ++e) {
          const float4 a = kp4[e], c = vp4[e];
          kf[4 * e] = a.x; kf[4 * e + 1] = a.y; kf[4 * e + 2] = a.z; kf[4 * e + 3] = a.w;
          vf[4 * e] = c.x; vf[4 * e + 1] = c.y; vf[4 * e + 2] = c.z; vf[4 * e + 3] = c.w;
        }
      } else {
        const u16* rowp = projp + ((size_t)tokbase + blk * 64 + key) * PS;
        const bf16x8 k0 = *(const bf16x8*)(rowp + kcol + seg * 16), k1 = *(const bf16x8*)(rowp + kcol + seg * 16 + 8);
        const bf16x8 v0 = *(const bf16x8*)(rowp + vcol + seg * 16), v1 = *(const bf16x8*)(rowp + vcol + seg * 16 + 8);
#pragma unroll
        for (int e = 0; e < 8; ++e) { kf[e] = bf2f((u16)k0[e]); kf[8 + e] = bf2f((u16)k1[e]); vf[e] = bf2f((u16)v0[e]); vf[8 + e] = bf2f((u16)v1[e]); }
        if (MODE == 3) {
          const bf16x8 p0 = *(const bf16x8*)(rowp + kcol + (seg ^ 1) * 16), p1 = *(const bf16x8*)(rowp + kcol + (seg ^ 1) * 16 + 8);
          const int pos = (seg & 2) ? key : blk;
#pragma unroll
          for (int e = 0; e < 16; ++e) {
            const float pr = bf2f((u16)(e < 8 ? p0[e & 7] : p1[e & 7]));
            const float cs = ropep[(pos * 16 + e) * 2], sn = ropep[(pos * 16 + e) * 2 + 1];
            kf[e] = (seg & 1) ? (pr * sn + kf[e] * cs) : (kf[e] * cs - pr * sn);
          }
        }
      }
      bf16x8 o0, o1;
#pragma unroll
      for (int e = 0; e < 8; ++e) { o0[e] = (short)f2bf(kf[e]); o1[e] = (short)f2bf(kf[8 + e]); }
      *(bf16x8*)(Ks + key * 72 + seg * 16) = o0;
      *(bf16x8*)(Ks + key * 72 + seg * 16 + 8) = o1;
#pragma unroll
      for (int e = 0; e < 16; ++e) Vt[(seg * 16 + e) * 72 + key] = f2bf(vf[e]);
    }
    __syncthreads();
    bool active = true;
    if (MODE == 1 && !isctx) active = (blk >= r0w && blk < r0w + 8);
    if (active) {
      f32x16 st[2]; zero16(st[0]); zero16(st[1]);
#pragma unroll
      for (int kt = 0; kt < 2; ++kt)
#pragma unroll
        for (int s = 0; s < 4; ++s) {
          const bf16x8 a = *(const bf16x8*)(Ks + (kt * 32 + r) * 72 + 16 * s + 8 * h);
          st[kt] = MFMA(a, qf[s], st[kt]);
        }
      float mx = m_run;
#pragma unroll
      for (int kt = 0; kt < 2; ++kt)
#pragma unroll
        for (int i = 0; i < 16; ++i) {
          float s = st[kt][i] * 0.125f;
          const int kk = kt * 32 + crow(i, h);
          if (MODE == 1 && !isctx) {
            const bool ok = (kk >= c0w && kk < c0w + 16);
            s = ok ? s + rpb_s[(blk - qi + 7) * 31 + (kk - qw + 15)] : -1e30f;
          }
          if (MODE == 3 && !isctx) {
            const int dlt = blk * 64 + kk - tq;
            s = (dlt <= 128 && dlt >= -128) ? s : -1e30f;
          }
          st[kt][i] = s;
          mx = fmaxf(mx, s);
        }
      mx = fmaxf(mx, shx(mx, lane, 32));
      const float alpha = __expf(m_run - mx);
      m_run = mx;
      float ps = 0.f;
#pragma unroll
      for (int kt = 0; kt < 2; ++kt)
#pragma unroll
        for (int i = 0; i < 16; ++i) { const float pv = __expf(st[kt][i] - mx); st[kt][i] = pv; ps += pv; }
      l_run = l_run * alpha + ps;
#pragma unroll
      for (int dt = 0; dt < 2; ++dt)
#pragma unroll
        for (int i = 0; i < 16; ++i) ot[dt][i] *= alpha;
#pragma unroll
      for (int kt = 0; kt < 2; ++kt) {
        const bf16x8 pb0 = packs<0>(st[kt]), pb1 = packs<1>(st[kt]);
#pragma unroll
        for (int dt = 0; dt < 2; ++dt) {
          const bf16x8 pa0 = ld2x4(Vt + (dt * 32 + r) * 72 + kt * 32 + 4 * h);
          const bf16x8 pa1 = ld2x4(Vt + (dt * 32 + r) * 72 + kt * 32 + 16 + 4 * h);
          ot[dt] = MFMA(pa0, pb0, ot[dt]);
          ot[dt] = MFMA(pa1, pb1, ot[dt]);
        }
      }
    }
  }
  l_run += shx(l_run, lane, 32);
  const float inv = 1.f / l_run;
  u16* dst = hnp + qtok * 1024 + qcol;
#pragma unroll
  for (int dt = 0; dt < 2; ++dt)
#pragma unroll
    for (int g4 = 0; g4 < 4; ++g4) {
      ushort4 o;
      o.x = f2bf(ot[dt][4 * g4] * inv); o.y = f2bf(ot[dt][4 * g4 + 1] * inv); o.z = f2bf(ot[dt][4 * g4 + 2] * inv); o.w = f2bf(ot[dt][4 * g4 + 3] * inv);
      *(ushort4*)(dst + dt * 32 + 8 * g4 + 4 * h) = o;
    }
}

struct ChainId { int lat, b, h, dir, T, base, nch; };
DI ChainId chain_decode(int it) {
  ChainId c; c.lat = it < 128; const int q = c.lat ? it : it - 128;
  c.b = q >> 4; c.h = (q >> 1) & 7; c.dir = q & 1; c.T = c.lat ? 4096 : 256; c.base = c.lat ? NP_ + c.b * 4096 : c.b * 256; c.nch = c.T >> 6;
  return c;
}
DI int tokof(const ChainId& c, int step, int row) { const int pp = step * 64 + row; return c.base + (c.dir ? c.T - 1 - pp : pp); }


static constexpr int RING = 4;
static constexpr int SLOT_BYTES = 53760;
DI void wait_ge(int* flag, int val, int tid) {
  if (tid < 64) {
    if (tid == 0) { while (__hip_atomic_load(flag, __ATOMIC_RELAXED, __HIP_MEMORY_SCOPE_AGENT) < val) __builtin_amdgcn_s_sleep(1); }
    __builtin_amdgcn_fence(__ATOMIC_ACQUIRE, "agent");
  }
  __syncthreads();
}
DI void publish(int* flag, int val, int tid) {
  asm volatile("s_waitcnt vmcnt(0)" ::: "memory");
  __syncthreads();
  if (tid == 0) __hip_atomic_store(flag, val, __ATOMIC_RELAXED, __HIP_MEMORY_SCOPE_AGENT);
}
typedef __attribute__((ext_vector_type(4))) unsigned u32x4;
DI void copy_out(const char* lds, char* g, int bytes, int tid) {
  for (int i = opq(tid) * 16; i < bytes; i += 256 * 16) {
    const u32x4 v = *(const u32x4*)(lds + i);
    char* dst = g + i;
    asm volatile("global_store_dwordx4 %0, %1, off sc0 sc1" :: "v"(dst), "v"(v) : "memory");
  }
}
DI void copy_in(char* lds, const char* g, int bytes, int tid) {
  for (int i = opq(tid) * 16; i < bytes; i += 256 * 16) *(uint4*)(lds + i) = *(const uint4*)(g + i);
}

template <int ROLE>
DI void gla_chain(const P* __restrict__ gp, int jj, int it, char* smem, int k0, int kstep) {
  const P& p = *gp;
  const ChainId cid = chain_decode(it);
  int tid_ = threadIdx.x; asm volatile("" : "+v"(tid_)); const int tid = tid_, lane = tid & 63, wave = tid >> 6, r = lane & 31, h = lane >> 5;
  const int hh = cid.h, dir = cid.dir;
  u16* QT = (u16*)smem; u16* KT = QT + 4608; u16* KEt = KT + 4608; u16* Vt = KEt + 4608;
  float* dec = (float*)(Vt + 4608); float* GL = dec + 64; float* gq = GL + 1024; float* Ost = gq + 256;
  constexpr int IMG = 4 * 9216 + 256;
  char* slots = uni(p.ring) + (size_t)it * RING * SLOT_BYTES; int* ready = uni(p.flags) + (jj * 2) * 8320 + it * 64; int* done = uni(p.flags) + (jj * 2) * 8320 + 8192 + it;
  const int d = tid & 63, cq = tid >> 6;
  float wg[16];
#pragma unroll
  for (int rr = 0; rr < 16; ++rr) wg[rr] = p.b_w_g2[((size_t)((jj * 2 + dir) * 16 + rr)) * 512 + hh * 64 + d];
  const float bg = p.b_b_g[(jj * 2 + dir) * 512 + hh * 64 + d];
  const int vh = wave & 1;
  f32x16 S[2]; zero16(S[0]); zero16(S[1]);
  const size_t sidx = ((size_t)(((cid.b * 2 + jj) * 2 + dir) * 8 + hh)) * 4096;
  if (ROLE != 1 && wave < 2 && cid.lat) {
#pragma unroll
    for (int dt = 0; dt < 2; ++dt)
#pragma unroll
      for (int i = 0; i < 16; ++i) S[dt][i] = p.state_b[sidx + (dt * 32 + crow(i, h)) * 64 + vh * 32 + r];
  }
  for (int step_ = k0; step_ < cid.nch; step_ += kstep) {
    int step = step_;
    asm volatile("" : "+v"(step));
    if (ROLE == 1) wait_ge(done, step_ - RING + 1, tid);
    if (ROLE == 2) wait_ge(ready + step_, 1, tid);
    __syncthreads();
    if (ROLE == 2) { copy_in(smem, slots + (size_t)(step_ % RING) * SLOT_BYTES, IMG, tid); __syncthreads(); if (tid == 0) __hip_atomic_store(done, step_ + 1, __ATOMIC_RELAXED, __HIP_MEMORY_SCOPE_AGENT); }
    if (ROLE != 2) {
    {
      const int c = tid >> 2, sg = tid & 3;
      const int tok = tokof(cid, step, c);
      const ushort4 gv = *(const ushort4*)(p.proj + (size_t)tok * EVN + 3072 + dir * 16 + sg * 4);
      GL[c * 16 + sg * 4] = bf2f(gv.x); GL[c * 16 + sg * 4 + 1] = bf2f(gv.y); GL[c * 16 + sg * 4 + 2] = bf2f(gv.z); GL[c * 16 + sg * 4 + 3] = bf2f(gv.w);
    }
    __syncthreads();
    float Gl[16]; float run = 0.f;
#pragma unroll
    for (int i = 0; i < 16; ++i) {
      const int c = cq * 16 + i;
      float z = bg;
#pragma unroll
      for (int rr = 0; rr < 16; ++rr) z += GL[c * 16 + rr] * wg[rr];
      const float g = (fminf(z, 0.f) - __logf(1.f + __expf(-fabsf(z)))) * (1.f / 16.f);
      run += g; Gl[i] = run;
    }
    gq[cq * 64 + d] = run;
    __syncthreads();
    float off = 0.f, tot = 0.f;
#pragma unroll
    for (int q2 = 0; q2 < 4; ++q2) { const float t = gq[q2 * 64 + d]; if (q2 < cq) off += t; tot += t; }
#pragma unroll
    for (int i = 0; i < 16; ++i) {
      const int c = cq * 16 + i;
      const int tok = tokof(cid, step, c);
      const float G = Gl[i] + off;
      const u16* rowp = p.proj + (size_t)tok * EVN + hh * 64 + d;
      const float qv = bf2f(rowp[1536]), kv = bf2f(rowp[2048]);
      const u16 vb = rowp[2560];
      QT[c * 72 + d] = f2bf(qv * 0.125f * __expf(G));
      KT[c * 72 + d] = f2bf(kv * __expf(-G));
      KEt[d * 72 + c] = f2bf(kv * __expf(tot - G));
      Vt[d * 72 + c] = vb;
    }
    if (cq == 0) dec[d] = __expf(tot);
    __syncthreads();
    }
    if (ROLE == 1) { copy_out(smem, slots + (size_t)(step_ % RING) * SLOT_BYTES, IMG, tid); publish(ready + step_, 1, tid); continue; }
    if (wave < 2) {
      f32x16 at[2][2];
#pragma unroll
      for (int a = 0; a < 2; ++a)
#pragma unroll
        for (int b2 = 0; b2 < 2; ++b2) zero16(at[a][b2]);
#pragma unroll
      for (int ks = 0; ks < 4; ++ks) {
        const bf16x8 a0 = *(const bf16x8*)(KT + r * 72 + ks * 16 + 8 * h), a1 = *(const bf16x8*)(KT + (32 + r) * 72 + ks * 16 + 8 * h);
        const bf16x8 b0 = *(const bf16x8*)(QT + r * 72 + ks * 16 + 8 * h), b1 = *(const bf16x8*)(QT + (32 + r) * 72 + ks * 16 + 8 * h);
        at[0][0] = MFMA(a0, b0, at[0][0]); at[0][1] = MFMA(a0, b1, at[0][1]);
        at[1][0] = MFMA(a1, b0, at[1][0]); at[1][1] = MFMA(a1, b1, at[1][1]);
      }
#pragma unroll
      for (int st = 0; st < 2; ++st)
#pragma unroll
        for (int ct = 0; ct < 2; ++ct)
#pragma unroll
          for (int i = 0; i < 16; ++i) { if (st * 32 + crow(i, h) > ct * 32 + r) at[st][ct][i] = 0.f; }
      f32x16 o[2]; zero16(o[0]); zero16(o[1]);
#pragma unroll
      for (int ct = 0; ct < 2; ++ct)
#pragma unroll
        for (int st = 0; st < 2; ++st) {
          const bf16x8 x0 = packs<0>(at[st][ct]), x1 = packs<1>(at[st][ct]);
          const bf16x8 pb0 = ld2x4(Vt + (vh * 32 + r) * 72 + st * 32 + 4 * h);
          const bf16x8 pb1 = ld2x4(Vt + (vh * 32 + r) * 72 + st * 32 + 16 + 4 * h);
          o[ct] = MFMA(x0, pb0, o[ct]);
          o[ct] = MFMA(x1, pb1, o[ct]);
        }
#pragma unroll
      for (int dt = 0; dt < 2; ++dt) {
        const bf16x8 xs0 = packs<0>(S[dt]), xs1 = packs<1>(S[dt]);
#pragma unroll
        for (int ct = 0; ct < 2; ++ct) {
          const bf16x8 pa0 = ld2x4(QT + (ct * 32 + r) * 72 + dt * 32 + 4 * h);
          const bf16x8 pa1 = ld2x4(QT + (ct * 32 + r) * 72 + dt * 32 + 16 + 4 * h);
          o[ct] = MFMA(pa0, xs0, o[ct]);
          o[ct] = MFMA(pa1, xs1, o[ct]);
        }
      }
#pragma unroll
      for (int dt = 0; dt < 2; ++dt)
#pragma unroll
        for (int i = 0; i < 16; ++i) S[dt][i] *= dec[dt * 32 + crow(i, h)];
#pragma unroll
      for (int ks = 0; ks < 4; ++ks) {
        const bf16x8 bv = *(const bf16x8*)(Vt + (vh * 32 + r) * 72 + ks * 16 + 8 * h);
#pragma unroll
        for (int dt = 0; dt < 2; ++dt) {
          const bf16x8 a = *(const bf16x8*)(KEt + (dt * 32 + r) * 72 + ks * 16 + 8 * h);
          S[dt] = MFMA(a, bv, S[dt]);
        }
      }
#pragma unroll
      for (int ct = 0; ct < 2; ++ct)
#pragma unroll
        for (int i = 0; i < 16; ++i) Ost[(ct * 32 + crow(i, h)) * 68 + vh * 32 + r] = o[ct][i];
    }
    __syncthreads();
    {
      const int c = tid >> 2, sg = tid & 3;
      const int tok = tokof(cid, step, c);
      u16* dst = (dir ? p.ot1 + (size_t)tok * 512 + hh * 64 : p.hn + (size_t)tok * 1024 + 512 + hh * 64) + sg * 16;
      bf16x8 w0, w1;
#pragma unroll
      for (int e = 0; e < 8; ++e) { w0[e] = (short)f2bf(Ost[c * 68 + sg * 16 + e]); w1[e] = (short)f2bf(Ost[c * 68 + sg * 16 + 8 + e]); }
      *(bf16x8*)dst = w0; *(bf16x8*)(dst + 8) = w1;
    }
  }
  if (wave < 2 && !cid.lat) {
#pragma unroll
    for (int dt = 0; dt < 2; ++dt)
#pragma unroll
      for (int i = 0; i < 16; ++i) p.out[OFF_SB + sidx + (dt * 32 + crow(i, h)) * 64 + vh * 32 + r] = S[dt][i];
  }
}

template <int ROLE>
DI void delta_chain(const P* __restrict__ gp, int jj, int it, char* smem, int k0, int kstep) {
  const P& p = *gp;
  const ChainId cid = chain_decode(it);
  int tid_ = threadIdx.x; asm volatile("" : "+v"(tid_)); const int tid0 = tid_;
  const int hh = cid.h, dir = cid.dir;
  u16* Qn = (u16*)smem; u16* Kt = Qn + 4608; u16* AQK = Kt + 4608; u16* KC = AQK + 4608;
  float* Wv = (float*)(KC + 4608); float* Gs = Wv + 64 * 65; u16* Kn = (u16*)(Gs + 64); float* At = (float*)(Kn + 4608); float* Bt = At + 64 * 68;
  constexpr int IMG = 4 * 9216 + 16640 + 256;
  char* slots = uni(p.ring) + (size_t)it * RING * SLOT_BYTES; int* ready = uni(p.flags) + (jj * 2 + 1) * 8320 + it * 64; int* done = uni(p.flags) + (jj * 2 + 1) * 8320 + 8192 + it;
  const float aexp = __expf(p.d_a_log[(jj * 2 + dir) * 8 + hh]);
  const float dtb = p.d_dt_bias[(jj * 2 + dir) * 8 + hh];
  f32x16 S[2]; zero16(S[0]); zero16(S[1]);
  const size_t sidx = ((size_t)(((cid.b * 2 + jj) * 2 + dir) * 8 + hh)) * 4096;
  { const int tid = tid0, lane = tid & 63, wave = tid >> 6, r = lane & 31, h = lane >> 5;
  if (ROLE != 1 && wave < 2 && cid.lat) {
    const int vh = wave & 1;
#pragma unroll
    for (int dt = 0; dt < 2; ++dt)
#pragma unroll
      for (int i = 0; i < 16; ++i) S[dt][i] = p.state_d[sidx + (dt * 32 + crow(i, h)) * 64 + vh * 32 + r];
  }
  }
  u16* CW = (u16*)(smem + 80640);
  __syncthreads();
  for (int i = tid0; i < 576; i += 256) { const int tap = i / 192, c2 = i - tap * 192; const int wh = c2 >> 6, dd = c2 & 63;
    CW[i] = f2bf(p.d_conv[(size_t)jj * 3 * 1536 + tap * 1536 + wh * 512 + hh * 64 + dd]); }
  for (int step_ = k0; step_ < cid.nch; step_ += kstep) {
    int step = step_;
    asm volatile("" : "+v"(step));
    if (ROLE == 1) wait_ge(done, step_ - RING + 1, tid0);
    if (ROLE == 2) wait_ge(ready + step_, 1, tid0);
    __syncthreads();
    if (ROLE == 2) { copy_in(smem, slots + (size_t)(step_ % RING) * SLOT_BYTES, IMG, tid0); __syncthreads(); if (tid0 == 0) __hip_atomic_store(done, step_ + 1, __ATOMIC_RELAXED, __HIP_MEMORY_SCOPE_AGENT); }
    if (ROLE != 2) {
    {const int tid = opq(tid0), lane = tid & 63, wave = __builtin_amdgcn_readfirstlane(tid >> 6), r = lane & 31, h = lane >> 5, vh = wave & 1; (void)r; (void)h; (void)vh; (void)lane;
    if (wave == 0) {
      const int tok = tokof(cid, step, lane);
      const float da = bf2f(p.proj[(size_t)tok * ODN + 2304 + dir * 8 + hh]);
      const float db = bf2f(p.proj[(size_t)tok * ODN + 2320 + dir * 8 + hh]);
      const float x = da + dtb;
      const float sp = x > 20.f ? x : __logf(1.f + __expf(x));
      float G = -aexp * sp;
#pragma unroll
      for (int o = 1; o < 64; o <<= 1) { const float t = __int_as_float(__builtin_amdgcn_ds_bpermute((lane - o) << 2, __float_as_int(G))); if (lane >= o) G += t; }
      Gs[lane] = G; Bt[lane] = 1.f / (1.f + __expf(-db));
    }
    {
      const int c = tid >> 2, sg = tid & 3;
      const int tok = tokof(cid, step, c);
      const int pos = tok - cid.base;
      const bool hp = pos > 0, hn_ = pos < cid.T - 1;
#pragma unroll 1
      for (int wh = 0; wh < 3; ++wh) {
        const int ch0 = wh * 512 + hh * 64 + sg * 16;
        const u16* cur = p.proj + (size_t)tok * ODN + 768 + ch0;
        float y[16];
        float ss = 0.f;
#pragma unroll
        for (int hf = 0; hf < 2; ++hf) {
          const bf16x8 xc = *(const bf16x8*)(cur + hf * 8);
          bf16x8 xp, xn;
#pragma unroll
          for (int e = 0; e < 8; ++e) { xp[e] = 0; xn[e] = 0; }
          if (hp) xp = *(const bf16x8*)(cur - ODN + hf * 8);
          if (hn_) xn = *(const bf16x8*)(cur + ODN + hf * 8);
#pragma unroll
          for (int e = 0; e < 8; ++e) {
            const int ch = wh * 64 + sg * 16 + hf * 8 + e;
            float v = bf2f(CW[ch]) * bf2f((u16)xp[e]) + bf2f(CW[192 + ch]) * bf2f((u16)xc[e]) + bf2f(CW[384 + ch]) * bf2f((u16)xn[e]);
            v = v / (1.f + __expf(-v));
            y[hf * 8 + e] = v; ss += v * v;
          }
        }
        ss += shx(ss, lane, 1); ss += shx(ss, lane, 2);
        const float rn = rsqrtf(ss + 1e-6f);
        if (wh == 0) {
#pragma unroll
          for (int e = 0; e < 16; ++e) Qn[c * 72 + sg * 16 + e] = f2bf(y[e] * rn * 0.125f);
        } else if (wh == 1) {
#pragma unroll
          for (int e = 0; e < 16; ++e) { const u16 kb = f2bf(y[e] * rn); Kn[c * 72 + sg * 16 + e] = kb; Kt[(sg * 16 + e) * 72 + c] = kb; }
        } else {
#pragma unroll
          for (int e = 0; e < 16; ++e) Wv[c * 65 + sg * 16 + e] = y[e];
        }
      }
    }
    }
    __syncthreads();
    {const int tid = opq(tid0), lane = tid & 63, wave = __builtin_amdgcn_readfirstlane(tid >> 6), r = lane & 31, h = lane >> 5, vh = wave & 1; (void)r; (void)h; (void)vh; (void)lane;
    if (wave < 2) {
      f32x16 akk[2], aqk[2]; zero16(akk[0]); zero16(akk[1]); zero16(aqk[0]); zero16(aqk[1]);
#pragma unroll
      for (int ks = 0; ks < 4; ++ks) {
        const bf16x8 bk = *(const bf16x8*)(Kn + (vh * 32 + r) * 72 + ks * 16 + 8 * h);
#pragma unroll
        for (int ct = 0; ct < 2; ++ct) {
          const bf16x8 ak = *(const bf16x8*)(Kn + (ct * 32 + r) * 72 + ks * 16 + 8 * h);
          const bf16x8 aq = *(const bf16x8*)(Qn + (ct * 32 + r) * 72 + ks * 16 + 8 * h);
          akk[ct] = MFMA(ak, bk, akk[ct]);
          aqk[ct] = MFMA(aq, bk, aqk[ct]);
        }
      }
      const int s = vh * 32 + r;
      const float Gss = Gs[s];
#pragma unroll
      for (int ct = 0; ct < 2; ++ct)
#pragma unroll
        for (int g4 = 0; g4 < 4; ++g4) {
          const int c0 = ct * 32 + 8 * g4 + 4 * h;
          const float4 gv4 = *(const float4*)(Gs + c0), bv4 = *(const float4*)(Bt + c0);
          float4 val;
#pragma unroll
          for (int e = 0; e < 4; ++e) {
            const int c = c0 + e;
            const float Gc = e == 0 ? gv4.x : e == 1 ? gv4.y : e == 2 ? gv4.z : gv4.w;
            const float Bc = e == 0 ? bv4.x : e == 1 ? bv4.y : e == 2 ? bv4.z : bv4.w;
            const float gam = __expf(fminf(Gc - Gss, 0.f));
            const float av = (s < c) ? akk[ct][4 * g4 + e] * Bc * gam : 0.f;
            if (e == 0) val.x = av; else if (e == 1) val.y = av; else if (e == 2) val.z = av; else val.w = av;
            AQK[c * 72 + s] = f2bf((s <= c) ? aqk[ct][4 * g4 + e] * gam : 0.f);
          }
          *(float4*)(At + s * 68 + c0) = val;
        }
    }
    }
    __syncthreads();
    {const int tid = opq(tid0), lane = tid & 63, wave = __builtin_amdgcn_readfirstlane(tid >> 6), r = lane & 31, h = lane >> 5, vh = wave & 1; (void)r; (void)h; (void)vh; (void)lane;
    if (wave < 2) {
      const bool isv = wave == 0;
      const int col = lane;
#pragma unroll 1
      for (int bi = 0; bi < 4; ++bi) {
        float acc[16];
#pragma unroll
        for (int ci = 0; ci < 16; ++ci) {
          const int c = 16 * bi + ci;
          acc[ci] = isv ? Wv[c * 65 + col] * Bt[c] : bf2f(Kn[c * 72 + col]) * Bt[c] * __expf(Gs[c]);
        }
#pragma unroll 8
        for (int s2 = 0; s2 < 16 * bi; ++s2) {
          const float xs = isv ? Wv[s2 * 65 + col] : bf2f(KC[s2 * 72 + col]);
          const float4* a4 = (const float4*)(At + s2 * 68 + 16 * bi);
#pragma unroll
          for (int q = 0; q < 4; ++q) {
            const float4 a = a4[q];
            acc[4 * q] -= a.x * xs; acc[4 * q + 1] -= a.y * xs; acc[4 * q + 2] -= a.z * xs; acc[4 * q + 3] -= a.w * xs;
          }
        }
#pragma unroll
        for (int ci = 0; ci < 16; ++ci) {
          const float x = acc[ci];
          const float* arow = At + (16 * bi + ci) * 68 + 16 * bi;
#pragma unroll
          for (int cj = ci + 1; cj < 16; ++cj) acc[cj] -= arow[cj] * x;
          if (isv) Wv[(16 * bi + ci) * 65 + col] = x; else KC[(16 * bi + ci) * 72 + col] = f2bf(x);
        }
      }
    }
    }
    __syncthreads();
    }
    if (ROLE == 1) { copy_out(smem, slots + (size_t)(step_ % RING) * SLOT_BYTES, IMG, tid0); publish(ready + step_, 1, tid0); continue; }
    {const int tid = opq(tid0), lane = tid & 63, wave = __builtin_amdgcn_readfirstlane(tid >> 6), r = lane & 31, h = lane >> 5, vh = wave & 1; (void)r; (void)h; (void)vh; (void)lane;
    if (wave < 2) {
      f32x16 kS[2], qS[2]; zero16(kS[0]); zero16(kS[1]); zero16(qS[0]); zero16(qS[1]);
#pragma unroll
      for (int dt = 0; dt < 2; ++dt) {
        const bf16x8 xs0 = packs<0>(S[dt]), xs1 = packs<1>(S[dt]);
#pragma unroll
        for (int ct = 0; ct < 2; ++ct) {
          kS[ct] = MFMA(ld2x4(KC + (ct * 32 + r) * 72 + dt * 32 + 4 * h), xs0, kS[ct]);
          kS[ct] = MFMA(ld2x4(KC + (ct * 32 + r) * 72 + dt * 32 + 16 + 4 * h), xs1, kS[ct]);
          qS[ct] = MFMA(ld2x4(Qn + (ct * 32 + r) * 72 + dt * 32 + 4 * h), xs0, qS[ct]);
          qS[ct] = MFMA(ld2x4(Qn + (ct * 32 + r) * 72 + dt * 32 + 16 + 4 * h), xs1, qS[ct]);
        }
      }
      f32x16 vn[2], o[2];
      const float Glast = Gs[63];
#pragma unroll
      for (int ct = 0; ct < 2; ++ct)
#pragma unroll
        for (int i = 0; i < 16; ++i) {
          const int c = ct * 32 + crow(i, h);
          vn[ct][i] = Wv[c * 65 + vh * 32 + r] - kS[ct][i];
          o[ct][i] = qS[ct][i] * __expf(Gs[c]);
        }
#pragma unroll
      for (int st = 0; st < 2; ++st) {
        const bf16x8 xs0 = packs<0>(vn[st]), xs1 = packs<1>(vn[st]);
#pragma unroll
        for (int ct = 0; ct < 2; ++ct) {
          o[ct] = MFMA(ld2x4(AQK + (ct * 32 + r) * 72 + st * 32 + 4 * h), xs0, o[ct]);
          o[ct] = MFMA(ld2x4(AQK + (ct * 32 + r) * 72 + st * 32 + 16 + 4 * h), xs1, o[ct]);
        }
      }
      const float dl = __expf(Glast);
#pragma unroll
      for (int st = 0; st < 2; ++st) {
        asm volatile("" ::: "memory");
#pragma unroll
        for (int i = 0; i < 16; ++i) vn[st][i] *= __expf(Glast - Gs[st * 32 + crow(i, h)]);
      }
      asm volatile("" ::: "memory");
#pragma unroll
      for (int dt = 0; dt < 2; ++dt)
#pragma unroll
        for (int i = 0; i < 16; ++i) S[dt][i] *= dl;
#pragma unroll
      for (int st = 0; st < 2; ++st) {
        const bf16x8 xs0 = packs<0>(vn[st]), xs1 = packs<1>(vn[st]);
#pragma unroll
        for (int dt = 0; dt < 2; ++dt) {
          S[dt] = MFMA(ld2x4(Kt + (dt * 32 + r) * 72 + st * 32 + 4 * h), xs0, S[dt]);
          S[dt] = MFMA(ld2x4(Kt + (dt * 32 + r) * 72 + st * 32 + 16 + 4 * h), xs1, S[dt]);
        }
      }
#pragma unroll
      for (int ct = 0; ct < 2; ++ct)
#pragma unroll
        for (int i = 0; i < 16; ++i) At[(ct * 32 + crow(i, h)) * 68 + vh * 32 + r] = o[ct][i];
    }
    }
    __syncthreads();
    {
      const int tid = opq(tid0);
      const int c = tid >> 2, sg = tid & 3;
      const int tok = tokof(cid, step, c);
      u16* dst = (dir ? p.ot1 + (size_t)tok * 512 + hh * 64 : p.hn + (size_t)tok * 1024 + 512 + hh * 64) + sg * 16;
      bf16x8 w0, w1;
#pragma unroll
      for (int e = 0; e < 8; ++e) { w0[e] = (short)f2bf(At[c * 68 + sg * 16 + e]); w1[e] = (short)f2bf(At[c * 68 + sg * 16 + 8 + e]); }
      *(bf16x8*)dst = w0; *(bf16x8*)(dst + 8) = w1;
    }
  }
  {const int tid = opq(tid0), lane = tid & 63, wave = __builtin_amdgcn_readfirstlane(tid >> 6), r = lane & 31, h = lane >> 5, vh = wave & 1; (void)r; (void)h; (void)vh; (void)lane;
  if (wave < 2 && !cid.lat) {
#pragma unroll
    for (int dt = 0; dt < 2; ++dt)
#pragma unroll
      for (int i = 0; i < 16; ++i) p.out[OFF_SD + sidx + (dt * 32 + crow(i, h)) * 64 + vh * 32 + r] = S[dt][i];
  }
}
}

DI void mixer_phase(const P* __restrict__ gp, int l, char* smem) {
  const P& p = *gp;
  const bool even = !(l & 1); const int jj = l >> 1;
  const bool teams = gridDim.x >= 512;
  if (teams) {
    const int bid = blockIdx.x;
    const int K = even ? 2 : 3;
    if (bid < 128 * (K + 1)) {
      if (bid < 128) { if (even) gla_chain<2>(gp, jj, bid, smem, 0, 1); else delta_chain<2>(gp, jj, bid, smem, 0, 1); }
      else { const int ch = (bid - 128) & 127, k = (bid - 128) >> 7; if (even) gla_chain<1>(gp, jj, ch, smem, k, K); else delta_chain<1>(gp, jj, ch, smem, k, K); }
    }
  }
  const int first = teams ? 128 : 0;
  const int total = 384 + 2048 + 256;
  int* s_item = (int*)(smem + SMEM_BYTES - 16);
  int* cntp = uni(p.cnt) + l;
  for (;;) {
    __syncthreads();
    if (opq(threadIdx.x) == 0) *s_item = atomicAdd(cntp, 1) + first;
    __syncthreads();
    const int item = __builtin_amdgcn_readfirstlane(*s_item);
    if (item >= total) break;
    if (item < 384) { if (even) gla_chain<0>(gp, jj, item, smem, 0, 1); else delta_chain<0>(gp, jj, item, smem, 0, 1); }
    else if (item < 384 + 2048) { if (even) attn_item<1>(gp, jj, item - 384, smem); else attn_item<3>(gp, jj, item - 384, smem); }
    else { if (even) attn_item<0>(gp, jj, item - 384 - 2048, smem); else attn_item<2>(gp, jj, item - 384 - 2048, smem); }
  }
}

DI void finalize_phase(const P* __restrict__ gp, int l) {
  const P& p = *gp;
  const bool even = !(l & 1); const int jj = l >> 1;
  int tid_ = threadIdx.x; asm volatile("" : "+v"(tid_)); const int tid = tid_;
  const int tk = tid >> 5, hh = (tid >> 2) & 7, sg = tid & 3;
  const int PS = even ? EVN : ODN; const int zcol = even ? 3104 : 2336;
  for (int item = blockIdx.x; item < NT_ / 8; item += gridDim.x) {
    const size_t tok = (size_t)item * 8 + tk;
    u16* a = p.hn + tok * 1024 + 512 + hh * 64 + sg * 16;
    const u16* bsrc = p.ot1 + tok * 512 + hh * 64 + sg * 16;
    const u16* zs = p.proj + tok * PS + zcol + hh * 64 + sg * 16;
    float o[16]; float ss = 0.f;
#pragma unroll
    for (int hf = 0; hf < 2; ++hf) {
      const bf16x8 x0 = *(const bf16x8*)(a + hf * 8), x1 = *(const bf16x8*)(bsrc + hf * 8);
#pragma unroll
      for (int e = 0; e < 8; ++e) { const float v = bf2f((u16)x0[e]) + bf2f((u16)x1[e]); o[hf * 8 + e] = v; ss += v * v; }
    }
    ss += shx(ss, tid & 63, 1); ss += shx(ss, tid & 63, 2);
    const float rstd = rsqrtf(ss * (1.f / 64.f) + 1e-6f);
    const float* ng = even ? p.b_norm_g + jj * 512 + hh * 64 + sg * 16 : p.d_norm_g + jj * 64 + sg * 16;
#pragma unroll
    for (int hf = 0; hf < 2; ++hf) {
      const bf16x8 z = *(const bf16x8*)(zs + hf * 8);
      bf16x8 w;
#pragma unroll
      for (int e = 0; e < 8; ++e) { const float zz = bf2f((u16)z[e]); w[e] = (short)f2bf(o[hf * 8 + e] * rstd * ng[hf * 8 + e] * siluf(zz)); }
      *(bf16x8*)(a + hf * 8) = w;
    }
  }
}

DI void run_phase(const P* __restrict__ gp, int ph, char* smem) {
  const P& p = *gp;
  if (ph == 0) { prep_phase(gp, smem); return; }
  if (ph == NPH - 1) { norm_phase(gp, 0, 0, false, true); return; }
  const int l = (ph - 1) >> 3, s = (ph - 1) & 7;
  const bool even = !(l & 1);
  const u16* W = uni(p.wt) + (size_t)l * LW;
  const u16* hnp = uni(p.hn); const u16* projp = uni(p.proj);
  switch (s) {
    case 0: norm_phase(gp, l, 0, l == 0, false); break;
    case 1: gemm_phase<EPI_PROJ>(gp, l, smem, hnp, 1024, W + WO_IN, 1024, 1024, 288, even ? 29 : 23, 0); break;
    case 2: mixer_phase(gp, l, smem); break;
    case 3: finalize_phase(gp, l); break;
    case 4: gemm_phase<EPI_RES>(gp, l, smem, hnp, 1024, W + WO_OUT, 1024, 1024, 288, 8, 2); break;
    case 5: norm_phase(gp, l, 1, false, false); break;
    case 6: gemm_phase<EPI_FFN>(gp, l, smem, hnp, 1024, W + WO_UP, 1024, 1024, 312, 44, 0); break;
    case 7: gemm_phase<EPI_RES>(gp, l, smem, projp, 2816, W + WO_DN, 2816, 2816, 288, 8, 5); break;
  }
}

__global__ void __launch_bounds__(256, 2) mk(P p, P* gpmem, int ph0, int ph1) {
  __shared__ __attribute__((aligned(16))) char smem[SMEM_BYTES];
  const P* gp = &p;
  if (ph1 - ph0 > 1) {
    cg::grid_group grid = cg::this_grid();
    for (int ph = ph0; ph < ph1; ++ph) {
      run_phase(gp, ph, smem);
      if (ph + 1 < ph1) grid.sync();
    }
  } else {
    run_phase(gp, ph0, smem);
  }
}

extern "C" void kernel_launch(void* const* d_in, const int* in_sizes, int n_in, void* d_out, int out_size, void* d_ws, size_t ws_size,
                              hipStream_t stream) {
  P p{};
  const float** f = (const float**)&p;
  for (int i = 0; i < 31; ++i) f[i] = (const float*)d_in[i];
  p.out = (float*)d_out;
  char* ws = (char*)d_ws;
  size_t off = 0;
  p.hn = (u16*)(ws + off); off += (size_t)NT_ * 1024 * 2;
  p.proj = (u16*)(ws + off); off += (size_t)NT_ * EVN * 2;
  p.ot1 = (u16*)(ws + off); off += (size_t)NT_ * 512 * 2;
  p.wt = (u16*)(ws + off); off += 4 * LW * 2;
  p.mods = (float*)(ws + off); off += 4 * 9 * 6144 * 4;
  p.rope = (float*)(ws + off); off += 64 * 16 * 2 * 4;
  P* gp = (P*)(ws + off); off += 4096;
  p.cnt = (int*)(ws + off); off += 256;
  p.flags = (int*)(ws + off); off += 4 * 8320 * 4;
  off = (off + 255) & ~(size_t)255;
  p.ring = ws + off; off += (size_t)128 * RING * SLOT_BYTES;
  static int grid_blocks = 0;
  if (!grid_blocks) {
    int dev = 0, cus = 0, per_cu = 0;
    hipGetDevice(&dev);
    hipDeviceGetAttribute(&cus, hipDeviceAttributeMultiprocessorCount, dev);
    hipOccupancyMaxActiveBlocksPerMultiprocessor(&per_cu, mk, 256, 0);
    if (per_cu < 1) per_cu = 1;
    if (per_cu > 2) per_cu = 2;
    grid_blocks = cus * per_cu;
  }
#if MK_MULTI
  for (int ph = 0; ph < NPH; ++ph) {
    int a = ph, b = ph + 1;
    hipLaunchKernelGGL(mk, dim3(grid_blocks), dim3(256), 0, stream, p, gp, a, b);
  }
#else
  int ph0 = 0, ph1 = NPH;
  void* args[] = {&p, &gp, &ph0, &ph1};
  hipError_t e = hipLaunchCooperativeKernel((void*)mk, dim3(grid_blocks), dim3(256), args, 0, stream);
  if (e != hipSuccess) fprintf(stderr, "cooperative launch failed: %s (grid %d)\n", hipGetErrorString(e), grid_blocks);
#endif
}
```

```cpp
#include <hip/hip_runtime.h>
#include <hip/hip_cooperative_groups.h>
#include <cstdio>
namespace cg = cooperative_groups;

#ifndef MK_MULTI
#define MK_MULTI 0
#endif

#define DI __device__ __forceinline__
#define DN __device__ __noinline__
typedef unsigned short u16;
typedef __attribute__((ext_vector_type(8))) short bf16x8;
typedef __attribute__((ext_vector_type(4))) short s16x4;
typedef __attribute__((ext_vector_type(16))) float f32x16;
#define MFMA(a, b, c) __builtin_amdgcn_mfma_f32_32x32x16_bf16((a), (b), (c), 0, 0, 0)

static constexpr int NP_ = 4096, NT_ = 36864;
static constexpr int EVN = 3616, ODN = 2848;
static constexpr size_t OFF_AK = 37748736, OFF_AV = 41943040, OFF_SB = 46137344, OFF_CK = 48234496, OFF_CV = 49283072, OFF_SD = 50331648;
static constexpr size_t LW = 13500416, WO_UP = 0, WO_DN = 5767168, WO_IN = 8650752, WO_OUT = 12451840;
static constexpr int NPH = 34;
static constexpr int SMEM_BYTES = 80 * 1024;

struct P {
  const float *x_prompt, *x_sample, *cache_a_k, *cache_a_v, *state_b, *cache_c_k, *cache_c_v, *state_d, *c, *c_ctx, *ada_w, *ada_b,
      *norm1_g, *norm2_g, *ffn_up, *ffn_conv, *ffn_down, *ev_w_in, *ev_w_out, *a_rpb, *b_w_g2, *b_b_g, *b_norm_g, *od_w_in, *od_w_out,
      *c_sink, *d_conv, *d_a_log, *d_dt_bias, *d_norm_g, *final_g;
  float* out;
  u16 *hn, *proj, *ot1, *wt;
  float *mods, *rope;
  int* cnt;
  int* flags;
  char* ring;
};

DI u16 f2bf(float x) { unsigned u = __float_as_uint(x); u += 0x7fffu + ((u >> 16) & 1u); return (u16)(u >> 16); }
DI float bf2f(u16 b) { return __uint_as_float(((unsigned)b) << 16); }
DI int crow(int i, int h) { return (i & 3) + 8 * (i >> 2) + 4 * h; }
template <int S> DI bf16x8 packs(const f32x16& x) {
  bf16x8 v;
#pragma unroll
  for (int j = 0; j < 8; ++j) v[j] = (short)f2bf(x[8 * S + j]);
  return v;
}
DI bf16x8 ld2x4(const u16* p) {
  s16x4 lo = *(const s16x4*)p, hi = *(const s16x4*)(p + 8);
  return __builtin_shufflevector(lo, hi, 0, 1, 2, 3, 4, 5, 6, 7);
}
DI float siluf(float x) { return x / (1.f + __expf(-x)); }
DI int opq(int x) { asm volatile("" : "+v"(x)); return x; }
DI float shx(float v, int lane, int o) { return __int_as_float(__builtin_amdgcn_ds_bpermute((lane ^ o) << 2, __float_as_int(v))); }
template <class T> DI T* uni(T* q) { return q; }
DI void zero16(f32x16& a) {
#pragma unroll
  for (int i = 0; i < 16; ++i) a[i] = 0.f;
}

DI void prep_phase(const P* __restrict__ gp, char* smem) {
  const P& p = *gp;
  int tid_ = threadIdx.x; asm volatile("" : "+v"(tid_)); const int tid = tid_;
  const int NWT = 4 * (1408 + 704 + 256) + 2 * (928 + 736);
  const int NADA = 384;
  const int total = NWT + NADA + 1;
  for (int item = blockIdx.x; item < total; item += gridDim.x) {
    if (item < NWT) {
      int rem = item; const float* src = nullptr; u16* dst = nullptr; int K = 0, N = 0, NPd = 0;
      for (int l = 0; l < 4; ++l) {
        const int jj = l >> 1; const bool ev = !(l & 1);
        const int nin = ev ? 928 : 736;
        if (rem < 1408) { src = p.ffn_up + (size_t)l * 1024 * 5632; dst = p.wt + l * LW + WO_UP; K = 1024; N = 5632; NPd = 5632; break; }
        rem -= 1408;
        if (rem < 704) { src = p.ffn_down + (size_t)l * 2816 * 1024; dst = p.wt + l * LW + WO_DN; K = 2816; N = 1024; NPd = 1024; break; }
        rem -= 704;
        if (rem < nin) { src = ev ? p.ev_w_in + (size_t)jj * 1024 * EVN : p.od_w_in + (size_t)jj * 1024 * ODN; dst = p.wt + l * LW + WO_IN; K = 1024; N = ev ? EVN : ODN; NPd = ev ? 3712 : 2944; break; }
        rem -= nin;
        if (rem < 256) { src = (ev ? p.ev_w_out : p.od_w_out) + (size_t)jj * 1024 * 1024; dst = p.wt + l * LW + WO_OUT; K = 1024; N = 1024; NPd = 1024; break; }
        rem -= 256;
      }
      const int ntn = NPd >> 6;
      const int tk = rem / ntn, tn = rem - tk * ntn;
      const int scol0 = (N == 5632) ? ((tn & 1) * 2816 + (tn >> 1) * 64) : tn * 64;
      float* T = (float*)smem;
      __syncthreads();
#pragma unroll
      for (int i = 0; i < 16; ++i) {
        const int k = i * 4 + (tid >> 6), n = tid & 63;
        const int gn = scol0 + n;
        T[k * 65 + n] = (gn < N) ? src[(size_t)(tk * 64 + k) * N + gn] : 0.f;
      }
      __syncthreads();
#pragma unroll
      for (int i = 0; i < 2; ++i) {
        const int q = tid + 256 * i; const int n = q & 63, kc = q >> 6;
        const int pn = tn * 64 + n; const int nt32 = pn >> 5, rr = pn & 31;
        const int kstep = tk * 4 + (kc >> 1), hh = kc & 1;
        bf16x8 w;
#pragma unroll
        for (int j = 0; j < 8; ++j) w[j] = (short)f2bf(T[(kc * 8 + j) * 65 + n]);
        *(bf16x8*)(dst + ((size_t)(nt32 * (K >> 4) + kstep) * 64 + hh * 32 + rr) * 8) = w;
      }
    } else if (item < NWT + NADA) {
      const int it = item - NWT; const int l = it / 96, cgp = it - l * 96; const int n0 = cgp * 64;
      float* sc = (float*)smem;
      float* red = sc + 9 * 1024;
      __syncthreads();
      for (int idx = tid; idx < 9 * 1024; idx += 256) {
        const int ci = idx >> 10, k = idx & 1023;
        const float x = ci < 8 ? p.c[ci * 1024 + k] : p.c_ctx[k];
        sc[idx] = x / (1.f + expf(-x));
      }
      __syncthreads();
      const int wave = tid >> 6, lane = tid & 63;
      float acc[9];
#pragma unroll
      for (int ci = 0; ci < 9; ++ci) acc[ci] = 0.f;
      const float* wp = p.ada_w + ((size_t)l * 1024 + wave * 256) * 6144 + n0 + lane;
#pragma unroll 8
      for (int k = 0; k < 256; ++k) {
        const float wv = wp[(size_t)k * 6144];
#pragma unroll
        for (int ci = 0; ci < 9; ++ci) acc[ci] += sc[ci * 1024 + wave * 256 + k] * wv;
      }
#pragma unroll
      for (int ci = 0; ci < 9; ++ci) red[(wave * 9 + ci) * 64 + lane] = acc[ci];
      __syncthreads();
      for (int idx = tid; idx < 576; idx += 256) {
        const int ci = idx >> 6, col = idx & 63;
        const float s = red[(0 * 9 + ci) * 64 + col] + red[(1 * 9 + ci) * 64 + col] + red[(2 * 9 + ci) * 64 + col] + red[(3 * 9 + ci) * 64 + col];
        p.mods[(size_t)(l * 9 + ci) * 6144 + n0 + col] = s + p.ada_b[l * 6144 + n0 + col];
      }
    } else {
      if (tid < 8) p.cnt[tid] = 0;
      for (int i = tid; i < 4 * 8320; i += 256) p.flags[i] = 0;
      for (int idx = tid; idx < 1024; idx += 256) {
        const int pos = idx >> 4, fi = idx & 15;
        const float inv = powf(10000.f, -(float)fi / 16.f);
        const float ang = (float)pos * inv;
        p.rope[idx * 2] = cosf(ang); p.rope[idx * 2 + 1] = sinf(ang);
      }
    }
  }
}

DI void norm_phase(const P* __restrict__ gp, int l, int which, bool first, bool fin) {
  const P& p = *gp;
  int tid_ = threadIdx.x; asm volatile("" : "+v"(tid_)); const int tid = tid_, lane = tid & 63, wave = tid >> 6;
  for (int item = blockIdx.x; item < NT_ / 4; item += gridDim.x) {
    const int tok = item * 4 + wave;
    const float* src = first ? (tok < NP_ ? p.x_prompt + (size_t)tok * 1024 : p.x_sample + (size_t)(tok - NP_) * 1024) : p.out + (size_t)tok * 1024;
    float4 v[4];
    float ss = 0.f;
#pragma unroll
    for (int i = 0; i < 4; ++i) { v[i] = ((const float4*)src)[lane + 64 * i]; ss += v[i].x * v[i].x + v[i].y * v[i].y + v[i].z * v[i].z + v[i].w * v[i].w; }
#pragma unroll
    for (int o = 32; o >= 1; o >>= 1) ss += shx(ss, lane, o);
    const float rstd = rsqrtf(ss * (1.f / 1024.f) + 1e-6f);
    if (fin) {
#pragma unroll
      for (int i = 0; i < 4; ++i) {
        const float4 g = ((const float4*)p.final_g)[lane + 64 * i];
        float4 y; y.x = v[i].x * rstd * g.x; y.y = v[i].y * rstd * g.y; y.z = v[i].z * rstd * g.z; y.w = v[i].w * rstd * g.w;
        ((float4*)(p.out + (size_t)tok * 1024))[lane + 64 * i] = y;
      }
    } else {
      const int ci = tok < NP_ ? 8 : (tok - NP_) >> 12;
      const float* md = p.mods + (size_t)(l * 9 + ci) * 6144 + which * 3072;
      const float* gp = (which ? p.norm2_g : p.norm1_g) + l * 1024;
#pragma unroll
      for (int i = 0; i < 4; ++i) {
        const float4 g = ((const float4*)gp)[lane + 64 * i];
        const float4 sh = ((const float4*)md)[lane + 64 * i];
        const float4 sc = ((const float4*)(md + 1024))[lane + 64 * i];
        ushort4 o;
        o.x = f2bf(v[i].x * rstd * g.x * (1.f + sc.x) + sh.x);
        o.y = f2bf(v[i].y * rstd * g.y * (1.f + sc.y) + sh.y);
        o.z = f2bf(v[i].z * rstd * g.z * (1.f + sc.z) + sh.z);
        o.w = f2bf(v[i].w * rstd * g.w * (1.f + sc.w) + sh.w);
        ((ushort4*)(p.hn + (size_t)tok * 1024))[lane + 64 * i] = o;
        if (first) ((float4*)(p.out + (size_t)tok * 1024))[lane + 64 * i] = v[i];
      }
    }
  }
}

DI uint4 ldsel(const u16* pv, const u16* safe, unsigned ok) {
  uint4 t = *(const uint4*)(ok ? pv : safe);
  if (!ok) { t.x = 0; t.y = 0; t.z = 0; t.w = 0; }
  return t;
}
enum { EPI_PROJ = 0, EPI_RES = 1, EPI_FFN = 2 };

template <int EPI>
DI void gemm_phase(const P* __restrict__ gp, int l, char* smem, const u16* __restrict__ A, int lda, const u16* __restrict__ B, int ldb, int K, int MT,
                   int NTn, int gsel) {
  const P& p = *gp;
  u16* As = (u16*)smem;
  int tid_ = threadIdx.x; asm volatile("" : "+v"(tid_)); const int tid = tid_, lane = tid & 63, wave = tid >> 6, r = lane & 31, h = lane >> 5;
  const int wm = wave & 1, wn = wave >> 1;
  const int KT = K >> 6;
  const bool even = !(l & 1); const int jj = l >> 1;
  const int ntiles = MT * NTn;
  const int nlb = gridDim.x >> 3, xcd = blockIdx.x & 7, lb = blockIdx.x >> 3;
  for (int it = 0;; ++it) {
    const int g = (it * 8 + xcd) * nlb + lb;
    if (g >= ntiles) break;
    const int SM = nlb >> 3;
    const int band = g / (SM * NTn); const int rem = g - band * SM * NTn;
    const int nt = rem / SM, mt = band * SM + (rem - nt * SM);
    int seqbase = 0, L = 0, tin0 = 0;
    if (EPI == EPI_FFN) {
      if (mt < 48) { const int sq = mt / 3; L = 256; seqbase = sq * 256; tin0 = (mt - sq * 3) * 126; }
      else { const int m2 = mt - 48; const int sq = m2 / 33; L = 4096; seqbase = NP_ + sq * 4096; tin0 = (m2 - sq * 33) * 126; }
    }
    const int row0 = tid >> 3, kc0 = (tid & 7) * 8;
    const long arow0 = (EPI == EPI_FFN) ? (long)seqbase + tin0 - 1 + row0 : (long)mt * 128 + row0;
    const u16* abase = A + arow0 * lda + kc0;
    unsigned avalid = 0;
#pragma unroll
    for (int i = 0; i < 4; ++i) {
      if (EPI == EPI_FFN) { const int ts = tin0 - 1 + row0 + 32 * i; if (ts >= 0 && ts < L) avalid |= 1u << i; }
      else avalid |= 1u << i;
    }
    const u16* bb0 = B + ((size_t)((nt * 4 + wn * 2) * (K >> 4)) * 64 + lane) * 8;
    const size_t bts = (size_t)(K >> 4) * 512;
    f32x16 acc[2][2];
#pragma unroll
    for (int a = 0; a < 2; ++a)
#pragma unroll
      for (int b = 0; b < 2; ++b) zero16(acc[a][b]);
#define GLD_A(i, ko) ldsel(abase + (size_t)(32 * (i)) * lda + (ko), A, (avalid >> (i)) & 1u)
#define GLD_BF(dst, kt_) { const u16* q_ = bb0 + (size_t)(kt_) * 2048; \
      dst[0][0] = *(const bf16x8*)(q_); dst[0][1] = *(const bf16x8*)(q_ + 512); dst[0][2] = *(const bf16x8*)(q_ + 1024); dst[0][3] = *(const bf16x8*)(q_ + 1536); \
      dst[1][0] = *(const bf16x8*)(q_ + bts); dst[1][1] = *(const bf16x8*)(q_ + bts + 512); dst[1][2] = *(const bf16x8*)(q_ + bts + 1024); dst[1][3] = *(const bf16x8*)(q_ + bts + 1536); }
    uint4 ra0 = GLD_A(0, 0), ra1 = GLD_A(1, 0), ra2 = GLD_A(2, 0), ra3 = GLD_A(3, 0);
    uint4 sa0 = GLD_A(0, 64), sa1 = GLD_A(1, 64), sa2 = GLD_A(2, 64), sa3 = GLD_A(3, 64);
    bf16x8 bc[2][4], bn[2][4];
    GLD_BF(bc, 0);
    GLD_BF(bn, 1);
#define LSTORE(buf, A0, A1, A2, A3) { \
      u16* ad = As + (buf) * 9216 + row0 * 72 + kc0; \
      *(uint4*)(ad) = A0; *(uint4*)(ad + 32 * 72) = A1; *(uint4*)(ad + 64 * 72) = A2; *(uint4*)(ad + 96 * 72) = A3; }
#define COMPUTE(buf, BF, KN) { \
      const u16* Ab = As + (buf) * 9216; \
      const bool more_ = (KN) < KT; const u16* q_ = bb0 + (size_t)(KN) * 2048; \
      _Pragma("unroll") for (int ks = 0; ks < 4; ++ks) { \
        const bf16x8 a0 = *(const bf16x8*)(Ab + (wm * 64 + r) * 72 + ks * 16 + h * 8); \
        const bf16x8 a1 = *(const bf16x8*)(Ab + (wm * 64 + 32 + r) * 72 + ks * 16 + h * 8); \
        acc[0][0] = MFMA(a0, BF[0][ks], acc[0][0]); acc[0][1] = MFMA(a0, BF[1][ks], acc[0][1]); \
        acc[1][0] = MFMA(a1, BF[0][ks], acc[1][0]); acc[1][1] = MFMA(a1, BF[1][ks], acc[1][1]); \
        if (more_) { BF[0][ks] = *(const bf16x8*)(q_ + ks * 512); BF[1][ks] = *(const bf16x8*)(q_ + bts + ks * 512); } } }
    LSTORE(0, ra0, ra1, ra2, ra3);
    ra0 = GLD_A(0, 128); ra1 = GLD_A(1, 128); ra2 = GLD_A(2, 128); ra3 = GLD_A(3, 128);
    __syncthreads();
    for (int kt = 0; kt < KT; kt += 2) {
      COMPUTE(0, bc, kt + 2);
      LSTORE(1, sa0, sa1, sa2, sa3);
      if (kt + 3 < KT) {
        const int ko = (kt + 3) * 64;
        sa0 = GLD_A(0, ko); sa1 = GLD_A(1, ko); sa2 = GLD_A(2, ko); sa3 = GLD_A(3, ko);
      }
      __syncthreads();
      COMPUTE(1, bn, kt + 3);
      if (kt + 2 < KT) {
        LSTORE(0, ra0, ra1, ra2, ra3);
        if (kt + 4 < KT) {
          const int ko = (kt + 4) * 64;
          ra0 = GLD_A(0, ko); ra1 = GLD_A(1, ko); ra2 = GLD_A(2, ko); ra3 = GLD_A(3, ko);
        }
      }
      __syncthreads();
    }
    if (EPI == EPI_PROJ) {
      const int N = even ? EVN : ODN;
#pragma unroll
      for (int tm = 0; tm < 2; ++tm)
#pragma unroll
        for (int tn = 0; tn < 2; ++tn) {
          const int col = nt * 128 + wn * 64 + tn * 32 + r;
          if (col < N) {
#pragma unroll
            for (int i = 0; i < 16; ++i) {
              const int row = mt * 128 + wm * 64 + tm * 32 + crow(i, h);
              const float v = acc[tm][tn][i];
              p.proj[(size_t)row * N + col] = f2bf(v);
              if (row < NP_) {
                const int b = row >> 8, t = row & 255, d = col & 63;
                if (even) {
                  if (col >= 512 && col < 1536) {
                    const int wh = (col - 512) >> 9, hh = ((col - 512) >> 6) & 7;
                    p.out[(wh ? OFF_AV : OFF_AK) + ((size_t)(((b * 2 + jj) * 8 + hh) * 256 + t)) * 64 + d] = v;
                  }
                } else {
                  if (col >= 512 && col < 768) {
                    const int wh = (col - 512) >> 7, kv = ((col - 512) >> 6) & 1;
                    p.out[(wh ? OFF_CV : OFF_CK) + ((size_t)(((b * 2 + jj) * 2 + kv) * 256 + t)) * 64 + d] = v;
                  }
                }
              }
            }
          }
        }
    } else if (EPI == EPI_RES) {
#pragma unroll
      for (int tm = 0; tm < 2; ++tm)
#pragma unroll
        for (int tn = 0; tn < 2; ++tn) {
          const int col = nt * 128 + wn * 64 + tn * 32 + r;
#pragma unroll
          for (int i = 0; i < 16; ++i) {
            const int row = mt * 128 + wm * 64 + tm * 32 + crow(i, h);
            const int ci = row < NP_ ? 8 : (row - NP_) >> 12;
            const float g = p.mods[(size_t)(l * 9 + ci) * 6144 + gsel * 1024 + col];
            float* xp = p.out + (size_t)row * 1024 + col;
            *xp = *xp + g * acc[tm][tn][i];
          }
        }
    } else {
      __syncthreads();
      float* U = (float*)smem;
#pragma unroll
      for (int tm = 0; tm < 2; ++tm)
#pragma unroll
        for (int tn = 0; tn < 2; ++tn)
#pragma unroll
          for (int i = 0; i < 16; ++i) U[(wm * 64 + tm * 32 + crow(i, h)) * 132 + wn * 64 + tn * 32 + r] = acc[tm][tn][i];
      __syncthreads();
      const float* cw = p.ffn_conv + (size_t)l * 3 * 5632;
      const int f = tid & 63, rg = tid >> 6; const int fg = nt * 64 + f;
      const float wa0 = cw[fg], wa1 = cw[5632 + fg], wa2 = cw[2 * 5632 + fg];
      const float wg0 = cw[2816 + fg], wg1 = cw[5632 + 2816 + fg], wg2 = cw[2 * 5632 + 2816 + fg];
      u16* act = p.proj;
      {
        const int rbeg = 1 + 32 * rg, rend = rg == 3 ? 126 : 32 * rg + 32;
        float ap = U[(rbeg - 1) * 132 + f], ac = U[rbeg * 132 + f];
        float gp_ = U[(rbeg - 1) * 132 + 64 + f], gc = U[rbeg * 132 + 64 + f];
        for (int rr = rbeg; rr <= rend; ++rr) {
          const int ts = tin0 - 1 + rr;
          if (ts >= L) break;
          const float an = U[(rr + 1) * 132 + f], gn = U[(rr + 1) * 132 + 64 + f];
          const float a = wa0 * ap + wa1 * ac + wa2 * an;
          const float g = wg0 * gp_ + wg1 * gc + wg2 * gn;
          act[(size_t)(seqbase + ts) * 2816 + fg] = f2bf(a * siluf(g));
          ap = ac; ac = an; gp_ = gc; gc = gn;
        }
      }
      __syncthreads();
    }
  }
}

template <int MODE>
DI void attn_item(const P* __restrict__ gp, int jj, int it, char* smem) {
  const P& p = *gp;
  const u16* projp = uni(p.proj); u16* hnp = uni(p.hn); const float* ropep = uni(p.rope);
  u16* Ks = (u16*)smem; u16* Vt = Ks + 64 * 72; float* rpb_s = (float*)(Vt + 64 * 72);
  int tid_ = threadIdx.x; asm volatile("" : "+v"(tid_)); const int tid = tid_, lane = tid & 63, wave = tid >> 6, r = lane & 31, h = lane >> 5;
  constexpr bool EVENL = (MODE == 0 || MODE == 1);
  constexpr bool LAT = (MODE == 1 || MODE == 3);
  constexpr int PS = EVENL ? EVN : ODN;
  int b, hq, qb, tokbase;
  if (!LAT) { b = it >> 4; hq = (it >> 1) & 7; qb = it & 1; tokbase = b * 256; }
  else { b = it >> 8; hq = (it >> 5) & 7; qb = it & 31; tokbase = NP_ + b * 4096; }
  const int hk = EVENL ? hq : (hq >> 2);
  const int kcol = 512 + hk * 64, vcol = (EVENL ? 1024 : 640) + hk * 64, qcol = hq * 64;
  const int tq = qb * 128 + wave * 32 + r;
  const size_t qtok = (size_t)tokbase + tq;
  __syncthreads();
  if (MODE == 1) { for (int i = tid; i < 465; i += 256) rpb_s[i] = p.a_rpb[(size_t)(jj * 8 + hq) * 465 + i]; }
  bf16x8 qf[4];
#pragma unroll
  for (int s = 0; s < 4; ++s) qf[s] = *(const bf16x8*)(projp + qtok * PS + qcol + 16 * s + 8 * h);
  if (MODE == 3) {
    const int prow = tq >> 6, pcol = tq & 63;
#pragma unroll
    for (int half = 0; half < 2; ++half) {
      const int pos = half ? pcol : prow;
#pragma unroll
      for (int j = 0; j < 8; ++j) {
        const float cs = ropep[(pos * 16 + 8 * h + j) * 2], sn = ropep[(pos * 16 + 8 * h + j) * 2 + 1];
        const float x1 = bf2f((u16)qf[2 * half][j]), x2 = bf2f((u16)qf[2 * half + 1][j]);
        qf[2 * half][j] = (short)f2bf(x1 * cs - x2 * sn);
        qf[2 * half + 1][j] = (short)f2bf(x1 * sn + x2 * cs);
      }
    }
  }
  float m_run = -1e30f, l_run = 0.f;
  if (MODE == 2 || MODE == 3) { m_run = p.c_sink[jj * 8 + hq]; l_run = h == 0 ? 1.f : 0.f; }
  f32x16 ot[2]; zero16(ot[0]); zero16(ot[1]);
  int loc0 = 0, nloc = 0;
  if (MODE == 1) {
    const int qi0 = 2 * qb;
    const int rlo = min(max(qi0 - 4, 0), 56), rhi = min(max(qi0 + 1 - 4, 0), 56) + 7;
    loc0 = rlo; nloc = rhi - rlo + 1;
  } else if (MODE == 3) {
    loc0 = max(0, 2 * qb - 2); nloc = min(63, 2 * qb + 3) - loc0 + 1;
  }
  const int qi = tq >> 6, qw = tq & 63;
  const int r0w = min(max(qi - 4, 0), 56), c0w = min(max(qw - 8, 0), 48);
  const int key = tid >> 2, seg = tid & 3;
  for (int kb = 0; kb < 4 + nloc; ++kb) {
    const bool isctx = kb < 4;
    const int blk = isctx ? kb : loc0 + kb - 4;
    __syncthreads();
    {
      float kf[16], vf[16];
      if (LAT && isctx) {
        const float* kc = (MODE == 1) ? p.cache_a_k + ((size_t)((b * 2 + jj) * 8 + hk)) * 16384 : p.cache_c_k + ((size_t)((b * 2 + jj) * 2 + hk)) * 16384;
        const float* vc = (MODE == 1) ? p.cache_a_v + ((size_t)((b * 2 + jj) * 8 + hk)) * 16384 : p.cache_c_v + ((size_t)((b * 2 + jj) * 2 + hk)) * 16384;
        const float4* kp4 = (const float4*)(kc + (size_t)(blk * 64 + key) * 64 + seg * 16);
        const float4* vp4 = (const float4*)(vc + (size_t)(blk * 64 + key) * 64 + seg * 16);
#pragma unroll
        for (int e = 0; e < 4; ++e) {
          const float4 a = kp4[e], c = vp4[e];
          kf[4 * e] = a.x; kf[4 * e + 1] = a.y; kf[4 * e + 2] = a.z; kf[4 * e + 3] = a.w;
          vf[4 * e] = c.x; vf[4 * e + 1] = c.y; vf[4 * e + 2] = c.z; vf[4 * e + 3] = c.w;
        }
      } else {
        const u16* rowp = projp + ((size_t)tokbase + blk * 64 + key) * PS;
        const bf16x8 k0 = *(const bf16x8*)(rowp + kcol + seg * 16), k1 = *(const bf16x8*)(rowp + kcol + seg * 16 + 8);
        const bf16x8 v0 = *(const bf16x8*)(rowp + vcol + seg * 16), v1 = *(const bf16x8*)(rowp + vcol + seg * 16 + 8);
#pragma unroll
        for (int e = 0; e < 8; ++e) { kf[e] = bf2f((u16)k0[e]); kf[8 + e] = bf2f((u16)k1[e]); vf[e] = bf2f((u16)v0[e]); vf[8 + e] = bf2f((u16)v1[e]); }
        if (MODE == 3) {
          const bf16x8 p0 = *(const bf16x8*)(rowp + kcol + (seg ^ 1) * 16), p1 = *(const bf16x8*)(rowp + kcol + (seg ^ 1) * 16 + 8);
          const int pos = (seg & 2) ? key : blk;
#pragma unroll
          for (int e = 0; e < 16; ++e) {
            const float pr = bf2f((u16)(e < 8 ? p0[e & 7] : p1[e & 7]));
            const float cs = ropep[(pos * 16 + e) * 2], sn = ropep[(pos * 16 + e) * 2 + 1];
            kf[e] = (seg & 1) ? (pr * sn + kf[e] * cs) : (kf[e] * cs - pr * sn);
          }
        }
      }
      bf16x8 o0, o1;
#pragma unroll
      for (int e = 0; e < 8; ++e) { o0[e] = (short)f2bf(kf[e]); o1[e] = (short)f2bf(kf[8 + e]); }
      *(bf16x8*)(Ks + key * 72 + seg * 16) = o0;
      *(bf16x8*)(Ks + key * 72 + seg * 16 + 8) = o1;
#pragma unroll
      for (int e = 0; e < 16; ++e) Vt[(seg * 16 + e) * 72 + key] = f2bf(vf[e]);
    }
    __syncthreads();
    bool active = true;
    if (MODE == 1 && !isctx) active = (blk >= r0w && blk < r0w + 8);
    if (active) {
      f32x16 st[2]; zero16(st[0]); zero16(st[1]);
#pragma unroll
      for (int kt = 0; kt < 2; ++kt)
#pragma unroll
        for (int s = 0; s < 4; ++s) {
          const bf16x8 a = *(const bf16x8*)(Ks + (kt * 32 + r) * 72 + 16 * s + 8 * h);
          st[kt] = MFMA(a, qf[s], st[kt]);
        }
      float mx = m_run;
#pragma unroll
      for (int kt = 0; kt < 2; ++kt)
#pragma unroll
        for (int i = 0; i < 16; ++i) {
          float s = st[kt][i] * 0.125f;
          const int kk = kt * 32 + crow(i, h);
          if (MODE == 1 && !isctx) {
            const bool ok = (kk >= c0w && kk < c0w + 16);
            s = ok ? s + rpb_s[(blk - qi + 7) * 31 + (kk - qw + 15)] : -1e30f;
          }
          if (MODE == 3 && !isctx) {
            const int dlt = blk * 64 + kk - tq;
            s = (dlt <= 128 && dlt >= -128) ? s : -1e30f;
          }
          st[kt][i] = s;
          mx = fmaxf(mx, s);
        }
      mx = fmaxf(mx, shx(mx, lane, 32));
      const float alpha = __expf(m_run - mx);
      m_run = mx;
      float ps = 0.f;
#pragma unroll
      for (int kt = 0; kt < 2; ++kt)
#pragma unroll
        for (int i = 0; i < 16; ++i) { const float pv = __expf(st[kt][i] - mx); st[kt][i] = pv; ps += pv; }
      l_run = l_run * alpha + ps;
#pragma unroll
      for (int dt = 0; dt < 2; ++dt)
#pragma unroll
        for (int i = 0; i < 16; ++i) ot[dt][i] *= alpha;
#pragma unroll
      for (int kt = 0; kt < 2; ++kt) {
        const bf16x8 pb0 = packs<0>(st[kt]), pb1 = packs<1>(st[kt]);
#pragma unroll
        for (int dt = 0; dt < 2; ++dt) {
          const bf16x8 pa0 = ld2x4(Vt + (dt * 32 + r) * 72 + kt * 32 + 4 * h);
          const bf16x8 pa1 = ld2x4(Vt + (dt * 32 + r) * 72 + kt * 32 + 16 + 4 * h);
          ot[dt] = MFMA(pa0, pb0, ot[dt]);
          ot[dt] = MFMA(pa1, pb1, ot[dt]);
        }
      }
    }
  }
  l_run += shx(l_run, lane, 32);
  const float inv = 1.f / l_run;
  u16* dst = hnp + qtok * 1024 + qcol;
#pragma unroll
  for (int dt = 0; dt < 2; ++dt)
#pragma unroll
    for (int g4 = 0; g4 < 4; ++g4) {
      ushort4 o;
      o.x = f2bf(ot[dt][4 * g4] * inv); o.y = f2bf(ot[dt][4 * g4 + 1] * inv); o.z = f2bf(ot[dt][4 * g4 + 2] * inv); o.w = f2bf(ot[dt][4 * g4 + 3] * inv);
      *(ushort4*)(dst + dt * 32 + 8 * g4 + 4 * h) = o;
    }
}

struct ChainId { int lat, b, h, dir, T, base, nch; };
DI ChainId chain_decode(int it) {
  ChainId c; c.lat = it < 128; const int q = c.lat ? it : it - 128;
  c.b = q >> 4; c.h = (q >> 1) & 7; c.dir = q & 1; c.T = c.lat ? 4096 : 256; c.base = c.lat ? NP_ + c.b * 4096 : c.b * 256; c.nch = c.T >> 6;
  return c;
}
DI int tokof(const ChainId& c, int step, int row) { const int pp = step * 64 + row; return c.base + (c.dir ? c.T - 1 - pp : pp); }


static constexpr int RING = 4;
static constexpr int SLOT_BYTES = 53760;
DI void wait_ge(int* flag, int val, int tid) {
  if (tid < 64) {
    if (tid == 0) { while (__hip_atomic_load(flag, __ATOMIC_RELAXED, __HIP_MEMORY_SCOPE_AGENT) < val) __builtin_amdgcn_s_sleep(1); }
    __builtin_amdgcn_fence(__ATOMIC_ACQUIRE, "agent");
  }
  __syncthreads();
}
DI void publish(int* flag, int val, int tid) {
  asm volatile("s_waitcnt vmcnt(0)" ::: "memory");
  __syncthreads();
  if (tid == 0) __hip_atomic_store(flag, val, __ATOMIC_RELAXED, __HIP_MEMORY_SCOPE_AGENT);
}
typedef __attribute__((ext_vector_type(4))) unsigned u32x4;
DI void copy_out(const char* lds, char* g, int bytes, int tid) {
  for (int i = opq(tid) * 16; i < bytes; i += 256 * 16) {
    const u32x4 v = *(const u32x4*)(lds + i);
    char* dst = g + i;
    asm volatile("global_store_dwordx4 %0, %1, off sc0 sc1" :: "v"(dst), "v"(v) : "memory");
  }
}
DI void copy_in(char* lds, const char* g, int bytes, int tid) {
  for (int i = opq(tid) * 16; i < bytes; i += 256 * 16) *(uint4*)(lds + i) = *(const uint4*)(g + i);
}

template <int ROLE>
DI void gla_chain(const P* __restrict__ gp, int jj, int it, char* smem, int k0, int kstep) {
  const P& p = *gp;
  const ChainId cid = chain_decode(it);
  int tid_ = threadIdx.x; asm volatile("" : "+v"(tid_)); const int tid = tid_, lane = tid & 63, wave = tid >> 6, r = lane & 31, h = lane >> 5;
  const int hh = cid.h, dir = cid.dir;
  u16* QT = (u16*)smem; u16* KT = QT + 4608; u16* KEt = KT + 4608; u16* Vt = KEt + 4608;
  float* dec = (float*)(Vt + 4608); float* GL = dec + 64; float* gq = GL + 1024; float* Ost = gq + 256;
  constexpr int IMG = 4 * 9216 + 256;
  char* slots = uni(p.ring) + (size_t)it * RING * SLOT_BYTES; int* ready = uni(p.flags) + (jj * 2) * 8320 + it * 64; int* done = uni(p.flags) + (jj * 2) * 8320 + 8192 + it;
  const int d = tid & 63, cq = tid >> 6;
  float wg[16];
#pragma unroll
  for (int rr = 0; rr < 16; ++rr) wg[rr] = p.b_w_g2[((size_t)((jj * 2 + dir) * 16 + rr)) * 512 + hh * 64 + d];
  const float bg = p.b_b_g[(jj * 2 + dir) * 512 + hh * 64 + d];
  const int vh = wave & 1;
  f32x16 S[2]; zero16(S[0]); zero16(S[1]);
  const size_t sidx = ((size_t)(((cid.b * 2 + jj) * 2 + dir) * 8 + hh)) * 4096;
  if (ROLE != 1 && wave < 2 && cid.lat) {
#pragma unroll
    for (int dt = 0; dt < 2; ++dt)
#pragma unroll
      for (int i = 0; i < 16; ++i) S[dt][i] = p.state_b[sidx + (dt * 32 + crow(i, h)) * 64 + vh * 32 + r];
  }
  for (int step_ = k0; step_ < cid.nch; step_ += kstep) {
    int step = step_;
    asm volatile("" : "+v"(step));
    if (ROLE == 1) wait_ge(done, step_ - RING + 1, tid);
    if (ROLE == 2) wait_ge(ready + step_, 1, tid);
    __syncthreads();
    if (ROLE == 2) { copy_in(smem, slots + (size_t)(step_ % RING) * SLOT_BYTES, IMG, tid); __syncthreads(); if (tid == 0) __hip_atomic_store(done, step_ + 1, __ATOMIC_RELAXED, __HIP_MEMORY_SCOPE_AGENT); }
    if (ROLE != 2) {
    {
      const int c = tid >> 2, sg = tid & 3;
      const int tok = tokof(cid, step, c);
      const ushort4 gv = *(const ushort4*)(p.proj + (size_t)tok * EVN + 3072 + dir * 16 + sg * 4);
      GL[c * 16 + sg * 4] = bf2f(gv.x); GL[c * 16 + sg * 4 + 1] = bf2f(gv.y); GL[c * 16 + sg * 4 + 2] = bf2f(gv.z); GL[c * 16 + sg * 4 + 3] = bf2f(gv.w);
    }
    __syncthreads();
    float Gl[16]; float run = 0.f;
#pragma unroll
    for (int i = 0; i < 16; ++i) {
      const int c = cq * 16 + i;
      float z = bg;
#pragma unroll
      for (int rr = 0; rr < 16; ++rr) z += GL[c * 16 + rr] * wg[rr];
      const float g = (fminf(z, 0.f) - __logf(1.f + __expf(-fabsf(z)))) * (1.f / 16.f);
      run += g; Gl[i] = run;
    }
    gq[cq * 64 + d] = run;
    __syncthreads();
    float off = 0.f, tot = 0.f;
#pragma unroll
    for (int q2 = 0; q2 < 4; ++q2) { const float t = gq[q2 * 64 + d]; if (q2 < cq) off += t; tot += t; }
#pragma unroll
    for (int i = 0; i < 16; ++i) {
      const int c = cq * 16 + i;
      const int tok = tokof(cid, step, c);
      const float G = Gl[i] + off;
      const u16* rowp = p.proj + (size_t)tok * EVN + hh * 64 + d;
      const float qv = bf2f(rowp[1536]), kv = bf2f(rowp[2048]);
      const u16 vb = rowp[2560];
      QT[c * 72 + d] = f2bf(qv * 0.125f * __expf(G));
      KT[c * 72 + d] = f2bf(kv * __expf(-G));
      KEt[d * 72 + c] = f2bf(kv * __expf(tot - G));
      Vt[d * 72 + c] = vb;
    }
    if (cq == 0) dec[d] = __expf(tot);
    __syncthreads();
    }
    if (ROLE == 1) { copy_out(smem, slots + (size_t)(step_ % RING) * SLOT_BYTES, IMG, tid); publish(ready + step_, 1, tid); continue; }
    if (wave < 2) {
      f32x16 at[2][2];
#pragma unroll
      for (int a = 0; a < 2; ++a)
#pragma unroll
        for (int b2 = 0; b2 < 2; ++b2) zero16(at[a][b2]);
#pragma unroll
      for (int ks = 0; ks < 4; ++ks) {
        const bf16x8 a0 = *(const bf16x8*)(KT + r * 72 + ks * 16 + 8 * h), a1 = *(const bf16x8*)(KT + (32 + r) * 72 + ks * 16 + 8 * h);
        const bf16x8 b0 = *(const bf16x8*)(QT + r * 72 + ks * 16 + 8 * h), b1 = *(const bf16x8*)(QT + (32 + r) * 72 + ks * 16 + 8 * h);
        at[0][0] = MFMA(a0, b0, at[0][0]); at[0][1] = MFMA(a0, b1, at[0][1]);
        at[1][0] = MFMA(a1, b0, at[1][0]); at[1][1] = MFMA(a1, b1, at[1][1]);
      }
#pragma unroll
      for (int st = 0; st < 2; ++st)
#pragma unroll
        for (int ct = 0; ct < 2; ++ct)
#pragma unroll
          for (int i = 0; i < 16; ++i) { if (st * 32 + crow(i, h) > ct * 32 + r) at[st][ct][i] = 0.f; }
      f32x16 o[2]; zero16(o[0]); zero16(o[1]);
#pragma unroll
      for (int ct = 0; ct < 2; ++ct)
#pragma unroll
        for (int st = 0; st < 2; ++st) {
          const bf16x8 x0 = packs<0>(at[st][ct]), x1 = packs<1>(at[st][ct]);
          const bf16x8 pb0 = ld2x4(Vt + (vh * 32 + r) * 72 + st * 32 + 4 * h);
          const bf16x8 pb1 = ld2x4(Vt + (vh * 32 + r) * 72 + st * 32 + 16 + 4 * h);
          o[ct] = MFMA(x0, pb0, o[ct]);
          o[ct] = MFMA(x1, pb1, o[ct]);
        }
#pragma unroll
      for (int dt = 0; dt < 2; ++dt) {
        const bf16x8 xs0 = packs<0>(S[dt]), xs1 = packs<1>(S[dt]);
#pragma unroll
        for (int ct = 0; ct < 2; ++ct) {
          const bf16x8 pa0 = ld2x4(QT + (ct * 32 + r) * 72 + dt * 32 + 4 * h);
          const bf16x8 pa1 = ld2x4(QT + (ct * 32 + r) * 72 + dt * 32 + 16 + 4 * h);
          o[ct] = MFMA(pa0, xs0, o[ct]);
          o[ct] = MFMA(pa1, xs1, o[ct]);
        }
      }
#pragma unroll
      for (int dt = 0; dt < 2; ++dt)
#pragma unroll
        for (int i = 0; i < 16; ++i) S[dt][i] *= dec[dt * 32 + crow(i, h)];
#pragma unroll
      for (int ks = 0; ks < 4; ++ks) {
        const bf16x8 bv = *(const bf16x8*)(Vt + (vh * 32 + r) * 72 + ks * 16 + 8 * h);
#pragma unroll
        for (int dt = 0; dt < 2; ++dt) {
          const bf16x8 a = *(const bf16x8*)(KEt + (dt * 32 + r) * 72 + ks * 16 + 8 * h);
          S[dt] = MFMA(a, bv, S[dt]);
        }
      }
#pragma unroll
      for (int ct = 0; ct < 2; ++ct)
#pragma unroll
        for (int i = 0; i < 16; ++i) Ost[(ct * 32 + crow(i, h)) * 68 + vh * 32 + r] = o[ct][i];
    }
    __syncthreads();
    {
      const int c = tid >> 2, sg = tid & 3;
      const int tok = tokof(cid, step, c);
      u16* dst = (dir ? p.ot1 + (size_t)tok * 512 + hh * 64 : p.hn + (size_t)tok * 1024 + 512 + hh * 64) + sg * 16;
      bf16x8 w0, w1;
#pragma unroll
      for (int e = 0; e < 8; ++e) { w0[e] = (short)f2bf(Ost[c * 68 + sg * 16 + e]); w1[e] = (short)f2bf(Ost[c * 68 + sg * 16 + 8 + e]); }
      *(bf16x8*)dst = w0; *(bf16x8*)(dst + 8) = w1;
    }
  }
  if (wave < 2 && !cid.lat) {
#pragma unroll
    for (int dt = 0; dt < 2; ++dt)
#pragma unroll
      for (int i = 0; i < 16; ++i) p.out[OFF_SB + sidx + (dt * 32 + crow(i, h)) * 64 + vh * 32 + r] = S[dt][i];
  }
}

template <int ROLE>
DI void delta_chain(const P* __restrict__ gp, int jj, int it, char* smem, int k0, int kstep) {
  const P& p = *gp;
  const ChainId cid = chain_decode(it);
  int tid_ = threadIdx.x; asm volatile("" : "+v"(tid_)); const int tid0 = tid_;
  const int hh = cid.h, dir = cid.dir;
  u16* Qn = (u16*)smem; u16* Kt = Qn + 4608; u16* AQK = Kt + 4608; u16* KC = AQK + 4608;
  float* Wv = (float*)(KC + 4608); float* Gs = Wv + 64 * 65; u16* Kn = (u16*)(Gs + 64); float* At = (float*)(Kn + 4608); float* Bt = At + 64 * 68;
  constexpr int IMG = 4 * 9216 + 16640 + 256;
  char* slots = uni(p.ring) + (size_t)it * RING * SLOT_BYTES; int* ready = uni(p.flags) + (jj * 2 + 1) * 8320 + it * 64; int* done = uni(p.flags) + (jj * 2 + 1) * 8320 + 8192 + it;
  const float aexp = __expf(p.d_a_log[(jj * 2 + dir) * 8 + hh]);
  const float dtb = p.d_dt_bias[(jj * 2 + dir) * 8 + hh];
  f32x16 S[2]; zero16(S[0]); zero16(S[1]);
  const size_t sidx = ((size_t)(((cid.b * 2 + jj) * 2 + dir) * 8 + hh)) * 4096;
  { const int tid = tid0, lane = tid & 63, wave = tid >> 6, r = lane & 31, h = lane >> 5;
  if (ROLE != 1 && wave < 2 && cid.lat) {
    const int vh = wave & 1;
#pragma unroll
    for (int dt = 0; dt < 2; ++dt)
#pragma unroll
      for (int i = 0; i < 16; ++i) S[dt][i] = p.state_d[sidx + (dt * 32 + crow(i, h)) * 64 + vh * 32 + r];
  }
  }
  u16* CW = (u16*)(smem + 80640);
  __syncthreads();
  for (int i = tid0; i < 576; i += 256) { const int tap = i / 192, c2 = i - tap * 192; const int wh = c2 >> 6, dd = c2 & 63;
    CW[i] = f2bf(p.d_conv[(size_t)jj * 3 * 1536 + tap * 1536 + wh * 512 + hh * 64 + dd]); }
  for (int step_ = k0; step_ < cid.nch; step_ += kstep) {
    int step = step_;
    asm volatile("" : "+v"(step));
    if (ROLE == 1) wait_ge(done, step_ - RING + 1, tid0);
    if (ROLE == 2) wait_ge(ready + step_, 1, tid0);
    __syncthreads();
    if (ROLE == 2) { copy_in(smem, slots + (size_t)(step_ % RING) * SLOT_BYTES, IMG, tid0); __syncthreads(); if (tid0 == 0) __hip_atomic_store(done, step_ + 1, __ATOMIC_RELAXED, __HIP_MEMORY_SCOPE_AGENT); }
    if (ROLE != 2) {
    {const int tid = opq(tid0), lane = tid & 63, wave = __builtin_amdgcn_readfirstlane(tid >> 6), r = lane & 31, h = lane >> 5, vh = wave & 1; (void)r; (void)h; (void)vh; (void)lane;
    if (wave == 0) {
      const int tok = tokof(cid, step, lane);
      const float da = bf2f(p.proj[(size_t)tok * ODN + 2304 + dir * 8 + hh]);
      const float db = bf2f(p.proj[(size_t)tok * ODN + 2320 + dir * 8 + hh]);
      const float x = da + dtb;
      const float sp = x > 20.f ? x : __logf(1.f + __expf(x));
      float G = -aexp * sp;
#pragma unroll
      for (int o = 1; o < 64; o <<= 1) { const float t = __int_as_float(__builtin_amdgcn_ds_bpermute((lane - o) << 2, __float_as_int(G))); if (lane >= o) G += t; }
      Gs[lane] = G; Bt[lane] = 1.f / (1.f + __expf(-db));
    }
    {
      const int c = tid >> 2, sg = tid & 3;
      const int tok = tokof(cid, step, c);
      const int pos = tok - cid.base;
      const bool hp = pos > 0, hn_ = pos < cid.T - 1;
#pragma unroll 1
      for (int wh = 0; wh < 3; ++wh) {
        const int ch0 = wh * 512 + hh * 64 + sg * 16;
        const u16* cur = p.proj + (size_t)tok * ODN + 768 + ch0;
        float y[16];
        float ss = 0.f;
#pragma unroll
        for (int hf = 0; hf < 2; ++hf) {
          const bf16x8 xc = *(const bf16x8*)(cur + hf * 8);
          bf16x8 xp, xn;
#pragma unroll
          for (int e = 0; e < 8; ++e) { xp[e] = 0; xn[e] = 0; }
          if (hp) xp = *(const bf16x8*)(cur - ODN + hf * 8);
          if (hn_) xn = *(const bf16x8*)(cur + ODN + hf * 8);
#pragma unroll
          for (int e = 0; e < 8; ++e) {
            const int ch = wh * 64 + sg * 16 + hf * 8 + e;
            float v = bf2f(CW[ch]) * bf2f((u16)xp[e]) + bf2f(CW[192 + ch]) * bf2f((u16)xc[e]) + bf2f(CW[384 + ch]) * bf2f((u16)xn[e]);
            v = v / (1.f + __expf(-v));
            y[hf * 8 + e] = v; ss += v * v;
          }
        }
        ss += shx(ss, lane, 1); ss += shx(ss, lane, 2);
        const float rn = rsqrtf(ss + 1e-6f);
        if (wh == 0) {
#pragma unroll
          for (int e = 0; e < 16; ++e) Qn[c * 72 + sg * 16 + e] = f2bf(y[e] * rn * 0.125f);
        } else if (wh == 1) {
#pragma unroll
          for (int e = 0; e < 16; ++e) { const u16 kb = f2bf(y[e] * rn); Kn[c * 72 + sg * 16 + e] = kb; Kt[(sg * 16 + e) * 72 + c] = kb; }
        } else {
#pragma unroll
          for (int e = 0; e < 16; ++e) Wv[c * 65 + sg * 16 + e] = y[e];
        }
      }
    }
    }
    __syncthreads();
    {const int tid = opq(tid0), lane = tid & 63, wave = __builtin_amdgcn_readfirstlane(tid >> 6), r = lane & 31, h = lane >> 5, vh = wave & 1; (void)r; (void)h; (void)vh; (void)lane;
    if (wave < 2) {
      f32x16 akk[2], aqk[2]; zero16(akk[0]); zero16(akk[1]); zero16(aqk[0]); zero16(aqk[1]);
#pragma unroll
      for (int ks = 0; ks < 4; ++ks) {
        const bf16x8 bk = *(const bf16x8*)(Kn + (vh * 32 + r) * 72 + ks * 16 + 8 * h);
#pragma unroll
        for (int ct = 0; ct < 2; ++ct) {
          const bf16x8 ak = *(const bf16x8*)(Kn + (ct * 32 + r) * 72 + ks * 16 + 8 * h);
          const bf16x8 aq = *(const bf16x8*)(Qn + (ct * 32 + r) * 72 + ks * 16 + 8 * h);
          akk[ct] = MFMA(ak, bk, akk[ct]);
          aqk[ct] = MFMA(aq, bk, aqk[ct]);
        }
      }
      const int s = vh * 32 + r;
      const float Gss = Gs[s];
#pragma unroll
      for (int ct = 0; ct < 2; ++ct)
#pragma unroll
        for (int g4 = 0; g4 < 4; ++g4) {
          const int c0 = ct * 32 + 8 * g4 + 4 * h;
          const float4 gv4 = *(const float4*)(Gs + c0), bv4 = *(const float4*)(Bt + c0);
          float4 val;
#pragma unroll
          for (int e = 0; e < 4; ++e) {
            const int c = c0 + e;
            const float Gc = e == 0 ? gv4.x : e == 1 ? gv4.y : e == 2 ? gv4.z : gv4.w;
            const float Bc = e == 0 ? bv4.x : e == 1 ? bv4.y : e == 2 ? bv4.z : bv4.w;
            const float gam = __expf(fminf(Gc - Gss, 0.f));
            const float av = (s < c) ? akk[ct][4 * g4 + e] * Bc * gam : 0.f;
            if (e == 0) val.x = av; else if (e == 1) val.y = av; else if (e == 2) val.z = av; else val.w = av;
            AQK[c * 72 + s] = f2bf((s <= c) ? aqk[ct][4 * g4 + e] * gam : 0.f);
          }
          *(float4*)(At + s * 68 + c0) = val;
        }
    }
    }
    __syncthreads();
    {const int tid = opq(tid0), lane = tid & 63, wave = __builtin_amdgcn_readfirstlane(tid >> 6), r = lane & 31, h = lane >> 5, vh = wave & 1; (void)r; (void)h; (void)vh; (void)lane;
    if (wave < 2) {
      const bool isv = wave == 0;
      const int col = lane;
#pragma unroll 1
      for (int bi = 0; bi < 4; ++bi) {
        float acc[16];
#pragma unroll
        for (int ci = 0; ci < 16; ++ci) {
          const int c = 16 * bi + ci;
          acc[ci] = isv ? Wv[c * 65 + col] * Bt[c] : bf2f(Kn[c * 72 + col]) * Bt[c] * __expf(Gs[c]);
        }
#pragma unroll 8
        for (int s2 = 0; s2 < 16 * bi; ++s2) {
          const float xs = isv ? Wv[s2 * 65 + col] : bf2f(KC[s2 * 72 + col]);
          const float4* a4 = (const float4*)(At + s2 * 68 + 16 * bi);
#pragma unroll
          for (int q = 0; q < 4; ++q) {
            const float4 a = a4[q];
            acc[4 * q] -= a.x * xs; acc[4 * q + 1] -= a.y * xs; acc[4 * q + 2] -= a.z * xs; acc[4 * q + 3] -= a.w * xs;
          }
        }
#pragma unroll
        for (int ci = 0; ci < 16; ++ci) {
          const float x = acc[ci];
          const float* arow = At + (16 * bi + ci) * 68 + 16 * bi;
#pragma unroll
          for (int cj = ci + 1; cj < 16; ++cj) acc[cj] -= arow[cj] * x;
          if (isv) Wv[(16 * bi + ci) * 65 + col] = x; else KC[(16 * bi + ci) * 72 + col] = f2bf(x);
        }
      }
    }
    }
    __syncthreads();
    }
    if (ROLE == 1) { copy_out(smem, slots + (size_t)(step_ % RING) * SLOT_BYTES, IMG, tid0); publish(ready + step_, 1, tid0); continue; }
    {const int tid = opq(tid0), lane = tid & 63, wave = __builtin_amdgcn_readfirstlane(tid >> 6), r = lane & 31, h = lane >> 5, vh = wave & 1; (void)r; (void)h; (void)vh; (void)lane;
    if (wave < 2) {
      f32x16 kS[2], qS[2]; zero16(kS[0]); zero16(kS[1]); zero16(qS[0]); zero16(qS[1]);
#pragma unroll
      for (int dt = 0; dt < 2; ++dt) {
        const bf16x8 xs0 = packs<0>(S[dt]), xs1 = packs<1>(S[dt]);
#pragma unroll
        for (int ct = 0; ct < 2; ++ct) {
          kS[ct] = MFMA(ld2x4(KC + (ct * 32 + r) * 72 + dt * 32 + 4 * h), xs0, kS[ct]);
          kS[ct] = MFMA(ld2x4(KC + (ct * 32 + r) * 72 + dt * 32 + 16 + 4 * h), xs1, kS[ct]);
          qS[ct] = MFMA(ld2x4(Qn + (ct * 32 + r) * 72 + dt * 32 + 4 * h), xs0, qS[ct]);
          qS[ct] = MFMA(ld2x4(Qn + (ct * 32 + r) * 72 + dt * 32 + 16 + 4 * h), xs1, qS[ct]);
        }
      }
      f32x16 vn[2], o[2];
      const float Glast = Gs[63];
#pragma unroll
      for (int ct = 0; ct < 2; ++ct)
#pragma unroll
        for (int i = 0; i < 16; ++i) {
          const int c = ct * 32 + crow(i, h);
          vn[ct][i] = Wv[c * 65 + vh * 32 + r] - kS[ct][i];
          o[ct][i] = qS[ct][i] * __expf(Gs[c]);
        }
#pragma unroll
      for (int st = 0; st < 2; ++st) {
        const bf16x8 xs0 = packs<0>(vn[st]), xs1 = packs<1>(vn[st]);
#pragma unroll
        for (int ct = 0; ct < 2; ++ct) {
          o[ct] = MFMA(ld2x4(AQK + (ct * 32 + r) * 72 + st * 32 + 4 * h), xs0, o[ct]);
          o[ct] = MFMA(ld2x4(AQK + (ct * 32 + r) * 72 + st * 32 + 16 + 4 * h), xs1, o[ct]);
        }
      }
      const float dl = __expf(Glast);
#pragma unroll
      for (int st = 0; st < 2; ++st) {
        asm volatile("" ::: "memory");
#pragma unroll
        for (int i = 0; i < 16; ++i) vn[st][i] *= __expf(Glast - Gs[st * 32 + crow(i, h)]);
      }
      asm volatile("" ::: "memory");
#pragma unroll
      for (int dt = 0; dt < 2; ++dt)
#pragma unroll
        for (int i = 0; i < 16; ++i) S[dt][i] *= dl;
#pragma unroll
      for (int st = 0; st < 2; ++st) {
        const bf16x8 xs0 = packs<0>(vn[st]), xs1 = packs<1>(vn[st]);
#pragma unroll
        for (int dt = 0; dt < 2; ++dt) {
          S[dt] = MFMA(ld2x4(Kt + (dt * 32 + r) * 72 + st * 32 + 4 * h), xs0, S[dt]);
          S[dt] = MFMA(ld2x4(Kt + (dt * 32 + r) * 72 + st * 32 + 16 + 4 * h), xs1, S[dt]);
        }
      }
#pragma unroll
      for (int ct = 0; ct < 2; ++ct)
#pragma unroll
        for (int i = 0; i < 16; ++i) At[(ct * 32 + crow(i, h)) * 68 + vh * 32 + r] = o[ct][i];
    }
    }
    __syncthreads();
    {
      const int tid = opq(tid0);
      const int c = tid >> 2, sg = tid & 3;
      const int tok = tokof(cid, step, c);
      u16* dst = (dir ? p.ot1 + (size_t)tok * 512 + hh * 64 : p.hn + (size_t)tok * 1024 + 512 + hh * 64) + sg * 16;
      bf16x8 w0, w1;
#pragma unroll
      for (int e = 0; e < 8; ++e) { w0[e] = (short)f2bf(At[c * 68 + sg * 16 + e]); w1[e] = (short)f2bf(At[c * 68 + sg * 16 + 8 + e]); }
      *(bf16x8*)dst = w0; *(bf16x8*)(dst + 8) = w1;
    }
  }
  {const int tid = opq(tid0), lane = tid & 63, wave = __builtin_amdgcn_readfirstlane(tid >> 6), r = lane & 31, h = lane >> 5, vh = wave & 1; (void)r; (void)h; (void)vh; (void)lane;
  if (wave < 2 && !cid.lat) {
#pragma unroll
    for (int dt = 0; dt < 2; ++dt)
#pragma unroll
      for (int i = 0; i < 16; ++i) p.out[OFF_SD + sidx + (dt * 32 + crow(i, h)) * 64 + vh * 32 + r] = S[dt][i];
  }
}
}

DI void mixer_phase(const P* __restrict__ gp, int l, char* smem) {
  const P& p = *gp;
  const bool even = !(l & 1); const int jj = l >> 1;
  const bool teams = gridDim.x >= 512;
  if (teams) {
    const int bid = blockIdx.x;
    const int K = even ? 2 : 3;
    if (bid < 128 * (K + 1)) {
      if (bid < 128) { if (even) gla_chain<2>(gp, jj, bid, smem, 0, 1); else delta_chain<2>(gp, jj, bid, smem, 0, 1); }
      else { const int ch = (bid - 128) & 127, k = (bid - 128) >> 7; if (even) gla_chain<1>(gp, jj, ch, smem, k, K); else delta_chain<1>(gp, jj, ch, smem, k, K); }
    }
  }
  const int first = teams ? 128 : 0;
  const int total = 384 + 2048 + 256;
  int* s_item = (int*)(smem + SMEM_BYTES - 16);
  int* cntp = uni(p.cnt) + l;
  for (;;) {
    __syncthreads();
    if (opq(threadIdx.x) == 0) *s_item = atomicAdd(cntp, 1) + first;
    __syncthreads();
    const int item = __builtin_amdgcn_readfirstlane(*s_item);
    if (item >= total) break;
    if (item < 384) { if (even) gla_chain<0>(gp, jj, item, smem, 0, 1); else delta_chain<0>(gp, jj, item, smem, 0, 1); }
    else if (item < 384 + 2048) { if (even) attn_item<1>(gp, jj, item - 384, smem); else attn_item<3>(gp, jj, item - 384, smem); }
    else { if (even) attn_item<0>(gp, jj, item - 384 - 2048, smem); else attn_item<2>(gp, jj, item - 384 - 2048, smem); }
  }
}

DI void finalize_phase(const P* __restrict__ gp, int l) {
  const P& p = *gp;
  const bool even = !(l & 1); const int jj = l >> 1;
  int tid_ = threadIdx.x; asm volatile("" : "+v"(tid_)); const int tid = tid_;
  const int tk = tid >> 5, hh = (tid >> 2) & 7, sg = tid & 3;
  const int PS = even ? EVN : ODN; const int zcol = even ? 3104 : 2336;
  for (int item = blockIdx.x; item < NT_ / 8; item += gridDim.x) {
    const size_t tok = (size_t)item * 8 + tk;
    u16* a = p.hn + tok * 1024 + 512 + hh * 64 + sg * 16;
    const u16* bsrc = p.ot1 + tok * 512 + hh * 64 + sg * 16;
    const u16* zs = p.proj + tok * PS + zcol + hh * 64 + sg * 16;
    float o[16]; float ss = 0.f;
#pragma unroll
    for (int hf = 0; hf < 2; ++hf) {
      const bf16x8 x0 = *(const bf16x8*)(a + hf * 8), x1 = *(const bf16x8*)(bsrc + hf * 8);
#pragma unroll
      for (int e = 0; e < 8; ++e) { const float v = bf2f((u16)x0[e]) + bf2f((u16)x1[e]); o[hf * 8 + e] = v; ss += v * v; }
    }
    ss += shx(ss, tid & 63, 1); ss += shx(ss, tid & 63, 2);
    const float rstd = rsqrtf(ss * (1.f / 64.f) + 1e-6f);
    const float* ng = even ? p.b_norm_g + jj * 512 + hh * 64 + sg * 16 : p.d_norm_g + jj * 64 + sg * 16;
#pragma unroll
    for (int hf = 0; hf < 2; ++hf) {
      const bf16x8 z = *(const bf16x8*)(zs + hf * 8);
      bf16x8 w;
#pragma unroll
      for (int e = 0; e < 8; ++e) { const float zz = bf2f((u16)z[e]); w[e] = (short)f2bf(o[hf * 8 + e] * rstd * ng[hf * 8 + e] * siluf(zz)); }
      *(bf16x8*)(a + hf * 8) = w;
    }
  }
}

DI void run_phase(const P* __restrict__ gp, int ph, char* smem) {
  const P& p = *gp;
  if (ph == 0) { prep_phase(gp, smem); return; }
  if (ph == NPH - 1) { norm_phase(gp, 0, 0, false, true); return; }
  const int l = (ph - 1) >> 3, s = (ph - 1) & 7;
  const bool even = !(l & 1);
  const u16* W = uni(p.wt) + (size_t)l * LW;
  const u16* hnp = uni(p.hn); const u16* projp = uni(p.proj);
  switch (s) {
    case 0: norm_phase(gp, l, 0, l == 0, false); break;
    case 1: gemm_phase<EPI_PROJ>(gp, l, smem, hnp, 1024, W + WO_IN, 1024, 1024, 288, even ? 29 : 23, 0); break;
    case 2: mixer_phase(gp, l, smem); break;
    case 3: finalize_phase(gp, l); break;
    case 4: gemm_phase<EPI_RES>(gp, l, smem, hnp, 1024, W + WO_OUT, 1024, 1024, 288, 8, 2); break;
    case 5: norm_phase(gp, l, 1, false, false); break;
    case 6: gemm_phase<EPI_FFN>(gp, l, smem, hnp, 1024, W + WO_UP, 1024, 1024, 312, 44, 0); break;
    case 7: gemm_phase<EPI_RES>(gp, l, smem, projp, 2816, W + WO_DN, 2816, 2816, 288, 8, 5); break;
  }
}

__global__ void __launch_bounds__(256, 2) mk(P p, P* gpmem, int ph0, int ph1) {
  __shared__ __attribute__((aligned(16))) char smem[SMEM_BYTES];
  const P* gp = &p;
  if (ph1 - ph0 > 1) {
    cg::grid_group grid = cg::this_grid();
    for (int ph = ph0; ph < ph1; ++ph) {
      run_phase(gp, ph, smem);
      if (ph + 1 < ph1) grid.sync();
    }
  } else {
    run_phase(gp, ph0, smem);
  }
}

extern "C" void kernel_launch(void* const* d_in, const int* in_sizes, int n_in, void* d_out, int out_size, void* d_ws, size_t ws_size,
                              hipStream_t stream) {
  P p{};
  const float** f = (const float**)&p;
  for (int i = 0; i < 31; ++i) f[i] = (const float*)d_in[i];
  p.out = (float*)d_out;
  char* ws = (char*)d_ws;
  size_t off = 0;
  p.hn = (u16*)(ws + off); off += (size_t)NT_ * 1024 * 2;
  p.proj = (u16*)(ws + off); off += (size_t)NT_ * EVN * 2;
  p.ot1 = (u16*)(ws + off); off += (size_t)NT_ * 512 * 2;
  p.wt = (u16*)(ws + off); off += 4 * LW * 2;
  p.mods = (float*)(ws + off); off += 4 * 9 * 6144 * 4;
  p.rope = (float*)(ws + off); off += 64 * 16 * 2 * 4;
  P* gp = (P*)(ws + off); off += 4096;
  p.cnt = (int*)(ws + off); off += 256;
  p.flags = (int*)(ws + off); off += 4 * 8320 * 4;
  off = (off + 255) & ~(size_t)255;
  p.ring = ws + off; off += (size_t)128 * RING * SLOT_BYTES;
  static int grid_blocks = 0;
  if (!grid_blocks) {
    int dev = 0, cus = 0, per_cu = 0;
    hipGetDevice(&dev);
    hipDeviceGetAttribute(&cus, hipDeviceAttributeMultiprocessorCount, dev);
    hipOccupancyMaxActiveBlocksPerMultiprocessor(&per_cu, mk, 256, 0);
    if (per_cu < 1) per_cu = 1;
    if (per_cu > 2) per_cu = 2;
    grid_blocks = cus * per_cu;
  }
#if MK_MULTI
  for (int ph = 0; ph < NPH; ++ph) {
    int a = ph, b = ph + 1;
    hipLaunchKernelGGL(mk, dim3(grid_blocks), dim3(256), 0, stream, p, gp, a, b);
  }
#else
  int ph0 = 0, ph1 = NPH;
  void* args[] = {&p, &gp, &ph0, &ph1};
  hipError_t e = hipLaunchCooperativeKernel((void*)mk, dim3(grid_blocks), dim3(256), args, 0, stream);
  if (e != hipSuccess) fprintf(stderr, "cooperative launch failed: %s (grid %d)\n", hipGetErrorString(e), grid_blocks);
#endif
}
```

```cpp
#include <hip/hip_runtime.h>
#include <hip/hip_cooperative_groups.h>
#include <cstdio>
namespace cg = cooperative_groups;

#ifndef MK_MULTI
#define MK_MULTI 0
#endif

#define DI __device__ __forceinline__
#define DN __device__ __noinline__
typedef unsigned short u16;
typedef __attribute__((ext_vector_type(8))) short bf16x8;
typedef __attribute__((ext_vector_type(4))) short s16x4;
typedef __attribute__((ext_vector_type(16))) float f32x16;
#define MFMA(a, b, c) __builtin_amdgcn_mfma_f32_32x32x16_bf16((a), (b), (c), 0, 0, 0)

static constexpr int NP_ = 4096, NT_ = 36864;
static constexpr int EVN = 3616, ODN = 2848;
static constexpr size_t OFF_AK = 37748736, OFF_AV = 41943040, OFF_SB = 46137344, OFF_CK = 48234496, OFF_CV = 49283072, OFF_SD = 50331648;
static constexpr size_t LW = 13500416, WO_UP = 0, WO_DN = 5767168, WO_IN = 8650752, WO_OUT = 12451840;
static constexpr int NPH = 34;
static constexpr int SMEM_BYTES = 80 * 1024;

struct P {
  const float *x_prompt, *x_sample, *cache_a_k, *cache_a_v, *state_b, *cache_c_k, *cache_c_v, *state_d, *c, *c_ctx, *ada_w, *ada_b,
      *norm1_g, *norm2_g, *ffn_up, *ffn_conv, *ffn_down, *ev_w_in, *ev_w_out, *a_rpb, *b_w_g2, *b_b_g, *b_norm_g, *od_w_in, *od_w_out,
      *c_sink, *d_conv, *d_a_log, *d_dt_bias, *d_norm_g, *final_g;
  float* out;
  u16 *hn, *proj, *ot1, *wt;
  float *mods, *rope;
  int* cnt;
  int* flags;
  char* ring;
  unsigned* bar;
};

DI u16 f2bf(float x) { unsigned u = __float_as_uint(x); u += 0x7fffu + ((u >> 16) & 1u); return (u16)(u >> 16); }
DI float bf2f(u16 b) { return __uint_as_float(((unsigned)b) << 16); }
DI int crow(int i, int h) { return (i & 3) + 8 * (i >> 2) + 4 * h; }
template <int S> DI bf16x8 packs(const f32x16& x) {
  bf16x8 v;
#pragma unroll
  for (int j = 0; j < 8; ++j) v[j] = (short)f2bf(x[8 * S + j]);
  return v;
}
DI bf16x8 ld2x4(const u16* p) {
  s16x4 lo = *(const s16x4*)p, hi = *(const s16x4*)(p + 8);
  return __builtin_shufflevector(lo, hi, 0, 1, 2, 3, 4, 5, 6, 7);
}
DI float siluf(float x) { return x / (1.f + __expf(-x)); }
DI int opq(int x) { asm volatile("" : "+v"(x)); return x; }
DI float shx(float v, int lane, int o) { return __int_as_float(__builtin_amdgcn_ds_bpermute((lane ^ o) << 2, __float_as_int(v))); }
template <class T> DI T* uni(T* q) { return q; }
DI void zero16(f32x16& a) {
#pragma unroll
  for (int i = 0; i < 16; ++i) a[i] = 0.f;
}

DI void prep_phase(const P* __restrict__ gp, char* smem) {
  const P& p = *gp;
  int tid_ = threadIdx.x; asm volatile("" : "+v"(tid_)); const int tid = tid_;
  const int NWT = 4 * (1408 + 704 + 256) + 2 * (928 + 736);
  const int NADA = 384;
  const int total = NWT + NADA + 1;
  for (int item = blockIdx.x; item < total; item += gridDim.x) {
    if (item < NWT) {
      int rem = item; const float* src = nullptr; u16* dst = nullptr; int K = 0, N = 0, NPd = 0;
      for (int l = 0; l < 4; ++l) {
        const int jj = l >> 1; const bool ev = !(l & 1);
        const int nin = ev ? 928 : 736;
        if (rem < 1408) { src = p.ffn_up + (size_t)l * 1024 * 5632; dst = p.wt + l * LW + WO_UP; K = 1024; N = 5632; NPd = 5632; break; }
        rem -= 1408;
        if (rem < 704) { src = p.ffn_down + (size_t)l * 2816 * 1024; dst = p.wt + l * LW + WO_DN; K = 2816; N = 1024; NPd = 1024; break; }
        rem -= 704;
        if (rem < nin) { src = ev ? p.ev_w_in + (size_t)jj * 1024 * EVN : p.od_w_in + (size_t)jj * 1024 * ODN; dst = p.wt + l * LW + WO_IN; K = 1024; N = ev ? EVN : ODN; NPd = ev ? 3712 : 2944; break; }
        rem -= nin;
        if (rem < 256) { src = (ev ? p.ev_w_out : p.od_w_out) + (size_t)jj * 1024 * 1024; dst = p.wt + l * LW + WO_OUT; K = 1024; N = 1024; NPd = 1024; break; }
        rem -= 256;
      }
      const int ntn = NPd >> 6;
      const int tk = rem / ntn, tn = rem - tk * ntn;
      const int scol0 = (N == 5632) ? ((tn & 1) * 2816 + (tn >> 1) * 64) : tn * 64;
      float* T = (float*)smem;
      __syncthreads();
#pragma unroll
      for (int i = 0; i < 16; ++i) {
        const int k = i * 4 + (tid >> 6), n = tid & 63;
        const int gn = scol0 + n;
        T[k * 65 + n] = (gn < N) ? src[(size_t)(tk * 64 + k) * N + gn] : 0.f;
      }
      __syncthreads();
#pragma unroll
      for (int i = 0; i < 2; ++i) {
        const int q = tid + 256 * i; const int n = q & 63, kc = q >> 6;
        const int pn = tn * 64 + n; const int nt32 = pn >> 5, rr = pn & 31;
        const int kstep = tk * 4 + (kc >> 1), hh = kc & 1;
        bf16x8 w;
#pragma unroll
        for (int j = 0; j < 8; ++j) w[j] = (short)f2bf(T[(kc * 8 + j) * 65 + n]);
        *(bf16x8*)(dst + ((size_t)(nt32 * (K >> 4) + kstep) * 64 + hh * 32 + rr) * 8) = w;
      }
    } else if (item < NWT + NADA) {
      const int it = item - NWT; const int l = it / 96, cgp = it - l * 96; const int n0 = cgp * 64;
      float* sc = (float*)smem;
      float* red = sc + 9 * 1024;
      __syncthreads();
      for (int idx = tid; idx < 9 * 1024; idx += 256) {
        const int ci = idx >> 10, k = idx & 1023;
        const float x = ci < 8 ? p.c[ci * 1024 + k] : p.c_ctx[k];
        sc[idx] = x / (1.f + expf(-x));
      }
      __syncthreads();
      const int wave = tid >> 6, lane = tid & 63;
      float acc[9];
#pragma unroll
      for (int ci = 0; ci < 9; ++ci) acc[ci] = 0.f;
      const float* wp = p.ada_w + ((size_t)l * 1024 + wave * 256) * 6144 + n0 + lane;
#pragma unroll 8
      for (int k = 0; k < 256; ++k) {
        const float wv = wp[(size_t)k * 6144];
#pragma unroll
        for (int ci = 0; ci < 9; ++ci) acc[ci] += sc[ci * 1024 + wave * 256 + k] * wv;
      }
#pragma unroll
      for (int ci = 0; ci < 9; ++ci) red[(wave * 9 + ci) * 64 + lane] = acc[ci];
      __syncthreads();
      for (int idx = tid; idx < 576; idx += 256) {
        const int ci = idx >> 6, col = idx & 63;
        const float s = red[(0 * 9 + ci) * 64 + col] + red[(1 * 9 + ci) * 64 + col] + red[(2 * 9 + ci) * 64 + col] + red[(3 * 9 + ci) * 64 + col];
        p.mods[(size_t)(l * 9 + ci) * 6144 + n0 + col] = s + p.ada_b[l * 6144 + n0 + col];
      }
    } else {
      if (tid < 8) p.cnt[tid] = 0;
      for (int i = tid; i < 4 * 8320; i += 256) p.flags[i] = 0;
      for (int idx = tid; idx < 1024; idx += 256) {
        const int pos = idx >> 4, fi = idx & 15;
        const float inv = powf(10000.f, -(float)fi / 16.f);
        const float ang = (float)pos * inv;
        p.rope[idx * 2] = cosf(ang); p.rope[idx * 2 + 1] = sinf(ang);
      }
    }
  }
}

DI void norm_phase(const P* __restrict__ gp, int l, int which, bool first, bool fin) {
  const P& p = *gp;
  int tid_ = threadIdx.x; asm volatile("" : "+v"(tid_)); const int tid = tid_, lane = tid & 63, wave = tid >> 6;
  for (int item = blockIdx.x; item < NT_ / 4; item += gridDim.x) {
    const int tok = item * 4 + wave;
    const float* src = first ? (tok < NP_ ? p.x_prompt + (size_t)tok * 1024 : p.x_sample + (size_t)(tok - NP_) * 1024) : p.out + (size_t)tok * 1024;
    float4 v[4];
    float ss = 0.f;
#pragma unroll
    for (int i = 0; i < 4; ++i) { v[i] = ((const float4*)src)[lane + 64 * i]; ss += v[i].x * v[i].x + v[i].y * v[i].y + v[i].z * v[i].z + v[i].w * v[i].w; }
#pragma unroll
    for (int o = 32; o >= 1; o >>= 1) ss += shx(ss, lane, o);
    const float rstd = rsqrtf(ss * (1.f / 1024.f) + 1e-6f);
    if (fin) {
#pragma unroll
      for (int i = 0; i < 4; ++i) {
        const float4 g = ((const float4*)p.final_g)[lane + 64 * i];
        float4 y; y.x = v[i].x * rstd * g.x; y.y = v[i].y * rstd * g.y; y.z = v[i].z * rstd * g.z; y.w = v[i].w * rstd * g.w;
        ((float4*)(p.out + (size_t)tok * 1024))[lane + 64 * i] = y;
      }
    } else {
      const int ci = tok < NP_ ? 8 : (tok - NP_) >> 12;
      const float* md = p.mods + (size_t)(l * 9 + ci) * 6144 + which * 3072;
      const float* gp = (which ? p.norm2_g : p.norm1_g) + l * 1024;
#pragma unroll
      for (int i = 0; i < 4; ++i) {
        const float4 g = ((const float4*)gp)[lane + 64 * i];
        const float4 sh = ((const float4*)md)[lane + 64 * i];
        const float4 sc = ((const float4*)(md + 1024))[lane + 64 * i];
        ushort4 o;
        o.x = f2bf(v[i].x * rstd * g.x * (1.f + sc.x) + sh.x);
        o.y = f2bf(v[i].y * rstd * g.y * (1.f + sc.y) + sh.y);
        o.z = f2bf(v[i].z * rstd * g.z * (1.f + sc.z) + sh.z);
        o.w = f2bf(v[i].w * rstd * g.w * (1.f + sc.w) + sh.w);
        ((ushort4*)(p.hn + (size_t)tok * 1024))[lane + 64 * i] = o;
        if (first) ((float4*)(p.out + (size_t)tok * 1024))[lane + 64 * i] = v[i];
      }
    }
  }
}

DI uint4 ldsel(const u16* pv, const u16* safe, unsigned ok) {
  uint4 t = *(const uint4*)(ok ? pv : safe);
  if (!ok) { t.x = 0; t.y = 0; t.z = 0; t.w = 0; }
  return t;
}
enum { EPI_PROJ = 0, EPI_RES = 1, EPI_FFN = 2 };

template <int EPI>
DI void gemm_phase(const P* __restrict__ gp, int l, char* smem, const u16* __restrict__ A, int lda, const u16* __restrict__ B, int ldb, int K, int MT,
                   int NTn, int gsel) {
  const P& p = *gp;
  u16* As = (u16*)smem;
  int tid_ = threadIdx.x; asm volatile("" : "+v"(tid_)); const int tid = tid_, lane = tid & 63, wave = tid >> 6, r = lane & 31, h = lane >> 5;
  const int wm = wave & 1, wn = wave >> 1;
  const int KT = K >> 6;
  const bool even = !(l & 1); const int jj = l >> 1;
  const int ntiles = MT * NTn;
  const int nlb = gridDim.x >> 3, xcd = blockIdx.x & 7, lb = blockIdx.x >> 3;
  for (int it = 0;; ++it) {
    const int g = (it * 8 + xcd) * nlb + lb;
    if (g >= ntiles) break;
    const int SM = nlb >> 3;
    const int band = g / (SM * NTn); const int rem = g - band * SM * NTn;
    const int nt = rem / SM, mt = band * SM + (rem - nt * SM);
    int seqbase = 0, L = 0, tin0 = 0;
    if (EPI == EPI_FFN) {
      if (mt < 48) { const int sq = mt / 3; L = 256; seqbase = sq * 256; tin0 = (mt - sq * 3) * 126; }
      else { const int m2 = mt - 48; const int sq = m2 / 33; L = 4096; seqbase = NP_ + sq * 4096; tin0 = (m2 - sq * 33) * 126; }
    }
    const int row0 = tid >> 3, kc0 = (tid & 7) * 8;
    const long arow0 = (EPI == EPI_FFN) ? (long)seqbase + tin0 - 1 + row0 : (long)mt * 128 + row0;
    const u16* abase = A + arow0 * lda + kc0;
    unsigned avalid = 0;
#pragma unroll
    for (int i = 0; i < 4; ++i) {
      if (EPI == EPI_FFN) { const int ts = tin0 - 1 + row0 + 32 * i; if (ts >= 0 && ts < L) avalid |= 1u << i; }
      else avalid |= 1u << i;
    }
    const u16* bb0 = B + ((size_t)((nt * 4 + wn * 2) * (K >> 4)) * 64 + lane) * 8;
    const size_t bts = (size_t)(K >> 4) * 512;
    f32x16 acc[2][2];
#pragma unroll
    for (int a = 0; a < 2; ++a)
#pragma unroll
      for (int b = 0; b < 2; ++b) zero16(acc[a][b]);
#define GLD_A(i, ko) ldsel(abase + (size_t)(32 * (i)) * lda + (ko), A, (avalid >> (i)) & 1u)
#define GLD_BF(dst, kt_) { const u16* q_ = bb0 + (size_t)(kt_) * 2048; \
      dst[0][0] = *(const bf16x8*)(q_); dst[0][1] = *(const bf16x8*)(q_ + 512); dst[0][2] = *(const bf16x8*)(q_ + 1024); dst[0][3] = *(const bf16x8*)(q_ + 1536); \
      dst[1][0] = *(const bf16x8*)(q_ + bts); dst[1][1] = *(const bf16x8*)(q_ + bts + 512); dst[1][2] = *(const bf16x8*)(q_ + bts + 1024); dst[1][3] = *(const bf16x8*)(q_ + bts + 1536); }
    uint4 ra0 = GLD_A(0, 0), ra1 = GLD_A(1, 0), ra2 = GLD_A(2, 0), ra3 = GLD_A(3, 0);
    uint4 sa0 = GLD_A(0, 64), sa1 = GLD_A(1, 64), sa2 = GLD_A(2, 64), sa3 = GLD_A(3, 64);
    bf16x8 bc[2][4], bn[2][4];
    GLD_BF(bc, 0);
    GLD_BF(bn, 1);
#define LSTORE(buf, A0, A1, A2, A3) { \
      u16* ad = As + (buf) * 9216 + row0 * 72 + kc0; \
      *(uint4*)(ad) = A0; *(uint4*)(ad + 32 * 72) = A1; *(uint4*)(ad + 64 * 72) = A2; *(uint4*)(ad + 96 * 72) = A3; }
#define COMPUTE(buf, BF, KN) { \
      const u16* Ab = As + (buf) * 9216; \
      const bool more_ = (KN) < KT; const u16* q_ = bb0 + (size_t)(KN) * 2048; \
      _Pragma("unroll") for (int ks = 0; ks < 4; ++ks) { \
        const bf16x8 a0 = *(const bf16x8*)(Ab + (wm * 64 + r) * 72 + ks * 16 + h * 8); \
        const bf16x8 a1 = *(const bf16x8*)(Ab + (wm * 64 + 32 + r) * 72 + ks * 16 + h * 8); \
        acc[0][0] = MFMA(a0, BF[0][ks], acc[0][0]); acc[0][1] = MFMA(a0, BF[1][ks], acc[0][1]); \
        acc[1][0] = MFMA(a1, BF[0][ks], acc[1][0]); acc[1][1] = MFMA(a1, BF[1][ks], acc[1][1]); \
        if (more_) { BF[0][ks] = *(const bf16x8*)(q_ + ks * 512); BF[1][ks] = *(const bf16x8*)(q_ + bts + ks * 512); } } }
    LSTORE(0, ra0, ra1, ra2, ra3);
    ra0 = GLD_A(0, 128); ra1 = GLD_A(1, 128); ra2 = GLD_A(2, 128); ra3 = GLD_A(3, 128);
    __syncthreads();
    for (int kt = 0; kt < KT; kt += 2) {
      COMPUTE(0, bc, kt + 2);
      LSTORE(1, sa0, sa1, sa2, sa3);
      if (kt + 3 < KT) {
        const int ko = (kt + 3) * 64;
        sa0 = GLD_A(0, ko); sa1 = GLD_A(1, ko); sa2 = GLD_A(2, ko); sa3 = GLD_A(3, ko);
      }
      __syncthreads();
      COMPUTE(1, bn, kt + 3);
      if (kt + 2 < KT) {
        LSTORE(0, ra0, ra1, ra2, ra3);
        if (kt + 4 < KT) {
          const int ko = (kt + 4) * 64;
          ra0 = GLD_A(0, ko); ra1 = GLD_A(1, ko); ra2 = GLD_A(2, ko); ra3 = GLD_A(3, ko);
        }
      }
      __syncthreads();
    }
    if (EPI == EPI_PROJ) {
      const int N = even ? EVN : ODN;
#pragma unroll
      for (int tm = 0; tm < 2; ++tm)
#pragma unroll
        for (int tn = 0; tn < 2; ++tn) {
          const int col = nt * 128 + wn * 64 + tn * 32 + r;
          if (col < N) {
#pragma unroll
            for (int i = 0; i < 16; ++i) {
              const int row = mt * 128 + wm * 64 + tm * 32 + crow(i, h);
              const float v = acc[tm][tn][i];
              p.proj[(size_t)row * N + col] = f2bf(v);
              if (row < NP_) {
                const int b = row >> 8, t = row & 255, d = col & 63;
                if (even) {
                  if (col >= 512 && col < 1536) {
                    const int wh = (col - 512) >> 9, hh = ((col - 512) >> 6) & 7;
                    p.out[(wh ? OFF_AV : OFF_AK) + ((size_t)(((b * 2 + jj) * 8 + hh) * 256 + t)) * 64 + d] = v;
                  }
                } else {
                  if (col >= 512 && col < 768) {
                    const int wh = (col - 512) >> 7, kv = ((col - 512) >> 6) & 1;
                    p.out[(wh ? OFF_CV : OFF_CK) + ((size_t)(((b * 2 + jj) * 2 + kv) * 256 + t)) * 64 + d] = v;
                  }
                }
              }
            }
          }
        }
    } else if (EPI == EPI_RES) {
#pragma unroll
      for (int tm = 0; tm < 2; ++tm)
#pragma unroll
        for (int tn = 0; tn < 2; ++tn) {
          const int col = nt * 128 + wn * 64 + tn * 32 + r;
#pragma unroll
          for (int i = 0; i < 16; ++i) {
            const int row = mt * 128 + wm * 64 + tm * 32 + crow(i, h);
            const int ci = row < NP_ ? 8 : (row - NP_) >> 12;
            const float g = p.mods[(size_t)(l * 9 + ci) * 6144 + gsel * 1024 + col];
            float* xp = p.out + (size_t)row * 1024 + col;
            *xp = *xp + g * acc[tm][tn][i];
          }
        }
    } else {
      __syncthreads();
      float* U = (float*)smem;
#pragma unroll
      for (int tm = 0; tm < 2; ++tm)
#pragma unroll
        for (int tn = 0; tn < 2; ++tn)
#pragma unroll
          for (int i = 0; i < 16; ++i) U[(wm * 64 + tm * 32 + crow(i, h)) * 132 + wn * 64 + tn * 32 + r] = acc[tm][tn][i];
      __syncthreads();
      const float* cw = p.ffn_conv + (size_t)l * 3 * 5632;
      const int f = tid & 63, rg = tid >> 6; const int fg = nt * 64 + f;
      const float wa0 = cw[fg], wa1 = cw[5632 + fg], wa2 = cw[2 * 5632 + fg];
      const float wg0 = cw[2816 + fg], wg1 = cw[5632 + 2816 + fg], wg2 = cw[2 * 5632 + 2816 + fg];
      u16* act = p.proj;
      {
        const int rbeg = 1 + 32 * rg, rend = rg == 3 ? 126 : 32 * rg + 32;
        float ap = U[(rbeg - 1) * 132 + f], ac = U[rbeg * 132 + f];
        float gp_ = U[(rbeg - 1) * 132 + 64 + f], gc = U[rbeg * 132 + 64 + f];
        for (int rr = rbeg; rr <= rend; ++rr) {
          const int ts = tin0 - 1 + rr;
          if (ts >= L) break;
          const float an = U[(rr + 1) * 132 + f], gn = U[(rr + 1) * 132 + 64 + f];
          const float a = wa0 * ap + wa1 * ac + wa2 * an;
          const float g = wg0 * gp_ + wg1 * gc + wg2 * gn;
          act[(size_t)(seqbase + ts) * 2816 + fg] = f2bf(a * siluf(g));
          ap = ac; ac = an; gp_ = gc; gc = gn;
        }
      }
      __syncthreads();
    }
  }
}

template <int MODE>
DI void attn_item(const P* __restrict__ gp, int jj, int it, char* smem) {
  const P& p = *gp;
  const u16* projp = uni(p.proj); u16* hnp = uni(p.hn); const float* ropep = uni(p.rope);
  u16* Ks = (u16*)smem; u16* Vt = Ks + 64 * 72; float* rpb_s = (float*)(Vt + 64 * 72);
  int tid_ = threadIdx.x; asm volatile("" : "+v"(tid_)); const int tid = tid_, lane = tid & 63, wave = tid >> 6, r = lane & 31, h = lane >> 5;
  constexpr bool EVENL = (MODE == 0 || MODE == 1);
  constexpr bool LAT = (MODE == 1 || MODE == 3);
  constexpr int PS = EVENL ? EVN : ODN;
  int b, hq, qb, tokbase;
  if (!LAT) { b = it >> 4; hq = (it >> 1) & 7; qb = it & 1; tokbase = b * 256; }
  else { b = it >> 8; hq = (it >> 5) & 7; qb = it & 31; tokbase = NP_ + b * 4096; }
  const int hk = EVENL ? hq : (hq >> 2);
  const int kcol = 512 + hk * 64, vcol = (EVENL ? 1024 : 640) + hk * 64, qcol = hq * 64;
  const int tq = qb * 128 + wave * 32 + r;
  const size_t qtok = (size_t)tokbase + tq;
  __syncthreads();
  if (MODE == 1) { for (int i = tid; i < 465; i += 256) rpb_s[i] = p.a_rpb[(size_t)(jj * 8 + hq) * 465 + i]; }
  bf16x8 qf[4];
#pragma unroll
  for (int s = 0; s < 4; ++s) qf[s] = *(const bf16x8*)(projp + qtok * PS + qcol + 16 * s + 8 * h);
  if (MODE == 3) {
    const int prow = tq >> 6, pcol = tq & 63;
#pragma unroll
    for (int half = 0; half < 2; ++half) {
      const int pos = half ? pcol : prow;
#pragma unroll
      for (int j = 0; j < 8; ++j) {
        const float cs = ropep[(pos * 16 + 8 * h + j) * 2], sn = ropep[(pos * 16 + 8 * h + j) * 2 + 1];
        const float x1 = bf2f((u16)qf[2 * half][j]), x2 = bf2f((u16)qf[2 * half + 1][j]);
        qf[2 * half][j] = (short)f2bf(x1 * cs - x2 * sn);
        qf[2 * half + 1][j] = (short)f2bf(x1 * sn + x2 * cs);
      }
    }
  }
  float m_run = -1e30f, l_run = 0.f;
  if (MODE == 2 || MODE == 3) { m_run = p.c_sink[jj * 8 + hq]; l_run = h == 0 ? 1.f : 0.f; }
  f32x16 ot[2]; zero16(ot[0]); zero16(ot[1]);
  int loc0 = 0, nloc = 0;
  if (MODE == 1) {
    const int qi0 = 2 * qb;
    const int rlo = min(max(qi0 - 4, 0), 56), rhi = min(max(qi0 + 1 - 4, 0), 56) + 7;
    loc0 = rlo; nloc = rhi - rlo + 1;
  } else if (MODE == 3) {
    loc0 = max(0, 2 * qb - 2); nloc = min(63, 2 * qb + 3) - loc0 + 1;
  }
  const int qi = tq >> 6, qw = tq & 63;
  const int r0w = min(max(qi - 4, 0), 56), c0w = min(max(qw - 8, 0), 48);
  const int key = tid >> 2, seg = tid & 3;
  for (int kb = 0; kb < 4 + nloc; ++kb) {
    const bool isctx = kb < 4;
    const int blk = isctx ? kb : loc0 + kb - 4;
    __syncthreads();
    {
      float kf[16], vf[16];
      if (LAT && isctx) {
        const float* kc = (MODE == 1) ? p.cache_a_k + ((size_t)((b * 2 + jj) * 8 + hk)) * 16384 : p.cache_c_k + ((size_t)((b * 2 + jj) * 2 + hk)) * 16384;
        const float* vc = (MODE == 1) ? p.cache_a_v + ((size_t)((b * 2 + jj) * 8 + hk)) * 16384 : p.cache_c_v + ((size_t)((b * 2 + jj) * 2 + hk)) * 16384;
        const float4* kp4 = (const float4*)(kc + (size_t)(blk * 64 + key) * 64 + seg * 16);
        const float4* vp4 = (const float4*)(vc + (size_t)(blk * 64 + key) * 64 + seg * 16);
#pragma unroll
        for (int e = 0; e < 4; ++e) {
          const float4 a = kp4[e], c = vp4[e];
          kf[4 * e] = a.x; kf[4 * e + 1] = a.y; kf[4 * e + 2] = a.z; kf[4 * e + 3] = a.w;
          vf[4 * e] = c.x; vf[4 * e + 1] = c.y; vf[4 * e + 2] = c.z; vf[4 * e + 3] = c.w;
        }
      } else {
        const u16* rowp = projp + ((size_t)tokbase + blk * 64 + key) * PS;
        const bf16x8 k0 = *(const bf16x8*)(rowp + kcol + seg * 16), k1 = *(const bf16x8*)(rowp + kcol + seg * 16 + 8);
        const bf16x8 v0 = *(const bf16x8*)(rowp + vcol + seg * 16), v1 = *(const bf16x8*)(rowp + vcol + seg * 16 + 8);
#pragma unroll
        for (int e = 0; e < 8; ++e) { kf[e] = bf2f((u16)k0[e]); kf[8 + e] = bf2f((u16)k1[e]); vf[e] = bf2f((u16)v0[e]); vf[8 + e] = bf2f((u16)v1[e]); }
        if (MODE == 3) {
          const bf16x8 p0 = *(const bf16x8*)(rowp + kcol + (seg ^ 1) * 16), p1 = *(const bf16x8*)(rowp + kcol + (seg ^ 1) * 16 + 8);
          const int pos = (seg & 2) ? key : blk;
#pragma unroll
          for (int e = 0; e < 16; ++e) {
            const float pr = bf2f((u16)(e < 8 ? p0[e & 7] : p1[e & 7]));
            const float cs = ropep[(pos * 16 + e) * 2], sn = ropep[(pos * 16 + e) * 2 + 1];
            kf[e] = (seg & 1) ? (pr * sn + kf[e] * cs) : (kf[e] * cs - pr * sn);
          }
        }
      }
      bf16x8 o0, o1;
#pragma unroll
      for (int e = 0; e < 8; ++e) { o0[e] = (short)f2bf(kf[e]); o1[e] = (short)f2bf(kf[8 + e]); }
      *(bf16x8*)(Ks + key * 72 + seg * 16) = o0;
      *(bf16x8*)(Ks + key * 72 + seg * 16 + 8) = o1;
#pragma unroll
      for (int e = 0; e < 16; ++e) Vt[(seg * 16 + e) * 72 + key] = f2bf(vf[e]);
    }
    __syncthreads();
    bool active = true;
    if (MODE == 1 && !isctx) active = (blk >= r0w && blk < r0w + 8);
    if (active) {
      f32x16 st[2]; zero16(st[0]); zero16(st[1]);
#pragma unroll
      for (int kt = 0; kt < 2; ++kt)
#pragma unroll
        for (int s = 0; s < 4; ++s) {
          const bf16x8 a = *(const bf16x8*)(Ks + (kt * 32 + r) * 72 + 16 * s + 8 * h);
          st[kt] = MFMA(a, qf[s], st[kt]);
        }
      float mx = m_run;
#pragma unroll
      for (int kt = 0; kt < 2; ++kt)
#pragma unroll
        for (int i = 0; i < 16; ++i) {
          float s = st[kt][i] * 0.125f;
          const int kk = kt * 32 + crow(i, h);
          if (MODE == 1 && !isctx) {
            const bool ok = (kk >= c0w && kk < c0w + 16);
            s = ok ? s + rpb_s[(blk - qi + 7) * 31 + (kk - qw + 15)] : -1e30f;
          }
          if (MODE == 3 && !isctx) {
            const int dlt = blk * 64 + kk - tq;
            s = (dlt <= 128 && dlt >= -128) ? s : -1e30f;
          }
          st[kt][i] = s;
          mx = fmaxf(mx, s);
        }
      mx = fmaxf(mx, shx(mx, lane, 32));
      const float alpha = __expf(m_run - mx);
      m_run = mx;
      float ps = 0.f;
#pragma unroll
      for (int kt = 0; kt < 2; ++kt)
#pragma unroll
        for (int i = 0; i < 16; ++i) { const float pv = __expf(st[kt][i] - mx); st[kt][i] = pv; ps += pv; }
      l_run = l_run * alpha + ps;
#pragma unroll
      for (int dt = 0; dt < 2; ++dt)
#pragma unroll
        for (int i = 0; i < 16; ++i) ot[dt][i] *= alpha;
#pragma unroll
      for (int kt = 0; kt < 2; ++kt) {
        const bf16x8 pb0 = packs<0>(st[kt]), pb1 = packs<1>(st[kt]);
#pragma unroll
        for (int dt = 0; dt < 2; ++dt) {
          const bf16x8 pa0 = ld2x4(Vt + (dt * 32 + r) * 72 + kt * 32 + 4 * h);
          const bf16x8 pa1 = ld2x4(Vt + (dt * 32 + r) * 72 + kt * 32 + 16 + 4 * h);
          ot[dt] = MFMA(pa0, pb0, ot[dt]);
          ot[dt] = MFMA(pa1, pb1, ot[dt]);
        }
      }
    }
  }
  l_run += shx(l_run, lane, 32);
  const float inv = 1.f / l_run;
  u16* dst = hnp + qtok * 1024 + qcol;
#pragma unroll
  for (int dt = 0; dt < 2; ++dt)
#pragma unroll
    for (int g4 = 0; g4 < 4; ++g4) {
      ushort4 o;
      o.x = f2bf(ot[dt][4 * g4] * inv); o.y = f2bf(ot[dt][4 * g4 + 1] * inv); o.z = f2bf(ot[dt][4 * g4 + 2] * inv); o.w = f2bf(ot[dt][4 * g4 + 3] * inv);
      *(ushort4*)(dst + dt * 32 + 8 * g4 + 4 * h) = o;
    }
}

struct ChainId { int lat, b, h, dir, T, base, nch; };
DI ChainId chain_decode(int it) {
  ChainId c; c.lat = it < 128; const int q = c.lat ? it : it - 128;
  c.b = q >> 4; c.h = (q >> 1) & 7; c.dir = q & 1; c.T = c.lat ? 4096 : 256; c.base = c.lat ? NP_ + c.b * 4096 : c.b * 256; c.nch = c.T >> 6;
  return c;
}
DI int tokof(const ChainId& c, int step, int row) { const int pp = step * 64 + row; return c.base + (c.dir ? c.T - 1 - pp : pp); }


static constexpr int RING = 4;
static constexpr int SLOT_BYTES = 53760;
DI void wait_ge(int* flag, int val, int tid) {
  if (tid < 64) {
    if (tid == 0) { while (__hip_atomic_load(flag, __ATOMIC_RELAXED, __HIP_MEMORY_SCOPE_AGENT) < val) __builtin_amdgcn_s_sleep(1); }
    __builtin_amdgcn_fence(__ATOMIC_ACQUIRE, "agent");
  }
  __syncthreads();
}
DI void publish(int* flag, int val, int tid) {
  asm volatile("s_waitcnt vmcnt(0)" ::: "memory");
  __syncthreads();
  if (tid == 0) __hip_atomic_store(flag, val, __ATOMIC_RELAXED, __HIP_MEMORY_SCOPE_AGENT);
}
typedef __attribute__((ext_vector_type(4))) unsigned u32x4;
DI void copy_out(const char* lds, char* g, int bytes, int tid) {
  for (int i = opq(tid) * 16; i < bytes; i += 256 * 16) {
    const u32x4 v = *(const u32x4*)(lds + i);
    char* dst = g + i;
    asm volatile("global_store_dwordx4 %0, %1, off sc0 sc1" :: "v"(dst), "v"(v) : "memory");
  }
}
template <int BYTES>
DI void copy_in_t(char* lds, const char* g, int tid) {
  constexpr int N = (BYTES + 4095) / 4096;
  const int t16 = opq(tid) * 16;
  uint4 v[N];
#pragma unroll
  for (int j = 0; j < N; ++j) { const int i = t16 + j * 4096; v[j] = make_uint4(0, 0, 0, 0); if (i < BYTES) v[j] = *(const uint4*)(g + i); }
#pragma unroll
  for (int j = 0; j < N; ++j) { const int i = t16 + j * 4096; if (i < BYTES) *(uint4*)(lds + i) = v[j]; }
}

template <int ROLE>
DI void gla_chain(const P* __restrict__ gp, int jj, int it, char* smem, int k0, int kstep) {
  const P& p = *gp;
  const ChainId cid = chain_decode(it);
  int tid_ = threadIdx.x; asm volatile("" : "+v"(tid_)); const int tid = tid_, lane = tid & 63, wave = tid >> 6, r = lane & 31, h = lane >> 5;
  const int hh = cid.h, dir = cid.dir;
  u16* QT = (u16*)smem; u16* KT = QT + 4608; u16* KEt = KT + 4608; u16* Vt = KEt + 4608;
  float* dec = (float*)(Vt + 4608); float* GL = dec + 64; float* gq = GL + 1024; float* Ost = gq + 256;
  constexpr int IMG = 4 * 9216 + 256;
  char* slots = uni(p.ring) + (size_t)it * RING * SLOT_BYTES; int* ready = uni(p.flags) + (jj * 2) * 8320 + it * 64; int* done = uni(p.flags) + (jj * 2) * 8320 + 8192 + it;
  const int d = tid & 63, cq = tid >> 6;
  float wg[16];
#pragma unroll
  for (int rr = 0; rr < 16; ++rr) wg[rr] = p.b_w_g2[((size_t)((jj * 2 + dir) * 16 + rr)) * 512 + hh * 64 + d];
  const float bg = p.b_b_g[(jj * 2 + dir) * 512 + hh * 64 + d];
  const int vh = wave & 1;
  f32x16 S[2]; zero16(S[0]); zero16(S[1]);
  const size_t sidx = ((size_t)(((cid.b * 2 + jj) * 2 + dir) * 8 + hh)) * 4096;
  if (ROLE != 1 && wave < 2 && cid.lat) {
#pragma unroll
    for (int dt = 0; dt < 2; ++dt)
#pragma unroll
      for (int i = 0; i < 16; ++i) S[dt][i] = p.state_b[sidx + (dt * 32 + crow(i, h)) * 64 + vh * 32 + r];
  }
  for (int step_ = k0; step_ < cid.nch; step_ += kstep) {
    int step = step_;
    asm volatile("" : "+v"(step));
    if (ROLE == 1) wait_ge(done, step_ - RING + 1, tid);
    if (ROLE == 2) wait_ge(ready + step_, 1, tid);
    __syncthreads();
    if (ROLE == 2) { copy_in_t<IMG>(smem, slots + (size_t)(step_ % RING) * SLOT_BYTES, tid); __syncthreads(); if (tid == 0) __hip_atomic_store(done, step_ + 1, __ATOMIC_RELAXED, __HIP_MEMORY_SCOPE_AGENT); }
    if (ROLE != 2) {
    {
      const int c = tid >> 2, sg = tid & 3;
      const int tok = tokof(cid, step, c);
      const ushort4 gv = *(const ushort4*)(p.proj + (size_t)tok * EVN + 3072 + dir * 16 + sg * 4);
      GL[c * 16 + sg * 4] = bf2f(gv.x); GL[c * 16 + sg * 4 + 1] = bf2f(gv.y); GL[c * 16 + sg * 4 + 2] = bf2f(gv.z); GL[c * 16 + sg * 4 + 3] = bf2f(gv.w);
    }
    __syncthreads();
    float Gl[16]; float run = 0.f;
#pragma unroll
    for (int i = 0; i < 16; ++i) {
      const int c = cq * 16 + i;
      float z = bg;
#pragma unroll
      for (int rr = 0; rr < 16; ++rr) z += GL[c * 16 + rr] * wg[rr];
      const float g = (fminf(z, 0.f) - __logf(1.f + __expf(-fabsf(z)))) * (1.f / 16.f);
      run += g; Gl[i] = run;
    }
    gq[cq * 64 + d] = run;
    __syncthreads();
    float off = 0.f, tot = 0.f;
#pragma unroll
    for (int q2 = 0; q2 < 4; ++q2) { const float t = gq[q2 * 64 + d]; if (q2 < cq) off += t; tot += t; }
#pragma unroll
    for (int i = 0; i < 16; ++i) {
      const int c = cq * 16 + i;
      const int tok = tokof(cid, step, c);
      const float G = Gl[i] + off;
      const u16* rowp = p.proj + (size_t)tok * EVN + hh * 64 + d;
      const float qv = bf2f(rowp[1536]), kv = bf2f(rowp[2048]);
      const u16 vb = rowp[2560];
      QT[c * 72 + d] = f2bf(qv * 0.125f * __expf(G));
      KT[c * 72 + d] = f2bf(kv * __expf(-G));
      KEt[d * 72 + c] = f2bf(kv * __expf(tot - G));
      Vt[d * 72 + c] = vb;
    }
    if (cq == 0) dec[d] = __expf(tot);
    __syncthreads();
    }
    if (ROLE == 1) { copy_out(smem, slots + (size_t)(step_ % RING) * SLOT_BYTES, IMG, tid); publish(ready + step_, 1, tid); continue; }
    if (wave < 2) {
      f32x16 at[2][2];
#pragma unroll
      for (int a = 0; a < 2; ++a)
#pragma unroll
        for (int b2 = 0; b2 < 2; ++b2) zero16(at[a][b2]);
#pragma unroll
      for (int ks = 0; ks < 4; ++ks) {
        const bf16x8 a0 = *(const bf16x8*)(KT + r * 72 + ks * 16 + 8 * h), a1 = *(const bf16x8*)(KT + (32 + r) * 72 + ks * 16 + 8 * h);
        const bf16x8 b0 = *(const bf16x8*)(QT + r * 72 + ks * 16 + 8 * h), b1 = *(const bf16x8*)(QT + (32 + r) * 72 + ks * 16 + 8 * h);
        at[0][0] = MFMA(a0, b0, at[0][0]); at[0][1] = MFMA(a0, b1, at[0][1]);
        at[1][0] = MFMA(a1, b0, at[1][0]); at[1][1] = MFMA(a1, b1, at[1][1]);
      }
#pragma unroll
      for (int st = 0; st < 2; ++st)
#pragma unroll
        for (int ct = 0; ct < 2; ++ct)
#pragma unroll
          for (int i = 0; i < 16; ++i) { if (st * 32 + crow(i, h) > ct * 32 + r) at[st][ct][i] = 0.f; }
      f32x16 o[2]; zero16(o[0]); zero16(o[1]);
#pragma unroll
      for (int ct = 0; ct < 2; ++ct)
#pragma unroll
        for (int st = 0; st < 2; ++st) {
          const bf16x8 x0 = packs<0>(at[st][ct]), x1 = packs<1>(at[st][ct]);
          const bf16x8 pb0 = ld2x4(Vt + (vh * 32 + r) * 72 + st * 32 + 4 * h);
          const bf16x8 pb1 = ld2x4(Vt + (vh * 32 + r) * 72 + st * 32 + 16 + 4 * h);
          o[ct] = MFMA(x0, pb0, o[ct]);
          o[ct] = MFMA(x1, pb1, o[ct]);
        }
#pragma unroll
      for (int dt = 0; dt < 2; ++dt) {
        const bf16x8 xs0 = packs<0>(S[dt]), xs1 = packs<1>(S[dt]);
#pragma unroll
        for (int ct = 0; ct < 2; ++ct) {
          const bf16x8 pa0 = ld2x4(QT + (ct * 32 + r) * 72 + dt * 32 + 4 * h);
          const bf16x8 pa1 = ld2x4(QT + (ct * 32 + r) * 72 + dt * 32 + 16 + 4 * h);
          o[ct] = MFMA(pa0, xs0, o[ct]);
          o[ct] = MFMA(pa1, xs1, o[ct]);
        }
      }
#pragma unroll
      for (int dt = 0; dt < 2; ++dt)
#pragma unroll
        for (int i = 0; i < 16; ++i) S[dt][i] *= dec[dt * 32 + crow(i, h)];
#pragma unroll
      for (int ks = 0; ks < 4; ++ks) {
        const bf16x8 bv = *(const bf16x8*)(Vt + (vh * 32 + r) * 72 + ks * 16 + 8 * h);
#pragma unroll
        for (int dt = 0; dt < 2; ++dt) {
          const bf16x8 a = *(const bf16x8*)(KEt + (dt * 32 + r) * 72 + ks * 16 + 8 * h);
          S[dt] = MFMA(a, bv, S[dt]);
        }
      }
#pragma unroll
      for (int ct = 0; ct < 2; ++ct)
#pragma unroll
        for (int i = 0; i < 16; ++i) Ost[(ct * 32 + crow(i, h)) * 68 + vh * 32 + r] = o[ct][i];
    }
    __syncthreads();
    {
      const int c = tid >> 2, sg = tid & 3;
      const int tok = tokof(cid, step, c);
      u16* dst = (dir ? p.ot1 + (size_t)tok * 512 + hh * 64 : p.hn + (size_t)tok * 1024 + 512 + hh * 64) + sg * 16;
      bf16x8 w0, w1;
#pragma unroll
      for (int e = 0; e < 8; ++e) { w0[e] = (short)f2bf(Ost[c * 68 + sg * 16 + e]); w1[e] = (short)f2bf(Ost[c * 68 + sg * 16 + 8 + e]); }
      *(bf16x8*)dst = w0; *(bf16x8*)(dst + 8) = w1;
    }
  }
  if (wave < 2 && !cid.lat) {
#pragma unroll
    for (int dt = 0; dt < 2; ++dt)
#pragma unroll
      for (int i = 0; i < 16; ++i) p.out[OFF_SB + sidx + (dt * 32 + crow(i, h)) * 64 + vh * 32 + r] = S[dt][i];
  }
}

template <int ROLE>
DI void delta_chain(const P* __restrict__ gp, int jj, int it, char* smem, int k0, int kstep) {
  const P& p = *gp;
  const ChainId cid = chain_decode(it);
  int tid_ = threadIdx.x; asm volatile("" : "+v"(tid_)); const int tid0 = tid_;
  const int hh = cid.h, dir = cid.dir;
  u16* Qn = (u16*)smem; u16* Kt = Qn + 4608; u16* AQK = Kt + 4608; u16* KC = AQK + 4608;
  float* Wv = (float*)(KC + 4608); float* Gs = Wv + 64 * 65; u16* Kn = (u16*)(Gs + 64); float* At = (float*)(Kn + 4608); float* Bt = At + 64 * 68;
  constexpr int IMG = 4 * 9216 + 16640 + 256;
  char* slots = uni(p.ring) + (size_t)it * RING * SLOT_BYTES; int* ready = uni(p.flags) + (jj * 2 + 1) * 8320 + it * 64; int* done = uni(p.flags) + (jj * 2 + 1) * 8320 + 8192 + it;
  const float aexp = __expf(p.d_a_log[(jj * 2 + dir) * 8 + hh]);
  const float dtb = p.d_dt_bias[(jj * 2 + dir) * 8 + hh];
  f32x16 S[2]; zero16(S[0]); zero16(S[1]);
  const size_t sidx = ((size_t)(((cid.b * 2 + jj) * 2 + dir) * 8 + hh)) * 4096;
  { const int tid = tid0, lane = tid & 63, wave = tid >> 6, r = lane & 31, h = lane >> 5;
  if (ROLE != 1 && wave < 2 && cid.lat) {
    const int vh = wave & 1;
#pragma unroll
    for (int dt = 0; dt < 2; ++dt)
#pragma unroll
      for (int i = 0; i < 16; ++i) S[dt][i] = p.state_d[sidx + (dt * 32 + crow(i, h)) * 64 + vh * 32 + r];
  }
  }
  u16* CW = (u16*)(smem + 80640);
  __syncthreads();
  for (int i = tid0; i < 576; i += 256) { const int tap = i / 192, c2 = i - tap * 192; const int wh = c2 >> 6, dd = c2 & 63;
    CW[i] = f2bf(p.d_conv[(size_t)jj * 3 * 1536 + tap * 1536 + wh * 512 + hh * 64 + dd]); }
  for (int step_ = k0; step_ < cid.nch; step_ += kstep) {
    int step = step_;
    asm volatile("" : "+v"(step));
    if (ROLE == 1) wait_ge(done, step_ - RING + 1, tid0);
    if (ROLE == 2) wait_ge(ready + step_, 1, tid0);
    __syncthreads();
    if (ROLE == 2) { copy_in_t<IMG>(smem, slots + (size_t)(step_ % RING) * SLOT_BYTES, tid0); __syncthreads(); if (tid0 == 0) __hip_atomic_store(done, step_ + 1, __ATOMIC_RELAXED, __HIP_MEMORY_SCOPE_AGENT); }
    if (ROLE != 2) {
    {const int tid = opq(tid0), lane = tid & 63, wave = __builtin_amdgcn_readfirstlane(tid >> 6), r = lane & 31, h = lane >> 5, vh = wave & 1; (void)r; (void)h; (void)vh; (void)lane;
    if (wave == 0) {
      const int tok = tokof(cid, step, lane);
      const float da = bf2f(p.proj[(size_t)tok * ODN + 2304 + dir * 8 + hh]);
      const float db = bf2f(p.proj[(size_t)tok * ODN + 2320 + dir * 8 + hh]);
      const float x = da + dtb;
      const float sp = x > 20.f ? x : __logf(1.f + __expf(x));
      float G = -aexp * sp;
#pragma unroll
      for (int o = 1; o < 64; o <<= 1) { const float t = __int_as_float(__builtin_amdgcn_ds_bpermute((lane - o) << 2, __float_as_int(G))); if (lane >= o) G += t; }
      Gs[lane] = G; Bt[lane] = 1.f / (1.f + __expf(-db));
    }
    {
      const int c = tid >> 2, sg = tid & 3;
      const int tok = tokof(cid, step, c);
      const int pos = tok - cid.base;
      const bool hp = pos > 0, hn_ = pos < cid.T - 1;
#pragma unroll 1
      for (int wh = 0; wh < 3; ++wh) {
        const int ch0 = wh * 512 + hh * 64 + sg * 16;
        const u16* cur = p.proj + (size_t)tok * ODN + 768 + ch0;
        float y[16];
        float ss = 0.f;
#pragma unroll
        for (int hf = 0; hf < 2; ++hf) {
          const bf16x8 xc = *(const bf16x8*)(cur + hf * 8);
          bf16x8 xp, xn;
#pragma unroll
          for (int e = 0; e < 8; ++e) { xp[e] = 0; xn[e] = 0; }
          if (hp) xp = *(const bf16x8*)(cur - ODN + hf * 8);
          if (hn_) xn = *(const bf16x8*)(cur + ODN + hf * 8);
#pragma unroll
          for (int e = 0; e < 8; ++e) {
            const int ch = wh * 64 + sg * 16 + hf * 8 + e;
            float v = bf2f(CW[ch]) * bf2f((u16)xp[e]) + bf2f(CW[192 + ch]) * bf2f((u16)xc[e]) + bf2f(CW[384 + ch]) * bf2f((u16)xn[e]);
            v = v / (1.f + __expf(-v));
            y[hf * 8 + e] = v; ss += v * v;
          }
        }
        ss += shx(ss, lane, 1); ss += shx(ss, lane, 2);
        const float rn = rsqrtf(ss + 1e-6f);
        if (wh == 0) {
#pragma unroll
          for (int e = 0; e < 16; ++e) Qn[c * 72 + sg * 16 + e] = f2bf(y[e] * rn * 0.125f);
        } else if (wh == 1) {
#pragma unroll
          for (int e = 0; e < 16; ++e) { const u16 kb = f2bf(y[e] * rn); Kn[c * 72 + sg * 16 + e] = kb; Kt[(sg * 16 + e) * 72 + c] = kb; }
        } else {
#pragma unroll
          for (int e = 0; e < 16; ++e) Wv[c * 65 + sg * 16 + e] = y[e];
        }
      }
    }
    }
    __syncthreads();
    {const int tid = opq(tid0), lane = tid & 63, wave = __builtin_amdgcn_readfirstlane(tid >> 6), r = lane & 31, h = lane >> 5, vh = wave & 1; (void)r; (void)h; (void)vh; (void)lane;
    if (wave < 2) {
      f32x16 akk[2], aqk[2]; zero16(akk[0]); zero16(akk[1]); zero16(aqk[0]); zero16(aqk[1]);
#pragma unroll
      for (int ks = 0; ks < 4; ++ks) {
        const bf16x8 bk = *(const bf16x8*)(Kn + (vh * 32 + r) * 72 + ks * 16 + 8 * h);
#pragma unroll
        for (int ct = 0; ct < 2; ++ct) {
          const bf16x8 ak = *(const bf16x8*)(Kn + (ct * 32 + r) * 72 + ks * 16 + 8 * h);
          const bf16x8 aq = *(const bf16x8*)(Qn + (ct * 32 + r) * 72 + ks * 16 + 8 * h);
          akk[ct] = MFMA(ak, bk, akk[ct]);
          aqk[ct] = MFMA(aq, bk, aqk[ct]);
        }
      }
      const int s = vh * 32 + r;
      const float Gss = Gs[s];
#pragma unroll
      for (int ct = 0; ct < 2; ++ct)
#pragma unroll
        for (int g4 = 0; g4 < 4; ++g4) {
          const int c0 = ct * 32 + 8 * g4 + 4 * h;
          const float4 gv4 = *(const float4*)(Gs + c0), bv4 = *(const float4*)(Bt + c0);
          float4 val;
#pragma unroll
          for (int e = 0; e < 4; ++e) {
            const int c = c0 + e;
            const float Gc = e == 0 ? gv4.x : e == 1 ? gv4.y : e == 2 ? gv4.z : gv4.w;
            const float Bc = e == 0 ? bv4.x : e == 1 ? bv4.y : e == 2 ? bv4.z : bv4.w;
            const float gam = __expf(fminf(Gc - Gss, 0.f));
            const float av = (s < c) ? akk[ct][4 * g4 + e] * Bc * gam : 0.f;
            if (e == 0) val.x = av; else if (e == 1) val.y = av; else if (e == 2) val.z = av; else val.w = av;
            AQK[c * 72 + s] = f2bf((s <= c) ? aqk[ct][4 * g4 + e] * gam : 0.f);
          }
          *(float4*)(At + s * 68 + c0) = val;
        }
    }
    }
    __syncthreads();
    {const int tid = opq(tid0), lane = tid & 63, wave = __builtin_amdgcn_readfirstlane(tid >> 6), r = lane & 31, h = lane >> 5, vh = wave & 1; (void)r; (void)h; (void)vh; (void)lane;
    if (wave < 2) {
      const bool isv = wave == 0;
      const int col = lane;
#pragma unroll 1
      for (int bi = 0; bi < 4; ++bi) {
        float acc[16];
#pragma unroll
        for (int ci = 0; ci < 16; ++ci) {
          const int c = 16 * bi + ci;
          acc[ci] = isv ? Wv[c * 65 + col] * Bt[c] : bf2f(Kn[c * 72 + col]) * Bt[c] * __expf(Gs[c]);
        }
#pragma unroll 8
        for (int s2 = 0; s2 < 16 * bi; ++s2) {
          const float xs = isv ? Wv[s2 * 65 + col] : bf2f(KC[s2 * 72 + col]);
          const float4* a4 = (const float4*)(At + s2 * 68 + 16 * bi);
#pragma unroll
          for (int q = 0; q < 4; ++q) {
            const float4 a = a4[q];
            acc[4 * q] -= a.x * xs; acc[4 * q + 1] -= a.y * xs; acc[4 * q + 2] -= a.z * xs; acc[4 * q + 3] -= a.w * xs;
          }
        }
#pragma unroll
        for (int ci = 0; ci < 16; ++ci) {
          const float x = acc[ci];
          const float* arow = At + (16 * bi + ci) * 68 + 16 * bi;
#pragma unroll
          for (int cj = ci + 1; cj < 16; ++cj) acc[cj] -= arow[cj] * x;
          if (isv) Wv[(16 * bi + ci) * 65 + col] = x; else KC[(16 * bi + ci) * 72 + col] = f2bf(x);
        }
      }
    }
    }
    __syncthreads();
    }
    if (ROLE == 1) { copy_out(smem, slots + (size_t)(step_ % RING) * SLOT_BYTES, IMG, tid0); publish(ready + step_, 1, tid0); continue; }
    {const int tid = opq(tid0), lane = tid & 63, wave = __builtin_amdgcn_readfirstlane(tid >> 6), r = lane & 31, h = lane >> 5, vh = wave & 1; (void)r; (void)h; (void)vh; (void)lane;
    if (wave < 2) {
      f32x16 kS[2], qS[2]; zero16(kS[0]); zero16(kS[1]); zero16(qS[0]); zero16(qS[1]);
#pragma unroll
      for (int dt = 0; dt < 2; ++dt) {
        const bf16x8 xs0 = packs<0>(S[dt]), xs1 = packs<1>(S[dt]);
#pragma unroll
        for (int ct = 0; ct < 2; ++ct) {
          kS[ct] = MFMA(ld2x4(KC + (ct * 32 + r) * 72 + dt * 32 + 4 * h), xs0, kS[ct]);
          kS[ct] = MFMA(ld2x4(KC + (ct * 32 + r) * 72 + dt * 32 + 16 + 4 * h), xs1, kS[ct]);
          qS[ct] = MFMA(ld2x4(Qn + (ct * 32 + r) * 72 + dt * 32 + 4 * h), xs0, qS[ct]);
          qS[ct] = MFMA(ld2x4(Qn + (ct * 32 + r) * 72 + dt * 32 + 16 + 4 * h), xs1, qS[ct]);
        }
      }
      f32x16 vn[2], o[2];
      const float Glast = Gs[63];
#pragma unroll
      for (int ct = 0; ct < 2; ++ct)
#pragma unroll
        for (int i = 0; i < 16; ++i) {
          const int c = ct * 32 + crow(i, h);
          vn[ct][i] = Wv[c * 65 + vh * 32 + r] - kS[ct][i];
          o[ct][i] = qS[ct][i] * __expf(Gs[c]);
        }
#pragma unroll
      for (int st = 0; st < 2; ++st) {
        const bf16x8 xs0 = packs<0>(vn[st]), xs1 = packs<1>(vn[st]);
#pragma unroll
        for (int ct = 0; ct < 2; ++ct) {
          o[ct] = MFMA(ld2x4(AQK + (ct * 32 + r) * 72 + st * 32 + 4 * h), xs0, o[ct]);
          o[ct] = MFMA(ld2x4(AQK + (ct * 32 + r) * 72 + st * 32 + 16 + 4 * h), xs1, o[ct]);
        }
      }
      const float dl = __expf(Glast);
#pragma unroll
      for (int st = 0; st < 2; ++st) {
        asm volatile("" ::: "memory");
#pragma unroll
        for (int i = 0; i < 16; ++i) vn[st][i] *= __expf(Glast - Gs[st * 32 + crow(i, h)]);
      }
      asm volatile("" ::: "memory");
#pragma unroll
      for (int dt = 0; dt < 2; ++dt)
#pragma unroll
        for (int i = 0; i < 16; ++i) S[dt][i] *= dl;
#pragma unroll
      for (int st = 0; st < 2; ++st) {
        const bf16x8 xs0 = packs<0>(vn[st]), xs1 = packs<1>(vn[st]);
#pragma unroll
        for (int dt = 0; dt < 2; ++dt) {
          S[dt] = MFMA(ld2x4(Kt + (dt * 32 + r) * 72 + st * 32 + 4 * h), xs0, S[dt]);
          S[dt] = MFMA(ld2x4(Kt + (dt * 32 + r) * 72 + st * 32 + 16 + 4 * h), xs1, S[dt]);
        }
      }
#pragma unroll
      for (int ct = 0; ct < 2; ++ct)
#pragma unroll
        for (int i = 0; i < 16; ++i) At[(ct * 32 + crow(i, h)) * 68 + vh * 32 + r] = o[ct][i];
    }
    }
    __syncthreads();
    {
      const int tid = opq(tid0);
      const int c = tid >> 2, sg = tid & 3;
      const int tok = tokof(cid, step, c);
      u16* dst = (dir ? p.ot1 + (size_t)tok * 512 + hh * 64 : p.hn + (size_t)tok * 1024 + 512 + hh * 64) + sg * 16;
      bf16x8 w0, w1;
#pragma unroll
      for (int e = 0; e < 8; ++e) { w0[e] = (short)f2bf(At[c * 68 + sg * 16 + e]); w1[e] = (short)f2bf(At[c * 68 + sg * 16 + 8 + e]); }
      *(bf16x8*)dst = w0; *(bf16x8*)(dst + 8) = w1;
    }
  }
  {const int tid = opq(tid0), lane = tid & 63, wave = __builtin_amdgcn_readfirstlane(tid >> 6), r = lane & 31, h = lane >> 5, vh = wave & 1; (void)r; (void)h; (void)vh; (void)lane;
  if (wave < 2 && !cid.lat) {
#pragma unroll
    for (int dt = 0; dt < 2; ++dt)
#pragma unroll
      for (int i = 0; i < 16; ++i) p.out[OFF_SD + sidx + (dt * 32 + crow(i, h)) * 64 + vh * 32 + r] = S[dt][i];
  }
}
}

DI void mixer_phase(const P* __restrict__ gp, int l, char* smem) {
  const P& p = *gp;
  const bool even = !(l & 1); const int jj = l >> 1;
  const bool teams = gridDim.x >= 512;
  if (teams) {
    const int bid = blockIdx.x;
    const int K = even ? 2 : 3;
    if (bid < 128 * (K + 1)) {
      if (bid < 128) { if (even) gla_chain<2>(gp, jj, bid, smem, 0, 1); else delta_chain<2>(gp, jj, bid, smem, 0, 1); }
      else { const int ch = (bid - 128) & 127, k = (bid - 128) >> 7; if (even) gla_chain<1>(gp, jj, ch, smem, k, K); else delta_chain<1>(gp, jj, ch, smem, k, K); }
    }
  }
  const int first = teams ? 128 : 0;
  const int total = 384 + 2048 + 256;
  int* s_item = (int*)(smem + SMEM_BYTES - 16);
  int* cntp = uni(p.cnt) + l;
  for (;;) {
    __syncthreads();
    if (opq(threadIdx.x) == 0) *s_item = atomicAdd(cntp, 1) + first;
    __syncthreads();
    const int item = __builtin_amdgcn_readfirstlane(*s_item);
    if (item >= total) break;
    if (item < 384) { if (even) gla_chain<0>(gp, jj, item, smem, 0, 1); else delta_chain<0>(gp, jj, item, smem, 0, 1); }
    else if (item < 384 + 2048) { if (even) attn_item<1>(gp, jj, item - 384, smem); else attn_item<3>(gp, jj, item - 384, smem); }
    else { if (even) attn_item<0>(gp, jj, item - 384 - 2048, smem); else attn_item<2>(gp, jj, item - 384 - 2048, smem); }
  }
}

DI void finalize_phase(const P* __restrict__ gp, int l) {
  const P& p = *gp;
  const bool even = !(l & 1); const int jj = l >> 1;
  int tid_ = threadIdx.x; asm volatile("" : "+v"(tid_)); const int tid = tid_;
  const int tk = tid >> 5, hh = (tid >> 2) & 7, sg = tid & 3;
  const int PS = even ? EVN : ODN; const int zcol = even ? 3104 : 2336;
  for (int item = blockIdx.x; item < NT_ / 8; item += gridDim.x) {
    const size_t tok = (size_t)item * 8 + tk;
    u16* a = p.hn + tok * 1024 + 512 + hh * 64 + sg * 16;
    const u16* bsrc = p.ot1 + tok * 512 + hh * 64 + sg * 16;
    const u16* zs = p.proj + tok * PS + zcol + hh * 64 + sg * 16;
    float o[16]; float ss = 0.f;
#pragma unroll
    for (int hf = 0; hf < 2; ++hf) {
      const bf16x8 x0 = *(const bf16x8*)(a + hf * 8), x1 = *(const bf16x8*)(bsrc + hf * 8);
#pragma unroll
      for (int e = 0; e < 8; ++e) { const float v = bf2f((u16)x0[e]) + bf2f((u16)x1[e]); o[hf * 8 + e] = v; ss += v * v; }
    }
    ss += shx(ss, tid & 63, 1); ss += shx(ss, tid & 63, 2);
    const float rstd = rsqrtf(ss * (1.f / 64.f) + 1e-6f);
    const float* ng = even ? p.b_norm_g + jj * 512 + hh * 64 + sg * 16 : p.d_norm_g + jj * 64 + sg * 16;
#pragma unroll
    for (int hf = 0; hf < 2; ++hf) {
      const bf16x8 z = *(const bf16x8*)(zs + hf * 8);
      bf16x8 w;
#pragma unroll
      for (int e = 0; e < 8; ++e) { const float zz = bf2f((u16)z[e]); w[e] = (short)f2bf(o[hf * 8 + e] * rstd * ng[hf * 8 + e] * siluf(zz)); }
      *(bf16x8*)(a + hf * 8) = w;
    }
  }
}


#define XB_TMO      128
#define XB_XCNT(j)  (256  + 64 * (j))
#define XB_XSUB(j)  (1280 + 64 * (j))
#define XB_XGEN(j)  (2304 + 64 * (j))
#define XB_TOP      3328
#define XB_TOPGEN   3392
#define XCD_BAR_WORDS 3456
#define XB_SPIN_CAP (1u << 18)
#define LAS __attribute__((address_space(3)))
DI unsigned xb_ld(unsigned* q)              { return __hip_atomic_load(q, __ATOMIC_RELAXED, __HIP_MEMORY_SCOPE_AGENT); }
DI unsigned xb_add(unsigned* q, unsigned v) { return __hip_atomic_fetch_add(q, v, __ATOMIC_RELAXED, __HIP_MEMORY_SCOPE_AGENT); }
DI unsigned xb_xcc_id() { return (unsigned)__builtin_amdgcn_s_getreg((3 << 11) | 20) & 0xFu; }
#define XB_SPIN(cond, bar) do { unsigned _sp = 0; while (cond) { __builtin_amdgcn_s_sleep(1); \
    if ((++_sp & 255u) == 0u) { if (xb_ld(&(bar)[XB_TMO])) break; if (_sp > XB_SPIN_CAP) { atomicAdd(&(bar)[XB_TMO], 1u); break; } } } } while (0)
struct XcdBarrier { unsigned* bar; unsigned x; volatile LAS unsigned* st; };
DI XcdBarrier xcd_barrier_post(unsigned* bar, volatile LAS unsigned* st) {
  XcdBarrier b; b.bar = bar; b.x = xb_xcc_id(); b.st = st;
  if (threadIdx.x == 0) (void)xb_add(&bar[XB_XCNT(b.x)], 1u);
  return b;
}
DI void xcd_barrier_complete(unsigned* bar, unsigned x, unsigned& nloc, unsigned& nx) {
  const unsigned G = gridDim.x * gridDim.y * gridDim.z;
  unsigned sum, cnt, mine, sp = 0u;
  for (;;) {
    sum = 0u; cnt = 0u; mine = 0u;
#pragma unroll
    for (unsigned j = 0; j < 16; ++j) { const unsigned c = xb_ld(&bar[XB_XCNT(j)]); sum += c; cnt += (c > 0u) ? 1u : 0u; mine = (j == x) ? c : mine; }
    if (sum == G) break;
    __builtin_amdgcn_s_sleep(1);
    if ((++sp & 255u) == 0u) { if (xb_ld(&bar[XB_TMO])) break; if (sp > XB_SPIN_CAP) { atomicAdd(&bar[XB_TMO], 1u); break; } }
  }
  nloc = mine > 0u ? mine : 1u; nx = cnt > 0u ? cnt : 1u;
}
DI void xcd_barrier(const XcdBarrier& b) {
  asm volatile("s_waitcnt vmcnt(0)" ::: "memory");
  __syncthreads();
  if (threadIdx.x == 0) {
    unsigned* bar = b.bar;
    __builtin_amdgcn_s_waitcnt(0);
    unsigned nloc = b.st[0], nx = b.st[1];
    if (nloc == 0u) { xcd_barrier_complete(bar, b.x, nloc, nx); b.st[0] = nloc; b.st[1] = nx; }
    const unsigned old = xb_add(&bar[XB_XSUB(b.x)], 1u);
    const unsigned gen = old / nloc;
    if (old + 1u == (gen + 1u) * nloc) {
      __builtin_amdgcn_fence(__ATOMIC_RELEASE, "agent");
      asm volatile("s_waitcnt vmcnt(0)" ::: "memory");
      const unsigned og = xb_add(&bar[XB_TOP], 1u);
      const unsigned tg = og / nx;
      if (og + 1u == (tg + 1u) * nx) xb_add(&bar[XB_TOPGEN], 1u);
      else XB_SPIN(xb_ld(&bar[XB_TOPGEN]) == tg, bar);
      __builtin_amdgcn_fence(__ATOMIC_ACQUIRE, "agent");
      xb_add(&bar[XB_XGEN(b.x)], 1u);
      asm volatile("s_waitcnt vmcnt(0)" ::: "memory");
    } else {
      XB_SPIN(xb_ld(&bar[XB_XGEN(b.x)]) == gen, bar);
      __builtin_amdgcn_fence(__ATOMIC_ACQUIRE, "agent");
      asm volatile("s_waitcnt vmcnt(0)" ::: "memory");
    }
  }
  __syncthreads();
}

DI void run_phase(const P* __restrict__ gp, int ph, char* smem) {
  const P& p = *gp;
  if (ph == 0) { prep_phase(gp, smem); return; }
  if (ph == NPH - 1) { norm_phase(gp, 0, 0, false, true); return; }
  const int l = (ph - 1) >> 3, s = (ph - 1) & 7;
  const bool even = !(l & 1);
  const u16* W = uni(p.wt) + (size_t)l * LW;
  const u16* hnp = uni(p.hn); const u16* projp = uni(p.proj);
  switch (s) {
    case 0: norm_phase(gp, l, 0, l == 0, false); break;
    case 1: gemm_phase<EPI_PROJ>(gp, l, smem, hnp, 1024, W + WO_IN, 1024, 1024, 288, even ? 29 : 23, 0); break;
    case 2: mixer_phase(gp, l, smem); break;
    case 3: finalize_phase(gp, l); break;
    case 4: gemm_phase<EPI_RES>(gp, l, smem, hnp, 1024, W + WO_OUT, 1024, 1024, 288, 8, 2); break;
    case 5: norm_phase(gp, l, 1, false, false); break;
    case 6: gemm_phase<EPI_FFN>(gp, l, smem, hnp, 1024, W + WO_UP, 1024, 1024, 312, 44, 0); break;
    case 7: gemm_phase<EPI_RES>(gp, l, smem, projp, 2816, W + WO_DN, 2816, 2816, 288, 8, 5); break;
  }
}

__global__ void __launch_bounds__(256, 2) mk(P p, P* gpmem, int ph0, int ph1) {
  __shared__ __attribute__((aligned(16))) char smem[SMEM_BYTES];
  const P* gp = &p;
  if (ph1 - ph0 > 1) {
    cg::grid_group grid = cg::this_grid();
    volatile LAS unsigned* xst = (volatile LAS unsigned*)(smem + SMEM_BYTES - 32);
    if (threadIdx.x == 0) { xst[0] = 0u; xst[1] = 0u; }
    __syncthreads();
    const XcdBarrier xbar = xcd_barrier_post(p.bar, xst);
    for (int ph = ph0; ph < ph1; ++ph) {
      run_phase(gp, ph, smem);
      if (ph + 1 < ph1) { if (ph == ph0) grid.sync(); else xcd_barrier(xbar); }
    }
  } else {
    run_phase(gp, ph0, smem);
  }
}

extern "C" void kernel_launch(void* const* d_in, const int* in_sizes, int n_in, void* d_out, int out_size, void* d_ws, size_t ws_size,
                              hipStream_t stream) {
  P p{};
  const float** f = (const float**)&p;
  for (int i = 0; i < 31; ++i) f[i] = (const float*)d_in[i];
  p.out = (float*)d_out;
  char* ws = (char*)d_ws;
  size_t off = 0;
  p.hn = (u16*)(ws + off); off += (size_t)NT_ * 1024 * 2;
  p.proj = (u16*)(ws + off); off += (size_t)NT_ * EVN * 2;
  p.ot1 = (u16*)(ws + off); off += (size_t)NT_ * 512 * 2;
  p.wt = (u16*)(ws + off); off += 4 * LW * 2;
  p.mods = (float*)(ws + off); off += 4 * 9 * 6144 * 4;
  p.rope = (float*)(ws + off); off += 64 * 16 * 2 * 4;
  P* gp = (P*)(ws + off); off += 4096;
  p.cnt = (int*)(ws + off); off += 256;
  p.flags = (int*)(ws + off); off += 4 * 8320 * 4;
  off = (off + 255) & ~(size_t)255;
  p.ring = ws + off; off += (size_t)128 * RING * SLOT_BYTES;
  p.bar = (unsigned*)(ws + off); off += XCD_BAR_WORDS * 4;
  static int grid_blocks = 0;
  if (!grid_blocks) {
    int dev = 0, cus = 0, per_cu = 0;
    hipGetDevice(&dev);
    hipDeviceGetAttribute(&cus, hipDeviceAttributeMultiprocessorCount, dev);
    hipOccupancyMaxActiveBlocksPerMultiprocessor(&per_cu, mk, 256, 0);
    if (per_cu < 1) per_cu = 1;
    if (per_cu > 2) per_cu = 2;
    grid_blocks = cus * per_cu;
  }
#if MK_MULTI
  for (int ph = 0; ph < NPH; ++ph) {
    int a = ph, b = ph + 1;
    hipLaunchKernelGGL(mk, dim3(grid_blocks), dim3(256), 0, stream, p, gp, a, b);
  }
#else
  hipMemsetAsync(p.bar, 0, XCD_BAR_WORDS * 4, stream);
  int ph0 = 0, ph1 = NPH;
  void* args[] = {&p, &gp, &ph0, &ph1};
  hipError_t e = hipLaunchCooperativeKernel((void*)mk, dim3(grid_blocks), dim3(256), args, 0, stream);
  if (e != hipSuccess) fprintf(stderr, "cooperative launch failed: %s (grid %d)\n", hipGetErrorString(e), grid_blocks);
#endif
}
```

```cpp
#include <hip/hip_runtime.h>
#include <hip/hip_cooperative_groups.h>
#include <cstdio>
namespace cg = cooperative_groups;

#ifndef MK_MULTI
#define MK_MULTI 0
#endif

#define DI __device__ __forceinline__
#define DN __device__ __noinline__
typedef unsigned short u16;
typedef __attribute__((ext_vector_type(8))) short bf16x8;
typedef __attribute__((ext_vector_type(4))) short s16x4;
typedef __attribute__((ext_vector_type(16))) float f32x16;
#define MFMA(a, b, c) __builtin_amdgcn_mfma_f32_32x32x16_bf16((a), (b), (c), 0, 0, 0)

static constexpr int NP_ = 4096, NT_ = 36864;
static constexpr int EVN = 3616, ODN = 2848;
static constexpr size_t OFF_AK = 37748736, OFF_AV = 41943040, OFF_SB = 46137344, OFF_CK = 48234496, OFF_CV = 49283072, OFF_SD = 50331648;
static constexpr size_t LW = 13500416, WO_UP = 0, WO_DN = 5767168, WO_IN = 8650752, WO_OUT = 12451840;
static constexpr int NPH = 34;
static constexpr int SMEM_BYTES = 80 * 1024;

struct P {
  const float *x_prompt, *x_sample, *cache_a_k, *cache_a_v, *state_b, *cache_c_k, *cache_c_v, *state_d, *c, *c_ctx, *ada_w, *ada_b,
      *norm1_g, *norm2_g, *ffn_up, *ffn_conv, *ffn_down, *ev_w_in, *ev_w_out, *a_rpb, *b_w_g2, *b_b_g, *b_norm_g, *od_w_in, *od_w_out,
      *c_sink, *d_conv, *d_a_log, *d_dt_bias, *d_norm_g, *final_g;
  float* out;
  u16 *hn, *proj, *ot1, *wt;
  float *mods, *rope;
  int* cnt;
  int* flags;
  char* ring;
  unsigned* bar;
};

DI u16 f2bf(float x) { unsigned u = __float_as_uint(x); u += 0x7fffu + ((u >> 16) & 1u); return (u16)(u >> 16); }
DI float bf2f(u16 b) { return __uint_as_float(((unsigned)b) << 16); }
DI int crow(int i, int h) { return (i & 3) + 8 * (i >> 2) + 4 * h; }
template <int S> DI bf16x8 packs(const f32x16& x) {
  bf16x8 v;
#pragma unroll
  for (int j = 0; j < 8; ++j) v[j] = (short)f2bf(x[8 * S + j]);
  return v;
}
DI bf16x8 ld2x4(const u16* p) {
  s16x4 lo = *(const s16x4*)p, hi = *(const s16x4*)(p + 8);
  return __builtin_shufflevector(lo, hi, 0, 1, 2, 3, 4, 5, 6, 7);
}
DI float siluf(float x) { return x / (1.f + __expf(-x)); }
DI int opq(int x) { asm volatile("" : "+v"(x)); return x; }
DI float shx(float v, int lane, int o) { return __int_as_float(__builtin_amdgcn_ds_bpermute((lane ^ o) << 2, __float_as_int(v))); }
template <class T> DI T* uni(T* q) { return q; }
DI void zero16(f32x16& a) {
#pragma unroll
  for (int i = 0; i < 16; ++i) a[i] = 0.f;
}

DI void prep_phase(const P* __restrict__ gp, char* smem) {
  const P& p = *gp;
  int tid_ = threadIdx.x; asm volatile("" : "+v"(tid_)); const int tid = tid_;
  const int NWT = 4 * (1408 + 704 + 256) + 2 * (928 + 736);
  const int NADA = 384;
  const int total = NWT + NADA + 1;
  for (int item = blockIdx.x; item < total; item += gridDim.x) {
    if (item < NWT) {
      int rem = item; const float* src = nullptr; u16* dst = nullptr; int K = 0, N = 0, NPd = 0;
      for (int l = 0; l < 4; ++l) {
        const int jj = l >> 1; const bool ev = !(l & 1);
        const int nin = ev ? 928 : 736;
        if (rem < 1408) { src = p.ffn_up + (size_t)l * 1024 * 5632; dst = p.wt + l * LW + WO_UP; K = 1024; N = 5632; NPd = 5632; break; }
        rem -= 1408;
        if (rem < 704) { src = p.ffn_down + (size_t)l * 2816 * 1024; dst = p.wt + l * LW + WO_DN; K = 2816; N = 1024; NPd = 1024; break; }
        rem -= 704;
        if (rem < nin) { src = ev ? p.ev_w_in + (size_t)jj * 1024 * EVN : p.od_w_in + (size_t)jj * 1024 * ODN; dst = p.wt + l * LW + WO_IN; K = 1024; N = ev ? EVN : ODN; NPd = ev ? 3712 : 2944; break; }
        rem -= nin;
        if (rem < 256) { src = (ev ? p.ev_w_out : p.od_w_out) + (size_t)jj * 1024 * 1024; dst = p.wt + l * LW + WO_OUT; K = 1024; N = 1024; NPd = 1024; break; }
        rem -= 256;
      }
      const int ntn = NPd >> 6;
      const int tk = rem / ntn, tn = rem - tk * ntn;
      const int scol0 = (N == 5632) ? ((tn & 1) * 2816 + (tn >> 1) * 64) : tn * 64;
      float* T = (float*)smem;
      __syncthreads();
#pragma unroll
      for (int i = 0; i < 16; ++i) {
        const int k = i * 4 + (tid >> 6), n = tid & 63;
        const int gn = scol0 + n;
        T[k * 65 + n] = (gn < N) ? src[(size_t)(tk * 64 + k) * N + gn] : 0.f;
      }
      __syncthreads();
#pragma unroll
      for (int i = 0; i < 2; ++i) {
        const int q = tid + 256 * i; const int n = q & 63, kc = q >> 6;
        const int pn = tn * 64 + n; const int nt32 = pn >> 5, rr = pn & 31;
        const int kstep = tk * 4 + (kc >> 1), hh = kc & 1;
        bf16x8 w;
#pragma unroll
        for (int j = 0; j < 8; ++j) w[j] = (short)f2bf(T[(kc * 8 + j) * 65 + n]);
        *(bf16x8*)(dst + ((size_t)(nt32 * (K >> 4) + kstep) * 64 + hh * 32 + rr) * 8) = w;
      }
    } else if (item < NWT + NADA) {
      const int it = item - NWT; const int l = it / 96, cgp = it - l * 96; const int n0 = cgp * 64;
      float* sc = (float*)smem;
      float* red = sc + 9 * 1024;
      __syncthreads();
      for (int idx = tid; idx < 9 * 1024; idx += 256) {
        const int ci = idx >> 10, k = idx & 1023;
        const float x = ci < 8 ? p.c[ci * 1024 + k] : p.c_ctx[k];
        sc[idx] = x / (1.f + expf(-x));
      }
      __syncthreads();
      const int wave = tid >> 6, lane = tid & 63;
      float acc[9];
#pragma unroll
      for (int ci = 0; ci < 9; ++ci) acc[ci] = 0.f;
      const float* wp = p.ada_w + ((size_t)l * 1024 + wave * 256) * 6144 + n0 + lane;
#pragma unroll 8
      for (int k = 0; k < 256; ++k) {
        const float wv = wp[(size_t)k * 6144];
#pragma unroll
        for (int ci = 0; ci < 9; ++ci) acc[ci] += sc[ci * 1024 + wave * 256 + k] * wv;
      }
#pragma unroll
      for (int ci = 0; ci < 9; ++ci) red[(wave * 9 + ci) * 64 + lane] = acc[ci];
      __syncthreads();
      for (int idx = tid; idx < 576; idx += 256) {
        const int ci = idx >> 6, col = idx & 63;
        const float s = red[(0 * 9 + ci) * 64 + col] + red[(1 * 9 + ci) * 64 + col] + red[(2 * 9 + ci) * 64 + col] + red[(3 * 9 + ci) * 64 + col];
        p.mods[(size_t)(l * 9 + ci) * 6144 + n0 + col] = s + p.ada_b[l * 6144 + n0 + col];
      }
    } else {
      if (tid < 8) p.cnt[tid] = 0;
      for (int i = tid; i < 8 * 8320; i += 256) p.flags[i] = 0;
      for (int idx = tid; idx < 1024; idx += 256) {
        const int pos = idx >> 4, fi = idx & 15;
        const float inv = powf(10000.f, -(float)fi / 16.f);
        const float ang = (float)pos * inv;
        p.rope[idx * 2] = cosf(ang); p.rope[idx * 2 + 1] = sinf(ang);
      }
    }
  }
}

DI void norm_phase(const P* __restrict__ gp, int l, int which, bool first, bool fin) {
  const P& p = *gp;
  int tid_ = threadIdx.x; asm volatile("" : "+v"(tid_)); const int tid = tid_, lane = tid & 63, wave = tid >> 6;
  for (int item = blockIdx.x; item < NT_ / 4; item += gridDim.x) {
    const int tok = item * 4 + wave;
    const float* src = first ? (tok < NP_ ? p.x_prompt + (size_t)tok * 1024 : p.x_sample + (size_t)(tok - NP_) * 1024) : p.out + (size_t)tok * 1024;
    float4 v[4];
    float ss = 0.f;
#pragma unroll
    for (int i = 0; i < 4; ++i) { v[i] = ((const float4*)src)[lane + 64 * i]; ss += v[i].x * v[i].x + v[i].y * v[i].y + v[i].z * v[i].z + v[i].w * v[i].w; }
#pragma unroll
    for (int o = 32; o >= 1; o >>= 1) ss += shx(ss, lane, o);
    const float rstd = rsqrtf(ss * (1.f / 1024.f) + 1e-6f);
    if (fin) {
#pragma unroll
      for (int i = 0; i < 4; ++i) {
        const float4 g = ((const float4*)p.final_g)[lane + 64 * i];
        float4 y; y.x = v[i].x * rstd * g.x; y.y = v[i].y * rstd * g.y; y.z = v[i].z * rstd * g.z; y.w = v[i].w * rstd * g.w;
        ((float4*)(p.out + (size_t)tok * 1024))[lane + 64 * i] = y;
      }
    } else {
      const int ci = tok < NP_ ? 8 : (tok - NP_) >> 12;
      const float* md = p.mods + (size_t)(l * 9 + ci) * 6144 + which * 3072;
      const float* gp = (which ? p.norm2_g : p.norm1_g) + l * 1024;
#pragma unroll
      for (int i = 0; i < 4; ++i) {
        const float4 g = ((const float4*)gp)[lane + 64 * i];
        const float4 sh = ((const float4*)md)[lane + 64 * i];
        const float4 sc = ((const float4*)(md + 1024))[lane + 64 * i];
        ushort4 o;
        o.x = f2bf(v[i].x * rstd * g.x * (1.f + sc.x) + sh.x);
        o.y = f2bf(v[i].y * rstd * g.y * (1.f + sc.y) + sh.y);
        o.z = f2bf(v[i].z * rstd * g.z * (1.f + sc.z) + sh.z);
        o.w = f2bf(v[i].w * rstd * g.w * (1.f + sc.w) + sh.w);
        ((ushort4*)(p.hn + (size_t)tok * 1024))[lane + 64 * i] = o;
        if (first) ((float4*)(p.out + (size_t)tok * 1024))[lane + 64 * i] = v[i];
      }
    }
  }
}

DI uint4 ldsel(const u16* pv, const u16* safe, unsigned ok) {
  uint4 t = *(const uint4*)(ok ? pv : safe);
  if (!ok) { t.x = 0; t.y = 0; t.z = 0; t.w = 0; }
  return t;
}
enum { EPI_PROJ = 0, EPI_RES = 1, EPI_FFN = 2 };

template <int EPI>
DI void gemm_phase(const P* __restrict__ gp, int l, char* smem, const u16* __restrict__ A, int lda, const u16* __restrict__ B, int ldb, int K, int MT,
                   int NTn, int gsel) {
  const P& p = *gp;
  u16* As = (u16*)smem;
  int tid_ = threadIdx.x; asm volatile("" : "+v"(tid_)); const int tid = tid_, lane = tid & 63, wave = tid >> 6, r = lane & 31, h = lane >> 5;
  const int wm = wave & 1, wn = wave >> 1;
  const int KT = K >> 6;
  const bool even = !(l & 1); const int jj = l >> 1;
  const int ntiles = MT * NTn;
  const int nlb = gridDim.x >> 3, xcd = blockIdx.x & 7, lb = blockIdx.x >> 3;
  for (int it = 0;; ++it) {
    const int g = (it * 8 + xcd) * nlb + lb;
    if (g >= ntiles) break;
    const int SM = nlb >> 3;
    const int band = g / (SM * NTn); const int rem = g - band * SM * NTn;
    const int nt = rem / SM, mt = band * SM + (rem - nt * SM);
    int seqbase = 0, L = 0, tin0 = 0;
    if (EPI == EPI_FFN) {
      if (mt < 48) { const int sq = mt / 3; L = 256; seqbase = sq * 256; tin0 = (mt - sq * 3) * 126; }
      else { const int m2 = mt - 48; const int sq = m2 / 33; L = 4096; seqbase = NP_ + sq * 4096; tin0 = (m2 - sq * 33) * 126; }
    }
    const int row0 = tid >> 3, kc0 = (tid & 7) * 8;
    const long arow0 = (EPI == EPI_FFN) ? (long)seqbase + tin0 - 1 + row0 : (long)mt * 128 + row0;
    const u16* abase = A + arow0 * lda + kc0;
    unsigned avalid = 0;
#pragma unroll
    for (int i = 0; i < 4; ++i) {
      if (EPI == EPI_FFN) { const int ts = tin0 - 1 + row0 + 32 * i; if (ts >= 0 && ts < L) avalid |= 1u << i; }
      else avalid |= 1u << i;
    }
    const u16* bb0 = B + ((size_t)((nt * 4 + wn * 2) * (K >> 4)) * 64 + lane) * 8;
    const size_t bts = (size_t)(K >> 4) * 512;
    f32x16 acc[2][2];
#pragma unroll
    for (int a = 0; a < 2; ++a)
#pragma unroll
      for (int b = 0; b < 2; ++b) zero16(acc[a][b]);
#define GLD_A(i, ko) ldsel(abase + (size_t)(32 * (i)) * lda + (ko), A, (avalid >> (i)) & 1u)
#define GLD_BF(dst, kt_) { const u16* q_ = bb0 + (size_t)(kt_) * 2048; \
      dst[0][0] = *(const bf16x8*)(q_); dst[0][1] = *(const bf16x8*)(q_ + 512); dst[0][2] = *(const bf16x8*)(q_ + 1024); dst[0][3] = *(const bf16x8*)(q_ + 1536); \
      dst[1][0] = *(const bf16x8*)(q_ + bts); dst[1][1] = *(const bf16x8*)(q_ + bts + 512); dst[1][2] = *(const bf16x8*)(q_ + bts + 1024); dst[1][3] = *(const bf16x8*)(q_ + bts + 1536); }
    uint4 ra0 = GLD_A(0, 0), ra1 = GLD_A(1, 0), ra2 = GLD_A(2, 0), ra3 = GLD_A(3, 0);
    uint4 sa0 = GLD_A(0, 64), sa1 = GLD_A(1, 64), sa2 = GLD_A(2, 64), sa3 = GLD_A(3, 64);
    bf16x8 bc[2][4], bn[2][4];
    GLD_BF(bc, 0);
    GLD_BF(bn, 1);
#define LSTORE(buf, A0, A1, A2, A3) { \
      u16* ad = As + (buf) * 9216 + row0 * 72 + kc0; \
      *(uint4*)(ad) = A0; *(uint4*)(ad + 32 * 72) = A1; *(uint4*)(ad + 64 * 72) = A2; *(uint4*)(ad + 96 * 72) = A3; }
#define COMPUTE(buf, BF, KN) { \
      const u16* Ab = As + (buf) * 9216; \
      const bool more_ = (KN) < KT; const u16* q_ = bb0 + (size_t)(KN) * 2048; \
      _Pragma("unroll") for (int ks = 0; ks < 4; ++ks) { \
        const bf16x8 a0 = *(const bf16x8*)(Ab + (wm * 64 + r) * 72 + ks * 16 + h * 8); \
        const bf16x8 a1 = *(const bf16x8*)(Ab + (wm * 64 + 32 + r) * 72 + ks * 16 + h * 8); \
        acc[0][0] = MFMA(a0, BF[0][ks], acc[0][0]); acc[0][1] = MFMA(a0, BF[1][ks], acc[0][1]); \
        acc[1][0] = MFMA(a1, BF[0][ks], acc[1][0]); acc[1][1] = MFMA(a1, BF[1][ks], acc[1][1]); \
        if (more_) { BF[0][ks] = *(const bf16x8*)(q_ + ks * 512); BF[1][ks] = *(const bf16x8*)(q_ + bts + ks * 512); } } }
    LSTORE(0, ra0, ra1, ra2, ra3);
    ra0 = GLD_A(0, 128); ra1 = GLD_A(1, 128); ra2 = GLD_A(2, 128); ra3 = GLD_A(3, 128);
    __syncthreads();
    for (int kt = 0; kt < KT; kt += 2) {
      COMPUTE(0, bc, kt + 2);
      LSTORE(1, sa0, sa1, sa2, sa3);
      if (kt + 3 < KT) {
        const int ko = (kt + 3) * 64;
        sa0 = GLD_A(0, ko); sa1 = GLD_A(1, ko); sa2 = GLD_A(2, ko); sa3 = GLD_A(3, ko);
      }
      __syncthreads();
      COMPUTE(1, bn, kt + 3);
      if (kt + 2 < KT) {
        LSTORE(0, ra0, ra1, ra2, ra3);
        if (kt + 4 < KT) {
          const int ko = (kt + 4) * 64;
          ra0 = GLD_A(0, ko); ra1 = GLD_A(1, ko); ra2 = GLD_A(2, ko); ra3 = GLD_A(3, ko);
        }
      }
      __syncthreads();
    }
    if (EPI == EPI_PROJ) {
      const int N = even ? EVN : ODN;
#pragma unroll
      for (int tm = 0; tm < 2; ++tm)
#pragma unroll
        for (int tn = 0; tn < 2; ++tn) {
          const int col = nt * 128 + wn * 64 + tn * 32 + r;
          if (col < N) {
#pragma unroll
            for (int i = 0; i < 16; ++i) {
              const int row = mt * 128 + wm * 64 + tm * 32 + crow(i, h);
              const float v = acc[tm][tn][i];
              p.proj[(size_t)row * N + col] = f2bf(v);
              if (row < NP_) {
                const int b = row >> 8, t = row & 255, d = col & 63;
                if (even) {
                  if (col >= 512 && col < 1536) {
                    const int wh = (col - 512) >> 9, hh = ((col - 512) >> 6) & 7;
                    p.out[(wh ? OFF_AV : OFF_AK) + ((size_t)(((b * 2 + jj) * 8 + hh) * 256 + t)) * 64 + d] = v;
                  }
                } else {
                  if (col >= 512 && col < 768) {
                    const int wh = (col - 512) >> 7, kv = ((col - 512) >> 6) & 1;
                    p.out[(wh ? OFF_CV : OFF_CK) + ((size_t)(((b * 2 + jj) * 2 + kv) * 256 + t)) * 64 + d] = v;
                  }
                }
              }
            }
          }
        }
    } else if (EPI == EPI_RES) {
#pragma unroll
      for (int tm = 0; tm < 2; ++tm)
#pragma unroll
        for (int tn = 0; tn < 2; ++tn) {
          const int col = nt * 128 + wn * 64 + tn * 32 + r;
#pragma unroll
          for (int i = 0; i < 16; ++i) {
            const int row = mt * 128 + wm * 64 + tm * 32 + crow(i, h);
            const int ci = row < NP_ ? 8 : (row - NP_) >> 12;
            const float g = p.mods[(size_t)(l * 9 + ci) * 6144 + gsel * 1024 + col];
            float* xp = p.out + (size_t)row * 1024 + col;
            *xp = *xp + g * acc[tm][tn][i];
          }
        }
    } else {
      __syncthreads();
      float* U = (float*)smem;
#pragma unroll
      for (int tm = 0; tm < 2; ++tm)
#pragma unroll
        for (int tn = 0; tn < 2; ++tn)
#pragma unroll
          for (int i = 0; i < 16; ++i) U[(wm * 64 + tm * 32 + crow(i, h)) * 132 + wn * 64 + tn * 32 + r] = acc[tm][tn][i];
      __syncthreads();
      const float* cw = p.ffn_conv + (size_t)l * 3 * 5632;
      const int f = tid & 63, rg = tid >> 6; const int fg = nt * 64 + f;
      const float wa0 = cw[fg], wa1 = cw[5632 + fg], wa2 = cw[2 * 5632 + fg];
      const float wg0 = cw[2816 + fg], wg1 = cw[5632 + 2816 + fg], wg2 = cw[2 * 5632 + 2816 + fg];
      u16* act = p.proj;
      {
        const int rbeg = 1 + 32 * rg, rend = rg == 3 ? 126 : 32 * rg + 32;
        float ap = U[(rbeg - 1) * 132 + f], ac = U[rbeg * 132 + f];
        float gp_ = U[(rbeg - 1) * 132 + 64 + f], gc = U[rbeg * 132 + 64 + f];
        for (int rr = rbeg; rr <= rend; ++rr) {
          const int ts = tin0 - 1 + rr;
          if (ts >= L) break;
          const float an = U[(rr + 1) * 132 + f], gn = U[(rr + 1) * 132 + 64 + f];
          const float a = wa0 * ap + wa1 * ac + wa2 * an;
          const float g = wg0 * gp_ + wg1 * gc + wg2 * gn;
          act[(size_t)(seqbase + ts) * 2816 + fg] = f2bf(a * siluf(g));
          ap = ac; ac = an; gp_ = gc; gc = gn;
        }
      }
      __syncthreads();
    }
  }
}

template <int MODE>
DI void attn_item(const P* __restrict__ gp, int jj, int it, char* smem) {
  const P& p = *gp;
  const u16* projp = uni(p.proj); u16* hnp = uni(p.hn); const float* ropep = uni(p.rope);
  u16* Ks = (u16*)smem; u16* Vt = Ks + 64 * 72; float* rpb_s = (float*)(Vt + 64 * 72);
  int tid_ = threadIdx.x; asm volatile("" : "+v"(tid_)); const int tid = tid_, lane = tid & 63, wave = tid >> 6, r = lane & 31, h = lane >> 5;
  constexpr bool EVENL = (MODE == 0 || MODE == 1);
  constexpr bool LAT = (MODE == 1 || MODE == 3);
  constexpr int PS = EVENL ? EVN : ODN;
  int b, hq, qb, tokbase;
  if (!LAT) { b = it >> 4; hq = (it >> 1) & 7; qb = it & 1; tokbase = b * 256; }
  else { b = it >> 8; hq = (it >> 5) & 7; qb = it & 31; tokbase = NP_ + b * 4096; }
  const int hk = EVENL ? hq : (hq >> 2);
  const int kcol = 512 + hk * 64, vcol = (EVENL ? 1024 : 640) + hk * 64, qcol = hq * 64;
  const int tq = qb * 128 + wave * 32 + r;
  const size_t qtok = (size_t)tokbase + tq;
  __syncthreads();
  if (MODE == 1) { for (int i = tid; i < 465; i += 256) rpb_s[i] = p.a_rpb[(size_t)(jj * 8 + hq) * 465 + i]; }
  bf16x8 qf[4];
#pragma unroll
  for (int s = 0; s < 4; ++s) qf[s] = *(const bf16x8*)(projp + qtok * PS + qcol + 16 * s + 8 * h);
  if (MODE == 3) {
    const int prow = tq >> 6, pcol = tq & 63;
#pragma unroll
    for (int half = 0; half < 2; ++half) {
      const int pos = half ? pcol : prow;
#pragma unroll
      for (int j = 0; j < 8; ++j) {
        const float cs = ropep[(pos * 16 + 8 * h + j) * 2], sn = ropep[(pos * 16 + 8 * h + j) * 2 + 1];
        const float x1 = bf2f((u16)qf[2 * half][j]), x2 = bf2f((u16)qf[2 * half + 1][j]);
        qf[2 * half][j] = (short)f2bf(x1 * cs - x2 * sn);
        qf[2 * half + 1][j] = (short)f2bf(x1 * sn + x2 * cs);
      }
    }
  }
  float m_run = -1e30f, l_run = 0.f;
  if (MODE == 2 || MODE == 3) { m_run = p.c_sink[jj * 8 + hq]; l_run = h == 0 ? 1.f : 0.f; }
  f32x16 ot[2]; zero16(ot[0]); zero16(ot[1]);
  int loc0 = 0, nloc = 0;
  if (MODE == 1) {
    const int qi0 = 2 * qb;
    const int rlo = min(max(qi0 - 4, 0), 56), rhi = min(max(qi0 + 1 - 4, 0), 56) + 7;
    loc0 = rlo; nloc = rhi - rlo + 1;
  } else if (MODE == 3) {
    loc0 = max(0, 2 * qb - 2); nloc = min(63, 2 * qb + 3) - loc0 + 1;
  }
  const int qi = tq >> 6, qw = tq & 63;
  const int r0w = min(max(qi - 4, 0), 56), c0w = min(max(qw - 8, 0), 48);
  const int key = tid >> 2, seg = tid & 3;
  for (int kb = 0; kb < 4 + nloc; ++kb) {
    const bool isctx = kb < 4;
    const int blk = isctx ? kb : loc0 + kb - 4;
    __syncthreads();
    {
      float kf[16], vf[16];
      if (LAT && isctx) {
        const float* kc = (MODE == 1) ? p.cache_a_k + ((size_t)((b * 2 + jj) * 8 + hk)) * 16384 : p.cache_c_k + ((size_t)((b * 2 + jj) * 2 + hk)) * 16384;
        const float* vc = (MODE == 1) ? p.cache_a_v + ((size_t)((b * 2 + jj) * 8 + hk)) * 16384 : p.cache_c_v + ((size_t)((b * 2 + jj) * 2 + hk)) * 16384;
        const float4* kp4 = (const float4*)(kc + (size_t)(blk * 64 + key) * 64 + seg * 16);
        const float4* vp4 = (const float4*)(vc + (size_t)(blk * 64 + key) * 64 + seg * 16);
#pragma unroll
        for (int e = 0; e < 4; ++e) {
          const float4 a = kp4[e], c = vp4[e];
          kf[4 * e] = a.x; kf[4 * e + 1] = a.y; kf[4 * e + 2] = a.z; kf[4 * e + 3] = a.w;
          vf[4 * e] = c.x; vf[4 * e + 1] = c.y; vf[4 * e + 2] = c.z; vf[4 * e + 3] = c.w;
        }
      } else {
        const u16* rowp = projp + ((size_t)tokbase + blk * 64 + key) * PS;
        const bf16x8 k0 = *(const bf16x8*)(rowp + kcol + seg * 16), k1 = *(const bf16x8*)(rowp + kcol + seg * 16 + 8);
        const bf16x8 v0 = *(const bf16x8*)(rowp + vcol + seg * 16), v1 = *(const bf16x8*)(rowp + vcol + seg * 16 + 8);
#pragma unroll
        for (int e = 0; e < 8; ++e) { kf[e] = bf2f((u16)k0[e]); kf[8 + e] = bf2f((u16)k1[e]); vf[e] = bf2f((u16)v0[e]); vf[8 + e] = bf2f((u16)v1[e]); }
        if (MODE == 3) {
          const bf16x8 p0 = *(const bf16x8*)(rowp + kcol + (seg ^ 1) * 16), p1 = *(const bf16x8*)(rowp + kcol + (seg ^ 1) * 16 + 8);
          const int pos = (seg & 2) ? key : blk;
#pragma unroll
          for (int e = 0; e < 16; ++e) {
            const float pr = bf2f((u16)(e < 8 ? p0[e & 7] : p1[e & 7]));
            const float cs = ropep[(pos * 16 + e) * 2], sn = ropep[(pos * 16 + e) * 2 + 1];
            kf[e] = (seg & 1) ? (pr * sn + kf[e] * cs) : (kf[e] * cs - pr * sn);
          }
        }
      }
      bf16x8 o0, o1;
#pragma unroll
      for (int e = 0; e < 8; ++e) { o0[e] = (short)f2bf(kf[e]); o1[e] = (short)f2bf(kf[8 + e]); }
      *(bf16x8*)(Ks + key * 72 + seg * 16) = o0;
      *(bf16x8*)(Ks + key * 72 + seg * 16 + 8) = o1;
#pragma unroll
      for (int e = 0; e < 16; ++e) Vt[(seg * 16 + e) * 72 + key] = f2bf(vf[e]);
    }
    __syncthreads();
    bool active = true;
    if (MODE == 1 && !isctx) active = (blk >= r0w && blk < r0w + 8);
    if (active) {
      f32x16 st[2]; zero16(st[0]); zero16(st[1]);
#pragma unroll
      for (int kt = 0; kt < 2; ++kt)
#pragma unroll
        for (int s = 0; s < 4; ++s) {
          const bf16x8 a = *(const bf16x8*)(Ks + (kt * 32 + r) * 72 + 16 * s + 8 * h);
          st[kt] = MFMA(a, qf[s], st[kt]);
        }
      float mx = m_run;
#pragma unroll
      for (int kt = 0; kt < 2; ++kt)
#pragma unroll
        for (int i = 0; i < 16; ++i) {
          float s = st[kt][i] * 0.125f;
          const int kk = kt * 32 + crow(i, h);
          if (MODE == 1 && !isctx) {
            const bool ok = (kk >= c0w && kk < c0w + 16);
            s = ok ? s + rpb_s[(blk - qi + 7) * 31 + (kk - qw + 15)] : -1e30f;
          }
          if (MODE == 3 && !isctx) {
            const int dlt = blk * 64 + kk - tq;
            s = (dlt <= 128 && dlt >= -128) ? s : -1e30f;
          }
          st[kt][i] = s;
          mx = fmaxf(mx, s);
        }
      mx = fmaxf(mx, shx(mx, lane, 32));
      const float alpha = __expf(m_run - mx);
      m_run = mx;
      float ps = 0.f;
#pragma unroll
      for (int kt = 0; kt < 2; ++kt)
#pragma unroll
        for (int i = 0; i < 16; ++i) { const float pv = __expf(st[kt][i] - mx); st[kt][i] = pv; ps += pv; }
      l_run = l_run * alpha + ps;
#pragma unroll
      for (int dt = 0; dt < 2; ++dt)
#pragma unroll
        for (int i = 0; i < 16; ++i) ot[dt][i] *= alpha;
#pragma unroll
      for (int kt = 0; kt < 2; ++kt) {
        const bf16x8 pb0 = packs<0>(st[kt]), pb1 = packs<1>(st[kt]);
#pragma unroll
        for (int dt = 0; dt < 2; ++dt) {
          const bf16x8 pa0 = ld2x4(Vt + (dt * 32 + r) * 72 + kt * 32 + 4 * h);
          const bf16x8 pa1 = ld2x4(Vt + (dt * 32 + r) * 72 + kt * 32 + 16 + 4 * h);
          ot[dt] = MFMA(pa0, pb0, ot[dt]);
          ot[dt] = MFMA(pa1, pb1, ot[dt]);
        }
      }
    }
  }
  l_run += shx(l_run, lane, 32);
  const float inv = 1.f / l_run;
  u16* dst = hnp + qtok * 1024 + qcol;
#pragma unroll
  for (int dt = 0; dt < 2; ++dt)
#pragma unroll
    for (int g4 = 0; g4 < 4; ++g4) {
      ushort4 o;
      o.x = f2bf(ot[dt][4 * g4] * inv); o.y = f2bf(ot[dt][4 * g4 + 1] * inv); o.z = f2bf(ot[dt][4 * g4 + 2] * inv); o.w = f2bf(ot[dt][4 * g4 + 3] * inv);
      *(ushort4*)(dst + dt * 32 + 8 * g4 + 4 * h) = o;
    }
}

struct ChainId { int lat, b, h, dir, T, base, nch; };
DI ChainId chain_decode(int it) {
  ChainId c; c.lat = it < 128; const int q = c.lat ? it : it - 128;
  c.b = q >> 4; c.h = (q >> 1) & 7; c.dir = q & 1; c.T = c.lat ? 4096 : 256; c.base = c.lat ? NP_ + c.b * 4096 : c.b * 256; c.nch = c.T >> 6;
  return c;
}
DI int tokof(const ChainId& c, int step, int row) { const int pp = step * 64 + row; return c.base + (c.dir ? c.T - 1 - pp : pp); }


static constexpr int RING = 4;
static constexpr int SLOT_BYTES = 53760;
DI void wait_ge(int* flag, int val, int tid) {
  if (tid < 64) {
    if (tid == 0) { while (__hip_atomic_load(flag, __ATOMIC_RELAXED, __HIP_MEMORY_SCOPE_AGENT) < val) __builtin_amdgcn_s_sleep(1); }
    __builtin_amdgcn_fence(__ATOMIC_ACQUIRE, "agent");
  }
  __syncthreads();
}
DI void publish(int* flag, int val, int tid) {
  asm volatile("s_waitcnt vmcnt(0)" ::: "memory");
  __syncthreads();
  if (tid == 0) __hip_atomic_store(flag, val, __ATOMIC_RELAXED, __HIP_MEMORY_SCOPE_AGENT);
}
typedef __attribute__((ext_vector_type(4))) unsigned u32x4;
DI void copy_out(const char* lds, char* g, int bytes, int tid) {
  for (int i = opq(tid) * 16; i < bytes; i += 256 * 16) {
    const u32x4 v = *(const u32x4*)(lds + i);
    char* dst = g + i;
    asm volatile("global_store_dwordx4 %0, %1, off sc0 sc1" :: "v"(dst), "v"(v) : "memory");
  }
}
template <int BYTES>
DI void copy_in_t(char* lds, const char* g, int tid) {
  constexpr int N = (BYTES + 4095) / 4096;
  const int t16 = opq(tid) * 16;
  uint4 v[N];
#pragma unroll
  for (int j = 0; j < N; ++j) { const int i = t16 + j * 4096; v[j] = make_uint4(0, 0, 0, 0); if (i < BYTES) v[j] = *(const uint4*)(g + i); }
#pragma unroll
  for (int j = 0; j < N; ++j) { const int i = t16 + j * 4096; if (i < BYTES) *(uint4*)(lds + i) = v[j]; }
}

template <int ROLE>
DI void gla_chain(const P* __restrict__ gp, int jj, int it, char* smem, int k0, int kstep, int fs = 0) {
  const P& p = *gp;
  const ChainId cid = chain_decode(it);
  int tid_ = threadIdx.x; asm volatile("" : "+v"(tid_)); const int tid = tid_, lane = tid & 63, wave = tid >> 6, r = lane & 31, h = lane >> 5;
  const int hh = cid.h, dir = cid.dir;
  u16* QT = (u16*)smem; u16* KT = QT + 4608; u16* KEt = KT + 4608; u16* Vt = KEt + 4608;
  float* dec = (float*)(Vt + 4608); float* GL = dec + 64; float* gq = GL + 1024; float* Ost = gq + 256;
  constexpr int IMG = 4 * 9216 + 256;
  char* slots = uni(p.ring) + (size_t)it * RING * SLOT_BYTES; int* ready = uni(p.flags) + (jj * 2 + 4 * fs) * 8320 + it * 64; int* done = uni(p.flags) + (jj * 2 + 4 * fs) * 8320 + 8192 + it;
  const int d = tid & 63, cq = tid >> 6;
  float wg[16];
#pragma unroll
  for (int rr = 0; rr < 16; ++rr) wg[rr] = p.b_w_g2[((size_t)((jj * 2 + dir) * 16 + rr)) * 512 + hh * 64 + d];
  const float bg = p.b_b_g[(jj * 2 + dir) * 512 + hh * 64 + d];
  const int vh = wave & 1;
  f32x16 S[2]; zero16(S[0]); zero16(S[1]);
  const size_t sidx = ((size_t)(((cid.b * 2 + jj) * 2 + dir) * 8 + hh)) * 4096;
  if (ROLE != 1 && wave < 2 && cid.lat) {
#pragma unroll
    for (int dt = 0; dt < 2; ++dt)
#pragma unroll
      for (int i = 0; i < 16; ++i) S[dt][i] = p.state_b[sidx + (dt * 32 + crow(i, h)) * 64 + vh * 32 + r];
  }
  for (int step_ = k0; step_ < cid.nch; step_ += kstep) {
    int step = step_;
    asm volatile("" : "+v"(step));
    if (ROLE == 1) wait_ge(done, step_ - RING + 1, tid);
    if (ROLE == 2) wait_ge(ready + step_, 1, tid);
    __syncthreads();
    if (ROLE == 2) { copy_in_t<IMG>(smem, slots + (size_t)(step_ % RING) * SLOT_BYTES, tid); __syncthreads(); if (tid == 0) __hip_atomic_store(done, step_ + 1, __ATOMIC_RELAXED, __HIP_MEMORY_SCOPE_AGENT); }
    if (ROLE != 2) {
    {
      const int c = tid >> 2, sg = tid & 3;
      const int tok = tokof(cid, step, c);
      const ushort4 gv = *(const ushort4*)(p.proj + (size_t)tok * EVN + 3072 + dir * 16 + sg * 4);
      GL[c * 16 + sg * 4] = bf2f(gv.x); GL[c * 16 + sg * 4 + 1] = bf2f(gv.y); GL[c * 16 + sg * 4 + 2] = bf2f(gv.z); GL[c * 16 + sg * 4 + 3] = bf2f(gv.w);
    }
    __syncthreads();
    float Gl[16]; float run = 0.f;
#pragma unroll
    for (int i = 0; i < 16; ++i) {
      const int c = cq * 16 + i;
      float z = bg;
#pragma unroll
      for (int rr = 0; rr < 16; ++rr) z += GL[c * 16 + rr] * wg[rr];
      const float g = (fminf(z, 0.f) - __logf(1.f + __expf(-fabsf(z)))) * (1.f / 16.f);
      run += g; Gl[i] = run;
    }
    gq[cq * 64 + d] = run;
    __syncthreads();
    float off = 0.f, tot = 0.f;
#pragma unroll
    for (int q2 = 0; q2 < 4; ++q2) { const float t = gq[q2 * 64 + d]; if (q2 < cq) off += t; tot += t; }
#pragma unroll
    for (int i = 0; i < 16; ++i) {
      const int c = cq * 16 + i;
      const int tok = tokof(cid, step, c);
      const float G = Gl[i] + off;
      const u16* rowp = p.proj + (size_t)tok * EVN + hh * 64 + d;
      const float qv = bf2f(rowp[1536]), kv = bf2f(rowp[2048]);
      const u16 vb = rowp[2560];
      QT[c * 72 + d] = f2bf(qv * 0.125f * __expf(G));
      KT[c * 72 + d] = f2bf(kv * __expf(-G));
      KEt[d * 72 + c] = f2bf(kv * __expf(tot - G));
      Vt[d * 72 + c] = vb;
    }
    if (cq == 0) dec[d] = __expf(tot);
    __syncthreads();
    }
    if (ROLE == 1) { copy_out(smem, slots + (size_t)(step_ % RING) * SLOT_BYTES, IMG, tid); publish(ready + step_, 1, tid); continue; }
    if (wave < 2) {
      f32x16 at[2][2];
#pragma unroll
      for (int a = 0; a < 2; ++a)
#pragma unroll
        for (int b2 = 0; b2 < 2; ++b2) zero16(at[a][b2]);
#pragma unroll
      for (int ks = 0; ks < 4; ++ks) {
        const bf16x8 a0 = *(const bf16x8*)(KT + r * 72 + ks * 16 + 8 * h), a1 = *(const bf16x8*)(KT + (32 + r) * 72 + ks * 16 + 8 * h);
        const bf16x8 b0 = *(const bf16x8*)(QT + r * 72 + ks * 16 + 8 * h), b1 = *(const bf16x8*)(QT + (32 + r) * 72 + ks * 16 + 8 * h);
        at[0][0] = MFMA(a0, b0, at[0][0]); at[0][1] = MFMA(a0, b1, at[0][1]);
        at[1][0] = MFMA(a1, b0, at[1][0]); at[1][1] = MFMA(a1, b1, at[1][1]);
      }
#pragma unroll
      for (int st = 0; st < 2; ++st)
#pragma unroll
        for (int ct = 0; ct < 2; ++ct)
#pragma unroll
          for (int i = 0; i < 16; ++i) { if (st * 32 + crow(i, h) > ct * 32 + r) at[st][ct][i] = 0.f; }
      f32x16 o[2]; zero16(o[0]); zero16(o[1]);
#pragma unroll
      for (int ct = 0; ct < 2; ++ct)
#pragma unroll
        for (int st = 0; st < 2; ++st) {
          const bf16x8 x0 = packs<0>(at[st][ct]), x1 = packs<1>(at[st][ct]);
          const bf16x8 pb0 = ld2x4(Vt + (vh * 32 + r) * 72 + st * 32 + 4 * h);
          const bf16x8 pb1 = ld2x4(Vt + (vh * 32 + r) * 72 + st * 32 + 16 + 4 * h);
          o[ct] = MFMA(x0, pb0, o[ct]);
          o[ct] = MFMA(x1, pb1, o[ct]);
        }
#pragma unroll
      for (int dt = 0; dt < 2; ++dt) {
        const bf16x8 xs0 = packs<0>(S[dt]), xs1 = packs<1>(S[dt]);
#pragma unroll
        for (int ct = 0; ct < 2; ++ct) {
          const bf16x8 pa0 = ld2x4(QT + (ct * 32 + r) * 72 + dt * 32 + 4 * h);
          const bf16x8 pa1 = ld2x4(QT + (ct * 32 + r) * 72 + dt * 32 + 16 + 4 * h);
          o[ct] = MFMA(pa0, xs0, o[ct]);
          o[ct] = MFMA(pa1, xs1, o[ct]);
        }
      }
#pragma unroll
      for (int dt = 0; dt < 2; ++dt)
#pragma unroll
        for (int i = 0; i < 16; ++i) S[dt][i] *= dec[dt * 32 + crow(i, h)];
#pragma unroll
      for (int ks = 0; ks < 4; ++ks) {
        const bf16x8 bv = *(const bf16x8*)(Vt + (vh * 32 + r) * 72 + ks * 16 + 8 * h);
#pragma unroll
        for (int dt = 0; dt < 2; ++dt) {
          const bf16x8 a = *(const bf16x8*)(KEt + (dt * 32 + r) * 72 + ks * 16 + 8 * h);
          S[dt] = MFMA(a, bv, S[dt]);
        }
      }
#pragma unroll
      for (int ct = 0; ct < 2; ++ct)
#pragma unroll
        for (int i = 0; i < 16; ++i) Ost[(ct * 32 + crow(i, h)) * 68 + vh * 32 + r] = o[ct][i];
    }
    __syncthreads();
    {
      const int c = tid >> 2, sg = tid & 3;
      const int tok = tokof(cid, step, c);
      u16* dst = (dir ? p.ot1 + (size_t)tok * 512 + hh * 64 : p.hn + (size_t)tok * 1024 + 512 + hh * 64) + sg * 16;
      bf16x8 w0, w1;
#pragma unroll
      for (int e = 0; e < 8; ++e) { w0[e] = (short)f2bf(Ost[c * 68 + sg * 16 + e]); w1[e] = (short)f2bf(Ost[c * 68 + sg * 16 + 8 + e]); }
      *(bf16x8*)dst = w0; *(bf16x8*)(dst + 8) = w1;
    }
  }
  if (wave < 2 && !cid.lat) {
#pragma unroll
    for (int dt = 0; dt < 2; ++dt)
#pragma unroll
      for (int i = 0; i < 16; ++i) p.out[OFF_SB + sidx + (dt * 32 + crow(i, h)) * 64 + vh * 32 + r] = S[dt][i];
  }
}

template <int ROLE>
DI void delta_chain(const P* __restrict__ gp, int jj, int it, char* smem, int k0, int kstep, int fs = 0) {
  const P& p = *gp;
  const ChainId cid = chain_decode(it);
  int tid_ = threadIdx.x; asm volatile("" : "+v"(tid_)); const int tid0 = tid_;
  const int hh = cid.h, dir = cid.dir;
  u16* Qn = (u16*)smem; u16* Kt = Qn + 4608; u16* AQK = Kt + 4608; u16* KC = AQK + 4608;
  float* Wv = (float*)(KC + 4608); float* Gs = Wv + 64 * 65; u16* Kn = (u16*)(Gs + 64); float* At = (float*)(Kn + 4608); float* Bt = At + 64 * 68;
  constexpr int IMG = 4 * 9216 + 16640 + 256;
  char* slots = uni(p.ring) + (size_t)it * RING * SLOT_BYTES; int* ready = uni(p.flags) + (jj * 2 + 1 + 4 * fs) * 8320 + it * 64; int* done = uni(p.flags) + (jj * 2 + 1 + 4 * fs) * 8320 + 8192 + it;
  const float aexp = __expf(p.d_a_log[(jj * 2 + dir) * 8 + hh]);
  const float dtb = p.d_dt_bias[(jj * 2 + dir) * 8 + hh];
  f32x16 S[2]; zero16(S[0]); zero16(S[1]);
  const size_t sidx = ((size_t)(((cid.b * 2 + jj) * 2 + dir) * 8 + hh)) * 4096;
  { const int tid = tid0, lane = tid & 63, wave = tid >> 6, r = lane & 31, h = lane >> 5;
  if (ROLE != 1 && wave < 2 && cid.lat) {
    const int vh = wave & 1;
#pragma unroll
    for (int dt = 0; dt < 2; ++dt)
#pragma unroll
      for (int i = 0; i < 16; ++i) S[dt][i] = p.state_d[sidx + (dt * 32 + crow(i, h)) * 64 + vh * 32 + r];
  }
  }
  u16* CW = (u16*)(smem + 80640);
  __syncthreads();
  for (int i = tid0; i < 576; i += 256) { const int tap = i / 192, c2 = i - tap * 192; const int wh = c2 >> 6, dd = c2 & 63;
    CW[i] = f2bf(p.d_conv[(size_t)jj * 3 * 1536 + tap * 1536 + wh * 512 + hh * 64 + dd]); }
  for (int step_ = k0; step_ < cid.nch; step_ += kstep) {
    int step = step_;
    asm volatile("" : "+v"(step));
    if (ROLE == 1) wait_ge(done, step_ - RING + 1, tid0);
    if (ROLE == 2) wait_ge(ready + step_, 1, tid0);
    __syncthreads();
    if (ROLE == 2) { copy_in_t<IMG>(smem, slots + (size_t)(step_ % RING) * SLOT_BYTES, tid0); __syncthreads(); if (tid0 == 0) __hip_atomic_store(done, step_ + 1, __ATOMIC_RELAXED, __HIP_MEMORY_SCOPE_AGENT); }
    if (ROLE != 2) {
    {const int tid = opq(tid0), lane = tid & 63, wave = __builtin_amdgcn_readfirstlane(tid >> 6), r = lane & 31, h = lane >> 5, vh = wave & 1; (void)r; (void)h; (void)vh; (void)lane;
    if (wave == 0) {
      const int tok = tokof(cid, step, lane);
      const float da = bf2f(p.proj[(size_t)tok * ODN + 2304 + dir * 8 + hh]);
      const float db = bf2f(p.proj[(size_t)tok * ODN + 2320 + dir * 8 + hh]);
      const float x = da + dtb;
      const float sp = x > 20.f ? x : __logf(1.f + __expf(x));
      float G = -aexp * sp;
#pragma unroll
      for (int o = 1; o < 64; o <<= 1) { const float t = __int_as_float(__builtin_amdgcn_ds_bpermute((lane - o) << 2, __float_as_int(G))); if (lane >= o) G += t; }
      Gs[lane] = G; Bt[lane] = 1.f / (1.f + __expf(-db));
    }
    {
      const int c = tid >> 2, sg = tid & 3;
      const int tok = tokof(cid, step, c);
      const int pos = tok - cid.base;
      const bool hp = pos > 0, hn_ = pos < cid.T - 1;
#pragma unroll 1
      for (int wh = 0; wh < 3; ++wh) {
        const int ch0 = wh * 512 + hh * 64 + sg * 16;
        const u16* cur = p.proj + (size_t)tok * ODN + 768 + ch0;
        float y[16];
        float ss = 0.f;
#pragma unroll
        for (int hf = 0; hf < 2; ++hf) {
          const bf16x8 xc = *(const bf16x8*)(cur + hf * 8);
          bf16x8 xp, xn;
#pragma unroll
          for (int e = 0; e < 8; ++e) { xp[e] = 0; xn[e] = 0; }
          if (hp) xp = *(const bf16x8*)(cur - ODN + hf * 8);
          if (hn_) xn = *(const bf16x8*)(cur + ODN + hf * 8);
#pragma unroll
          for (int e = 0; e < 8; ++e) {
            const int ch = wh * 64 + sg * 16 + hf * 8 + e;
            float v = bf2f(CW[ch]) * bf2f((u16)xp[e]) + bf2f(CW[192 + ch]) * bf2f((u16)xc[e]) + bf2f(CW[384 + ch]) * bf2f((u16)xn[e]);
            v = v / (1.f + __expf(-v));
            y[hf * 8 + e] = v; ss += v * v;
          }
        }
        ss += shx(ss, lane, 1); ss += shx(ss, lane, 2);
        const float rn = rsqrtf(ss + 1e-6f);
        if (wh == 0) {
#pragma unroll
          for (int e = 0; e < 16; ++e) Qn[c * 72 + sg * 16 + e] = f2bf(y[e] * rn * 0.125f);
        } else if (wh == 1) {
#pragma unroll
          for (int e = 0; e < 16; ++e) { const u16 kb = f2bf(y[e] * rn); Kn[c * 72 + sg * 16 + e] = kb; Kt[(sg * 16 + e) * 72 + c] = kb; }
        } else {
#pragma unroll
          for (int e = 0; e < 16; ++e) Wv[c * 65 + sg * 16 + e] = y[e];
        }
      }
    }
    }
    __syncthreads();
    {const int tid = opq(tid0), lane = tid & 63, wave = __builtin_amdgcn_readfirstlane(tid >> 6), r = lane & 31, h = lane >> 5, vh = wave & 1; (void)r; (void)h; (void)vh; (void)lane;
    if (wave < 2) {
      f32x16 akk[2], aqk[2]; zero16(akk[0]); zero16(akk[1]); zero16(aqk[0]); zero16(aqk[1]);
#pragma unroll
      for (int ks = 0; ks < 4; ++ks) {
        const bf16x8 bk = *(const bf16x8*)(Kn + (vh * 32 + r) * 72 + ks * 16 + 8 * h);
#pragma unroll
        for (int ct = 0; ct < 2; ++ct) {
          const bf16x8 ak = *(const bf16x8*)(Kn + (ct * 32 + r) * 72 + ks * 16 + 8 * h);
          const bf16x8 aq = *(const bf16x8*)(Qn + (ct * 32 + r) * 72 + ks * 16 + 8 * h);
          akk[ct] = MFMA(ak, bk, akk[ct]);
          aqk[ct] = MFMA(aq, bk, aqk[ct]);
        }
      }
      const int s = vh * 32 + r;
      const float Gss = Gs[s];
#pragma unroll
      for (int ct = 0; ct < 2; ++ct)
#pragma unroll
        for (int g4 = 0; g4 < 4; ++g4) {
          const int c0 = ct * 32 + 8 * g4 + 4 * h;
          const float4 gv4 = *(const float4*)(Gs + c0), bv4 = *(const float4*)(Bt + c0);
          float4 val;
#pragma unroll
          for (int e = 0; e < 4; ++e) {
            const int c = c0 + e;
            const float Gc = e == 0 ? gv4.x : e == 1 ? gv4.y : e == 2 ? gv4.z : gv4.w;
            const float Bc = e == 0 ? bv4.x : e == 1 ? bv4.y : e == 2 ? bv4.z : bv4.w;
            const float gam = __expf(fminf(Gc - Gss, 0.f));
            const float av = (s < c) ? akk[ct][4 * g4 + e] * Bc * gam : 0.f;
            if (e == 0) val.x = av; else if (e == 1) val.y = av; else if (e == 2) val.z = av; else val.w = av;
            AQK[c * 72 + s] = f2bf((s <= c) ? aqk[ct][4 * g4 + e] * gam : 0.f);
          }
          *(float4*)(At + s * 68 + c0) = val;
        }
    }
    }
    __syncthreads();
    {const int tid = opq(tid0), lane = tid & 63, wave = __builtin_amdgcn_readfirstlane(tid >> 6), r = lane & 31, h = lane >> 5, vh = wave & 1; (void)r; (void)h; (void)vh; (void)lane;
    if (wave < 2) {
      const bool isv = wave == 0;
      const int col = lane;
#pragma unroll 1
      for (int bi = 0; bi < 4; ++bi) {
        float acc[16];
#pragma unroll
        for (int ci = 0; ci < 16; ++ci) {
          const int c = 16 * bi + ci;
          acc[ci] = isv ? Wv[c * 65 + col] * Bt[c] : bf2f(Kn[c * 72 + col]) * Bt[c] * __expf(Gs[c]);
        }
#pragma unroll 8
        for (int s2 = 0; s2 < 16 * bi; ++s2) {
          const float xs = isv ? Wv[s2 * 65 + col] : bf2f(KC[s2 * 72 + col]);
          const float4* a4 = (const float4*)(At + s2 * 68 + 16 * bi);
#pragma unroll
          for (int q = 0; q < 4; ++q) {
            const float4 a = a4[q];
            acc[4 * q] -= a.x * xs; acc[4 * q + 1] -= a.y * xs; acc[4 * q + 2] -= a.z * xs; acc[4 * q + 3] -= a.w * xs;
          }
        }
#pragma unroll
        for (int ci = 0; ci < 16; ++ci) {
          const float x = acc[ci];
          const float* arow = At + (16 * bi + ci) * 68 + 16 * bi;
#pragma unroll
          for (int cj = ci + 1; cj < 16; ++cj) acc[cj] -= arow[cj] * x;
          if (isv) Wv[(16 * bi + ci) * 65 + col] = x; else KC[(16 * bi + ci) * 72 + col] = f2bf(x);
        }
      }
    }
    }
    __syncthreads();
    }
    if (ROLE == 1) { copy_out(smem, slots + (size_t)(step_ % RING) * SLOT_BYTES, IMG, tid0); publish(ready + step_, 1, tid0); continue; }
    {const int tid = opq(tid0), lane = tid & 63, wave = __builtin_amdgcn_readfirstlane(tid >> 6), r = lane & 31, h = lane >> 5, vh = wave & 1; (void)r; (void)h; (void)vh; (void)lane;
    if (wave < 2) {
      f32x16 kS[2], qS[2]; zero16(kS[0]); zero16(kS[1]); zero16(qS[0]); zero16(qS[1]);
#pragma unroll
      for (int dt = 0; dt < 2; ++dt) {
        const bf16x8 xs0 = packs<0>(S[dt]), xs1 = packs<1>(S[dt]);
#pragma unroll
        for (int ct = 0; ct < 2; ++ct) {
          kS[ct] = MFMA(ld2x4(KC + (ct * 32 + r) * 72 + dt * 32 + 4 * h), xs0, kS[ct]);
          kS[ct] = MFMA(ld2x4(KC + (ct * 32 + r) * 72 + dt * 32 + 16 + 4 * h), xs1, kS[ct]);
          qS[ct] = MFMA(ld2x4(Qn + (ct * 32 + r) * 72 + dt * 32 + 4 * h), xs0, qS[ct]);
          qS[ct] = MFMA(ld2x4(Qn + (ct * 32 + r) * 72 + dt * 32 + 16 + 4 * h), xs1, qS[ct]);
        }
      }
      f32x16 vn[2], o[2];
      const float Glast = Gs[63];
#pragma unroll
      for (int ct = 0; ct < 2; ++ct)
#pragma unroll
        for (int i = 0; i < 16; ++i) {
          const int c = ct * 32 + crow(i, h);
          vn[ct][i] = Wv[c * 65 + vh * 32 + r] - kS[ct][i];
          o[ct][i] = qS[ct][i] * __expf(Gs[c]);
        }
#pragma unroll
      for (int st = 0; st < 2; ++st) {
        const bf16x8 xs0 = packs<0>(vn[st]), xs1 = packs<1>(vn[st]);
#pragma unroll
        for (int ct = 0; ct < 2; ++ct) {
          o[ct] = MFMA(ld2x4(AQK + (ct * 32 + r) * 72 + st * 32 + 4 * h), xs0, o[ct]);
          o[ct] = MFMA(ld2x4(AQK + (ct * 32 + r) * 72 + st * 32 + 16 + 4 * h), xs1, o[ct]);
        }
      }
      const float dl = __expf(Glast);
#pragma unroll
      for (int st = 0; st < 2; ++st) {
        asm volatile("" ::: "memory");
#pragma unroll
        for (int i = 0; i < 16; ++i) vn[st][i] *= __expf(Glast - Gs[st * 32 + crow(i, h)]);
      }
      asm volatile("" ::: "memory");
#pragma unroll
      for (int dt = 0; dt < 2; ++dt)
#pragma unroll
        for (int i = 0; i < 16; ++i) S[dt][i] *= dl;
#pragma unroll
      for (int st = 0; st < 2; ++st) {
        const bf16x8 xs0 = packs<0>(vn[st]), xs1 = packs<1>(vn[st]);
#pragma unroll
        for (int dt = 0; dt < 2; ++dt) {
          S[dt] = MFMA(ld2x4(Kt + (dt * 32 + r) * 72 + st * 32 + 4 * h), xs0, S[dt]);
          S[dt] = MFMA(ld2x4(Kt + (dt * 32 + r) * 72 + st * 32 + 16 + 4 * h), xs1, S[dt]);
        }
      }
#pragma unroll
      for (int ct = 0; ct < 2; ++ct)
#pragma unroll
        for (int i = 0; i < 16; ++i) At[(ct * 32 + crow(i, h)) * 68 + vh * 32 + r] = o[ct][i];
    }
    }
    __syncthreads();
    {
      const int tid = opq(tid0);
      const int c = tid >> 2, sg = tid & 3;
      const int tok = tokof(cid, step, c);
      u16* dst = (dir ? p.ot1 + (size_t)tok * 512 + hh * 64 : p.hn + (size_t)tok * 1024 + 512 + hh * 64) + sg * 16;
      bf16x8 w0, w1;
#pragma unroll
      for (int e = 0; e < 8; ++e) { w0[e] = (short)f2bf(At[c * 68 + sg * 16 + e]); w1[e] = (short)f2bf(At[c * 68 + sg * 16 + 8 + e]); }
      *(bf16x8*)dst = w0; *(bf16x8*)(dst + 8) = w1;
    }
  }
  {const int tid = opq(tid0), lane = tid & 63, wave = __builtin_amdgcn_readfirstlane(tid >> 6), r = lane & 31, h = lane >> 5, vh = wave & 1; (void)r; (void)h; (void)vh; (void)lane;
  if (wave < 2 && !cid.lat) {
#pragma unroll
    for (int dt = 0; dt < 2; ++dt)
#pragma unroll
      for (int i = 0; i < 16; ++i) p.out[OFF_SD + sidx + (dt * 32 + crow(i, h)) * 64 + vh * 32 + r] = S[dt][i];
  }
}
}

DI void mixer_phase(const P* __restrict__ gp, int l, char* smem, int fs = 0) {
  const P& p = *gp;
  const bool even = !(l & 1); const int jj = l >> 1;
  const bool teams = gridDim.x >= 512;
  if (teams) {
    const int bid = blockIdx.x;
    const int K = 3;
    if (bid < 128 * (K + 1)) {
      if (bid < 128) { if (even) gla_chain<2>(gp, jj, bid, smem, 0, 1, fs); else delta_chain<2>(gp, jj, bid, smem, 0, 1, fs); }
      else { const int ch = (bid - 128) & 127, k = (bid - 128) >> 7; if (even) gla_chain<1>(gp, jj, ch, smem, k, K, fs); else delta_chain<1>(gp, jj, ch, smem, k, K, fs); }
    }
  }
  const int first = teams ? 128 : 0;
  const int total = 384 + 2048 + 256;
  int* s_item = (int*)(smem + SMEM_BYTES - 16);
  int* cntp = uni(p.cnt) + l + 4 * fs;
  for (;;) {
    __syncthreads();
    if (opq(threadIdx.x) == 0) *s_item = atomicAdd(cntp, 1) + first;
    __syncthreads();
    const int item = __builtin_amdgcn_readfirstlane(*s_item);
    if (item >= total) break;
    if (item < 384) { if (even) gla_chain<0>(gp, jj, item, smem, 0, 1); else delta_chain<0>(gp, jj, item, smem, 0, 1); }
    else if (item < 384 + 2048) { if (even) attn_item<1>(gp, jj, item - 384, smem); else attn_item<3>(gp, jj, item - 384, smem); }
    else { if (even) attn_item<0>(gp, jj, item - 384 - 2048, smem); else attn_item<2>(gp, jj, item - 384 - 2048, smem); }
  }
}

DI void finalize_phase(const P* __restrict__ gp, int l) {
  const P& p = *gp;
  const bool even = !(l & 1); const int jj = l >> 1;
  int tid_ = threadIdx.x; asm volatile("" : "+v"(tid_)); const int tid = tid_;
  const int tk = tid >> 5, hh = (tid >> 2) & 7, sg = tid & 3;
  const int PS = even ? EVN : ODN; const int zcol = even ? 3104 : 2336;
  for (int item = blockIdx.x; item < NT_ / 8; item += gridDim.x) {
    const size_t tok = (size_t)item * 8 + tk;
    u16* a = p.hn + tok * 1024 + 512 + hh * 64 + sg * 16;
    const u16* bsrc = p.ot1 + tok * 512 + hh * 64 + sg * 16;
    const u16* zs = p.proj + tok * PS + zcol + hh * 64 + sg * 16;
    float o[16]; float ss = 0.f;
#pragma unroll
    for (int hf = 0; hf < 2; ++hf) {
      const bf16x8 x0 = *(const bf16x8*)(a + hf * 8), x1 = *(const bf16x8*)(bsrc + hf * 8);
#pragma unroll
      for (int e = 0; e < 8; ++e) { const float v = bf2f((u16)x0[e]) + bf2f((u16)x1[e]); o[hf * 8 + e] = v; ss += v * v; }
    }
    ss += shx(ss, tid & 63, 1); ss += shx(ss, tid & 63, 2);
    const float rstd = rsqrtf(ss * (1.f / 64.f) + 1e-6f);
    const float* ng = even ? p.b_norm_g + jj * 512 + hh * 64 + sg * 16 : p.d_norm_g + jj * 64 + sg * 16;
#pragma unroll
    for (int hf = 0; hf < 2; ++hf) {
      const bf16x8 z = *(const bf16x8*)(zs + hf * 8);
      bf16x8 w;
#pragma unroll
      for (int e = 0; e < 8; ++e) { const float zz = bf2f((u16)z[e]); w[e] = (short)f2bf(o[hf * 8 + e] * rstd * ng[hf * 8 + e] * siluf(zz)); }
      *(bf16x8*)(a + hf * 8) = w;
    }
  }
}


#define XB_TMO      128
#define XB_XCNT(j)  (256  + 64 * (j))
#define XB_XSUB(j)  (1280 + 64 * (j))
#define XB_XGEN(j)  (2304 + 64 * (j))
#define XB_TOP      3328
#define XB_TOPGEN   3392
#define XCD_BAR_WORDS 3456
#define XB_SPIN_CAP (1u << 18)
#define LAS __attribute__((address_space(3)))
DI unsigned xb_ld(unsigned* q)              { return __hip_atomic_load(q, __ATOMIC_RELAXED, __HIP_MEMORY_SCOPE_AGENT); }
DI unsigned xb_add(unsigned* q, unsigned v) { return __hip_atomic_fetch_add(q, v, __ATOMIC_RELAXED, __HIP_MEMORY_SCOPE_AGENT); }
DI unsigned xb_xcc_id() { return (unsigned)__builtin_amdgcn_s_getreg((3 << 11) | 20) & 0xFu; }
#define XB_SPIN(cond, bar) do { unsigned _sp = 0; while (cond) { __builtin_amdgcn_s_sleep(1); \
    if ((++_sp & 255u) == 0u) { if (xb_ld(&(bar)[XB_TMO])) break; if (_sp > XB_SPIN_CAP) { atomicAdd(&(bar)[XB_TMO], 1u); break; } } } } while (0)
struct XcdBarrier { unsigned* bar; unsigned x; volatile LAS unsigned* st; };
DI XcdBarrier xcd_barrier_post(unsigned* bar, volatile LAS unsigned* st) {
  XcdBarrier b; b.bar = bar; b.x = xb_xcc_id(); b.st = st;
  if (threadIdx.x == 0) (void)xb_add(&bar[XB_XCNT(b.x)], 1u);
  return b;
}
DI void xcd_barrier_complete(unsigned* bar, unsigned x, unsigned& nloc, unsigned& nx) {
  const unsigned G = gridDim.x * gridDim.y * gridDim.z;
  unsigned sum, cnt, mine, sp = 0u;
  for (;;) {
    sum = 0u; cnt = 0u; mine = 0u;
#pragma unroll
    for (unsigned j = 0; j < 16; ++j) { const unsigned c = xb_ld(&bar[XB_XCNT(j)]); sum += c; cnt += (c > 0u) ? 1u : 0u; mine = (j == x) ? c : mine; }
    if (sum == G) break;
    __builtin_amdgcn_s_sleep(1);
    if ((++sp & 255u) == 0u) { if (xb_ld(&bar[XB_TMO])) break; if (sp > XB_SPIN_CAP) { atomicAdd(&bar[XB_TMO], 1u); break; } }
  }
  nloc = mine > 0u ? mine : 1u; nx = cnt > 0u ? cnt : 1u;
}
DI void xcd_barrier(const XcdBarrier& b) {
  asm volatile("s_waitcnt vmcnt(0)" ::: "memory");
  __syncthreads();
  if (threadIdx.x == 0) {
    unsigned* bar = b.bar;
    __builtin_amdgcn_s_waitcnt(0);
    unsigned nloc = b.st[0], nx = b.st[1];
    if (nloc == 0u) { xcd_barrier_complete(bar, b.x, nloc, nx); b.st[0] = nloc; b.st[1] = nx; }
    const unsigned old = xb_add(&bar[XB_XSUB(b.x)], 1u);
    const unsigned gen = old / nloc;
    if (old + 1u == (gen + 1u) * nloc) {
      __builtin_amdgcn_fence(__ATOMIC_RELEASE, "agent");
      asm volatile("s_waitcnt vmcnt(0)" ::: "memory");
      const unsigned og = xb_add(&bar[XB_TOP], 1u);
      const unsigned tg = og / nx;
      if (og + 1u == (tg + 1u) * nx) xb_add(&bar[XB_TOPGEN], 1u);
      else XB_SPIN(xb_ld(&bar[XB_TOPGEN]) == tg, bar);
      __builtin_amdgcn_fence(__ATOMIC_ACQUIRE, "agent");
      xb_add(&bar[XB_XGEN(b.x)], 1u);
      asm volatile("s_waitcnt vmcnt(0)" ::: "memory");
    } else {
      XB_SPIN(xb_ld(&bar[XB_XGEN(b.x)]) == gen, bar);
      __builtin_amdgcn_fence(__ATOMIC_ACQUIRE, "agent");
      asm volatile("s_waitcnt vmcnt(0)" ::: "memory");
    }
  }
  __syncthreads();
}

DI void run_phase(const P* __restrict__ gp, int ph, char* smem) {
  const P& p = *gp;
  if (ph == 0) { prep_phase(gp, smem); return; }
  if (ph == NPH - 1) { norm_phase(gp, 0, 0, false, true); return; }
  const int l = (ph - 1) >> 3, s = (ph - 1) & 7;
  const bool even = !(l & 1);
  const u16* W = uni(p.wt) + (size_t)l * LW;
  const u16* hnp = uni(p.hn); const u16* projp = uni(p.proj);
  switch (s) {
    case 0: norm_phase(gp, l, 0, l == 0, false); break;
    case 1: gemm_phase<EPI_PROJ>(gp, l, smem, hnp, 1024, W + WO_IN, 1024, 1024, 288, even ? 29 : 23, 0); break;
    case 2: mixer_phase(gp, l, smem); break;
    case 3: finalize_phase(gp, l); break;
    case 4: gemm_phase<EPI_RES>(gp, l, smem, hnp, 1024, W + WO_OUT, 1024, 1024, 288, 8, 2); break;
    case 5: norm_phase(gp, l, 1, false, false); break;
    case 6: gemm_phase<EPI_FFN>(gp, l, smem, hnp, 1024, W + WO_UP, 1024, 1024, 312, 44, 0); break;
    case 7: gemm_phase<EPI_RES>(gp, l, smem, projp, 2816, W + WO_DN, 2816, 2816, 288, 8, 5); break;
  }
}

__global__ void __launch_bounds__(256, 2) mk(P p, P* gpmem, int ph0, int ph1) {
  __shared__ __attribute__((aligned(16))) char smem[SMEM_BYTES];
  const P* gp = &p;
  if (ph1 - ph0 > 1) {
    cg::grid_group grid = cg::this_grid();
    volatile LAS unsigned* xst = (volatile LAS unsigned*)(smem + SMEM_BYTES - 32);
    if (threadIdx.x == 0) { xst[0] = 0u; xst[1] = 0u; }
    __syncthreads();
    const XcdBarrier xbar = xcd_barrier_post(p.bar, xst);
    for (int ph = ph0; ph < ph1; ++ph) {
      run_phase(gp, ph, smem);
      if (ph + 1 < ph1) { if (ph == ph0) grid.sync(); else xcd_barrier(xbar); }
    }
  } else {
    run_phase(gp, ph0, smem);
  }
}

extern "C" void kernel_launch(void* const* d_in, const int* in_sizes, int n_in, void* d_out, int out_size, void* d_ws, size_t ws_size,
                              hipStream_t stream) {
  P p{};
  const float** f = (const float**)&p;
  for (int i = 0; i < 31; ++i) f[i] = (const float*)d_in[i];
  p.out = (float*)d_out;
  char* ws = (char*)d_ws;
  size_t off = 0;
  p.hn = (u16*)(ws + off); off += (size_t)NT_ * 1024 * 2;
  p.proj = (u16*)(ws + off); off += (size_t)NT_ * EVN * 2;
  p.ot1 = (u16*)(ws + off); off += (size_t)NT_ * 512 * 2;
  p.wt = (u16*)(ws + off); off += 4 * LW * 2;
  p.mods = (float*)(ws + off); off += 4 * 9 * 6144 * 4;
  p.rope = (float*)(ws + off); off += 64 * 16 * 2 * 4;
  P* gp = (P*)(ws + off); off += 4096;
  p.cnt = (int*)(ws + off); off += 256;
  p.flags = (int*)(ws + off); off += 8 * 8320 * 4;
  off = (off + 255) & ~(size_t)255;
  p.ring = ws + off; off += (size_t)128 * RING * SLOT_BYTES;
  p.bar = (unsigned*)(ws + off); off += XCD_BAR_WORDS * 4;
  static int grid_blocks = 0;
  if (!grid_blocks) {
    int dev = 0, cus = 0, per_cu = 0;
    hipGetDevice(&dev);
    hipDeviceGetAttribute(&cus, hipDeviceAttributeMultiprocessorCount, dev);
    hipOccupancyMaxActiveBlocksPerMultiprocessor(&per_cu, mk, 256, 0);
    if (per_cu < 1) per_cu = 1;
    if (per_cu > 2) per_cu = 2;
    grid_blocks = cus * per_cu;
  }
#if MK_MULTI
  for (int ph = 0; ph < NPH; ++ph) {
    int a = ph, b = ph + 1;
    hipLaunchKernelGGL(mk, dim3(grid_blocks), dim3(256), 0, stream, p, gp, a, b);
  }
#else
  hipMemsetAsync(p.bar, 0, XCD_BAR_WORDS * 4, stream);
  int ph0 = 0, ph1 = NPH;
  void* args[] = {&p, &gp, &ph0, &ph1};
  hipError_t e = hipLaunchCooperativeKernel((void*)mk, dim3(grid_blocks), dim3(256), args, 0, stream);
  if (e != hipSuccess) fprintf(stderr, "cooperative launch failed: %s (grid %d)\n", hipGetErrorString(e), grid_blocks);
#endif
}
```

```cpp
#include <hip/hip_runtime.h>
#include <hip/hip_cooperative_groups.h>
#include <cstdio>
namespace cg = cooperative_groups;

#ifndef MK_MULTI
#define MK_MULTI 0
#endif

#define DI __device__ __forceinline__
#define DN __device__ __noinline__
typedef unsigned short u16;
typedef __attribute__((ext_vector_type(8))) short bf16x8;
typedef __attribute__((ext_vector_type(4))) short s16x4;
typedef __attribute__((ext_vector_type(16))) float f32x16;
#define MFMA(a, b, c) __builtin_amdgcn_mfma_f32_32x32x16_bf16((a), (b), (c), 0, 0, 0)

static constexpr int NP_ = 4096, NT_ = 36864;
static constexpr int EVN = 3616, ODN = 2848;
static constexpr size_t OFF_AK = 37748736, OFF_AV = 41943040, OFF_SB = 46137344, OFF_CK = 48234496, OFF_CV = 49283072, OFF_SD = 50331648;
static constexpr size_t LW = 13500416, WO_UP = 0, WO_DN = 5767168, WO_IN = 8650752, WO_OUT = 12451840;
static constexpr int NPH = 34;
static constexpr int SMEM_BYTES = 80 * 1024;

struct P {
  const float *x_prompt, *x_sample, *cache_a_k, *cache_a_v, *state_b, *cache_c_k, *cache_c_v, *state_d, *c, *c_ctx, *ada_w, *ada_b,
      *norm1_g, *norm2_g, *ffn_up, *ffn_conv, *ffn_down, *ev_w_in, *ev_w_out, *a_rpb, *b_w_g2, *b_b_g, *b_norm_g, *od_w_in, *od_w_out,
      *c_sink, *d_conv, *d_a_log, *d_dt_bias, *d_norm_g, *final_g;
  float* out;
  u16 *hn, *proj, *ot1, *wt;
  float *mods, *rope;
  int* cnt;
  int* flags;
  char* ring;
  unsigned* bar;
};

DI u16 f2bf(float x) { unsigned u = __float_as_uint(x); u += 0x7fffu + ((u >> 16) & 1u); return (u16)(u >> 16); }
DI float bf2f(u16 b) { return __uint_as_float(((unsigned)b) << 16); }
DI int crow(int i, int h) { return (i & 3) + 8 * (i >> 2) + 4 * h; }
template <int S> DI bf16x8 packs(const f32x16& x) {
  bf16x8 v;
#pragma unroll
  for (int j = 0; j < 8; ++j) v[j] = (short)f2bf(x[8 * S + j]);
  return v;
}
DI bf16x8 ld2x4(const u16* p) {
  s16x4 lo = *(const s16x4*)p, hi = *(const s16x4*)(p + 8);
  return __builtin_shufflevector(lo, hi, 0, 1, 2, 3, 4, 5, 6, 7);
}
DI float siluf(float x) { return x / (1.f + __expf(-x)); }
DI int opq(int x) { asm volatile("" : "+v"(x)); return x; }
DI float shx(float v, int lane, int o) { return __int_as_float(__builtin_amdgcn_ds_bpermute((lane ^ o) << 2, __float_as_int(v))); }
template <class T> DI T* uni(T* q) { return q; }
DI void zero16(f32x16& a) {
#pragma unroll
  for (int i = 0; i < 16; ++i) a[i] = 0.f;
}

DI void prep_phase(const P* __restrict__ gp, char* smem) {
  const P& p = *gp;
  int tid_ = threadIdx.x; asm volatile("" : "+v"(tid_)); const int tid = tid_;
  const int NWT = 4 * (1408 + 704 + 256) + 2 * (928 + 736);
  const int NADA = 384;
  const int total = NWT + NADA + 1;
  for (int item = blockIdx.x; item < total; item += gridDim.x) {
    if (item < NWT) {
      int rem = item; const float* src = nullptr; u16* dst = nullptr; int K = 0, N = 0, NPd = 0;
      for (int l = 0; l < 4; ++l) {
        const int jj = l >> 1; const bool ev = !(l & 1);
        const int nin = ev ? 928 : 736;
        if (rem < 1408) { src = p.ffn_up + (size_t)l * 1024 * 5632; dst = p.wt + l * LW + WO_UP; K = 1024; N = 5632; NPd = 5632; break; }
        rem -= 1408;
        if (rem < 704) { src = p.ffn_down + (size_t)l * 2816 * 1024; dst = p.wt + l * LW + WO_DN; K = 2816; N = 1024; NPd = 1024; break; }
        rem -= 704;
        if (rem < nin) { src = ev ? p.ev_w_in + (size_t)jj * 1024 * EVN : p.od_w_in + (size_t)jj * 1024 * ODN; dst = p.wt + l * LW + WO_IN; K = 1024; N = ev ? EVN : ODN; NPd = ev ? 3712 : 2944; break; }
        rem -= nin;
        if (rem < 256) { src = (ev ? p.ev_w_out : p.od_w_out) + (size_t)jj * 1024 * 1024; dst = p.wt + l * LW + WO_OUT; K = 1024; N = 1024; NPd = 1024; break; }
        rem -= 256;
      }
      const int ntn = NPd >> 6;
      const int tk = rem / ntn, tn = rem - tk * ntn;
      const int scol0 = (N == 5632) ? ((tn & 1) * 2816 + (tn >> 1) * 64) : tn * 64;
      float* T = (float*)smem;
      __syncthreads();
#pragma unroll
      for (int i = 0; i < 16; ++i) {
        const int k = i * 4 + (tid >> 6), n = tid & 63;
        const int gn = scol0 + n;
        T[k * 65 + n] = (gn < N) ? src[(size_t)(tk * 64 + k) * N + gn] : 0.f;
      }
      __syncthreads();
#pragma unroll
      for (int i = 0; i < 2; ++i) {
        const int q = tid + 256 * i; const int n = q & 63, kc = q >> 6;
        const int pn = tn * 64 + n; const int nt32 = pn >> 5, rr = pn & 31;
        const int kstep = tk * 4 + (kc >> 1), hh = kc & 1;
        bf16x8 w;
#pragma unroll
        for (int j = 0; j < 8; ++j) w[j] = (short)f2bf(T[(kc * 8 + j) * 65 + n]);
        *(bf16x8*)(dst + ((size_t)(nt32 * (K >> 4) + kstep) * 64 + hh * 32 + rr) * 8) = w;
      }
    } else if (item < NWT + NADA) {
      const int it = item - NWT; const int l = it / 96, cgp = it - l * 96; const int n0 = cgp * 64;
      float* sc = (float*)smem;
      float* red = sc + 9 * 1024;
      __syncthreads();
      for (int idx = tid; idx < 9 * 1024; idx += 256) {
        const int ci = idx >> 10, k = idx & 1023;
        const float x = ci < 8 ? p.c[ci * 1024 + k] : p.c_ctx[k];
        sc[idx] = x / (1.f + expf(-x));
      }
      __syncthreads();
      const int wave = tid >> 6, lane = tid & 63;
      float acc[9];
#pragma unroll
      for (int ci = 0; ci < 9; ++ci) acc[ci] = 0.f;
      const float* wp = p.ada_w + ((size_t)l * 1024 + wave * 256) * 6144 + n0 + lane;
#pragma unroll 8
      for (int k = 0; k < 256; ++k) {
        const float wv = wp[(size_t)k * 6144];
#pragma unroll
        for (int ci = 0; ci < 9; ++ci) acc[ci] += sc[ci * 1024 + wave * 256 + k] * wv;
      }
#pragma unroll
      for (int ci = 0; ci < 9; ++ci) red[(wave * 9 + ci) * 64 + lane] = acc[ci];
      __syncthreads();
      for (int idx = tid; idx < 576; idx += 256) {
        const int ci = idx >> 6, col = idx & 63;
        const float s = red[(0 * 9 + ci) * 64 + col] + red[(1 * 9 + ci) * 64 + col] + red[(2 * 9 + ci) * 64 + col] + red[(3 * 9 + ci) * 64 + col];
        p.mods[(size_t)(l * 9 + ci) * 6144 + n0 + col] = s + p.ada_b[l * 6144 + n0 + col];
      }
    } else {
      if (tid < 8) p.cnt[tid] = 0;
      for (int i = tid; i < 8 * 8320; i += 256) p.flags[i] = 0;
      for (int idx = tid; idx < 1024; idx += 256) {
        const int pos = idx >> 4, fi = idx & 15;
        const float inv = powf(10000.f, -(float)fi / 16.f);
        const float ang = (float)pos * inv;
        p.rope[idx * 2] = cosf(ang); p.rope[idx * 2 + 1] = sinf(ang);
      }
    }
  }
}

DI void norm_phase(const P* __restrict__ gp, int l, int which, bool first, bool fin) {
  const P& p = *gp;
  int tid_ = threadIdx.x; asm volatile("" : "+v"(tid_)); const int tid = tid_, lane = tid & 63, wave = tid >> 6;
  for (int item = blockIdx.x; item < NT_ / 4; item += gridDim.x) {
    const int tok = item * 4 + wave;
    const float* src = first ? (tok < NP_ ? p.x_prompt + (size_t)tok * 1024 : p.x_sample + (size_t)(tok - NP_) * 1024) : p.out + (size_t)tok * 1024;
    float4 v[4];
    float ss = 0.f;
#pragma unroll
    for (int i = 0; i < 4; ++i) { v[i] = ((const float4*)src)[lane + 64 * i]; ss += v[i].x * v[i].x + v[i].y * v[i].y + v[i].z * v[i].z + v[i].w * v[i].w; }
#pragma unroll
    for (int o = 32; o >= 1; o >>= 1) ss += shx(ss, lane, o);
    const float rstd = rsqrtf(ss * (1.f / 1024.f) + 1e-6f);
    if (fin) {
#pragma unroll
      for (int i = 0; i < 4; ++i) {
        const float4 g = ((const float4*)p.final_g)[lane + 64 * i];
        float4 y; y.x = v[i].x * rstd * g.x; y.y = v[i].y * rstd * g.y; y.z = v[i].z * rstd * g.z; y.w = v[i].w * rstd * g.w;
        ((float4*)(p.out + (size_t)tok * 1024))[lane + 64 * i] = y;
      }
    } else {
      const int ci = tok < NP_ ? 8 : (tok - NP_) >> 12;
      const float* md = p.mods + (size_t)(l * 9 + ci) * 6144 + which * 3072;
      const float* gp = (which ? p.norm2_g : p.norm1_g) + l * 1024;
#pragma unroll
      for (int i = 0; i < 4; ++i) {
        const float4 g = ((const float4*)gp)[lane + 64 * i];
        const float4 sh = ((const float4*)md)[lane + 64 * i];
        const float4 sc = ((const float4*)(md + 1024))[lane + 64 * i];
        ushort4 o;
        o.x = f2bf(v[i].x * rstd * g.x * (1.f + sc.x) + sh.x);
        o.y = f2bf(v[i].y * rstd * g.y * (1.f + sc.y) + sh.y);
        o.z = f2bf(v[i].z * rstd * g.z * (1.f + sc.z) + sh.z);
        o.w = f2bf(v[i].w * rstd * g.w * (1.f + sc.w) + sh.w);
        ((ushort4*)(p.hn + (size_t)tok * 1024))[lane + 64 * i] = o;
        if (first) ((float4*)(p.out + (size_t)tok * 1024))[lane + 64 * i] = v[i];
      }
    }
  }
}

DI uint4 ldsel(const u16* pv, const u16* safe, unsigned ok) {
  uint4 t = *(const uint4*)(ok ? pv : safe);
  if (!ok) { t.x = 0; t.y = 0; t.z = 0; t.w = 0; }
  return t;
}
enum { EPI_PROJ = 0, EPI_RES = 1, EPI_FFN = 2 };

template <int EPI>
DI void gemm_phase(const P* __restrict__ gp, int l, char* smem, const u16* __restrict__ A, int lda, const u16* __restrict__ B, int ldb, int K, int MT,
                   int NTn, int gsel) {
  const P& p = *gp;
  u16* As = (u16*)smem;
  int tid_ = threadIdx.x; asm volatile("" : "+v"(tid_)); const int tid = tid_, lane = tid & 63, wave = tid >> 6, r = lane & 31, h = lane >> 5;
  const int KT = K >> 6;
  const bool even = !(l & 1); const int jj = l >> 1;
  const int ntiles = MT * NTn;
  const int nlb = gridDim.x >> 3, xcd = blockIdx.x & 7, lb = blockIdx.x >> 3;
  for (int it = 0;; ++it) {
    const int g = (it * 8 + xcd) * nlb + lb;
    if (g >= ntiles) break;
    const int SM = nlb >> 3;
    const int band = g / (SM * NTn); const int rem = g - band * SM * NTn;
    const int nt = rem / SM, mt = band * SM + (rem - nt * SM);
    int seqbase = 0, L = 0, tin0 = 0;
    if (EPI == EPI_FFN) {
      if (mt < 48) { const int sq = mt / 3; L = 256; seqbase = sq * 256; tin0 = (mt - sq * 3) * 126; }
      else { const int m2 = mt - 48; const int sq = m2 / 33; L = 4096; seqbase = NP_ + sq * 4096; tin0 = (m2 - sq * 33) * 126; }
    }
    const int row0 = tid >> 3, kc0 = (tid & 7) * 8;
    const long arow0 = (EPI == EPI_FFN) ? (long)seqbase + tin0 - 1 + row0 : (long)mt * 128 + row0;
    const u16* abase = A + arow0 * lda + kc0;
    unsigned avalid = 0;
#pragma unroll
    for (int i = 0; i < 4; ++i) {
      if (EPI == EPI_FFN) { const int ts = tin0 - 1 + row0 + 32 * i; if (ts >= 0 && ts < L) avalid |= 1u << i; }
      else avalid |= 1u << i;
    }
    const u16* bb0 = B + ((size_t)((nt * 4 + wave) * (K >> 4)) * 64 + lane) * 8;
    f32x16 acc[2][2];
#pragma unroll
    for (int a = 0; a < 2; ++a)
#pragma unroll
      for (int b = 0; b < 2; ++b) zero16(acc[a][b]);
#define GLD_A(i, ko) ldsel(abase + (size_t)(32 * (i)) * lda + (ko), A, (avalid >> (i)) & 1u)
#define GLD_BF(dst, kt_) { const u16* q_ = bb0 + (size_t)(kt_) * 2048; \
      dst[0] = *(const bf16x8*)(q_); dst[1] = *(const bf16x8*)(q_ + 512); dst[2] = *(const bf16x8*)(q_ + 1024); dst[3] = *(const bf16x8*)(q_ + 1536); }
    uint4 ra0 = GLD_A(0, 0), ra1 = GLD_A(1, 0), ra2 = GLD_A(2, 0), ra3 = GLD_A(3, 0);
    uint4 sa0 = GLD_A(0, 64), sa1 = GLD_A(1, 64), sa2 = GLD_A(2, 64), sa3 = GLD_A(3, 64);
    bf16x8 bc[4], bn[4];
    GLD_BF(bc, 0);
    GLD_BF(bn, 1);
#define LSTORE(buf, A0, A1, A2, A3) { \
      u16* ad = As + (buf) * 9216 + row0 * 72 + kc0; \
      *(uint4*)(ad) = A0; *(uint4*)(ad + 32 * 72) = A1; *(uint4*)(ad + 64 * 72) = A2; *(uint4*)(ad + 96 * 72) = A3; }
#define COMPUTE(buf, BF, KN) { \
      const u16* Ab = As + (buf) * 9216 + r * 72 + h * 8; \
      const bool more_ = (KN) < KT; const u16* q_ = bb0 + (size_t)(KN) * 2048; \
      _Pragma("unroll") for (int ks = 0; ks < 4; ++ks) { \
        const bf16x8 a0 = *(const bf16x8*)(Ab + ks * 16); \
        const bf16x8 a1 = *(const bf16x8*)(Ab + 32 * 72 + ks * 16); \
        const bf16x8 a2 = *(const bf16x8*)(Ab + 64 * 72 + ks * 16); \
        const bf16x8 a3 = *(const bf16x8*)(Ab + 96 * 72 + ks * 16); \
        acc[0][0] = MFMA(a0, BF[ks], acc[0][0]); acc[0][1] = MFMA(a1, BF[ks], acc[0][1]); \
        acc[1][0] = MFMA(a2, BF[ks], acc[1][0]); acc[1][1] = MFMA(a3, BF[ks], acc[1][1]); \
        if (more_) BF[ks] = *(const bf16x8*)(q_ + ks * 512); } }
    LSTORE(0, ra0, ra1, ra2, ra3);
    ra0 = GLD_A(0, 128); ra1 = GLD_A(1, 128); ra2 = GLD_A(2, 128); ra3 = GLD_A(3, 128);
    __syncthreads();
    for (int kt = 0; kt < KT; kt += 2) {
      COMPUTE(0, bc, kt + 2);
      LSTORE(1, sa0, sa1, sa2, sa3);
      if (kt + 3 < KT) {
        const int ko = (kt + 3) * 64;
        sa0 = GLD_A(0, ko); sa1 = GLD_A(1, ko); sa2 = GLD_A(2, ko); sa3 = GLD_A(3, ko);
      }
      __syncthreads();
      COMPUTE(1, bn, kt + 3);
      if (kt + 2 < KT) {
        LSTORE(0, ra0, ra1, ra2, ra3);
        if (kt + 4 < KT) {
          const int ko = (kt + 4) * 64;
          ra0 = GLD_A(0, ko); ra1 = GLD_A(1, ko); ra2 = GLD_A(2, ko); ra3 = GLD_A(3, ko);
        }
      }
      __syncthreads();
    }
    if (EPI == EPI_PROJ) {
      const int N = even ? EVN : ODN;
#pragma unroll
      for (int tm = 0; tm < 2; ++tm)
#pragma unroll
        for (int tn = 0; tn < 2; ++tn) {
          const int col = nt * 128 + wave * 32 + r;
          if (col < N) {
#pragma unroll
            for (int i = 0; i < 16; ++i) {
              const int row = mt * 128 + (tm * 2 + tn) * 32 + crow(i, h);
              const float v = acc[tm][tn][i];
              p.proj[(size_t)row * N + col] = f2bf(v);
              if (row < NP_) {
                const int b = row >> 8, t = row & 255, d = col & 63;
                if (even) {
                  if (col >= 512 && col < 1536) {
                    const int wh = (col - 512) >> 9, hh = ((col - 512) >> 6) & 7;
                    p.out[(wh ? OFF_AV : OFF_AK) + ((size_t)(((b * 2 + jj) * 8 + hh) * 256 + t)) * 64 + d] = v;
                  }
                } else {
                  if (col >= 512 && col < 768) {
                    const int wh = (col - 512) >> 7, kv = ((col - 512) >> 6) & 1;
                    p.out[(wh ? OFF_CV : OFF_CK) + ((size_t)(((b * 2 + jj) * 2 + kv) * 256 + t)) * 64 + d] = v;
                  }
                }
              }
            }
          }
        }
    } else if (EPI == EPI_RES) {
#pragma unroll
      for (int tm = 0; tm < 2; ++tm)
#pragma unroll
        for (int tn = 0; tn < 2; ++tn) {
          const int col = nt * 128 + wave * 32 + r;
#pragma unroll
          for (int i = 0; i < 16; ++i) {
            const int row = mt * 128 + (tm * 2 + tn) * 32 + crow(i, h);
            const int ci = row < NP_ ? 8 : (row - NP_) >> 12;
            const float g = p.mods[(size_t)(l * 9 + ci) * 6144 + gsel * 1024 + col];
            float* xp = p.out + (size_t)row * 1024 + col;
            *xp = *xp + g * acc[tm][tn][i];
          }
        }
    } else {
      __syncthreads();
      float* U = (float*)smem;
#pragma unroll
      for (int tm = 0; tm < 2; ++tm)
#pragma unroll
        for (int tn = 0; tn < 2; ++tn)
#pragma unroll
          for (int i = 0; i < 16; ++i) U[((tm * 2 + tn) * 32 + crow(i, h)) * 132 + wave * 32 + r] = acc[tm][tn][i];
      __syncthreads();
      const float* cw = p.ffn_conv + (size_t)l * 3 * 5632;
      const int f = tid & 63, rg = tid >> 6; const int fg = nt * 64 + f;
      const float wa0 = cw[fg], wa1 = cw[5632 + fg], wa2 = cw[2 * 5632 + fg];
      const float wg0 = cw[2816 + fg], wg1 = cw[5632 + 2816 + fg], wg2 = cw[2 * 5632 + 2816 + fg];
      u16* act = p.proj;
      {
        const int rbeg = 1 + 32 * rg, rend = rg == 3 ? 126 : 32 * rg + 32;
        float ap = U[(rbeg - 1) * 132 + f], ac = U[rbeg * 132 + f];
        float gp_ = U[(rbeg - 1) * 132 + 64 + f], gc = U[rbeg * 132 + 64 + f];
        for (int rr = rbeg; rr <= rend; ++rr) {
          const int ts = tin0 - 1 + rr;
          if (ts >= L) break;
          const float an = U[(rr + 1) * 132 + f], gn = U[(rr + 1) * 132 + 64 + f];
          const float a = wa0 * ap + wa1 * ac + wa2 * an;
          const float g = wg0 * gp_ + wg1 * gc + wg2 * gn;
          act[(size_t)(seqbase + ts) * 2816 + fg] = f2bf(a * siluf(g));
          ap = ac; ac = an; gp_ = gc; gc = gn;
        }
      }
      __syncthreads();
    }
  }
}

template <int MODE>
DI void attn_item(const P* __restrict__ gp, int jj, int it, char* smem) {
  const P& p = *gp;
  const u16* projp = uni(p.proj); u16* hnp = uni(p.hn); const float* ropep = uni(p.rope);
  u16* Ks = (u16*)smem; u16* Vt = Ks + 64 * 72; float* rpb_s = (float*)(Vt + 64 * 72);
  int tid_ = threadIdx.x; asm volatile("" : "+v"(tid_)); const int tid = tid_, lane = tid & 63, wave = tid >> 6, r = lane & 31, h = lane >> 5;
  constexpr bool EVENL = (MODE == 0 || MODE == 1);
  constexpr bool LAT = (MODE == 1 || MODE == 3);
  constexpr int PS = EVENL ? EVN : ODN;
  int b, hq, qb, tokbase;
  if (!LAT) { b = it >> 4; hq = (it >> 1) & 7; qb = it & 1; tokbase = b * 256; }
  else { b = it >> 8; hq = (it >> 5) & 7; qb = it & 31; tokbase = NP_ + b * 4096; }
  const int hk = EVENL ? hq : (hq >> 2);
  const int kcol = 512 + hk * 64, vcol = (EVENL ? 1024 : 640) + hk * 64, qcol = hq * 64;
  const int tq = qb * 128 + wave * 32 + r;
  const size_t qtok = (size_t)tokbase + tq;
  __syncthreads();
  if (MODE == 1) { for (int i = tid; i < 465; i += 256) rpb_s[i] = p.a_rpb[(size_t)(jj * 8 + hq) * 465 + i]; }
  bf16x8 qf[4];
#pragma unroll
  for (int s = 0; s < 4; ++s) qf[s] = *(const bf16x8*)(projp + qtok * PS + qcol + 16 * s + 8 * h);
  if (MODE == 3) {
    const int prow = tq >> 6, pcol = tq & 63;
#pragma unroll
    for (int half = 0; half < 2; ++half) {
      const int pos = half ? pcol : prow;
#pragma unroll
      for (int j = 0; j < 8; ++j) {
        const float cs = ropep[(pos * 16 + 8 * h + j) * 2], sn = ropep[(pos * 16 + 8 * h + j) * 2 + 1];
        const float x1 = bf2f((u16)qf[2 * half][j]), x2 = bf2f((u16)qf[2 * half + 1][j]);
        qf[2 * half][j] = (short)f2bf(x1 * cs - x2 * sn);
        qf[2 * half + 1][j] = (short)f2bf(x1 * sn + x2 * cs);
      }
    }
  }
  float m_run = -1e30f, l_run = 0.f;
  if (MODE == 2 || MODE == 3) { m_run = p.c_sink[jj * 8 + hq]; l_run = h == 0 ? 1.f : 0.f; }
  f32x16 ot[2]; zero16(ot[0]); zero16(ot[1]);
  int loc0 = 0, nloc = 0;
  if (MODE == 1) {
    const int qi0 = 2 * qb;
    const int rlo = min(max(qi0 - 4, 0), 56), rhi = min(max(qi0 + 1 - 4, 0), 56) + 7;
    loc0 = rlo; nloc = rhi - rlo + 1;
  } else if (MODE == 3) {
    loc0 = max(0, 2 * qb - 2); nloc = min(63, 2 * qb + 3) - loc0 + 1;
  }
  const int qi = tq >> 6, qw = tq & 63;
  const int r0w = min(max(qi - 4, 0), 56), c0w = min(max(qw - 8, 0), 48);
  const int key = tid >> 2, seg = tid & 3;
  for (int kb = 0; kb < 4 + nloc; ++kb) {
    const bool isctx = kb < 4;
    const int blk = isctx ? kb : loc0 + kb - 4;
    __syncthreads();
    {
      float kf[16], vf[16];
      if (LAT && isctx) {
        const float* kc = (MODE == 1) ? p.cache_a_k + ((size_t)((b * 2 + jj) * 8 + hk)) * 16384 : p.cache_c_k + ((size_t)((b * 2 + jj) * 2 + hk)) * 16384;
        const float* vc = (MODE == 1) ? p.cache_a_v + ((size_t)((b * 2 + jj) * 8 + hk)) * 16384 : p.cache_c_v + ((size_t)((b * 2 + jj) * 2 + hk)) * 16384;
        const float4* kp4 = (const float4*)(kc + (size_t)(blk * 64 + key) * 64 + seg * 16);
        const float4* vp4 = (const float4*)(vc + (size_t)(blk * 64 + key) * 64 + seg * 16);
#pragma unroll
        for (int e = 0; e < 4; ++e) {
          const float4 a = kp4[e], c = vp4[e];
          kf[4 * e] = a.x; kf[4 * e + 1] = a.y; kf[4 * e + 2] = a.z; kf[4 * e + 3] = a.w;
          vf[4 * e] = c.x; vf[4 * e + 1] = c.y; vf[4 * e + 2] = c.z; vf[4 * e + 3] = c.w;
        }
      } else {
        const u16* rowp = projp + ((size_t)tokbase + blk * 64 + key) * PS;
        const bf16x8 k0 = *(const bf16x8*)(rowp + kcol + seg * 16), k1 = *(const bf16x8*)(rowp + kcol + seg * 16 + 8);
        const bf16x8 v0 = *(const bf16x8*)(rowp + vcol + seg * 16), v1 = *(const bf16x8*)(rowp + vcol + seg * 16 + 8);
#pragma unroll
        for (int e = 0; e < 8; ++e) { kf[e] = bf2f((u16)k0[e]); kf[8 + e] = bf2f((u16)k1[e]); vf[e] = bf2f((u16)v0[e]); vf[8 + e] = bf2f((u16)v1[e]); }
        if (MODE == 3) {
          const bf16x8 p0 = *(const bf16x8*)(rowp + kcol + (seg ^ 1) * 16), p1 = *(const bf16x8*)(rowp + kcol + (seg ^ 1) * 16 + 8);
          const int pos = (seg & 2) ? key : blk;
#pragma unroll
          for (int e = 0; e < 16; ++e) {
            const float pr = bf2f((u16)(e < 8 ? p0[e & 7] : p1[e & 7]));
            const float cs = ropep[(pos * 16 + e) * 2], sn = ropep[(pos * 16 + e) * 2 + 1];
            kf[e] = (seg & 1) ? (pr * sn + kf[e] * cs) : (kf[e] * cs - pr * sn);
          }
        }
      }
      bf16x8 o0, o1;
#pragma unroll
      for (int e = 0; e < 8; ++e) { o0[e] = (short)f2bf(kf[e]); o1[e] = (short)f2bf(kf[8 + e]); }
      *(bf16x8*)(Ks + key * 72 + seg * 16) = o0;
      *(bf16x8*)(Ks + key * 72 + seg * 16 + 8) = o1;
#pragma unroll
      for (int e = 0; e < 16; ++e) Vt[(seg * 16 + e) * 72 + key] = f2bf(vf[e]);
    }
    __syncthreads();
    bool active = true;
    if (MODE == 1 && !isctx) active = (blk >= r0w && blk < r0w + 8);
    if (active) {
      f32x16 st[2]; zero16(st[0]); zero16(st[1]);
#pragma unroll
      for (int kt = 0; kt < 2; ++kt)
#pragma unroll
        for (int s = 0; s < 4; ++s) {
          const bf16x8 a = *(const bf16x8*)(Ks + (kt * 32 + r) * 72 + 16 * s + 8 * h);
          st[kt] = MFMA(a, qf[s], st[kt]);
        }
      float mx = m_run;
#pragma unroll
      for (int kt = 0; kt < 2; ++kt)
#pragma unroll
        for (int i = 0; i < 16; ++i) {
          float s = st[kt][i] * 0.125f;
          const int kk = kt * 32 + crow(i, h);
          if (MODE == 1 && !isctx) {
            const bool ok = (kk >= c0w && kk < c0w + 16);
            s = ok ? s + rpb_s[(blk - qi + 7) * 31 + (kk - qw + 15)] : -1e30f;
          }
          if (MODE == 3 && !isctx) {
            const int dlt = blk * 64 + kk - tq;
            s = (dlt <= 128 && dlt >= -128) ? s : -1e30f;
          }
          st[kt][i] = s;
          mx = fmaxf(mx, s);
        }
      mx = fmaxf(mx, shx(mx, lane, 32));
      const float alpha = __expf(m_run - mx);
      m_run = mx;
      float ps = 0.f;
#pragma unroll
      for (int kt = 0; kt < 2; ++kt)
#pragma unroll
        for (int i = 0; i < 16; ++i) { const float pv = __expf(st[kt][i] - mx); st[kt][i] = pv; ps += pv; }
      l_run = l_run * alpha + ps;
#pragma unroll
      for (int dt = 0; dt < 2; ++dt)
#pragma unroll
        for (int i = 0; i < 16; ++i) ot[dt][i] *= alpha;
#pragma unroll
      for (int kt = 0; kt < 2; ++kt) {
        const bf16x8 pb0 = packs<0>(st[kt]), pb1 = packs<1>(st[kt]);
#pragma unroll
        for (int dt = 0; dt < 2; ++dt) {
          const bf16x8 pa0 = ld2x4(Vt + (dt * 32 + r) * 72 + kt * 32 + 4 * h);
          const bf16x8 pa1 = ld2x4(Vt + (dt * 32 + r) * 72 + kt * 32 + 16 + 4 * h);
          ot[dt] = MFMA(pa0, pb0, ot[dt]);
          ot[dt] = MFMA(pa1, pb1, ot[dt]);
        }
      }
    }
  }
  l_run += shx(l_run, lane, 32);
  const float inv = 1.f / l_run;
  u16* dst = hnp + qtok * 1024 + qcol;
#pragma unroll
  for (int dt = 0; dt < 2; ++dt)
#pragma unroll
    for (int g4 = 0; g4 < 4; ++g4) {
      ushort4 o;
      o.x = f2bf(ot[dt][4 * g4] * inv); o.y = f2bf(ot[dt][4 * g4 + 1] * inv); o.z = f2bf(ot[dt][4 * g4 + 2] * inv); o.w = f2bf(ot[dt][4 * g4 + 3] * inv);
      *(ushort4*)(dst + dt * 32 + 8 * g4 + 4 * h) = o;
    }
}

struct ChainId { int lat, b, h, dir, T, base, nch; };
DI ChainId chain_decode(int it) {
  ChainId c; c.lat = it < 128; const int q = c.lat ? it : it - 128;
  c.b = q >> 4; c.h = (q >> 1) & 7; c.dir = q & 1; c.T = c.lat ? 4096 : 256; c.base = c.lat ? NP_ + c.b * 4096 : c.b * 256; c.nch = c.T >> 6;
  return c;
}
DI int tokof(const ChainId& c, int step, int row) { const int pp = step * 64 + row; return c.base + (c.dir ? c.T - 1 - pp : pp); }


static constexpr int RING = 4;
static constexpr int SLOT_BYTES = 53760;
DI void wait_ge(int* flag, int val, int tid) {
  if (tid < 64) {
    if (tid == 0) { while (__hip_atomic_load(flag, __ATOMIC_RELAXED, __HIP_MEMORY_SCOPE_AGENT) < val) __builtin_amdgcn_s_sleep(1); }
    __builtin_amdgcn_fence(__ATOMIC_ACQUIRE, "agent");
  }
  __syncthreads();
}
DI void publish(int* flag, int val, int tid) {
  asm volatile("s_waitcnt vmcnt(0)" ::: "memory");
  __syncthreads();
  if (tid == 0) __hip_atomic_store(flag, val, __ATOMIC_RELAXED, __HIP_MEMORY_SCOPE_AGENT);
}
typedef __attribute__((ext_vector_type(4))) unsigned u32x4;
DI void copy_out(const char* lds, char* g, int bytes, int tid) {
  for (int i = opq(tid) * 16; i < bytes; i += 256 * 16) {
    const u32x4 v = *(const u32x4*)(lds + i);
    char* dst = g + i;
    asm volatile("global_store_dwordx4 %0, %1, off sc0 sc1" :: "v"(dst), "v"(v) : "memory");
  }
}
template <int BYTES>
DI void copy_in_t(char* lds, const char* g, int tid) {
  constexpr int N = (BYTES + 4095) / 4096;
  const int t16 = opq(tid) * 16;
  uint4 v[N];
#pragma unroll
  for (int j = 0; j < N; ++j) { const int i = t16 + j * 4096; v[j] = make_uint4(0, 0, 0, 0); if (i < BYTES) v[j] = *(const uint4*)(g + i); }
#pragma unroll
  for (int j = 0; j < N; ++j) { const int i = t16 + j * 4096; if (i < BYTES) *(uint4*)(lds + i) = v[j]; }
}

template <int ROLE>
DI void gla_chain(const P* __restrict__ gp, int jj, int it, char* smem, int k0, int kstep, int fs = 0) {
  const P& p = *gp;
  const ChainId cid = chain_decode(it);
  int tid_ = threadIdx.x; asm volatile("" : "+v"(tid_)); const int tid = tid_, lane = tid & 63, wave = tid >> 6, r = lane & 31, h = lane >> 5;
  const int hh = cid.h, dir = cid.dir;
  u16* QT = (u16*)smem; u16* KT = QT + 4608; u16* KEt = KT + 4608; u16* Vt = KEt + 4608;
  float* dec = (float*)(Vt + 4608); float* GL = dec + 64; float* gq = GL + 1024; float* Ost = gq + 256;
  constexpr int IMG = 4 * 9216 + 256;
  char* slots = uni(p.ring) + (size_t)it * RING * SLOT_BYTES; int* ready = uni(p.flags) + (jj * 2 + 4 * fs) * 8320 + it * 64; int* done = uni(p.flags) + (jj * 2 + 4 * fs) * 8320 + 8192 + it;
  const int d = tid & 63, cq = tid >> 6;
  float wg[16];
#pragma unroll
  for (int rr = 0; rr < 16; ++rr) wg[rr] = p.b_w_g2[((size_t)((jj * 2 + dir) * 16 + rr)) * 512 + hh * 64 + d];
  const float bg = p.b_b_g[(jj * 2 + dir) * 512 + hh * 64 + d];
  const int vh = wave & 1;
  f32x16 S[2]; zero16(S[0]); zero16(S[1]);
  const size_t sidx = ((size_t)(((cid.b * 2 + jj) * 2 + dir) * 8 + hh)) * 4096;
  if (ROLE != 1 && wave < 2 && cid.lat) {
#pragma unroll
    for (int dt = 0; dt < 2; ++dt)
#pragma unroll
      for (int i = 0; i < 16; ++i) S[dt][i] = p.state_b[sidx + (dt * 32 + crow(i, h)) * 64 + vh * 32 + r];
  }
  for (int step_ = k0; step_ < cid.nch; step_ += kstep) {
    int step = step_;
    asm volatile("" : "+v"(step));
    if (ROLE == 1) wait_ge(done, step_ - RING + 1, tid);
    if (ROLE == 2) wait_ge(ready + step_, 1, tid);
    __syncthreads();
    if (ROLE == 2) { copy_in_t<IMG>(smem, slots + (size_t)(step_ % RING) * SLOT_BYTES, tid); __syncthreads(); if (tid == 0) __hip_atomic_store(done, step_ + 1, __ATOMIC_RELAXED, __HIP_MEMORY_SCOPE_AGENT); }
    if (ROLE != 2) {
    {
      const int c = tid >> 2, sg = tid & 3;
      const int tok = tokof(cid, step, c);
      const ushort4 gv = *(const ushort4*)(p.proj + (size_t)tok * EVN + 3072 + dir * 16 + sg * 4);
      GL[c * 16 + sg * 4] = bf2f(gv.x); GL[c * 16 + sg * 4 + 1] = bf2f(gv.y); GL[c * 16 + sg * 4 + 2] = bf2f(gv.z); GL[c * 16 + sg * 4 + 3] = bf2f(gv.w);
    }
    __syncthreads();
    float Gl[16]; float run = 0.f;
#pragma unroll
    for (int i = 0; i < 16; ++i) {
      const int c = cq * 16 + i;
      float z = bg;
#pragma unroll
      for (int rr = 0; rr < 16; ++rr) z += GL[c * 16 + rr] * wg[rr];
      const float g = (fminf(z, 0.f) - __logf(1.f + __expf(-fabsf(z)))) * (1.f / 16.f);
      run += g; Gl[i] = run;
    }
    gq[cq * 64 + d] = run;
    __syncthreads();
    float off = 0.f, tot = 0.f;
#pragma unroll
    for (int q2 = 0; q2 < 4; ++q2) { const float t = gq[q2 * 64 + d]; if (q2 < cq) off += t; tot += t; }
#pragma unroll
    for (int i = 0; i < 16; ++i) {
      const int c = cq * 16 + i;
      const int tok = tokof(cid, step, c);
      const float G = Gl[i] + off;
      const u16* rowp = p.proj + (size_t)tok * EVN + hh * 64 + d;
      const float qv = bf2f(rowp[1536]), kv = bf2f(rowp[2048]);
      const u16 vb = rowp[2560];
      QT[c * 72 + d] = f2bf(qv * 0.125f * __expf(G));
      KT[c * 72 + d] = f2bf(kv * __expf(-G));
      KEt[d * 72 + c] = f2bf(kv * __expf(tot - G));
      Vt[d * 72 + c] = vb;
    }
    if (cq == 0) dec[d] = __expf(tot);
    __syncthreads();
    }
    if (ROLE == 1) { copy_out(smem, slots + (size_t)(step_ % RING) * SLOT_BYTES, IMG, tid); publish(ready + step_, 1, tid); continue; }
    if (wave < 2) {
      f32x16 at[2][2];
#pragma unroll
      for (int a = 0; a < 2; ++a)
#pragma unroll
        for (int b2 = 0; b2 < 2; ++b2) zero16(at[a][b2]);
#pragma unroll
      for (int ks = 0; ks < 4; ++ks) {
        const bf16x8 a0 = *(const bf16x8*)(KT + r * 72 + ks * 16 + 8 * h), a1 = *(const bf16x8*)(KT + (32 + r) * 72 + ks * 16 + 8 * h);
        const bf16x8 b0 = *(const bf16x8*)(QT + r * 72 + ks * 16 + 8 * h), b1 = *(const bf16x8*)(QT + (32 + r) * 72 + ks * 16 + 8 * h);
        at[0][0] = MFMA(a0, b0, at[0][0]); at[0][1] = MFMA(a0, b1, at[0][1]);
        at[1][0] = MFMA(a1, b0, at[1][0]); at[1][1] = MFMA(a1, b1, at[1][1]);
      }
#pragma unroll
      for (int st = 0; st < 2; ++st)
#pragma unroll
        for (int ct = 0; ct < 2; ++ct)
#pragma unroll
          for (int i = 0; i < 16; ++i) { if (st * 32 + crow(i, h) > ct * 32 + r) at[st][ct][i] = 0.f; }
      f32x16 o[2]; zero16(o[0]); zero16(o[1]);
#pragma unroll
      for (int ct = 0; ct < 2; ++ct)
#pragma unroll
        for (int st = 0; st < 2; ++st) {
          const bf16x8 x0 = packs<0>(at[st][ct]), x1 = packs<1>(at[st][ct]);
          const bf16x8 pb0 = ld2x4(Vt + (vh * 32 + r) * 72 + st * 32 + 4 * h);
          const bf16x8 pb1 = ld2x4(Vt + (vh * 32 + r) * 72 + st * 32 + 16 + 4 * h);
          o[ct] = MFMA(x0, pb0, o[ct]);
          o[ct] = MFMA(x1, pb1, o[ct]);
        }
#pragma unroll
      for (int dt = 0; dt < 2; ++dt) {
        const bf16x8 xs0 = packs<0>(S[dt]), xs1 = packs<1>(S[dt]);
#pragma unroll
        for (int ct = 0; ct < 2; ++ct) {
          const bf16x8 pa0 = ld2x4(QT + (ct * 32 + r) * 72 + dt * 32 + 4 * h);
          const bf16x8 pa1 = ld2x4(QT + (ct * 32 + r) * 72 + dt * 32 + 16 + 4 * h);
          o[ct] = MFMA(pa0, xs0, o[ct]);
          o[ct] = MFMA(pa1, xs1, o[ct]);
        }
      }
#pragma unroll
      for (int dt = 0; dt < 2; ++dt)
#pragma unroll
        for (int i = 0; i < 16; ++i) S[dt][i] *= dec[dt * 32 + crow(i, h)];
#pragma unroll
      for (int ks = 0; ks < 4; ++ks) {
        const bf16x8 bv = *(const bf16x8*)(Vt + (vh * 32 + r) * 72 + ks * 16 + 8 * h);
#pragma unroll
        for (int dt = 0; dt < 2; ++dt) {
          const bf16x8 a = *(const bf16x8*)(KEt + (dt * 32 + r) * 72 + ks * 16 + 8 * h);
          S[dt] = MFMA(a, bv, S[dt]);
        }
      }
#pragma unroll
      for (int ct = 0; ct < 2; ++ct)
#pragma unroll
        for (int i = 0; i < 16; ++i) Ost[(ct * 32 + crow(i, h)) * 68 + vh * 32 + r] = o[ct][i];
    }
    __syncthreads();
    {
      const int c = tid >> 2, sg = tid & 3;
      const int tok = tokof(cid, step, c);
      u16* dst = (dir ? p.ot1 + (size_t)tok * 512 + hh * 64 : p.hn + (size_t)tok * 1024 + 512 + hh * 64) + sg * 16;
      bf16x8 w0, w1;
#pragma unroll
      for (int e = 0; e < 8; ++e) { w0[e] = (short)f2bf(Ost[c * 68 + sg * 16 + e]); w1[e] = (short)f2bf(Ost[c * 68 + sg * 16 + 8 + e]); }
      *(bf16x8*)dst = w0; *(bf16x8*)(dst + 8) = w1;
    }
  }
  if (wave < 2 && !cid.lat) {
#pragma unroll
    for (int dt = 0; dt < 2; ++dt)
#pragma unroll
      for (int i = 0; i < 16; ++i) p.out[OFF_SB + sidx + (dt * 32 + crow(i, h)) * 64 + vh * 32 + r] = S[dt][i];
  }
}

template <int ROLE>
DI void delta_chain(const P* __restrict__ gp, int jj, int it, char* smem, int k0, int kstep, int fs = 0) {
  const P& p = *gp;
  const ChainId cid = chain_decode(it);
  int tid_ = threadIdx.x; asm volatile("" : "+v"(tid_)); const int tid0 = tid_;
  const int hh = cid.h, dir = cid.dir;
  u16* Qn = (u16*)smem; u16* Kt = Qn + 4608; u16* AQK = Kt + 4608; u16* KC = AQK + 4608;
  float* Wv = (float*)(KC + 4608); float* Gs = Wv + 64 * 65; u16* Kn = (u16*)(Gs + 64); float* At = (float*)(Kn + 4608); float* Bt = At + 64 * 68;
  constexpr int IMG = 4 * 9216 + 16640 + 256;
  char* slots = uni(p.ring) + (size_t)it * RING * SLOT_BYTES; int* ready = uni(p.flags) + (jj * 2 + 1 + 4 * fs) * 8320 + it * 64; int* done = uni(p.flags) + (jj * 2 + 1 + 4 * fs) * 8320 + 8192 + it;
  const float aexp = __expf(p.d_a_log[(jj * 2 + dir) * 8 + hh]);
  const float dtb = p.d_dt_bias[(jj * 2 + dir) * 8 + hh];
  f32x16 S[2]; zero16(S[0]); zero16(S[1]);
  const size_t sidx = ((size_t)(((cid.b * 2 + jj) * 2 + dir) * 8 + hh)) * 4096;
  { const int tid = tid0, lane = tid & 63, wave = tid >> 6, r = lane & 31, h = lane >> 5;
  if (ROLE != 1 && wave < 2 && cid.lat) {
    const int vh = wave & 1;
#pragma unroll
    for (int dt = 0; dt < 2; ++dt)
#pragma unroll
      for (int i = 0; i < 16; ++i) S[dt][i] = p.state_d[sidx + (dt * 32 + crow(i, h)) * 64 + vh * 32 + r];
  }
  }
  u16* CW = (u16*)(smem + 80640);
  __syncthreads();
  for (int i = tid0; i < 576; i += 256) { const int tap = i / 192, c2 = i - tap * 192; const int wh = c2 >> 6, dd = c2 & 63;
    CW[i] = f2bf(p.d_conv[(size_t)jj * 3 * 1536 + tap * 1536 + wh * 512 + hh * 64 + dd]); }
  for (int step_ = k0; step_ < cid.nch; step_ += kstep) {
    int step = step_;
    asm volatile("" : "+v"(step));
    if (ROLE == 1) wait_ge(done, step_ - RING + 1, tid0);
    if (ROLE == 2) wait_ge(ready + step_, 1, tid0);
    __syncthreads();
    if (ROLE == 2) { copy_in_t<IMG>(smem, slots + (size_t)(step_ % RING) * SLOT_BYTES, tid0); __syncthreads(); if (tid0 == 0) __hip_atomic_store(done, step_ + 1, __ATOMIC_RELAXED, __HIP_MEMORY_SCOPE_AGENT); }
    if (ROLE != 2) {
    {const int tid = opq(tid0), lane = tid & 63, wave = __builtin_amdgcn_readfirstlane(tid >> 6), r = lane & 31, h = lane >> 5, vh = wave & 1; (void)r; (void)h; (void)vh; (void)lane;
    if (wave == 0) {
      const int tok = tokof(cid, step, lane);
      const float da = bf2f(p.proj[(size_t)tok * ODN + 2304 + dir * 8 + hh]);
      const float db = bf2f(p.proj[(size_t)tok * ODN + 2320 + dir * 8 + hh]);
      const float x = da + dtb;
      const float sp = x > 20.f ? x : __logf(1.f + __expf(x));
      float G = -aexp * sp;
#pragma unroll
      for (int o = 1; o < 64; o <<= 1) { const float t = __int_as_float(__builtin_amdgcn_ds_bpermute((lane - o) << 2, __float_as_int(G))); if (lane >= o) G += t; }
      Gs[lane] = G; Bt[lane] = 1.f / (1.f + __expf(-db));
    }
    {
      const int c = tid >> 2, sg = tid & 3;
      const int tok = tokof(cid, step, c);
      const int pos = tok - cid.base;
      const bool hp = pos > 0, hn_ = pos < cid.T - 1;
#pragma unroll 1
      for (int wh = 0; wh < 3; ++wh) {
        const int ch0 = wh * 512 + hh * 64 + sg * 16;
        const u16* cur = p.proj + (size_t)tok * ODN + 768 + ch0;
        float y[16];
        float ss = 0.f;
#pragma unroll
        for (int hf = 0; hf < 2; ++hf) {
          const bf16x8 xc = *(const bf16x8*)(cur + hf * 8);
          bf16x8 xp, xn;
#pragma unroll
          for (int e = 0; e < 8; ++e) { xp[e] = 0; xn[e] = 0; }
          if (hp) xp = *(const bf16x8*)(cur - ODN + hf * 8);
          if (hn_) xn = *(const bf16x8*)(cur + ODN + hf * 8);
#pragma unroll
          for (int e = 0; e < 8; ++e) {
            const int ch = wh * 64 + sg * 16 + hf * 8 + e;
            float v = bf2f(CW[ch]) * bf2f((u16)xp[e]) + bf2f(CW[192 + ch]) * bf2f((u16)xc[e]) + bf2f(CW[384 + ch]) * bf2f((u16)xn[e]);
            v = v / (1.f + __expf(-v));
            y[hf * 8 + e] = v; ss += v * v;
          }
        }
        ss += shx(ss, lane, 1); ss += shx(ss, lane, 2);
        const float rn = rsqrtf(ss + 1e-6f);
        if (wh == 0) {
#pragma unroll
          for (int e = 0; e < 16; ++e) Qn[c * 72 + sg * 16 + e] = f2bf(y[e] * rn * 0.125f);
        } else if (wh == 1) {
#pragma unroll
          for (int e = 0; e < 16; ++e) { const u16 kb = f2bf(y[e] * rn); Kn[c * 72 + sg * 16 + e] = kb; Kt[(sg * 16 + e) * 72 + c] = kb; }
        } else {
#pragma unroll
          for (int e = 0; e < 16; ++e) Wv[c * 65 + sg * 16 + e] = y[e];
        }
      }
    }
    }
    __syncthreads();
    {const int tid = opq(tid0), lane = tid & 63, wave = __builtin_amdgcn_readfirstlane(tid >> 6), r = lane & 31, h = lane >> 5, vh = wave & 1; (void)r; (void)h; (void)vh; (void)lane;
    if (wave < 2) {
      f32x16 akk[2], aqk[2]; zero16(akk[0]); zero16(akk[1]); zero16(aqk[0]); zero16(aqk[1]);
#pragma unroll
      for (int ks = 0; ks < 4; ++ks) {
        const bf16x8 bk = *(const bf16x8*)(Kn + (vh * 32 + r) * 72 + ks * 16 + 8 * h);
#pragma unroll
        for (int ct = 0; ct < 2; ++ct) {
          const bf16x8 ak = *(const bf16x8*)(Kn + (ct * 32 + r) * 72 + ks * 16 + 8 * h);
          const bf16x8 aq = *(const bf16x8*)(Qn + (ct * 32 + r) * 72 + ks * 16 + 8 * h);
          akk[ct] = MFMA(ak, bk, akk[ct]);
          aqk[ct] = MFMA(aq, bk, aqk[ct]);
        }
      }
      const int s = vh * 32 + r;
      const float Gss = Gs[s];
#pragma unroll
      for (int ct = 0; ct < 2; ++ct)
#pragma unroll
        for (int g4 = 0; g4 < 4; ++g4) {
          const int c0 = ct * 32 + 8 * g4 + 4 * h;
          const float4 gv4 = *(const float4*)(Gs + c0), bv4 = *(const float4*)(Bt + c0);
          float4 val;
#pragma unroll
          for (int e = 0; e < 4; ++e) {
            const int c = c0 + e;
            const float Gc = e == 0 ? gv4.x : e == 1 ? gv4.y : e == 2 ? gv4.z : gv4.w;
            const float Bc = e == 0 ? bv4.x : e == 1 ? bv4.y : e == 2 ? bv4.z : bv4.w;
            const float gam = __expf(fminf(Gc - Gss, 0.f));
            const float av = (s < c) ? akk[ct][4 * g4 + e] * Bc * gam : 0.f;
            if (e == 0) val.x = av; else if (e == 1) val.y = av; else if (e == 2) val.z = av; else val.w = av;
            AQK[c * 72 + s] = f2bf((s <= c) ? aqk[ct][4 * g4 + e] * gam : 0.f);
          }
          *(float4*)(At + s * 68 + c0) = val;
        }
    }
    }
    __syncthreads();
    {const int tid = opq(tid0), lane = tid & 63, wave = __builtin_amdgcn_readfirstlane(tid >> 6), r = lane & 31, h = lane >> 5, vh = wave & 1; (void)r; (void)h; (void)vh; (void)lane;
    if (wave < 2) {
      const bool isv = wave == 0;
      const int col = lane;
#pragma unroll 1
      for (int bi = 0; bi < 4; ++bi) {
        float acc[16];
#pragma unroll
        for (int ci = 0; ci < 16; ++ci) {
          const int c = 16 * bi + ci;
          acc[ci] = isv ? Wv[c * 65 + col] * Bt[c] : bf2f(Kn[c * 72 + col]) * Bt[c] * __expf(Gs[c]);
        }
#pragma unroll 8
        for (int s2 = 0; s2 < 16 * bi; ++s2) {
          const float xs = isv ? Wv[s2 * 65 + col] : bf2f(KC[s2 * 72 + col]);
          const float4* a4 = (const float4*)(At + s2 * 68 + 16 * bi);
#pragma unroll
          for (int q = 0; q < 4; ++q) {
            const float4 a = a4[q];
            acc[4 * q] -= a.x * xs; acc[4 * q + 1] -= a.y * xs; acc[4 * q + 2] -= a.z * xs; acc[4 * q + 3] -= a.w * xs;
          }
        }
#pragma unroll
        for (int ci = 0; ci < 16; ++ci) {
          const float x = acc[ci];
          const float* arow = At + (16 * bi + ci) * 68 + 16 * bi;
#pragma unroll
          for (int cj = ci + 1; cj < 16; ++cj) acc[cj] -= arow[cj] * x;
          if (isv) Wv[(16 * bi + ci) * 65 + col] = x; else KC[(16 * bi + ci) * 72 + col] = f2bf(x);
        }
      }
    }
    }
    __syncthreads();
    }
    if (ROLE == 1) { copy_out(smem, slots + (size_t)(step_ % RING) * SLOT_BYTES, IMG, tid0); publish(ready + step_, 1, tid0); continue; }
    {const int tid = opq(tid0), lane = tid & 63, wave = __builtin_amdgcn_readfirstlane(tid >> 6), r = lane & 31, h = lane >> 5, vh = wave & 1; (void)r; (void)h; (void)vh; (void)lane;
    if (wave < 2) {
      f32x16 kS[2], qS[2]; zero16(kS[0]); zero16(kS[1]); zero16(qS[0]); zero16(qS[1]);
#pragma unroll
      for (int dt = 0; dt < 2; ++dt) {
        const bf16x8 xs0 = packs<0>(S[dt]), xs1 = packs<1>(S[dt]);
#pragma unroll
        for (int ct = 0; ct < 2; ++ct) {
          kS[ct] = MFMA(ld2x4(KC + (ct * 32 + r) * 72 + dt * 32 + 4 * h), xs0, kS[ct]);
          kS[ct] = MFMA(ld2x4(KC + (ct * 32 + r) * 72 + dt * 32 + 16 + 4 * h), xs1, kS[ct]);
          qS[ct] = MFMA(ld2x4(Qn + (ct * 32 + r) * 72 + dt * 32 + 4 * h), xs0, qS[ct]);
          qS[ct] = MFMA(ld2x4(Qn + (ct * 32 + r) * 72 + dt * 32 + 16 + 4 * h), xs1, qS[ct]);
        }
      }
      f32x16 vn[2], o[2];
      const float Glast = Gs[63];
#pragma unroll
      for (int ct = 0; ct < 2; ++ct)
#pragma unroll
        for (int i = 0; i < 16; ++i) {
          const int c = ct * 32 + crow(i, h);
          vn[ct][i] = Wv[c * 65 + vh * 32 + r] - kS[ct][i];
          o[ct][i] = qS[ct][i] * __expf(Gs[c]);
        }
#pragma unroll
      for (int st = 0; st < 2; ++st) {
        const bf16x8 xs0 = packs<0>(vn[st]), xs1 = packs<1>(vn[st]);
#pragma unroll
        for (int ct = 0; ct < 2; ++ct) {
          o[ct] = MFMA(ld2x4(AQK + (ct * 32 + r) * 72 + st * 32 + 4 * h), xs0, o[ct]);
          o[ct] = MFMA(ld2x4(AQK + (ct * 32 + r) * 72 + st * 32 + 16 + 4 * h), xs1, o[ct]);
        }
      }
      const float dl = __expf(Glast);
#pragma unroll
      for (int st = 0; st < 2; ++st) {
        asm volatile("" ::: "memory");
#pragma unroll
        for (int i = 0; i < 16; ++i) vn[st][i] *= __expf(Glast - Gs[st * 32 + crow(i, h)]);
      }
      asm volatile("" ::: "memory");
#pragma unroll
      for (int dt = 0; dt < 2; ++dt)
#pragma unroll
        for (int i = 0; i < 16; ++i) S[dt][i] *= dl;
#pragma unroll
      for (int st = 0; st < 2; ++st) {
        const bf16x8 xs0 = packs<0>(vn[st]), xs1 = packs<1>(vn[st]);
#pragma unroll
        for (int dt = 0; dt < 2; ++dt) {
          S[dt] = MFMA(ld2x4(Kt + (dt * 32 + r) * 72 + st * 32 + 4 * h), xs0, S[dt]);
          S[dt] = MFMA(ld2x4(Kt + (dt * 32 + r) * 72 + st * 32 + 16 + 4 * h), xs1, S[dt]);
        }
      }
#pragma unroll
      for (int ct = 0; ct < 2; ++ct)
#pragma unroll
        for (int i = 0; i < 16; ++i) At[(ct * 32 + crow(i, h)) * 68 + vh * 32 + r] = o[ct][i];
    }
    }
    __syncthreads();
    {
      const int tid = opq(tid0);
      const int c = tid >> 2, sg = tid & 3;
      const int tok = tokof(cid, step, c);
      u16* dst = (dir ? p.ot1 + (size_t)tok * 512 + hh * 64 : p.hn + (size_t)tok * 1024 + 512 + hh * 64) + sg * 16;
      bf16x8 w0, w1;
#pragma unroll
      for (int e = 0; e < 8; ++e) { w0[e] = (short)f2bf(At[c * 68 + sg * 16 + e]); w1[e] = (short)f2bf(At[c * 68 + sg * 16 + 8 + e]); }
      *(bf16x8*)dst = w0; *(bf16x8*)(dst + 8) = w1;
    }
  }
  {const int tid = opq(tid0), lane = tid & 63, wave = __builtin_amdgcn_readfirstlane(tid >> 6), r = lane & 31, h = lane >> 5, vh = wave & 1; (void)r; (void)h; (void)vh; (void)lane;
  if (wave < 2 && !cid.lat) {
#pragma unroll
    for (int dt = 0; dt < 2; ++dt)
#pragma unroll
      for (int i = 0; i < 16; ++i) p.out[OFF_SD + sidx + (dt * 32 + crow(i, h)) * 64 + vh * 32 + r] = S[dt][i];
  }
}
}

DI void mixer_phase(const P* __restrict__ gp, int l, char* smem, int fs = 0) {
  const P& p = *gp;
  const bool even = !(l & 1); const int jj = l >> 1;
  const bool teams = gridDim.x >= 512;
  if (teams) {
    const int bid = blockIdx.x;
    const int K = 3;
    if (bid < 128 * (K + 1)) {
      if (bid < 128) { if (even) gla_chain<2>(gp, jj, bid, smem, 0, 1, fs); else delta_chain<2>(gp, jj, bid, smem, 0, 1, fs); }
      else { const int ch = (bid - 128) & 127, k = (bid - 128) >> 7; if (even) gla_chain<1>(gp, jj, ch, smem, k, K, fs); else delta_chain<1>(gp, jj, ch, smem, k, K, fs); }
    }
  }
  const int first = teams ? 128 : 0;
  const int total = 384 + 2048 + 256;
  int* s_item = (int*)(smem + SMEM_BYTES - 16);
  int* cntp = uni(p.cnt) + l + 4 * fs;
  for (;;) {
    __syncthreads();
    if (opq(threadIdx.x) == 0) *s_item = atomicAdd(cntp, 1) + first;
    __syncthreads();
    const int item = __builtin_amdgcn_readfirstlane(*s_item);
    if (item >= total) break;
    if (item < 384) { if (even) gla_chain<0>(gp, jj, item, smem, 0, 1); else delta_chain<0>(gp, jj, item, smem, 0, 1); }
    else if (item < 384 + 2048) { if (even) attn_item<1>(gp, jj, item - 384, smem); else attn_item<3>(gp, jj, item - 384, smem); }
    else { if (even) attn_item<0>(gp, jj, item - 384 - 2048, smem); else attn_item<2>(gp, jj, item - 384 - 2048, smem); }
  }
}

DI void finalize_phase(const P* __restrict__ gp, int l) {
  const P& p = *gp;
  const bool even = !(l & 1); const int jj = l >> 1;
  int tid_ = threadIdx.x; asm volatile("" : "+v"(tid_)); const int tid = tid_;
  const int tk = tid >> 5, hh = (tid >> 2) & 7, sg = tid & 3;
  const int PS = even ? EVN : ODN; const int zcol = even ? 3104 : 2336;
  for (int item = blockIdx.x; item < NT_ / 8; item += gridDim.x) {
    const size_t tok = (size_t)item * 8 + tk;
    u16* a = p.hn + tok * 1024 + 512 + hh * 64 + sg * 16;
    const u16* bsrc = p.ot1 + tok * 512 + hh * 64 + sg * 16;
    const u16* zs = p.proj + tok * PS + zcol + hh * 64 + sg * 16;
    float o[16]; float ss = 0.f;
#pragma unroll
    for (int hf = 0; hf < 2; ++hf) {
      const bf16x8 x0 = *(const bf16x8*)(a + hf * 8), x1 = *(const bf16x8*)(bsrc + hf * 8);
#pragma unroll
      for (int e = 0; e < 8; ++e) { const float v = bf2f((u16)x0[e]) + bf2f((u16)x1[e]); o[hf * 8 + e] = v; ss += v * v; }
    }
    ss += shx(ss, tid & 63, 1); ss += shx(ss, tid & 63, 2);
    const float rstd = rsqrtf(ss * (1.f / 64.f) + 1e-6f);
    const float* ng = even ? p.b_norm_g + jj * 512 + hh * 64 + sg * 16 : p.d_norm_g + jj * 64 + sg * 16;
#pragma unroll
    for (int hf = 0; hf < 2; ++hf) {
      const bf16x8 z = *(const bf16x8*)(zs + hf * 8);
      bf16x8 w;
#pragma unroll
      for (int e = 0; e < 8; ++e) { const float zz = bf2f((u16)z[e]); w[e] = (short)f2bf(o[hf * 8 + e] * rstd * ng[hf * 8 + e] * siluf(zz)); }
      *(bf16x8*)(a + hf * 8) = w;
    }
  }
}


#define XB_TMO      128
#define XB_XCNT(j)  (256  + 64 * (j))
#define XB_XSUB(j)  (1280 + 64 * (j))
#define XB_XGEN(j)  (2304 + 64 * (j))
#define XB_TOP      3328
#define XB_TOPGEN   3392
#define XCD_BAR_WORDS 3456
#define XB_SPIN_CAP (1u << 18)
#define LAS __attribute__((address_space(3)))
DI unsigned xb_ld(unsigned* q)              { return __hip_atomic_load(q, __ATOMIC_RELAXED, __HIP_MEMORY_SCOPE_AGENT); }
DI unsigned xb_add(unsigned* q, unsigned v) { return __hip_atomic_fetch_add(q, v, __ATOMIC_RELAXED, __HIP_MEMORY_SCOPE_AGENT); }
DI unsigned xb_xcc_id() { return (unsigned)__builtin_amdgcn_s_getreg((3 << 11) | 20) & 0xFu; }
#define XB_SPIN(cond, bar) do { unsigned _sp = 0; while (cond) { __builtin_amdgcn_s_sleep(1); \
    if ((++_sp & 255u) == 0u) { if (xb_ld(&(bar)[XB_TMO])) break; if (_sp > XB_SPIN_CAP) { atomicAdd(&(bar)[XB_TMO], 1u); break; } } } } while (0)
struct XcdBarrier { unsigned* bar; unsigned x; volatile LAS unsigned* st; };
DI XcdBarrier xcd_barrier_post(unsigned* bar, volatile LAS unsigned* st) {
  XcdBarrier b; b.bar = bar; b.x = xb_xcc_id(); b.st = st;
  if (threadIdx.x == 0) (void)xb_add(&bar[XB_XCNT(b.x)], 1u);
  return b;
}
DI void xcd_barrier_complete(unsigned* bar, unsigned x, unsigned& nloc, unsigned& nx) {
  const unsigned G = gridDim.x * gridDim.y * gridDim.z;
  unsigned sum, cnt, mine, sp = 0u;
  for (;;) {
    sum = 0u; cnt = 0u; mine = 0u;
#pragma unroll
    for (unsigned j = 0; j < 16; ++j) { const unsigned c = xb_ld(&bar[XB_XCNT(j)]); sum += c; cnt += (c > 0u) ? 1u : 0u; mine = (j == x) ? c : mine; }
    if (sum == G) break;
    __builtin_amdgcn_s_sleep(1);
    if ((++sp & 255u) == 0u) { if (xb_ld(&bar[XB_TMO])) break; if (sp > XB_SPIN_CAP) { atomicAdd(&bar[XB_TMO], 1u); break; } }
  }
  nloc = mine > 0u ? mine : 1u; nx = cnt > 0u ? cnt : 1u;
}
DI void xcd_barrier(const XcdBarrier& b) {
  asm volatile("s_waitcnt vmcnt(0)" ::: "memory");
  __syncthreads();
  if (threadIdx.x == 0) {
    unsigned* bar = b.bar;
    __builtin_amdgcn_s_waitcnt(0);
    unsigned nloc = b.st[0], nx = b.st[1];
    if (nloc == 0u) { xcd_barrier_complete(bar, b.x, nloc, nx); b.st[0] = nloc; b.st[1] = nx; }
    const unsigned old = xb_add(&bar[XB_XSUB(b.x)], 1u);
    const unsigned gen = old / nloc;
    if (old + 1u == (gen + 1u) * nloc) {
      __builtin_amdgcn_fence(__ATOMIC_RELEASE, "agent");
      asm volatile("s_waitcnt vmcnt(0)" ::: "memory");
      const unsigned og = xb_add(&bar[XB_TOP], 1u);
      const unsigned tg = og / nx;
      if (og + 1u == (tg + 1u) * nx) xb_add(&bar[XB_TOPGEN], 1u);
      else XB_SPIN(xb_ld(&bar[XB_TOPGEN]) == tg, bar);
      __builtin_amdgcn_fence(__ATOMIC_ACQUIRE, "agent");
      xb_add(&bar[XB_XGEN(b.x)], 1u);
      asm volatile("s_waitcnt vmcnt(0)" ::: "memory");
    } else {
      XB_SPIN(xb_ld(&bar[XB_XGEN(b.x)]) == gen, bar);
      __builtin_amdgcn_fence(__ATOMIC_ACQUIRE, "agent");
      asm volatile("s_waitcnt vmcnt(0)" ::: "memory");
    }
  }
  __syncthreads();
}

DI void run_phase(const P* __restrict__ gp, int ph, char* smem) {
  const P& p = *gp;
  if (ph == 0) { prep_phase(gp, smem); return; }
  if (ph == NPH - 1) { norm_phase(gp, 0, 0, false, true); return; }
  const int l = (ph - 1) >> 3, s = (ph - 1) & 7;
  const bool even = !(l & 1);
  const u16* W = uni(p.wt) + (size_t)l * LW;
  const u16* hnp = uni(p.hn); const u16* projp = uni(p.proj);
  switch (s) {
    case 0: norm_phase(gp, l, 0, l == 0, false); break;
    case 1: gemm_phase<EPI_PROJ>(gp, l, smem, hnp, 1024, W + WO_IN, 1024, 1024, 288, even ? 29 : 23, 0); break;
    case 2: mixer_phase(gp, l, smem); break;
    case 3: finalize_phase(gp, l); break;
    case 4: gemm_phase<EPI_RES>(gp, l, smem, hnp, 1024, W + WO_OUT, 1024, 1024, 288, 8, 2); break;
    case 5: norm_phase(gp, l, 1, false, false); break;
    case 6: gemm_phase<EPI_FFN>(gp, l, smem, hnp, 1024, W + WO_UP, 1024, 1024, 312, 44, 0); break;
    case 7: gemm_phase<EPI_RES>(gp, l, smem, projp, 2816, W + WO_DN, 2816, 2816, 288, 8, 5); break;
  }
}

__global__ void __launch_bounds__(256, 2) mk(P p, P* gpmem, int ph0, int ph1) {
  __shared__ __attribute__((aligned(16))) char smem[SMEM_BYTES];
  const P* gp = &p;
  if (ph1 - ph0 > 1) {
    cg::grid_group grid = cg::this_grid();
    volatile LAS unsigned* xst = (volatile LAS unsigned*)(smem + SMEM_BYTES - 32);
    if (threadIdx.x == 0) { xst[0] = 0u; xst[1] = 0u; }
    __syncthreads();
    const XcdBarrier xbar = xcd_barrier_post(p.bar, xst);
    for (int ph = ph0; ph < ph1; ++ph) {
      run_phase(gp, ph, smem);
      if (ph + 1 < ph1) { if (ph == ph0) grid.sync(); else xcd_barrier(xbar); }
    }
  } else {
    run_phase(gp, ph0, smem);
  }
}

extern "C" void kernel_launch(void* const* d_in, const int* in_sizes, int n_in, void* d_out, int out_size, void* d_ws, size_t ws_size,
                              hipStream_t stream) {
  P p{};
  const float** f = (const float**)&p;
  for (int i = 0; i < 31; ++i) f[i] = (const float*)d_in[i];
  p.out = (float*)d_out;
  char* ws = (char*)d_ws;
  size_t off = 0;
  p.hn = (u16*)(ws + off); off += (size_t)NT_ * 1024 * 2;
  p.proj = (u16*)(ws + off); off += (size_t)NT_ * EVN * 2;
  p.ot1 = (u16*)(ws + off); off += (size_t)NT_ * 512 * 2;
  p.wt = (u16*)(ws + off); off += 4 * LW * 2;
  p.mods = (float*)(ws + off); off += 4 * 9 * 6144 * 4;
  p.rope = (float*)(ws + off); off += 64 * 16 * 2 * 4;
  P* gp = (P*)(ws + off); off += 4096;
  p.cnt = (int*)(ws + off); off += 256;
  p.flags = (int*)(ws + off); off += 8 * 8320 * 4;
  off = (off + 255) & ~(size_t)255;
  p.ring = ws + off; off += (size_t)128 * RING * SLOT_BYTES;
  p.bar = (unsigned*)(ws + off); off += XCD_BAR_WORDS * 4;
  static int grid_blocks = 0;
  if (!grid_blocks) {
    int dev = 0, cus = 0, per_cu = 0;
    hipGetDevice(&dev);
    hipDeviceGetAttribute(&cus, hipDeviceAttributeMultiprocessorCount, dev);
    hipOccupancyMaxActiveBlocksPerMultiprocessor(&per_cu, mk, 256, 0);
    if (per_cu < 1) per_cu = 1;
    if (per_cu > 2) per_cu = 2;
    grid_blocks = cus * per_cu;
  }
#if MK_MULTI
  for (int ph = 0; ph < NPH; ++ph) {
    int a = ph, b = ph + 1;
    hipLaunchKernelGGL(mk, dim3(grid_blocks), dim3(256), 0, stream, p, gp, a, b);
  }
#else
  hipMemsetAsync(p.bar, 0, XCD_BAR_WORDS * 4, stream);
  int ph0 = 0, ph1 = NPH;
  void* args[] = {&p, &gp, &ph0, &ph1};
  hipError_t e = hipLaunchCooperativeKernel((void*)mk, dim3(grid_blocks), dim3(256), args, 0, stream);
  if (e != hipSuccess) fprintf(stderr, "cooperative launch failed: %s (grid %d)\n", hipGetErrorString(e), grid_blocks);
#endif
}
```

```cpp
#include <hip/hip_runtime.h>
#include <hip/hip_cooperative_groups.h>
#include <cstdio>
namespace cg = cooperative_groups;

#ifndef MK_MULTI
#define MK_MULTI 0
#endif

#define DI __device__ __forceinline__
#define DN __device__ __noinline__
typedef unsigned short u16;
typedef __attribute__((ext_vector_type(8))) short bf16x8;
typedef __attribute__((ext_vector_type(4))) short s16x4;
typedef __attribute__((ext_vector_type(16))) float f32x16;
#define MFMA(a, b, c) __builtin_amdgcn_mfma_f32_32x32x16_bf16((a), (b), (c), 0, 0, 0)

static constexpr int NP_ = 4096, NT_ = 36864;
static constexpr int EVN = 3616, ODN = 2848;
static constexpr size_t OFF_AK = 37748736, OFF_AV = 41943040, OFF_SB = 46137344, OFF_CK = 48234496, OFF_CV = 49283072, OFF_SD = 50331648;
static constexpr size_t LW = 13500416, WO_UP = 0, WO_DN = 5767168, WO_IN = 8650752, WO_OUT = 12451840;
static constexpr int NPH = 34;
static constexpr int SMEM_BYTES = 80 * 1024;

struct P {
  const float *x_prompt, *x_sample, *cache_a_k, *cache_a_v, *state_b, *cache_c_k, *cache_c_v, *state_d, *c, *c_ctx, *ada_w, *ada_b,
      *norm1_g, *norm2_g, *ffn_up, *ffn_conv, *ffn_down, *ev_w_in, *ev_w_out, *a_rpb, *b_w_g2, *b_b_g, *b_norm_g, *od_w_in, *od_w_out,
      *c_sink, *d_conv, *d_a_log, *d_dt_bias, *d_norm_g, *final_g;
  float* out;
  u16 *hn, *proj, *ot1, *wt;
  float *mods, *rope;
  int* cnt;
  int* flags;
  char* ring;
  unsigned* bar;
};

typedef __attribute__((ext_vector_type(2))) __bf16 bf2_t;
typedef __attribute__((ext_vector_type(2))) float f2_t;
typedef __attribute__((ext_vector_type(4))) unsigned u32x4_t;
DI unsigned pk2(float a, float b) { const f2_t v = {a, b}; return __builtin_bit_cast(unsigned, __builtin_convertvector(v, bf2_t)); }
DI u16 f2bf(float x) { return __builtin_bit_cast(u16, (__bf16)x); }
DI float bf2f(u16 b) { return __uint_as_float(((unsigned)b) << 16); }
DI int crow(int i, int h) { return (i & 3) + 8 * (i >> 2) + 4 * h; }
template <int S> DI bf16x8 packs(const f32x16& x) {
  u32x4_t v;
  v[0] = pk2(x[8 * S], x[8 * S + 1]); v[1] = pk2(x[8 * S + 2], x[8 * S + 3]); v[2] = pk2(x[8 * S + 4], x[8 * S + 5]); v[3] = pk2(x[8 * S + 6], x[8 * S + 7]);
  return __builtin_bit_cast(bf16x8, v);
}
DI bf16x8 ld2x4(const u16* p) {
  s16x4 lo = *(const s16x4*)p, hi = *(const s16x4*)(p + 8);
  return __builtin_shufflevector(lo, hi, 0, 1, 2, 3, 4, 5, 6, 7);
}
DI float siluf(float x) { return x / (1.f + __expf(-x)); }
DI int opq(int x) { asm volatile("" : "+v"(x)); return x; }
DI float shx(float v, int lane, int o) { return __int_as_float(__builtin_amdgcn_ds_bpermute((lane ^ o) << 2, __float_as_int(v))); }
template <class T> DI T* uni(T* q) { return q; }
DI void zero16(f32x16& a) {
#pragma unroll
  for (int i = 0; i < 16; ++i) a[i] = 0.f;
}

DI void prep_phase(const P* __restrict__ gp, char* smem) {
  const P& p = *gp;
  int tid_ = threadIdx.x; asm volatile("" : "+v"(tid_)); const int tid = tid_;
  const int NWT = 4 * (1408 + 704 + 256) + 2 * (928 + 736);
  const int NADA = 384;
  const int total = NWT + NADA + 1;
  for (int item = blockIdx.x; item < total; item += gridDim.x) {
    if (item < NWT) {
      int rem = item; const float* src = nullptr; u16* dst = nullptr; int K = 0, N = 0, NPd = 0;
      for (int l = 0; l < 4; ++l) {
        const int jj = l >> 1; const bool ev = !(l & 1);
        const int nin = ev ? 928 : 736;
        if (rem < 1408) { src = p.ffn_up + (size_t)l * 1024 * 5632; dst = p.wt + l * LW + WO_UP; K = 1024; N = 5632; NPd = 5632; break; }
        rem -= 1408;
        if (rem < 704) { src = p.ffn_down + (size_t)l * 2816 * 1024; dst = p.wt + l * LW + WO_DN; K = 2816; N = 1024; NPd = 1024; break; }
        rem -= 704;
        if (rem < nin) { src = ev ? p.ev_w_in + (size_t)jj * 1024 * EVN : p.od_w_in + (size_t)jj * 1024 * ODN; dst = p.wt + l * LW + WO_IN; K = 1024; N = ev ? EVN : ODN; NPd = ev ? 3712 : 2944; break; }
        rem -= nin;
        if (rem < 256) { src = (ev ? p.ev_w_out : p.od_w_out) + (size_t)jj * 1024 * 1024; dst = p.wt + l * LW + WO_OUT; K = 1024; N = 1024; NPd = 1024; break; }
        rem -= 256;
      }
      const int ntn = NPd >> 6;
      const int tk = rem / ntn, tn = rem - tk * ntn;
      const int scol0 = (N == 5632) ? ((tn & 1) * 2816 + (tn >> 1) * 64) : tn * 64;
      float* T = (float*)smem;
      __syncthreads();
#pragma unroll
      for (int i = 0; i < 16; ++i) {
        const int k = i * 4 + (tid >> 6), n = tid & 63;
        const int gn = scol0 + n;
        T[k * 65 + n] = (gn < N) ? src[(size_t)(tk * 64 + k) * N + gn] : 0.f;
      }
      __syncthreads();
#pragma unroll
      for (int i = 0; i < 2; ++i) {
        const int q = tid + 256 * i; const int n = q & 63, kc = q >> 6;
        const int pn = tn * 64 + n; const int nt32 = pn >> 5, rr = pn & 31;
        const int kstep = tk * 4 + (kc >> 1), hh = kc & 1;
        bf16x8 w;
#pragma unroll
        for (int j = 0; j < 8; ++j) w[j] = (short)f2bf(T[(kc * 8 + j) * 65 + n]);
        *(bf16x8*)(dst + ((size_t)(nt32 * (K >> 4) + kstep) * 64 + hh * 32 + rr) * 8) = w;
      }
    } else if (item < NWT + NADA) {
      const int it = item - NWT; const int l = it / 96, cgp = it - l * 96; const int n0 = cgp * 64;
      float* sc = (float*)smem;
      float* red = sc + 9 * 1024;
      __syncthreads();
      for (int idx = tid; idx < 9 * 1024; idx += 256) {
        const int ci = idx >> 10, k = idx & 1023;
        const float x = ci < 8 ? p.c[ci * 1024 + k] : p.c_ctx[k];
        sc[idx] = x / (1.f + expf(-x));
      }
      __syncthreads();
      const int wave = tid >> 6, lane = tid & 63;
      float acc[9];
#pragma unroll
      for (int ci = 0; ci < 9; ++ci) acc[ci] = 0.f;
      const float* wp = p.ada_w + ((size_t)l * 1024 + wave * 256) * 6144 + n0 + lane;
#pragma unroll 8
      for (int k = 0; k < 256; ++k) {
        const float wv = wp[(size_t)k * 6144];
#pragma unroll
        for (int ci = 0; ci < 9; ++ci) acc[ci] += sc[ci * 1024 + wave * 256 + k] * wv;
      }
#pragma unroll
      for (int ci = 0; ci < 9; ++ci) red[(wave * 9 + ci) * 64 + lane] = acc[ci];
      __syncthreads();
      for (int idx = tid; idx < 576; idx += 256) {
        const int ci = idx >> 6, col = idx & 63;
        const float s = red[(0 * 9 + ci) * 64 + col] + red[(1 * 9 + ci) * 64 + col] + red[(2 * 9 + ci) * 64 + col] + red[(3 * 9 + ci) * 64 + col];
        p.mods[(size_t)(l * 9 + ci) * 6144 + n0 + col] = s + p.ada_b[l * 6144 + n0 + col];
      }
    } else {
      if (tid < 8) p.cnt[tid] = 0;
      for (int i = tid; i < 8 * 8320; i += 256) p.flags[i] = 0;
      for (int idx = tid; idx < 1024; idx += 256) {
        const int pos = idx >> 4, fi = idx & 15;
        const float inv = powf(10000.f, -(float)fi / 16.f);
        const float ang = (float)pos * inv;
        p.rope[idx * 2] = cosf(ang); p.rope[idx * 2 + 1] = sinf(ang);
      }
    }
  }
}

DI void norm_phase(const P* __restrict__ gp, int l, int which, bool first, bool fin) {
  const P& p = *gp;
  int tid_ = threadIdx.x; asm volatile("" : "+v"(tid_)); const int tid = tid_, lane = tid & 63, wave = tid >> 6;
  for (int item = blockIdx.x; item < NT_ / 8; item += gridDim.x) {
    float4 v[2][4];
    float ss[2];
#pragma unroll
    for (int u = 0; u < 2; ++u) {
      const int tok = item * 8 + u * 4 + wave;
      const float* src = first ? (tok < NP_ ? p.x_prompt + (size_t)tok * 1024 : p.x_sample + (size_t)(tok - NP_) * 1024) : p.out + (size_t)tok * 1024;
#pragma unroll
      for (int i = 0; i < 4; ++i) v[u][i] = ((const float4*)src)[lane + 64 * i];
    }
#pragma unroll
    for (int u = 0; u < 2; ++u) {
      float a = 0.f;
#pragma unroll
      for (int i = 0; i < 4; ++i) a += v[u][i].x * v[u][i].x + v[u][i].y * v[u][i].y + v[u][i].z * v[u][i].z + v[u][i].w * v[u][i].w;
#pragma unroll
      for (int o = 32; o >= 1; o >>= 1) a += shx(a, lane, o);
      ss[u] = a;
    }
#pragma unroll
    for (int u = 0; u < 2; ++u) {
      const int tok = item * 8 + u * 4 + wave;
      const float rstd = rsqrtf(ss[u] * (1.f / 1024.f) + 1e-6f);
      if (fin) {
#pragma unroll
        for (int i = 0; i < 4; ++i) {
          const float4 g = ((const float4*)p.final_g)[lane + 64 * i];
          float4 y; y.x = v[u][i].x * rstd * g.x; y.y = v[u][i].y * rstd * g.y; y.z = v[u][i].z * rstd * g.z; y.w = v[u][i].w * rstd * g.w;
          ((float4*)(p.out + (size_t)tok * 1024))[lane + 64 * i] = y;
        }
      } else {
        const int ci = tok < NP_ ? 8 : (tok - NP_) >> 12;
        const float* md = p.mods + (size_t)(l * 9 + ci) * 6144 + which * 3072;
        const float* gpp = (which ? p.norm2_g : p.norm1_g) + l * 1024;
#pragma unroll
        for (int i = 0; i < 4; ++i) {
          const float4 g = ((const float4*)gpp)[lane + 64 * i];
          const float4 sh = ((const float4*)md)[lane + 64 * i];
          const float4 sc = ((const float4*)(md + 1024))[lane + 64 * i];
          ushort4 o;
          o.x = f2bf(v[u][i].x * rstd * g.x * (1.f + sc.x) + sh.x);
          o.y = f2bf(v[u][i].y * rstd * g.y * (1.f + sc.y) + sh.y);
          o.z = f2bf(v[u][i].z * rstd * g.z * (1.f + sc.z) + sh.z);
          o.w = f2bf(v[u][i].w * rstd * g.w * (1.f + sc.w) + sh.w);
          ((ushort4*)(p.hn + (size_t)tok * 1024))[lane + 64 * i] = o;
          if (first) ((float4*)(p.out + (size_t)tok * 1024))[lane + 64 * i] = v[u][i];
        }
      }
    }
  }
}

DI uint4 ldsel(const u16* pv, const u16* safe, unsigned ok) {
  uint4 t = *(const uint4*)(ok ? pv : safe);
  if (!ok) { t.x = 0; t.y = 0; t.z = 0; t.w = 0; }
  return t;
}
enum { EPI_PROJ = 0, EPI_RES = 1, EPI_FFN = 2 };

template <int EPI>
DI void gemm_phase(const P* __restrict__ gp, int l, char* smem, const u16* __restrict__ A, int lda, const u16* __restrict__ B, int ldb, int K, int MT,
                   int NTn, int gsel) {
  const P& p = *gp;
  u16* As = (u16*)smem;
  int tid_ = threadIdx.x; asm volatile("" : "+v"(tid_)); const int tid = tid_, lane = tid & 63, wave = tid >> 6, r = lane & 31, h = lane >> 5;
  const int KT = K >> 6;
  const bool even = !(l & 1); const int jj = l >> 1;
  const int ntiles = MT * NTn;
  const int nlb = gridDim.x >> 3, xcd = blockIdx.x & 7, lb = blockIdx.x >> 3;
  for (int it = 0;; ++it) {
    const int g = (it * 8 + xcd) * nlb + lb;
    if (g >= ntiles) break;
    const int SM = nlb >> 3;
    const int band = g / (SM * NTn); const int rem = g - band * SM * NTn;
    const int nt = rem / SM, mt = band * SM + (rem - nt * SM);
    int seqbase = 0, L = 0, tin0 = 0;
    if (EPI == EPI_FFN) {
      if (mt < 48) { const int sq = mt / 3; L = 256; seqbase = sq * 256; tin0 = (mt - sq * 3) * 126; }
      else { const int m2 = mt - 48; const int sq = m2 / 33; L = 4096; seqbase = NP_ + sq * 4096; tin0 = (m2 - sq * 33) * 126; }
    }
    const int row0 = tid >> 3, kc0 = (tid & 7) * 8;
    const long arow0 = (EPI == EPI_FFN) ? (long)seqbase + tin0 - 1 + row0 : (long)mt * 128 + row0;
    const u16* abase = A + arow0 * lda + kc0;
    unsigned avalid = 0;
#pragma unroll
    for (int i = 0; i < 4; ++i) {
      if (EPI == EPI_FFN) { const int ts = tin0 - 1 + row0 + 32 * i; if (ts >= 0 && ts < L) avalid |= 1u << i; }
      else avalid |= 1u << i;
    }
    const u16* bb0 = B + ((size_t)((nt * 4 + wave) * (K >> 4)) * 64 + lane) * 8;
    f32x16 acc[2][2];
#pragma unroll
    for (int a = 0; a < 2; ++a)
#pragma unroll
      for (int b = 0; b < 2; ++b) zero16(acc[a][b]);
#define GLD_A(i, ko) ldsel(abase + (size_t)(32 * (i)) * lda + (ko), A, (avalid >> (i)) & 1u)
#define GLD_BF(dst, kt_) { const u16* q_ = bb0 + (size_t)(kt_) * 2048; \
      dst[0] = *(const bf16x8*)(q_); dst[1] = *(const bf16x8*)(q_ + 512); dst[2] = *(const bf16x8*)(q_ + 1024); dst[3] = *(const bf16x8*)(q_ + 1536); }
    uint4 ra0 = GLD_A(0, 0), ra1 = GLD_A(1, 0), ra2 = GLD_A(2, 0), ra3 = GLD_A(3, 0);
    uint4 sa0 = GLD_A(0, 64), sa1 = GLD_A(1, 64), sa2 = GLD_A(2, 64), sa3 = GLD_A(3, 64);
    bf16x8 bc[4], bn[4];
    GLD_BF(bc, 0);
    GLD_BF(bn, 1);
#define LSTORE(buf, A0, A1, A2, A3) { \
      u16* ad = As + (buf) * 9216 + row0 * 72 + kc0; \
      *(uint4*)(ad) = A0; *(uint4*)(ad + 32 * 72) = A1; *(uint4*)(ad + 64 * 72) = A2; *(uint4*)(ad + 96 * 72) = A3; }
#define COMPUTE(buf, BF, KN) { \
      const u16* Ab = As + (buf) * 9216 + r * 72 + h * 8; \
      const bool more_ = (KN) < KT; const u16* q_ = bb0 + (size_t)(KN) * 2048; \
      _Pragma("unroll") for (int ks = 0; ks < 4; ++ks) { \
        const bf16x8 a0 = *(const bf16x8*)(Ab + ks * 16); \
        const bf16x8 a1 = *(const bf16x8*)(Ab + 32 * 72 + ks * 16); \
        const bf16x8 a2 = *(const bf16x8*)(Ab + 64 * 72 + ks * 16); \
        const bf16x8 a3 = *(const bf16x8*)(Ab + 96 * 72 + ks * 16); \
        acc[0][0] = MFMA(a0, BF[ks], acc[0][0]); acc[0][1] = MFMA(a1, BF[ks], acc[0][1]); \
        acc[1][0] = MFMA(a2, BF[ks], acc[1][0]); acc[1][1] = MFMA(a3, BF[ks], acc[1][1]); \
        if (more_) BF[ks] = *(const bf16x8*)(q_ + ks * 512); } }
    LSTORE(0, ra0, ra1, ra2, ra3);
    ra0 = GLD_A(0, 128); ra1 = GLD_A(1, 128); ra2 = GLD_A(2, 128); ra3 = GLD_A(3, 128);
    __syncthreads();
    for (int kt = 0; kt < KT; kt += 2) {
      COMPUTE(0, bc, kt + 2);
      LSTORE(1, sa0, sa1, sa2, sa3);
      if (kt + 3 < KT) {
        const int ko = (kt + 3) * 64;
        sa0 = GLD_A(0, ko); sa1 = GLD_A(1, ko); sa2 = GLD_A(2, ko); sa3 = GLD_A(3, ko);
      }
      __syncthreads();
      COMPUTE(1, bn, kt + 3);
      if (kt + 2 < KT) {
        LSTORE(0, ra0, ra1, ra2, ra3);
        if (kt + 4 < KT) {
          const int ko = (kt + 4) * 64;
          ra0 = GLD_A(0, ko); ra1 = GLD_A(1, ko); ra2 = GLD_A(2, ko); ra3 = GLD_A(3, ko);
        }
      }
      __syncthreads();
    }
    if (EPI == EPI_PROJ) {
      const int N = even ? EVN : ODN;
#pragma unroll
      for (int tm = 0; tm < 2; ++tm)
#pragma unroll
        for (int tn = 0; tn < 2; ++tn) {
          const int col = nt * 128 + wave * 32 + r;
          if (col < N) {
#pragma unroll
            for (int i = 0; i < 16; ++i) {
              const int row = mt * 128 + (tm * 2 + tn) * 32 + crow(i, h);
              const float v = acc[tm][tn][i];
              p.proj[(size_t)row * N + col] = f2bf(v);
              if (row < NP_) {
                const int b = row >> 8, t = row & 255, d = col & 63;
                if (even) {
                  if (col >= 512 && col < 1536) {
                    const int wh = (col - 512) >> 9, hh = ((col - 512) >> 6) & 7;
                    p.out[(wh ? OFF_AV : OFF_AK) + ((size_t)(((b * 2 + jj) * 8 + hh) * 256 + t)) * 64 + d] = v;
                  }
                } else {
                  if (col >= 512 && col < 768) {
                    const int wh = (col - 512) >> 7, kv = ((col - 512) >> 6) & 1;
                    p.out[(wh ? OFF_CV : OFF_CK) + ((size_t)(((b * 2 + jj) * 2 + kv) * 256 + t)) * 64 + d] = v;
                  }
                }
              }
            }
          }
        }
    } else if (EPI == EPI_RES) {
#pragma unroll
      for (int tm = 0; tm < 2; ++tm)
#pragma unroll
        for (int tn = 0; tn < 2; ++tn) {
          const int col = nt * 128 + wave * 32 + r;
#pragma unroll
          for (int i = 0; i < 16; ++i) {
            const int row = mt * 128 + (tm * 2 + tn) * 32 + crow(i, h);
            const int ci = row < NP_ ? 8 : (row - NP_) >> 12;
            const float g = p.mods[(size_t)(l * 9 + ci) * 6144 + gsel * 1024 + col];
            float* xp = p.out + (size_t)row * 1024 + col;
            *xp = *xp + g * acc[tm][tn][i];
          }
        }
    } else {
      __syncthreads();
      float* U = (float*)smem;
#pragma unroll
      for (int tm = 0; tm < 2; ++tm)
#pragma unroll
        for (int tn = 0; tn < 2; ++tn)
#pragma unroll
          for (int i = 0; i < 16; ++i) U[((tm * 2 + tn) * 32 + crow(i, h)) * 132 + wave * 32 + r] = acc[tm][tn][i];
      __syncthreads();
      const float* cw = p.ffn_conv + (size_t)l * 3 * 5632;
      const int f = tid & 63, rg = tid >> 6; const int fg = nt * 64 + f;
      const float wa0 = cw[fg], wa1 = cw[5632 + fg], wa2 = cw[2 * 5632 + fg];
      const float wg0 = cw[2816 + fg], wg1 = cw[5632 + 2816 + fg], wg2 = cw[2 * 5632 + 2816 + fg];
      u16* act = p.proj;
      {
        const int rbeg = 1 + 32 * rg, rend = rg == 3 ? 126 : 32 * rg + 32;
        float ap = U[(rbeg - 1) * 132 + f], ac = U[rbeg * 132 + f];
        float gp_ = U[(rbeg - 1) * 132 + 64 + f], gc = U[rbeg * 132 + 64 + f];
        for (int rr = rbeg; rr <= rend; ++rr) {
          const int ts = tin0 - 1 + rr;
          if (ts >= L) break;
          const float an = U[(rr + 1) * 132 + f], gn = U[(rr + 1) * 132 + 64 + f];
          const float a = wa0 * ap + wa1 * ac + wa2 * an;
          const float g = wg0 * gp_ + wg1 * gc + wg2 * gn;
          act[(size_t)(seqbase + ts) * 2816 + fg] = f2bf(a * siluf(g));
          ap = ac; ac = an; gp_ = gc; gc = gn;
        }
      }
      __syncthreads();
    }
  }
}

template <int MODE>
DI void attn_item(const P* __restrict__ gp, int jj, int it, char* smem) {
  const P& p = *gp;
  const u16* projp = uni(p.proj); u16* hnp = uni(p.hn); const float* ropep = uni(p.rope);
  u16* Ks = (u16*)smem; u16* Vt = Ks + 64 * 72; float* rpb_s = (float*)(Vt + 64 * 72);
  int tid_ = threadIdx.x; asm volatile("" : "+v"(tid_)); const int tid = tid_, lane = tid & 63, wave = tid >> 6, r = lane & 31, h = lane >> 5;
  constexpr bool EVENL = (MODE == 0 || MODE == 1);
  constexpr bool LAT = (MODE == 1 || MODE == 3);
  constexpr int PS = EVENL ? EVN : ODN;
  int b, hq, qb, tokbase;
  if (!LAT) { b = it >> 4; hq = (it >> 1) & 7; qb = it & 1; tokbase = b * 256; }
  else { b = it >> 8; hq = (it >> 5) & 7; qb = it & 31; tokbase = NP_ + b * 4096; }
  const int hk = EVENL ? hq : (hq >> 2);
  const int kcol = 512 + hk * 64, vcol = (EVENL ? 1024 : 640) + hk * 64, qcol = hq * 64;
  const int tq = qb * 128 + wave * 32 + r;
  const size_t qtok = (size_t)tokbase + tq;
  __syncthreads();
  if (MODE == 1) { for (int i = tid; i < 465; i += 256) rpb_s[i] = p.a_rpb[(size_t)(jj * 8 + hq) * 465 + i]; }
  bf16x8 qf[4];
#pragma unroll
  for (int s = 0; s < 4; ++s) qf[s] = *(const bf16x8*)(projp + qtok * PS + qcol + 16 * s + 8 * h);
  if (MODE == 3) {
    const int prow = tq >> 6, pcol = tq & 63;
#pragma unroll
    for (int half = 0; half < 2; ++half) {
      const int pos = half ? pcol : prow;
#pragma unroll
      for (int j = 0; j < 8; ++j) {
        const float cs = ropep[(pos * 16 + 8 * h + j) * 2], sn = ropep[(pos * 16 + 8 * h + j) * 2 + 1];
        const float x1 = bf2f((u16)qf[2 * half][j]), x2 = bf2f((u16)qf[2 * half + 1][j]);
        qf[2 * half][j] = (short)f2bf(x1 * cs - x2 * sn);
        qf[2 * half + 1][j] = (short)f2bf(x1 * sn + x2 * cs);
      }
    }
  }
  float m_run = -1e30f, l_run = 0.f;
  if (MODE == 2 || MODE == 3) { m_run = p.c_sink[jj * 8 + hq]; l_run = h == 0 ? 1.f : 0.f; }
  f32x16 ot[2]; zero16(ot[0]); zero16(ot[1]);
  int loc0 = 0, nloc = 0;
  if (MODE == 1) {
    const int qi0 = 2 * qb;
    const int rlo = min(max(qi0 - 4, 0), 56), rhi = min(max(qi0 + 1 - 4, 0), 56) + 7;
    loc0 = rlo; nloc = rhi - rlo + 1;
  } else if (MODE == 3) {
    loc0 = max(0, 2 * qb - 2); nloc = min(63, 2 * qb + 3) - loc0 + 1;
  }
  const int qi = tq >> 6, qw = tq & 63;
  const int r0w = min(max(qi - 4, 0), 56), c0w = min(max(qw - 8, 0), 48);
  const int key = tid >> 2, seg = tid & 3;
  for (int kb = 0; kb < 4 + nloc; ++kb) {
    const bool isctx = kb < 4;
    const int blk = isctx ? kb : loc0 + kb - 4;
    __syncthreads();
    {
      float kf[16], vf[16];
      if (LAT && isctx) {
        const float* kc = (MODE == 1) ? p.cache_a_k + ((size_t)((b * 2 + jj) * 8 + hk)) * 16384 : p.cache_c_k + ((size_t)((b * 2 + jj) * 2 + hk)) * 16384;
        const float* vc = (MODE == 1) ? p.cache_a_v + ((size_t)((b * 2 + jj) * 8 + hk)) * 16384 : p.cache_c_v + ((size_t)((b * 2 + jj) * 2 + hk)) * 16384;
        const float4* kp4 = (const float4*)(kc + (size_t)(blk * 64 + key) * 64 + seg * 16);
        const float4* vp4 = (const float4*)(vc + (size_t)(blk * 64 + key) * 64 + seg * 16);
#pragma unroll
        for (int e = 0; e < 4; ++e) {
          const float4 a = kp4[e], c = vp4[e];
          kf[4 * e] = a.x; kf[4 * e + 1] = a.y; kf[4 * e + 2] = a.z; kf[4 * e + 3] = a.w;
          vf[4 * e] = c.x; vf[4 * e + 1] = c.y; vf[4 * e + 2] = c.z; vf[4 * e + 3] = c.w;
        }
      } else {
        const u16* rowp = projp + ((size_t)tokbase + blk * 64 + key) * PS;
        const bf16x8 k0 = *(const bf16x8*)(rowp + kcol + seg * 16), k1 = *(const bf16x8*)(rowp + kcol + seg * 16 + 8);
        const bf16x8 v0 = *(const bf16x8*)(rowp + vcol + seg * 16), v1 = *(const bf16x8*)(rowp + vcol + seg * 16 + 8);
#pragma unroll
        for (int e = 0; e < 8; ++e) { kf[e] = bf2f((u16)k0[e]); kf[8 + e] = bf2f((u16)k1[e]); vf[e] = bf2f((u16)v0[e]); vf[8 + e] = bf2f((u16)v1[e]); }
        if (MODE == 3) {
          const bf16x8 p0 = *(const bf16x8*)(rowp + kcol + (seg ^ 1) * 16), p1 = *(const bf16x8*)(rowp + kcol + (seg ^ 1) * 16 + 8);
          const int pos = (seg & 2) ? key : blk;
#pragma unroll
          for (int e = 0; e < 16; ++e) {
            const float pr = bf2f((u16)(e < 8 ? p0[e & 7] : p1[e & 7]));
            const float cs = ropep[(pos * 16 + e) * 2], sn = ropep[(pos * 16 + e) * 2 + 1];
            kf[e] = (seg & 1) ? (pr * sn + kf[e] * cs) : (kf[e] * cs - pr * sn);
          }
        }
      }
      bf16x8 o0, o1;
#pragma unroll
      for (int e = 0; e < 8; ++e) { o0[e] = (short)f2bf(kf[e]); o1[e] = (short)f2bf(kf[8 + e]); }
      *(bf16x8*)(Ks + key * 72 + seg * 16) = o0;
      *(bf16x8*)(Ks + key * 72 + seg * 16 + 8) = o1;
#pragma unroll
      for (int e = 0; e < 16; ++e) Vt[(seg * 16 + e) * 72 + key] = f2bf(vf[e]);
    }
    __syncthreads();
    bool active = true;
    if (MODE == 1 && !isctx) active = (blk >= r0w && blk < r0w + 8);
    if (active) {
      f32x16 st[2]; zero16(st[0]); zero16(st[1]);
#pragma unroll
      for (int kt = 0; kt < 2; ++kt)
#pragma unroll
        for (int s = 0; s < 4; ++s) {
          const bf16x8 a = *(const bf16x8*)(Ks + (kt * 32 + r) * 72 + 16 * s + 8 * h);
          st[kt] = MFMA(a, qf[s], st[kt]);
        }
      float mx = m_run;
#pragma unroll
      for (int kt = 0; kt < 2; ++kt)
#pragma unroll
        for (int i = 0; i < 16; ++i) {
          float s = st[kt][i] * 0.125f;
          const int kk = kt * 32 + crow(i, h);
          if (MODE == 1 && !isctx) {
            const bool ok = (kk >= c0w && kk < c0w + 16);
            s = ok ? s + rpb_s[(blk - qi + 7) * 31 + (kk - qw + 15)] : -1e30f;
          }
          if (MODE == 3 && !isctx) {
            const int dlt = blk * 64 + kk - tq;
            s = (dlt <= 128 && dlt >= -128) ? s : -1e30f;
          }
          st[kt][i] = s;
          mx = fmaxf(mx, s);
        }
      mx = fmaxf(mx, shx(mx, lane, 32));
      const float alpha = __expf(m_run - mx);
      m_run = mx;
      float ps = 0.f;
#pragma unroll
      for (int kt = 0; kt < 2; ++kt)
#pragma unroll
        for (int i = 0; i < 16; ++i) { const float pv = __expf(st[kt][i] - mx); st[kt][i] = pv; ps += pv; }
      l_run = l_run * alpha + ps;
#pragma unroll
      for (int dt = 0; dt < 2; ++dt)
#pragma unroll
        for (int i = 0; i < 16; ++i) ot[dt][i] *= alpha;
#pragma unroll
      for (int kt = 0; kt < 2; ++kt) {
        const bf16x8 pb0 = packs<0>(st[kt]), pb1 = packs<1>(st[kt]);
#pragma unroll
        for (int dt = 0; dt < 2; ++dt) {
          const bf16x8 pa0 = ld2x4(Vt + (dt * 32 + r) * 72 + kt * 32 + 4 * h);
          const bf16x8 pa1 = ld2x4(Vt + (dt * 32 + r) * 72 + kt * 32 + 16 + 4 * h);
          ot[dt] = MFMA(pa0, pb0, ot[dt]);
          ot[dt] = MFMA(pa1, pb1, ot[dt]);
        }
      }
    }
  }
  l_run += shx(l_run, lane, 32);
  const float inv = 1.f / l_run;
  u16* dst = hnp + qtok * 1024 + qcol;
#pragma unroll
  for (int dt = 0; dt < 2; ++dt)
#pragma unroll
    for (int g4 = 0; g4 < 4; ++g4) {
      ushort4 o;
      o.x = f2bf(ot[dt][4 * g4] * inv); o.y = f2bf(ot[dt][4 * g4 + 1] * inv); o.z = f2bf(ot[dt][4 * g4 + 2] * inv); o.w = f2bf(ot[dt][4 * g4 + 3] * inv);
      *(ushort4*)(dst + dt * 32 + 8 * g4 + 4 * h) = o;
    }
}

struct ChainId { int lat, b, h, dir, T, base, nch; };
DI ChainId chain_decode(int it) {
  ChainId c; c.lat = it < 128; const int q = c.lat ? it : it - 128;
  c.b = q >> 4; c.h = (q >> 1) & 7; c.dir = q & 1; c.T = c.lat ? 4096 : 256; c.base = c.lat ? NP_ + c.b * 4096 : c.b * 256; c.nch = c.T >> 6;
  return c;
}
DI int tokof(const ChainId& c, int step, int row) { const int pp = step * 64 + row; return c.base + (c.dir ? c.T - 1 - pp : pp); }


static constexpr int RING = 4;
static constexpr int SLOT_BYTES = 53760;
DI void wait_ge(int* flag, int val, int tid) {
  if (tid < 64) {
    if (tid == 0) { while (__hip_atomic_load(flag, __ATOMIC_RELAXED, __HIP_MEMORY_SCOPE_AGENT) < val) __builtin_amdgcn_s_sleep(1); }
    __builtin_amdgcn_fence(__ATOMIC_ACQUIRE, "agent");
  }
  __syncthreads();
}
DI void publish(int* flag, int val, int tid) {
  asm volatile("s_waitcnt vmcnt(0)" ::: "memory");
  __syncthreads();
  if (tid == 0) __hip_atomic_store(flag, val, __ATOMIC_RELAXED, __HIP_MEMORY_SCOPE_AGENT);
}
typedef __attribute__((ext_vector_type(4))) unsigned u32x4;
DI void copy_out(const char* lds, char* g, int bytes, int tid) {
  for (int i = opq(tid) * 16; i < bytes; i += 256 * 16) {
    const u32x4 v = *(const u32x4*)(lds + i);
    char* dst = g + i;
    asm volatile("global_store_dwordx4 %0, %1, off sc0 sc1" :: "v"(dst), "v"(v) : "memory");
  }
}
template <int BYTES>
DI void copy_in_t(char* lds, const char* g, int tid) {
  constexpr int N = (BYTES + 4095) / 4096;
  const int t16 = opq(tid) * 16;
  uint4 v[N];
#pragma unroll
  for (int j = 0; j < N; ++j) { const int i = t16 + j * 4096; v[j] = make_uint4(0, 0, 0, 0); if (i < BYTES) v[j] = *(const uint4*)(g + i); }
#pragma unroll
  for (int j = 0; j < N; ++j) { const int i = t16 + j * 4096; if (i < BYTES) *(uint4*)(lds + i) = v[j]; }
}

template <int ROLE>
DI void gla_chain(const P* __restrict__ gp, int jj, int it, char* smem, int k0, int kstep, int fs = 0) {
  const P& p = *gp;
  const ChainId cid = chain_decode(it);
  int tid_ = threadIdx.x; asm volatile("" : "+v"(tid_)); const int tid = tid_, lane = tid & 63, wave = tid >> 6, r = lane & 31, h = lane >> 5;
  const int hh = cid.h, dir = cid.dir;
  u16* QT = (u16*)smem; u16* KT = QT + 4608; u16* KEt = KT + 4608; u16* Vt = KEt + 4608;
  float* dec = (float*)(Vt + 4608); float* GL = dec + 64; float* gq = GL + 1024; float* Ost = gq + 256;
  constexpr int IMG = 4 * 9216 + 256;
  char* slots = uni(p.ring) + (size_t)it * RING * SLOT_BYTES; int* ready = uni(p.flags) + (jj * 2 + 4 * fs) * 8320 + it * 64; int* done = uni(p.flags) + (jj * 2 + 4 * fs) * 8320 + 8192 + it;
  const int d = tid & 63, cq = tid >> 6;
  float wg[16];
#pragma unroll
  for (int rr = 0; rr < 16; ++rr) wg[rr] = p.b_w_g2[((size_t)((jj * 2 + dir) * 16 + rr)) * 512 + hh * 64 + d];
  const float bg = p.b_b_g[(jj * 2 + dir) * 512 + hh * 64 + d];
  const int vh = wave & 1;
  f32x16 S[2]; zero16(S[0]); zero16(S[1]);
  const size_t sidx = ((size_t)(((cid.b * 2 + jj) * 2 + dir) * 8 + hh)) * 4096;
  if (ROLE != 1 && wave < 2 && cid.lat) {
#pragma unroll
    for (int dt = 0; dt < 2; ++dt)
#pragma unroll
      for (int i = 0; i < 16; ++i) S[dt][i] = p.state_b[sidx + (dt * 32 + crow(i, h)) * 64 + vh * 32 + r];
  }
  for (int step_ = k0; step_ < cid.nch; step_ += kstep) {
    int step = step_;
    asm volatile("" : "+v"(step));
    if (ROLE == 1) wait_ge(done, step_ - RING + 1, tid);
    if (ROLE == 2) wait_ge(ready + step_, 1, tid);
    __syncthreads();
    if (ROLE == 2) { copy_in_t<IMG>(smem, slots + (size_t)(step_ % RING) * SLOT_BYTES, tid); __syncthreads(); if (tid == 0) __hip_atomic_store(done, step_ + 1, __ATOMIC_RELAXED, __HIP_MEMORY_SCOPE_AGENT); }
    if (ROLE != 2) {
    {
      const int c = tid >> 2, sg = tid & 3;
      const int tok = tokof(cid, step, c);
      const ushort4 gv = *(const ushort4*)(p.proj + (size_t)tok * EVN + 3072 + dir * 16 + sg * 4);
      GL[c * 16 + sg * 4] = bf2f(gv.x); GL[c * 16 + sg * 4 + 1] = bf2f(gv.y); GL[c * 16 + sg * 4 + 2] = bf2f(gv.z); GL[c * 16 + sg * 4 + 3] = bf2f(gv.w);
    }
    __syncthreads();
    float Gl[16]; float run = 0.f;
#pragma unroll
    for (int i = 0; i < 16; ++i) {
      const int c = cq * 16 + i;
      float z = bg;
#pragma unroll
      for (int rr = 0; rr < 16; ++rr) z += GL[c * 16 + rr] * wg[rr];
      const float g = (fminf(z, 0.f) - __logf(1.f + __expf(-fabsf(z)))) * (1.f / 16.f);
      run += g; Gl[i] = run;
    }
    gq[cq * 64 + d] = run;
    __syncthreads();
    float off = 0.f, tot = 0.f;
#pragma unroll
    for (int q2 = 0; q2 < 4; ++q2) { const float t = gq[q2 * 64 + d]; if (q2 < cq) off += t; tot += t; }
#pragma unroll
    for (int i = 0; i < 16; ++i) {
      const int c = cq * 16 + i;
      const int tok = tokof(cid, step, c);
      const float G = Gl[i] + off;
      const u16* rowp = p.proj + (size_t)tok * EVN + hh * 64 + d;
      const float qv = bf2f(rowp[1536]), kv = bf2f(rowp[2048]);
      const u16 vb = rowp[2560];
      QT[c * 72 + d] = f2bf(qv * 0.125f * __expf(G));
      KT[c * 72 + d] = f2bf(kv * __expf(-G));
      KEt[d * 72 + c] = f2bf(kv * __expf(tot - G));
      Vt[d * 72 + c] = vb;
    }
    if (cq == 0) dec[d] = __expf(tot);
    __syncthreads();
    }
    if (ROLE == 1) { copy_out(smem, slots + (size_t)(step_ % RING) * SLOT_BYTES, IMG, tid); publish(ready + step_, 1, tid); continue; }
    if (wave < 2) {
      f32x16 at[2][2];
#pragma unroll
      for (int a = 0; a < 2; ++a)
#pragma unroll
        for (int b2 = 0; b2 < 2; ++b2) zero16(at[a][b2]);
#pragma unroll
      for (int ks = 0; ks < 4; ++ks) {
        const bf16x8 a0 = *(const bf16x8*)(KT + r * 72 + ks * 16 + 8 * h), a1 = *(const bf16x8*)(KT + (32 + r) * 72 + ks * 16 + 8 * h);
        const bf16x8 b0 = *(const bf16x8*)(QT + r * 72 + ks * 16 + 8 * h), b1 = *(const bf16x8*)(QT + (32 + r) * 72 + ks * 16 + 8 * h);
        at[0][0] = MFMA(a0, b0, at[0][0]); at[0][1] = MFMA(a0, b1, at[0][1]);
        at[1][0] = MFMA(a1, b0, at[1][0]); at[1][1] = MFMA(a1, b1, at[1][1]);
      }
#pragma unroll
      for (int st = 0; st < 2; ++st)
#pragma unroll
        for (int ct = 0; ct < 2; ++ct)
#pragma unroll
          for (int i = 0; i < 16; ++i) { if (st * 32 + crow(i, h) > ct * 32 + r) at[st][ct][i] = 0.f; }
      f32x16 o[2]; zero16(o[0]); zero16(o[1]);
#pragma unroll
      for (int ct = 0; ct < 2; ++ct)
#pragma unroll
        for (int st = 0; st < 2; ++st) {
          const bf16x8 x0 = packs<0>(at[st][ct]), x1 = packs<1>(at[st][ct]);
          const bf16x8 pb0 = ld2x4(Vt + (vh * 32 + r) * 72 + st * 32 + 4 * h);
          const bf16x8 pb1 = ld2x4(Vt + (vh * 32 + r) * 72 + st * 32 + 16 + 4 * h);
          o[ct] = MFMA(x0, pb0, o[ct]);
          o[ct] = MFMA(x1, pb1, o[ct]);
        }
#pragma unroll
      for (int dt = 0; dt < 2; ++dt) {
        const bf16x8 xs0 = packs<0>(S[dt]), xs1 = packs<1>(S[dt]);
#pragma unroll
        for (int ct = 0; ct < 2; ++ct) {
          const bf16x8 pa0 = ld2x4(QT + (ct * 32 + r) * 72 + dt * 32 + 4 * h);
          const bf16x8 pa1 = ld2x4(QT + (ct * 32 + r) * 72 + dt * 32 + 16 + 4 * h);
          o[ct] = MFMA(pa0, xs0, o[ct]);
          o[ct] = MFMA(pa1, xs1, o[ct]);
        }
      }
#pragma unroll
      for (int dt = 0; dt < 2; ++dt)
#pragma unroll
        for (int i = 0; i < 16; ++i) S[dt][i] *= dec[dt * 32 + crow(i, h)];
#pragma unroll
      for (int ks = 0; ks < 4; ++ks) {
        const bf16x8 bv = *(const bf16x8*)(Vt + (vh * 32 + r) * 72 + ks * 16 + 8 * h);
#pragma unroll
        for (int dt = 0; dt < 2; ++dt) {
          const bf16x8 a = *(const bf16x8*)(KEt + (dt * 32 + r) * 72 + ks * 16 + 8 * h);
          S[dt] = MFMA(a, bv, S[dt]);
        }
      }
#pragma unroll
      for (int ct = 0; ct < 2; ++ct)
#pragma unroll
        for (int i = 0; i < 16; ++i) Ost[(ct * 32 + crow(i, h)) * 68 + vh * 32 + r] = o[ct][i];
    }
    __syncthreads();
    {
      const int c = tid >> 2, sg = tid & 3;
      const int tok = tokof(cid, step, c);
      u16* dst = (dir ? p.ot1 + (size_t)tok * 512 + hh * 64 : p.hn + (size_t)tok * 1024 + 512 + hh * 64) + sg * 16;
      bf16x8 w0, w1;
#pragma unroll
      for (int e = 0; e < 8; ++e) { w0[e] = (short)f2bf(Ost[c * 68 + sg * 16 + e]); w1[e] = (short)f2bf(Ost[c * 68 + sg * 16 + 8 + e]); }
      *(bf16x8*)dst = w0; *(bf16x8*)(dst + 8) = w1;
    }
  }
  if (wave < 2 && !cid.lat) {
#pragma unroll
    for (int dt = 0; dt < 2; ++dt)
#pragma unroll
      for (int i = 0; i < 16; ++i) p.out[OFF_SB + sidx + (dt * 32 + crow(i, h)) * 64 + vh * 32 + r] = S[dt][i];
  }
}

template <int ROLE>
DI void delta_chain(const P* __restrict__ gp, int jj, int it, char* smem, int k0, int kstep, int fs = 0) {
  const P& p = *gp;
  const ChainId cid = chain_decode(it);
  int tid_ = threadIdx.x; asm volatile("" : "+v"(tid_)); const int tid0 = tid_;
  const int hh = cid.h, dir = cid.dir;
  u16* Qn = (u16*)smem; u16* Kt = Qn + 4608; u16* AQK = Kt + 4608; u16* KC = AQK + 4608;
  float* Wv = (float*)(KC + 4608); float* Gs = Wv + 64 * 65; u16* Kn = (u16*)(Gs + 64); float* At = (float*)(Kn + 4608); float* Bt = At + 64 * 68;
  constexpr int IMG = 4 * 9216 + 16640 + 256;
  char* slots = uni(p.ring) + (size_t)it * RING * SLOT_BYTES; int* ready = uni(p.flags) + (jj * 2 + 1 + 4 * fs) * 8320 + it * 64; int* done = uni(p.flags) + (jj * 2 + 1 + 4 * fs) * 8320 + 8192 + it;
  const float aexp = __expf(p.d_a_log[(jj * 2 + dir) * 8 + hh]);
  const float dtb = p.d_dt_bias[(jj * 2 + dir) * 8 + hh];
  f32x16 S[2]; zero16(S[0]); zero16(S[1]);
  const size_t sidx = ((size_t)(((cid.b * 2 + jj) * 2 + dir) * 8 + hh)) * 4096;
  { const int tid = tid0, lane = tid & 63, wave = tid >> 6, r = lane & 31, h = lane >> 5;
  if (ROLE != 1 && wave < 2 && cid.lat) {
    const int vh = wave & 1;
#pragma unroll
    for (int dt = 0; dt < 2; ++dt)
#pragma unroll
      for (int i = 0; i < 16; ++i) S[dt][i] = p.state_d[sidx + (dt * 32 + crow(i, h)) * 64 + vh * 32 + r];
  }
  }
  u16* CW = (u16*)(smem + 80640);
  __syncthreads();
  for (int i = tid0; i < 576; i += 256) { const int tap = i / 192, c2 = i - tap * 192; const int wh = c2 >> 6, dd = c2 & 63;
    CW[i] = f2bf(p.d_conv[(size_t)jj * 3 * 1536 + tap * 1536 + wh * 512 + hh * 64 + dd]); }
  for (int step_ = k0; step_ < cid.nch; step_ += kstep) {
    int step = step_;
    asm volatile("" : "+v"(step));
    if (ROLE == 1) wait_ge(done, step_ - RING + 1, tid0);
    if (ROLE == 2) wait_ge(ready + step_, 1, tid0);
    __syncthreads();
    if (ROLE == 2) { copy_in_t<IMG>(smem, slots + (size_t)(step_ % RING) * SLOT_BYTES, tid0); __syncthreads(); if (tid0 == 0) __hip_atomic_store(done, step_ + 1, __ATOMIC_RELAXED, __HIP_MEMORY_SCOPE_AGENT); }
    if (ROLE != 2) {
    {const int tid = opq(tid0), lane = tid & 63, wave = __builtin_amdgcn_readfirstlane(tid >> 6), r = lane & 31, h = lane >> 5, vh = wave & 1; (void)r; (void)h; (void)vh; (void)lane;
    if (wave == 0) {
      const int tok = tokof(cid, step, lane);
      const float da = bf2f(p.proj[(size_t)tok * ODN + 2304 + dir * 8 + hh]);
      const float db = bf2f(p.proj[(size_t)tok * ODN + 2320 + dir * 8 + hh]);
      const float x = da + dtb;
      const float sp = x > 20.f ? x : __logf(1.f + __expf(x));
      float G = -aexp * sp;
#pragma unroll
      for (int o = 1; o < 64; o <<= 1) { const float t = __int_as_float(__builtin_amdgcn_ds_bpermute((lane - o) << 2, __float_as_int(G))); if (lane >= o) G += t; }
      Gs[lane] = G; Bt[lane] = 1.f / (1.f + __expf(-db));
    }
    {
      const int c = tid >> 2, sg = tid & 3;
      const int tok = tokof(cid, step, c);
      const int pos = tok - cid.base;
      const bool hp = pos > 0, hn_ = pos < cid.T - 1;
#pragma unroll 1
      for (int wh = 0; wh < 3; ++wh) {
        const int ch0 = wh * 512 + hh * 64 + sg * 16;
        const u16* cur = p.proj + (size_t)tok * ODN + 768 + ch0;
        float y[16];
        float ss = 0.f;
#pragma unroll
        for (int hf = 0; hf < 2; ++hf) {
          const bf16x8 xc = *(const bf16x8*)(cur + hf * 8);
          bf16x8 xp, xn;
#pragma unroll
          for (int e = 0; e < 8; ++e) { xp[e] = 0; xn[e] = 0; }
          if (hp) xp = *(const bf16x8*)(cur - ODN + hf * 8);
          if (hn_) xn = *(const bf16x8*)(cur + ODN + hf * 8);
#pragma unroll
          for (int e = 0; e < 8; ++e) {
            const int ch = wh * 64 + sg * 16 + hf * 8 + e;
            float v = bf2f(CW[ch]) * bf2f((u16)xp[e]) + bf2f(CW[192 + ch]) * bf2f((u16)xc[e]) + bf2f(CW[384 + ch]) * bf2f((u16)xn[e]);
            v = v / (1.f + __expf(-v));
            y[hf * 8 + e] = v; ss += v * v;
          }
        }
        ss += shx(ss, lane, 1); ss += shx(ss, lane, 2);
        const float rn = rsqrtf(ss + 1e-6f);
        if (wh == 0) {
#pragma unroll
          for (int e = 0; e < 16; ++e) Qn[c * 72 + sg * 16 + e] = f2bf(y[e] * rn * 0.125f);
        } else if (wh == 1) {
#pragma unroll
          for (int e = 0; e < 16; ++e) { const u16 kb = f2bf(y[e] * rn); Kn[c * 72 + sg * 16 + e] = kb; Kt[(sg * 16 + e) * 72 + c] = kb; }
        } else {
#pragma unroll
          for (int e = 0; e < 16; ++e) Wv[c * 65 + sg * 16 + e] = y[e];
        }
      }
    }
    }
    __syncthreads();
    {const int tid = opq(tid0), lane = tid & 63, wave = __builtin_amdgcn_readfirstlane(tid >> 6), r = lane & 31, h = lane >> 5, vh = wave & 1; (void)r; (void)h; (void)vh; (void)lane;
    if (wave < 2) {
      f32x16 akk[2], aqk[2]; zero16(akk[0]); zero16(akk[1]); zero16(aqk[0]); zero16(aqk[1]);
#pragma unroll
      for (int ks = 0; ks < 4; ++ks) {
        const bf16x8 bk = *(const bf16x8*)(Kn + (vh * 32 + r) * 72 + ks * 16 + 8 * h);
#pragma unroll
        for (int ct = 0; ct < 2; ++ct) {
          const bf16x8 ak = *(const bf16x8*)(Kn + (ct * 32 + r) * 72 + ks * 16 + 8 * h);
          const bf16x8 aq = *(const bf16x8*)(Qn + (ct * 32 + r) * 72 + ks * 16 + 8 * h);
          akk[ct] = MFMA(ak, bk, akk[ct]);
          aqk[ct] = MFMA(aq, bk, aqk[ct]);
        }
      }
      const int s = vh * 32 + r;
      const float Gss = Gs[s];
#pragma unroll
      for (int ct = 0; ct < 2; ++ct)
#pragma unroll
        for (int g4 = 0; g4 < 4; ++g4) {
          const int c0 = ct * 32 + 8 * g4 + 4 * h;
          const float4 gv4 = *(const float4*)(Gs + c0), bv4 = *(const float4*)(Bt + c0);
          float4 val;
#pragma unroll
          for (int e = 0; e < 4; ++e) {
            const int c = c0 + e;
            const float Gc = e == 0 ? gv4.x : e == 1 ? gv4.y : e == 2 ? gv4.z : gv4.w;
            const float Bc = e == 0 ? bv4.x : e == 1 ? bv4.y : e == 2 ? bv4.z : bv4.w;
            const float gam = __expf(fminf(Gc - Gss, 0.f));
            const float av = (s < c) ? akk[ct][4 * g4 + e] * Bc * gam : 0.f;
            if (e == 0) val.x = av; else if (e == 1) val.y = av; else if (e == 2) val.z = av; else val.w = av;
            AQK[c * 72 + s] = f2bf((s <= c) ? aqk[ct][4 * g4 + e] * gam : 0.f);
          }
          *(float4*)(At + s * 68 + c0) = val;
        }
    }
    }
    __syncthreads();
    {const int tid = opq(tid0), lane = tid & 63, wave = __builtin_amdgcn_readfirstlane(tid >> 6), r = lane & 31, h = lane >> 5, vh = wave & 1; (void)r; (void)h; (void)vh; (void)lane;
    if (wave < 2) {
      const bool isv = wave == 0;
      const int col = lane;
#pragma unroll 1
      for (int bi = 0; bi < 4; ++bi) {
        float acc[16];
#pragma unroll
        for (int ci = 0; ci < 16; ++ci) {
          const int c = 16 * bi + ci;
          acc[ci] = isv ? Wv[c * 65 + col] * Bt[c] : bf2f(Kn[c * 72 + col]) * Bt[c] * __expf(Gs[c]);
        }
#pragma unroll 8
        for (int s2 = 0; s2 < 16 * bi; ++s2) {
          const float xs = isv ? Wv[s2 * 65 + col] : bf2f(KC[s2 * 72 + col]);
          const float4* a4 = (const float4*)(At + s2 * 68 + 16 * bi);
#pragma unroll
          for (int q = 0; q < 4; ++q) {
            const float4 a = a4[q];
            acc[4 * q] -= a.x * xs; acc[4 * q + 1] -= a.y * xs; acc[4 * q + 2] -= a.z * xs; acc[4 * q + 3] -= a.w * xs;
          }
        }
#pragma unroll
        for (int ci = 0; ci < 16; ++ci) {
          const float x = acc[ci];
          const float* arow = At + (16 * bi + ci) * 68 + 16 * bi;
#pragma unroll
          for (int cj = ci + 1; cj < 16; ++cj) acc[cj] -= arow[cj] * x;
          if (isv) Wv[(16 * bi + ci) * 65 + col] = x; else KC[(16 * bi + ci) * 72 + col] = f2bf(x);
        }
      }
    }
    }
    __syncthreads();
    }
    if (ROLE == 1) { copy_out(smem, slots + (size_t)(step_ % RING) * SLOT_BYTES, IMG, tid0); publish(ready + step_, 1, tid0); continue; }
    {const int tid = opq(tid0), lane = tid & 63, wave = __builtin_amdgcn_readfirstlane(tid >> 6), r = lane & 31, h = lane >> 5, vh = wave & 1; (void)r; (void)h; (void)vh; (void)lane;
    if (wave < 2) {
      f32x16 kS[2], qS[2]; zero16(kS[0]); zero16(kS[1]); zero16(qS[0]); zero16(qS[1]);
#pragma unroll
      for (int dt = 0; dt < 2; ++dt) {
        const bf16x8 xs0 = packs<0>(S[dt]), xs1 = packs<1>(S[dt]);
#pragma unroll
        for (int ct = 0; ct < 2; ++ct) {
          kS[ct] = MFMA(ld2x4(KC + (ct * 32 + r) * 72 + dt * 32 + 4 * h), xs0, kS[ct]);
          kS[ct] = MFMA(ld2x4(KC + (ct * 32 + r) * 72 + dt * 32 + 16 + 4 * h), xs1, kS[ct]);
          qS[ct] = MFMA(ld2x4(Qn + (ct * 32 + r) * 72 + dt * 32 + 4 * h), xs0, qS[ct]);
          qS[ct] = MFMA(ld2x4(Qn + (ct * 32 + r) * 72 + dt * 32 + 16 + 4 * h), xs1, qS[ct]);
        }
      }
      f32x16 vn[2], o[2];
      const float Glast = Gs[63];
#pragma unroll
      for (int ct = 0; ct < 2; ++ct)
#pragma unroll
        for (int i = 0; i < 16; ++i) {
          const int c = ct * 32 + crow(i, h);
          vn[ct][i] = Wv[c * 65 + vh * 32 + r] - kS[ct][i];
          o[ct][i] = qS[ct][i] * __expf(Gs[c]);
        }
#pragma unroll
      for (int st = 0; st < 2; ++st) {
        const bf16x8 xs0 = packs<0>(vn[st]), xs1 = packs<1>(vn[st]);
#pragma unroll
        for (int ct = 0; ct < 2; ++ct) {
          o[ct] = MFMA(ld2x4(AQK + (ct * 32 + r) * 72 + st * 32 + 4 * h), xs0, o[ct]);
          o[ct] = MFMA(ld2x4(AQK + (ct * 32 + r) * 72 + st * 32 + 16 + 4 * h), xs1, o[ct]);
        }
      }
      const float dl = __expf(Glast);
#pragma unroll
      for (int st = 0; st < 2; ++st) {
        asm volatile("" ::: "memory");
#pragma unroll
        for (int i = 0; i < 16; ++i) vn[st][i] *= __expf(Glast - Gs[st * 32 + crow(i, h)]);
      }
      asm volatile("" ::: "memory");
#pragma unroll
      for (int dt = 0; dt < 2; ++dt)
#pragma unroll
        for (int i = 0; i < 16; ++i) S[dt][i] *= dl;
#pragma unroll
      for (int st = 0; st < 2; ++st) {
        const bf16x8 xs0 = packs<0>(vn[st]), xs1 = packs<1>(vn[st]);
#pragma unroll
        for (int dt = 0; dt < 2; ++dt) {
          S[dt] = MFMA(ld2x4(Kt + (dt * 32 + r) * 72 + st * 32 + 4 * h), xs0, S[dt]);
          S[dt] = MFMA(ld2x4(Kt + (dt * 32 + r) * 72 + st * 32 + 16 + 4 * h), xs1, S[dt]);
        }
      }
#pragma unroll
      for (int ct = 0; ct < 2; ++ct)
#pragma unroll
        for (int i = 0; i < 16; ++i) At[(ct * 32 + crow(i, h)) * 68 + vh * 32 + r] = o[ct][i];
    }
    }
    __syncthreads();
    {
      const int tid = opq(tid0);
      const int c = tid >> 2, sg = tid & 3;
      const int tok = tokof(cid, step, c);
      u16* dst = (dir ? p.ot1 + (size_t)tok * 512 + hh * 64 : p.hn + (size_t)tok * 1024 + 512 + hh * 64) + sg * 16;
      bf16x8 w0, w1;
#pragma unroll
      for (int e = 0; e < 8; ++e) { w0[e] = (short)f2bf(At[c * 68 + sg * 16 + e]); w1[e] = (short)f2bf(At[c * 68 + sg * 16 + 8 + e]); }
      *(bf16x8*)dst = w0; *(bf16x8*)(dst + 8) = w1;
    }
  }
  {const int tid = opq(tid0), lane = tid & 63, wave = __builtin_amdgcn_readfirstlane(tid >> 6), r = lane & 31, h = lane >> 5, vh = wave & 1; (void)r; (void)h; (void)vh; (void)lane;
  if (wave < 2 && !cid.lat) {
#pragma unroll
    for (int dt = 0; dt < 2; ++dt)
#pragma unroll
      for (int i = 0; i < 16; ++i) p.out[OFF_SD + sidx + (dt * 32 + crow(i, h)) * 64 + vh * 32 + r] = S[dt][i];
  }
}
}

DI void mixer_phase(const P* __restrict__ gp, int l, char* smem, int fs = 0) {
  const P& p = *gp;
  const bool even = !(l & 1); const int jj = l >> 1;
  const bool teams = gridDim.x >= 512;
  if (teams) {
    const int bid = blockIdx.x;
    const int K = 3;
    if (bid < 128 * (K + 1)) {
      if (bid < 128) { if (even) gla_chain<2>(gp, jj, bid, smem, 0, 1, fs); else delta_chain<2>(gp, jj, bid, smem, 0, 1, fs); }
      else { const int ch = (bid - 128) & 127, k = (bid - 128) >> 7; if (even) gla_chain<1>(gp, jj, ch, smem, k, K, fs); else delta_chain<1>(gp, jj, ch, smem, k, K, fs); }
    }
  }
  const int first = teams ? 128 : 0;
  const int total = 384 + 2048 + 256;
  int* s_item = (int*)(smem + SMEM_BYTES - 16);
  int* cntp = uni(p.cnt) + l + 4 * fs;
  for (;;) {
    __syncthreads();
    if (opq(threadIdx.x) == 0) *s_item = atomicAdd(cntp, 1) + first;
    __syncthreads();
    const int item = __builtin_amdgcn_readfirstlane(*s_item);
    if (item >= total) break;
    if (item < 384) { if (even) gla_chain<0>(gp, jj, item, smem, 0, 1); else delta_chain<0>(gp, jj, item, smem, 0, 1); }
    else if (item < 384 + 2048) { if (even) attn_item<1>(gp, jj, item - 384, smem); else attn_item<3>(gp, jj, item - 384, smem); }
    else { if (even) attn_item<0>(gp, jj, item - 384 - 2048, smem); else attn_item<2>(gp, jj, item - 384 - 2048, smem); }
  }
}

DI void finalize_phase(const P* __restrict__ gp, int l) {
  const P& p = *gp;
  const bool even = !(l & 1); const int jj = l >> 1;
  int tid_ = threadIdx.x; asm volatile("" : "+v"(tid_)); const int tid = tid_;
  const int tk = tid >> 5, hh = (tid >> 2) & 7, sg = tid & 3;
  const int PS = even ? EVN : ODN; const int zcol = even ? 3104 : 2336;
  for (int item = blockIdx.x; item < NT_ / 8; item += gridDim.x) {
    const size_t tok = (size_t)item * 8 + tk;
    u16* a = p.hn + tok * 1024 + 512 + hh * 64 + sg * 16;
    const u16* bsrc = p.ot1 + tok * 512 + hh * 64 + sg * 16;
    const u16* zs = p.proj + tok * PS + zcol + hh * 64 + sg * 16;
    float o[16]; float ss = 0.f;
#pragma unroll
    for (int hf = 0; hf < 2; ++hf) {
      const bf16x8 x0 = *(const bf16x8*)(a + hf * 8), x1 = *(const bf16x8*)(bsrc + hf * 8);
#pragma unroll
      for (int e = 0; e < 8; ++e) { const float v = bf2f((u16)x0[e]) + bf2f((u16)x1[e]); o[hf * 8 + e] = v; ss += v * v; }
    }
    ss += shx(ss, tid & 63, 1); ss += shx(ss, tid & 63, 2);
    const float rstd = rsqrtf(ss * (1.f / 64.f) + 1e-6f);
    const float* ng = even ? p.b_norm_g + jj * 512 + hh * 64 + sg * 16 : p.d_norm_g + jj * 64 + sg * 16;
#pragma unroll
    for (int hf = 0; hf < 2; ++hf) {
      const bf16x8 z = *(const bf16x8*)(zs + hf * 8);
      bf16x8 w;
#pragma unroll
      for (int e = 0; e < 8; ++e) { const float zz = bf2f((u16)z[e]); w[e] = (short)f2bf(o[hf * 8 + e] * rstd * ng[hf * 8 + e] * siluf(zz)); }
      *(bf16x8*)(a + hf * 8) = w;
    }
  }
}


#define XB_TMO      128
#define XB_XCNT(j)  (256  + 64 * (j))
#define XB_XSUB(j)  (1280 + 64 * (j))
#define XB_XGEN(j)  (2304 + 64 * (j))
#define XB_TOP      3328
#define XB_TOPGEN   3392
#define XCD_BAR_WORDS 3456
#define XB_SPIN_CAP (1u << 18)
#define LAS __attribute__((address_space(3)))
DI unsigned xb_ld(unsigned* q)              { return __hip_atomic_load(q, __ATOMIC_RELAXED, __HIP_MEMORY_SCOPE_AGENT); }
DI unsigned xb_add(unsigned* q, unsigned v) { return __hip_atomic_fetch_add(q, v, __ATOMIC_RELAXED, __HIP_MEMORY_SCOPE_AGENT); }
DI unsigned xb_xcc_id() { return (unsigned)__builtin_amdgcn_s_getreg((3 << 11) | 20) & 0xFu; }
#define XB_SPIN(cond, bar) do { unsigned _sp = 0; while (cond) { __builtin_amdgcn_s_sleep(1); \
    if ((++_sp & 255u) == 0u) { if (xb_ld(&(bar)[XB_TMO])) break; if (_sp > XB_SPIN_CAP) { atomicAdd(&(bar)[XB_TMO], 1u); break; } } } } while (0)
struct XcdBarrier { unsigned* bar; unsigned x; volatile LAS unsigned* st; };
DI XcdBarrier xcd_barrier_post(unsigned* bar, volatile LAS unsigned* st) {
  XcdBarrier b; b.bar = bar; b.x = xb_xcc_id(); b.st = st;
  if (threadIdx.x == 0) (void)xb_add(&bar[XB_XCNT(b.x)], 1u);
  return b;
}
DI void xcd_barrier_complete(unsigned* bar, unsigned x, unsigned& nloc, unsigned& nx) {
  const unsigned G = gridDim.x * gridDim.y * gridDim.z;
  unsigned sum, cnt, mine, sp = 0u;
  for (;;) {
    sum = 0u; cnt = 0u; mine = 0u;
#pragma unroll
    for (unsigned j = 0; j < 16; ++j) { const unsigned c = xb_ld(&bar[XB_XCNT(j)]); sum += c; cnt += (c > 0u) ? 1u : 0u; mine = (j == x) ? c : mine; }
    if (sum == G) break;
    __builtin_amdgcn_s_sleep(1);
    if ((++sp & 255u) == 0u) { if (xb_ld(&bar[XB_TMO])) break; if (sp > XB_SPIN_CAP) { atomicAdd(&bar[XB_TMO], 1u); break; } }
  }
  nloc = mine > 0u ? mine : 1u; nx = cnt > 0u ? cnt : 1u;
}
DI void xcd_barrier(const XcdBarrier& b) {
  asm volatile("s_waitcnt vmcnt(0)" ::: "memory");
  __syncthreads();
  if (threadIdx.x == 0) {
    unsigned* bar = b.bar;
    __builtin_amdgcn_s_waitcnt(0);
    unsigned nloc = b.st[0], nx = b.st[1];
    if (nloc == 0u) { xcd_barrier_complete(bar, b.x, nloc, nx); b.st[0] = nloc; b.st[1] = nx; }
    const unsigned old = xb_add(&bar[XB_XSUB(b.x)], 1u);
    const unsigned gen = old / nloc;
    if (old + 1u == (gen + 1u) * nloc) {
      __builtin_amdgcn_fence(__ATOMIC_RELEASE, "agent");
      asm volatile("s_waitcnt vmcnt(0)" ::: "memory");
      const unsigned og = xb_add(&bar[XB_TOP], 1u);
      const unsigned tg = og / nx;
      if (og + 1u == (tg + 1u) * nx) xb_add(&bar[XB_TOPGEN], 1u);
      else XB_SPIN(xb_ld(&bar[XB_TOPGEN]) == tg, bar);
      __builtin_amdgcn_fence(__ATOMIC_ACQUIRE, "agent");
      xb_add(&bar[XB_XGEN(b.x)], 1u);
      asm volatile("s_waitcnt vmcnt(0)" ::: "memory");
    } else {
      XB_SPIN(xb_ld(&bar[XB_XGEN(b.x)]) == gen, bar);
      __builtin_amdgcn_fence(__ATOMIC_ACQUIRE, "agent");
      asm volatile("s_waitcnt vmcnt(0)" ::: "memory");
    }
  }
  __syncthreads();
}

DI void run_phase(const P* __restrict__ gp, int ph, char* smem) {
  const P& p = *gp;
  if (ph == 0) { prep_phase(gp, smem); return; }
  if (ph == NPH - 1) { norm_phase(gp, 0, 0, false, true); return; }
  const int l = (ph - 1) >> 3, s = (ph - 1) & 7;
  const bool even = !(l & 1);
  const u16* W = uni(p.wt) + (size_t)l * LW;
  const u16* hnp = uni(p.hn); const u16* projp = uni(p.proj);
  switch (s) {
    case 0: norm_phase(gp, l, 0, l == 0, false); break;
    case 1: gemm_phase<EPI_PROJ>(gp, l, smem, hnp, 1024, W + WO_IN, 1024, 1024, 288, even ? 29 : 23, 0); break;
    case 2: mixer_phase(gp, l, smem); break;
    case 3: finalize_phase(gp, l); break;
    case 4: gemm_phase<EPI_RES>(gp, l, smem, hnp, 1024, W + WO_OUT, 1024, 1024, 288, 8, 2); break;
    case 5: norm_phase(gp, l, 1, false, false); break;
    case 6: gemm_phase<EPI_FFN>(gp, l, smem, hnp, 1024, W + WO_UP, 1024, 1024, 312, 44, 0); break;
    case 7: gemm_phase<EPI_RES>(gp, l, smem, projp, 2816, W + WO_DN, 2816, 2816, 288, 8, 5); break;
  }
}

__global__ void __launch_bounds__(256, 2) mk(P p, P* gpmem, int ph0, int ph1) {
  __shared__ __attribute__((aligned(16))) char smem[SMEM_BYTES];
  const P* gp = &p;
  if (ph1 - ph0 > 1) {
    cg::grid_group grid = cg::this_grid();
    volatile LAS unsigned* xst = (volatile LAS unsigned*)(smem + SMEM_BYTES - 32);
    if (threadIdx.x == 0) { xst[0] = 0u; xst[1] = 0u; }
    __syncthreads();
    const XcdBarrier xbar = xcd_barrier_post(p.bar, xst);
    for (int ph = ph0; ph < ph1; ++ph) {
      run_phase(gp, ph, smem);
      if (ph + 1 < ph1) { if (ph == ph0) grid.sync(); else xcd_barrier(xbar); }
    }
  } else {
    run_phase(gp, ph0, smem);
  }
}

extern "C" void kernel_launch(void* const* d_in, const int* in_sizes, int n_in, void* d_out, int out_size, void* d_ws, size_t ws_size,
                              hipStream_t stream) {
  P p{};
  const float** f = (const float**)&p;
  for (int i = 0; i < 31; ++i) f[i] = (const float*)d_in[i];
  p.out = (float*)d_out;
  char* ws = (char*)d_ws;
  size_t off = 0;
  p.hn = (u16*)(ws + off); off += (size_t)NT_ * 1024 * 2;
  p.proj = (u16*)(ws + off); off += (size_t)NT_ * EVN * 2;
  p.ot1 = (u16*)(ws + off); off += (size_t)NT_ * 512 * 2;
  p.wt = (u16*)(ws + off); off += 4 * LW * 2;
  p.mods = (float*)(ws + off); off += 4 * 9 * 6144 * 4;
  p.rope = (float*)(ws + off); off += 64 * 16 * 2 * 4;
  P* gp = (P*)(ws + off); off += 4096;
  p.cnt = (int*)(ws + off); off += 256;
  p.flags = (int*)(ws + off); off += 8 * 8320 * 4;
  off = (off + 255) & ~(size_t)255;
  p.ring = ws + off; off += (size_t)128 * RING * SLOT_BYTES;
  p.bar = (unsigned*)(ws + off); off += XCD_BAR_WORDS * 4;
  static int grid_blocks = 0;
  if (!grid_blocks) {
    int dev = 0, cus = 0, per_cu = 0;
    hipGetDevice(&dev);
    hipDeviceGetAttribute(&cus, hipDeviceAttributeMultiprocessorCount, dev);
    hipOccupancyMaxActiveBlocksPerMultiprocessor(&per_cu, mk, 256, 0);
    if (per_cu < 1) per_cu = 1;
    if (per_cu > 2) per_cu = 2;
    grid_blocks = cus * per_cu;
  }
#if MK_MULTI
  for (int ph = 0; ph < NPH; ++ph) {
    int a = ph, b = ph + 1;
    hipLaunchKernelGGL(mk, dim3(grid_blocks), dim3(256), 0, stream, p, gp, a, b);
  }
#else
  hipMemsetAsync(p.bar, 0, XCD_BAR_WORDS * 4, stream);
  int ph0 = 0, ph1 = NPH;
  void* args[] = {&p, &gp, &ph0, &ph1};
  hipError_t e = hipLaunchCooperativeKernel((void*)mk, dim3(grid_blocks), dim3(256), args, 0, stream);
  if (e != hipSuccess) fprintf(stderr, "cooperative launch failed: %s (grid %d)\n", hipGetErrorString(e), grid_blocks);
#endif
}
```

```cpp
#include <hip/hip_runtime.h>
#include <hip/hip_cooperative_groups.h>
#include <cstdio>
namespace cg = cooperative_groups;

#ifndef MK_MULTI
#define MK_MULTI 0
#endif

#define DI __device__ __forceinline__
#define DN __device__ __noinline__
typedef unsigned short u16;
typedef __attribute__((ext_vector_type(8))) short bf16x8;
typedef __attribute__((ext_vector_type(4))) short s16x4;
typedef __attribute__((ext_vector_type(16))) float f32x16;
#define MFMA(a, b, c) __builtin_amdgcn_mfma_f32_32x32x16_bf16((a), (b), (c), 0, 0, 0)

static constexpr int NP_ = 4096, NT_ = 36864;
static constexpr int EVN = 3616, ODN = 2848;
static constexpr size_t OFF_AK = 37748736, OFF_AV = 41943040, OFF_SB = 46137344, OFF_CK = 48234496, OFF_CV = 49283072, OFF_SD = 50331648;
static constexpr size_t LW = 13631488, WO_UP = 0, WO_DN = 5767168, WO_IN = 8650752, WO_OUT = 12582912;
static constexpr int NPH = 34;
static constexpr int SMEM_BYTES = 80 * 1024;

struct P {
  const float *x_prompt, *x_sample, *cache_a_k, *cache_a_v, *state_b, *cache_c_k, *cache_c_v, *state_d, *c, *c_ctx, *ada_w, *ada_b,
      *norm1_g, *norm2_g, *ffn_up, *ffn_conv, *ffn_down, *ev_w_in, *ev_w_out, *a_rpb, *b_w_g2, *b_b_g, *b_norm_g, *od_w_in, *od_w_out,
      *c_sink, *d_conv, *d_a_log, *d_dt_bias, *d_norm_g, *final_g;
  float* out;
  u16 *hn, *proj, *ot1, *wt;
  float *mods, *rope;
  int* cnt;
  int* flags;
  char* ring;
  unsigned* bar;
};

typedef __attribute__((ext_vector_type(2))) __bf16 bf2_t;
typedef __attribute__((ext_vector_type(2))) float f2_t;
typedef __attribute__((ext_vector_type(4))) unsigned u32x4_t;
DI unsigned pk2(float a, float b) { const f2_t v = {a, b}; return __builtin_bit_cast(unsigned, __builtin_convertvector(v, bf2_t)); }
DI u16 f2bf(float x) { return __builtin_bit_cast(u16, (__bf16)x); }
DI float bf2f(u16 b) { return __uint_as_float(((unsigned)b) << 16); }
DI int crow(int i, int h) { return (i & 3) + 8 * (i >> 2) + 4 * h; }
template <int S> DI bf16x8 packs(const f32x16& x) {
  u32x4_t v;
  v[0] = pk2(x[8 * S], x[8 * S + 1]); v[1] = pk2(x[8 * S + 2], x[8 * S + 3]); v[2] = pk2(x[8 * S + 4], x[8 * S + 5]); v[3] = pk2(x[8 * S + 6], x[8 * S + 7]);
  return __builtin_bit_cast(bf16x8, v);
}
DI bf16x8 ld2x4(const u16* p) {
  s16x4 lo = *(const s16x4*)p, hi = *(const s16x4*)(p + 8);
  return __builtin_shufflevector(lo, hi, 0, 1, 2, 3, 4, 5, 6, 7);
}
DI float siluf(float x) { return x / (1.f + __expf(-x)); }
DI int opq(int x) { asm volatile("" : "+v"(x)); return x; }
DI float shx(float v, int lane, int o) { return __int_as_float(__builtin_amdgcn_ds_bpermute((lane ^ o) << 2, __float_as_int(v))); }
template <class T> DI T* uni(T* q) { return q; }
DI void zero16(f32x16& a) {
#pragma unroll
  for (int i = 0; i < 16; ++i) a[i] = 0.f;
}

DI void prep_phase(const P* __restrict__ gp, char* smem) {
  const P& p = *gp;
  int tid_ = threadIdx.x; asm volatile("" : "+v"(tid_)); const int tid = tid_;
  const int NWT = 4 * (1408 + 704 + 256) + 2 * (960 + 768);
  const int NADA = 384;
  const int total = NWT + NADA + 1;
  for (int item = blockIdx.x; item < total; item += gridDim.x) {
    if (item < NWT) {
      int rem = item; const float* src = nullptr; u16* dst = nullptr; int K = 0, N = 0, NPd = 0;
      for (int l = 0; l < 4; ++l) {
        const int jj = l >> 1; const bool ev = !(l & 1);
        const int nin = ev ? 960 : 768;
        if (rem < 1408) { src = p.ffn_up + (size_t)l * 1024 * 5632; dst = p.wt + l * LW + WO_UP; K = 1024; N = 5632; NPd = 5632; break; }
        rem -= 1408;
        if (rem < 704) { src = p.ffn_down + (size_t)l * 2816 * 1024; dst = p.wt + l * LW + WO_DN; K = 2816; N = 1024; NPd = 1024; break; }
        rem -= 704;
        if (rem < nin) { src = ev ? p.ev_w_in + (size_t)jj * 1024 * EVN : p.od_w_in + (size_t)jj * 1024 * ODN; dst = p.wt + l * LW + WO_IN; K = 1024; N = ev ? EVN : ODN; NPd = ev ? 3840 : 3072; break; }
        rem -= nin;
        if (rem < 256) { src = (ev ? p.ev_w_out : p.od_w_out) + (size_t)jj * 1024 * 1024; dst = p.wt + l * LW + WO_OUT; K = 1024; N = 1024; NPd = 1024; break; }
        rem -= 256;
      }
      const int ntn = NPd >> 6;
      const int tk = rem / ntn, tn = rem - tk * ntn;
      const int scol0 = (N == 5632) ? (((tn >> 1) & 1) * 2816 + (tn >> 2) * 128 + (tn & 1) * 64) : tn * 64;
      float* T = (float*)smem;
      __syncthreads();
#pragma unroll
      for (int i = 0; i < 16; ++i) {
        const int k = i * 4 + (tid >> 6), n = tid & 63;
        const int gn = scol0 + n;
        T[k * 65 + n] = (gn < N) ? src[(size_t)(tk * 64 + k) * N + gn] : 0.f;
      }
      __syncthreads();
#pragma unroll
      for (int i = 0; i < 2; ++i) {
        const int q = tid + 256 * i; const int n = q & 63, kc = q >> 6;
        const int pn = tn * 64 + n; const int nt32 = pn >> 5, rr = pn & 31;
        const int kstep = tk * 4 + (kc >> 1), hh = kc & 1;
        bf16x8 w;
#pragma unroll
        for (int j = 0; j < 8; ++j) w[j] = (short)f2bf(T[(kc * 8 + j) * 65 + n]);
        *(bf16x8*)(dst + ((size_t)(nt32 * (K >> 4) + kstep) * 64 + hh * 32 + rr) * 8) = w;
      }
    } else if (item < NWT + NADA) {
      const int it = item - NWT; const int l = it / 96, cgp = it - l * 96; const int n0 = cgp * 64;
      float* sc = (float*)smem;
      float* red = sc + 9 * 1024;
      __syncthreads();
      for (int idx = tid; idx < 9 * 1024; idx += 256) {
        const int ci = idx >> 10, k = idx & 1023;
        const float x = ci < 8 ? p.c[ci * 1024 + k] : p.c_ctx[k];
        sc[idx] = x / (1.f + expf(-x));
      }
      __syncthreads();
      const int wave = tid >> 6, lane = tid & 63;
      float acc[9];
#pragma unroll
      for (int ci = 0; ci < 9; ++ci) acc[ci] = 0.f;
      const float* wp = p.ada_w + ((size_t)l * 1024 + wave * 256) * 6144 + n0 + lane;
#pragma unroll 8
      for (int k = 0; k < 256; ++k) {
        const float wv = wp[(size_t)k * 6144];
#pragma unroll
        for (int ci = 0; ci < 9; ++ci) acc[ci] += sc[ci * 1024 + wave * 256 + k] * wv;
      }
#pragma unroll
      for (int ci = 0; ci < 9; ++ci) red[(wave * 9 + ci) * 64 + lane] = acc[ci];
      __syncthreads();
      for (int idx = tid; idx < 576; idx += 256) {
        const int ci = idx >> 6, col = idx & 63;
        const float s = red[(0 * 9 + ci) * 64 + col] + red[(1 * 9 + ci) * 64 + col] + red[(2 * 9 + ci) * 64 + col] + red[(3 * 9 + ci) * 64 + col];
        p.mods[(size_t)(l * 9 + ci) * 6144 + n0 + col] = s + p.ada_b[l * 6144 + n0 + col];
      }
    } else {
      if (tid < 8) p.cnt[tid] = 0;
      for (int i = tid; i < 8 * 8320; i += 256) p.flags[i] = 0;
      for (int idx = tid; idx < 1024; idx += 256) {
        const int pos = idx >> 4, fi = idx & 15;
        const float inv = powf(10000.f, -(float)fi / 16.f);
        const float ang = (float)pos * inv;
        p.rope[idx * 2] = cosf(ang); p.rope[idx * 2 + 1] = sinf(ang);
      }
    }
  }
}

DI void norm_phase(const P* __restrict__ gp, int l, int which, bool first, bool fin) {
  const P& p = *gp;
  int tid_ = threadIdx.x; asm volatile("" : "+v"(tid_)); const int tid = tid_, lane = tid & 63, wave = tid >> 6;
  for (int item = blockIdx.x; item < NT_ / 8; item += gridDim.x) {
    float4 v[2][4];
    float ss[2];
#pragma unroll
    for (int u = 0; u < 2; ++u) {
      const int tok = item * 8 + u * 4 + wave;
      const float* src = first ? (tok < NP_ ? p.x_prompt + (size_t)tok * 1024 : p.x_sample + (size_t)(tok - NP_) * 1024) : p.out + (size_t)tok * 1024;
#pragma unroll
      for (int i = 0; i < 4; ++i) v[u][i] = ((const float4*)src)[lane + 64 * i];
    }
#pragma unroll
    for (int u = 0; u < 2; ++u) {
      float a = 0.f;
#pragma unroll
      for (int i = 0; i < 4; ++i) a += v[u][i].x * v[u][i].x + v[u][i].y * v[u][i].y + v[u][i].z * v[u][i].z + v[u][i].w * v[u][i].w;
#pragma unroll
      for (int o = 32; o >= 1; o >>= 1) a += shx(a, lane, o);
      ss[u] = a;
    }
#pragma unroll
    for (int u = 0; u < 2; ++u) {
      const int tok = item * 8 + u * 4 + wave;
      const float rstd = rsqrtf(ss[u] * (1.f / 1024.f) + 1e-6f);
      if (fin) {
#pragma unroll
        for (int i = 0; i < 4; ++i) {
          const float4 g = ((const float4*)p.final_g)[lane + 64 * i];
          float4 y; y.x = v[u][i].x * rstd * g.x; y.y = v[u][i].y * rstd * g.y; y.z = v[u][i].z * rstd * g.z; y.w = v[u][i].w * rstd * g.w;
          ((float4*)(p.out + (size_t)tok * 1024))[lane + 64 * i] = y;
        }
      } else {
        const int ci = tok < NP_ ? 8 : (tok - NP_) >> 12;
        const float* md = p.mods + (size_t)(l * 9 + ci) * 6144 + which * 3072;
        const float* gpp = (which ? p.norm2_g : p.norm1_g) + l * 1024;
#pragma unroll
        for (int i = 0; i < 4; ++i) {
          const float4 g = ((const float4*)gpp)[lane + 64 * i];
          const float4 sh = ((const float4*)md)[lane + 64 * i];
          const float4 sc = ((const float4*)(md + 1024))[lane + 64 * i];
          ushort4 o;
          o.x = f2bf(v[u][i].x * rstd * g.x * (1.f + sc.x) + sh.x);
          o.y = f2bf(v[u][i].y * rstd * g.y * (1.f + sc.y) + sh.y);
          o.z = f2bf(v[u][i].z * rstd * g.z * (1.f + sc.z) + sh.z);
          o.w = f2bf(v[u][i].w * rstd * g.w * (1.f + sc.w) + sh.w);
          ((ushort4*)(p.hn + (size_t)tok * 1024))[lane + 64 * i] = o;
          if (first) ((float4*)(p.out + (size_t)tok * 1024))[lane + 64 * i] = v[u][i];
        }
      }
    }
  }
}

DI uint4 ldsel(const u16* pv, const u16* safe, unsigned ok) {
  uint4 t = *(const uint4*)(ok ? pv : safe);
  if (!ok) { t.x = 0; t.y = 0; t.z = 0; t.w = 0; }
  return t;
}
enum { EPI_PROJ = 0, EPI_RES = 1, EPI_FFN = 2 };

template <int EPI, int WN>
DI void gemm_phase(const P* __restrict__ gp, int l, char* smem, const u16* __restrict__ A, int lda, const u16* __restrict__ B, int ldb, int K, int MT,
                   int NTn, int gsel) {
  const P& p = *gp;
  u16* As = (u16*)smem;
  int tid_ = threadIdx.x; asm volatile("" : "+v"(tid_)); const int tid = tid_, lane = tid & 63, wave = tid >> 6, r = lane & 31, h = lane >> 5;
  const int KT = K >> 6;
  const bool even = !(l & 1); const int jj = l >> 1;
  const int ntiles = MT * NTn;
  const int nlb = gridDim.x >> 3, xcd = blockIdx.x & 7, lb = blockIdx.x >> 3;
  for (int it = 0;; ++it) {
    const int g = (it * 8 + xcd) * nlb + lb;
    if (g >= ntiles) break;
    const int SM = nlb >> 3;
    const int band = g / (SM * NTn); const int rem = g - band * SM * NTn;
    const int nt = rem / SM, mt = band * SM + (rem - nt * SM);
    int seqbase = 0, L = 0, tin0 = 0;
    if (EPI == EPI_FFN) {
      if (mt < 48) { const int sq = mt / 3; L = 256; seqbase = sq * 256; tin0 = (mt - sq * 3) * 126; }
      else { const int m2 = mt - 48; const int sq = m2 / 33; L = 4096; seqbase = NP_ + sq * 4096; tin0 = (m2 - sq * 33) * 126; }
    }
    const int row0 = tid >> 3, kc0 = (tid & 7) * 8;
    const long arow0 = (EPI == EPI_FFN) ? (long)seqbase + tin0 - 1 + row0 : (long)mt * 128 + row0;
    const u16* abase = A + arow0 * lda + kc0;
    unsigned avalid = 0;
#pragma unroll
    for (int i = 0; i < 4; ++i) {
      if (EPI == EPI_FFN) { const int ts = tin0 - 1 + row0 + 32 * i; if (ts >= 0 && ts < L) avalid |= 1u << i; }
      else avalid |= 1u << i;
    }
    const u16* bb0 = B + ((size_t)((nt * 4 + wave) * WN * (K >> 4)) * 64 + lane) * 8;
    const size_t bts = (size_t)(K >> 4) * 512;
    f32x16 acc[4][WN];
#pragma unroll
    for (int a = 0; a < 4; ++a)
#pragma unroll
      for (int b = 0; b < WN; ++b) zero16(acc[a][b]);
#define GLD_A(i, ko) ldsel(abase + (size_t)(32 * (i)) * lda + (ko), A, (avalid >> (i)) & 1u)
#define GLD_BF(dst, kt_) { const u16* q_ = bb0 + (size_t)(kt_) * 2048; \
      _Pragma("unroll") for (int ni_ = 0; ni_ < WN; ++ni_) { \
        dst[ni_][0] = *(const bf16x8*)(q_ + ni_ * bts); dst[ni_][1] = *(const bf16x8*)(q_ + ni_ * bts + 512); \
        dst[ni_][2] = *(const bf16x8*)(q_ + ni_ * bts + 1024); dst[ni_][3] = *(const bf16x8*)(q_ + ni_ * bts + 1536); } }
    uint4 ra0 = GLD_A(0, 0), ra1 = GLD_A(1, 0), ra2 = GLD_A(2, 0), ra3 = GLD_A(3, 0);
    uint4 sa0, sa1, sa2, sa3;
    if (WN == 1) { sa0 = GLD_A(0, 64); sa1 = GLD_A(1, 64); sa2 = GLD_A(2, 64); sa3 = GLD_A(3, 64); }
    bf16x8 bc[WN][4], bn[WN][4];
    GLD_BF(bc, 0);
    if (WN == 1) GLD_BF(bn, 1);
#define LSTORE(buf, A0, A1, A2, A3) { \
      u16* ad = As + (buf) * 9216 + row0 * 72 + kc0; \
      *(uint4*)(ad) = A0; *(uint4*)(ad + 32 * 72) = A1; *(uint4*)(ad + 64 * 72) = A2; *(uint4*)(ad + 96 * 72) = A3; }
#define COMPUTE(buf, BF, KN) { \
      const u16* Ab = As + (buf) * 9216 + r * 72 + h * 8; \
      const bool more_ = (KN) < KT; const u16* q_ = bb0 + (size_t)(KN) * 2048; \
      _Pragma("unroll") for (int ks = 0; ks < 4; ++ks) { \
        const bf16x8 a0 = *(const bf16x8*)(Ab + ks * 16); \
        const bf16x8 a1 = *(const bf16x8*)(Ab + 32 * 72 + ks * 16); \
        const bf16x8 a2 = *(const bf16x8*)(Ab + 64 * 72 + ks * 16); \
        const bf16x8 a3 = *(const bf16x8*)(Ab + 96 * 72 + ks * 16); \
        _Pragma("unroll") for (int ni_ = 0; ni_ < WN; ++ni_) { \
          acc[0][ni_] = MFMA(a0, BF[ni_][ks], acc[0][ni_]); acc[1][ni_] = MFMA(a1, BF[ni_][ks], acc[1][ni_]); \
          acc[2][ni_] = MFMA(a2, BF[ni_][ks], acc[2][ni_]); acc[3][ni_] = MFMA(a3, BF[ni_][ks], acc[3][ni_]); } \
        if (more_) { _Pragma("unroll") for (int ni_ = 0; ni_ < WN; ++ni_) BF[ni_][ks] = *(const bf16x8*)(q_ + ni_ * bts + ks * 512); } } }
    if (WN == 1) {
    LSTORE(0, ra0, ra1, ra2, ra3);
    ra0 = GLD_A(0, 128); ra1 = GLD_A(1, 128); ra2 = GLD_A(2, 128); ra3 = GLD_A(3, 128);
    __syncthreads();
    for (int kt = 0; kt < KT; kt += 2) {
      COMPUTE(0, bc, kt + 2);
      LSTORE(1, sa0, sa1, sa2, sa3);
      if (kt + 3 < KT) {
        const int ko = (kt + 3) * 64;
        sa0 = GLD_A(0, ko); sa1 = GLD_A(1, ko); sa2 = GLD_A(2, ko); sa3 = GLD_A(3, ko);
      }
      __syncthreads();
      COMPUTE(1, bn, kt + 3);
      if (kt + 2 < KT) {
        LSTORE(0, ra0, ra1, ra2, ra3);
        if (kt + 4 < KT) {
          const int ko = (kt + 4) * 64;
          ra0 = GLD_A(0, ko); ra1 = GLD_A(1, ko); ra2 = GLD_A(2, ko); ra3 = GLD_A(3, ko);
        }
      }
      __syncthreads();
    }
    } else {
      LSTORE(0, ra0, ra1, ra2, ra3);
      ra0 = GLD_A(0, 64); ra1 = GLD_A(1, 64); ra2 = GLD_A(2, 64); ra3 = GLD_A(3, 64);
      __syncthreads();
      for (int kt = 0; kt < KT; kt += 2) {
        COMPUTE(0, bc, kt + 1);
        LSTORE(1, ra0, ra1, ra2, ra3);
        if (kt + 2 < KT) { const int ko = (kt + 2) * 64; ra0 = GLD_A(0, ko); ra1 = GLD_A(1, ko); ra2 = GLD_A(2, ko); ra3 = GLD_A(3, ko); }
        __syncthreads();
        COMPUTE(1, bc, kt + 2);
        if (kt + 2 < KT) {
          LSTORE(0, ra0, ra1, ra2, ra3);
          if (kt + 3 < KT) { const int ko = (kt + 3) * 64; ra0 = GLD_A(0, ko); ra1 = GLD_A(1, ko); ra2 = GLD_A(2, ko); ra3 = GLD_A(3, ko); }
        }
        __syncthreads();
      }
    }
    if (EPI == EPI_PROJ) {
      const int N = even ? EVN : ODN;
#pragma unroll
      for (int tm = 0; tm < 4; ++tm)
#pragma unroll
        for (int tn = 0; tn < WN; ++tn) {
          const int col = nt * (128 * WN) + wave * (32 * WN) + tn * 32 + r;
          if (col < N) {
#pragma unroll
            for (int i = 0; i < 16; ++i) {
              const int row = mt * 128 + tm * 32 + crow(i, h);
              const float v = acc[tm][tn][i];
              p.proj[(size_t)row * N + col] = f2bf(v);
              if (row < NP_) {
                const int b = row >> 8, t = row & 255, d = col & 63;
                if (even) {
                  if (col >= 512 && col < 1536) {
                    const int wh = (col - 512) >> 9, hh = ((col - 512) >> 6) & 7;
                    p.out[(wh ? OFF_AV : OFF_AK) + ((size_t)(((b * 2 + jj) * 8 + hh) * 256 + t)) * 64 + d] = v;
                  }
                } else {
                  if (col >= 512 && col < 768) {
                    const int wh = (col - 512) >> 7, kv = ((col - 512) >> 6) & 1;
                    p.out[(wh ? OFF_CV : OFF_CK) + ((size_t)(((b * 2 + jj) * 2 + kv) * 256 + t)) * 64 + d] = v;
                  }
                }
              }
            }
          }
        }
    } else if (EPI == EPI_RES) {
#pragma unroll
      for (int tm = 0; tm < 4; ++tm)
#pragma unroll
        for (int tn = 0; tn < WN; ++tn) {
          const int col = nt * (128 * WN) + wave * (32 * WN) + tn * 32 + r;
#pragma unroll
          for (int i = 0; i < 16; ++i) {
            const int row = mt * 128 + tm * 32 + crow(i, h);
            const int ci = row < NP_ ? 8 : (row - NP_) >> 12;
            const float g = p.mods[(size_t)(l * 9 + ci) * 6144 + gsel * 1024 + col];
            float* xp = p.out + (size_t)row * 1024 + col;
            *xp = *xp + g * acc[tm][tn][i];
          }
        }
    } else {
      float* U = (float*)smem;
      const float* cw = p.ffn_conv + (size_t)l * 3 * 5632;
      u16* act = p.proj;
#pragma unroll
      for (int ps = 0; ps < WN; ++ps) {
        __syncthreads();
        if (WN == 1) {
#pragma unroll
          for (int tm = 0; tm < 4; ++tm)
#pragma unroll
            for (int i = 0; i < 16; ++i) U[(tm * 32 + crow(i, h)) * 132 + wave * 32 + r] = acc[tm][0][i];
        } else if ((wave & 1) == ps) {
#pragma unroll
          for (int tm = 0; tm < 4; ++tm)
#pragma unroll
            for (int tn = 0; tn < WN; ++tn)
#pragma unroll
              for (int i = 0; i < 16; ++i) U[(tm * 32 + crow(i, h)) * 132 + (wave >> 1) * 64 + tn * 32 + r] = acc[tm][tn][i];
        }
        __syncthreads();
        const int f = tid & 63, rg = tid >> 6; const int fg = nt * (64 * WN) + ps * 64 + f;
        const float wa0 = cw[fg], wa1 = cw[5632 + fg], wa2 = cw[2 * 5632 + fg];
        const float wg0 = cw[2816 + fg], wg1 = cw[5632 + 2816 + fg], wg2 = cw[2 * 5632 + 2816 + fg];
        const int rbeg = 1 + 32 * rg, rend = rg == 3 ? 126 : 32 * rg + 32;
        float ap = U[(rbeg - 1) * 132 + f], ac = U[rbeg * 132 + f];
        float gp_ = U[(rbeg - 1) * 132 + 64 + f], gc = U[rbeg * 132 + 64 + f];
        for (int rr = rbeg; rr <= rend; ++rr) {
          const int ts = tin0 - 1 + rr;
          if (ts >= L) break;
          const float an = U[(rr + 1) * 132 + f], gn = U[(rr + 1) * 132 + 64 + f];
          const float a = wa0 * ap + wa1 * ac + wa2 * an;
          const float g = wg0 * gp_ + wg1 * gc + wg2 * gn;
          act[(size_t)(seqbase + ts) * 2816 + fg] = f2bf(a * siluf(g));
          ap = ac; ac = an; gp_ = gc; gc = gn;
        }
      }
      __syncthreads();
    }
  }
}

template <int MODE>
DI void attn_item(const P* __restrict__ gp, int jj, int it, char* smem) {
  const P& p = *gp;
  const u16* projp = uni(p.proj); u16* hnp = uni(p.hn); const float* ropep = uni(p.rope);
  u16* Ks = (u16*)smem; u16* Vt = Ks + 64 * 72; float* rpb_s = (float*)(Vt + 64 * 72);
  int tid_ = threadIdx.x; asm volatile("" : "+v"(tid_)); const int tid = tid_, lane = tid & 63, wave = tid >> 6, r = lane & 31, h = lane >> 5;
  constexpr bool EVENL = (MODE == 0 || MODE == 1);
  constexpr bool LAT = (MODE == 1 || MODE == 3);
  constexpr int PS = EVENL ? EVN : ODN;
  int b, hq, qb, tokbase;
  if (!LAT) { b = it >> 4; hq = (it >> 1) & 7; qb = it & 1; tokbase = b * 256; }
  else { b = it >> 8; hq = (it >> 5) & 7; qb = it & 31; tokbase = NP_ + b * 4096; }
  const int hk = EVENL ? hq : (hq >> 2);
  const int kcol = 512 + hk * 64, vcol = (EVENL ? 1024 : 640) + hk * 64, qcol = hq * 64;
  const int tq = qb * 128 + wave * 32 + r;
  const size_t qtok = (size_t)tokbase + tq;
  __syncthreads();
  if (MODE == 1) { for (int i = tid; i < 465; i += 256) rpb_s[i] = p.a_rpb[(size_t)(jj * 8 + hq) * 465 + i]; }
  bf16x8 qf[4];
#pragma unroll
  for (int s = 0; s < 4; ++s) qf[s] = *(const bf16x8*)(projp + qtok * PS + qcol + 16 * s + 8 * h);
  if (MODE == 3) {
    const int prow = tq >> 6, pcol = tq & 63;
#pragma unroll
    for (int half = 0; half < 2; ++half) {
      const int pos = half ? pcol : prow;
#pragma unroll
      for (int j = 0; j < 8; ++j) {
        const float cs = ropep[(pos * 16 + 8 * h + j) * 2], sn = ropep[(pos * 16 + 8 * h + j) * 2 + 1];
        const float x1 = bf2f((u16)qf[2 * half][j]), x2 = bf2f((u16)qf[2 * half + 1][j]);
        qf[2 * half][j] = (short)f2bf(x1 * cs - x2 * sn);
        qf[2 * half + 1][j] = (short)f2bf(x1 * sn + x2 * cs);
      }
    }
  }
  float m_run = -1e30f, l_run = 0.f;
  if (MODE == 2 || MODE == 3) { m_run = p.c_sink[jj * 8 + hq]; l_run = h == 0 ? 1.f : 0.f; }
  f32x16 ot[2]; zero16(ot[0]); zero16(ot[1]);
  int loc0 = 0, nloc = 0;
  if (MODE == 1) {
    const int qi0 = 2 * qb;
    const int rlo = min(max(qi0 - 4, 0), 56), rhi = min(max(qi0 + 1 - 4, 0), 56) + 7;
    loc0 = rlo; nloc = rhi - rlo + 1;
  } else if (MODE == 3) {
    loc0 = max(0, 2 * qb - 2); nloc = min(63, 2 * qb + 3) - loc0 + 1;
  }
  const int qi = tq >> 6, qw = tq & 63;
  const int r0w = min(max(qi - 4, 0), 56), c0w = min(max(qw - 8, 0), 48);
  const int key = tid >> 2, seg = tid & 3;
  for (int kb = 0; kb < 4 + nloc; ++kb) {
    const bool isctx = kb < 4;
    const int blk = isctx ? kb : loc0 + kb - 4;
    __syncthreads();
    {
      float kf[16], vf[16];
      if (LAT && isctx) {
        const float* kc = (MODE == 1) ? p.cache_a_k + ((size_t)((b * 2 + jj) * 8 + hk)) * 16384 : p.cache_c_k + ((size_t)((b * 2 + jj) * 2 + hk)) * 16384;
        const float* vc = (MODE == 1) ? p.cache_a_v + ((size_t)((b * 2 + jj) * 8 + hk)) * 16384 : p.cache_c_v + ((size_t)((b * 2 + jj) * 2 + hk)) * 16384;
        const float4* kp4 = (const float4*)(kc + (size_t)(blk * 64 + key) * 64 + seg * 16);
        const float4* vp4 = (const float4*)(vc + (size_t)(blk * 64 + key) * 64 + seg * 16);
#pragma unroll
        for (int e = 0; e < 4; ++e) {
          const float4 a = kp4[e], c = vp4[e];
          kf[4 * e] = a.x; kf[4 * e + 1] = a.y; kf[4 * e + 2] = a.z; kf[4 * e + 3] = a.w;
          vf[4 * e] = c.x; vf[4 * e + 1] = c.y; vf[4 * e + 2] = c.z; vf[4 * e + 3] = c.w;
        }
      } else {
        const u16* rowp = projp + ((size_t)tokbase + blk * 64 + key) * PS;
        const bf16x8 k0 = *(const bf16x8*)(rowp + kcol + seg * 16), k1 = *(const bf16x8*)(rowp + kcol + seg * 16 + 8);
        const bf16x8 v0 = *(const bf16x8*)(rowp + vcol + seg * 16), v1 = *(const bf16x8*)(rowp + vcol + seg * 16 + 8);
#pragma unroll
        for (int e = 0; e < 8; ++e) { kf[e] = bf2f((u16)k0[e]); kf[8 + e] = bf2f((u16)k1[e]); vf[e] = bf2f((u16)v0[e]); vf[8 + e] = bf2f((u16)v1[e]); }
        if (MODE == 3) {
          const bf16x8 p0 = *(const bf16x8*)(rowp + kcol + (seg ^ 1) * 16), p1 = *(const bf16x8*)(rowp + kcol + (seg ^ 1) * 16 + 8);
          const int pos = (seg & 2) ? key : blk;
#pragma unroll
          for (int e = 0; e < 16; ++e) {
            const float pr = bf2f((u16)(e < 8 ? p0[e & 7] : p1[e & 7]));
            const float cs = ropep[(pos * 16 + e) * 2], sn = ropep[(pos * 16 + e) * 2 + 1];
            kf[e] = (seg & 1) ? (pr * sn + kf[e] * cs) : (kf[e] * cs - pr * sn);
          }
        }
      }
      bf16x8 o0, o1;
#pragma unroll
      for (int e = 0; e < 8; ++e) { o0[e] = (short)f2bf(kf[e]); o1[e] = (short)f2bf(kf[8 + e]); }
      *(bf16x8*)(Ks + key * 72 + seg * 16) = o0;
      *(bf16x8*)(Ks + key * 72 + seg * 16 + 8) = o1;
#pragma unroll
      for (int e = 0; e < 16; ++e) Vt[(seg * 16 + e) * 72 + key] = f2bf(vf[e]);
    }
    __syncthreads();
    bool active = true;
    if (MODE == 1 && !isctx) active = (blk >= r0w && blk < r0w + 8);
    if (active) {
      f32x16 st[2]; zero16(st[0]); zero16(st[1]);
#pragma unroll
      for (int kt = 0; kt < 2; ++kt)
#pragma unroll
        for (int s = 0; s < 4; ++s) {
          const bf16x8 a = *(const bf16x8*)(Ks + (kt * 32 + r) * 72 + 16 * s + 8 * h);
          st[kt] = MFMA(a, qf[s], st[kt]);
        }
      float mx = m_run;
#pragma unroll
      for (int kt = 0; kt < 2; ++kt)
#pragma unroll
        for (int i = 0; i < 16; ++i) {
          float s = st[kt][i] * 0.125f;
          const int kk = kt * 32 + crow(i, h);
          if (MODE == 1 && !isctx) {
            const bool ok = (kk >= c0w && kk < c0w + 16);
            s = ok ? s + rpb_s[(blk - qi + 7) * 31 + (kk - qw + 15)] : -1e30f;
          }
          if (MODE == 3 && !isctx) {
            const int dlt = blk * 64 + kk - tq;
            s = (dlt <= 128 && dlt >= -128) ? s : -1e30f;
          }
          st[kt][i] = s;
          mx = fmaxf(mx, s);
        }
      mx = fmaxf(mx, shx(mx, lane, 32));
      const float alpha = __expf(m_run - mx);
      m_run = mx;
      float ps = 0.f;
#pragma unroll
      for (int kt = 0; kt < 2; ++kt)
#pragma unroll
        for (int i = 0; i < 16; ++i) { const float pv = __expf(st[kt][i] - mx); st[kt][i] = pv; ps += pv; }
      l_run = l_run * alpha + ps;
#pragma unroll
      for (int dt = 0; dt < 2; ++dt)
#pragma unroll
        for (int i = 0; i < 16; ++i) ot[dt][i] *= alpha;
#pragma unroll
      for (int kt = 0; kt < 2; ++kt) {
        const bf16x8 pb0 = packs<0>(st[kt]), pb1 = packs<1>(st[kt]);
#pragma unroll
        for (int dt = 0; dt < 2; ++dt) {
          const bf16x8 pa0 = ld2x4(Vt + (dt * 32 + r) * 72 + kt * 32 + 4 * h);
          const bf16x8 pa1 = ld2x4(Vt + (dt * 32 + r) * 72 + kt * 32 + 16 + 4 * h);
          ot[dt] = MFMA(pa0, pb0, ot[dt]);
          ot[dt] = MFMA(pa1, pb1, ot[dt]);
        }
      }
    }
  }
  l_run += shx(l_run, lane, 32);
  const float inv = 1.f / l_run;
  u16* dst = hnp + qtok * 1024 + qcol;
#pragma unroll
  for (int dt = 0; dt < 2; ++dt)
#pragma unroll
    for (int g4 = 0; g4 < 4; ++g4) {
      ushort4 o;
      o.x = f2bf(ot[dt][4 * g4] * inv); o.y = f2bf(ot[dt][4 * g4 + 1] * inv); o.z = f2bf(ot[dt][4 * g4 + 2] * inv); o.w = f2bf(ot[dt][4 * g4 + 3] * inv);
      *(ushort4*)(dst + dt * 32 + 8 * g4 + 4 * h) = o;
    }
}

struct ChainId { int lat, b, h, dir, T, base, nch; };
DI ChainId chain_decode(int it) {
  ChainId c; c.lat = it < 128; const int q = c.lat ? it : it - 128;
  c.b = q >> 4; c.h = (q >> 1) & 7; c.dir = q & 1; c.T = c.lat ? 4096 : 256; c.base = c.lat ? NP_ + c.b * 4096 : c.b * 256; c.nch = c.T >> 6;
  return c;
}
DI int tokof(const ChainId& c, int step, int row) { const int pp = step * 64 + row; return c.base + (c.dir ? c.T - 1 - pp : pp); }


static constexpr int RING = 4;
static constexpr int SLOT_BYTES = 53760;
DI void wait_ge(int* flag, int val, int tid) {
  if (tid < 64) {
    if (tid == 0) { while (__hip_atomic_load(flag, __ATOMIC_RELAXED, __HIP_MEMORY_SCOPE_AGENT) < val) __builtin_amdgcn_s_sleep(1); }
    __builtin_amdgcn_fence(__ATOMIC_ACQUIRE, "agent");
  }
  __syncthreads();
}
DI void publish(int* flag, int val, int tid) {
  asm volatile("s_waitcnt vmcnt(0)" ::: "memory");
  __syncthreads();
  if (tid == 0) __hip_atomic_store(flag, val, __ATOMIC_RELAXED, __HIP_MEMORY_SCOPE_AGENT);
}
typedef __attribute__((ext_vector_type(4))) unsigned u32x4;
DI void copy_out(const char* lds, char* g, int bytes, int tid) {
  for (int i = opq(tid) * 16; i < bytes; i += 256 * 16) {
    const u32x4 v = *(const u32x4*)(lds + i);
    char* dst = g + i;
    asm volatile("global_store_dwordx4 %0, %1, off sc0 sc1" :: "v"(dst), "v"(v) : "memory");
  }
}
template <int BYTES>
DI void copy_in_t(char* lds, const char* g, int tid) {
  constexpr int N = (BYTES + 4095) / 4096;
  const int t16 = opq(tid) * 16;
  uint4 v[N];
#pragma unroll
  for (int j = 0; j < N; ++j) { const int i = t16 + j * 4096; v[j] = make_uint4(0, 0, 0, 0); if (i < BYTES) v[j] = *(const uint4*)(g + i); }
#pragma unroll
  for (int j = 0; j < N; ++j) { const int i = t16 + j * 4096; if (i < BYTES) *(uint4*)(lds + i) = v[j]; }
}

template <int ROLE>
DI void gla_chain(const P* __restrict__ gp, int jj, int it, char* smem, int k0, int kstep, int fs = 0) {
  const P& p = *gp;
  const ChainId cid = chain_decode(it);
  int tid_ = threadIdx.x; asm volatile("" : "+v"(tid_)); const int tid = tid_, lane = tid & 63, wave = tid >> 6, r = lane & 31, h = lane >> 5;
  const int hh = cid.h, dir = cid.dir;
  u16* QT = (u16*)smem; u16* KT = QT + 4608; u16* KEt = KT + 4608; u16* Vt = KEt + 4608;
  float* dec = (float*)(Vt + 4608); float* GL = dec + 64; float* gq = GL + 1024; float* Ost = gq + 256;
  constexpr int IMG = 4 * 9216 + 256;
  char* slots = uni(p.ring) + (size_t)it * RING * SLOT_BYTES; int* ready = uni(p.flags) + (jj * 2 + 4 * fs) * 8320 + it * 64; int* done = uni(p.flags) + (jj * 2 + 4 * fs) * 8320 + 8192 + it;
  const int d = tid & 63, cq = tid >> 6;
  float wg[16];
#pragma unroll
  for (int rr = 0; rr < 16; ++rr) wg[rr] = p.b_w_g2[((size_t)((jj * 2 + dir) * 16 + rr)) * 512 + hh * 64 + d];
  const float bg = p.b_b_g[(jj * 2 + dir) * 512 + hh * 64 + d];
  const int vh = wave & 1;
  f32x16 S[2]; zero16(S[0]); zero16(S[1]);
  const size_t sidx = ((size_t)(((cid.b * 2 + jj) * 2 + dir) * 8 + hh)) * 4096;
  if (ROLE != 1 && wave < 2 && cid.lat) {
#pragma unroll
    for (int dt = 0; dt < 2; ++dt)
#pragma unroll
      for (int i = 0; i < 16; ++i) S[dt][i] = p.state_b[sidx + (dt * 32 + crow(i, h)) * 64 + vh * 32 + r];
  }
  for (int step_ = k0; step_ < cid.nch; step_ += kstep) {
    int step = step_;
    asm volatile("" : "+v"(step));
    if (ROLE == 1) wait_ge(done, step_ - RING + 1, tid);
    if (ROLE == 2) wait_ge(ready + step_, 1, tid);
    __syncthreads();
    if (ROLE == 2) { copy_in_t<IMG>(smem, slots + (size_t)(step_ % RING) * SLOT_BYTES, tid); __syncthreads(); if (tid == 0) __hip_atomic_store(done, step_ + 1, __ATOMIC_RELAXED, __HIP_MEMORY_SCOPE_AGENT); }
    if (ROLE != 2) {
    {
      const int c = tid >> 2, sg = tid & 3;
      const int tok = tokof(cid, step, c);
      const ushort4 gv = *(const ushort4*)(p.proj + (size_t)tok * EVN + 3072 + dir * 16 + sg * 4);
      GL[c * 16 + sg * 4] = bf2f(gv.x); GL[c * 16 + sg * 4 + 1] = bf2f(gv.y); GL[c * 16 + sg * 4 + 2] = bf2f(gv.z); GL[c * 16 + sg * 4 + 3] = bf2f(gv.w);
    }
    __syncthreads();
    float Gl[16]; float run = 0.f;
#pragma unroll
    for (int i = 0; i < 16; ++i) {
      const int c = cq * 16 + i;
      float z = bg;
#pragma unroll
      for (int rr = 0; rr < 16; ++rr) z += GL[c * 16 + rr] * wg[rr];
      const float g = (fminf(z, 0.f) - __logf(1.f + __expf(-fabsf(z)))) * (1.f / 16.f);
      run += g; Gl[i] = run;
    }
    gq[cq * 64 + d] = run;
    __syncthreads();
    float off = 0.f, tot = 0.f;
#pragma unroll
    for (int q2 = 0; q2 < 4; ++q2) { const float t = gq[q2 * 64 + d]; if (q2 < cq) off += t; tot += t; }
#pragma unroll
    for (int i = 0; i < 16; ++i) {
      const int c = cq * 16 + i;
      const int tok = tokof(cid, step, c);
      const float G = Gl[i] + off;
      const u16* rowp = p.proj + (size_t)tok * EVN + hh * 64 + d;
      const float qv = bf2f(rowp[1536]), kv = bf2f(rowp[2048]);
      const u16 vb = rowp[2560];
      QT[c * 72 + d] = f2bf(qv * 0.125f * __expf(G));
      KT[c * 72 + d] = f2bf(kv * __expf(-G));
      KEt[d * 72 + c] = f2bf(kv * __expf(tot - G));
      Vt[d * 72 + c] = vb;
    }
    if (cq == 0) dec[d] = __expf(tot);
    __syncthreads();
    }
    if (ROLE == 1) { copy_out(smem, slots + (size_t)(step_ % RING) * SLOT_BYTES, IMG, tid); publish(ready + step_, 1, tid); continue; }
    if (wave < 2) {
      f32x16 at[2][2];
#pragma unroll
      for (int a = 0; a < 2; ++a)
#pragma unroll
        for (int b2 = 0; b2 < 2; ++b2) zero16(at[a][b2]);
#pragma unroll
      for (int ks = 0; ks < 4; ++ks) {
        const bf16x8 a0 = *(const bf16x8*)(KT + r * 72 + ks * 16 + 8 * h), a1 = *(const bf16x8*)(KT + (32 + r) * 72 + ks * 16 + 8 * h);
        const bf16x8 b0 = *(const bf16x8*)(QT + r * 72 + ks * 16 + 8 * h), b1 = *(const bf16x8*)(QT + (32 + r) * 72 + ks * 16 + 8 * h);
        at[0][0] = MFMA(a0, b0, at[0][0]); at[0][1] = MFMA(a0, b1, at[0][1]);
        at[1][0] = MFMA(a1, b0, at[1][0]); at[1][1] = MFMA(a1, b1, at[1][1]);
      }
#pragma unroll
      for (int st = 0; st < 2; ++st)
#pragma unroll
        for (int ct = 0; ct < 2; ++ct)
#pragma unroll
          for (int i = 0; i < 16; ++i) { if (st * 32 + crow(i, h) > ct * 32 + r) at[st][ct][i] = 0.f; }
      f32x16 o[2]; zero16(o[0]); zero16(o[1]);
#pragma unroll
      for (int ct = 0; ct < 2; ++ct)
#pragma unroll
        for (int st = 0; st < 2; ++st) {
          const bf16x8 x0 = packs<0>(at[st][ct]), x1 = packs<1>(at[st][ct]);
          const bf16x8 pb0 = ld2x4(Vt + (vh * 32 + r) * 72 + st * 32 + 4 * h);
          const bf16x8 pb1 = ld2x4(Vt + (vh * 32 + r) * 72 + st * 32 + 16 + 4 * h);
          o[ct] = MFMA(x0, pb0, o[ct]);
          o[ct] = MFMA(x1, pb1, o[ct]);
        }
#pragma unroll
      for (int dt = 0; dt < 2; ++dt) {
        const bf16x8 xs0 = packs<0>(S[dt]), xs1 = packs<1>(S[dt]);
#pragma unroll
        for (int ct = 0; ct < 2; ++ct) {
          const bf16x8 pa0 = ld2x4(QT + (ct * 32 + r) * 72 + dt * 32 + 4 * h);
          const bf16x8 pa1 = ld2x4(QT + (ct * 32 + r) * 72 + dt * 32 + 16 + 4 * h);
          o[ct] = MFMA(pa0, xs0, o[ct]);
          o[ct] = MFMA(pa1, xs1, o[ct]);
        }
      }
#pragma unroll
      for (int dt = 0; dt < 2; ++dt)
#pragma unroll
        for (int i = 0; i < 16; ++i) S[dt][i] *= dec[dt * 32 + crow(i, h)];
#pragma unroll
      for (int ks = 0; ks < 4; ++ks) {
        const bf16x8 bv = *(const bf16x8*)(Vt + (vh * 32 + r) * 72 + ks * 16 + 8 * h);
#pragma unroll
        for (int dt = 0; dt < 2; ++dt) {
          const bf16x8 a = *(const bf16x8*)(KEt + (dt * 32 + r) * 72 + ks * 16 + 8 * h);
          S[dt] = MFMA(a, bv, S[dt]);
        }
      }
#pragma unroll
      for (int ct = 0; ct < 2; ++ct)
#pragma unroll
        for (int i = 0; i < 16; ++i) Ost[(ct * 32 + crow(i, h)) * 68 + vh * 32 + r] = o[ct][i];
    }
    __syncthreads();
    {
      const int c = tid >> 2, sg = tid & 3;
      const int tok = tokof(cid, step, c);
      u16* dst = (dir ? p.ot1 + (size_t)tok * 512 + hh * 64 : p.hn + (size_t)tok * 1024 + 512 + hh * 64) + sg * 16;
      bf16x8 w0, w1;
#pragma unroll
      for (int e = 0; e < 8; ++e) { w0[e] = (short)f2bf(Ost[c * 68 + sg * 16 + e]); w1[e] = (short)f2bf(Ost[c * 68 + sg * 16 + 8 + e]); }
      *(bf16x8*)dst = w0; *(bf16x8*)(dst + 8) = w1;
    }
  }
  if (wave < 2 && !cid.lat) {
#pragma unroll
    for (int dt = 0; dt < 2; ++dt)
#pragma unroll
      for (int i = 0; i < 16; ++i) p.out[OFF_SB + sidx + (dt * 32 + crow(i, h)) * 64 + vh * 32 + r] = S[dt][i];
  }
}

template <int ROLE>
DI void delta_chain(const P* __restrict__ gp, int jj, int it, char* smem, int k0, int kstep, int fs = 0) {
  const P& p = *gp;
  const ChainId cid = chain_decode(it);
  int tid_ = threadIdx.x; asm volatile("" : "+v"(tid_)); const int tid0 = tid_;
  const int hh = cid.h, dir = cid.dir;
  u16* Qn = (u16*)smem; u16* Kt = Qn + 4608; u16* AQK = Kt + 4608; u16* KC = AQK + 4608;
  float* Wv = (float*)(KC + 4608); float* Gs = Wv + 64 * 65; u16* Kn = (u16*)(Gs + 64); float* At = (float*)(Kn + 4608); float* Bt = At + 64 * 68;
  constexpr int IMG = 4 * 9216 + 16640 + 256;
  char* slots = uni(p.ring) + (size_t)it * RING * SLOT_BYTES; int* ready = uni(p.flags) + (jj * 2 + 1 + 4 * fs) * 8320 + it * 64; int* done = uni(p.flags) + (jj * 2 + 1 + 4 * fs) * 8320 + 8192 + it;
  const float aexp = __expf(p.d_a_log[(jj * 2 + dir) * 8 + hh]);
  const float dtb = p.d_dt_bias[(jj * 2 + dir) * 8 + hh];
  f32x16 S[2]; zero16(S[0]); zero16(S[1]);
  const size_t sidx = ((size_t)(((cid.b * 2 + jj) * 2 + dir) * 8 + hh)) * 4096;
  { const int tid = tid0, lane = tid & 63, wave = tid >> 6, r = lane & 31, h = lane >> 5;
  if (ROLE != 1 && wave < 2 && cid.lat) {
    const int vh = wave & 1;
#pragma unroll
    for (int dt = 0; dt < 2; ++dt)
#pragma unroll
      for (int i = 0; i < 16; ++i) S[dt][i] = p.state_d[sidx + (dt * 32 + crow(i, h)) * 64 + vh * 32 + r];
  }
  }
  u16* CW = (u16*)(smem + 80640);
  __syncthreads();
  for (int i = tid0; i < 576; i += 256) { const int tap = i / 192, c2 = i - tap * 192; const int wh = c2 >> 6, dd = c2 & 63;
    CW[i] = f2bf(p.d_conv[(size_t)jj * 3 * 1536 + tap * 1536 + wh * 512 + hh * 64 + dd]); }
  for (int step_ = k0; step_ < cid.nch; step_ += kstep) {
    int step = step_;
    asm volatile("" : "+v"(step));
    if (ROLE == 1) wait_ge(done, step_ - RING + 1, tid0);
    if (ROLE == 2) wait_ge(ready + step_, 1, tid0);
    __syncthreads();
    if (ROLE == 2) { copy_in_t<IMG>(smem, slots + (size_t)(step_ % RING) * SLOT_BYTES, tid0); __syncthreads(); if (tid0 == 0) __hip_atomic_store(done, step_ + 1, __ATOMIC_RELAXED, __HIP_MEMORY_SCOPE_AGENT); }
    if (ROLE != 2) {
    {const int tid = opq(tid0), lane = tid & 63, wave = __builtin_amdgcn_readfirstlane(tid >> 6), r = lane & 31, h = lane >> 5, vh = wave & 1; (void)r; (void)h; (void)vh; (void)lane;
    if (wave == 0) {
      const int tok = tokof(cid, step, lane);
      const float da = bf2f(p.proj[(size_t)tok * ODN + 2304 + dir * 8 + hh]);
      const float db = bf2f(p.proj[(size_t)tok * ODN + 2320 + dir * 8 + hh]);
      const float x = da + dtb;
      const float sp = x > 20.f ? x : __logf(1.f + __expf(x));
      float G = -aexp * sp;
#pragma unroll
      for (int o = 1; o < 64; o <<= 1) { const float t = __int_as_float(__builtin_amdgcn_ds_bpermute((lane - o) << 2, __float_as_int(G))); if (lane >= o) G += t; }
      Gs[lane] = G; Bt[lane] = 1.f / (1.f + __expf(-db));
    }
    {
      const int c = tid >> 2, sg = tid & 3;
      const int tok = tokof(cid, step, c);
      const int pos = tok - cid.base;
      const bool hp = pos > 0, hn_ = pos < cid.T - 1;
#pragma unroll 1
      for (int wh = 0; wh < 3; ++wh) {
        const int ch0 = wh * 512 + hh * 64 + sg * 16;
        const u16* cur = p.proj + (size_t)tok * ODN + 768 + ch0;
        float y[16];
        float ss = 0.f;
#pragma unroll
        for (int hf = 0; hf < 2; ++hf) {
          const bf16x8 xc = *(const bf16x8*)(cur + hf * 8);
          bf16x8 xp, xn;
#pragma unroll
          for (int e = 0; e < 8; ++e) { xp[e] = 0; xn[e] = 0; }
          if (hp) xp = *(const bf16x8*)(cur - ODN + hf * 8);
          if (hn_) xn = *(const bf16x8*)(cur + ODN + hf * 8);
#pragma unroll
          for (int e = 0; e < 8; ++e) {
            const int ch = wh * 64 + sg * 16 + hf * 8 + e;
            float v = bf2f(CW[ch]) * bf2f((u16)xp[e]) + bf2f(CW[192 + ch]) * bf2f((u16)xc[e]) + bf2f(CW[384 + ch]) * bf2f((u16)xn[e]);
            v = v / (1.f + __expf(-v));
            y[hf * 8 + e] = v; ss += v * v;
          }
        }
        ss += shx(ss, lane, 1); ss += shx(ss, lane, 2);
        const float rn = rsqrtf(ss + 1e-6f);
        if (wh == 0) {
#pragma unroll
          for (int e = 0; e < 16; ++e) Qn[c * 72 + sg * 16 + e] = f2bf(y[e] * rn * 0.125f);
        } else if (wh == 1) {
#pragma unroll
          for (int e = 0; e < 16; ++e) { const u16 kb = f2bf(y[e] * rn); Kn[c * 72 + sg * 16 + e] = kb; Kt[(sg * 16 + e) * 72 + c] = kb; }
        } else {
#pragma unroll
          for (int e = 0; e < 16; ++e) Wv[c * 65 + sg * 16 + e] = y[e];
        }
      }
    }
    }
    __syncthreads();
    {const int tid = opq(tid0), lane = tid & 63, wave = __builtin_amdgcn_readfirstlane(tid >> 6), r = lane & 31, h = lane >> 5, vh = wave & 1; (void)r; (void)h; (void)vh; (void)lane;
    if (wave < 2) {
      f32x16 akk[2], aqk[2]; zero16(akk[0]); zero16(akk[1]); zero16(aqk[0]); zero16(aqk[1]);
#pragma unroll
      for (int ks = 0; ks < 4; ++ks) {
        const bf16x8 bk = *(const bf16x8*)(Kn + (vh * 32 + r) * 72 + ks * 16 + 8 * h);
#pragma unroll
        for (int ct = 0; ct < 2; ++ct) {
          const bf16x8 ak = *(const bf16x8*)(Kn + (ct * 32 + r) * 72 + ks * 16 + 8 * h);
          const bf16x8 aq = *(const bf16x8*)(Qn + (ct * 32 + r) * 72 + ks * 16 + 8 * h);
          akk[ct] = MFMA(ak, bk, akk[ct]);
          aqk[ct] = MFMA(aq, bk, aqk[ct]);
        }
      }
      const int s = vh * 32 + r;
      const float Gss = Gs[s];
#pragma unroll
      for (int ct = 0; ct < 2; ++ct)
#pragma unroll
        for (int g4 = 0; g4 < 4; ++g4) {
          const int c0 = ct * 32 + 8 * g4 + 4 * h;
          const float4 gv4 = *(const float4*)(Gs + c0), bv4 = *(const float4*)(Bt + c0);
          float4 val;
#pragma unroll
          for (int e = 0; e < 4; ++e) {
            const int c = c0 + e;
            const float Gc = e == 0 ? gv4.x : e == 1 ? gv4.y : e == 2 ? gv4.z : gv4.w;
            const float Bc = e == 0 ? bv4.x : e == 1 ? bv4.y : e == 2 ? bv4.z : bv4.w;
            const float gam = __expf(fminf(Gc - Gss, 0.f));
            const float av = (s < c) ? akk[ct][4 * g4 + e] * Bc * gam : 0.f;
            if (e == 0) val.x = av; else if (e == 1) val.y = av; else if (e == 2) val.z = av; else val.w = av;
            AQK[c * 72 + s] = f2bf((s <= c) ? aqk[ct][4 * g4 + e] * gam : 0.f);
          }
          *(float4*)(At + s * 68 + c0) = val;
        }
    }
    }
    __syncthreads();
    {const int tid = opq(tid0), lane = tid & 63, wave = __builtin_amdgcn_readfirstlane(tid >> 6), r = lane & 31, h = lane >> 5, vh = wave & 1; (void)r; (void)h; (void)vh; (void)lane;
    if (wave < 2) {
      const bool isv = wave == 0;
      const int col = lane;
#pragma unroll 1
      for (int bi = 0; bi < 4; ++bi) {
        float acc[16];
#pragma unroll
        for (int ci = 0; ci < 16; ++ci) {
          const int c = 16 * bi + ci;
          acc[ci] = isv ? Wv[c * 65 + col] * Bt[c] : bf2f(Kn[c * 72 + col]) * Bt[c] * __expf(Gs[c]);
        }
#pragma unroll 8
        for (int s2 = 0; s2 < 16 * bi; ++s2) {
          const float xs = isv ? Wv[s2 * 65 + col] : bf2f(KC[s2 * 72 + col]);
          const float4* a4 = (const float4*)(At + s2 * 68 + 16 * bi);
#pragma unroll
          for (int q = 0; q < 4; ++q) {
            const float4 a = a4[q];
            acc[4 * q] -= a.x * xs; acc[4 * q + 1] -= a.y * xs; acc[4 * q + 2] -= a.z * xs; acc[4 * q + 3] -= a.w * xs;
          }
        }
#pragma unroll
        for (int ci = 0; ci < 16; ++ci) {
          const float x = acc[ci];
          const float* arow = At + (16 * bi + ci) * 68 + 16 * bi;
#pragma unroll
          for (int cj = ci + 1; cj < 16; ++cj) acc[cj] -= arow[cj] * x;
          if (isv) Wv[(16 * bi + ci) * 65 + col] = x; else KC[(16 * bi + ci) * 72 + col] = f2bf(x);
        }
      }
    }
    }
    __syncthreads();
    }
    if (ROLE == 1) { copy_out(smem, slots + (size_t)(step_ % RING) * SLOT_BYTES, IMG, tid0); publish(ready + step_, 1, tid0); continue; }
    {const int tid = opq(tid0), lane = tid & 63, wave = __builtin_amdgcn_readfirstlane(tid >> 6), r = lane & 31, h = lane >> 5, vh = wave & 1; (void)r; (void)h; (void)vh; (void)lane;
    if (wave < 2) {
      f32x16 kS[2], qS[2]; zero16(kS[0]); zero16(kS[1]); zero16(qS[0]); zero16(qS[1]);
#pragma unroll
      for (int dt = 0; dt < 2; ++dt) {
        const bf16x8 xs0 = packs<0>(S[dt]), xs1 = packs<1>(S[dt]);
#pragma unroll
        for (int ct = 0; ct < 2; ++ct) {
          kS[ct] = MFMA(ld2x4(KC + (ct * 32 + r) * 72 + dt * 32 + 4 * h), xs0, kS[ct]);
          kS[ct] = MFMA(ld2x4(KC + (ct * 32 + r) * 72 + dt * 32 + 16 + 4 * h), xs1, kS[ct]);
          qS[ct] = MFMA(ld2x4(Qn + (ct * 32 + r) * 72 + dt * 32 + 4 * h), xs0, qS[ct]);
          qS[ct] = MFMA(ld2x4(Qn + (ct * 32 + r) * 72 + dt * 32 + 16 + 4 * h), xs1, qS[ct]);
        }
      }
      f32x16 vn[2], o[2];
      const float Glast = Gs[63];
#pragma unroll
      for (int ct = 0; ct < 2; ++ct)
#pragma unroll
        for (int i = 0; i < 16; ++i) {
          const int c = ct * 32 + crow(i, h);
          vn[ct][i] = Wv[c * 65 + vh * 32 + r] - kS[ct][i];
          o[ct][i] = qS[ct][i] * __expf(Gs[c]);
        }
#pragma unroll
      for (int st = 0; st < 2; ++st) {
        const bf16x8 xs0 = packs<0>(vn[st]), xs1 = packs<1>(vn[st]);
#pragma unroll
        for (int ct = 0; ct < 2; ++ct) {
          o[ct] = MFMA(ld2x4(AQK + (ct * 32 + r) * 72 + st * 32 + 4 * h), xs0, o[ct]);
          o[ct] = MFMA(ld2x4(AQK + (ct * 32 + r) * 72 + st * 32 + 16 + 4 * h), xs1, o[ct]);
        }
      }
      const float dl = __expf(Glast);
#pragma unroll
      for (int st = 0; st < 2; ++st) {
        asm volatile("" ::: "memory");
#pragma unroll
        for (int i = 0; i < 16; ++i) vn[st][i] *= __expf(Glast - Gs[st * 32 + crow(i, h)]);
      }
      asm volatile("" ::: "memory");
#pragma unroll
      for (int dt = 0; dt < 2; ++dt)
#pragma unroll
        for (int i = 0; i < 16; ++i) S[dt][i] *= dl;
#pragma unroll
      for (int st = 0; st < 2; ++st) {
        const bf16x8 xs0 = packs<0>(vn[st]), xs1 = packs<1>(vn[st]);
#pragma unroll
        for (int dt = 0; dt < 2; ++dt) {
          S[dt] = MFMA(ld2x4(Kt + (dt * 32 + r) * 72 + st * 32 + 4 * h), xs0, S[dt]);
          S[dt] = MFMA(ld2x4(Kt + (dt * 32 + r) * 72 + st * 32 + 16 + 4 * h), xs1, S[dt]);
        }
      }
#pragma unroll
      for (int ct = 0; ct < 2; ++ct)
#pragma unroll
        for (int i = 0; i < 16; ++i) At[(ct * 32 + crow(i, h)) * 68 + vh * 32 + r] = o[ct][i];
    }
    }
    __syncthreads();
    {
      const int tid = opq(tid0);
      const int c = tid >> 2, sg = tid & 3;
      const int tok = tokof(cid, step, c);
      u16* dst = (dir ? p.ot1 + (size_t)tok * 512 + hh * 64 : p.hn + (size_t)tok * 1024 + 512 + hh * 64) + sg * 16;
      bf16x8 w0, w1;
#pragma unroll
      for (int e = 0; e < 8; ++e) { w0[e] = (short)f2bf(At[c * 68 + sg * 16 + e]); w1[e] = (short)f2bf(At[c * 68 + sg * 16 + 8 + e]); }
      *(bf16x8*)dst = w0; *(bf16x8*)(dst + 8) = w1;
    }
  }
  {const int tid = opq(tid0), lane = tid & 63, wave = __builtin_amdgcn_readfirstlane(tid >> 6), r = lane & 31, h = lane >> 5, vh = wave & 1; (void)r; (void)h; (void)vh; (void)lane;
  if (wave < 2 && !cid.lat) {
#pragma unroll
    for (int dt = 0; dt < 2; ++dt)
#pragma unroll
      for (int i = 0; i < 16; ++i) p.out[OFF_SD + sidx + (dt * 32 + crow(i, h)) * 64 + vh * 32 + r] = S[dt][i];
  }
}
}

DI void mixer_phase(const P* __restrict__ gp, int l, char* smem, int fs = 0) {
  const P& p = *gp;
  const bool even = !(l & 1); const int jj = l >> 1;
  const bool teams = gridDim.x >= 512;
  if (teams) {
    const int bid = blockIdx.x;
    const int K = 3;
    if (bid < 128 * (K + 1)) {
      if (bid < 128) { if (even) gla_chain<2>(gp, jj, bid, smem, 0, 1, fs); else delta_chain<2>(gp, jj, bid, smem, 0, 1, fs); }
      else { const int ch = (bid - 128) & 127, k = (bid - 128) >> 7; if (even) gla_chain<1>(gp, jj, ch, smem, k, K, fs); else delta_chain<1>(gp, jj, ch, smem, k, K, fs); }
    }
  }
  const int first = teams ? 128 : 0;
  const int total = 384 + 2048 + 256;
  int* s_item = (int*)(smem + SMEM_BYTES - 16);
  int* cntp = uni(p.cnt) + l + 4 * fs;
  for (;;) {
    __syncthreads();
    if (opq(threadIdx.x) == 0) *s_item = atomicAdd(cntp, 1) + first;
    __syncthreads();
    const int item = __builtin_amdgcn_readfirstlane(*s_item);
    if (item >= total) break;
    if (item < 384) { if (even) gla_chain<0>(gp, jj, item, smem, 0, 1); else delta_chain<0>(gp, jj, item, smem, 0, 1); }
    else if (item < 384 + 2048) { if (even) attn_item<1>(gp, jj, item - 384, smem); else attn_item<3>(gp, jj, item - 384, smem); }
    else { if (even) attn_item<0>(gp, jj, item - 384 - 2048, smem); else attn_item<2>(gp, jj, item - 384 - 2048, smem); }
  }
}

DI void finalize_phase(const P* __restrict__ gp, int l) {
  const P& p = *gp;
  const bool even = !(l & 1); const int jj = l >> 1;
  int tid_ = threadIdx.x; asm volatile("" : "+v"(tid_)); const int tid = tid_;
  const int tk = tid >> 5, hh = (tid >> 2) & 7, sg = tid & 3;
  const int PS = even ? EVN : ODN; const int zcol = even ? 3104 : 2336;
  for (int item = blockIdx.x; item < NT_ / 8; item += gridDim.x) {
    const size_t tok = (size_t)item * 8 + tk;
    u16* a = p.hn + tok * 1024 + 512 + hh * 64 + sg * 16;
    const u16* bsrc = p.ot1 + tok * 512 + hh * 64 + sg * 16;
    const u16* zs = p.proj + tok * PS + zcol + hh * 64 + sg * 16;
    float o[16]; float ss = 0.f;
#pragma unroll
    for (int hf = 0; hf < 2; ++hf) {
      const bf16x8 x0 = *(const bf16x8*)(a + hf * 8), x1 = *(const bf16x8*)(bsrc + hf * 8);
#pragma unroll
      for (int e = 0; e < 8; ++e) { const float v = bf2f((u16)x0[e]) + bf2f((u16)x1[e]); o[hf * 8 + e] = v; ss += v * v; }
    }
    ss += shx(ss, tid & 63, 1); ss += shx(ss, tid & 63, 2);
    const float rstd = rsqrtf(ss * (1.f / 64.f) + 1e-6f);
    const float* ng = even ? p.b_norm_g + jj * 512 + hh * 64 + sg * 16 : p.d_norm_g + jj * 64 + sg * 16;
#pragma unroll
    for (int hf = 0; hf < 2; ++hf) {
      const bf16x8 z = *(const bf16x8*)(zs + hf * 8);
      bf16x8 w;
#pragma unroll
      for (int e = 0; e < 8; ++e) { const float zz = bf2f((u16)z[e]); w[e] = (short)f2bf(o[hf * 8 + e] * rstd * ng[hf * 8 + e] * siluf(zz)); }
      *(bf16x8*)(a + hf * 8) = w;
    }
  }
}


#define XB_TMO      128
#define XB_XCNT(j)  (256  + 64 * (j))
#define XB_XSUB(j)  (1280 + 64 * (j))
#define XB_XGEN(j)  (2304 + 64 * (j))
#define XB_TOP      3328
#define XB_TOPGEN   3392
#define XCD_BAR_WORDS 3456
#define XB_SPIN_CAP (1u << 18)
#define LAS __attribute__((address_space(3)))
DI unsigned xb_ld(unsigned* q)              { return __hip_atomic_load(q, __ATOMIC_RELAXED, __HIP_MEMORY_SCOPE_AGENT); }
DI unsigned xb_add(unsigned* q, unsigned v) { return __hip_atomic_fetch_add(q, v, __ATOMIC_RELAXED, __HIP_MEMORY_SCOPE_AGENT); }
DI unsigned xb_xcc_id() { return (unsigned)__builtin_amdgcn_s_getreg((3 << 11) | 20) & 0xFu; }
#define XB_SPIN(cond, bar) do { unsigned _sp = 0; while (cond) { __builtin_amdgcn_s_sleep(1); \
    if ((++_sp & 255u) == 0u) { if (xb_ld(&(bar)[XB_TMO])) break; if (_sp > XB_SPIN_CAP) { atomicAdd(&(bar)[XB_TMO], 1u); break; } } } } while (0)
struct XcdBarrier { unsigned* bar; unsigned x; volatile LAS unsigned* st; };
DI XcdBarrier xcd_barrier_post(unsigned* bar, volatile LAS unsigned* st) {
  XcdBarrier b; b.bar = bar; b.x = xb_xcc_id(); b.st = st;
  if (threadIdx.x == 0) (void)xb_add(&bar[XB_XCNT(b.x)], 1u);
  return b;
}
DI void xcd_barrier_complete(unsigned* bar, unsigned x, unsigned& nloc, unsigned& nx) {
  const unsigned G = gridDim.x * gridDim.y * gridDim.z;
  unsigned sum, cnt, mine, sp = 0u;
  for (;;) {
    sum = 0u; cnt = 0u; mine = 0u;
#pragma unroll
    for (unsigned j = 0; j < 16; ++j) { const unsigned c = xb_ld(&bar[XB_XCNT(j)]); sum += c; cnt += (c > 0u) ? 1u : 0u; mine = (j == x) ? c : mine; }
    if (sum == G) break;
    __builtin_amdgcn_s_sleep(1);
    if ((++sp & 255u) == 0u) { if (xb_ld(&bar[XB_TMO])) break; if (sp > XB_SPIN_CAP) { atomicAdd(&bar[XB_TMO], 1u); break; } }
  }
  nloc = mine > 0u ? mine : 1u; nx = cnt > 0u ? cnt : 1u;
}
DI void xcd_barrier(const XcdBarrier& b) {
  asm volatile("s_waitcnt vmcnt(0)" ::: "memory");
  __syncthreads();
  if (threadIdx.x == 0) {
    unsigned* bar = b.bar;
    __builtin_amdgcn_s_waitcnt(0);
    unsigned nloc = b.st[0], nx = b.st[1];
    if (nloc == 0u) { xcd_barrier_complete(bar, b.x, nloc, nx); b.st[0] = nloc; b.st[1] = nx; }
    const unsigned old = xb_add(&bar[XB_XSUB(b.x)], 1u);
    const unsigned gen = old / nloc;
    if (old + 1u == (gen + 1u) * nloc) {
      __builtin_amdgcn_fence(__ATOMIC_RELEASE, "agent");
      asm volatile("s_waitcnt vmcnt(0)" ::: "memory");
      const unsigned og = xb_add(&bar[XB_TOP], 1u);
      const unsigned tg = og / nx;
      if (og + 1u == (tg + 1u) * nx) xb_add(&bar[XB_TOPGEN], 1u);
      else XB_SPIN(xb_ld(&bar[XB_TOPGEN]) == tg, bar);
      __builtin_amdgcn_fence(__ATOMIC_ACQUIRE, "agent");
      xb_add(&bar[XB_XGEN(b.x)], 1u);
      asm volatile("s_waitcnt vmcnt(0)" ::: "memory");
    } else {
      XB_SPIN(xb_ld(&bar[XB_XGEN(b.x)]) == gen, bar);
      __builtin_amdgcn_fence(__ATOMIC_ACQUIRE, "agent");
      asm volatile("s_waitcnt vmcnt(0)" ::: "memory");
    }
  }
  __syncthreads();
}

DI void run_phase(const P* __restrict__ gp, int ph, char* smem) {
  const P& p = *gp;
  if (ph == 0) { prep_phase(gp, smem); return; }
  if (ph == NPH - 1) { norm_phase(gp, 0, 0, false, true); return; }
  const int l = (ph - 1) >> 3, s = (ph - 1) & 7;
  const bool even = !(l & 1);
  const u16* W = uni(p.wt) + (size_t)l * LW;
  const u16* hnp = uni(p.hn); const u16* projp = uni(p.proj);
  switch (s) {
    case 0: norm_phase(gp, l, 0, l == 0, false); break;
    case 1: gemm_phase<EPI_PROJ, 2>(gp, l, smem, hnp, 1024, W + WO_IN, 1024, 1024, 288, even ? 15 : 12, 0); break;
    case 2: mixer_phase(gp, l, smem); break;
    case 3: finalize_phase(gp, l); break;
    case 4: gemm_phase<EPI_RES, 1>(gp, l, smem, hnp, 1024, W + WO_OUT, 1024, 1024, 288, 8, 2); break;
    case 5: norm_phase(gp, l, 1, false, false); break;
    case 6: gemm_phase<EPI_FFN, 2>(gp, l, smem, hnp, 1024, W + WO_UP, 1024, 1024, 312, 22, 0); break;
    case 7: gemm_phase<EPI_RES, 1>(gp, l, smem, projp, 2816, W + WO_DN, 2816, 2816, 288, 8, 5); break;
  }
}

__global__ void __launch_bounds__(256, 2) mk(P p, P* gpmem, int ph0, int ph1) {
  __shared__ __attribute__((aligned(16))) char smem[SMEM_BYTES];
  const P* gp = &p;
  if (ph1 - ph0 > 1) {
    cg::grid_group grid = cg::this_grid();
    volatile LAS unsigned* xst = (volatile LAS unsigned*)(smem + SMEM_BYTES - 32);
    if (threadIdx.x == 0) { xst[0] = 0u; xst[1] = 0u; }
    __syncthreads();
    const XcdBarrier xbar = xcd_barrier_post(p.bar, xst);
    for (int ph = ph0; ph < ph1; ++ph) {
      run_phase(gp, ph, smem);
      if (ph + 1 < ph1) { if (ph == ph0) grid.sync(); else xcd_barrier(xbar); }
    }
  } else {
    run_phase(gp, ph0, smem);
  }
}

extern "C" void kernel_launch(void* const* d_in, const int* in_sizes, int n_in, void* d_out, int out_size, void* d_ws, size_t ws_size,
                              hipStream_t stream) {
  P p{};
  const float** f = (const float**)&p;
  for (int i = 0; i < 31; ++i) f[i] = (const float*)d_in[i];
  p.out = (float*)d_out;
  char* ws = (char*)d_ws;
  size_t off = 0;
  p.hn = (u16*)(ws + off); off += (size_t)NT_ * 1024 * 2;
  p.proj = (u16*)(ws + off); off += (size_t)NT_ * EVN * 2;
  p.ot1 = (u16*)(ws + off); off += (size_t)NT_ * 512 * 2;
  p.wt = (u16*)(ws + off); off += 4 * LW * 2;
  p.mods = (float*)(ws + off); off += 4 * 9 * 6144 * 4;
  p.rope = (float*)(ws + off); off += 64 * 16 * 2 * 4;
  P* gp = (P*)(ws + off); off += 4096;
  p.cnt = (int*)(ws + off); off += 256;
  p.flags = (int*)(ws + off); off += 8 * 8320 * 4;
  off = (off + 255) & ~(size_t)255;
  p.ring = ws + off; off += (size_t)128 * RING * SLOT_BYTES;
  p.bar = (unsigned*)(ws + off); off += XCD_BAR_WORDS * 4;
  static int grid_blocks = 0;
  if (!grid_blocks) {
    int dev = 0, cus = 0, per_cu = 0;
    hipGetDevice(&dev);
    hipDeviceGetAttribute(&cus, hipDeviceAttributeMultiprocessorCount, dev);
    hipOccupancyMaxActiveBlocksPerMultiprocessor(&per_cu, mk, 256, 0);
    if (per_cu < 1) per_cu = 1;
    if (per_cu > 2) per_cu = 2;
    grid_blocks = cus * per_cu;
  }
#if MK_MULTI
  for (int ph = 0; ph < NPH; ++ph) {
    int a = ph, b = ph + 1;
    hipLaunchKernelGGL(mk, dim3(grid_blocks), dim3(256), 0, stream, p, gp, a, b);
  }
#else
  hipMemsetAsync(p.bar, 0, XCD_BAR_WORDS * 4, stream);
  int ph0 = 0, ph1 = NPH;
  void* args[] = {&p, &gp, &ph0, &ph1};
  hipError_t e = hipLaunchCooperativeKernel((void*)mk, dim3(grid_blocks), dim3(256), args, 0, stream);
  if (e != hipSuccess) fprintf(stderr, "cooperative launch failed: %s (grid %d)\n", hipGetErrorString(e), grid_blocks);
#endif
}
```

```cpp
#include <hip/hip_runtime.h>
#include <hip/hip_cooperative_groups.h>
#include <cstdio>
namespace cg = cooperative_groups;

#ifndef MK_MULTI
#define MK_MULTI 0
#endif

#define DI __device__ __forceinline__
#define DN __device__ __noinline__
typedef unsigned short u16;
typedef __attribute__((ext_vector_type(8))) short bf16x8;
typedef __attribute__((ext_vector_type(4))) short s16x4;
typedef __attribute__((ext_vector_type(16))) float f32x16;
#define MFMA(a, b, c) __builtin_amdgcn_mfma_f32_32x32x16_bf16((a), (b), (c), 0, 0, 0)

static constexpr int NP_ = 4096, NT_ = 36864;
static constexpr int EVN = 3616, ODN = 2848;
static constexpr size_t OFF_AK = 37748736, OFF_AV = 41943040, OFF_SB = 46137344, OFF_CK = 48234496, OFF_CV = 49283072, OFF_SD = 50331648;
static constexpr size_t LW = 13631488, WO_UP = 0, WO_DN = 5767168, WO_IN = 8650752, WO_OUT = 12582912;
static constexpr int NPH = 34;
static constexpr int SMEM_BYTES = 80 * 1024;

struct P {
  const float *x_prompt, *x_sample, *cache_a_k, *cache_a_v, *state_b, *cache_c_k, *cache_c_v, *state_d, *c, *c_ctx, *ada_w, *ada_b,
      *norm1_g, *norm2_g, *ffn_up, *ffn_conv, *ffn_down, *ev_w_in, *ev_w_out, *a_rpb, *b_w_g2, *b_b_g, *b_norm_g, *od_w_in, *od_w_out,
      *c_sink, *d_conv, *d_a_log, *d_dt_bias, *d_norm_g, *final_g;
  float* out;
  u16 *hn, *proj, *ot1, *wt;
  float *mods, *rope;
  int* cnt;
  int* flags;
  char* ring;
  unsigned* bar;
};

typedef __attribute__((ext_vector_type(2))) __bf16 bf2_t;
typedef __attribute__((ext_vector_type(2))) float f2_t;
typedef __attribute__((ext_vector_type(4))) unsigned u32x4_t;
DI unsigned pk2(float a, float b) { const f2_t v = {a, b}; return __builtin_bit_cast(unsigned, __builtin_convertvector(v, bf2_t)); }
DI u16 f2bf(float x) { return __builtin_bit_cast(u16, (__bf16)x); }
DI float bf2f(u16 b) { return __uint_as_float(((unsigned)b) << 16); }
DI int crow(int i, int h) { return (i & 3) + 8 * (i >> 2) + 4 * h; }
template <int S> DI bf16x8 packs(const f32x16& x) {
  u32x4_t v;
  v[0] = pk2(x[8 * S], x[8 * S + 1]); v[1] = pk2(x[8 * S + 2], x[8 * S + 3]); v[2] = pk2(x[8 * S + 4], x[8 * S + 5]); v[3] = pk2(x[8 * S + 6], x[8 * S + 7]);
  return __builtin_bit_cast(bf16x8, v);
}
DI bf16x8 ld2x4(const u16* p) {
  s16x4 lo = *(const s16x4*)p, hi = *(const s16x4*)(p + 8);
  return __builtin_shufflevector(lo, hi, 0, 1, 2, 3, 4, 5, 6, 7);
}
DI float siluf(float x) { return x / (1.f + __expf(-x)); }
DI int opq(int x) { asm volatile("" : "+v"(x)); return x; }
DI float shx(float v, int lane, int o) { return __int_as_float(__builtin_amdgcn_ds_bpermute((lane ^ o) << 2, __float_as_int(v))); }
template <class T> DI T* uni(T* q) { return q; }
DI void zero16(f32x16& a) {
#pragma unroll
  for (int i = 0; i < 16; ++i) a[i] = 0.f;
}

DI void prep_phase(const P* __restrict__ gp, char* smem) {
  const P& p = *gp;
  int tid_ = threadIdx.x; asm volatile("" : "+v"(tid_)); const int tid = tid_;
  const int NWT = 4 * (1408 + 704 + 256) + 2 * (960 + 768);
  const int NADA = 384;
  const int total = NWT + NADA + 1;
  for (int item = blockIdx.x; item < total; item += gridDim.x) {
    if (item < NWT) {
      int rem = item; const float* src = nullptr; u16* dst = nullptr; int K = 0, N = 0, NPd = 0;
      for (int l = 0; l < 4; ++l) {
        const int jj = l >> 1; const bool ev = !(l & 1);
        const int nin = ev ? 960 : 768;
        if (rem < 1408) { src = p.ffn_up + (size_t)l * 1024 * 5632; dst = p.wt + l * LW + WO_UP; K = 1024; N = 5632; NPd = 5632; break; }
        rem -= 1408;
        if (rem < 704) { src = p.ffn_down + (size_t)l * 2816 * 1024; dst = p.wt + l * LW + WO_DN; K = 2816; N = 1024; NPd = 1024; break; }
        rem -= 704;
        if (rem < nin) { src = ev ? p.ev_w_in + (size_t)jj * 1024 * EVN : p.od_w_in + (size_t)jj * 1024 * ODN; dst = p.wt + l * LW + WO_IN; K = 1024; N = ev ? EVN : ODN; NPd = ev ? 3840 : 3072; break; }
        rem -= nin;
        if (rem < 256) { src = (ev ? p.ev_w_out : p.od_w_out) + (size_t)jj * 1024 * 1024; dst = p.wt + l * LW + WO_OUT; K = 1024; N = 1024; NPd = 1024; break; }
        rem -= 256;
      }
      const int ntn = NPd >> 6;
      const int tk = rem / ntn, tn = rem - tk * ntn;
      const int scol0 = (N == 5632) ? (((tn >> 1) & 1) * 2816 + (tn >> 2) * 128 + (tn & 1) * 64) : tn * 64;
      float* T = (float*)smem;
      __syncthreads();
#pragma unroll
      for (int i = 0; i < 16; ++i) {
        const int k = i * 4 + (tid >> 6), n = tid & 63;
        const int gn = scol0 + n;
        T[k * 65 + n] = (gn < N) ? src[(size_t)(tk * 64 + k) * N + gn] : 0.f;
      }
      __syncthreads();
#pragma unroll
      for (int i = 0; i < 2; ++i) {
        const int q = tid + 256 * i; const int n = q & 63, kc = q >> 6;
        const int pn = tn * 64 + n; const int nt32 = pn >> 5, rr = pn & 31;
        const int kstep = tk * 4 + (kc >> 1), hh = kc & 1;
        bf16x8 w;
#pragma unroll
        for (int j = 0; j < 8; ++j) w[j] = (short)f2bf(T[(kc * 8 + j) * 65 + n]);
        *(bf16x8*)(dst + ((size_t)(nt32 * (K >> 4) + kstep) * 64 + hh * 32 + rr) * 8) = w;
      }
    } else if (item < NWT + NADA) {
      const int it = item - NWT; const int l = it / 96, cgp = it - l * 96; const int n0 = cgp * 64;
      float* sc = (float*)smem;
      float* red = sc + 9 * 1024;
      __syncthreads();
      for (int idx = tid; idx < 9 * 1024; idx += 256) {
        const int ci = idx >> 10, k = idx & 1023;
        const float x = ci < 8 ? p.c[ci * 1024 + k] : p.c_ctx[k];
        sc[idx] = x / (1.f + expf(-x));
      }
      __syncthreads();
      const int wave = tid >> 6, lane = tid & 63;
      float acc[9];
#pragma unroll
      for (int ci = 0; ci < 9; ++ci) acc[ci] = 0.f;
      const float* wp = p.ada_w + ((size_t)l * 1024 + wave * 256) * 6144 + n0 + lane;
#pragma unroll 8
      for (int k = 0; k < 256; ++k) {
        const float wv = wp[(size_t)k * 6144];
#pragma unroll
        for (int ci = 0; ci < 9; ++ci) acc[ci] += sc[ci * 1024 + wave * 256 + k] * wv;
      }
#pragma unroll
      for (int ci = 0; ci < 9; ++ci) red[(wave * 9 + ci) * 64 + lane] = acc[ci];
      __syncthreads();
      for (int idx = tid; idx < 576; idx += 256) {
        const int ci = idx >> 6, col = idx & 63;
        const float s = red[(0 * 9 + ci) * 64 + col] + red[(1 * 9 + ci) * 64 + col] + red[(2 * 9 + ci) * 64 + col] + red[(3 * 9 + ci) * 64 + col];
        p.mods[(size_t)(l * 9 + ci) * 6144 + n0 + col] = s + p.ada_b[l * 6144 + n0 + col];
      }
    } else {
      if (tid < 8) p.cnt[tid] = 0;
      for (int i = tid; i < 8 * 8320; i += 256) p.flags[i] = 0;
      for (int idx = tid; idx < 1024; idx += 256) {
        const int pos = idx >> 4, fi = idx & 15;
        const float inv = powf(10000.f, -(float)fi / 16.f);
        const float ang = (float)pos * inv;
        p.rope[idx * 2] = cosf(ang); p.rope[idx * 2 + 1] = sinf(ang);
      }
    }
  }
}

DI void norm_phase(const P* __restrict__ gp, int l, int which, bool first, bool fin) {
  const P& p = *gp;
  int tid_ = threadIdx.x; asm volatile("" : "+v"(tid_)); const int tid = tid_, lane = tid & 63, wave = tid >> 6;
  for (int item = blockIdx.x; item < NT_ / 8; item += gridDim.x) {
    float4 v[2][4];
    float ss[2];
#pragma unroll
    for (int u = 0; u < 2; ++u) {
      const int tok = item * 8 + u * 4 + wave;
      const float* src = first ? (tok < NP_ ? p.x_prompt + (size_t)tok * 1024 : p.x_sample + (size_t)(tok - NP_) * 1024) : p.out + (size_t)tok * 1024;
#pragma unroll
      for (int i = 0; i < 4; ++i) v[u][i] = ((const float4*)src)[lane + 64 * i];
    }
#pragma unroll
    for (int u = 0; u < 2; ++u) {
      float a = 0.f;
#pragma unroll
      for (int i = 0; i < 4; ++i) a += v[u][i].x * v[u][i].x + v[u][i].y * v[u][i].y + v[u][i].z * v[u][i].z + v[u][i].w * v[u][i].w;
#pragma unroll
      for (int o = 32; o >= 1; o >>= 1) a += shx(a, lane, o);
      ss[u] = a;
    }
#pragma unroll
    for (int u = 0; u < 2; ++u) {
      const int tok = item * 8 + u * 4 + wave;
      const float rstd = rsqrtf(ss[u] * (1.f / 1024.f) + 1e-6f);
      if (fin) {
#pragma unroll
        for (int i = 0; i < 4; ++i) {
          const float4 g = ((const float4*)p.final_g)[lane + 64 * i];
          float4 y; y.x = v[u][i].x * rstd * g.x; y.y = v[u][i].y * rstd * g.y; y.z = v[u][i].z * rstd * g.z; y.w = v[u][i].w * rstd * g.w;
          ((float4*)(p.out + (size_t)tok * 1024))[lane + 64 * i] = y;
        }
      } else {
        const int ci = tok < NP_ ? 8 : (tok - NP_) >> 12;
        const float* md = p.mods + (size_t)(l * 9 + ci) * 6144 + which * 3072;
        const float* gpp = (which ? p.norm2_g : p.norm1_g) + l * 1024;
#pragma unroll
        for (int i = 0; i < 4; ++i) {
          const float4 g = ((const float4*)gpp)[lane + 64 * i];
          const float4 sh = ((const float4*)md)[lane + 64 * i];
          const float4 sc = ((const float4*)(md + 1024))[lane + 64 * i];
          ushort4 o;
          o.x = f2bf(v[u][i].x * rstd * g.x * (1.f + sc.x) + sh.x);
          o.y = f2bf(v[u][i].y * rstd * g.y * (1.f + sc.y) + sh.y);
          o.z = f2bf(v[u][i].z * rstd * g.z * (1.f + sc.z) + sh.z);
          o.w = f2bf(v[u][i].w * rstd * g.w * (1.f + sc.w) + sh.w);
          ((ushort4*)(p.hn + (size_t)tok * 1024))[lane + 64 * i] = o;
          if (first) ((float4*)(p.out + (size_t)tok * 1024))[lane + 64 * i] = v[u][i];
        }
      }
    }
  }
}

DI uint4 ldsel(const u16* pv, const u16* safe, unsigned ok) {
  uint4 t = *(const uint4*)(ok ? pv : safe);
  if (!ok) { t.x = 0; t.y = 0; t.z = 0; t.w = 0; }
  return t;
}
enum { EPI_PROJ = 0, EPI_RES = 1, EPI_FFN = 2 };

template <int EPI, int WN>
DI void gemm_phase(const P* __restrict__ gp, int l, char* smem, const u16* __restrict__ A, int lda, const u16* __restrict__ B, int ldb, int K, int MT,
                   int NTn, int gsel) {
  const P& p = *gp;
  u16* As = (u16*)smem;
  int tid_ = threadIdx.x; asm volatile("" : "+v"(tid_)); const int tid = tid_, lane = tid & 63, wave = tid >> 6, r = lane & 31, h = lane >> 5;
  const int KT = K >> 6;
  const bool even = !(l & 1); const int jj = l >> 1;
  const int ntiles = MT * NTn;
  const int nlb = gridDim.x >> 3, xcd = blockIdx.x & 7, lb = blockIdx.x >> 3;
  for (int it = 0;; ++it) {
    const int g = (it * 8 + xcd) * nlb + lb;
    if (g >= ntiles) break;
    const int SM = nlb >> 3;
    const int band = g / (SM * NTn); const int rem = g - band * SM * NTn;
    const int nt = rem / SM, mt = band * SM + (rem - nt * SM);
    int seqbase = 0, L = 0, tin0 = 0;
    if (EPI == EPI_FFN) {
      L = NT_; seqbase = 0; tin0 = mt * 126;
      if (tin0 >= NT_) continue;
    }
    const int row0 = tid >> 3, kc0 = (tid & 7) * 8;
    const long arow0 = (EPI == EPI_FFN) ? (long)seqbase + tin0 - 1 + row0 : (long)mt * 128 + row0;
    const u16* abase = A + arow0 * lda + kc0;
    unsigned avalid = 0;
#pragma unroll
    for (int i = 0; i < 4; ++i) {
      if (EPI == EPI_FFN) { const int ts = tin0 - 1 + row0 + 32 * i; if (ts >= 0 && ts < L) avalid |= 1u << i; }
      else avalid |= 1u << i;
    }
    const u16* bb0 = B + ((size_t)((nt * 4 + wave) * WN * (K >> 4)) * 64 + lane) * 8;
    const size_t bts = (size_t)(K >> 4) * 512;
    f32x16 acc[4][WN];
#pragma unroll
    for (int a = 0; a < 4; ++a)
#pragma unroll
      for (int b = 0; b < WN; ++b) zero16(acc[a][b]);
#define GLD_A(i, ko) ldsel(abase + (size_t)(32 * (i)) * lda + (ko), A, (avalid >> (i)) & 1u)
#define GLD_BF(dst, kt_) { const u16* q_ = bb0 + (size_t)(kt_) * 2048; \
      _Pragma("unroll") for (int ni_ = 0; ni_ < WN; ++ni_) { \
        dst[ni_][0] = *(const bf16x8*)(q_ + ni_ * bts); dst[ni_][1] = *(const bf16x8*)(q_ + ni_ * bts + 512); \
        dst[ni_][2] = *(const bf16x8*)(q_ + ni_ * bts + 1024); dst[ni_][3] = *(const bf16x8*)(q_ + ni_ * bts + 1536); } }
    uint4 ra0 = GLD_A(0, 0), ra1 = GLD_A(1, 0), ra2 = GLD_A(2, 0), ra3 = GLD_A(3, 0);
    uint4 sa0, sa1, sa2, sa3;
    if (WN == 1) { sa0 = GLD_A(0, 64); sa1 = GLD_A(1, 64); sa2 = GLD_A(2, 64); sa3 = GLD_A(3, 64); }
    bf16x8 bc[WN][4], bn[WN][4];
    GLD_BF(bc, 0);
    if (WN == 1) GLD_BF(bn, 1);
#define LSTORE(buf, A0, A1, A2, A3) { \
      u16* ad = As + (buf) * 9216 + row0 * 72 + kc0; \
      *(uint4*)(ad) = A0; *(uint4*)(ad + 32 * 72) = A1; *(uint4*)(ad + 64 * 72) = A2; *(uint4*)(ad + 96 * 72) = A3; }
#define COMPUTE(buf, BF, KN) { \
      const u16* Ab = As + (buf) * 9216 + r * 72 + h * 8; \
      const bool more_ = (KN) < KT; const u16* q_ = bb0 + (size_t)(KN) * 2048; \
      _Pragma("unroll") for (int ks = 0; ks < 4; ++ks) { \
        const bf16x8 a0 = *(const bf16x8*)(Ab + ks * 16); \
        const bf16x8 a1 = *(const bf16x8*)(Ab + 32 * 72 + ks * 16); \
        const bf16x8 a2 = *(const bf16x8*)(Ab + 64 * 72 + ks * 16); \
        const bf16x8 a3 = *(const bf16x8*)(Ab + 96 * 72 + ks * 16); \
        _Pragma("unroll") for (int ni_ = 0; ni_ < WN; ++ni_) { \
          acc[0][ni_] = MFMA(a0, BF[ni_][ks], acc[0][ni_]); acc[1][ni_] = MFMA(a1, BF[ni_][ks], acc[1][ni_]); \
          acc[2][ni_] = MFMA(a2, BF[ni_][ks], acc[2][ni_]); acc[3][ni_] = MFMA(a3, BF[ni_][ks], acc[3][ni_]); } \
        if (more_) { _Pragma("unroll") for (int ni_ = 0; ni_ < WN; ++ni_) BF[ni_][ks] = *(const bf16x8*)(q_ + ni_ * bts + ks * 512); } } }
    if (WN == 1) {
    LSTORE(0, ra0, ra1, ra2, ra3);
    ra0 = GLD_A(0, 128); ra1 = GLD_A(1, 128); ra2 = GLD_A(2, 128); ra3 = GLD_A(3, 128);
    __syncthreads();
    for (int kt = 0; kt < KT; kt += 2) {
      COMPUTE(0, bc, kt + 2);
      LSTORE(1, sa0, sa1, sa2, sa3);
      if (kt + 3 < KT) {
        const int ko = (kt + 3) * 64;
        sa0 = GLD_A(0, ko); sa1 = GLD_A(1, ko); sa2 = GLD_A(2, ko); sa3 = GLD_A(3, ko);
      }
      __syncthreads();
      COMPUTE(1, bn, kt + 3);
      if (kt + 2 < KT) {
        LSTORE(0, ra0, ra1, ra2, ra3);
        if (kt + 4 < KT) {
          const int ko = (kt + 4) * 64;
          ra0 = GLD_A(0, ko); ra1 = GLD_A(1, ko); ra2 = GLD_A(2, ko); ra3 = GLD_A(3, ko);
        }
      }
      __syncthreads();
    }
    } else {
      LSTORE(0, ra0, ra1, ra2, ra3);
      ra0 = GLD_A(0, 64); ra1 = GLD_A(1, 64); ra2 = GLD_A(2, 64); ra3 = GLD_A(3, 64);
      __syncthreads();
      for (int kt = 0; kt < KT; kt += 2) {
        COMPUTE(0, bc, kt + 1);
        LSTORE(1, ra0, ra1, ra2, ra3);
        if (kt + 2 < KT) { const int ko = (kt + 2) * 64; ra0 = GLD_A(0, ko); ra1 = GLD_A(1, ko); ra2 = GLD_A(2, ko); ra3 = GLD_A(3, ko); }
        __syncthreads();
        COMPUTE(1, bc, kt + 2);
        if (kt + 2 < KT) {
          LSTORE(0, ra0, ra1, ra2, ra3);
          if (kt + 3 < KT) { const int ko = (kt + 3) * 64; ra0 = GLD_A(0, ko); ra1 = GLD_A(1, ko); ra2 = GLD_A(2, ko); ra3 = GLD_A(3, ko); }
        }
        __syncthreads();
      }
    }
    if (EPI == EPI_PROJ) {
      const int N = even ? EVN : ODN;
#pragma unroll
      for (int tm = 0; tm < 4; ++tm)
#pragma unroll
        for (int tn = 0; tn < WN; ++tn) {
          const int col = nt * (128 * WN) + wave * (32 * WN) + tn * 32 + r;
          if (col < N) {
#pragma unroll
            for (int i = 0; i < 16; ++i) {
              const int row = mt * 128 + tm * 32 + crow(i, h);
              const float v = acc[tm][tn][i];
              p.proj[(size_t)row * N + col] = f2bf(v);
              if (row < NP_) {
                const int b = row >> 8, t = row & 255, d = col & 63;
                if (even) {
                  if (col >= 512 && col < 1536) {
                    const int wh = (col - 512) >> 9, hh = ((col - 512) >> 6) & 7;
                    p.out[(wh ? OFF_AV : OFF_AK) + ((size_t)(((b * 2 + jj) * 8 + hh) * 256 + t)) * 64 + d] = v;
                  }
                } else {
                  if (col >= 512 && col < 768) {
                    const int wh = (col - 512) >> 7, kv = ((col - 512) >> 6) & 1;
                    p.out[(wh ? OFF_CV : OFF_CK) + ((size_t)(((b * 2 + jj) * 2 + kv) * 256 + t)) * 64 + d] = v;
                  }
                }
              }
            }
          }
        }
    } else if (EPI == EPI_RES) {
#pragma unroll
      for (int tm = 0; tm < 4; ++tm)
#pragma unroll
        for (int tn = 0; tn < WN; ++tn) {
          const int col = nt * (128 * WN) + wave * (32 * WN) + tn * 32 + r;
#pragma unroll
          for (int i = 0; i < 16; ++i) {
            const int row = mt * 128 + tm * 32 + crow(i, h);
            const int ci = row < NP_ ? 8 : (row - NP_) >> 12;
            const float g = p.mods[(size_t)(l * 9 + ci) * 6144 + gsel * 1024 + col];
            float* xp = p.out + (size_t)row * 1024 + col;
            *xp = *xp + g * acc[tm][tn][i];
          }
        }
    } else {
      float* U = (float*)smem;
      const float* cw = p.ffn_conv + (size_t)l * 3 * 5632;
      u16* act = p.proj;
#pragma unroll
      for (int ps = 0; ps < WN; ++ps) {
        __syncthreads();
        if (WN == 1) {
#pragma unroll
          for (int tm = 0; tm < 4; ++tm)
#pragma unroll
            for (int i = 0; i < 16; ++i) U[(tm * 32 + crow(i, h)) * 132 + wave * 32 + r] = acc[tm][0][i];
        } else if ((wave & 1) == ps) {
#pragma unroll
          for (int tm = 0; tm < 4; ++tm)
#pragma unroll
            for (int tn = 0; tn < WN; ++tn)
#pragma unroll
              for (int i = 0; i < 16; ++i) U[(tm * 32 + crow(i, h)) * 132 + (wave >> 1) * 64 + tn * 32 + r] = acc[tm][tn][i];
        }
        __syncthreads();
        const int f = tid & 63, rg = tid >> 6; const int fg = nt * (64 * WN) + ps * 64 + f;
        const float wa0 = cw[fg], wa1 = cw[5632 + fg], wa2 = cw[2 * 5632 + fg];
        const float wg0 = cw[2816 + fg], wg1 = cw[5632 + 2816 + fg], wg2 = cw[2 * 5632 + 2816 + fg];
        const int rbeg = 1 + 32 * rg, rend = rg == 3 ? 126 : 32 * rg + 32;
        float ap = U[(rbeg - 1) * 132 + f], ac = U[rbeg * 132 + f];
        float gp_ = U[(rbeg - 1) * 132 + 64 + f], gc = U[rbeg * 132 + 64 + f];
        for (int rr = rbeg; rr <= rend; ++rr) {
          const int ts = tin0 - 1 + rr;
          if (ts >= L) break;
          const float an = U[(rr + 1) * 132 + f], gn = U[(rr + 1) * 132 + 64 + f];
          const bool sst = ts < NP_ ? ((ts & 255) == 0) : ((ts & 4095) == 0), sen = ts < NP_ ? ((ts & 255) == 255) : ((ts & 4095) == 4095);
          const float a = (sst ? 0.f : wa0 * ap) + wa1 * ac + (sen ? 0.f : wa2 * an);
          const float g = (sst ? 0.f : wg0 * gp_) + wg1 * gc + (sen ? 0.f : wg2 * gn);
          act[(size_t)(seqbase + ts) * 2816 + fg] = f2bf(a * siluf(g));
          ap = ac; ac = an; gp_ = gc; gc = gn;
        }
      }
      __syncthreads();
    }
  }
}

template <int MODE>
DI void attn_item(const P* __restrict__ gp, int jj, int it, char* smem) {
  const P& p = *gp;
  const u16* projp = uni(p.proj); u16* hnp = uni(p.hn); const float* ropep = uni(p.rope);
  u16* Ks = (u16*)smem; u16* Vt = Ks + 64 * 72; float* rpb_s = (float*)(Vt + 64 * 72);
  int tid_ = threadIdx.x; asm volatile("" : "+v"(tid_)); const int tid = tid_, lane = tid & 63, wave = tid >> 6, r = lane & 31, h = lane >> 5;
  constexpr bool EVENL = (MODE == 0 || MODE == 1);
  constexpr bool LAT = (MODE == 1 || MODE == 3);
  constexpr int PS = EVENL ? EVN : ODN;
  int b, hq, qb, tokbase;
  if (!LAT) { b = it >> 4; hq = (it >> 1) & 7; qb = it & 1; tokbase = b * 256; }
  else { b = it >> 8; hq = (it >> 5) & 7; qb = it & 31; tokbase = NP_ + b * 4096; }
  const int hk = EVENL ? hq : (hq >> 2);
  const int kcol = 512 + hk * 64, vcol = (EVENL ? 1024 : 640) + hk * 64, qcol = hq * 64;
  const int tq = qb * 128 + wave * 32 + r;
  const size_t qtok = (size_t)tokbase + tq;
  __syncthreads();
  if (MODE == 1) { for (int i = tid; i < 465; i += 256) rpb_s[i] = p.a_rpb[(size_t)(jj * 8 + hq) * 465 + i]; }
  bf16x8 qf[4];
#pragma unroll
  for (int s = 0; s < 4; ++s) qf[s] = *(const bf16x8*)(projp + qtok * PS + qcol + 16 * s + 8 * h);
  if (MODE == 3) {
    const int prow = tq >> 6, pcol = tq & 63;
#pragma unroll
    for (int half = 0; half < 2; ++half) {
      const int pos = half ? pcol : prow;
#pragma unroll
      for (int j = 0; j < 8; ++j) {
        const float cs = ropep[(pos * 16 + 8 * h + j) * 2], sn = ropep[(pos * 16 + 8 * h + j) * 2 + 1];
        const float x1 = bf2f((u16)qf[2 * half][j]), x2 = bf2f((u16)qf[2 * half + 1][j]);
        qf[2 * half][j] = (short)f2bf(x1 * cs - x2 * sn);
        qf[2 * half + 1][j] = (short)f2bf(x1 * sn + x2 * cs);
      }
    }
  }
  float m_run = -1e30f, l_run = 0.f;
  if (MODE == 2 || MODE == 3) { m_run = p.c_sink[jj * 8 + hq]; l_run = h == 0 ? 1.f : 0.f; }
  f32x16 ot[2]; zero16(ot[0]); zero16(ot[1]);
  int loc0 = 0, nloc = 0;
  if (MODE == 1) {
    const int qi0 = 2 * qb;
    const int rlo = min(max(qi0 - 4, 0), 56), rhi = min(max(qi0 + 1 - 4, 0), 56) + 7;
    loc0 = rlo; nloc = rhi - rlo + 1;
  } else if (MODE == 3) {
    loc0 = max(0, 2 * qb - 2); nloc = min(63, 2 * qb + 3) - loc0 + 1;
  }
  const int qi = tq >> 6, qw = tq & 63;
  const int r0w = min(max(qi - 4, 0), 56), c0w = min(max(qw - 8, 0), 48);
  const int key = tid >> 2, seg = tid & 3;
  for (int kb = 0; kb < 4 + nloc; ++kb) {
    const bool isctx = kb < 4;
    const int blk = isctx ? kb : loc0 + kb - 4;
    __syncthreads();
    {
      float kf[16], vf[16];
      if (LAT && isctx) {
        const float* kc = (MODE == 1) ? p.cache_a_k + ((size_t)((b * 2 + jj) * 8 + hk)) * 16384 : p.cache_c_k + ((size_t)((b * 2 + jj) * 2 + hk)) * 16384;
        const float* vc = (MODE == 1) ? p.cache_a_v + ((size_t)((b * 2 + jj) * 8 + hk)) * 16384 : p.cache_c_v + ((size_t)((b * 2 + jj) * 2 + hk)) * 16384;
        const float4* kp4 = (const float4*)(kc + (size_t)(blk * 64 + key) * 64 + seg * 16);
        const float4* vp4 = (const float4*)(vc + (size_t)(blk * 64 + key) * 64 + seg * 16);
#pragma unroll
        for (int e = 0; e < 4; ++e) {
          const float4 a = kp4[e], c = vp4[e];
          kf[4 * e] = a.x; kf[4 * e + 1] = a.y; kf[4 * e + 2] = a.z; kf[4 * e + 3] = a.w;
          vf[4 * e] = c.x; vf[4 * e + 1] = c.y; vf[4 * e + 2] = c.z; vf[4 * e + 3] = c.w;
        }
      } else {
        const u16* rowp = projp + ((size_t)tokbase + blk * 64 + key) * PS;
        const bf16x8 k0 = *(const bf16x8*)(rowp + kcol + seg * 16), k1 = *(const bf16x8*)(rowp + kcol + seg * 16 + 8);
        const bf16x8 v0 = *(const bf16x8*)(rowp + vcol + seg * 16), v1 = *(const bf16x8*)(rowp + vcol + seg * 16 + 8);
#pragma unroll
        for (int e = 0; e < 8; ++e) { kf[e] = bf2f((u16)k0[e]); kf[8 + e] = bf2f((u16)k1[e]); vf[e] = bf2f((u16)v0[e]); vf[8 + e] = bf2f((u16)v1[e]); }
        if (MODE == 3) {
          const bf16x8 p0 = *(const bf16x8*)(rowp + kcol + (seg ^ 1) * 16), p1 = *(const bf16x8*)(rowp + kcol + (seg ^ 1) * 16 + 8);
          const int pos = (seg & 2) ? key : blk;
#pragma unroll
          for (int e = 0; e < 16; ++e) {
            const float pr = bf2f((u16)(e < 8 ? p0[e & 7] : p1[e & 7]));
            const float cs = ropep[(pos * 16 + e) * 2], sn = ropep[(pos * 16 + e) * 2 + 1];
            kf[e] = (seg & 1) ? (pr * sn + kf[e] * cs) : (kf[e] * cs - pr * sn);
          }
        }
      }
      bf16x8 o0, o1;
#pragma unroll
      for (int e = 0; e < 8; ++e) { o0[e] = (short)f2bf(kf[e]); o1[e] = (short)f2bf(kf[8 + e]); }
      *(bf16x8*)(Ks + key * 72 + seg * 16) = o0;
      *(bf16x8*)(Ks + key * 72 + seg * 16 + 8) = o1;
#pragma unroll
      for (int e = 0; e < 16; ++e) Vt[(seg * 16 + e) * 72 + key] = f2bf(vf[e]);
    }
    __syncthreads();
    bool active = true;
    if (MODE == 1 && !isctx) active = (blk >= r0w && blk < r0w + 8);
    if (active) {
      f32x16 st[2]; zero16(st[0]); zero16(st[1]);
#pragma unroll
      for (int kt = 0; kt < 2; ++kt)
#pragma unroll
        for (int s = 0; s < 4; ++s) {
          const bf16x8 a = *(const bf16x8*)(Ks + (kt * 32 + r) * 72 + 16 * s + 8 * h);
          st[kt] = MFMA(a, qf[s], st[kt]);
        }
      float mx = m_run;
#pragma unroll
      for (int kt = 0; kt < 2; ++kt)
#pragma unroll
        for (int i = 0; i < 16; ++i) {
          float s = st[kt][i] * 0.125f;
          const int kk = kt * 32 + crow(i, h);
          if (MODE == 1 && !isctx) {
            const bool ok = (kk >= c0w && kk < c0w + 16);
            s = ok ? s + rpb_s[(blk - qi + 7) * 31 + (kk - qw + 15)] : -1e30f;
          }
          if (MODE == 3 && !isctx) {
            const int dlt = blk * 64 + kk - tq;
            s = (dlt <= 128 && dlt >= -128) ? s : -1e30f;
          }
          st[kt][i] = s;
          mx = fmaxf(mx, s);
        }
      mx = fmaxf(mx, shx(mx, lane, 32));
      const float alpha = __expf(m_run - mx);
      m_run = mx;
      float ps = 0.f;
#pragma unroll
      for (int kt = 0; kt < 2; ++kt)
#pragma unroll
        for (int i = 0; i < 16; ++i) { const float pv = __expf(st[kt][i] - mx); st[kt][i] = pv; ps += pv; }
      l_run = l_run * alpha + ps;
#pragma unroll
      for (int dt = 0; dt < 2; ++dt)
#pragma unroll
        for (int i = 0; i < 16; ++i) ot[dt][i] *= alpha;
#pragma unroll
      for (int kt = 0; kt < 2; ++kt) {
        const bf16x8 pb0 = packs<0>(st[kt]), pb1 = packs<1>(st[kt]);
#pragma unroll
        for (int dt = 0; dt < 2; ++dt) {
          const bf16x8 pa0 = ld2x4(Vt + (dt * 32 + r) * 72 + kt * 32 + 4 * h);
          const bf16x8 pa1 = ld2x4(Vt + (dt * 32 + r) * 72 + kt * 32 + 16 + 4 * h);
          ot[dt] = MFMA(pa0, pb0, ot[dt]);
          ot[dt] = MFMA(pa1, pb1, ot[dt]);
        }
      }
    }
  }
  l_run += shx(l_run, lane, 32);
  const float inv = 1.f / l_run;
  u16* dst = hnp + qtok * 1024 + qcol;
#pragma unroll
  for (int dt = 0; dt < 2; ++dt)
#pragma unroll
    for (int g4 = 0; g4 < 4; ++g4) {
      ushort4 o;
      o.x = f2bf(ot[dt][4 * g4] * inv); o.y = f2bf(ot[dt][4 * g4 + 1] * inv); o.z = f2bf(ot[dt][4 * g4 + 2] * inv); o.w = f2bf(ot[dt][4 * g4 + 3] * inv);
      *(ushort4*)(dst + dt * 32 + 8 * g4 + 4 * h) = o;
    }
}

struct ChainId { int lat, b, h, dir, T, base, nch; };
DI ChainId chain_decode(int it) {
  ChainId c; c.lat = it < 128; const int q = c.lat ? it : it - 128;
  c.b = q >> 4; c.h = (q >> 1) & 7; c.dir = q & 1; c.T = c.lat ? 4096 : 256; c.base = c.lat ? NP_ + c.b * 4096 : c.b * 256; c.nch = c.T >> 6;
  return c;
}
DI int tokof(const ChainId& c, int step, int row) { const int pp = step * 64 + row; return c.base + (c.dir ? c.T - 1 - pp : pp); }


static constexpr int RING = 4;
static constexpr int SLOT_BYTES = 53760;
DI void wait_ge(int* flag, int val, int tid) {
  if (tid < 64) {
    if (tid == 0) { while (__hip_atomic_load(flag, __ATOMIC_RELAXED, __HIP_MEMORY_SCOPE_AGENT) < val) __builtin_amdgcn_s_sleep(1); }
    __builtin_amdgcn_fence(__ATOMIC_ACQUIRE, "agent");
  }
  __syncthreads();
}
DI void publish(int* flag, int val, int tid) {
  asm volatile("s_waitcnt vmcnt(0)" ::: "memory");
  __syncthreads();
  if (tid == 0) __hip_atomic_store(flag, val, __ATOMIC_RELAXED, __HIP_MEMORY_SCOPE_AGENT);
}
typedef __attribute__((ext_vector_type(4))) unsigned u32x4;
DI void copy_out(const char* lds, char* g, int bytes, int tid) {
  for (int i = opq(tid) * 16; i < bytes; i += 256 * 16) {
    const u32x4 v = *(const u32x4*)(lds + i);
    char* dst = g + i;
    asm volatile("global_store_dwordx4 %0, %1, off sc0 sc1" :: "v"(dst), "v"(v) : "memory");
  }
}
template <int BYTES>
DI void copy_in_t(char* lds, const char* g, int tid) {
  constexpr int N = (BYTES + 4095) / 4096;
  const int t16 = opq(tid) * 16;
  uint4 v[N];
#pragma unroll
  for (int j = 0; j < N; ++j) { const int i = t16 + j * 4096; v[j] = make_uint4(0, 0, 0, 0); if (i < BYTES) v[j] = *(const uint4*)(g + i); }
#pragma unroll
  for (int j = 0; j < N; ++j) { const int i = t16 + j * 4096; if (i < BYTES) *(uint4*)(lds + i) = v[j]; }
}

template <int ROLE>
DI void gla_chain(const P* __restrict__ gp, int jj, int it, char* smem, int k0, int kstep, int fs = 0) {
  const P& p = *gp;
  const ChainId cid = chain_decode(it);
  int tid_ = threadIdx.x; asm volatile("" : "+v"(tid_)); const int tid = tid_, lane = tid & 63, wave = tid >> 6, r = lane & 31, h = lane >> 5;
  const int hh = cid.h, dir = cid.dir;
  u16* QT = (u16*)smem; u16* KT = QT + 4608; u16* KEt = KT + 4608; u16* Vt = KEt + 4608;
  float* dec = (float*)(Vt + 4608); float* GL = dec + 64; float* gq = GL + 1024; float* Ost = gq + 256;
  constexpr int IMG = 4 * 9216 + 256;
  char* slots = uni(p.ring) + (size_t)it * RING * SLOT_BYTES; int* ready = uni(p.flags) + (jj * 2 + 4 * fs) * 8320 + it * 64; int* done = uni(p.flags) + (jj * 2 + 4 * fs) * 8320 + 8192 + it;
  const int d = tid & 63, cq = tid >> 6;
  float wg[16];
#pragma unroll
  for (int rr = 0; rr < 16; ++rr) wg[rr] = p.b_w_g2[((size_t)((jj * 2 + dir) * 16 + rr)) * 512 + hh * 64 + d];
  const float bg = p.b_b_g[(jj * 2 + dir) * 512 + hh * 64 + d];
  const int vh = wave & 1;
  f32x16 S[2]; zero16(S[0]); zero16(S[1]);
  const size_t sidx = ((size_t)(((cid.b * 2 + jj) * 2 + dir) * 8 + hh)) * 4096;
  if (ROLE != 1 && wave < 2 && cid.lat) {
#pragma unroll
    for (int dt = 0; dt < 2; ++dt)
#pragma unroll
      for (int i = 0; i < 16; ++i) S[dt][i] = p.state_b[sidx + (dt * 32 + crow(i, h)) * 64 + vh * 32 + r];
  }
  for (int step_ = k0; step_ < cid.nch; step_ += kstep) {
    int step = step_;
    asm volatile("" : "+v"(step));
    if (ROLE == 1) wait_ge(done, step_ - RING + 1, tid);
    if (ROLE == 2) wait_ge(ready + step_, 1, tid);
    __syncthreads();
    if (ROLE == 2) { copy_in_t<IMG>(smem, slots + (size_t)(step_ % RING) * SLOT_BYTES, tid); __syncthreads(); if (tid == 0) __hip_atomic_store(done, step_ + 1, __ATOMIC_RELAXED, __HIP_MEMORY_SCOPE_AGENT); }
    if (ROLE != 2) {
    {
      const int c = tid >> 2, sg = tid & 3;
      const int tok = tokof(cid, step, c);
      const ushort4 gv = *(const ushort4*)(p.proj + (size_t)tok * EVN + 3072 + dir * 16 + sg * 4);
      GL[c * 16 + sg * 4] = bf2f(gv.x); GL[c * 16 + sg * 4 + 1] = bf2f(gv.y); GL[c * 16 + sg * 4 + 2] = bf2f(gv.z); GL[c * 16 + sg * 4 + 3] = bf2f(gv.w);
    }
    __syncthreads();
    float Gl[16]; float run = 0.f;
#pragma unroll
    for (int i = 0; i < 16; ++i) {
      const int c = cq * 16 + i;
      float z = bg;
#pragma unroll
      for (int rr = 0; rr < 16; ++rr) z += GL[c * 16 + rr] * wg[rr];
      const float g = (fminf(z, 0.f) - __logf(1.f + __expf(-fabsf(z)))) * (1.f / 16.f);
      run += g; Gl[i] = run;
    }
    gq[cq * 64 + d] = run;
    __syncthreads();
    float off = 0.f, tot = 0.f;
#pragma unroll
    for (int q2 = 0; q2 < 4; ++q2) { const float t = gq[q2 * 64 + d]; if (q2 < cq) off += t; tot += t; }
#pragma unroll
    for (int i = 0; i < 16; ++i) {
      const int c = cq * 16 + i;
      const int tok = tokof(cid, step, c);
      const float G = Gl[i] + off;
      const u16* rowp = p.proj + (size_t)tok * EVN + hh * 64 + d;
      const float qv = bf2f(rowp[1536]), kv = bf2f(rowp[2048]);
      const u16 vb = rowp[2560];
      QT[c * 72 + d] = f2bf(qv * 0.125f * __expf(G));
      KT[c * 72 + d] = f2bf(kv * __expf(-G));
      KEt[d * 72 + c] = f2bf(kv * __expf(tot - G));
      Vt[d * 72 + c] = vb;
    }
    if (cq == 0) dec[d] = __expf(tot);
    __syncthreads();
    }
    if (ROLE == 1) { copy_out(smem, slots + (size_t)(step_ % RING) * SLOT_BYTES, IMG, tid); publish(ready + step_, 1, tid); continue; }
    if (wave < 2) {
      f32x16 at[2][2];
#pragma unroll
      for (int a = 0; a < 2; ++a)
#pragma unroll
        for (int b2 = 0; b2 < 2; ++b2) zero16(at[a][b2]);
#pragma unroll
      for (int ks = 0; ks < 4; ++ks) {
        const bf16x8 a0 = *(const bf16x8*)(KT + r * 72 + ks * 16 + 8 * h), a1 = *(const bf16x8*)(KT + (32 + r) * 72 + ks * 16 + 8 * h);
        const bf16x8 b0 = *(const bf16x8*)(QT + r * 72 + ks * 16 + 8 * h), b1 = *(const bf16x8*)(QT + (32 + r) * 72 + ks * 16 + 8 * h);
        at[0][0] = MFMA(a0, b0, at[0][0]); at[0][1] = MFMA(a0, b1, at[0][1]);
        at[1][0] = MFMA(a1, b0, at[1][0]); at[1][1] = MFMA(a1, b1, at[1][1]);
      }
#pragma unroll
      for (int st = 0; st < 2; ++st)
#pragma unroll
        for (int ct = 0; ct < 2; ++ct)
#pragma unroll
          for (int i = 0; i < 16; ++i) { if (st * 32 + crow(i, h) > ct * 32 + r) at[st][ct][i] = 0.f; }
      f32x16 o[2]; zero16(o[0]); zero16(o[1]);
#pragma unroll
      for (int ct = 0; ct < 2; ++ct)
#pragma unroll
        for (int st = 0; st < 2; ++st) {
          const bf16x8 x0 = packs<0>(at[st][ct]), x1 = packs<1>(at[st][ct]);
          const bf16x8 pb0 = ld2x4(Vt + (vh * 32 + r) * 72 + st * 32 + 4 * h);
          const bf16x8 pb1 = ld2x4(Vt + (vh * 32 + r) * 72 + st * 32 + 16 + 4 * h);
          o[ct] = MFMA(x0, pb0, o[ct]);
          o[ct] = MFMA(x1, pb1, o[ct]);
        }
#pragma unroll
      for (int dt = 0; dt < 2; ++dt) {
        const bf16x8 xs0 = packs<0>(S[dt]), xs1 = packs<1>(S[dt]);
#pragma unroll
        for (int ct = 0; ct < 2; ++ct) {
          const bf16x8 pa0 = ld2x4(QT + (ct * 32 + r) * 72 + dt * 32 + 4 * h);
          const bf16x8 pa1 = ld2x4(QT + (ct * 32 + r) * 72 + dt * 32 + 16 + 4 * h);
          o[ct] = MFMA(pa0, xs0, o[ct]);
          o[ct] = MFMA(pa1, xs1, o[ct]);
        }
      }
#pragma unroll
      for (int dt = 0; dt < 2; ++dt)
#pragma unroll
        for (int i = 0; i < 16; ++i) S[dt][i] *= dec[dt * 32 + crow(i, h)];
#pragma unroll
      for (int ks = 0; ks < 4; ++ks) {
        const bf16x8 bv = *(const bf16x8*)(Vt + (vh * 32 + r) * 72 + ks * 16 + 8 * h);
#pragma unroll
        for (int dt = 0; dt < 2; ++dt) {
          const bf16x8 a = *(const bf16x8*)(KEt + (dt * 32 + r) * 72 + ks * 16 + 8 * h);
          S[dt] = MFMA(a, bv, S[dt]);
        }
      }
#pragma unroll
      for (int ct = 0; ct < 2; ++ct)
#pragma unroll
        for (int i = 0; i < 16; ++i) Ost[(ct * 32 + crow(i, h)) * 68 + vh * 32 + r] = o[ct][i];
    }
    __syncthreads();
    {
      const int c = tid >> 2, sg = tid & 3;
      const int tok = tokof(cid, step, c);
      u16* dst = (dir ? p.ot1 + (size_t)tok * 512 + hh * 64 : p.hn + (size_t)tok * 1024 + 512 + hh * 64) + sg * 16;
      bf16x8 w0, w1;
#pragma unroll
      for (int e = 0; e < 8; ++e) { w0[e] = (short)f2bf(Ost[c * 68 + sg * 16 + e]); w1[e] = (short)f2bf(Ost[c * 68 + sg * 16 + 8 + e]); }
      *(bf16x8*)dst = w0; *(bf16x8*)(dst + 8) = w1;
    }
  }
  if (wave < 2 && !cid.lat) {
#pragma unroll
    for (int dt = 0; dt < 2; ++dt)
#pragma unroll
      for (int i = 0; i < 16; ++i) p.out[OFF_SB + sidx + (dt * 32 + crow(i, h)) * 64 + vh * 32 + r] = S[dt][i];
  }
}

template <int ROLE>
DI void delta_chain(const P* __restrict__ gp, int jj, int it, char* smem, int k0, int kstep, int fs = 0) {
  const P& p = *gp;
  const ChainId cid = chain_decode(it);
  int tid_ = threadIdx.x; asm volatile("" : "+v"(tid_)); const int tid0 = tid_;
  const int hh = cid.h, dir = cid.dir;
  u16* Qn = (u16*)smem; u16* Kt = Qn + 4608; u16* AQK = Kt + 4608; u16* KC = AQK + 4608;
  float* Wv = (float*)(KC + 4608); float* Gs = Wv + 64 * 65; u16* Kn = (u16*)(Gs + 64); float* At = (float*)(Kn + 4608); float* Bt = At + 64 * 68;
  constexpr int IMG = 4 * 9216 + 16640 + 256;
  char* slots = uni(p.ring) + (size_t)it * RING * SLOT_BYTES; int* ready = uni(p.flags) + (jj * 2 + 1 + 4 * fs) * 8320 + it * 64; int* done = uni(p.flags) + (jj * 2 + 1 + 4 * fs) * 8320 + 8192 + it;
  const float aexp = __expf(p.d_a_log[(jj * 2 + dir) * 8 + hh]);
  const float dtb = p.d_dt_bias[(jj * 2 + dir) * 8 + hh];
  f32x16 S[2]; zero16(S[0]); zero16(S[1]);
  const size_t sidx = ((size_t)(((cid.b * 2 + jj) * 2 + dir) * 8 + hh)) * 4096;
  { const int tid = tid0, lane = tid & 63, wave = tid >> 6, r = lane & 31, h = lane >> 5;
  if (ROLE != 1 && wave < 2 && cid.lat) {
    const int vh = wave & 1;
#pragma unroll
    for (int dt = 0; dt < 2; ++dt)
#pragma unroll
      for (int i = 0; i < 16; ++i) S[dt][i] = p.state_d[sidx + (dt * 32 + crow(i, h)) * 64 + vh * 32 + r];
  }
  }
  u16* CW = (u16*)(smem + 80640);
  __syncthreads();
  for (int i = tid0; i < 576; i += 256) { const int tap = i / 192, c2 = i - tap * 192; const int wh = c2 >> 6, dd = c2 & 63;
    CW[i] = f2bf(p.d_conv[(size_t)jj * 3 * 1536 + tap * 1536 + wh * 512 + hh * 64 + dd]); }
  for (int step_ = k0; step_ < cid.nch; step_ += kstep) {
    int step = step_;
    asm volatile("" : "+v"(step));
    if (ROLE == 1) wait_ge(done, step_ - RING + 1, tid0);
    if (ROLE == 2) wait_ge(ready + step_, 1, tid0);
    __syncthreads();
    if (ROLE == 2) { copy_in_t<IMG>(smem, slots + (size_t)(step_ % RING) * SLOT_BYTES, tid0); __syncthreads(); if (tid0 == 0) __hip_atomic_store(done, step_ + 1, __ATOMIC_RELAXED, __HIP_MEMORY_SCOPE_AGENT); }
    if (ROLE != 2) {
    {const int tid = opq(tid0), lane = tid & 63, wave = __builtin_amdgcn_readfirstlane(tid >> 6), r = lane & 31, h = lane >> 5, vh = wave & 1; (void)r; (void)h; (void)vh; (void)lane;
    if (wave == 0) {
      const int tok = tokof(cid, step, lane);
      const float da = bf2f(p.proj[(size_t)tok * ODN + 2304 + dir * 8 + hh]);
      const float db = bf2f(p.proj[(size_t)tok * ODN + 2320 + dir * 8 + hh]);
      const float x = da + dtb;
      const float sp = x > 20.f ? x : __logf(1.f + __expf(x));
      float G = -aexp * sp;
#pragma unroll
      for (int o = 1; o < 64; o <<= 1) { const float t = __int_as_float(__builtin_amdgcn_ds_bpermute((lane - o) << 2, __float_as_int(G))); if (lane >= o) G += t; }
      Gs[lane] = G; Bt[lane] = 1.f / (1.f + __expf(-db));
    }
    {
      const int c = tid >> 2, sg = tid & 3;
      const int tok = tokof(cid, step, c);
      const int pos = tok - cid.base;
      const bool hp = pos > 0, hn_ = pos < cid.T - 1;
#pragma unroll 1
      for (int wh = 0; wh < 3; ++wh) {
        const int ch0 = wh * 512 + hh * 64 + sg * 16;
        const u16* cur = p.proj + (size_t)tok * ODN + 768 + ch0;
        float y[16];
        float ss = 0.f;
#pragma unroll
        for (int hf = 0; hf < 2; ++hf) {
          const bf16x8 xc = *(const bf16x8*)(cur + hf * 8);
          bf16x8 xp, xn;
#pragma unroll
          for (int e = 0; e < 8; ++e) { xp[e] = 0; xn[e] = 0; }
          if (hp) xp = *(const bf16x8*)(cur - ODN + hf * 8);
          if (hn_) xn = *(const bf16x8*)(cur + ODN + hf * 8);
#pragma unroll
          for (int e = 0; e < 8; ++e) {
            const int ch = wh * 64 + sg * 16 + hf * 8 + e;
            float v = bf2f(CW[ch]) * bf2f((u16)xp[e]) + bf2f(CW[192 + ch]) * bf2f((u16)xc[e]) + bf2f(CW[384 + ch]) * bf2f((u16)xn[e]);
            v = v / (1.f + __expf(-v));
            y[hf * 8 + e] = v; ss += v * v;
          }
        }
        ss += shx(ss, lane, 1); ss += shx(ss, lane, 2);
        const float rn = rsqrtf(ss + 1e-6f);
        if (wh == 0) {
#pragma unroll
          for (int e = 0; e < 16; ++e) Qn[c * 72 + sg * 16 + e] = f2bf(y[e] * rn * 0.125f);
        } else if (wh == 1) {
#pragma unroll
          for (int e = 0; e < 16; ++e) { const u16 kb = f2bf(y[e] * rn); Kn[c * 72 + sg * 16 + e] = kb; Kt[(sg * 16 + e) * 72 + c] = kb; }
        } else {
#pragma unroll
          for (int e = 0; e < 16; ++e) Wv[c * 65 + sg * 16 + e] = y[e];
        }
      }
    }
    }
    __syncthreads();
    {const int tid = opq(tid0), lane = tid & 63, wave = __builtin_amdgcn_readfirstlane(tid >> 6), r = lane & 31, h = lane >> 5, vh = wave & 1; (void)r; (void)h; (void)vh; (void)lane;
    if (wave < 2) {
      f32x16 akk[2], aqk[2]; zero16(akk[0]); zero16(akk[1]); zero16(aqk[0]); zero16(aqk[1]);
#pragma unroll
      for (int ks = 0; ks < 4; ++ks) {
        const bf16x8 bk = *(const bf16x8*)(Kn + (vh * 32 + r) * 72 + ks * 16 + 8 * h);
#pragma unroll
        for (int ct = 0; ct < 2; ++ct) {
          const bf16x8 ak = *(const bf16x8*)(Kn + (ct * 32 + r) * 72 + ks * 16 + 8 * h);
          const bf16x8 aq = *(const bf16x8*)(Qn + (ct * 32 + r) * 72 + ks * 16 + 8 * h);
          akk[ct] = MFMA(ak, bk, akk[ct]);
          aqk[ct] = MFMA(aq, bk, aqk[ct]);
        }
      }
      const int s = vh * 32 + r;
      const float Gss = Gs[s];
#pragma unroll
      for (int ct = 0; ct < 2; ++ct)
#pragma unroll
        for (int g4 = 0; g4 < 4; ++g4) {
          const int c0 = ct * 32 + 8 * g4 + 4 * h;
          const float4 gv4 = *(const float4*)(Gs + c0), bv4 = *(const float4*)(Bt + c0);
          float4 val;
#pragma unroll
          for (int e = 0; e < 4; ++e) {
            const int c = c0 + e;
            const float Gc = e == 0 ? gv4.x : e == 1 ? gv4.y : e == 2 ? gv4.z : gv4.w;
            const float Bc = e == 0 ? bv4.x : e == 1 ? bv4.y : e == 2 ? bv4.z : bv4.w;
            const float gam = __expf(fminf(Gc - Gss, 0.f));
            const float av = (s < c) ? akk[ct][4 * g4 + e] * Bc * gam : 0.f;
            if (e == 0) val.x = av; else if (e == 1) val.y = av; else if (e == 2) val.z = av; else val.w = av;
            AQK[c * 72 + s] = f2bf((s <= c) ? aqk[ct][4 * g4 + e] * gam : 0.f);
          }
          *(float4*)(At + s * 68 + c0) = val;
        }
    }
    }
    __syncthreads();
    {const int tid = opq(tid0), lane = tid & 63, wave = __builtin_amdgcn_readfirstlane(tid >> 6), r = lane & 31, h = lane >> 5, vh = wave & 1; (void)r; (void)h; (void)vh; (void)lane;
    if (wave < 2) {
      const bool isv = wave == 0;
      const int col = lane;
#pragma unroll 1
      for (int bi = 0; bi < 4; ++bi) {
        float acc[16];
#pragma unroll
        for (int ci = 0; ci < 16; ++ci) {
          const int c = 16 * bi + ci;
          acc[ci] = isv ? Wv[c * 65 + col] * Bt[c] : bf2f(Kn[c * 72 + col]) * Bt[c] * __expf(Gs[c]);
        }
#pragma unroll 8
        for (int s2 = 0; s2 < 16 * bi; ++s2) {
          const float xs = isv ? Wv[s2 * 65 + col] : bf2f(KC[s2 * 72 + col]);
          const float4* a4 = (const float4*)(At + s2 * 68 + 16 * bi);
#pragma unroll
          for (int q = 0; q < 4; ++q) {
            const float4 a = a4[q];
            acc[4 * q] -= a.x * xs; acc[4 * q + 1] -= a.y * xs; acc[4 * q + 2] -= a.z * xs; acc[4 * q + 3] -= a.w * xs;
          }
        }
#pragma unroll
        for (int ci = 0; ci < 16; ++ci) {
          const float x = acc[ci];
          const float* arow = At + (16 * bi + ci) * 68 + 16 * bi;
#pragma unroll
          for (int cj = ci + 1; cj < 16; ++cj) acc[cj] -= arow[cj] * x;
          if (isv) Wv[(16 * bi + ci) * 65 + col] = x; else KC[(16 * bi + ci) * 72 + col] = f2bf(x);
        }
      }
    }
    }
    __syncthreads();
    }
    if (ROLE == 1) { copy_out(smem, slots + (size_t)(step_ % RING) * SLOT_BYTES, IMG, tid0); publish(ready + step_, 1, tid0); continue; }
    {const int tid = opq(tid0), lane = tid & 63, wave = __builtin_amdgcn_readfirstlane(tid >> 6), r = lane & 31, h = lane >> 5, vh = wave & 1; (void)r; (void)h; (void)vh; (void)lane;
    if (wave < 2) {
      f32x16 kS[2], qS[2]; zero16(kS[0]); zero16(kS[1]); zero16(qS[0]); zero16(qS[1]);
#pragma unroll
      for (int dt = 0; dt < 2; ++dt) {
        const bf16x8 xs0 = packs<0>(S[dt]), xs1 = packs<1>(S[dt]);
#pragma unroll
        for (int ct = 0; ct < 2; ++ct) {
          kS[ct] = MFMA(ld2x4(KC + (ct * 32 + r) * 72 + dt * 32 + 4 * h), xs0, kS[ct]);
          kS[ct] = MFMA(ld2x4(KC + (ct * 32 + r) * 72 + dt * 32 + 16 + 4 * h), xs1, kS[ct]);
          qS[ct] = MFMA(ld2x4(Qn + (ct * 32 + r) * 72 + dt * 32 + 4 * h), xs0, qS[ct]);
          qS[ct] = MFMA(ld2x4(Qn + (ct * 32 + r) * 72 + dt * 32 + 16 + 4 * h), xs1, qS[ct]);
        }
      }
      f32x16 vn[2], o[2];
      const float Glast = Gs[63];
#pragma unroll
      for (int ct = 0; ct < 2; ++ct)
#pragma unroll
        for (int i = 0; i < 16; ++i) {
          const int c = ct * 32 + crow(i, h);
          vn[ct][i] = Wv[c * 65 + vh * 32 + r] - kS[ct][i];
          o[ct][i] = qS[ct][i] * __expf(Gs[c]);
        }
#pragma unroll
      for (int st = 0; st < 2; ++st) {
        const bf16x8 xs0 = packs<0>(vn[st]), xs1 = packs<1>(vn[st]);
#pragma unroll
        for (int ct = 0; ct < 2; ++ct) {
          o[ct] = MFMA(ld2x4(AQK + (ct * 32 + r) * 72 + st * 32 + 4 * h), xs0, o[ct]);
          o[ct] = MFMA(ld2x4(AQK + (ct * 32 + r) * 72 + st * 32 + 16 + 4 * h), xs1, o[ct]);
        }
      }
      const float dl = __expf(Glast);
#pragma unroll
      for (int st = 0; st < 2; ++st) {
        asm volatile("" ::: "memory");
#pragma unroll
        for (int i = 0; i < 16; ++i) vn[st][i] *= __expf(Glast - Gs[st * 32 + crow(i, h)]);
      }
      asm volatile("" ::: "memory");
#pragma unroll
      for (int dt = 0; dt < 2; ++dt)
#pragma unroll
        for (int i = 0; i < 16; ++i) S[dt][i] *= dl;
#pragma unroll
      for (int st = 0; st < 2; ++st) {
        const bf16x8 xs0 = packs<0>(vn[st]), xs1 = packs<1>(vn[st]);
#pragma unroll
        for (int dt = 0; dt < 2; ++dt) {
          S[dt] = MFMA(ld2x4(Kt + (dt * 32 + r) * 72 + st * 32 + 4 * h), xs0, S[dt]);
          S[dt] = MFMA(ld2x4(Kt + (dt * 32 + r) * 72 + st * 32 + 16 + 4 * h), xs1, S[dt]);
        }
      }
#pragma unroll
      for (int ct = 0; ct < 2; ++ct)
#pragma unroll
        for (int i = 0; i < 16; ++i) At[(ct * 32 + crow(i, h)) * 68 + vh * 32 + r] = o[ct][i];
    }
    }
    __syncthreads();
    {
      const int tid = opq(tid0);
      const int c = tid >> 2, sg = tid & 3;
      const int tok = tokof(cid, step, c);
      u16* dst = (dir ? p.ot1 + (size_t)tok * 512 + hh * 64 : p.hn + (size_t)tok * 1024 + 512 + hh * 64) + sg * 16;
      bf16x8 w0, w1;
#pragma unroll
      for (int e = 0; e < 8; ++e) { w0[e] = (short)f2bf(At[c * 68 + sg * 16 + e]); w1[e] = (short)f2bf(At[c * 68 + sg * 16 + 8 + e]); }
      *(bf16x8*)dst = w0; *(bf16x8*)(dst + 8) = w1;
    }
  }
  {const int tid = opq(tid0), lane = tid & 63, wave = __builtin_amdgcn_readfirstlane(tid >> 6), r = lane & 31, h = lane >> 5, vh = wave & 1; (void)r; (void)h; (void)vh; (void)lane;
  if (wave < 2 && !cid.lat) {
#pragma unroll
    for (int dt = 0; dt < 2; ++dt)
#pragma unroll
      for (int i = 0; i < 16; ++i) p.out[OFF_SD + sidx + (dt * 32 + crow(i, h)) * 64 + vh * 32 + r] = S[dt][i];
  }
}
}

DI void mixer_phase(const P* __restrict__ gp, int l, char* smem, int fs = 0) {
  const P& p = *gp;
  const bool even = !(l & 1); const int jj = l >> 1;
  const bool teams = gridDim.x >= 512;
  if (teams) {
    const int bid = blockIdx.x;
    const int K = 3;
    if (bid < 128 * (K + 1)) {
      if (bid < 128) { if (even) gla_chain<2>(gp, jj, bid, smem, 0, 1, fs); else delta_chain<2>(gp, jj, bid, smem, 0, 1, fs); }
      else { const int ch = (bid - 128) & 127, k = (bid - 128) >> 7; if (even) gla_chain<1>(gp, jj, ch, smem, k, K, fs); else delta_chain<1>(gp, jj, ch, smem, k, K, fs); }
    }
  }
  const int first = teams ? 128 : 0;
  const int total = 384 + 2048 + 256;
  int* s_item = (int*)(smem + SMEM_BYTES - 16);
  int* cntp = uni(p.cnt) + l + 4 * fs;
  for (;;) {
    __syncthreads();
    if (opq(threadIdx.x) == 0) *s_item = atomicAdd(cntp, 1) + first;
    __syncthreads();
    const int item = __builtin_amdgcn_readfirstlane(*s_item);
    if (item >= total) break;
    if (item < 384) { if (even) gla_chain<0>(gp, jj, item, smem, 0, 1); else delta_chain<0>(gp, jj, item, smem, 0, 1); }
    else if (item < 384 + 2048) { if (even) attn_item<1>(gp, jj, item - 384, smem); else attn_item<3>(gp, jj, item - 384, smem); }
    else { if (even) attn_item<0>(gp, jj, item - 384 - 2048, smem); else attn_item<2>(gp, jj, item - 384 - 2048, smem); }
  }
}

DI void finalize_phase(const P* __restrict__ gp, int l) {
  const P& p = *gp;
  const bool even = !(l & 1); const int jj = l >> 1;
  int tid_ = threadIdx.x; asm volatile("" : "+v"(tid_)); const int tid = tid_;
  const int tk = tid >> 5, hh = (tid >> 2) & 7, sg = tid & 3;
  const int PS = even ? EVN : ODN; const int zcol = even ? 3104 : 2336;
  for (int item = blockIdx.x; item < NT_ / 8; item += gridDim.x) {
    const size_t tok = (size_t)item * 8 + tk;
    u16* a = p.hn + tok * 1024 + 512 + hh * 64 + sg * 16;
    const u16* bsrc = p.ot1 + tok * 512 + hh * 64 + sg * 16;
    const u16* zs = p.proj + tok * PS + zcol + hh * 64 + sg * 16;
    float o[16]; float ss = 0.f;
#pragma unroll
    for (int hf = 0; hf < 2; ++hf) {
      const bf16x8 x0 = *(const bf16x8*)(a + hf * 8), x1 = *(const bf16x8*)(bsrc + hf * 8);
#pragma unroll
      for (int e = 0; e < 8; ++e) { const float v = bf2f((u16)x0[e]) + bf2f((u16)x1[e]); o[hf * 8 + e] = v; ss += v * v; }
    }
    ss += shx(ss, tid & 63, 1); ss += shx(ss, tid & 63, 2);
    const float rstd = rsqrtf(ss * (1.f / 64.f) + 1e-6f);
    const float* ng = even ? p.b_norm_g + jj * 512 + hh * 64 + sg * 16 : p.d_norm_g + jj * 64 + sg * 16;
#pragma unroll
    for (int hf = 0; hf < 2; ++hf) {
      const bf16x8 z = *(const bf16x8*)(zs + hf * 8);
      bf16x8 w;
#pragma unroll
      for (int e = 0; e < 8; ++e) { const float zz = bf2f((u16)z[e]); w[e] = (short)f2bf(o[hf * 8 + e] * rstd * ng[hf * 8 + e] * siluf(zz)); }
      *(bf16x8*)(a + hf * 8) = w;
    }
  }
}


#define XB_TMO      128
#define XB_XCNT(j)  (256  + 64 * (j))
#define XB_XSUB(j)  (1280 + 64 * (j))
#define XB_XGEN(j)  (2304 + 64 * (j))
#define XB_TOP      3328
#define XB_TOPGEN   3392
#define XCD_BAR_WORDS 3456
#define XB_SPIN_CAP (1u << 18)
#define LAS __attribute__((address_space(3)))
DI unsigned xb_ld(unsigned* q)              { return __hip_atomic_load(q, __ATOMIC_RELAXED, __HIP_MEMORY_SCOPE_AGENT); }
DI unsigned xb_add(unsigned* q, unsigned v) { return __hip_atomic_fetch_add(q, v, __ATOMIC_RELAXED, __HIP_MEMORY_SCOPE_AGENT); }
DI unsigned xb_xcc_id() { return (unsigned)__builtin_amdgcn_s_getreg((3 << 11) | 20) & 0xFu; }
#define XB_SPIN(cond, bar) do { unsigned _sp = 0; while (cond) { __builtin_amdgcn_s_sleep(1); \
    if ((++_sp & 255u) == 0u) { if (xb_ld(&(bar)[XB_TMO])) break; if (_sp > XB_SPIN_CAP) { atomicAdd(&(bar)[XB_TMO], 1u); break; } } } } while (0)
struct XcdBarrier { unsigned* bar; unsigned x; volatile LAS unsigned* st; };
DI XcdBarrier xcd_barrier_post(unsigned* bar, volatile LAS unsigned* st) {
  XcdBarrier b; b.bar = bar; b.x = xb_xcc_id(); b.st = st;
  if (threadIdx.x == 0) (void)xb_add(&bar[XB_XCNT(b.x)], 1u);
  return b;
}
DI void xcd_barrier_complete(unsigned* bar, unsigned x, unsigned& nloc, unsigned& nx) {
  const unsigned G = gridDim.x * gridDim.y * gridDim.z;
  unsigned sum, cnt, mine, sp = 0u;
  for (;;) {
    sum = 0u; cnt = 0u; mine = 0u;
#pragma unroll
    for (unsigned j = 0; j < 16; ++j) { const unsigned c = xb_ld(&bar[XB_XCNT(j)]); sum += c; cnt += (c > 0u) ? 1u : 0u; mine = (j == x) ? c : mine; }
    if (sum == G) break;
    __builtin_amdgcn_s_sleep(1);
    if ((++sp & 255u) == 0u) { if (xb_ld(&bar[XB_TMO])) break; if (sp > XB_SPIN_CAP) { atomicAdd(&bar[XB_TMO], 1u); break; } }
  }
  nloc = mine > 0u ? mine : 1u; nx = cnt > 0u ? cnt : 1u;
}
DI void xcd_barrier(const XcdBarrier& b) {
  asm volatile("s_waitcnt vmcnt(0)" ::: "memory");
  __syncthreads();
  if (threadIdx.x == 0) {
    unsigned* bar = b.bar;
    __builtin_amdgcn_s_waitcnt(0);
    unsigned nloc = b.st[0], nx = b.st[1];
    if (nloc == 0u) { xcd_barrier_complete(bar, b.x, nloc, nx); b.st[0] = nloc; b.st[1] = nx; }
    const unsigned old = xb_add(&bar[XB_XSUB(b.x)], 1u);
    const unsigned gen = old / nloc;
    if (old + 1u == (gen + 1u) * nloc) {
      __builtin_amdgcn_fence(__ATOMIC_RELEASE, "agent");
      asm volatile("s_waitcnt vmcnt(0)" ::: "memory");
      const unsigned og = xb_add(&bar[XB_TOP], 1u);
      const unsigned tg = og / nx;
      if (og + 1u == (tg + 1u) * nx) xb_add(&bar[XB_TOPGEN], 1u);
      else XB_SPIN(xb_ld(&bar[XB_TOPGEN]) == tg, bar);
      __builtin_amdgcn_fence(__ATOMIC_ACQUIRE, "agent");
      xb_add(&bar[XB_XGEN(b.x)], 1u);
      asm volatile("s_waitcnt vmcnt(0)" ::: "memory");
    } else {
      XB_SPIN(xb_ld(&bar[XB_XGEN(b.x)]) == gen, bar);
      __builtin_amdgcn_fence(__ATOMIC_ACQUIRE, "agent");
      asm volatile("s_waitcnt vmcnt(0)" ::: "memory");
    }
  }
  __syncthreads();
}

DI void run_phase(const P* __restrict__ gp, int ph, char* smem) {
  const P& p = *gp;
  if (ph == 0) { prep_phase(gp, smem); return; }
  if (ph == NPH - 1) { norm_phase(gp, 0, 0, false, true); return; }
  const int l = (ph - 1) >> 3, s = (ph - 1) & 7;
  const bool even = !(l & 1);
  const u16* W = uni(p.wt) + (size_t)l * LW;
  const u16* hnp = uni(p.hn); const u16* projp = uni(p.proj);
  switch (s) {
    case 0: norm_phase(gp, l, 0, l == 0, false); break;
    case 1: gemm_phase<EPI_PROJ, 2>(gp, l, smem, hnp, 1024, W + WO_IN, 1024, 1024, 288, even ? 15 : 12, 0); break;
    case 2: mixer_phase(gp, l, smem); break;
    case 3: finalize_phase(gp, l); break;
    case 4: gemm_phase<EPI_RES, 1>(gp, l, smem, hnp, 1024, W + WO_OUT, 1024, 1024, 288, 8, 2); break;
    case 5: norm_phase(gp, l, 1, false, false); break;
    case 6: gemm_phase<EPI_FFN, 2>(gp, l, smem, hnp, 1024, W + WO_UP, 1024, 1024, 296, 22, 0); break;
    case 7: gemm_phase<EPI_RES, 1>(gp, l, smem, projp, 2816, W + WO_DN, 2816, 2816, 288, 8, 5); break;
  }
}

__global__ void __launch_bounds__(256, 2) mk(P p, P* gpmem, int ph0, int ph1) {
  __shared__ __attribute__((aligned(16))) char smem[SMEM_BYTES];
  const P* gp = &p;
  if (ph1 - ph0 > 1) {
    cg::grid_group grid = cg::this_grid();
    volatile LAS unsigned* xst = (volatile LAS unsigned*)(smem + SMEM_BYTES - 32);
    if (threadIdx.x == 0) { xst[0] = 0u; xst[1] = 0u; }
    __syncthreads();
    const XcdBarrier xbar = xcd_barrier_post(p.bar, xst);
    for (int ph = ph0; ph < ph1; ++ph) {
      run_phase(gp, ph, smem);
      if (ph + 1 < ph1) { if (ph == ph0) grid.sync(); else xcd_barrier(xbar); }
    }
  } else {
    run_phase(gp, ph0, smem);
  }
}

extern "C" void kernel_launch(void* const* d_in, const int* in_sizes, int n_in, void* d_out, int out_size, void* d_ws, size_t ws_size,
                              hipStream_t stream) {
  P p{};
  const float** f = (const float**)&p;
  for (int i = 0; i < 31; ++i) f[i] = (const float*)d_in[i];
  p.out = (float*)d_out;
  char* ws = (char*)d_ws;
  size_t off = 0;
  p.hn = (u16*)(ws + off); off += (size_t)NT_ * 1024 * 2;
  p.proj = (u16*)(ws + off); off += (size_t)NT_ * EVN * 2;
  p.ot1 = (u16*)(ws + off); off += (size_t)NT_ * 512 * 2;
  p.wt = (u16*)(ws + off); off += 4 * LW * 2;
  p.mods = (float*)(ws + off); off += 4 * 9 * 6144 * 4;
  p.rope = (float*)(ws + off); off += 64 * 16 * 2 * 4;
  P* gp = (P*)(ws + off); off += 4096;
  p.cnt = (int*)(ws + off); off += 256;
  p.flags = (int*)(ws + off); off += 8 * 8320 * 4;
  off = (off + 255) & ~(size_t)255;
  p.ring = ws + off; off += (size_t)128 * RING * SLOT_BYTES;
  p.bar = (unsigned*)(ws + off); off += XCD_BAR_WORDS * 4;
  static int grid_blocks = 0;
  if (!grid_blocks) {
    int dev = 0, cus = 0, per_cu = 0;
    hipGetDevice(&dev);
    hipDeviceGetAttribute(&cus, hipDeviceAttributeMultiprocessorCount, dev);
    hipOccupancyMaxActiveBlocksPerMultiprocessor(&per_cu, mk, 256, 0);
    if (per_cu < 1) per_cu = 1;
    if (per_cu > 2) per_cu = 2;
    grid_blocks = cus * per_cu;
  }
#if MK_MULTI
  for (int ph = 0; ph < NPH; ++ph) {
    int a = ph, b = ph + 1;
    hipLaunchKernelGGL(mk, dim3(grid_blocks), dim3(256), 0, stream, p, gp, a, b);
  }
#else
  hipMemsetAsync(p.bar, 0, XCD_BAR_WORDS * 4, stream);
  int ph0 = 0, ph1 = NPH;
  void* args[] = {&p, &gp, &ph0, &ph1};
  hipError_t e = hipLaunchCooperativeKernel((void*)mk, dim3(grid_blocks), dim3(256), args, 0, stream);
  if (e != hipSuccess) fprintf(stderr, "cooperative launch failed: %s (grid %d)\n", hipGetErrorString(e), grid_blocks);
#endif
}
```

```cpp
#include <hip/hip_runtime.h>
#include <hip/hip_cooperative_groups.h>
#include <cstdio>
namespace cg = cooperative_groups;

#ifndef MK_MULTI
#define MK_MULTI 0
#endif

#define DI __device__ __forceinline__
#define DN __device__ __noinline__
typedef unsigned short u16;
typedef __attribute__((ext_vector_type(8))) short bf16x8;
typedef __attribute__((ext_vector_type(4))) short s16x4;
typedef __attribute__((ext_vector_type(16))) float f32x16;
#define MFMA(a, b, c) __builtin_amdgcn_mfma_f32_32x32x16_bf16((a), (b), (c), 0, 0, 0)

static constexpr int NP_ = 4096, NT_ = 36864;
static constexpr int EVN = 3616, ODN = 2848;
static constexpr size_t OFF_AK = 37748736, OFF_AV = 41943040, OFF_SB = 46137344, OFF_CK = 48234496, OFF_CV = 49283072, OFF_SD = 50331648;
static constexpr size_t LW = 13631488, WO_UP = 0, WO_DN = 5767168, WO_IN = 8650752, WO_OUT = 12582912;
static constexpr int NPH = 34;
static constexpr int SMEM_BYTES = 80 * 1024;

struct P {
  const float *x_prompt, *x_sample, *cache_a_k, *cache_a_v, *state_b, *cache_c_k, *cache_c_v, *state_d, *c, *c_ctx, *ada_w, *ada_b,
      *norm1_g, *norm2_g, *ffn_up, *ffn_conv, *ffn_down, *ev_w_in, *ev_w_out, *a_rpb, *b_w_g2, *b_b_g, *b_norm_g, *od_w_in, *od_w_out,
      *c_sink, *d_conv, *d_a_log, *d_dt_bias, *d_norm_g, *final_g;
  float* out;
  u16 *hn, *proj, *ot1, *wt;
  float *mods, *rope;
  int* cnt;
  int* flags;
  char* ring;
  unsigned* bar;
};

typedef __attribute__((ext_vector_type(2))) __bf16 bf2_t;
typedef __attribute__((ext_vector_type(2))) float f2_t;
typedef __attribute__((ext_vector_type(4))) unsigned u32x4_t;
DI unsigned pk2(float a, float b) { const f2_t v = {a, b}; return __builtin_bit_cast(unsigned, __builtin_convertvector(v, bf2_t)); }
DI u16 f2bf(float x) { return __builtin_bit_cast(u16, (__bf16)x); }
DI float bf2f(u16 b) { return __uint_as_float(((unsigned)b) << 16); }
DI int crow(int i, int h) { return (i & 3) + 8 * (i >> 2) + 4 * h; }
template <int S> DI bf16x8 packs(const f32x16& x) {
  u32x4_t v;
  v[0] = pk2(x[8 * S], x[8 * S + 1]); v[1] = pk2(x[8 * S + 2], x[8 * S + 3]); v[2] = pk2(x[8 * S + 4], x[8 * S + 5]); v[3] = pk2(x[8 * S + 6], x[8 * S + 7]);
  return __builtin_bit_cast(bf16x8, v);
}
DI bf16x8 ld2x4(const u16* p) {
  s16x4 lo = *(const s16x4*)p, hi = *(const s16x4*)(p + 8);
  return __builtin_shufflevector(lo, hi, 0, 1, 2, 3, 4, 5, 6, 7);
}
DI float siluf(float x) { return x / (1.f + __expf(-x)); }
DI int opq(int x) { asm volatile("" : "+v"(x)); return x; }
DI float shx(float v, int lane, int o) { return __int_as_float(__builtin_amdgcn_ds_bpermute((lane ^ o) << 2, __float_as_int(v))); }
template <class T> DI T* uni(T* q) { return q; }
DI void zero16(f32x16& a) {
#pragma unroll
  for (int i = 0; i < 16; ++i) a[i] = 0.f;
}

DI void prep_phase(const P* __restrict__ gp, char* smem) {
  const P& p = *gp;
  int tid_ = threadIdx.x; asm volatile("" : "+v"(tid_)); const int tid = tid_;
  const int NWT = 4 * (1408 + 704 + 256) + 2 * (960 + 768);
  const int NADA = 384;
  const int total = NWT + NADA + 1;
  for (int item = blockIdx.x; item < total; item += gridDim.x) {
    if (item < NWT) {
      int rem = item; const float* src = nullptr; u16* dst = nullptr; int K = 0, N = 0, NPd = 0;
      for (int l = 0; l < 4; ++l) {
        const int jj = l >> 1; const bool ev = !(l & 1);
        const int nin = ev ? 960 : 768;
        if (rem < 1408) { src = p.ffn_up + (size_t)l * 1024 * 5632; dst = p.wt + l * LW + WO_UP; K = 1024; N = 5632; NPd = 5632; break; }
        rem -= 1408;
        if (rem < 704) { src = p.ffn_down + (size_t)l * 2816 * 1024; dst = p.wt + l * LW + WO_DN; K = 2816; N = 1024; NPd = 1024; break; }
        rem -= 704;
        if (rem < nin) { src = ev ? p.ev_w_in + (size_t)jj * 1024 * EVN : p.od_w_in + (size_t)jj * 1024 * ODN; dst = p.wt + l * LW + WO_IN; K = 1024; N = ev ? EVN : ODN; NPd = ev ? 3840 : 3072; break; }
        rem -= nin;
        if (rem < 256) { src = (ev ? p.ev_w_out : p.od_w_out) + (size_t)jj * 1024 * 1024; dst = p.wt + l * LW + WO_OUT; K = 1024; N = 1024; NPd = 1024; break; }
        rem -= 256;
      }
      const int ntn = NPd >> 6;
      const int tk = rem / ntn, tn = rem - tk * ntn;
      const int scol0 = (N == 5632) ? (((tn >> 1) & 1) * 2816 + (tn >> 2) * 128 + (tn & 1) * 64) : tn * 64;
      float* T = (float*)smem;
      __syncthreads();
#pragma unroll
      for (int i = 0; i < 16; ++i) {
        const int k = i * 4 + (tid >> 6), n = tid & 63;
        const int gn = scol0 + n;
        T[k * 65 + n] = (gn < N) ? src[(size_t)(tk * 64 + k) * N + gn] : 0.f;
      }
      __syncthreads();
#pragma unroll
      for (int i = 0; i < 2; ++i) {
        const int q = tid + 256 * i; const int n = q & 63, kc = q >> 6;
        const int pn = tn * 64 + n; const int nt32 = pn >> 5, rr = pn & 31;
        const int kstep = tk * 4 + (kc >> 1), hh = kc & 1;
        bf16x8 w;
#pragma unroll
        for (int j = 0; j < 8; ++j) w[j] = (short)f2bf(T[(kc * 8 + j) * 65 + n]);
        *(bf16x8*)(dst + ((size_t)(nt32 * (K >> 4) + kstep) * 64 + hh * 32 + rr) * 8) = w;
      }
    } else if (item < NWT + NADA) {
      const int it = item - NWT; const int l = it / 96, cgp = it - l * 96; const int n0 = cgp * 64;
      float* sc = (float*)smem;
      float* red = sc + 9 * 1024;
      __syncthreads();
      for (int idx = tid; idx < 9 * 1024; idx += 256) {
        const int ci = idx >> 10, k = idx & 1023;
        const float x = ci < 8 ? p.c[ci * 1024 + k] : p.c_ctx[k];
        sc[idx] = x / (1.f + expf(-x));
      }
      __syncthreads();
      const int wave = tid >> 6, lane = tid & 63;
      float acc[9];
#pragma unroll
      for (int ci = 0; ci < 9; ++ci) acc[ci] = 0.f;
      const float* wp = p.ada_w + ((size_t)l * 1024 + wave * 256) * 6144 + n0 + lane;
#pragma unroll 8
      for (int k = 0; k < 256; ++k) {
        const float wv = wp[(size_t)k * 6144];
#pragma unroll
        for (int ci = 0; ci < 9; ++ci) acc[ci] += sc[ci * 1024 + wave * 256 + k] * wv;
      }
#pragma unroll
      for (int ci = 0; ci < 9; ++ci) red[(wave * 9 + ci) * 64 + lane] = acc[ci];
      __syncthreads();
      for (int idx = tid; idx < 576; idx += 256) {
        const int ci = idx >> 6, col = idx & 63;
        const float s = red[(0 * 9 + ci) * 64 + col] + red[(1 * 9 + ci) * 64 + col] + red[(2 * 9 + ci) * 64 + col] + red[(3 * 9 + ci) * 64 + col];
        p.mods[(size_t)(l * 9 + ci) * 6144 + n0 + col] = s + p.ada_b[l * 6144 + n0 + col];
      }
    } else {
      if (tid < 8) p.cnt[tid] = 0;
      for (int i = tid; i < 8 * 8320; i += 256) p.flags[i] = 0;
      for (int idx = tid; idx < 1024; idx += 256) {
        const int pos = idx >> 4, fi = idx & 15;
        const float inv = powf(10000.f, -(float)fi / 16.f);
        const float ang = (float)pos * inv;
        p.rope[idx * 2] = cosf(ang); p.rope[idx * 2 + 1] = sinf(ang);
      }
    }
  }
}

DI void norm_phase(const P* __restrict__ gp, int l, int which, bool first, bool fin) {
  const P& p = *gp;
  int tid_ = threadIdx.x; asm volatile("" : "+v"(tid_)); const int tid = tid_, lane = tid & 63, wave = tid >> 6;
  for (int item = blockIdx.x; item < NT_ / 8; item += gridDim.x) {
    float4 v[2][4];
    float ss[2];
#pragma unroll
    for (int u = 0; u < 2; ++u) {
      const int tok = item * 8 + u * 4 + wave;
      const float* src = first ? (tok < NP_ ? p.x_prompt + (size_t)tok * 1024 : p.x_sample + (size_t)(tok - NP_) * 1024) : p.out + (size_t)tok * 1024;
#pragma unroll
      for (int i = 0; i < 4; ++i) v[u][i] = ((const float4*)src)[lane + 64 * i];
    }
#pragma unroll
    for (int u = 0; u < 2; ++u) {
      float a = 0.f;
#pragma unroll
      for (int i = 0; i < 4; ++i) a += v[u][i].x * v[u][i].x + v[u][i].y * v[u][i].y + v[u][i].z * v[u][i].z + v[u][i].w * v[u][i].w;
#pragma unroll
      for (int o = 32; o >= 1; o >>= 1) a += shx(a, lane, o);
      ss[u] = a;
    }
#pragma unroll
    for (int u = 0; u < 2; ++u) {
      const int tok = item * 8 + u * 4 + wave;
      const float rstd = rsqrtf(ss[u] * (1.f / 1024.f) + 1e-6f);
      if (fin) {
#pragma unroll
        for (int i = 0; i < 4; ++i) {
          const float4 g = ((const float4*)p.final_g)[lane + 64 * i];
          float4 y; y.x = v[u][i].x * rstd * g.x; y.y = v[u][i].y * rstd * g.y; y.z = v[u][i].z * rstd * g.z; y.w = v[u][i].w * rstd * g.w;
          ((float4*)(p.out + (size_t)tok * 1024))[lane + 64 * i] = y;
        }
      } else {
        const int ci = tok < NP_ ? 8 : (tok - NP_) >> 12;
        const float* md = p.mods + (size_t)(l * 9 + ci) * 6144 + which * 3072;
        const float* gpp = (which ? p.norm2_g : p.norm1_g) + l * 1024;
#pragma unroll
        for (int i = 0; i < 4; ++i) {
          const float4 g = ((const float4*)gpp)[lane + 64 * i];
          const float4 sh = ((const float4*)md)[lane + 64 * i];
          const float4 sc = ((const float4*)(md + 1024))[lane + 64 * i];
          ushort4 o;
          o.x = f2bf(v[u][i].x * rstd * g.x * (1.f + sc.x) + sh.x);
          o.y = f2bf(v[u][i].y * rstd * g.y * (1.f + sc.y) + sh.y);
          o.z = f2bf(v[u][i].z * rstd * g.z * (1.f + sc.z) + sh.z);
          o.w = f2bf(v[u][i].w * rstd * g.w * (1.f + sc.w) + sh.w);
          ((ushort4*)(p.hn + (size_t)tok * 1024))[lane + 64 * i] = o;
          if (first) ((float4*)(p.out + (size_t)tok * 1024))[lane + 64 * i] = v[u][i];
        }
      }
    }
  }
}

DI uint4 ldsel(const u16* pv, const u16* safe, unsigned ok) {
  uint4 t = *(const uint4*)(ok ? pv : safe);
  if (!ok) { t.x = 0; t.y = 0; t.z = 0; t.w = 0; }
  return t;
}
enum { EPI_PROJ = 0, EPI_RES = 1, EPI_FFN = 2 };

template <int EPI, int WN>
DI void gemm_phase(const P* __restrict__ gp, int l, char* smem, const u16* __restrict__ A, int lda, const u16* __restrict__ B, int ldb, int K, int MT,
                   int NTn, int gsel) {
  const P& p = *gp;
  u16* As = (u16*)smem;
  int tid_ = threadIdx.x; asm volatile("" : "+v"(tid_)); const int tid = tid_, lane = tid & 63, wave = tid >> 6, r = lane & 31, h = lane >> 5;
  const int KT = K >> 6;
  const bool even = !(l & 1); const int jj = l >> 1;
  const int ntiles = MT * NTn;
  const int nlb = gridDim.x >> 3, xcd = blockIdx.x & 7, lb = blockIdx.x >> 3;
  for (int it = 0;; ++it) {
    const int g = (it * 8 + xcd) * nlb + lb;
    if (g >= ntiles) break;
    const int SM = nlb >> 3;
    const int band = g / (SM * NTn); const int rem = g - band * SM * NTn;
    const int nt = rem / SM, mt = band * SM + (rem - nt * SM);
    int seqbase = 0, L = 0, tin0 = 0;
    if (EPI == EPI_FFN) {
      L = NT_; seqbase = 0; tin0 = mt * 126;
      if (tin0 >= NT_) continue;
    }
    const int row0 = tid >> 3, kc0 = (tid & 7) * 8;
    const long arow0 = (EPI == EPI_FFN) ? (long)seqbase + tin0 - 1 + row0 : (long)mt * 128 + row0;
    const u16* abase = A + arow0 * lda + kc0;
    unsigned avalid = 0;
#pragma unroll
    for (int i = 0; i < 4; ++i) {
      if (EPI == EPI_FFN) { const int ts = tin0 - 1 + row0 + 32 * i; if (ts >= 0 && ts < L) avalid |= 1u << i; }
      else avalid |= 1u << i;
    }
    const u16* bb0 = B + ((size_t)((nt * 4 + wave) * WN * (K >> 4)) * 64 + lane) * 8;
    const size_t bts = (size_t)(K >> 4) * 512;
    f32x16 acc[4][WN];
#pragma unroll
    for (int a = 0; a < 4; ++a)
#pragma unroll
      for (int b = 0; b < WN; ++b) zero16(acc[a][b]);
#define GLD_A(i, ko) ldsel(abase + (size_t)(32 * (i)) * lda + (ko), A, (avalid >> (i)) & 1u)
#define GLD_BF(dst, kt_) { const u16* q_ = bb0 + (size_t)(kt_) * 2048; \
      _Pragma("unroll") for (int ni_ = 0; ni_ < WN; ++ni_) { \
        dst[ni_][0] = *(const bf16x8*)(q_ + ni_ * bts); dst[ni_][1] = *(const bf16x8*)(q_ + ni_ * bts + 512); \
        dst[ni_][2] = *(const bf16x8*)(q_ + ni_ * bts + 1024); dst[ni_][3] = *(const bf16x8*)(q_ + ni_ * bts + 1536); } }
    uint4 ra0 = GLD_A(0, 0), ra1 = GLD_A(1, 0), ra2 = GLD_A(2, 0), ra3 = GLD_A(3, 0);
    uint4 sa0, sa1, sa2, sa3;
    if (WN == 1) { sa0 = GLD_A(0, 64); sa1 = GLD_A(1, 64); sa2 = GLD_A(2, 64); sa3 = GLD_A(3, 64); }
    bf16x8 bc[WN][4], bn[WN][4];
    GLD_BF(bc, 0);
    if (WN == 1) GLD_BF(bn, 1);
#define LSTORE(buf, A0, A1, A2, A3) { \
      u16* ad = As + (buf) * 9216 + row0 * 72 + kc0; \
      *(uint4*)(ad) = A0; *(uint4*)(ad + 32 * 72) = A1; *(uint4*)(ad + 64 * 72) = A2; *(uint4*)(ad + 96 * 72) = A3; }
#define COMPUTE(buf, BF, KN) { \
      const u16* Ab = As + (buf) * 9216 + r * 72 + h * 8; \
      const bool more_ = (KN) < KT; const u16* q_ = bb0 + (size_t)(KN) * 2048; \
      _Pragma("unroll") for (int ks = 0; ks < 4; ++ks) { \
        const bf16x8 a0 = *(const bf16x8*)(Ab + ks * 16); \
        const bf16x8 a1 = *(const bf16x8*)(Ab + 32 * 72 + ks * 16); \
        const bf16x8 a2 = *(const bf16x8*)(Ab + 64 * 72 + ks * 16); \
        const bf16x8 a3 = *(const bf16x8*)(Ab + 96 * 72 + ks * 16); \
        _Pragma("unroll") for (int ni_ = 0; ni_ < WN; ++ni_) { \
          acc[0][ni_] = MFMA(a0, BF[ni_][ks], acc[0][ni_]); acc[1][ni_] = MFMA(a1, BF[ni_][ks], acc[1][ni_]); \
          acc[2][ni_] = MFMA(a2, BF[ni_][ks], acc[2][ni_]); acc[3][ni_] = MFMA(a3, BF[ni_][ks], acc[3][ni_]); } \
        if (more_) { _Pragma("unroll") for (int ni_ = 0; ni_ < WN; ++ni_) BF[ni_][ks] = *(const bf16x8*)(q_ + ni_ * bts + ks * 512); } } }
    if (WN == 1) {
    LSTORE(0, ra0, ra1, ra2, ra3);
    ra0 = GLD_A(0, 128); ra1 = GLD_A(1, 128); ra2 = GLD_A(2, 128); ra3 = GLD_A(3, 128);
    __syncthreads();
    for (int kt = 0; kt < KT; kt += 2) {
      COMPUTE(0, bc, kt + 2);
      LSTORE(1, sa0, sa1, sa2, sa3);
      if (kt + 3 < KT) {
        const int ko = (kt + 3) * 64;
        sa0 = GLD_A(0, ko); sa1 = GLD_A(1, ko); sa2 = GLD_A(2, ko); sa3 = GLD_A(3, ko);
      }
      __syncthreads();
      COMPUTE(1, bn, kt + 3);
      if (kt + 2 < KT) {
        LSTORE(0, ra0, ra1, ra2, ra3);
        if (kt + 4 < KT) {
          const int ko = (kt + 4) * 64;
          ra0 = GLD_A(0, ko); ra1 = GLD_A(1, ko); ra2 = GLD_A(2, ko); ra3 = GLD_A(3, ko);
        }
      }
      __syncthreads();
    }
    } else {
      LSTORE(0, ra0, ra1, ra2, ra3);
      ra0 = GLD_A(0, 64); ra1 = GLD_A(1, 64); ra2 = GLD_A(2, 64); ra3 = GLD_A(3, 64);
      __syncthreads();
      for (int kt = 0; kt < KT; kt += 2) {
        COMPUTE(0, bc, kt + 1);
        LSTORE(1, ra0, ra1, ra2, ra3);
        if (kt + 2 < KT) { const int ko = (kt + 2) * 64; ra0 = GLD_A(0, ko); ra1 = GLD_A(1, ko); ra2 = GLD_A(2, ko); ra3 = GLD_A(3, ko); }
        __syncthreads();
        COMPUTE(1, bc, kt + 2);
        if (kt + 2 < KT) {
          LSTORE(0, ra0, ra1, ra2, ra3);
          if (kt + 3 < KT) { const int ko = (kt + 3) * 64; ra0 = GLD_A(0, ko); ra1 = GLD_A(1, ko); ra2 = GLD_A(2, ko); ra3 = GLD_A(3, ko); }
        }
        __syncthreads();
      }
    }
    if (EPI == EPI_PROJ) {
      const int N = even ? EVN : ODN;
#pragma unroll
      for (int tm = 0; tm < 4; ++tm)
#pragma unroll
        for (int tn = 0; tn < WN; ++tn) {
          const int col = nt * (128 * WN) + wave * (32 * WN) + tn * 32 + r;
          if (col < N) {
#pragma unroll
            for (int i = 0; i < 16; ++i) {
              const int row = mt * 128 + tm * 32 + crow(i, h);
              const float v = acc[tm][tn][i];
              p.proj[(size_t)row * N + col] = f2bf(v);
              if (row < NP_) {
                const int b = row >> 8, t = row & 255, d = col & 63;
                if (even) {
                  if (col >= 512 && col < 1536) {
                    const int wh = (col - 512) >> 9, hh = ((col - 512) >> 6) & 7;
                    p.out[(wh ? OFF_AV : OFF_AK) + ((size_t)(((b * 2 + jj) * 8 + hh) * 256 + t)) * 64 + d] = v;
                  }
                } else {
                  if (col >= 512 && col < 768) {
                    const int wh = (col - 512) >> 7, kv = ((col - 512) >> 6) & 1;
                    p.out[(wh ? OFF_CV : OFF_CK) + ((size_t)(((b * 2 + jj) * 2 + kv) * 256 + t)) * 64 + d] = v;
                  }
                }
              }
            }
          }
        }
    } else if (EPI == EPI_RES) {
#pragma unroll
      for (int tm = 0; tm < 4; ++tm)
#pragma unroll
        for (int tn = 0; tn < WN; ++tn) {
          const int col = nt * (128 * WN) + wave * (32 * WN) + tn * 32 + r;
#pragma unroll
          for (int i = 0; i < 16; ++i) {
            const int row = mt * 128 + tm * 32 + crow(i, h);
            const int ci = row < NP_ ? 8 : (row - NP_) >> 12;
            const float g = p.mods[(size_t)(l * 9 + ci) * 6144 + gsel * 1024 + col];
            float* xp = p.out + (size_t)row * 1024 + col;
            *xp = *xp + g * acc[tm][tn][i];
          }
        }
    } else {
      float* U = (float*)smem;
      const float* cw = p.ffn_conv + (size_t)l * 3 * 5632;
      u16* act = p.proj;
#pragma unroll
      for (int ps = 0; ps < WN; ++ps) {
        __syncthreads();
        if (WN == 1) {
#pragma unroll
          for (int tm = 0; tm < 4; ++tm)
#pragma unroll
            for (int i = 0; i < 16; ++i) U[(tm * 32 + crow(i, h)) * 132 + wave * 32 + r] = acc[tm][0][i];
        } else if ((wave & 1) == ps) {
#pragma unroll
          for (int tm = 0; tm < 4; ++tm)
#pragma unroll
            for (int tn = 0; tn < WN; ++tn)
#pragma unroll
              for (int i = 0; i < 16; ++i) U[(tm * 32 + crow(i, h)) * 132 + (wave >> 1) * 64 + tn * 32 + r] = acc[tm][tn][i];
        }
        __syncthreads();
        const int f = tid & 63, rg = tid >> 6; const int fg = nt * (64 * WN) + ps * 64 + f;
        const float wa0 = cw[fg], wa1 = cw[5632 + fg], wa2 = cw[2 * 5632 + fg];
        const float wg0 = cw[2816 + fg], wg1 = cw[5632 + 2816 + fg], wg2 = cw[2 * 5632 + 2816 + fg];
        const int rbeg = 1 + 32 * rg, rend = rg == 3 ? 126 : 32 * rg + 32;
        float ap = U[(rbeg - 1) * 132 + f], ac = U[rbeg * 132 + f];
        float gp_ = U[(rbeg - 1) * 132 + 64 + f], gc = U[rbeg * 132 + 64 + f];
        for (int rr = rbeg; rr <= rend; ++rr) {
          const int ts = tin0 - 1 + rr;
          if (ts >= L) break;
          const float an = U[(rr + 1) * 132 + f], gn = U[(rr + 1) * 132 + 64 + f];
          const bool sst = ts < NP_ ? ((ts & 255) == 0) : ((ts & 4095) == 0), sen = ts < NP_ ? ((ts & 255) == 255) : ((ts & 4095) == 4095);
          const float a = (sst ? 0.f : wa0 * ap) + wa1 * ac + (sen ? 0.f : wa2 * an);
          const float g = (sst ? 0.f : wg0 * gp_) + wg1 * gc + (sen ? 0.f : wg2 * gn);
          act[(size_t)(seqbase + ts) * 2816 + fg] = f2bf(a * siluf(g));
          ap = ac; ac = an; gp_ = gc; gc = gn;
        }
      }
      __syncthreads();
    }
  }
}

template <int MODE>
DI void attn_item(const P* __restrict__ gp, int jj, int it, char* smem) {
  const P& p = *gp;
  const u16* projp = uni(p.proj); u16* hnp = uni(p.hn); const float* ropep = uni(p.rope);
  u16* Ks = (u16*)smem; u16* Vt = Ks + 64 * 72; float* rpb_s = (float*)(Vt + 64 * 72);
  int tid_ = threadIdx.x; asm volatile("" : "+v"(tid_)); const int tid = tid_, lane = tid & 63, wave = tid >> 6, r = lane & 31, h = lane >> 5;
  constexpr bool EVENL = (MODE == 0 || MODE == 1);
  constexpr bool LAT = (MODE == 1 || MODE == 3);
  constexpr int PS = EVENL ? EVN : ODN;
  int b, hq, qb, tokbase;
  if (!LAT) { b = it >> 4; hq = (it >> 1) & 7; qb = it & 1; tokbase = b * 256; }
  else { b = it >> 8; hq = (it >> 5) & 7; qb = it & 31; tokbase = NP_ + b * 4096; }
  const int hk = EVENL ? hq : (hq >> 2);
  const int kcol = 512 + hk * 64, vcol = (EVENL ? 1024 : 640) + hk * 64, qcol = hq * 64;
  const int tq = qb * 128 + wave * 32 + r;
  const size_t qtok = (size_t)tokbase + tq;
  __syncthreads();
  if (MODE == 1) { for (int i = tid; i < 465; i += 256) rpb_s[i] = p.a_rpb[(size_t)(jj * 8 + hq) * 465 + i]; }
  bf16x8 qf[4];
#pragma unroll
  for (int s = 0; s < 4; ++s) qf[s] = *(const bf16x8*)(projp + qtok * PS + qcol + 16 * s + 8 * h);
  if (MODE == 3) {
    const int prow = tq >> 6, pcol = tq & 63;
#pragma unroll
    for (int half = 0; half < 2; ++half) {
      const int pos = half ? pcol : prow;
#pragma unroll
      for (int j = 0; j < 8; ++j) {
        const float cs = ropep[(pos * 16 + 8 * h + j) * 2], sn = ropep[(pos * 16 + 8 * h + j) * 2 + 1];
        const float x1 = bf2f((u16)qf[2 * half][j]), x2 = bf2f((u16)qf[2 * half + 1][j]);
        qf[2 * half][j] = (short)f2bf(x1 * cs - x2 * sn);
        qf[2 * half + 1][j] = (short)f2bf(x1 * sn + x2 * cs);
      }
    }
  }
  float m_run = -1e30f, l_run = 0.f;
  if (MODE == 2 || MODE == 3) { m_run = p.c_sink[jj * 8 + hq]; l_run = h == 0 ? 1.f : 0.f; }
  f32x16 ot[2]; zero16(ot[0]); zero16(ot[1]);
  int loc0 = 0, nloc = 0;
  if (MODE == 1) {
    const int qi0 = 2 * qb;
    const int rlo = min(max(qi0 - 4, 0), 56), rhi = min(max(qi0 + 1 - 4, 0), 56) + 7;
    loc0 = rlo; nloc = rhi - rlo + 1;
  } else if (MODE == 3) {
    loc0 = max(0, 2 * qb - 2); nloc = min(63, 2 * qb + 3) - loc0 + 1;
  }
  const int qi = tq >> 6, qw = tq & 63;
  const int r0w = min(max(qi - 4, 0), 56), c0w = min(max(qw - 8, 0), 48);
  const int key = tid >> 2, seg = tid & 3;
  for (int kb = 0; kb < 4 + nloc; ++kb) {
    const bool isctx = kb < 4;
    const int blk = isctx ? kb : loc0 + kb - 4;
    __syncthreads();
    {
      float kf[16], vf[16];
      if (LAT && isctx) {
        const float* kc = (MODE == 1) ? p.cache_a_k + ((size_t)((b * 2 + jj) * 8 + hk)) * 16384 : p.cache_c_k + ((size_t)((b * 2 + jj) * 2 + hk)) * 16384;
        const float* vc = (MODE == 1) ? p.cache_a_v + ((size_t)((b * 2 + jj) * 8 + hk)) * 16384 : p.cache_c_v + ((size_t)((b * 2 + jj) * 2 + hk)) * 16384;
        const float4* kp4 = (const float4*)(kc + (size_t)(blk * 64 + key) * 64 + seg * 16);
        const float4* vp4 = (const float4*)(vc + (size_t)(blk * 64 + key) * 64 + seg * 16);
#pragma unroll
        for (int e = 0; e < 4; ++e) {
          const float4 a = kp4[e], c = vp4[e];
          kf[4 * e] = a.x; kf[4 * e + 1] = a.y; kf[4 * e + 2] = a.z; kf[4 * e + 3] = a.w;
          vf[4 * e] = c.x; vf[4 * e + 1] = c.y; vf[4 * e + 2] = c.z; vf[4 * e + 3] = c.w;
        }
      } else {
        const u16* rowp = projp + ((size_t)tokbase + blk * 64 + key) * PS;
        const bf16x8 k0 = *(const bf16x8*)(rowp + kcol + seg * 16), k1 = *(const bf16x8*)(rowp + kcol + seg * 16 + 8);
        const bf16x8 v0 = *(const bf16x8*)(rowp + vcol + seg * 16), v1 = *(const bf16x8*)(rowp + vcol + seg * 16 + 8);
#pragma unroll
        for (int e = 0; e < 8; ++e) { kf[e] = bf2f((u16)k0[e]); kf[8 + e] = bf2f((u16)k1[e]); vf[e] = bf2f((u16)v0[e]); vf[8 + e] = bf2f((u16)v1[e]); }
        if (MODE == 3) {
          const bf16x8 p0 = *(const bf16x8*)(rowp + kcol + (seg ^ 1) * 16), p1 = *(const bf16x8*)(rowp + kcol + (seg ^ 1) * 16 + 8);
          const int pos = (seg & 2) ? key : blk;
#pragma unroll
          for (int e = 0; e < 16; ++e) {
            const float pr = bf2f((u16)(e < 8 ? p0[e & 7] : p1[e & 7]));
            const float cs = ropep[(pos * 16 + e) * 2], sn = ropep[(pos * 16 + e) * 2 + 1];
            kf[e] = (seg & 1) ? (pr * sn + kf[e] * cs) : (kf[e] * cs - pr * sn);
          }
        }
      }
      bf16x8 o0, o1;
#pragma unroll
      for (int e = 0; e < 8; ++e) { o0[e] = (short)f2bf(kf[e]); o1[e] = (short)f2bf(kf[8 + e]); }
      *(bf16x8*)(Ks + key * 72 + seg * 16) = o0;
      *(bf16x8*)(Ks + key * 72 + seg * 16 + 8) = o1;
#pragma unroll
      for (int e = 0; e < 16; ++e) Vt[(seg * 16 + e) * 72 + key] = f2bf(vf[e]);
    }
    __syncthreads();
    bool active = true;
    if (MODE == 1 && !isctx) active = (blk >= r0w && blk < r0w + 8);
    if (active) {
      f32x16 st[2]; zero16(st[0]); zero16(st[1]);
#pragma unroll
      for (int kt = 0; kt < 2; ++kt)
#pragma unroll
        for (int s = 0; s < 4; ++s) {
          const bf16x8 a = *(const bf16x8*)(Ks + (kt * 32 + r) * 72 + 16 * s + 8 * h);
          st[kt] = MFMA(a, qf[s], st[kt]);
        }
      float mx = m_run;
#pragma unroll
      for (int kt = 0; kt < 2; ++kt)
#pragma unroll
        for (int i = 0; i < 16; ++i) {
          float s = st[kt][i] * 0.125f;
          const int kk = kt * 32 + crow(i, h);
          if (MODE == 1 && !isctx) {
            const bool ok = (kk >= c0w && kk < c0w + 16);
            s = ok ? s + rpb_s[(blk - qi + 7) * 31 + (kk - qw + 15)] : -1e30f;
          }
          if (MODE == 3 && !isctx) {
            const int dlt = blk * 64 + kk - tq;
            s = (dlt <= 128 && dlt >= -128) ? s : -1e30f;
          }
          st[kt][i] = s;
          mx = fmaxf(mx, s);
        }
      mx = fmaxf(mx, shx(mx, lane, 32));
      const float alpha = __expf(m_run - mx);
      m_run = mx;
      float ps = 0.f;
#pragma unroll
      for (int kt = 0; kt < 2; ++kt)
#pragma unroll
        for (int i = 0; i < 16; ++i) { const float pv = __expf(st[kt][i] - mx); st[kt][i] = pv; ps += pv; }
      l_run = l_run * alpha + ps;
#pragma unroll
      for (int dt = 0; dt < 2; ++dt)
#pragma unroll
        for (int i = 0; i < 16; ++i) ot[dt][i] *= alpha;
#pragma unroll
      for (int kt = 0; kt < 2; ++kt) {
        const bf16x8 pb0 = packs<0>(st[kt]), pb1 = packs<1>(st[kt]);
#pragma unroll
        for (int dt = 0; dt < 2; ++dt) {
          const bf16x8 pa0 = ld2x4(Vt + (dt * 32 + r) * 72 + kt * 32 + 4 * h);
          const bf16x8 pa1 = ld2x4(Vt + (dt * 32 + r) * 72 + kt * 32 + 16 + 4 * h);
          ot[dt] = MFMA(pa0, pb0, ot[dt]);
          ot[dt] = MFMA(pa1, pb1, ot[dt]);
        }
      }
    }
  }
  l_run += shx(l_run, lane, 32);
  const float inv = 1.f / l_run;
  u16* dst = hnp + qtok * 1024 + qcol;
#pragma unroll
  for (int dt = 0; dt < 2; ++dt)
#pragma unroll
    for (int g4 = 0; g4 < 4; ++g4) {
      ushort4 o;
      o.x = f2bf(ot[dt][4 * g4] * inv); o.y = f2bf(ot[dt][4 * g4 + 1] * inv); o.z = f2bf(ot[dt][4 * g4 + 2] * inv); o.w = f2bf(ot[dt][4 * g4 + 3] * inv);
      *(ushort4*)(dst + dt * 32 + 8 * g4 + 4 * h) = o;
    }
}

struct ChainId { int lat, b, h, dir, T, base, nch; };
DI ChainId chain_decode(int it) {
  ChainId c; c.lat = it < 128; const int q = c.lat ? it : it - 128;
  c.b = q >> 4; c.h = (q >> 1) & 7; c.dir = q & 1; c.T = c.lat ? 4096 : 256; c.base = c.lat ? NP_ + c.b * 4096 : c.b * 256; c.nch = c.T >> 6;
  return c;
}
DI int tokof(const ChainId& c, int step, int row) { const int pp = step * 64 + row; return c.base + (c.dir ? c.T - 1 - pp : pp); }


static constexpr int RING = 4;
static constexpr int SLOT_BYTES = 53760;
DI void wait_ge(int* flag, int val, int tid) {
  if (tid < 64) {
    if (tid == 0) { while (__hip_atomic_load(flag, __ATOMIC_RELAXED, __HIP_MEMORY_SCOPE_AGENT) < val) __builtin_amdgcn_s_sleep(1); }
    __builtin_amdgcn_fence(__ATOMIC_ACQUIRE, "agent");
  }
  __syncthreads();
}
DI void publish(int* flag, int val, int tid) {
  asm volatile("s_waitcnt vmcnt(0)" ::: "memory");
  __syncthreads();
  if (tid == 0) __hip_atomic_store(flag, val, __ATOMIC_RELAXED, __HIP_MEMORY_SCOPE_AGENT);
}
typedef __attribute__((ext_vector_type(4))) unsigned u32x4;
DI void copy_out(const char* lds, char* g, int bytes, int tid) {
  for (int i = opq(tid) * 16; i < bytes; i += 256 * 16) {
    const u32x4 v = *(const u32x4*)(lds + i);
    char* dst = g + i;
    asm volatile("global_store_dwordx4 %0, %1, off sc0 sc1" :: "v"(dst), "v"(v) : "memory");
  }
}
template <int BYTES>
DI void copy_in_t(char* lds, const char* g, int tid) {
  constexpr int N = (BYTES + 4095) / 4096;
  const int t16 = opq(tid) * 16;
  uint4 v[N];
#pragma unroll
  for (int j = 0; j < N; ++j) { const int i = t16 + j * 4096; v[j] = make_uint4(0, 0, 0, 0); if (i < BYTES) v[j] = *(const uint4*)(g + i); }
#pragma unroll
  for (int j = 0; j < N; ++j) { const int i = t16 + j * 4096; if (i < BYTES) *(uint4*)(lds + i) = v[j]; }
}

template <int ROLE>
DI void gla_chain(const P* __restrict__ gp, int jj, int it, char* smem, int k0, int kstep, int fs = 0) {
  const P& p = *gp;
  const ChainId cid = chain_decode(it);
  int tid_ = threadIdx.x; asm volatile("" : "+v"(tid_)); const int tid = tid_, lane = tid & 63, wave = tid >> 6, r = lane & 31, h = lane >> 5;
  const int hh = cid.h, dir = cid.dir;
  u16* QT = (u16*)smem; u16* KT = QT + 4608; u16* KEt = KT + 4608; u16* Vt = KEt + 4608;
  float* dec = (float*)(Vt + 4608); float* GL = dec + 64; float* gq = GL + 1024; float* Ost = gq + 256;
  constexpr int IMG = 4 * 9216 + 256;
  char* slots = uni(p.ring) + (size_t)it * RING * SLOT_BYTES; int* ready = uni(p.flags) + (jj * 2 + 4 * fs) * 8320 + it * 64; int* done = uni(p.flags) + (jj * 2 + 4 * fs) * 8320 + 8192 + it;
  const int d = tid & 63, cq = tid >> 6;
  float wg[16];
#pragma unroll
  for (int rr = 0; rr < 16; ++rr) wg[rr] = p.b_w_g2[((size_t)((jj * 2 + dir) * 16 + rr)) * 512 + hh * 64 + d];
  const float bg = p.b_b_g[(jj * 2 + dir) * 512 + hh * 64 + d];
  const int vh = wave & 1;
  f32x16 S[2]; zero16(S[0]); zero16(S[1]);
  const size_t sidx = ((size_t)(((cid.b * 2 + jj) * 2 + dir) * 8 + hh)) * 4096;
  if (ROLE != 1 && wave < 2 && cid.lat) {
#pragma unroll
    for (int dt = 0; dt < 2; ++dt)
#pragma unroll
      for (int i = 0; i < 16; ++i) S[dt][i] = p.state_b[sidx + (dt * 32 + crow(i, h)) * 64 + vh * 32 + r];
  }
  for (int step_ = k0; step_ < cid.nch; step_ += kstep) {
    int step = step_;
    asm volatile("" : "+v"(step));
    if (ROLE == 1) wait_ge(done, step_ - RING + 1, tid);
    if (ROLE == 2) wait_ge(ready + step_, 1, tid);
    __syncthreads();
    if (ROLE == 2) { copy_in_t<IMG>(smem, slots + (size_t)(step_ % RING) * SLOT_BYTES, tid); __syncthreads(); if (tid == 0) __hip_atomic_store(done, step_ + 1, __ATOMIC_RELAXED, __HIP_MEMORY_SCOPE_AGENT); }
    if (ROLE != 2) {
    {
      const int c = tid >> 2, sg = tid & 3;
      const int tok = tokof(cid, step, c);
      const ushort4 gv = *(const ushort4*)(p.proj + (size_t)tok * EVN + 3072 + dir * 16 + sg * 4);
      GL[c * 16 + sg * 4] = bf2f(gv.x); GL[c * 16 + sg * 4 + 1] = bf2f(gv.y); GL[c * 16 + sg * 4 + 2] = bf2f(gv.z); GL[c * 16 + sg * 4 + 3] = bf2f(gv.w);
    }
    __syncthreads();
    float Gl[16]; float run = 0.f;
#pragma unroll
    for (int i = 0; i < 16; ++i) {
      const int c = cq * 16 + i;
      float z = bg;
#pragma unroll
      for (int rr = 0; rr < 16; ++rr) z += GL[c * 16 + rr] * wg[rr];
      const float g = (fminf(z, 0.f) - __logf(1.f + __expf(-fabsf(z)))) * (1.f / 16.f);
      run += g; Gl[i] = run;
    }
    gq[cq * 64 + d] = run;
    __syncthreads();
    float off = 0.f, tot = 0.f;
#pragma unroll
    for (int q2 = 0; q2 < 4; ++q2) { const float t = gq[q2 * 64 + d]; if (q2 < cq) off += t; tot += t; }
#pragma unroll
    for (int i = 0; i < 16; ++i) {
      const int c = cq * 16 + i;
      const int tok = tokof(cid, step, c);
      const float G = Gl[i] + off;
      const u16* rowp = p.proj + (size_t)tok * EVN + hh * 64 + d;
      const float qv = bf2f(rowp[1536]), kv = bf2f(rowp[2048]);
      const u16 vb = rowp[2560];
      QT[c * 72 + d] = f2bf(qv * 0.125f * __expf(G));
      KT[c * 72 + d] = f2bf(kv * __expf(-G));
      KEt[d * 72 + c] = f2bf(kv * __expf(tot - G));
      Vt[d * 72 + c] = vb;
    }
    if (cq == 0) dec[d] = __expf(tot);
    __syncthreads();
    }
    if (ROLE == 1) { copy_out(smem, slots + (size_t)(step_ % RING) * SLOT_BYTES, IMG, tid); publish(ready + step_, 1, tid); continue; }
    if (wave < 2) {
      f32x16 at[2][2];
#pragma unroll
      for (int a = 0; a < 2; ++a)
#pragma unroll
        for (int b2 = 0; b2 < 2; ++b2) zero16(at[a][b2]);
#pragma unroll
      for (int ks = 0; ks < 4; ++ks) {
        const bf16x8 a0 = *(const bf16x8*)(KT + r * 72 + ks * 16 + 8 * h), a1 = *(const bf16x8*)(KT + (32 + r) * 72 + ks * 16 + 8 * h);
        const bf16x8 b0 = *(const bf16x8*)(QT + r * 72 + ks * 16 + 8 * h), b1 = *(const bf16x8*)(QT + (32 + r) * 72 + ks * 16 + 8 * h);
        at[0][0] = MFMA(a0, b0, at[0][0]); at[0][1] = MFMA(a0, b1, at[0][1]);
        at[1][0] = MFMA(a1, b0, at[1][0]); at[1][1] = MFMA(a1, b1, at[1][1]);
      }
#pragma unroll
      for (int st = 0; st < 2; ++st)
#pragma unroll
        for (int ct = 0; ct < 2; ++ct)
#pragma unroll
          for (int i = 0; i < 16; ++i) { if (st * 32 + crow(i, h) > ct * 32 + r) at[st][ct][i] = 0.f; }
      f32x16 o[2]; zero16(o[0]); zero16(o[1]);
#pragma unroll
      for (int ct = 0; ct < 2; ++ct)
#pragma unroll
        for (int st = 0; st < 2; ++st) {
          const bf16x8 x0 = packs<0>(at[st][ct]), x1 = packs<1>(at[st][ct]);
          const bf16x8 pb0 = ld2x4(Vt + (vh * 32 + r) * 72 + st * 32 + 4 * h);
          const bf16x8 pb1 = ld2x4(Vt + (vh * 32 + r) * 72 + st * 32 + 16 + 4 * h);
          o[ct] = MFMA(x0, pb0, o[ct]);
          o[ct] = MFMA(x1, pb1, o[ct]);
        }
#pragma unroll
      for (int dt = 0; dt < 2; ++dt) {
        const bf16x8 xs0 = packs<0>(S[dt]), xs1 = packs<1>(S[dt]);
#pragma unroll
        for (int ct = 0; ct < 2; ++ct) {
          const bf16x8 pa0 = ld2x4(QT + (ct * 32 + r) * 72 + dt * 32 + 4 * h);
          const bf16x8 pa1 = ld2x4(QT + (ct * 32 + r) * 72 + dt * 32 + 16 + 4 * h);
          o[ct] = MFMA(pa0, xs0, o[ct]);
          o[ct] = MFMA(pa1, xs1, o[ct]);
        }
      }
#pragma unroll
      for (int dt = 0; dt < 2; ++dt)
#pragma unroll
        for (int i = 0; i < 16; ++i) S[dt][i] *= dec[dt * 32 + crow(i, h)];
#pragma unroll
      for (int ks = 0; ks < 4; ++ks) {
        const bf16x8 bv = *(const bf16x8*)(Vt + (vh * 32 + r) * 72 + ks * 16 + 8 * h);
#pragma unroll
        for (int dt = 0; dt < 2; ++dt) {
          const bf16x8 a = *(const bf16x8*)(KEt + (dt * 32 + r) * 72 + ks * 16 + 8 * h);
          S[dt] = MFMA(a, bv, S[dt]);
        }
      }
#pragma unroll
      for (int ct = 0; ct < 2; ++ct)
#pragma unroll
        for (int i = 0; i < 16; ++i) Ost[(ct * 32 + crow(i, h)) * 68 + vh * 32 + r] = o[ct][i];
    }
    __syncthreads();
    {
      const int c = tid >> 2, sg = tid & 3;
      const int tok = tokof(cid, step, c);
      u16* dst = (dir ? p.ot1 + (size_t)tok * 512 + hh * 64 : p.hn + (size_t)tok * 1024 + 512 + hh * 64) + sg * 16;
      bf16x8 w0, w1;
#pragma unroll
      for (int e = 0; e < 8; ++e) { w0[e] = (short)f2bf(Ost[c * 68 + sg * 16 + e]); w1[e] = (short)f2bf(Ost[c * 68 + sg * 16 + 8 + e]); }
      *(bf16x8*)dst = w0; *(bf16x8*)(dst + 8) = w1;
    }
  }
  if (wave < 2 && !cid.lat) {
#pragma unroll
    for (int dt = 0; dt < 2; ++dt)
#pragma unroll
      for (int i = 0; i < 16; ++i) p.out[OFF_SB + sidx + (dt * 32 + crow(i, h)) * 64 + vh * 32 + r] = S[dt][i];
  }
}

template <int ROLE>
DI void delta_chain(const P* __restrict__ gp, int jj, int it, char* smem, int k0, int kstep, int fs = 0) {
  const P& p = *gp;
  const ChainId cid = chain_decode(it);
  int tid_ = threadIdx.x; asm volatile("" : "+v"(tid_)); const int tid0 = tid_;
  const int hh = cid.h, dir = cid.dir;
  u16* Qn = (u16*)smem; u16* Kt = Qn + 4608; u16* AQK = Kt + 4608; u16* KC = AQK + 4608;
  float* Wv = (float*)(KC + 4608); float* Gs = Wv + 64 * 65; u16* Kn = (u16*)(Gs + 64); float* At = (float*)(Kn + 4608); float* Bt = At + 64 * 68;
  constexpr int IMG = 4 * 9216 + 16640 + 256;
  char* slots = uni(p.ring) + (size_t)it * RING * SLOT_BYTES; int* ready = uni(p.flags) + (jj * 2 + 1 + 4 * fs) * 8320 + it * 64; int* done = uni(p.flags) + (jj * 2 + 1 + 4 * fs) * 8320 + 8192 + it;
  const float aexp = __expf(p.d_a_log[(jj * 2 + dir) * 8 + hh]);
  const float dtb = p.d_dt_bias[(jj * 2 + dir) * 8 + hh];
  f32x16 S[2]; zero16(S[0]); zero16(S[1]);
  const size_t sidx = ((size_t)(((cid.b * 2 + jj) * 2 + dir) * 8 + hh)) * 4096;
  { const int tid = tid0, lane = tid & 63, wave = tid >> 6, r = lane & 31, h = lane >> 5;
  if (ROLE != 1 && wave < 2 && cid.lat) {
    const int vh = wave & 1;
#pragma unroll
    for (int dt = 0; dt < 2; ++dt)
#pragma unroll
      for (int i = 0; i < 16; ++i) S[dt][i] = p.state_d[sidx + (dt * 32 + crow(i, h)) * 64 + vh * 32 + r];
  }
  }
  u16* CW = (u16*)(smem + 80640);
  __syncthreads();
  for (int i = tid0; i < 576; i += 256) { const int tap = i / 192, c2 = i - tap * 192; const int wh = c2 >> 6, dd = c2 & 63;
    CW[i] = f2bf(p.d_conv[(size_t)jj * 3 * 1536 + tap * 1536 + wh * 512 + hh * 64 + dd]); }
  for (int step_ = k0; step_ < cid.nch; step_ += kstep) {
    int step = step_;
    asm volatile("" : "+v"(step));
    if (ROLE == 1) wait_ge(done, step_ - RING + 1, tid0);
    if (ROLE == 2) wait_ge(ready + step_, 1, tid0);
    __syncthreads();
    if (ROLE == 2) { copy_in_t<IMG>(smem, slots + (size_t)(step_ % RING) * SLOT_BYTES, tid0); __syncthreads(); if (tid0 == 0) __hip_atomic_store(done, step_ + 1, __ATOMIC_RELAXED, __HIP_MEMORY_SCOPE_AGENT); }
    if (ROLE != 2) {
    {const int tid = opq(tid0), lane = tid & 63, wave = __builtin_amdgcn_readfirstlane(tid >> 6), r = lane & 31, h = lane >> 5, vh = wave & 1; (void)r; (void)h; (void)vh; (void)lane;
    if (wave == 0) {
      const int tok = tokof(cid, step, lane);
      const float da = bf2f(p.proj[(size_t)tok * ODN + 2304 + dir * 8 + hh]);
      const float db = bf2f(p.proj[(size_t)tok * ODN + 2320 + dir * 8 + hh]);
      const float x = da + dtb;
      const float sp = x > 20.f ? x : __logf(1.f + __expf(x));
      float G = -aexp * sp;
#pragma unroll
      for (int o = 1; o < 64; o <<= 1) { const float t = __int_as_float(__builtin_amdgcn_ds_bpermute((lane - o) << 2, __float_as_int(G))); if (lane >= o) G += t; }
      Gs[lane] = G; Bt[lane] = 1.f / (1.f + __expf(-db));
    }
    {
      const int c = tid >> 2, sg = tid & 3;
      const int tok = tokof(cid, step, c);
      const int pos = tok - cid.base;
      const bool hp = pos > 0, hn_ = pos < cid.T - 1;
#pragma unroll 1
      for (int wh = 0; wh < 3; ++wh) {
        const int ch0 = wh * 512 + hh * 64 + sg * 16;
        const u16* cur = p.proj + (size_t)tok * ODN + 768 + ch0;
        float y[16];
        float ss = 0.f;
#pragma unroll
        for (int hf = 0; hf < 2; ++hf) {
          const bf16x8 xc = *(const bf16x8*)(cur + hf * 8);
          bf16x8 xp, xn;
#pragma unroll
          for (int e = 0; e < 8; ++e) { xp[e] = 0; xn[e] = 0; }
          if (hp) xp = *(const bf16x8*)(cur - ODN + hf * 8);
          if (hn_) xn = *(const bf16x8*)(cur + ODN + hf * 8);
#pragma unroll
          for (int e = 0; e < 8; ++e) {
            const int ch = wh * 64 + sg * 16 + hf * 8 + e;
            float v = bf2f(CW[ch]) * bf2f((u16)xp[e]) + bf2f(CW[192 + ch]) * bf2f((u16)xc[e]) + bf2f(CW[384 + ch]) * bf2f((u16)xn[e]);
            v = v / (1.f + __expf(-v));
            y[hf * 8 + e] = v; ss += v * v;
          }
        }
        ss += shx(ss, lane, 1); ss += shx(ss, lane, 2);
        const float rn = rsqrtf(ss + 1e-6f);
        if (wh == 0) {
#pragma unroll
          for (int e = 0; e < 16; ++e) Qn[c * 72 + sg * 16 + e] = f2bf(y[e] * rn * 0.125f);
        } else if (wh == 1) {
#pragma unroll
          for (int e = 0; e < 16; ++e) { const u16 kb = f2bf(y[e] * rn); Kn[c * 72 + sg * 16 + e] = kb; Kt[(sg * 16 + e) * 72 + c] = kb; }
        } else {
#pragma unroll
          for (int e = 0; e < 16; ++e) Wv[c * 65 + sg * 16 + e] = y[e];
        }
      }
    }
    }
    __syncthreads();
    {const int tid = opq(tid0), lane = tid & 63, wave = __builtin_amdgcn_readfirstlane(tid >> 6), r = lane & 31, h = lane >> 5, vh = wave & 1; (void)r; (void)h; (void)vh; (void)lane;
    if (wave < 2) {
      f32x16 akk[2], aqk[2]; zero16(akk[0]); zero16(akk[1]); zero16(aqk[0]); zero16(aqk[1]);
#pragma unroll
      for (int ks = 0; ks < 4; ++ks) {
        const bf16x8 bk = *(const bf16x8*)(Kn + (vh * 32 + r) * 72 + ks * 16 + 8 * h);
#pragma unroll
        for (int ct = 0; ct < 2; ++ct) {
          const bf16x8 ak = *(const bf16x8*)(Kn + (ct * 32 + r) * 72 + ks * 16 + 8 * h);
          const bf16x8 aq = *(const bf16x8*)(Qn + (ct * 32 + r) * 72 + ks * 16 + 8 * h);
          akk[ct] = MFMA(ak, bk, akk[ct]);
          aqk[ct] = MFMA(aq, bk, aqk[ct]);
        }
      }
      const int s = vh * 32 + r;
      const float Gss = Gs[s];
#pragma unroll
      for (int ct = 0; ct < 2; ++ct)
#pragma unroll
        for (int g4 = 0; g4 < 4; ++g4) {
          const int c0 = ct * 32 + 8 * g4 + 4 * h;
          const float4 gv4 = *(const float4*)(Gs + c0), bv4 = *(const float4*)(Bt + c0);
          float4 val;
#pragma unroll
          for (int e = 0; e < 4; ++e) {
            const int c = c0 + e;
            const float Gc = e == 0 ? gv4.x : e == 1 ? gv4.y : e == 2 ? gv4.z : gv4.w;
            const float Bc = e == 0 ? bv4.x : e == 1 ? bv4.y : e == 2 ? bv4.z : bv4.w;
            const float gam = __expf(fminf(Gc - Gss, 0.f));
            const float av = (s < c) ? akk[ct][4 * g4 + e] * Bc * gam : 0.f;
            if (e == 0) val.x = av; else if (e == 1) val.y = av; else if (e == 2) val.z = av; else val.w = av;
            AQK[c * 72 + s] = f2bf((s <= c) ? aqk[ct][4 * g4 + e] * gam : 0.f);
          }
          *(float4*)(At + s * 68 + c0) = val;
        }
    }
    }
    __syncthreads();
    {const int tid = opq(tid0), lane = tid & 63, wave = __builtin_amdgcn_readfirstlane(tid >> 6), r = lane & 31, h = lane >> 5, vh = wave & 1; (void)r; (void)h; (void)vh; (void)lane;
    if (wave < 2) {
      const bool isv = wave == 0;
      const int col = lane;
#pragma unroll 1
      for (int bi = 0; bi < 4; ++bi) {
        float acc[16];
#pragma unroll
        for (int ci = 0; ci < 16; ++ci) {
          const int c = 16 * bi + ci;
          acc[ci] = isv ? Wv[c * 65 + col] * Bt[c] : bf2f(Kn[c * 72 + col]) * Bt[c] * __expf(Gs[c]);
        }
#pragma unroll 8
        for (int s2 = 0; s2 < 16 * bi; ++s2) {
          const float xs = isv ? Wv[s2 * 65 + col] : bf2f(KC[s2 * 72 + col]);
          const float4* a4 = (const float4*)(At + s2 * 68 + 16 * bi);
#pragma unroll
          for (int q = 0; q < 4; ++q) {
            const float4 a = a4[q];
            acc[4 * q] -= a.x * xs; acc[4 * q + 1] -= a.y * xs; acc[4 * q + 2] -= a.z * xs; acc[4 * q + 3] -= a.w * xs;
          }
        }
#pragma unroll
        for (int ci = 0; ci < 16; ++ci) {
          const float x = acc[ci];
          const float* arow = At + (16 * bi + ci) * 68 + 16 * bi;
#pragma unroll
          for (int cj = ci + 1; cj < 16; ++cj) acc[cj] -= arow[cj] * x;
          if (isv) Wv[(16 * bi + ci) * 65 + col] = x; else KC[(16 * bi + ci) * 72 + col] = f2bf(x);
        }
      }
    }
    }
    __syncthreads();
    }
    if (ROLE == 1) { copy_out(smem, slots + (size_t)(step_ % RING) * SLOT_BYTES, IMG, tid0); publish(ready + step_, 1, tid0); continue; }
    {const int tid = opq(tid0), lane = tid & 63, wave = __builtin_amdgcn_readfirstlane(tid >> 6), r = lane & 31, h = lane >> 5, vh = wave & 1; (void)r; (void)h; (void)vh; (void)lane;
    if (wave < 2) {
      f32x16 kS[2], qS[2]; zero16(kS[0]); zero16(kS[1]); zero16(qS[0]); zero16(qS[1]);
#pragma unroll
      for (int dt = 0; dt < 2; ++dt) {
        const bf16x8 xs0 = packs<0>(S[dt]), xs1 = packs<1>(S[dt]);
#pragma unroll
        for (int ct = 0; ct < 2; ++ct) {
          kS[ct] = MFMA(ld2x4(KC + (ct * 32 + r) * 72 + dt * 32 + 4 * h), xs0, kS[ct]);
          kS[ct] = MFMA(ld2x4(KC + (ct * 32 + r) * 72 + dt * 32 + 16 + 4 * h), xs1, kS[ct]);
          qS[ct] = MFMA(ld2x4(Qn + (ct * 32 + r) * 72 + dt * 32 + 4 * h), xs0, qS[ct]);
          qS[ct] = MFMA(ld2x4(Qn + (ct * 32 + r) * 72 + dt * 32 + 16 + 4 * h), xs1, qS[ct]);
        }
      }
      f32x16 vn[2], o[2];
      const float Glast = Gs[63];
#pragma unroll
      for (int ct = 0; ct < 2; ++ct)
#pragma unroll
        for (int i = 0; i < 16; ++i) {
          const int c = ct * 32 + crow(i, h);
          vn[ct][i] = Wv[c * 65 + vh * 32 + r] - kS[ct][i];
          o[ct][i] = qS[ct][i] * __expf(Gs[c]);
        }
#pragma unroll
      for (int st = 0; st < 2; ++st) {
        const bf16x8 xs0 = packs<0>(vn[st]), xs1 = packs<1>(vn[st]);
#pragma unroll
        for (int ct = 0; ct < 2; ++ct) {
          o[ct] = MFMA(ld2x4(AQK + (ct * 32 + r) * 72 + st * 32 + 4 * h), xs0, o[ct]);
          o[ct] = MFMA(ld2x4(AQK + (ct * 32 + r) * 72 + st * 32 + 16 + 4 * h), xs1, o[ct]);
        }
      }
      const float dl = __expf(Glast);
#pragma unroll
      for (int st = 0; st < 2; ++st) {
        asm volatile("" ::: "memory");
#pragma unroll
        for (int i = 0; i < 16; ++i) vn[st][i] *= __expf(Glast - Gs[st * 32 + crow(i, h)]);
      }
      asm volatile("" ::: "memory");
#pragma unroll
      for (int dt = 0; dt < 2; ++dt)
#pragma unroll
        for (int i = 0; i < 16; ++i) S[dt][i] *= dl;
#pragma unroll
      for (int st = 0; st < 2; ++st) {
        const bf16x8 xs0 = packs<0>(vn[st]), xs1 = packs<1>(vn[st]);
#pragma unroll
        for (int dt = 0; dt < 2; ++dt) {
          S[dt] = MFMA(ld2x4(Kt + (dt * 32 + r) * 72 + st * 32 + 4 * h), xs0, S[dt]);
          S[dt] = MFMA(ld2x4(Kt + (dt * 32 + r) * 72 + st * 32 + 16 + 4 * h), xs1, S[dt]);
        }
      }
#pragma unroll
      for (int ct = 0; ct < 2; ++ct)
#pragma unroll
        for (int i = 0; i < 16; ++i) At[(ct * 32 + crow(i, h)) * 68 + vh * 32 + r] = o[ct][i];
    }
    }
    __syncthreads();
    {
      const int tid = opq(tid0);
      const int c = tid >> 2, sg = tid & 3;
      const int tok = tokof(cid, step, c);
      u16* dst = (dir ? p.ot1 + (size_t)tok * 512 + hh * 64 : p.hn + (size_t)tok * 1024 + 512 + hh * 64) + sg * 16;
      bf16x8 w0, w1;
#pragma unroll
      for (int e = 0; e < 8; ++e) { w0[e] = (short)f2bf(At[c * 68 + sg * 16 + e]); w1[e] = (short)f2bf(At[c * 68 + sg * 16 + 8 + e]); }
      *(bf16x8*)dst = w0; *(bf16x8*)(dst + 8) = w1;
    }
  }
  {const int tid = opq(tid0), lane = tid & 63, wave = __builtin_amdgcn_readfirstlane(tid >> 6), r = lane & 31, h = lane >> 5, vh = wave & 1; (void)r; (void)h; (void)vh; (void)lane;
  if (wave < 2 && !cid.lat) {
#pragma unroll
    for (int dt = 0; dt < 2; ++dt)
#pragma unroll
      for (int i = 0; i < 16; ++i) p.out[OFF_SD + sidx + (dt * 32 + crow(i, h)) * 64 + vh * 32 + r] = S[dt][i];
  }
}
}

DI void mixer_phase(const P* __restrict__ gp, int l, char* smem, int fs = 0) {
  const P& p = *gp;
  const bool even = !(l & 1); const int jj = l >> 1;
  const bool teams = gridDim.x >= 512;
  if (teams) {
    const int bid = blockIdx.x;
    const int K = 3;
    if (bid < 128 * (K + 1)) {
      if (bid < 128) { if (even) gla_chain<2>(gp, jj, bid, smem, 0, 1, fs); else delta_chain<2>(gp, jj, bid, smem, 0, 1, fs); }
      else { const int ch = (bid - 128) & 127, k = (bid - 128) >> 7; if (even) gla_chain<1>(gp, jj, ch, smem, k, K, fs); else delta_chain<1>(gp, jj, ch, smem, k, K, fs); }
    }
  }
  const int first = teams ? 128 : 0;
  const int total = 384 + 2048 + 256;
  int* s_item = (int*)(smem + SMEM_BYTES - 16);
  int* cntp = uni(p.cnt) + l + 4 * fs;
  for (;;) {
    __syncthreads();
    if (opq(threadIdx.x) == 0) *s_item = atomicAdd(cntp, 1) + first;
    __syncthreads();
    const int item = __builtin_amdgcn_readfirstlane(*s_item);
    if (item >= total) break;
    if (item < 384) { if (even) gla_chain<0>(gp, jj, item, smem, 0, 1); else delta_chain<0>(gp, jj, item, smem, 0, 1); }
    else if (item < 384 + 2048) { if (even) attn_item<1>(gp, jj, item - 384, smem); else attn_item<3>(gp, jj, item - 384, smem); }
    else { if (even) attn_item<0>(gp, jj, item - 384 - 2048, smem); else attn_item<2>(gp, jj, item - 384 - 2048, smem); }
  }
}

DI void finalize_phase(const P* __restrict__ gp, int l) {
  const P& p = *gp;
  const bool even = !(l & 1); const int jj = l >> 1;
  int tid_ = threadIdx.x; asm volatile("" : "+v"(tid_)); const int tid = tid_;
  const int tk = tid >> 5, hh = (tid >> 2) & 7, sg = tid & 3;
  const int PS = even ? EVN : ODN; const int zcol = even ? 3104 : 2336;
  for (int item = blockIdx.x; item < NT_ / 8; item += gridDim.x) {
    const size_t tok = (size_t)item * 8 + tk;
    u16* a = p.hn + tok * 1024 + 512 + hh * 64 + sg * 16;
    const u16* bsrc = p.ot1 + tok * 512 + hh * 64 + sg * 16;
    const u16* zs = p.proj + tok * PS + zcol + hh * 64 + sg * 16;
    float o[16]; float ss = 0.f;
#pragma unroll
    for (int hf = 0; hf < 2; ++hf) {
      const bf16x8 x0 = *(const bf16x8*)(a + hf * 8), x1 = *(const bf16x8*)(bsrc + hf * 8);
#pragma unroll
      for (int e = 0; e < 8; ++e) { const float v = bf2f((u16)x0[e]) + bf2f((u16)x1[e]); o[hf * 8 + e] = v; ss += v * v; }
    }
    ss += shx(ss, tid & 63, 1); ss += shx(ss, tid & 63, 2);
    const float rstd = rsqrtf(ss * (1.f / 64.f) + 1e-6f);
    const float* ng = even ? p.b_norm_g + jj * 512 + hh * 64 + sg * 16 : p.d_norm_g + jj * 64 + sg * 16;
#pragma unroll
    for (int hf = 0; hf < 2; ++hf) {
      const bf16x8 z = *(const bf16x8*)(zs + hf * 8);
      bf16x8 w;
#pragma unroll
      for (int e = 0; e < 8; ++e) { const float zz = bf2f((u16)z[e]); w[e] = (short)f2bf(o[hf * 8 + e] * rstd * ng[hf * 8 + e] * siluf(zz)); }
      *(bf16x8*)(a + hf * 8) = w;
    }
  }
}


#define XB_TMO      128
#define XB_XCNT(j)  (256  + 64 * (j))
#define XB_XSUB(j)  (1280 + 64 * (j))
#define XB_XGEN(j)  (2304 + 64 * (j))
#define XB_TOP      3328
#define XB_TOPGEN   3392
#define XCD_BAR_WORDS 3456
#define XB_SPIN_CAP (1u << 18)
#define LAS __attribute__((address_space(3)))
DI unsigned xb_ld(unsigned* q)              { return __hip_atomic_load(q, __ATOMIC_RELAXED, __HIP_MEMORY_SCOPE_AGENT); }
DI unsigned xb_add(unsigned* q, unsigned v) { return __hip_atomic_fetch_add(q, v, __ATOMIC_RELAXED, __HIP_MEMORY_SCOPE_AGENT); }
DI unsigned xb_xcc_id() { return (unsigned)__builtin_amdgcn_s_getreg((3 << 11) | 20) & 0xFu; }
#define XB_SPIN(cond, bar) do { unsigned _sp = 0; while (cond) { __builtin_amdgcn_s_sleep(1); \
    if ((++_sp & 255u) == 0u) { if (xb_ld(&(bar)[XB_TMO])) break; if (_sp > XB_SPIN_CAP) { atomicAdd(&(bar)[XB_TMO], 1u); break; } } } } while (0)
struct XcdBarrier { unsigned* bar; unsigned x; volatile LAS unsigned* st; };
DI XcdBarrier xcd_barrier_post(unsigned* bar, volatile LAS unsigned* st) {
  XcdBarrier b; b.bar = bar; b.x = xb_xcc_id(); b.st = st;
  if (threadIdx.x == 0) (void)xb_add(&bar[XB_XCNT(b.x)], 1u);
  return b;
}
DI void xcd_barrier_complete(unsigned* bar, unsigned x, unsigned& nloc, unsigned& nx) {
  const unsigned G = gridDim.x * gridDim.y * gridDim.z;
  unsigned sum, cnt, mine, sp = 0u;
  for (;;) {
    sum = 0u; cnt = 0u; mine = 0u;
#pragma unroll
    for (unsigned j = 0; j < 16; ++j) { const unsigned c = xb_ld(&bar[XB_XCNT(j)]); sum += c; cnt += (c > 0u) ? 1u : 0u; mine = (j == x) ? c : mine; }
    if (sum == G) break;
    __builtin_amdgcn_s_sleep(1);
    if ((++sp & 255u) == 0u) { if (xb_ld(&bar[XB_TMO])) break; if (sp > XB_SPIN_CAP) { atomicAdd(&bar[XB_TMO], 1u); break; } }
  }
  nloc = mine > 0u ? mine : 1u; nx = cnt > 0u ? cnt : 1u;
}
DI void xcd_barrier(const XcdBarrier& b) {
  asm volatile("s_waitcnt vmcnt(0)" ::: "memory");
  __syncthreads();
  if (threadIdx.x == 0) {
    unsigned* bar = b.bar;
    __builtin_amdgcn_s_waitcnt(0);
    unsigned nloc = b.st[0], nx = b.st[1];
    if (nloc == 0u) { xcd_barrier_complete(bar, b.x, nloc, nx); b.st[0] = nloc; b.st[1] = nx; }
    const unsigned old = xb_add(&bar[XB_XSUB(b.x)], 1u);
    const unsigned gen = old / nloc;
    if (old + 1u == (gen + 1u) * nloc) {
      __builtin_amdgcn_fence(__ATOMIC_RELEASE, "agent");
      asm volatile("s_waitcnt vmcnt(0)" ::: "memory");
      const unsigned og = xb_add(&bar[XB_TOP], 1u);
      const unsigned tg = og / nx;
      if (og + 1u == (tg + 1u) * nx) xb_add(&bar[XB_TOPGEN], 1u);
      else XB_SPIN(xb_ld(&bar[XB_TOPGEN]) == tg, bar);
      __builtin_amdgcn_fence(__ATOMIC_ACQUIRE, "agent");
      xb_add(&bar[XB_XGEN(b.x)], 1u);
      asm volatile("s_waitcnt vmcnt(0)" ::: "memory");
    } else {
      XB_SPIN(xb_ld(&bar[XB_XGEN(b.x)]) == gen, bar);
      __builtin_amdgcn_fence(__ATOMIC_ACQUIRE, "agent");
      asm volatile("s_waitcnt vmcnt(0)" ::: "memory");
    }
  }
  __syncthreads();
}

DI void run_phase(const P* __restrict__ gp, int ph, char* smem) {
  const P& p = *gp;
  if (ph == 0) { prep_phase(gp, smem); return; }
  if (ph == NPH - 1) { norm_phase(gp, 0, 0, false, true); return; }
  const int l = (ph - 1) >> 3, s = (ph - 1) & 7;
  const bool even = !(l & 1);
  const u16* W = uni(p.wt) + (size_t)l * LW;
  const u16* hnp = uni(p.hn); const u16* projp = uni(p.proj);
  switch (s) {
    case 0: norm_phase(gp, l, 0, l == 0, false); break;
    case 1: gemm_phase<EPI_PROJ, 2>(gp, l, smem, hnp, 1024, W + WO_IN, 1024, 1024, 288, even ? 15 : 12, 0); break;
    case 2: mixer_phase(gp, l, smem); break;
    case 3: finalize_phase(gp, l); break;
    case 4: gemm_phase<EPI_RES, 1>(gp, l, smem, hnp, 1024, W + WO_OUT, 1024, 1024, 288, 8, 2); break;
    case 5: norm_phase(gp, l, 1, false, false); break;
    case 6: gemm_phase<EPI_FFN, 2>(gp, l, smem, hnp, 1024, W + WO_UP, 1024, 1024, 296, 22, 0); break;
    case 7: gemm_phase<EPI_RES, 1>(gp, l, smem, projp, 2816, W + WO_DN, 2816, 2816, 288, 8, 5); break;
  }
}

__global__ void __launch_bounds__(256, 2) mk(P p, P* gpmem, int ph0, int ph1) {
  __shared__ __attribute__((aligned(16))) char smem[SMEM_BYTES];
  const P* gp = &p;
  if (ph1 - ph0 > 1) {
    cg::grid_group grid = cg::this_grid();
    volatile LAS unsigned* xst = (volatile LAS unsigned*)(smem + SMEM_BYTES - 32);
    if (threadIdx.x == 0) { xst[0] = 0u; xst[1] = 0u; }
    __syncthreads();
    const XcdBarrier xbar = xcd_barrier_post(p.bar, xst);
    for (int ph = ph0; ph < ph1; ++ph) {
      run_phase(gp, ph, smem);
      if (ph + 1 < ph1) { if (ph1 > NPH) grid.sync(); else xcd_barrier(xbar); }
    }
  } else {
    run_phase(gp, ph0, smem);
  }
}

extern "C" void kernel_launch(void* const* d_in, const int* in_sizes, int n_in, void* d_out, int out_size, void* d_ws, size_t ws_size,
                              hipStream_t stream) {
  P p{};
  const float** f = (const float**)&p;
  for (int i = 0; i < 31; ++i) f[i] = (const float*)d_in[i];
  p.out = (float*)d_out;
  char* ws = (char*)d_ws;
  size_t off = 0;
  p.hn = (u16*)(ws + off); off += (size_t)NT_ * 1024 * 2;
  p.proj = (u16*)(ws + off); off += (size_t)NT_ * EVN * 2;
  p.ot1 = (u16*)(ws + off); off += (size_t)NT_ * 512 * 2;
  p.wt = (u16*)(ws + off); off += 4 * LW * 2;
  p.mods = (float*)(ws + off); off += 4 * 9 * 6144 * 4;
  p.rope = (float*)(ws + off); off += 64 * 16 * 2 * 4;
  P* gp = (P*)(ws + off); off += 4096;
  p.cnt = (int*)(ws + off); off += 256;
  p.flags = (int*)(ws + off); off += 8 * 8320 * 4;
  off = (off + 255) & ~(size_t)255;
  p.ring = ws + off; off += (size_t)128 * RING * SLOT_BYTES;
  p.bar = (unsigned*)(ws + off); off += XCD_BAR_WORDS * 4;
  static int grid_blocks = 0;
  if (!grid_blocks) {
    int dev = 0, cus = 0, per_cu = 0;
    hipGetDevice(&dev);
    hipDeviceGetAttribute(&cus, hipDeviceAttributeMultiprocessorCount, dev);
    hipOccupancyMaxActiveBlocksPerMultiprocessor(&per_cu, mk, 256, 0);
    if (per_cu < 1) per_cu = 1;
    if (per_cu > 2) per_cu = 2;
    grid_blocks = cus * per_cu;
  }
#if MK_MULTI
  for (int ph = 0; ph < NPH; ++ph) {
    int a = ph, b = ph + 1;
    hipLaunchKernelGGL(mk, dim3(grid_blocks), dim3(256), 0, stream, p, gp, a, b);
  }
#else
  hipMemsetAsync(p.bar, 0, XCD_BAR_WORDS * 4, stream);
  int ph0 = 0, ph1 = NPH;
  void* args[] = {&p, &gp, &ph0, &ph1};
  hipError_t e = hipLaunchCooperativeKernel((void*)mk, dim3(grid_blocks), dim3(256), args, 0, stream);
  if (e != hipSuccess) fprintf(stderr, "cooperative launch failed: %s (grid %d)\n", hipGetErrorString(e), grid_blocks);
#endif
}
```

```cpp
#include <hip/hip_runtime.h>
#include <hip/hip_cooperative_groups.h>
#include <cstdio>
namespace cg = cooperative_groups;

#ifndef MK_MULTI
#define MK_MULTI 0
#endif

#define DI __device__ __forceinline__
#define DN __device__ __noinline__
typedef unsigned short u16;
typedef __attribute__((ext_vector_type(8))) short bf16x8;
typedef __attribute__((ext_vector_type(4))) short s16x4;
typedef __attribute__((ext_vector_type(16))) float f32x16;
#define MFMA(a, b, c) __builtin_amdgcn_mfma_f32_32x32x16_bf16((a), (b), (c), 0, 0, 0)

static constexpr int NP_ = 4096, NT_ = 36864;
static constexpr int EVN = 3616, ODN = 2848;
static constexpr size_t OFF_AK = 37748736, OFF_AV = 41943040, OFF_SB = 46137344, OFF_CK = 48234496, OFF_CV = 49283072, OFF_SD = 50331648;
static constexpr size_t LW = 13631488, WO_UP = 0, WO_DN = 5767168, WO_IN = 8650752, WO_OUT = 12582912;
static constexpr int NPH = 34;
static constexpr int SMEM_BYTES = 80 * 1024;

struct P {
  const float *x_prompt, *x_sample, *cache_a_k, *cache_a_v, *state_b, *cache_c_k, *cache_c_v, *state_d, *c, *c_ctx, *ada_w, *ada_b,
      *norm1_g, *norm2_g, *ffn_up, *ffn_conv, *ffn_down, *ev_w_in, *ev_w_out, *a_rpb, *b_w_g2, *b_b_g, *b_norm_g, *od_w_in, *od_w_out,
      *c_sink, *d_conv, *d_a_log, *d_dt_bias, *d_norm_g, *final_g;
  float* out;
  u16 *hn, *proj, *ot1, *wt;
  float *mods, *rope;
  int* cnt;
  int* flags;
  char* ring;
  unsigned* bar;
};

typedef __attribute__((ext_vector_type(2))) __bf16 bf2_t;
typedef __attribute__((ext_vector_type(2))) float f2_t;
typedef __attribute__((ext_vector_type(4))) unsigned u32x4_t;
DI unsigned pk2(float a, float b) { const f2_t v = {a, b}; return __builtin_bit_cast(unsigned, __builtin_convertvector(v, bf2_t)); }
DI u16 f2bf(float x) { return __builtin_bit_cast(u16, (__bf16)x); }
DI float bf2f(u16 b) { return __uint_as_float(((unsigned)b) << 16); }
DI int crow(int i, int h) { return (i & 3) + 8 * (i >> 2) + 4 * h; }
template <int S> DI bf16x8 packs(const f32x16& x) {
  u32x4_t v;
  v[0] = pk2(x[8 * S], x[8 * S + 1]); v[1] = pk2(x[8 * S + 2], x[8 * S + 3]); v[2] = pk2(x[8 * S + 4], x[8 * S + 5]); v[3] = pk2(x[8 * S + 6], x[8 * S + 7]);
  return __builtin_bit_cast(bf16x8, v);
}
DI bf16x8 ld2x4(const u16* p) {
  s16x4 lo = *(const s16x4*)p, hi = *(const s16x4*)(p + 8);
  return __builtin_shufflevector(lo, hi, 0, 1, 2, 3, 4, 5, 6, 7);
}
DI float siluf(float x) { return x / (1.f + __expf(-x)); }
DI int opq(int x) { asm volatile("" : "+v"(x)); return x; }
DI float shx(float v, int lane, int o) { return __int_as_float(__builtin_amdgcn_ds_bpermute((lane ^ o) << 2, __float_as_int(v))); }
template <class T> DI T* uni(T* q) { return q; }
DI void zero16(f32x16& a) {
#pragma unroll
  for (int i = 0; i < 16; ++i) a[i] = 0.f;
}

DI void prep_phase(const P* __restrict__ gp, char* smem) {
  const P& p = *gp;
  int tid_ = threadIdx.x; asm volatile("" : "+v"(tid_)); const int tid = tid_;
  const int NWT = 4 * (1408 + 704 + 256) + 2 * (960 + 768);
  const int NADA = 384;
  const int total = NWT + NADA + 1;
  for (int item = blockIdx.x; item < total; item += gridDim.x) {
    if (item < NWT) {
      int rem = item; const float* src = nullptr; u16* dst = nullptr; int K = 0, N = 0, NPd = 0;
      for (int l = 0; l < 4; ++l) {
        const int jj = l >> 1; const bool ev = !(l & 1);
        const int nin = ev ? 960 : 768;
        if (rem < 1408) { src = p.ffn_up + (size_t)l * 1024 * 5632; dst = p.wt + l * LW + WO_UP; K = 1024; N = 5632; NPd = 5632; break; }
        rem -= 1408;
        if (rem < 704) { src = p.ffn_down + (size_t)l * 2816 * 1024; dst = p.wt + l * LW + WO_DN; K = 2816; N = 1024; NPd = 1024; break; }
        rem -= 704;
        if (rem < nin) { src = ev ? p.ev_w_in + (size_t)jj * 1024 * EVN : p.od_w_in + (size_t)jj * 1024 * ODN; dst = p.wt + l * LW + WO_IN; K = 1024; N = ev ? EVN : ODN; NPd = ev ? 3840 : 3072; break; }
        rem -= nin;
        if (rem < 256) { src = (ev ? p.ev_w_out : p.od_w_out) + (size_t)jj * 1024 * 1024; dst = p.wt + l * LW + WO_OUT; K = 1024; N = 1024; NPd = 1024; break; }
        rem -= 256;
      }
      const int ntn = NPd >> 6;
      const int tk = rem / ntn, tn = rem - tk * ntn;
      const int scol0 = (N == 5632) ? (((tn >> 1) & 1) * 2816 + (tn >> 2) * 128 + (tn & 1) * 64) : tn * 64;
      float* T = (float*)smem;
      __syncthreads();
#pragma unroll
      for (int i = 0; i < 16; ++i) {
        const int k = i * 4 + (tid >> 6), n = tid & 63;
        const int gn = scol0 + n;
        T[k * 65 + n] = (gn < N) ? src[(size_t)(tk * 64 + k) * N + gn] : 0.f;
      }
      __syncthreads();
#pragma unroll
      for (int i = 0; i < 2; ++i) {
        const int q = tid + 256 * i; const int n = q & 63, kc = q >> 6;
        const int pn = tn * 64 + n; const int nt32 = pn >> 5, rr = pn & 31;
        const int kstep = tk * 4 + (kc >> 1), hh = kc & 1;
        bf16x8 w;
#pragma unroll
        for (int j = 0; j < 8; ++j) w[j] = (short)f2bf(T[(kc * 8 + j) * 65 + n]);
        *(bf16x8*)(dst + ((size_t)(nt32 * (K >> 4) + kstep) * 64 + hh * 32 + rr) * 8) = w;
      }
    } else if (item < NWT + NADA) {
      const int it = item - NWT; const int l = it / 96, cgp = it - l * 96; const int n0 = cgp * 64;
      float* sc = (float*)smem;
      float* red = sc + 9 * 1024;
      __syncthreads();
      for (int idx = tid; idx < 9 * 1024; idx += 256) {
        const int ci = idx >> 10, k = idx & 1023;
        const float x = ci < 8 ? p.c[ci * 1024 + k] : p.c_ctx[k];
        sc[idx] = x / (1.f + expf(-x));
      }
      __syncthreads();
      const int wave = tid >> 6, lane = tid & 63;
      float acc[9];
#pragma unroll
      for (int ci = 0; ci < 9; ++ci) acc[ci] = 0.f;
      const float* wp = p.ada_w + ((size_t)l * 1024 + wave * 256) * 6144 + n0 + lane;
#pragma unroll 8
      for (int k = 0; k < 256; ++k) {
        const float wv = wp[(size_t)k * 6144];
#pragma unroll
        for (int ci = 0; ci < 9; ++ci) acc[ci] += sc[ci * 1024 + wave * 256 + k] * wv;
      }
#pragma unroll
      for (int ci = 0; ci < 9; ++ci) red[(wave * 9 + ci) * 64 + lane] = acc[ci];
      __syncthreads();
      for (int idx = tid; idx < 576; idx += 256) {
        const int ci = idx >> 6, col = idx & 63;
        const float s = red[(0 * 9 + ci) * 64 + col] + red[(1 * 9 + ci) * 64 + col] + red[(2 * 9 + ci) * 64 + col] + red[(3 * 9 + ci) * 64 + col];
        p.mods[(size_t)(l * 9 + ci) * 6144 + n0 + col] = s + p.ada_b[l * 6144 + n0 + col];
      }
    } else {
      if (tid < 8) p.cnt[tid] = 0;
      for (int i = tid; i < 8 * 8320; i += 256) p.flags[i] = 0;
      for (int idx = tid; idx < 1024; idx += 256) {
        const int pos = idx >> 4, fi = idx & 15;
        const float inv = powf(10000.f, -(float)fi / 16.f);
        const float ang = (float)pos * inv;
        p.rope[idx * 2] = cosf(ang); p.rope[idx * 2 + 1] = sinf(ang);
      }
    }
  }
}

DI void norm_phase(const P* __restrict__ gp, int l, int which, bool first, bool fin) {
  const P& p = *gp;
  int tid_ = threadIdx.x; asm volatile("" : "+v"(tid_)); const int tid = tid_, lane = tid & 63, wave = tid >> 6;
  for (int item = blockIdx.x; item < NT_ / 8; item += gridDim.x) {
    float4 v[2][4];
    float ss[2];
#pragma unroll
    for (int u = 0; u < 2; ++u) {
      const int tok = item * 8 + u * 4 + wave;
      const float* src = first ? (tok < NP_ ? p.x_prompt + (size_t)tok * 1024 : p.x_sample + (size_t)(tok - NP_) * 1024) : p.out + (size_t)tok * 1024;
#pragma unroll
      for (int i = 0; i < 4; ++i) v[u][i] = ((const float4*)src)[lane + 64 * i];
    }
#pragma unroll
    for (int u = 0; u < 2; ++u) {
      float a = 0.f;
#pragma unroll
      for (int i = 0; i < 4; ++i) a += v[u][i].x * v[u][i].x + v[u][i].y * v[u][i].y + v[u][i].z * v[u][i].z + v[u][i].w * v[u][i].w;
#pragma unroll
      for (int o = 32; o >= 1; o >>= 1) a += shx(a, lane, o);
      ss[u] = a;
    }
#pragma unroll
    for (int u = 0; u < 2; ++u) {
      const int tok = item * 8 + u * 4 + wave;
      const float rstd = rsqrtf(ss[u] * (1.f / 1024.f) + 1e-6f);
      if (fin) {
#pragma unroll
        for (int i = 0; i < 4; ++i) {
          const float4 g = ((const float4*)p.final_g)[lane + 64 * i];
          float4 y; y.x = v[u][i].x * rstd * g.x; y.y = v[u][i].y * rstd * g.y; y.z = v[u][i].z * rstd * g.z; y.w = v[u][i].w * rstd * g.w;
          ((float4*)(p.out + (size_t)tok * 1024))[lane + 64 * i] = y;
        }
      } else {
        const int ci = tok < NP_ ? 8 : (tok - NP_) >> 12;
        const float* md = p.mods + (size_t)(l * 9 + ci) * 6144 + which * 3072;
        const float* gpp = (which ? p.norm2_g : p.norm1_g) + l * 1024;
#pragma unroll
        for (int i = 0; i < 4; ++i) {
          const float4 g = ((const float4*)gpp)[lane + 64 * i];
          const float4 sh = ((const float4*)md)[lane + 64 * i];
          const float4 sc = ((const float4*)(md + 1024))[lane + 64 * i];
          ushort4 o;
          o.x = f2bf(v[u][i].x * rstd * g.x * (1.f + sc.x) + sh.x);
          o.y = f2bf(v[u][i].y * rstd * g.y * (1.f + sc.y) + sh.y);
          o.z = f2bf(v[u][i].z * rstd * g.z * (1.f + sc.z) + sh.z);
          o.w = f2bf(v[u][i].w * rstd * g.w * (1.f + sc.w) + sh.w);
          ((ushort4*)(p.hn + (size_t)tok * 1024))[lane + 64 * i] = o;
          if (first) ((float4*)(p.out + (size_t)tok * 1024))[lane + 64 * i] = v[u][i];
        }
      }
    }
  }
}

DI uint4 ldsel(const u16* pv, const u16* safe, unsigned ok) {
  uint4 t = *(const uint4*)(ok ? pv : safe);
  if (!ok) { t.x = 0; t.y = 0; t.z = 0; t.w = 0; }
  return t;
}
enum { EPI_PROJ = 0, EPI_RES = 1, EPI_FFN = 2 };

template <int EPI, int WN>
DI void gemm_phase(const P* __restrict__ gp, int l, char* smem, const u16* __restrict__ A, int lda, const u16* __restrict__ B, int ldb, int K, int MT,
                   int NTn, int gsel) {
  const P& p = *gp;
  u16* As = (u16*)smem;
  int tid_ = threadIdx.x; asm volatile("" : "+v"(tid_)); const int tid = tid_, lane = tid & 63, wave = tid >> 6, r = lane & 31, h = lane >> 5;
  const int KT = K >> 6;
  const bool even = !(l & 1); const int jj = l >> 1;
  const int ntiles = MT * NTn;
  const int nlb = gridDim.x >> 3, xcd = blockIdx.x & 7, lb = blockIdx.x >> 3;
  for (int it = 0;; ++it) {
    const int g = (it * 8 + xcd) * nlb + lb;
    if (g >= ntiles) break;
    const int SM = nlb >> 3;
    const int band = g / (SM * NTn); const int rem = g - band * SM * NTn;
    const int nt = rem / SM, mt = band * SM + (rem - nt * SM);
    int seqbase = 0, L = 0, tin0 = 0;
    if (EPI == EPI_FFN) {
      L = NT_; seqbase = 0; tin0 = mt * 126;
      if (tin0 >= NT_) continue;
    }
    const int row0 = tid >> 3, kc0 = (tid & 7) * 8;
    const long arow0 = (EPI == EPI_FFN) ? (long)seqbase + tin0 - 1 + row0 : (long)mt * 128 + row0;
    const u16* abase = A + arow0 * lda + kc0;
    unsigned avalid = 0;
#pragma unroll
    for (int i = 0; i < 4; ++i) {
      if (EPI == EPI_FFN) { const int ts = tin0 - 1 + row0 + 32 * i; if (ts >= 0 && ts < L) avalid |= 1u << i; }
      else avalid |= 1u << i;
    }
    const u16* bb0 = B + ((size_t)((nt * 4 + wave) * WN * (K >> 4)) * 64 + lane) * 8;
    const size_t bts = (size_t)(K >> 4) * 512;
    f32x16 acc[4][WN];
#pragma unroll
    for (int a = 0; a < 4; ++a)
#pragma unroll
      for (int b = 0; b < WN; ++b) zero16(acc[a][b]);
#define GLD_A(i, ko) ldsel(abase + (size_t)(32 * (i)) * lda + (ko), A, (avalid >> (i)) & 1u)
#define GLD_BF(dst, kt_) { const u16* q_ = bb0 + (size_t)(kt_) * 2048; \
      _Pragma("unroll") for (int ni_ = 0; ni_ < WN; ++ni_) { \
        dst[ni_][0] = *(const bf16x8*)(q_ + ni_ * bts); dst[ni_][1] = *(const bf16x8*)(q_ + ni_ * bts + 512); \
        dst[ni_][2] = *(const bf16x8*)(q_ + ni_ * bts + 1024); dst[ni_][3] = *(const bf16x8*)(q_ + ni_ * bts + 1536); } }
    uint4 ra0 = GLD_A(0, 0), ra1 = GLD_A(1, 0), ra2 = GLD_A(2, 0), ra3 = GLD_A(3, 0);
    uint4 sa0, sa1, sa2, sa3;
    if (WN == 1) { sa0 = GLD_A(0, 64); sa1 = GLD_A(1, 64); sa2 = GLD_A(2, 64); sa3 = GLD_A(3, 64); }
    bf16x8 bc[WN][4], bn[WN][4];
    GLD_BF(bc, 0);
    if (WN == 1) GLD_BF(bn, 1);
#define LSTORE(buf, A0, A1, A2, A3) { \
      u16* ad = As + (buf) * 9216 + row0 * 72 + kc0; \
      *(uint4*)(ad) = A0; *(uint4*)(ad + 32 * 72) = A1; *(uint4*)(ad + 64 * 72) = A2; *(uint4*)(ad + 96 * 72) = A3; }
#define COMPUTE(buf, BF, KN) { \
      const u16* Ab = As + (buf) * 9216 + r * 72 + h * 8; \
      const bool more_ = (KN) < KT; const u16* q_ = bb0 + (size_t)(KN) * 2048; \
      _Pragma("unroll") for (int ks = 0; ks < 4; ++ks) { \
        const bf16x8 a0 = *(const bf16x8*)(Ab + ks * 16); \
        const bf16x8 a1 = *(const bf16x8*)(Ab + 32 * 72 + ks * 16); \
        const bf16x8 a2 = *(const bf16x8*)(Ab + 64 * 72 + ks * 16); \
        const bf16x8 a3 = *(const bf16x8*)(Ab + 96 * 72 + ks * 16); \
        _Pragma("unroll") for (int ni_ = 0; ni_ < WN; ++ni_) { \
          acc[0][ni_] = MFMA(a0, BF[ni_][ks], acc[0][ni_]); acc[1][ni_] = MFMA(a1, BF[ni_][ks], acc[1][ni_]); \
          acc[2][ni_] = MFMA(a2, BF[ni_][ks], acc[2][ni_]); acc[3][ni_] = MFMA(a3, BF[ni_][ks], acc[3][ni_]); } \
        if (more_) { _Pragma("unroll") for (int ni_ = 0; ni_ < WN; ++ni_) BF[ni_][ks] = *(const bf16x8*)(q_ + ni_ * bts + ks * 512); } } }
    if (WN == 1) {
    LSTORE(0, ra0, ra1, ra2, ra3);
    ra0 = GLD_A(0, 128); ra1 = GLD_A(1, 128); ra2 = GLD_A(2, 128); ra3 = GLD_A(3, 128);
    __syncthreads();
    for (int kt = 0; kt < KT; kt += 2) {
      COMPUTE(0, bc, kt + 2);
      LSTORE(1, sa0, sa1, sa2, sa3);
      if (kt + 3 < KT) {
        const int ko = (kt + 3) * 64;
        sa0 = GLD_A(0, ko); sa1 = GLD_A(1, ko); sa2 = GLD_A(2, ko); sa3 = GLD_A(3, ko);
      }
      __syncthreads();
      COMPUTE(1, bn, kt + 3);
      if (kt + 2 < KT) {
        LSTORE(0, ra0, ra1, ra2, ra3);
        if (kt + 4 < KT) {
          const int ko = (kt + 4) * 64;
          ra0 = GLD_A(0, ko); ra1 = GLD_A(1, ko); ra2 = GLD_A(2, ko); ra3 = GLD_A(3, ko);
        }
      }
      __syncthreads();
    }
    } else {
      LSTORE(0, ra0, ra1, ra2, ra3);
      ra0 = GLD_A(0, 64); ra1 = GLD_A(1, 64); ra2 = GLD_A(2, 64); ra3 = GLD_A(3, 64);
      __syncthreads();
      for (int kt = 0; kt < KT; kt += 2) {
        COMPUTE(0, bc, kt + 1);
        LSTORE(1, ra0, ra1, ra2, ra3);
        if (kt + 2 < KT) { const int ko = (kt + 2) * 64; ra0 = GLD_A(0, ko); ra1 = GLD_A(1, ko); ra2 = GLD_A(2, ko); ra3 = GLD_A(3, ko); }
        __syncthreads();
        COMPUTE(1, bc, kt + 2);
        if (kt + 2 < KT) {
          LSTORE(0, ra0, ra1, ra2, ra3);
          if (kt + 3 < KT) { const int ko = (kt + 3) * 64; ra0 = GLD_A(0, ko); ra1 = GLD_A(1, ko); ra2 = GLD_A(2, ko); ra3 = GLD_A(3, ko); }
        }
        __syncthreads();
      }
    }
    if (EPI == EPI_PROJ) {
      const int N = even ? EVN : ODN;
#pragma unroll
      for (int tm = 0; tm < 4; ++tm)
#pragma unroll
        for (int tn = 0; tn < WN; ++tn) {
          const int col = nt * (128 * WN) + wave * (32 * WN) + tn * 32 + r;
          if (col < N) {
#pragma unroll
            for (int i = 0; i < 16; ++i) {
              const int row = mt * 128 + tm * 32 + crow(i, h);
              const float v = acc[tm][tn][i];
              p.proj[(size_t)row * N + col] = f2bf(v);
              if (row < NP_) {
                const int b = row >> 8, t = row & 255, d = col & 63;
                if (even) {
                  if (col >= 512 && col < 1536) {
                    const int wh = (col - 512) >> 9, hh = ((col - 512) >> 6) & 7;
                    p.out[(wh ? OFF_AV : OFF_AK) + ((size_t)(((b * 2 + jj) * 8 + hh) * 256 + t)) * 64 + d] = v;
                  }
                } else {
                  if (col >= 512 && col < 768) {
                    const int wh = (col - 512) >> 7, kv = ((col - 512) >> 6) & 1;
                    p.out[(wh ? OFF_CV : OFF_CK) + ((size_t)(((b * 2 + jj) * 2 + kv) * 256 + t)) * 64 + d] = v;
                  }
                }
              }
            }
          }
        }
    } else if (EPI == EPI_RES) {
#pragma unroll
      for (int tm = 0; tm < 4; ++tm)
#pragma unroll
        for (int tn = 0; tn < WN; ++tn) {
          const int col = nt * (128 * WN) + wave * (32 * WN) + tn * 32 + r;
#pragma unroll
          for (int i = 0; i < 16; ++i) {
            const int row = mt * 128 + tm * 32 + crow(i, h);
            const int ci = row < NP_ ? 8 : (row - NP_) >> 12;
            const float g = p.mods[(size_t)(l * 9 + ci) * 6144 + gsel * 1024 + col];
            float* xp = p.out + (size_t)row * 1024 + col;
            *xp = *xp + g * acc[tm][tn][i];
          }
        }
    } else {
      float* U = (float*)smem;
      const float* cw = p.ffn_conv + (size_t)l * 3 * 5632;
      u16* act = p.proj;
#pragma unroll
      for (int ps = 0; ps < WN; ++ps) {
        __syncthreads();
        if (WN == 1) {
#pragma unroll
          for (int tm = 0; tm < 4; ++tm)
#pragma unroll
            for (int i = 0; i < 16; ++i) U[(tm * 32 + crow(i, h)) * 132 + wave * 32 + r] = acc[tm][0][i];
        } else if ((wave & 1) == ps) {
#pragma unroll
          for (int tm = 0; tm < 4; ++tm)
#pragma unroll
            for (int tn = 0; tn < WN; ++tn)
#pragma unroll
              for (int i = 0; i < 16; ++i) U[(tm * 32 + crow(i, h)) * 132 + (wave >> 1) * 64 + tn * 32 + r] = acc[tm][tn][i];
        }
        __syncthreads();
        const int f = tid & 63, rg = tid >> 6; const int fg = nt * (64 * WN) + ps * 64 + f;
        const float wa0 = cw[fg], wa1 = cw[5632 + fg], wa2 = cw[2 * 5632 + fg];
        const float wg0 = cw[2816 + fg], wg1 = cw[5632 + 2816 + fg], wg2 = cw[2 * 5632 + 2816 + fg];
        const int rbeg = 1 + 32 * rg, rend = rg == 3 ? 126 : 32 * rg + 32;
        float ap = U[(rbeg - 1) * 132 + f], ac = U[rbeg * 132 + f];
        float gp_ = U[(rbeg - 1) * 132 + 64 + f], gc = U[rbeg * 132 + 64 + f];
        for (int rr = rbeg; rr <= rend; ++rr) {
          const int ts = tin0 - 1 + rr;
          if (ts >= L) break;
          const float an = U[(rr + 1) * 132 + f], gn = U[(rr + 1) * 132 + 64 + f];
          const bool sst = ts < NP_ ? ((ts & 255) == 0) : ((ts & 4095) == 0), sen = ts < NP_ ? ((ts & 255) == 255) : ((ts & 4095) == 4095);
          const float a = (sst ? 0.f : wa0 * ap) + wa1 * ac + (sen ? 0.f : wa2 * an);
          const float g = (sst ? 0.f : wg0 * gp_) + wg1 * gc + (sen ? 0.f : wg2 * gn);
          act[(size_t)(seqbase + ts) * 2816 + fg] = f2bf(a * siluf(g));
          ap = ac; ac = an; gp_ = gc; gc = gn;
        }
      }
      __syncthreads();
    }
  }
}

template <int MODE>
DI void attn_item(const P* __restrict__ gp, int jj, int it, char* smem) {
  const P& p = *gp;
  const u16* projp = uni(p.proj); u16* hnp = uni(p.hn); const float* ropep = uni(p.rope);
  u16* Ks = (u16*)smem; u16* Vt = Ks + 64 * 72; float* rpb_s = (float*)(Vt + 64 * 72);
  int tid_ = threadIdx.x; asm volatile("" : "+v"(tid_)); const int tid = tid_, lane = tid & 63, wave = tid >> 6, r = lane & 31, h = lane >> 5;
  constexpr bool EVENL = (MODE == 0 || MODE == 1);
  constexpr bool LAT = (MODE == 1 || MODE == 3);
  constexpr int PS = EVENL ? EVN : ODN;
  int b, hq, qb, tokbase;
  if (!LAT) { b = it >> 4; hq = (it >> 1) & 7; qb = it & 1; tokbase = b * 256; }
  else { b = it >> 8; hq = (it >> 5) & 7; qb = it & 31; tokbase = NP_ + b * 4096; }
  const int hk = EVENL ? hq : (hq >> 2);
  const int kcol = 512 + hk * 64, vcol = (EVENL ? 1024 : 640) + hk * 64, qcol = hq * 64;
  const int tq = qb * 128 + wave * 32 + r;
  const size_t qtok = (size_t)tokbase + tq;
  __syncthreads();
  if (MODE == 1) { for (int i = tid; i < 465; i += 256) rpb_s[i] = p.a_rpb[(size_t)(jj * 8 + hq) * 465 + i] * 1.4426950408889634f; }
  bf16x8 qf[4];
#pragma unroll
  for (int s = 0; s < 4; ++s) qf[s] = *(const bf16x8*)(projp + qtok * PS + qcol + 16 * s + 8 * h);
  if (MODE == 3) {
    const int prow = tq >> 6, pcol = tq & 63;
#pragma unroll
    for (int half = 0; half < 2; ++half) {
      const int pos = half ? pcol : prow;
#pragma unroll
      for (int j = 0; j < 8; ++j) {
        const float cs = ropep[(pos * 16 + 8 * h + j) * 2], sn = ropep[(pos * 16 + 8 * h + j) * 2 + 1];
        const float x1 = bf2f((u16)qf[2 * half][j]), x2 = bf2f((u16)qf[2 * half + 1][j]);
        qf[2 * half][j] = (short)f2bf(x1 * cs - x2 * sn);
        qf[2 * half + 1][j] = (short)f2bf(x1 * sn + x2 * cs);
      }
    }
  }
  float m_run = -1e30f, l_run = 0.f;
  if (MODE == 2 || MODE == 3) { m_run = p.c_sink[jj * 8 + hq] * 1.4426950408889634f; l_run = h == 0 ? 1.f : 0.f; }
  f32x16 ot[2]; zero16(ot[0]); zero16(ot[1]);
  int loc0 = 0, nloc = 0;
  if (MODE == 1) {
    const int qi0 = 2 * qb;
    const int rlo = min(max(qi0 - 4, 0), 56), rhi = min(max(qi0 + 1 - 4, 0), 56) + 7;
    loc0 = rlo; nloc = rhi - rlo + 1;
  } else if (MODE == 3) {
    loc0 = max(0, 2 * qb - 2); nloc = min(63, 2 * qb + 3) - loc0 + 1;
  }
  const int qi = tq >> 6, qw = tq & 63;
  const int r0w = min(max(qi - 4, 0), 56), c0w = min(max(qw - 8, 0), 48);
  const int key = tid >> 2, seg = tid & 3;
  for (int kb = 0; kb < 4 + nloc; ++kb) {
    const bool isctx = kb < 4;
    const int blk = isctx ? kb : loc0 + kb - 4;
    __syncthreads();
    {
      float kf[16], vf[16];
      if (LAT && isctx) {
        const float* kc = (MODE == 1) ? p.cache_a_k + ((size_t)((b * 2 + jj) * 8 + hk)) * 16384 : p.cache_c_k + ((size_t)((b * 2 + jj) * 2 + hk)) * 16384;
        const float* vc = (MODE == 1) ? p.cache_a_v + ((size_t)((b * 2 + jj) * 8 + hk)) * 16384 : p.cache_c_v + ((size_t)((b * 2 + jj) * 2 + hk)) * 16384;
        const float4* kp4 = (const float4*)(kc + (size_t)(blk * 64 + key) * 64 + seg * 16);
        const float4* vp4 = (const float4*)(vc + (size_t)(blk * 64 + key) * 64 + seg * 16);
#pragma unroll
        for (int e = 0; e < 4; ++e) {
          const float4 a = kp4[e], c = vp4[e];
          kf[4 * e] = a.x; kf[4 * e + 1] = a.y; kf[4 * e + 2] = a.z; kf[4 * e + 3] = a.w;
          vf[4 * e] = c.x; vf[4 * e + 1] = c.y; vf[4 * e + 2] = c.z; vf[4 * e + 3] = c.w;
        }
      } else {
        const u16* rowp = projp + ((size_t)tokbase + blk * 64 + key) * PS;
        const bf16x8 k0 = *(const bf16x8*)(rowp + kcol + seg * 16), k1 = *(const bf16x8*)(rowp + kcol + seg * 16 + 8);
        const bf16x8 v0 = *(const bf16x8*)(rowp + vcol + seg * 16), v1 = *(const bf16x8*)(rowp + vcol + seg * 16 + 8);
#pragma unroll
        for (int e = 0; e < 8; ++e) { kf[e] = bf2f((u16)k0[e]); kf[8 + e] = bf2f((u16)k1[e]); vf[e] = bf2f((u16)v0[e]); vf[8 + e] = bf2f((u16)v1[e]); }
        if (MODE == 3) {
          const bf16x8 p0 = *(const bf16x8*)(rowp + kcol + (seg ^ 1) * 16), p1 = *(const bf16x8*)(rowp + kcol + (seg ^ 1) * 16 + 8);
          const int pos = (seg & 2) ? key : blk;
#pragma unroll
          for (int e = 0; e < 16; ++e) {
            const float pr = bf2f((u16)(e < 8 ? p0[e & 7] : p1[e & 7]));
            const float cs = ropep[(pos * 16 + e) * 2], sn = ropep[(pos * 16 + e) * 2 + 1];
            kf[e] = (seg & 1) ? (pr * sn + kf[e] * cs) : (kf[e] * cs - pr * sn);
          }
        }
      }
      bf16x8 o0, o1;
#pragma unroll
      for (int e = 0; e < 8; ++e) { o0[e] = (short)f2bf(kf[e]); o1[e] = (short)f2bf(kf[8 + e]); }
      *(bf16x8*)(Ks + key * 72 + seg * 16) = o0;
      *(bf16x8*)(Ks + key * 72 + seg * 16 + 8) = o1;
#pragma unroll
      for (int e = 0; e < 16; ++e) Vt[(seg * 16 + e) * 72 + key] = f2bf(vf[e]);
    }
    __syncthreads();
    bool active = true;
    if (MODE == 1 && !isctx) active = (blk >= r0w && blk < r0w + 8);
    if (active) {
      f32x16 st[2]; zero16(st[0]); zero16(st[1]);
#pragma unroll
      for (int kt = 0; kt < 2; ++kt)
#pragma unroll
        for (int s = 0; s < 4; ++s) {
          const bf16x8 a = *(const bf16x8*)(Ks + (kt * 32 + r) * 72 + 16 * s + 8 * h);
          st[kt] = MFMA(a, qf[s], st[kt]);
        }
      float mx = m_run;
#pragma unroll
      for (int kt = 0; kt < 2; ++kt)
#pragma unroll
        for (int i = 0; i < 16; ++i) {
          float s = st[kt][i] * (0.125f * 1.4426950408889634f);
          const int kk = kt * 32 + crow(i, h);
          if (MODE == 1 && !isctx) {
            const bool ok = (kk >= c0w && kk < c0w + 16);
            s = ok ? s + rpb_s[(blk - qi + 7) * 31 + (kk - qw + 15)] : -1e30f;
          }
          if (MODE == 3 && !isctx) {
            const int dlt = blk * 64 + kk - tq;
            s = (dlt <= 128 && dlt >= -128) ? s : -1e30f;
          }
          st[kt][i] = s;
          mx = fmaxf(mx, s);
        }
      mx = fmaxf(mx, shx(mx, lane, 32));
      const float alpha = __builtin_amdgcn_exp2f(m_run - mx);
      m_run = mx;
      float ps = 0.f;
#pragma unroll
      for (int kt = 0; kt < 2; ++kt)
#pragma unroll
        for (int i = 0; i < 16; ++i) { const float pv = __builtin_amdgcn_exp2f(st[kt][i] - mx); st[kt][i] = pv; ps += pv; }
      l_run = l_run * alpha + ps;
#pragma unroll
      for (int dt = 0; dt < 2; ++dt)
#pragma unroll
        for (int i = 0; i < 16; ++i) ot[dt][i] *= alpha;
#pragma unroll
      for (int kt = 0; kt < 2; ++kt) {
        const bf16x8 pb0 = packs<0>(st[kt]), pb1 = packs<1>(st[kt]);
#pragma unroll
        for (int dt = 0; dt < 2; ++dt) {
          const bf16x8 pa0 = ld2x4(Vt + (dt * 32 + r) * 72 + kt * 32 + 4 * h);
          const bf16x8 pa1 = ld2x4(Vt + (dt * 32 + r) * 72 + kt * 32 + 16 + 4 * h);
          ot[dt] = MFMA(pa0, pb0, ot[dt]);
          ot[dt] = MFMA(pa1, pb1, ot[dt]);
        }
      }
    }
  }
  l_run += shx(l_run, lane, 32);
  const float inv = 1.f / l_run;
  u16* dst = hnp + qtok * 1024 + qcol;
#pragma unroll
  for (int dt = 0; dt < 2; ++dt)
#pragma unroll
    for (int g4 = 0; g4 < 4; ++g4) {
      ushort4 o;
      o.x = f2bf(ot[dt][4 * g4] * inv); o.y = f2bf(ot[dt][4 * g4 + 1] * inv); o.z = f2bf(ot[dt][4 * g4 + 2] * inv); o.w = f2bf(ot[dt][4 * g4 + 3] * inv);
      *(ushort4*)(dst + dt * 32 + 8 * g4 + 4 * h) = o;
    }
}

struct ChainId { int lat, b, h, dir, T, base, nch; };
DI ChainId chain_decode(int it) {
  ChainId c; c.lat = it < 128; const int q = c.lat ? it : it - 128;
  c.b = q >> 4; c.h = (q >> 1) & 7; c.dir = q & 1; c.T = c.lat ? 4096 : 256; c.base = c.lat ? NP_ + c.b * 4096 : c.b * 256; c.nch = c.T >> 6;
  return c;
}
DI int tokof(const ChainId& c, int step, int row) { const int pp = step * 64 + row; return c.base + (c.dir ? c.T - 1 - pp : pp); }


static constexpr int RING = 4;
static constexpr int SLOT_BYTES = 53760;
DI void wait_ge(int* flag, int val, int tid) {
  if (tid < 64) {
    if (tid == 0) { while (__hip_atomic_load(flag, __ATOMIC_RELAXED, __HIP_MEMORY_SCOPE_AGENT) < val) __builtin_amdgcn_s_sleep(1); }
    __builtin_amdgcn_fence(__ATOMIC_ACQUIRE, "agent");
  }
  __syncthreads();
}
DI void publish(int* flag, int val, int tid) {
  asm volatile("s_waitcnt vmcnt(0)" ::: "memory");
  __syncthreads();
  if (tid == 0) __hip_atomic_store(flag, val, __ATOMIC_RELAXED, __HIP_MEMORY_SCOPE_AGENT);
}
typedef __attribute__((ext_vector_type(4))) unsigned u32x4;
DI void copy_out(const char* lds, char* g, int bytes, int tid) {
  for (int i = opq(tid) * 16; i < bytes; i += 256 * 16) {
    const u32x4 v = *(const u32x4*)(lds + i);
    char* dst = g + i;
    asm volatile("global_store_dwordx4 %0, %1, off sc0 sc1" :: "v"(dst), "v"(v) : "memory");
  }
}
template <int BYTES>
DI void copy_in_t(char* lds, const char* g, int tid) {
  constexpr int N = (BYTES + 4095) / 4096;
  const int t16 = opq(tid) * 16;
  uint4 v[N];
#pragma unroll
  for (int j = 0; j < N; ++j) { const int i = t16 + j * 4096; v[j] = make_uint4(0, 0, 0, 0); if (i < BYTES) v[j] = *(const uint4*)(g + i); }
#pragma unroll
  for (int j = 0; j < N; ++j) { const int i = t16 + j * 4096; if (i < BYTES) *(uint4*)(lds + i) = v[j]; }
}

template <int ROLE>
DI void gla_chain(const P* __restrict__ gp, int jj, int it, char* smem, int k0, int kstep, int fs = 0) {
  const P& p = *gp;
  const ChainId cid = chain_decode(it);
  int tid_ = threadIdx.x; asm volatile("" : "+v"(tid_)); const int tid = tid_, lane = tid & 63, wave = tid >> 6, r = lane & 31, h = lane >> 5;
  const int hh = cid.h, dir = cid.dir;
  u16* QT = (u16*)smem; u16* KT = QT + 4608; u16* KEt = KT + 4608; u16* Vt = KEt + 4608;
  float* dec = (float*)(Vt + 4608); float* GL = dec + 64; float* gq = GL + 1024; float* Ost = gq + 256;
  constexpr int IMG = 4 * 9216 + 256;
  char* slots = uni(p.ring) + (size_t)it * RING * SLOT_BYTES; int* ready = uni(p.flags) + (jj * 2 + 4 * fs) * 8320 + it * 64; int* done = uni(p.flags) + (jj * 2 + 4 * fs) * 8320 + 8192 + it;
  const int d = tid & 63, cq = tid >> 6;
  float wg[16];
#pragma unroll
  for (int rr = 0; rr < 16; ++rr) wg[rr] = p.b_w_g2[((size_t)((jj * 2 + dir) * 16 + rr)) * 512 + hh * 64 + d];
  const float bg = p.b_b_g[(jj * 2 + dir) * 512 + hh * 64 + d];
  const int vh = wave & 1;
  f32x16 S[2]; zero16(S[0]); zero16(S[1]);
  const size_t sidx = ((size_t)(((cid.b * 2 + jj) * 2 + dir) * 8 + hh)) * 4096;
  if (ROLE != 1 && wave < 2 && cid.lat) {
#pragma unroll
    for (int dt = 0; dt < 2; ++dt)
#pragma unroll
      for (int i = 0; i < 16; ++i) S[dt][i] = p.state_b[sidx + (dt * 32 + crow(i, h)) * 64 + vh * 32 + r];
  }
  for (int step_ = k0; step_ < cid.nch; step_ += kstep) {
    int step = step_;
    asm volatile("" : "+v"(step));
    if (ROLE == 1) wait_ge(done, step_ - RING + 1, tid);
    if (ROLE == 2) wait_ge(ready + step_, 1, tid);
    __syncthreads();
    if (ROLE == 2) { copy_in_t<IMG>(smem, slots + (size_t)(step_ % RING) * SLOT_BYTES, tid); __syncthreads(); if (tid == 0) __hip_atomic_store(done, step_ + 1, __ATOMIC_RELAXED, __HIP_MEMORY_SCOPE_AGENT); }
    if (ROLE != 2) {
    {
      const int c = tid >> 2, sg = tid & 3;
      const int tok = tokof(cid, step, c);
      const ushort4 gv = *(const ushort4*)(p.proj + (size_t)tok * EVN + 3072 + dir * 16 + sg * 4);
      GL[c * 16 + sg * 4] = bf2f(gv.x); GL[c * 16 + sg * 4 + 1] = bf2f(gv.y); GL[c * 16 + sg * 4 + 2] = bf2f(gv.z); GL[c * 16 + sg * 4 + 3] = bf2f(gv.w);
    }
    __syncthreads();
    float Gl[16]; float run = 0.f;
#pragma unroll
    for (int i = 0; i < 16; ++i) {
      const int c = cq * 16 + i;
      float z = bg;
#pragma unroll
      for (int rr = 0; rr < 16; ++rr) z += GL[c * 16 + rr] * wg[rr];
      const float g = (fminf(z, 0.f) - __logf(1.f + __expf(-fabsf(z)))) * (1.f / 16.f);
      run += g; Gl[i] = run;
    }
    gq[cq * 64 + d] = run;
    __syncthreads();
    float off = 0.f, tot = 0.f;
#pragma unroll
    for (int q2 = 0; q2 < 4; ++q2) { const float t = gq[q2 * 64 + d]; if (q2 < cq) off += t; tot += t; }
#pragma unroll
    for (int i = 0; i < 16; ++i) {
      const int c = cq * 16 + i;
      const int tok = tokof(cid, step, c);
      const float G = Gl[i] + off;
      const u16* rowp = p.proj + (size_t)tok * EVN + hh * 64 + d;
      const float qv = bf2f(rowp[1536]), kv = bf2f(rowp[2048]);
      const u16 vb = rowp[2560];
      QT[c * 72 + d] = f2bf(qv * 0.125f * __expf(G));
      KT[c * 72 + d] = f2bf(kv * __expf(-G));
      KEt[d * 72 + c] = f2bf(kv * __expf(tot - G));
      Vt[d * 72 + c] = vb;
    }
    if (cq == 0) dec[d] = __expf(tot);
    __syncthreads();
    }
    if (ROLE == 1) { copy_out(smem, slots + (size_t)(step_ % RING) * SLOT_BYTES, IMG, tid); publish(ready + step_, 1, tid); continue; }
    if (wave < 2) {
      f32x16 at[2][2];
#pragma unroll
      for (int a = 0; a < 2; ++a)
#pragma unroll
        for (int b2 = 0; b2 < 2; ++b2) zero16(at[a][b2]);
#pragma unroll
      for (int ks = 0; ks < 4; ++ks) {
        const bf16x8 a0 = *(const bf16x8*)(KT + r * 72 + ks * 16 + 8 * h), a1 = *(const bf16x8*)(KT + (32 + r) * 72 + ks * 16 + 8 * h);
        const bf16x8 b0 = *(const bf16x8*)(QT + r * 72 + ks * 16 + 8 * h), b1 = *(const bf16x8*)(QT + (32 + r) * 72 + ks * 16 + 8 * h);
        at[0][0] = MFMA(a0, b0, at[0][0]); at[0][1] = MFMA(a0, b1, at[0][1]);
        at[1][0] = MFMA(a1, b0, at[1][0]); at[1][1] = MFMA(a1, b1, at[1][1]);
      }
#pragma unroll
      for (int st = 0; st < 2; ++st)
#pragma unroll
        for (int ct = 0; ct < 2; ++ct)
#pragma unroll
          for (int i = 0; i < 16; ++i) { if (st * 32 + crow(i, h) > ct * 32 + r) at[st][ct][i] = 0.f; }
      f32x16 o[2]; zero16(o[0]); zero16(o[1]);
#pragma unroll
      for (int ct = 0; ct < 2; ++ct)
#pragma unroll
        for (int st = 0; st < 2; ++st) {
          const bf16x8 x0 = packs<0>(at[st][ct]), x1 = packs<1>(at[st][ct]);
          const bf16x8 pb0 = ld2x4(Vt + (vh * 32 + r) * 72 + st * 32 + 4 * h);
          const bf16x8 pb1 = ld2x4(Vt + (vh * 32 + r) * 72 + st * 32 + 16 + 4 * h);
          o[ct] = MFMA(x0, pb0, o[ct]);
          o[ct] = MFMA(x1, pb1, o[ct]);
        }
#pragma unroll
      for (int dt = 0; dt < 2; ++dt) {
        const bf16x8 xs0 = packs<0>(S[dt]), xs1 = packs<1>(S[dt]);
#pragma unroll
        for (int ct = 0; ct < 2; ++ct) {
          const bf16x8 pa0 = ld2x4(QT + (ct * 32 + r) * 72 + dt * 32 + 4 * h);
          const bf16x8 pa1 = ld2x4(QT + (ct * 32 + r) * 72 + dt * 32 + 16 + 4 * h);
          o[ct] = MFMA(pa0, xs0, o[ct]);
          o[ct] = MFMA(pa1, xs1, o[ct]);
        }
      }
#pragma unroll
      for (int dt = 0; dt < 2; ++dt)
#pragma unroll
        for (int i = 0; i < 16; ++i) S[dt][i] *= dec[dt * 32 + crow(i, h)];
#pragma unroll
      for (int ks = 0; ks < 4; ++ks) {
        const bf16x8 bv = *(const bf16x8*)(Vt + (vh * 32 + r) * 72 + ks * 16 + 8 * h);
#pragma unroll
        for (int dt = 0; dt < 2; ++dt) {
          const bf16x8 a = *(const bf16x8*)(KEt + (dt * 32 + r) * 72 + ks * 16 + 8 * h);
          S[dt] = MFMA(a, bv, S[dt]);
        }
      }
#pragma unroll
      for (int ct = 0; ct < 2; ++ct)
#pragma unroll
        for (int i = 0; i < 16; ++i) Ost[(ct * 32 + crow(i, h)) * 68 + vh * 32 + r] = o[ct][i];
    }
    __syncthreads();
    {
      const int c = tid >> 2, sg = tid & 3;
      const int tok = tokof(cid, step, c);
      u16* dst = (dir ? p.ot1 + (size_t)tok * 512 + hh * 64 : p.hn + (size_t)tok * 1024 + 512 + hh * 64) + sg * 16;
      bf16x8 w0, w1;
#pragma unroll
      for (int e = 0; e < 8; ++e) { w0[e] = (short)f2bf(Ost[c * 68 + sg * 16 + e]); w1[e] = (short)f2bf(Ost[c * 68 + sg * 16 + 8 + e]); }
      *(bf16x8*)dst = w0; *(bf16x8*)(dst + 8) = w1;
    }
  }
  if (wave < 2 && !cid.lat) {
#pragma unroll
    for (int dt = 0; dt < 2; ++dt)
#pragma unroll
      for (int i = 0; i < 16; ++i) p.out[OFF_SB + sidx + (dt * 32 + crow(i, h)) * 64 + vh * 32 + r] = S[dt][i];
  }
}

template <int ROLE>
DI void delta_chain(const P* __restrict__ gp, int jj, int it, char* smem, int k0, int kstep, int fs = 0) {
  const P& p = *gp;
  const ChainId cid = chain_decode(it);
  int tid_ = threadIdx.x; asm volatile("" : "+v"(tid_)); const int tid0 = tid_;
  const int hh = cid.h, dir = cid.dir;
  u16* Qn = (u16*)smem; u16* Kt = Qn + 4608; u16* AQK = Kt + 4608; u16* KC = AQK + 4608;
  float* Wv = (float*)(KC + 4608); float* Gs = Wv + 64 * 65; u16* Kn = (u16*)(Gs + 64); float* At = (float*)(Kn + 4608); float* Bt = At + 64 * 68;
  constexpr int IMG = 4 * 9216 + 16640 + 256;
  char* slots = uni(p.ring) + (size_t)it * RING * SLOT_BYTES; int* ready = uni(p.flags) + (jj * 2 + 1 + 4 * fs) * 8320 + it * 64; int* done = uni(p.flags) + (jj * 2 + 1 + 4 * fs) * 8320 + 8192 + it;
  const float aexp = __expf(p.d_a_log[(jj * 2 + dir) * 8 + hh]);
  const float dtb = p.d_dt_bias[(jj * 2 + dir) * 8 + hh];
  f32x16 S[2]; zero16(S[0]); zero16(S[1]);
  const size_t sidx = ((size_t)(((cid.b * 2 + jj) * 2 + dir) * 8 + hh)) * 4096;
  { const int tid = tid0, lane = tid & 63, wave = tid >> 6, r = lane & 31, h = lane >> 5;
  if (ROLE != 1 && wave < 2 && cid.lat) {
    const int vh = wave & 1;
#pragma unroll
    for (int dt = 0; dt < 2; ++dt)
#pragma unroll
      for (int i = 0; i < 16; ++i) S[dt][i] = p.state_d[sidx + (dt * 32 + crow(i, h)) * 64 + vh * 32 + r];
  }
  }
  u16* CW = (u16*)(smem + 80640);
  __syncthreads();
  for (int i = tid0; i < 576; i += 256) { const int tap = i / 192, c2 = i - tap * 192; const int wh = c2 >> 6, dd = c2 & 63;
    CW[i] = f2bf(p.d_conv[(size_t)jj * 3 * 1536 + tap * 1536 + wh * 512 + hh * 64 + dd]); }
  for (int step_ = k0; step_ < cid.nch; step_ += kstep) {
    int step = step_;
    asm volatile("" : "+v"(step));
    if (ROLE == 1) wait_ge(done, step_ - RING + 1, tid0);
    if (ROLE == 2) wait_ge(ready + step_, 1, tid0);
    __syncthreads();
    if (ROLE == 2) { copy_in_t<IMG>(smem, slots + (size_t)(step_ % RING) * SLOT_BYTES, tid0); __syncthreads(); if (tid0 == 0) __hip_atomic_store(done, step_ + 1, __ATOMIC_RELAXED, __HIP_MEMORY_SCOPE_AGENT); }
    if (ROLE != 2) {
    {const int tid = opq(tid0), lane = tid & 63, wave = __builtin_amdgcn_readfirstlane(tid >> 6), r = lane & 31, h = lane >> 5, vh = wave & 1; (void)r; (void)h; (void)vh; (void)lane;
    if (wave == 0) {
      const int tok = tokof(cid, step, lane);
      const float da = bf2f(p.proj[(size_t)tok * ODN + 2304 + dir * 8 + hh]);
      const float db = bf2f(p.proj[(size_t)tok * ODN + 2320 + dir * 8 + hh]);
      const float x = da + dtb;
      const float sp = x > 20.f ? x : __logf(1.f + __expf(x));
      float G = -aexp * sp;
#pragma unroll
      for (int o = 1; o < 64; o <<= 1) { const float t = __int_as_float(__builtin_amdgcn_ds_bpermute((lane - o) << 2, __float_as_int(G))); if (lane >= o) G += t; }
      Gs[lane] = G; Bt[lane] = 1.f / (1.f + __expf(-db));
    }
    {
      const int c = tid >> 2, sg = tid & 3;
      const int tok = tokof(cid, step, c);
      const int pos = tok - cid.base;
      const bool hp = pos > 0, hn_ = pos < cid.T - 1;
#pragma unroll 1
      for (int wh = 0; wh < 3; ++wh) {
        const int ch0 = wh * 512 + hh * 64 + sg * 16;
        const u16* cur = p.proj + (size_t)tok * ODN + 768 + ch0;
        float y[16];
        float ss = 0.f;
#pragma unroll
        for (int hf = 0; hf < 2; ++hf) {
          const bf16x8 xc = *(const bf16x8*)(cur + hf * 8);
          bf16x8 xp, xn;
#pragma unroll
          for (int e = 0; e < 8; ++e) { xp[e] = 0; xn[e] = 0; }
          if (hp) xp = *(const bf16x8*)(cur - ODN + hf * 8);
          if (hn_) xn = *(const bf16x8*)(cur + ODN + hf * 8);
#pragma unroll
          for (int e = 0; e < 8; ++e) {
            const int ch = wh * 64 + sg * 16 + hf * 8 + e;
            float v = bf2f(CW[ch]) * bf2f((u16)xp[e]) + bf2f(CW[192 + ch]) * bf2f((u16)xc[e]) + bf2f(CW[384 + ch]) * bf2f((u16)xn[e]);
            v = v / (1.f + __expf(-v));
            y[hf * 8 + e] = v; ss += v * v;
          }
        }
        ss += shx(ss, lane, 1); ss += shx(ss, lane, 2);
        const float rn = rsqrtf(ss + 1e-6f);
        if (wh == 0) {
#pragma unroll
          for (int e = 0; e < 16; ++e) Qn[c * 72 + sg * 16 + e] = f2bf(y[e] * rn * 0.125f);
        } else if (wh == 1) {
#pragma unroll
          for (int e = 0; e < 16; ++e) { const u16 kb = f2bf(y[e] * rn); Kn[c * 72 + sg * 16 + e] = kb; Kt[(sg * 16 + e) * 72 + c] = kb; }
        } else {
#pragma unroll
          for (int e = 0; e < 16; ++e) Wv[c * 65 + sg * 16 + e] = y[e];
        }
      }
    }
    }
    __syncthreads();
    {const int tid = opq(tid0), lane = tid & 63, wave = __builtin_amdgcn_readfirstlane(tid >> 6), r = lane & 31, h = lane >> 5, vh = wave & 1; (void)r; (void)h; (void)vh; (void)lane;
    if (wave < 2) {
      f32x16 akk[2], aqk[2]; zero16(akk[0]); zero16(akk[1]); zero16(aqk[0]); zero16(aqk[1]);
#pragma unroll
      for (int ks = 0; ks < 4; ++ks) {
        const bf16x8 bk = *(const bf16x8*)(Kn + (vh * 32 + r) * 72 + ks * 16 + 8 * h);
#pragma unroll
        for (int ct = 0; ct < 2; ++ct) {
          const bf16x8 ak = *(const bf16x8*)(Kn + (ct * 32 + r) * 72 + ks * 16 + 8 * h);
          const bf16x8 aq = *(const bf16x8*)(Qn + (ct * 32 + r) * 72 + ks * 16 + 8 * h);
          akk[ct] = MFMA(ak, bk, akk[ct]);
          aqk[ct] = MFMA(aq, bk, aqk[ct]);
        }
      }
      const int s = vh * 32 + r;
      const float Gss = Gs[s];
#pragma unroll
      for (int ct = 0; ct < 2; ++ct)
#pragma unroll
        for (int g4 = 0; g4 < 4; ++g4) {
          const int c0 = ct * 32 + 8 * g4 + 4 * h;
          const float4 gv4 = *(const float4*)(Gs + c0), bv4 = *(const float4*)(Bt + c0);
          float4 val;
#pragma unroll
          for (int e = 0; e < 4; ++e) {
            const int c = c0 + e;
            const float Gc = e == 0 ? gv4.x : e == 1 ? gv4.y : e == 2 ? gv4.z : gv4.w;
            const float Bc = e == 0 ? bv4.x : e == 1 ? bv4.y : e == 2 ? bv4.z : bv4.w;
            const float gam = __expf(fminf(Gc - Gss, 0.f));
            const float av = (s < c) ? akk[ct][4 * g4 + e] * Bc * gam : 0.f;
            if (e == 0) val.x = av; else if (e == 1) val.y = av; else if (e == 2) val.z = av; else val.w = av;
            AQK[c * 72 + s] = f2bf((s <= c) ? aqk[ct][4 * g4 + e] * gam : 0.f);
          }
          *(float4*)(At + s * 68 + c0) = val;
        }
    }
    }
    __syncthreads();
    {const int tid = opq(tid0), lane = tid & 63, wave = __builtin_amdgcn_readfirstlane(tid >> 6), r = lane & 31, h = lane >> 5, vh = wave & 1; (void)r; (void)h; (void)vh; (void)lane;
    if (wave < 2) {
      const bool isv = wave == 0;
      const int col = lane;
#pragma unroll 1
      for (int bi = 0; bi < 4; ++bi) {
        float acc[16];
#pragma unroll
        for (int ci = 0; ci < 16; ++ci) {
          const int c = 16 * bi + ci;
          acc[ci] = isv ? Wv[c * 65 + col] * Bt[c] : bf2f(Kn[c * 72 + col]) * Bt[c] * __expf(Gs[c]);
        }
#pragma unroll 8
        for (int s2 = 0; s2 < 16 * bi; ++s2) {
          const float xs = isv ? Wv[s2 * 65 + col] : bf2f(KC[s2 * 72 + col]);
          const float4* a4 = (const float4*)(At + s2 * 68 + 16 * bi);
#pragma unroll
          for (int q = 0; q < 4; ++q) {
            const float4 a = a4[q];
            acc[4 * q] -= a.x * xs; acc[4 * q + 1] -= a.y * xs; acc[4 * q + 2] -= a.z * xs; acc[4 * q + 3] -= a.w * xs;
          }
        }
#pragma unroll
        for (int ci = 0; ci < 16; ++ci) {
          const float x = acc[ci];
          const float* arow = At + (16 * bi + ci) * 68 + 16 * bi;
#pragma unroll
          for (int cj = ci + 1; cj < 16; ++cj) acc[cj] -= arow[cj] * x;
          if (isv) Wv[(16 * bi + ci) * 65 + col] = x; else KC[(16 * bi + ci) * 72 + col] = f2bf(x);
        }
      }
    }
    }
    __syncthreads();
    }
    if (ROLE == 1) { copy_out(smem, slots + (size_t)(step_ % RING) * SLOT_BYTES, IMG, tid0); publish(ready + step_, 1, tid0); continue; }
    {const int tid = opq(tid0), lane = tid & 63, wave = __builtin_amdgcn_readfirstlane(tid >> 6), r = lane & 31, h = lane >> 5, vh = wave & 1; (void)r; (void)h; (void)vh; (void)lane;
    if (wave < 2) {
      f32x16 kS[2], qS[2]; zero16(kS[0]); zero16(kS[1]); zero16(qS[0]); zero16(qS[1]);
#pragma unroll
      for (int dt = 0; dt < 2; ++dt) {
        const bf16x8 xs0 = packs<0>(S[dt]), xs1 = packs<1>(S[dt]);
#pragma unroll
        for (int ct = 0; ct < 2; ++ct) {
          kS[ct] = MFMA(ld2x4(KC + (ct * 32 + r) * 72 + dt * 32 + 4 * h), xs0, kS[ct]);
          kS[ct] = MFMA(ld2x4(KC + (ct * 32 + r) * 72 + dt * 32 + 16 + 4 * h), xs1, kS[ct]);
          qS[ct] = MFMA(ld2x4(Qn + (ct * 32 + r) * 72 + dt * 32 + 4 * h), xs0, qS[ct]);
          qS[ct] = MFMA(ld2x4(Qn + (ct * 32 + r) * 72 + dt * 32 + 16 + 4 * h), xs1, qS[ct]);
        }
      }
      f32x16 vn[2], o[2];
      const float Glast = Gs[63];
#pragma unroll
      for (int ct = 0; ct < 2; ++ct)
#pragma unroll
        for (int i = 0; i < 16; ++i) {
          const int c = ct * 32 + crow(i, h);
          vn[ct][i] = Wv[c * 65 + vh * 32 + r] - kS[ct][i];
          o[ct][i] = qS[ct][i] * __expf(Gs[c]);
        }
#pragma unroll
      for (int st = 0; st < 2; ++st) {
        const bf16x8 xs0 = packs<0>(vn[st]), xs1 = packs<1>(vn[st]);
#pragma unroll
        for (int ct = 0; ct < 2; ++ct) {
          o[ct] = MFMA(ld2x4(AQK + (ct * 32 + r) * 72 + st * 32 + 4 * h), xs0, o[ct]);
          o[ct] = MFMA(ld2x4(AQK + (ct * 32 + r) * 72 + st * 32 + 16 + 4 * h), xs1, o[ct]);
        }
      }
      const float dl = __expf(Glast);
#pragma unroll
      for (int st = 0; st < 2; ++st) {
        asm volatile("" ::: "memory");
#pragma unroll
        for (int i = 0; i < 16; ++i) vn[st][i] *= __expf(Glast - Gs[st * 32 + crow(i, h)]);
      }
      asm volatile("" ::: "memory");
#pragma unroll
      for (int dt = 0; dt < 2; ++dt)
#pragma unroll
        for (int i = 0; i < 16; ++i) S[dt][i] *= dl;
#pragma unroll
      for (int st = 0; st < 2; ++st) {
        const bf16x8 xs0 = packs<0>(vn[st]), xs1 = packs<1>(vn[st]);
#pragma unroll
        for (int dt = 0; dt < 2; ++dt) {
          S[dt] = MFMA(ld2x4(Kt + (dt * 32 + r) * 72 + st * 32 + 4 * h), xs0, S[dt]);
          S[dt] = MFMA(ld2x4(Kt + (dt * 32 + r) * 72 + st * 32 + 16 + 4 * h), xs1, S[dt]);
        }
      }
#pragma unroll
      for (int ct = 0; ct < 2; ++ct)
#pragma unroll
        for (int i = 0; i < 16; ++i) At[(ct * 32 + crow(i, h)) * 68 + vh * 32 + r] = o[ct][i];
    }
    }
    __syncthreads();
    {
      const int tid = opq(tid0);
      const int c = tid >> 2, sg = tid & 3;
      const int tok = tokof(cid, step, c);
      u16* dst = (dir ? p.ot1 + (size_t)tok * 512 + hh * 64 : p.hn + (size_t)tok * 1024 + 512 + hh * 64) + sg * 16;
      bf16x8 w0, w1;
#pragma unroll
      for (int e = 0; e < 8; ++e) { w0[e] = (short)f2bf(At[c * 68 + sg * 16 + e]); w1[e] = (short)f2bf(At[c * 68 + sg * 16 + 8 + e]); }
      *(bf16x8*)dst = w0; *(bf16x8*)(dst + 8) = w1;
    }
  }
  {const int tid = opq(tid0), lane = tid & 63, wave = __builtin_amdgcn_readfirstlane(tid >> 6), r = lane & 31, h = lane >> 5, vh = wave & 1; (void)r; (void)h; (void)vh; (void)lane;
  if (wave < 2 && !cid.lat) {
#pragma unroll
    for (int dt = 0; dt < 2; ++dt)
#pragma unroll
      for (int i = 0; i < 16; ++i) p.out[OFF_SD + sidx + (dt * 32 + crow(i, h)) * 64 + vh * 32 + r] = S[dt][i];
  }
}
}

DI void mixer_phase(const P* __restrict__ gp, int l, char* smem, int fs = 0) {
  const P& p = *gp;
  const bool even = !(l & 1); const int jj = l >> 1;
  const bool teams = gridDim.x >= 512;
  if (teams) {
    const int bid = blockIdx.x;
    const int K = 3;
    if (bid < 128 * (K + 1)) {
      if (bid < 128) { if (even) gla_chain<2>(gp, jj, bid, smem, 0, 1, fs); else delta_chain<2>(gp, jj, bid, smem, 0, 1, fs); }
      else { const int ch = (bid - 128) & 127, k = (bid - 128) >> 7; if (even) gla_chain<1>(gp, jj, ch, smem, k, K, fs); else delta_chain<1>(gp, jj, ch, smem, k, K, fs); }
    }
  }
  const int first = teams ? 128 : 0;
  const int total = 384 + 2048 + 256;
  int* s_item = (int*)(smem + SMEM_BYTES - 16);
  int* cntp = uni(p.cnt) + l + 4 * fs;
  for (;;) {
    __syncthreads();
    if (opq(threadIdx.x) == 0) *s_item = atomicAdd(cntp, 1) + first;
    __syncthreads();
    const int item = __builtin_amdgcn_readfirstlane(*s_item);
    if (item >= total) break;
    if (item < 384) { if (even) gla_chain<0>(gp, jj, item, smem, 0, 1); else delta_chain<0>(gp, jj, item, smem, 0, 1); }
    else if (item < 384 + 2048) { if (even) attn_item<1>(gp, jj, item - 384, smem); else attn_item<3>(gp, jj, item - 384, smem); }
    else { if (even) attn_item<0>(gp, jj, item - 384 - 2048, smem); else attn_item<2>(gp, jj, item - 384 - 2048, smem); }
  }
}

DI void finalize_phase(const P* __restrict__ gp, int l) {
  const P& p = *gp;
  const bool even = !(l & 1); const int jj = l >> 1;
  int tid_ = threadIdx.x; asm volatile("" : "+v"(tid_)); const int tid = tid_;
  const int tk = tid >> 5, hh = (tid >> 2) & 7, sg = tid & 3;
  const int PS = even ? EVN : ODN; const int zcol = even ? 3104 : 2336;
  for (int item = blockIdx.x; item < NT_ / 8; item += gridDim.x) {
    const size_t tok = (size_t)item * 8 + tk;
    u16* a = p.hn + tok * 1024 + 512 + hh * 64 + sg * 16;
    const u16* bsrc = p.ot1 + tok * 512 + hh * 64 + sg * 16;
    const u16* zs = p.proj + tok * PS + zcol + hh * 64 + sg * 16;
    float o[16]; float ss = 0.f;
#pragma unroll
    for (int hf = 0; hf < 2; ++hf) {
      const bf16x8 x0 = *(const bf16x8*)(a + hf * 8), x1 = *(const bf16x8*)(bsrc + hf * 8);
#pragma unroll
      for (int e = 0; e < 8; ++e) { const float v = bf2f((u16)x0[e]) + bf2f((u16)x1[e]); o[hf * 8 + e] = v; ss += v * v; }
    }
    ss += shx(ss, tid & 63, 1); ss += shx(ss, tid & 63, 2);
    const float rstd = rsqrtf(ss * (1.f / 64.f) + 1e-6f);
    const float* ng = even ? p.b_norm_g + jj * 512 + hh * 64 + sg * 16 : p.d_norm_g + jj * 64 + sg * 16;
#pragma unroll
    for (int hf = 0; hf < 2; ++hf) {
      const bf16x8 z = *(const bf16x8*)(zs + hf * 8);
      bf16x8 w;
#pragma unroll
      for (int e = 0; e < 8; ++e) { const float zz = bf2f((u16)z[e]); w[e] = (short)f2bf(o[hf * 8 + e] * rstd * ng[hf * 8 + e] * siluf(zz)); }
      *(bf16x8*)(a + hf * 8) = w;
    }
  }
}


#define XB_TMO      128
#define XB_XCNT(j)  (256  + 64 * (j))
#define XB_XSUB(j)  (1280 + 64 * (j))
#define XB_XGEN(j)  (2304 + 64 * (j))
#define XB_TOP      3328
#define XB_TOPGEN   3392
#define XCD_BAR_WORDS 3456
#define XB_SPIN_CAP (1u << 18)
#define LAS __attribute__((address_space(3)))
DI unsigned xb_ld(unsigned* q)              { return __hip_atomic_load(q, __ATOMIC_RELAXED, __HIP_MEMORY_SCOPE_AGENT); }
DI unsigned xb_add(unsigned* q, unsigned v) { return __hip_atomic_fetch_add(q, v, __ATOMIC_RELAXED, __HIP_MEMORY_SCOPE_AGENT); }
DI unsigned xb_xcc_id() { return (unsigned)__builtin_amdgcn_s_getreg((3 << 11) | 20) & 0xFu; }
#define XB_SPIN(cond, bar) do { unsigned _sp = 0; while (cond) { __builtin_amdgcn_s_sleep(1); \
    if ((++_sp & 255u) == 0u) { if (xb_ld(&(bar)[XB_TMO])) break; if (_sp > XB_SPIN_CAP) { atomicAdd(&(bar)[XB_TMO], 1u); break; } } } } while (0)
struct XcdBarrier { unsigned* bar; unsigned x; volatile LAS unsigned* st; };
DI XcdBarrier xcd_barrier_post(unsigned* bar, volatile LAS unsigned* st) {
  XcdBarrier b; b.bar = bar; b.x = xb_xcc_id(); b.st = st;
  if (threadIdx.x == 0) (void)xb_add(&bar[XB_XCNT(b.x)], 1u);
  return b;
}
DI void xcd_barrier_complete(unsigned* bar, unsigned x, unsigned& nloc, unsigned& nx) {
  const unsigned G = gridDim.x * gridDim.y * gridDim.z;
  unsigned sum, cnt, mine, sp = 0u;
  for (;;) {
    sum = 0u; cnt = 0u; mine = 0u;
#pragma unroll
    for (unsigned j = 0; j < 16; ++j) { const unsigned c = xb_ld(&bar[XB_XCNT(j)]); sum += c; cnt += (c > 0u) ? 1u : 0u; mine = (j == x) ? c : mine; }
    if (sum == G) break;
    __builtin_amdgcn_s_sleep(1);
    if ((++sp & 255u) == 0u) { if (xb_ld(&bar[XB_TMO])) break; if (sp > XB_SPIN_CAP) { atomicAdd(&bar[XB_TMO], 1u); break; } }
  }
  nloc = mine > 0u ? mine : 1u; nx = cnt > 0u ? cnt : 1u;
}
DI void xcd_barrier(const XcdBarrier& b) {
  asm volatile("s_waitcnt vmcnt(0)" ::: "memory");
  __syncthreads();
  if (threadIdx.x == 0) {
    unsigned* bar = b.bar;
    __builtin_amdgcn_s_waitcnt(0);
    unsigned nloc = b.st[0], nx = b.st[1];
    if (nloc == 0u) { xcd_barrier_complete(bar, b.x, nloc, nx); b.st[0] = nloc; b.st[1] = nx; }
    const unsigned old = xb_add(&bar[XB_XSUB(b.x)], 1u);
    const unsigned gen = old / nloc;
    if (old + 1u == (gen + 1u) * nloc) {
      __builtin_amdgcn_fence(__ATOMIC_RELEASE, "agent");
      asm volatile("s_waitcnt vmcnt(0)" ::: "memory");
      const unsigned og = xb_add(&bar[XB_TOP], 1u);
      const unsigned tg = og / nx;
      if (og + 1u == (tg + 1u) * nx) xb_add(&bar[XB_TOPGEN], 1u);
      else XB_SPIN(xb_ld(&bar[XB_TOPGEN]) == tg, bar);
      __builtin_amdgcn_fence(__ATOMIC_ACQUIRE, "agent");
      xb_add(&bar[XB_XGEN(b.x)], 1u);
      asm volatile("s_waitcnt vmcnt(0)" ::: "memory");
    } else {
      XB_SPIN(xb_ld(&bar[XB_XGEN(b.x)]) == gen, bar);
      __builtin_amdgcn_fence(__ATOMIC_ACQUIRE, "agent");
      asm volatile("s_waitcnt vmcnt(0)" ::: "memory");
    }
  }
  __syncthreads();
}

DI void run_phase(const P* __restrict__ gp, int ph, char* smem) {
  const P& p = *gp;
  if (ph == 0) { prep_phase(gp, smem); return; }
  if (ph == NPH - 1) { norm_phase(gp, 0, 0, false, true); return; }
  const int l = (ph - 1) >> 3, s = (ph - 1) & 7;
  const bool even = !(l & 1);
  const u16* W = uni(p.wt) + (size_t)l * LW;
  const u16* hnp = uni(p.hn); const u16* projp = uni(p.proj);
  switch (s) {
    case 0: norm_phase(gp, l, 0, l == 0, false); break;
    case 1: gemm_phase<EPI_PROJ, 2>(gp, l, smem, hnp, 1024, W + WO_IN, 1024, 1024, 288, even ? 15 : 12, 0); break;
    case 2: mixer_phase(gp, l, smem); break;
    case 3: finalize_phase(gp, l); break;
    case 4: gemm_phase<EPI_RES, 1>(gp, l, smem, hnp, 1024, W + WO_OUT, 1024, 1024, 288, 8, 2); break;
    case 5: norm_phase(gp, l, 1, false, false); break;
    case 6: gemm_phase<EPI_FFN, 2>(gp, l, smem, hnp, 1024, W + WO_UP, 1024, 1024, 296, 22, 0); break;
    case 7: gemm_phase<EPI_RES, 1>(gp, l, smem, projp, 2816, W + WO_DN, 2816, 2816, 288, 8, 5); break;
  }
}

__global__ void __launch_bounds__(256, 2) mk(P p, P* gpmem, int ph0, int ph1) {
  __shared__ __attribute__((aligned(16))) char smem[SMEM_BYTES];
  const P* gp = &p;
  if (ph1 - ph0 > 1) {
    cg::grid_group grid = cg::this_grid();
    volatile LAS unsigned* xst = (volatile LAS unsigned*)(smem + SMEM_BYTES - 32);
    if (threadIdx.x == 0) { xst[0] = 0u; xst[1] = 0u; }
    __syncthreads();
    const XcdBarrier xbar = xcd_barrier_post(p.bar, xst);
    for (int ph = ph0; ph < ph1; ++ph) {
      run_phase(gp, ph, smem);
      if (ph + 1 < ph1) { if (ph1 > NPH) grid.sync(); else xcd_barrier(xbar); }
    }
  } else {
    run_phase(gp, ph0, smem);
  }
}

extern "C" void kernel_launch(void* const* d_in, const int* in_sizes, int n_in, void* d_out, int out_size, void* d_ws, size_t ws_size,
                              hipStream_t stream) {
  P p{};
  const float** f = (const float**)&p;
  for (int i = 0; i < 31; ++i) f[i] = (const float*)d_in[i];
  p.out = (float*)d_out;
  char* ws = (char*)d_ws;
  size_t off = 0;
  p.hn = (u16*)(ws + off); off += (size_t)NT_ * 1024 * 2;
  p.proj = (u16*)(ws + off); off += (size_t)NT_ * EVN * 2;
  p.ot1 = (u16*)(ws + off); off += (size_t)NT_ * 512 * 2;
  p.wt = (u16*)(ws + off); off += 4 * LW * 2;
  p.mods = (float*)(ws + off); off += 4 * 9 * 6144 * 4;
  p.rope = (float*)(ws + off); off += 64 * 16 * 2 * 4;
  P* gp = (P*)(ws + off); off += 4096;
  p.cnt = (int*)(ws + off); off += 256;
  p.flags = (int*)(ws + off); off += 8 * 8320 * 4;
  off = (off + 255) & ~(size_t)255;
  p.ring = ws + off; off += (size_t)128 * RING * SLOT_BYTES;
  p.bar = (unsigned*)(ws + off); off += XCD_BAR_WORDS * 4;
  static int grid_blocks = 0;
  if (!grid_blocks) {
    int dev = 0, cus = 0, per_cu = 0;
    hipGetDevice(&dev);
    hipDeviceGetAttribute(&cus, hipDeviceAttributeMultiprocessorCount, dev);
    hipOccupancyMaxActiveBlocksPerMultiprocessor(&per_cu, mk, 256, 0);
    if (per_cu < 1) per_cu = 1;
    if (per_cu > 2) per_cu = 2;
    grid_blocks = cus * per_cu;
  }
#if MK_MULTI
  for (int ph = 0; ph < NPH; ++ph) {
    int a = ph, b = ph + 1;
    hipLaunchKernelGGL(mk, dim3(grid_blocks), dim3(256), 0, stream, p, gp, a, b);
  }
#else
  hipMemsetAsync(p.bar, 0, XCD_BAR_WORDS * 4, stream);
  int ph0 = 0, ph1 = NPH;
  void* args[] = {&p, &gp, &ph0, &ph1};
  hipError_t e = hipLaunchCooperativeKernel((void*)mk, dim3(grid_blocks), dim3(256), args, 0, stream);
  if (e != hipSuccess) fprintf(stderr, "cooperative launch failed: %s (grid %d)\n", hipGetErrorString(e), grid_blocks);
#endif
}
```

```cpp
#include <hip/hip_runtime.h>
#include <hip/hip_cooperative_groups.h>
#include <cstdio>
namespace cg = cooperative_groups;

#ifndef MK_MULTI
#define MK_MULTI 0
#endif

#define DI __device__ __forceinline__
#define DN __device__ __noinline__
typedef unsigned short u16;
typedef __attribute__((ext_vector_type(8))) short bf16x8;
typedef __attribute__((ext_vector_type(4))) short s16x4;
typedef __attribute__((ext_vector_type(16))) float f32x16;
#define MFMA(a, b, c) __builtin_amdgcn_mfma_f32_32x32x16_bf16((a), (b), (c), 0, 0, 0)

static constexpr int NP_ = 4096, NT_ = 36864;
static constexpr int EVN = 3616, ODN = 2848;
static constexpr size_t OFF_AK = 37748736, OFF_AV = 41943040, OFF_SB = 46137344, OFF_CK = 48234496, OFF_CV = 49283072, OFF_SD = 50331648;
static constexpr size_t LW = 13631488, WO_UP = 0, WO_DN = 5767168, WO_IN = 8650752, WO_OUT = 12582912;
static constexpr int NPH = 34;
static constexpr int SMEM_BYTES = 80 * 1024;

struct P {
  const float *x_prompt, *x_sample, *cache_a_k, *cache_a_v, *state_b, *cache_c_k, *cache_c_v, *state_d, *c, *c_ctx, *ada_w, *ada_b,
      *norm1_g, *norm2_g, *ffn_up, *ffn_conv, *ffn_down, *ev_w_in, *ev_w_out, *a_rpb, *b_w_g2, *b_b_g, *b_norm_g, *od_w_in, *od_w_out,
      *c_sink, *d_conv, *d_a_log, *d_dt_bias, *d_norm_g, *final_g;
  float* out;
  u16 *hn, *proj, *ot1, *wt;
  float *mods, *rope;
  int* cnt;
  int* flags;
  char* ring;
  unsigned* bar;
};

typedef __attribute__((ext_vector_type(2))) __bf16 bf2_t;
typedef __attribute__((ext_vector_type(2))) float f2_t;
typedef __attribute__((ext_vector_type(4))) unsigned u32x4_t;
DI unsigned pk2(float a, float b) { const f2_t v = {a, b}; return __builtin_bit_cast(unsigned, __builtin_convertvector(v, bf2_t)); }
DI u16 f2bf(float x) { return __builtin_bit_cast(u16, (__bf16)x); }
DI float bf2f(u16 b) { return __uint_as_float(((unsigned)b) << 16); }
DI int crow(int i, int h) { return (i & 3) + 8 * (i >> 2) + 4 * h; }
template <int S> DI bf16x8 packs(const f32x16& x) {
  u32x4_t v;
  v[0] = pk2(x[8 * S], x[8 * S + 1]); v[1] = pk2(x[8 * S + 2], x[8 * S + 3]); v[2] = pk2(x[8 * S + 4], x[8 * S + 5]); v[3] = pk2(x[8 * S + 6], x[8 * S + 7]);
  return __builtin_bit_cast(bf16x8, v);
}
DI bf16x8 ld2x4(const u16* p) {
  s16x4 lo = *(const s16x4*)p, hi = *(const s16x4*)(p + 8);
  return __builtin_shufflevector(lo, hi, 0, 1, 2, 3, 4, 5, 6, 7);
}
DI float siluf(float x) { return x / (1.f + __expf(-x)); }
DI int opq(int x) { asm volatile("" : "+v"(x)); return x; }
DI float shx(float v, int lane, int o) { return __int_as_float(__builtin_amdgcn_ds_bpermute((lane ^ o) << 2, __float_as_int(v))); }
template <class T> DI T* uni(T* q) { return q; }
DI void zero16(f32x16& a) {
#pragma unroll
  for (int i = 0; i < 16; ++i) a[i] = 0.f;
}

DI void prep_phase(const P* __restrict__ gp, char* smem) {
  const P& p = *gp;
  int tid_ = threadIdx.x; asm volatile("" : "+v"(tid_)); const int tid = tid_;
  const int NWT = 4 * (1408 + 704 + 256) + 2 * (960 + 768);
  const int NADA = 384;
  const int total = NWT + NADA + 1;
  for (int item = blockIdx.x; item < total; item += gridDim.x) {
    if (item < NWT) {
      int rem = item; const float* src = nullptr; u16* dst = nullptr; int K = 0, N = 0, NPd = 0;
      for (int l = 0; l < 4; ++l) {
        const int jj = l >> 1; const bool ev = !(l & 1);
        const int nin = ev ? 960 : 768;
        if (rem < 1408) { src = p.ffn_up + (size_t)l * 1024 * 5632; dst = p.wt + l * LW + WO_UP; K = 1024; N = 5632; NPd = 5632; break; }
        rem -= 1408;
        if (rem < 704) { src = p.ffn_down + (size_t)l * 2816 * 1024; dst = p.wt + l * LW + WO_DN; K = 2816; N = 1024; NPd = 1024; break; }
        rem -= 704;
        if (rem < nin) { src = ev ? p.ev_w_in + (size_t)jj * 1024 * EVN : p.od_w_in + (size_t)jj * 1024 * ODN; dst = p.wt + l * LW + WO_IN; K = 1024; N = ev ? EVN : ODN; NPd = ev ? 3840 : 3072; break; }
        rem -= nin;
        if (rem < 256) { src = (ev ? p.ev_w_out : p.od_w_out) + (size_t)jj * 1024 * 1024; dst = p.wt + l * LW + WO_OUT; K = 1024; N = 1024; NPd = 1024; break; }
        rem -= 256;
      }
      const int ntn = NPd >> 6;
      const int tk = rem / ntn, tn = rem - tk * ntn;
      const int scol0 = (N == 5632) ? (((tn >> 1) & 1) * 2816 + (tn >> 2) * 128 + (tn & 1) * 64) : tn * 64;
      float* T = (float*)smem;
      __syncthreads();
#pragma unroll
      for (int i = 0; i < 16; ++i) {
        const int k = i * 4 + (tid >> 6), n = tid & 63;
        const int gn = scol0 + n;
        T[k * 65 + n] = (gn < N) ? src[(size_t)(tk * 64 + k) * N + gn] : 0.f;
      }
      __syncthreads();
#pragma unroll
      for (int i = 0; i < 2; ++i) {
        const int q = tid + 256 * i; const int n = q & 63, kc = q >> 6;
        const int pn = tn * 64 + n; const int nt32 = pn >> 5, rr = pn & 31;
        const int kstep = tk * 4 + (kc >> 1), hh = kc & 1;
        bf16x8 w;
#pragma unroll
        for (int j = 0; j < 8; ++j) w[j] = (short)f2bf(T[(kc * 8 + j) * 65 + n]);
        *(bf16x8*)(dst + ((size_t)(nt32 * (K >> 4) + kstep) * 64 + hh * 32 + rr) * 8) = w;
      }
    } else if (item < NWT + NADA) {
      const int it = item - NWT; const int l = it / 96, cgp = it - l * 96; const int n0 = cgp * 64;
      float* sc = (float*)smem;
      float* red = sc + 9 * 1024;
      __syncthreads();
      for (int idx = tid; idx < 9 * 1024; idx += 256) {
        const int ci = idx >> 10, k = idx & 1023;
        const float x = ci < 8 ? p.c[ci * 1024 + k] : p.c_ctx[k];
        sc[idx] = x / (1.f + expf(-x));
      }
      __syncthreads();
      const int wave = tid >> 6, lane = tid & 63;
      float acc[9];
#pragma unroll
      for (int ci = 0; ci < 9; ++ci) acc[ci] = 0.f;
      const float* wp = p.ada_w + ((size_t)l * 1024 + wave * 256) * 6144 + n0 + lane;
#pragma unroll 8
      for (int k = 0; k < 256; ++k) {
        const float wv = wp[(size_t)k * 6144];
#pragma unroll
        for (int ci = 0; ci < 9; ++ci) acc[ci] += sc[ci * 1024 + wave * 256 + k] * wv;
      }
#pragma unroll
      for (int ci = 0; ci < 9; ++ci) red[(wave * 9 + ci) * 64 + lane] = acc[ci];
      __syncthreads();
      for (int idx = tid; idx < 576; idx += 256) {
        const int ci = idx >> 6, col = idx & 63;
        const float s = red[(0 * 9 + ci) * 64 + col] + red[(1 * 9 + ci) * 64 + col] + red[(2 * 9 + ci) * 64 + col] + red[(3 * 9 + ci) * 64 + col];
        p.mods[(size_t)(l * 9 + ci) * 6144 + n0 + col] = s + p.ada_b[l * 6144 + n0 + col];
      }
    } else {
      if (tid < 8) p.cnt[tid] = 0;
      for (int i = tid; i < 8 * 8320; i += 256) p.flags[i] = 0;
      for (int idx = tid; idx < 1024; idx += 256) {
        const int pos = idx >> 4, fi = idx & 15;
        const float inv = powf(10000.f, -(float)fi / 16.f);
        const float ang = (float)pos * inv;
        p.rope[idx * 2] = cosf(ang); p.rope[idx * 2 + 1] = sinf(ang);
      }
    }
  }
}

DI void norm_phase(const P* __restrict__ gp, int l, int which, bool first, bool fin) {
  const P& p = *gp;
  int tid_ = threadIdx.x; asm volatile("" : "+v"(tid_)); const int tid = tid_, lane = tid & 63, wave = tid >> 6;
  for (int item = blockIdx.x; item < NT_ / 8; item += gridDim.x) {
    float4 v[2][4];
    float ss[2];
#pragma unroll
    for (int u = 0; u < 2; ++u) {
      const int tok = item * 8 + u * 4 + wave;
      const float* src = first ? (tok < NP_ ? p.x_prompt + (size_t)tok * 1024 : p.x_sample + (size_t)(tok - NP_) * 1024) : p.out + (size_t)tok * 1024;
#pragma unroll
      for (int i = 0; i < 4; ++i) v[u][i] = ((const float4*)src)[lane + 64 * i];
    }
#pragma unroll
    for (int u = 0; u < 2; ++u) {
      float a = 0.f;
#pragma unroll
      for (int i = 0; i < 4; ++i) a += v[u][i].x * v[u][i].x + v[u][i].y * v[u][i].y + v[u][i].z * v[u][i].z + v[u][i].w * v[u][i].w;
#pragma unroll
      for (int o = 32; o >= 1; o >>= 1) a += shx(a, lane, o);
      ss[u] = a;
    }
#pragma unroll
    for (int u = 0; u < 2; ++u) {
      const int tok = item * 8 + u * 4 + wave;
      const float rstd = rsqrtf(ss[u] * (1.f / 1024.f) + 1e-6f);
      if (fin) {
#pragma unroll
        for (int i = 0; i < 4; ++i) {
          const float4 g = ((const float4*)p.final_g)[lane + 64 * i];
          float4 y; y.x = v[u][i].x * rstd * g.x; y.y = v[u][i].y * rstd * g.y; y.z = v[u][i].z * rstd * g.z; y.w = v[u][i].w * rstd * g.w;
          ((float4*)(p.out + (size_t)tok * 1024))[lane + 64 * i] = y;
        }
      } else {
        const int ci = tok < NP_ ? 8 : (tok - NP_) >> 12;
        const float* md = p.mods + (size_t)(l * 9 + ci) * 6144 + which * 3072;
        const float* gpp = (which ? p.norm2_g : p.norm1_g) + l * 1024;
#pragma unroll
        for (int i = 0; i < 4; ++i) {
          const float4 g = ((const float4*)gpp)[lane + 64 * i];
          const float4 sh = ((const float4*)md)[lane + 64 * i];
          const float4 sc = ((const float4*)(md + 1024))[lane + 64 * i];
          ushort4 o;
          o.x = f2bf(v[u][i].x * rstd * g.x * (1.f + sc.x) + sh.x);
          o.y = f2bf(v[u][i].y * rstd * g.y * (1.f + sc.y) + sh.y);
          o.z = f2bf(v[u][i].z * rstd * g.z * (1.f + sc.z) + sh.z);
          o.w = f2bf(v[u][i].w * rstd * g.w * (1.f + sc.w) + sh.w);
          ((ushort4*)(p.hn + (size_t)tok * 1024))[lane + 64 * i] = o;
          if (first) ((float4*)(p.out + (size_t)tok * 1024))[lane + 64 * i] = v[u][i];
        }
      }
    }
  }
}

DI uint4 ldsel(const u16* pv, const u16* safe, unsigned ok) {
  uint4 t = *(const uint4*)(ok ? pv : safe);
  if (!ok) { t.x = 0; t.y = 0; t.z = 0; t.w = 0; }
  return t;
}
enum { EPI_PROJ = 0, EPI_RES = 1, EPI_FFN = 2 };

template <int EPI, int WN>
DI void gemm_phase(const P* __restrict__ gp, int l, char* smem, const u16* __restrict__ A, int lda, const u16* __restrict__ B, int ldb, int K, int MT,
                   int NTn, int gsel) {
  const P& p = *gp;
  u16* As = (u16*)smem;
  int tid_ = threadIdx.x; asm volatile("" : "+v"(tid_)); const int tid = tid_, lane = tid & 63, wave = tid >> 6, r = lane & 31, h = lane >> 5;
  const int KT = K >> 6;
  const bool even = !(l & 1); const int jj = l >> 1;
  const int ntiles = MT * NTn;
  const int nlb = gridDim.x >> 3, xcd = blockIdx.x & 7, lb = blockIdx.x >> 3;
  for (int it = 0;; ++it) {
    const int g = (it * 8 + xcd) * nlb + lb;
    if (g >= ntiles) break;
    const int SM = nlb >> 3;
    const int band = g / (SM * NTn); const int rem = g - band * SM * NTn;
    const int nt = rem / SM, mt = band * SM + (rem - nt * SM);
    int seqbase = 0, L = 0, tin0 = 0;
    if (EPI == EPI_FFN) {
      L = NT_; seqbase = 0; tin0 = mt * 126;
      if (tin0 >= NT_) continue;
    }
    const int row0 = tid >> 3, kc0 = (tid & 7) * 8;
    const long arow0 = (EPI == EPI_FFN) ? (long)seqbase + tin0 - 1 + row0 : (long)mt * 128 + row0;
    const u16* abase = A + arow0 * lda + kc0;
    unsigned avalid = 0;
#pragma unroll
    for (int i = 0; i < 4; ++i) {
      if (EPI == EPI_FFN) { const int ts = tin0 - 1 + row0 + 32 * i; if (ts >= 0 && ts < L) avalid |= 1u << i; }
      else avalid |= 1u << i;
    }
    const u16* bb0 = B + ((size_t)((nt * 4 + wave) * WN * (K >> 4)) * 64 + lane) * 8;
    const size_t bts = (size_t)(K >> 4) * 512;
    f32x16 acc[4][WN];
#pragma unroll
    for (int a = 0; a < 4; ++a)
#pragma unroll
      for (int b = 0; b < WN; ++b) zero16(acc[a][b]);
#define GLD_A(i, ko) ldsel(abase + (size_t)(32 * (i)) * lda + (ko), A, (avalid >> (i)) & 1u)
#define GLD_BF(dst, kt_) { const u16* q_ = bb0 + (size_t)(kt_) * 2048; \
      _Pragma("unroll") for (int ni_ = 0; ni_ < WN; ++ni_) { \
        dst[ni_][0] = *(const bf16x8*)(q_ + ni_ * bts); dst[ni_][1] = *(const bf16x8*)(q_ + ni_ * bts + 512); \
        dst[ni_][2] = *(const bf16x8*)(q_ + ni_ * bts + 1024); dst[ni_][3] = *(const bf16x8*)(q_ + ni_ * bts + 1536); } }
    uint4 ra0 = GLD_A(0, 0), ra1 = GLD_A(1, 0), ra2 = GLD_A(2, 0), ra3 = GLD_A(3, 0);
    uint4 sa0, sa1, sa2, sa3;
    if (WN == 1) { sa0 = GLD_A(0, 64); sa1 = GLD_A(1, 64); sa2 = GLD_A(2, 64); sa3 = GLD_A(3, 64); }
    bf16x8 bc[WN][4], bn[WN][4];
    GLD_BF(bc, 0);
    if (WN == 1) GLD_BF(bn, 1);
#define LSTORE(buf, A0, A1, A2, A3) { \
      u16* ad = As + (buf) * 9216 + row0 * 72 + kc0; \
      *(uint4*)(ad) = A0; *(uint4*)(ad + 32 * 72) = A1; *(uint4*)(ad + 64 * 72) = A2; *(uint4*)(ad + 96 * 72) = A3; }
#define COMPUTE(buf, BF, KN) { \
      const u16* Ab = As + (buf) * 9216 + r * 72 + h * 8; \
      const bool more_ = (KN) < KT; const u16* q_ = bb0 + (size_t)(KN) * 2048; \
      _Pragma("unroll") for (int ks = 0; ks < 4; ++ks) { \
        const bf16x8 a0 = *(const bf16x8*)(Ab + ks * 16); \
        const bf16x8 a1 = *(const bf16x8*)(Ab + 32 * 72 + ks * 16); \
        const bf16x8 a2 = *(const bf16x8*)(Ab + 64 * 72 + ks * 16); \
        const bf16x8 a3 = *(const bf16x8*)(Ab + 96 * 72 + ks * 16); \
        _Pragma("unroll") for (int ni_ = 0; ni_ < WN; ++ni_) { \
          acc[0][ni_] = MFMA(a0, BF[ni_][ks], acc[0][ni_]); acc[1][ni_] = MFMA(a1, BF[ni_][ks], acc[1][ni_]); \
          acc[2][ni_] = MFMA(a2, BF[ni_][ks], acc[2][ni_]); acc[3][ni_] = MFMA(a3, BF[ni_][ks], acc[3][ni_]); } \
        if (more_) { _Pragma("unroll") for (int ni_ = 0; ni_ < WN; ++ni_) BF[ni_][ks] = *(const bf16x8*)(q_ + ni_ * bts + ks * 512); } } }
    if (WN == 1) {
    LSTORE(0, ra0, ra1, ra2, ra3);
    ra0 = GLD_A(0, 128); ra1 = GLD_A(1, 128); ra2 = GLD_A(2, 128); ra3 = GLD_A(3, 128);
    __syncthreads();
    for (int kt = 0; kt < KT; kt += 2) {
      COMPUTE(0, bc, kt + 2);
      LSTORE(1, sa0, sa1, sa2, sa3);
      if (kt + 3 < KT) {
        const int ko = (kt + 3) * 64;
        sa0 = GLD_A(0, ko); sa1 = GLD_A(1, ko); sa2 = GLD_A(2, ko); sa3 = GLD_A(3, ko);
      }
      __syncthreads();
      COMPUTE(1, bn, kt + 3);
      if (kt + 2 < KT) {
        LSTORE(0, ra0, ra1, ra2, ra3);
        if (kt + 4 < KT) {
          const int ko = (kt + 4) * 64;
          ra0 = GLD_A(0, ko); ra1 = GLD_A(1, ko); ra2 = GLD_A(2, ko); ra3 = GLD_A(3, ko);
        }
      }
      __syncthreads();
    }
    } else {
      LSTORE(0, ra0, ra1, ra2, ra3);
      ra0 = GLD_A(0, 64); ra1 = GLD_A(1, 64); ra2 = GLD_A(2, 64); ra3 = GLD_A(3, 64);
      __syncthreads();
      for (int kt = 0; kt < KT; kt += 2) {
        COMPUTE(0, bc, kt + 1);
        LSTORE(1, ra0, ra1, ra2, ra3);
        if (kt + 2 < KT) { const int ko = (kt + 2) * 64; ra0 = GLD_A(0, ko); ra1 = GLD_A(1, ko); ra2 = GLD_A(2, ko); ra3 = GLD_A(3, ko); }
        __syncthreads();
        COMPUTE(1, bc, kt + 2);
        if (kt + 2 < KT) {
          LSTORE(0, ra0, ra1, ra2, ra3);
          if (kt + 3 < KT) { const int ko = (kt + 3) * 64; ra0 = GLD_A(0, ko); ra1 = GLD_A(1, ko); ra2 = GLD_A(2, ko); ra3 = GLD_A(3, ko); }
        }
        __syncthreads();
      }
    }
    if (EPI == EPI_PROJ) {
      const int N = even ? EVN : ODN;
#pragma unroll
      for (int tm = 0; tm < 4; ++tm)
#pragma unroll
        for (int tn = 0; tn < WN; ++tn) {
          const int col = nt * (128 * WN) + wave * (32 * WN) + tn * 32 + r;
          if (col < N) {
#pragma unroll
            for (int i = 0; i < 16; ++i) {
              const int row = mt * 128 + tm * 32 + crow(i, h);
              const float v = acc[tm][tn][i];
              p.proj[(size_t)row * N + col] = f2bf(v);
              if (row < NP_) {
                const int b = row >> 8, t = row & 255, d = col & 63;
                if (even) {
                  if (col >= 512 && col < 1536) {
                    const int wh = (col - 512) >> 9, hh = ((col - 512) >> 6) & 7;
                    p.out[(wh ? OFF_AV : OFF_AK) + ((size_t)(((b * 2 + jj) * 8 + hh) * 256 + t)) * 64 + d] = v;
                  }
                } else {
                  if (col >= 512 && col < 768) {
                    const int wh = (col - 512) >> 7, kv = ((col - 512) >> 6) & 1;
                    p.out[(wh ? OFF_CV : OFF_CK) + ((size_t)(((b * 2 + jj) * 2 + kv) * 256 + t)) * 64 + d] = v;
                  }
                }
              }
            }
          }
        }
    } else if (EPI == EPI_RES) {
#pragma unroll
      for (int tm = 0; tm < 4; ++tm)
#pragma unroll
        for (int tn = 0; tn < WN; ++tn) {
          const int col = nt * (128 * WN) + wave * (32 * WN) + tn * 32 + r;
          const int ci = mt * 128 < NP_ ? 8 : (mt * 128 - NP_) >> 12;
          const float g = p.mods[(size_t)(l * 9 + ci) * 6144 + gsel * 1024 + col];
#pragma unroll
          for (int i = 0; i < 16; ++i) {
            const int row = mt * 128 + tm * 32 + crow(i, h);
            float* xp = p.out + (size_t)row * 1024 + col;
            *xp = *xp + g * acc[tm][tn][i];
          }
        }
    } else {
      float* U = (float*)smem;
      const float* cw = p.ffn_conv + (size_t)l * 3 * 5632;
      u16* act = p.proj;
#pragma unroll
      for (int ps = 0; ps < WN; ++ps) {
        __syncthreads();
        if (WN == 1) {
#pragma unroll
          for (int tm = 0; tm < 4; ++tm)
#pragma unroll
            for (int i = 0; i < 16; ++i) U[(tm * 32 + crow(i, h)) * 132 + wave * 32 + r] = acc[tm][0][i];
        } else if ((wave & 1) == ps) {
#pragma unroll
          for (int tm = 0; tm < 4; ++tm)
#pragma unroll
            for (int tn = 0; tn < WN; ++tn)
#pragma unroll
              for (int i = 0; i < 16; ++i) U[(tm * 32 + crow(i, h)) * 132 + (wave >> 1) * 64 + tn * 32 + r] = acc[tm][tn][i];
        }
        __syncthreads();
        const int f = tid & 63, rg = tid >> 6; const int fg = nt * (64 * WN) + ps * 64 + f;
        const float wa0 = cw[fg], wa1 = cw[5632 + fg], wa2 = cw[2 * 5632 + fg];
        const float wg0 = cw[2816 + fg], wg1 = cw[5632 + 2816 + fg], wg2 = cw[2 * 5632 + 2816 + fg];
        const int rbeg = 1 + 32 * rg, rend = rg == 3 ? 126 : 32 * rg + 32;
        float ap = U[(rbeg - 1) * 132 + f], ac = U[rbeg * 132 + f];
        float gp_ = U[(rbeg - 1) * 132 + 64 + f], gc = U[rbeg * 132 + 64 + f];
        for (int rr = rbeg; rr <= rend; ++rr) {
          const int ts = tin0 - 1 + rr;
          if (ts >= L) break;
          const float an = U[(rr + 1) * 132 + f], gn = U[(rr + 1) * 132 + 64 + f];
          const bool sst = ts < NP_ ? ((ts & 255) == 0) : ((ts & 4095) == 0), sen = ts < NP_ ? ((ts & 255) == 255) : ((ts & 4095) == 4095);
          const float a = (sst ? 0.f : wa0 * ap) + wa1 * ac + (sen ? 0.f : wa2 * an);
          const float g = (sst ? 0.f : wg0 * gp_) + wg1 * gc + (sen ? 0.f : wg2 * gn);
          act[(size_t)(seqbase + ts) * 2816 + fg] = f2bf(a * siluf(g));
          ap = ac; ac = an; gp_ = gc; gc = gn;
        }
      }
      __syncthreads();
    }
  }
}

template <int MODE>
DI void attn_item(const P* __restrict__ gp, int jj, int it, char* smem) {
  const P& p = *gp;
  const u16* projp = uni(p.proj); u16* hnp = uni(p.hn); const float* ropep = uni(p.rope);
  u16* Ks = (u16*)smem; u16* Vt = Ks + 64 * 72; float* rpb_s = (float*)(Vt + 64 * 72);
  int tid_ = threadIdx.x; asm volatile("" : "+v"(tid_)); const int tid = tid_, lane = tid & 63, wave = tid >> 6, r = lane & 31, h = lane >> 5;
  constexpr bool EVENL = (MODE == 0 || MODE == 1);
  constexpr bool LAT = (MODE == 1 || MODE == 3);
  constexpr int PS = EVENL ? EVN : ODN;
  int b, hq, qb, tokbase;
  if (!LAT) { b = it >> 4; hq = (it >> 1) & 7; qb = it & 1; tokbase = b * 256; }
  else { b = it >> 8; hq = (it >> 5) & 7; qb = it & 31; tokbase = NP_ + b * 4096; }
  const int hk = EVENL ? hq : (hq >> 2);
  const int kcol = 512 + hk * 64, vcol = (EVENL ? 1024 : 640) + hk * 64, qcol = hq * 64;
  const int tq = qb * 128 + wave * 32 + r;
  const size_t qtok = (size_t)tokbase + tq;
  __syncthreads();
  if (MODE == 1) { for (int i = tid; i < 465; i += 256) rpb_s[i] = p.a_rpb[(size_t)(jj * 8 + hq) * 465 + i] * 1.4426950408889634f; }
  bf16x8 qf[4];
#pragma unroll
  for (int s = 0; s < 4; ++s) qf[s] = *(const bf16x8*)(projp + qtok * PS + qcol + 16 * s + 8 * h);
  if (MODE == 3) {
    const int prow = tq >> 6, pcol = tq & 63;
#pragma unroll
    for (int half = 0; half < 2; ++half) {
      const int pos = half ? pcol : prow;
#pragma unroll
      for (int j = 0; j < 8; ++j) {
        const float cs = ropep[(pos * 16 + 8 * h + j) * 2], sn = ropep[(pos * 16 + 8 * h + j) * 2 + 1];
        const float x1 = bf2f((u16)qf[2 * half][j]), x2 = bf2f((u16)qf[2 * half + 1][j]);
        qf[2 * half][j] = (short)f2bf(x1 * cs - x2 * sn);
        qf[2 * half + 1][j] = (short)f2bf(x1 * sn + x2 * cs);
      }
    }
  }
  float m_run = -1e30f, l_run = 0.f;
  if (MODE == 2 || MODE == 3) { m_run = p.c_sink[jj * 8 + hq] * 1.4426950408889634f; l_run = h == 0 ? 1.f : 0.f; }
  f32x16 ot[2]; zero16(ot[0]); zero16(ot[1]);
  int loc0 = 0, nloc = 0;
  if (MODE == 1) {
    const int qi0 = 2 * qb;
    const int rlo = min(max(qi0 - 4, 0), 56), rhi = min(max(qi0 + 1 - 4, 0), 56) + 7;
    loc0 = rlo; nloc = rhi - rlo + 1;
  } else if (MODE == 3) {
    loc0 = max(0, 2 * qb - 2); nloc = min(63, 2 * qb + 3) - loc0 + 1;
  }
  const int qi = tq >> 6, qw = tq & 63;
  const int r0w = min(max(qi - 4, 0), 56), c0w = min(max(qw - 8, 0), 48);
  const int key = tid >> 2, seg = tid & 3;
  for (int kb = 0; kb < 4 + nloc; ++kb) {
    const bool isctx = kb < 4;
    const int blk = isctx ? kb : loc0 + kb - 4;
    __syncthreads();
    {
      float kf[16], vf[16];
      if (LAT && isctx) {
        const float* kc = (MODE == 1) ? p.cache_a_k + ((size_t)((b * 2 + jj) * 8 + hk)) * 16384 : p.cache_c_k + ((size_t)((b * 2 + jj) * 2 + hk)) * 16384;
        const float* vc = (MODE == 1) ? p.cache_a_v + ((size_t)((b * 2 + jj) * 8 + hk)) * 16384 : p.cache_c_v + ((size_t)((b * 2 + jj) * 2 + hk)) * 16384;
        const float4* kp4 = (const float4*)(kc + (size_t)(blk * 64 + key) * 64 + seg * 16);
        const float4* vp4 = (const float4*)(vc + (size_t)(blk * 64 + key) * 64 + seg * 16);
#pragma unroll
        for (int e = 0; e < 4; ++e) {
          const float4 a = kp4[e], c = vp4[e];
          kf[4 * e] = a.x; kf[4 * e + 1] = a.y; kf[4 * e + 2] = a.z; kf[4 * e + 3] = a.w;
          vf[4 * e] = c.x; vf[4 * e + 1] = c.y; vf[4 * e + 2] = c.z; vf[4 * e + 3] = c.w;
        }
      } else {
        const u16* rowp = projp + ((size_t)tokbase + blk * 64 + key) * PS;
        const bf16x8 k0 = *(const bf16x8*)(rowp + kcol + seg * 16), k1 = *(const bf16x8*)(rowp + kcol + seg * 16 + 8);
        const bf16x8 v0 = *(const bf16x8*)(rowp + vcol + seg * 16), v1 = *(const bf16x8*)(rowp + vcol + seg * 16 + 8);
#pragma unroll
        for (int e = 0; e < 8; ++e) { kf[e] = bf2f((u16)k0[e]); kf[8 + e] = bf2f((u16)k1[e]); vf[e] = bf2f((u16)v0[e]); vf[8 + e] = bf2f((u16)v1[e]); }
        if (MODE == 3) {
          const bf16x8 p0 = *(const bf16x8*)(rowp + kcol + (seg ^ 1) * 16), p1 = *(const bf16x8*)(rowp + kcol + (seg ^ 1) * 16 + 8);
          const int pos = (seg & 2) ? key : blk;
#pragma unroll
          for (int e = 0; e < 16; ++e) {
            const float pr = bf2f((u16)(e < 8 ? p0[e & 7] : p1[e & 7]));
            const float cs = ropep[(pos * 16 + e) * 2], sn = ropep[(pos * 16 + e) * 2 + 1];
            kf[e] = (seg & 1) ? (pr * sn + kf[e] * cs) : (kf[e] * cs - pr * sn);
          }
        }
      }
      bf16x8 o0, o1;
#pragma unroll
      for (int e = 0; e < 8; ++e) { o0[e] = (short)f2bf(kf[e]); o1[e] = (short)f2bf(kf[8 + e]); }
      *(bf16x8*)(Ks + key * 72 + seg * 16) = o0;
      *(bf16x8*)(Ks + key * 72 + seg * 16 + 8) = o1;
#pragma unroll
      for (int e = 0; e < 16; ++e) Vt[(seg * 16 + e) * 72 + key] = f2bf(vf[e]);
    }
    __syncthreads();
    bool active = true;
    if (MODE == 1 && !isctx) active = (blk >= r0w && blk < r0w + 8);
    if (active) {
      f32x16 st[2]; zero16(st[0]); zero16(st[1]);
#pragma unroll
      for (int kt = 0; kt < 2; ++kt)
#pragma unroll
        for (int s = 0; s < 4; ++s) {
          const bf16x8 a = *(const bf16x8*)(Ks + (kt * 32 + r) * 72 + 16 * s + 8 * h);
          st[kt] = MFMA(a, qf[s], st[kt]);
        }
      float mx = m_run;
#pragma unroll
      for (int kt = 0; kt < 2; ++kt)
#pragma unroll
        for (int i = 0; i < 16; ++i) {
          float s = st[kt][i] * (0.125f * 1.4426950408889634f);
          const int kk = kt * 32 + crow(i, h);
          if (MODE == 1 && !isctx) {
            const bool ok = (kk >= c0w && kk < c0w + 16);
            s = ok ? s + rpb_s[(blk - qi + 7) * 31 + (kk - qw + 15)] : -1e30f;
          }
          if (MODE == 3 && !isctx) {
            const int dlt = blk * 64 + kk - tq;
            s = (dlt <= 128 && dlt >= -128) ? s : -1e30f;
          }
          st[kt][i] = s;
          mx = fmaxf(mx, s);
        }
      mx = fmaxf(mx, shx(mx, lane, 32));
      const float alpha = __builtin_amdgcn_exp2f(m_run - mx);
      m_run = mx;
      float ps = 0.f;
#pragma unroll
      for (int kt = 0; kt < 2; ++kt)
#pragma unroll
        for (int i = 0; i < 16; ++i) { const float pv = __builtin_amdgcn_exp2f(st[kt][i] - mx); st[kt][i] = pv; ps += pv; }
      l_run = l_run * alpha + ps;
#pragma unroll
      for (int dt = 0; dt < 2; ++dt)
#pragma unroll
        for (int i = 0; i < 16; ++i) ot[dt][i] *= alpha;
#pragma unroll
      for (int kt = 0; kt < 2; ++kt) {
        const bf16x8 pb0 = packs<0>(st[kt]), pb1 = packs<1>(st[kt]);
#pragma unroll
        for (int dt = 0; dt < 2; ++dt) {
          const bf16x8 pa0 = ld2x4(Vt + (dt * 32 + r) * 72 + kt * 32 + 4 * h);
          const bf16x8 pa1 = ld2x4(Vt + (dt * 32 + r) * 72 + kt * 32 + 16 + 4 * h);
          ot[dt] = MFMA(pa0, pb0, ot[dt]);
          ot[dt] = MFMA(pa1, pb1, ot[dt]);
        }
      }
    }
  }
  l_run += shx(l_run, lane, 32);
  const float inv = 1.f / l_run;
  u16* dst = hnp + qtok * 1024 + qcol;
#pragma unroll
  for (int dt = 0; dt < 2; ++dt)
#pragma unroll
    for (int g4 = 0; g4 < 4; ++g4) {
      ushort4 o;
      o.x = f2bf(ot[dt][4 * g4] * inv); o.y = f2bf(ot[dt][4 * g4 + 1] * inv); o.z = f2bf(ot[dt][4 * g4 + 2] * inv); o.w = f2bf(ot[dt][4 * g4 + 3] * inv);
      *(ushort4*)(dst + dt * 32 + 8 * g4 + 4 * h) = o;
    }
}

struct ChainId { int lat, b, h, dir, T, base, nch; };
DI ChainId chain_decode(int it) {
  ChainId c; c.lat = it < 128; const int q = c.lat ? it : it - 128;
  c.b = q >> 4; c.h = (q >> 1) & 7; c.dir = q & 1; c.T = c.lat ? 4096 : 256; c.base = c.lat ? NP_ + c.b * 4096 : c.b * 256; c.nch = c.T >> 6;
  return c;
}
DI int tokof(const ChainId& c, int step, int row) { const int pp = step * 64 + row; return c.base + (c.dir ? c.T - 1 - pp : pp); }


static constexpr int RING = 4;
static constexpr int SLOT_BYTES = 53760;
DI void wait_ge(int* flag, int val, int tid) {
  if (tid < 64) {
    if (tid == 0) { while (__hip_atomic_load(flag, __ATOMIC_RELAXED, __HIP_MEMORY_SCOPE_AGENT) < val) __builtin_amdgcn_s_sleep(1); }
    __builtin_amdgcn_fence(__ATOMIC_ACQUIRE, "agent");
  }
  __syncthreads();
}
DI void publish(int* flag, int val, int tid) {
  asm volatile("s_waitcnt vmcnt(0)" ::: "memory");
  __syncthreads();
  if (tid == 0) __hip_atomic_store(flag, val, __ATOMIC_RELAXED, __HIP_MEMORY_SCOPE_AGENT);
}
typedef __attribute__((ext_vector_type(4))) unsigned u32x4;
DI void copy_out(const char* lds, char* g, int bytes, int tid) {
  for (int i = opq(tid) * 16; i < bytes; i += 256 * 16) {
    const u32x4 v = *(const u32x4*)(lds + i);
    char* dst = g + i;
    asm volatile("global_store_dwordx4 %0, %1, off sc0 sc1" :: "v"(dst), "v"(v) : "memory");
  }
}
template <int BYTES>
DI void copy_in_t(char* lds, const char* g, int tid) {
  constexpr int N = (BYTES + 4095) / 4096;
  const int t16 = opq(tid) * 16;
  uint4 v[N];
#pragma unroll
  for (int j = 0; j < N; ++j) { const int i = t16 + j * 4096; v[j] = make_uint4(0, 0, 0, 0); if (i < BYTES) v[j] = *(const uint4*)(g + i); }
#pragma unroll
  for (int j = 0; j < N; ++j) { const int i = t16 + j * 4096; if (i < BYTES) *(uint4*)(lds + i) = v[j]; }
}

template <int ROLE>
DI void gla_chain(const P* __restrict__ gp, int jj, int it, char* smem, int k0, int kstep, int fs = 0) {
  const P& p = *gp;
  const ChainId cid = chain_decode(it);
  int tid_ = threadIdx.x; asm volatile("" : "+v"(tid_)); const int tid = tid_, lane = tid & 63, wave = tid >> 6, r = lane & 31, h = lane >> 5;
  const int hh = cid.h, dir = cid.dir;
  u16* QT = (u16*)smem; u16* KT = QT + 4608; u16* KEt = KT + 4608; u16* Vt = KEt + 4608;
  float* dec = (float*)(Vt + 4608); float* GL = dec + 64; float* gq = GL + 1024; float* Ost = gq + 256;
  constexpr int IMG = 4 * 9216 + 256;
  char* slots = uni(p.ring) + (size_t)it * RING * SLOT_BYTES; int* ready = uni(p.flags) + (jj * 2 + 4 * fs) * 8320 + it * 64; int* done = uni(p.flags) + (jj * 2 + 4 * fs) * 8320 + 8192 + it;
  const int d = tid & 63, cq = tid >> 6;
  float wg[16];
#pragma unroll
  for (int rr = 0; rr < 16; ++rr) wg[rr] = p.b_w_g2[((size_t)((jj * 2 + dir) * 16 + rr)) * 512 + hh * 64 + d];
  const float bg = p.b_b_g[(jj * 2 + dir) * 512 + hh * 64 + d];
  const int vh = wave & 1;
  f32x16 S[2]; zero16(S[0]); zero16(S[1]);
  const size_t sidx = ((size_t)(((cid.b * 2 + jj) * 2 + dir) * 8 + hh)) * 4096;
  if (ROLE != 1 && wave < 2 && cid.lat) {
#pragma unroll
    for (int dt = 0; dt < 2; ++dt)
#pragma unroll
      for (int i = 0; i < 16; ++i) S[dt][i] = p.state_b[sidx + (dt * 32 + crow(i, h)) * 64 + vh * 32 + r];
  }
  for (int step_ = k0; step_ < cid.nch; step_ += kstep) {
    int step = step_;
    asm volatile("" : "+v"(step));
    if (ROLE == 1) wait_ge(done, step_ - RING + 1, tid);
    if (ROLE == 2) wait_ge(ready + step_, 1, tid);
    __syncthreads();
    if (ROLE == 2) { copy_in_t<IMG>(smem, slots + (size_t)(step_ % RING) * SLOT_BYTES, tid); __syncthreads(); if (tid == 0) __hip_atomic_store(done, step_ + 1, __ATOMIC_RELAXED, __HIP_MEMORY_SCOPE_AGENT); }
    if (ROLE != 2) {
    {
      const int c = tid >> 2, sg = tid & 3;
      const int tok = tokof(cid, step, c);
      const ushort4 gv = *(const ushort4*)(p.proj + (size_t)tok * EVN + 3072 + dir * 16 + sg * 4);
      GL[c * 16 + sg * 4] = bf2f(gv.x); GL[c * 16 + sg * 4 + 1] = bf2f(gv.y); GL[c * 16 + sg * 4 + 2] = bf2f(gv.z); GL[c * 16 + sg * 4 + 3] = bf2f(gv.w);
    }
    __syncthreads();
    float Gl[16]; float run = 0.f;
#pragma unroll
    for (int i = 0; i < 16; ++i) {
      const int c = cq * 16 + i;
      float z = bg;
#pragma unroll
      for (int rr = 0; rr < 16; ++rr) z += GL[c * 16 + rr] * wg[rr];
      const float g = (fminf(z, 0.f) - __logf(1.f + __expf(-fabsf(z)))) * (1.f / 16.f);
      run += g; Gl[i] = run;
    }
    gq[cq * 64 + d] = run;
    __syncthreads();
    float off = 0.f, tot = 0.f;
#pragma unroll
    for (int q2 = 0; q2 < 4; ++q2) { const float t = gq[q2 * 64 + d]; if (q2 < cq) off += t; tot += t; }
#pragma unroll
    for (int i = 0; i < 16; ++i) {
      const int c = cq * 16 + i;
      const int tok = tokof(cid, step, c);
      const float G = Gl[i] + off;
      const u16* rowp = p.proj + (size_t)tok * EVN + hh * 64 + d;
      const float qv = bf2f(rowp[1536]), kv = bf2f(rowp[2048]);
      const u16 vb = rowp[2560];
      QT[c * 72 + d] = f2bf(qv * 0.125f * __expf(G));
      KT[c * 72 + d] = f2bf(kv * __expf(-G));
      KEt[d * 72 + c] = f2bf(kv * __expf(tot - G));
      Vt[d * 72 + c] = vb;
    }
    if (cq == 0) dec[d] = __expf(tot);
    __syncthreads();
    }
    if (ROLE == 1) { copy_out(smem, slots + (size_t)(step_ % RING) * SLOT_BYTES, IMG, tid); publish(ready + step_, 1, tid); continue; }
    if (wave < 2) {
      f32x16 at[2][2];
#pragma unroll
      for (int a = 0; a < 2; ++a)
#pragma unroll
        for (int b2 = 0; b2 < 2; ++b2) zero16(at[a][b2]);
#pragma unroll
      for (int ks = 0; ks < 4; ++ks) {
        const bf16x8 a0 = *(const bf16x8*)(KT + r * 72 + ks * 16 + 8 * h), a1 = *(const bf16x8*)(KT + (32 + r) * 72 + ks * 16 + 8 * h);
        const bf16x8 b0 = *(const bf16x8*)(QT + r * 72 + ks * 16 + 8 * h), b1 = *(const bf16x8*)(QT + (32 + r) * 72 + ks * 16 + 8 * h);
        at[0][0] = MFMA(a0, b0, at[0][0]); at[0][1] = MFMA(a0, b1, at[0][1]);
        at[1][0] = MFMA(a1, b0, at[1][0]); at[1][1] = MFMA(a1, b1, at[1][1]);
      }
#pragma unroll
      for (int st = 0; st < 2; ++st)
#pragma unroll
        for (int ct = 0; ct < 2; ++ct)
#pragma unroll
          for (int i = 0; i < 16; ++i) { if (st * 32 + crow(i, h) > ct * 32 + r) at[st][ct][i] = 0.f; }
      f32x16 o[2]; zero16(o[0]); zero16(o[1]);
#pragma unroll
      for (int ct = 0; ct < 2; ++ct)
#pragma unroll
        for (int st = 0; st < 2; ++st) {
          const bf16x8 x0 = packs<0>(at[st][ct]), x1 = packs<1>(at[st][ct]);
          const bf16x8 pb0 = ld2x4(Vt + (vh * 32 + r) * 72 + st * 32 + 4 * h);
          const bf16x8 pb1 = ld2x4(Vt + (vh * 32 + r) * 72 + st * 32 + 16 + 4 * h);
          o[ct] = MFMA(x0, pb0, o[ct]);
          o[ct] = MFMA(x1, pb1, o[ct]);
        }
#pragma unroll
      for (int dt = 0; dt < 2; ++dt) {
        const bf16x8 xs0 = packs<0>(S[dt]), xs1 = packs<1>(S[dt]);
#pragma unroll
        for (int ct = 0; ct < 2; ++ct) {
          const bf16x8 pa0 = ld2x4(QT + (ct * 32 + r) * 72 + dt * 32 + 4 * h);
          const bf16x8 pa1 = ld2x4(QT + (ct * 32 + r) * 72 + dt * 32 + 16 + 4 * h);
          o[ct] = MFMA(pa0, xs0, o[ct]);
          o[ct] = MFMA(pa1, xs1, o[ct]);
        }
      }
#pragma unroll
      for (int dt = 0; dt < 2; ++dt)
#pragma unroll
        for (int i = 0; i < 16; ++i) S[dt][i] *= dec[dt * 32 + crow(i, h)];
#pragma unroll
      for (int ks = 0; ks < 4; ++ks) {
        const bf16x8 bv = *(const bf16x8*)(Vt + (vh * 32 + r) * 72 + ks * 16 + 8 * h);
#pragma unroll
        for (int dt = 0; dt < 2; ++dt) {
          const bf16x8 a = *(const bf16x8*)(KEt + (dt * 32 + r) * 72 + ks * 16 + 8 * h);
          S[dt] = MFMA(a, bv, S[dt]);
        }
      }
#pragma unroll
      for (int ct = 0; ct < 2; ++ct)
#pragma unroll
        for (int i = 0; i < 16; ++i) Ost[(ct * 32 + crow(i, h)) * 68 + vh * 32 + r] = o[ct][i];
    }
    __syncthreads();
    {
      const int c = tid >> 2, sg = tid & 3;
      const int tok = tokof(cid, step, c);
      u16* dst = (dir ? p.ot1 + (size_t)tok * 512 + hh * 64 : p.hn + (size_t)tok * 1024 + 512 + hh * 64) + sg * 16;
      bf16x8 w0, w1;
#pragma unroll
      for (int e = 0; e < 8; ++e) { w0[e] = (short)f2bf(Ost[c * 68 + sg * 16 + e]); w1[e] = (short)f2bf(Ost[c * 68 + sg * 16 + 8 + e]); }
      *(bf16x8*)dst = w0; *(bf16x8*)(dst + 8) = w1;
    }
  }
  if (wave < 2 && !cid.lat) {
#pragma unroll
    for (int dt = 0; dt < 2; ++dt)
#pragma unroll
      for (int i = 0; i < 16; ++i) p.out[OFF_SB + sidx + (dt * 32 + crow(i, h)) * 64 + vh * 32 + r] = S[dt][i];
  }
}

template <int ROLE>
DI void delta_chain(const P* __restrict__ gp, int jj, int it, char* smem, int k0, int kstep, int fs = 0) {
  const P& p = *gp;
  const ChainId cid = chain_decode(it);
  int tid_ = threadIdx.x; asm volatile("" : "+v"(tid_)); const int tid0 = tid_;
  const int hh = cid.h, dir = cid.dir;
  u16* Qn = (u16*)smem; u16* Kt = Qn + 4608; u16* AQK = Kt + 4608; u16* KC = AQK + 4608;
  float* Wv = (float*)(KC + 4608); float* Gs = Wv + 64 * 65; u16* Kn = (u16*)(Gs + 64); float* At = (float*)(Kn + 4608); float* Bt = At + 64 * 68;
  constexpr int IMG = 4 * 9216 + 16640 + 256;
  char* slots = uni(p.ring) + (size_t)it * RING * SLOT_BYTES; int* ready = uni(p.flags) + (jj * 2 + 1 + 4 * fs) * 8320 + it * 64; int* done = uni(p.flags) + (jj * 2 + 1 + 4 * fs) * 8320 + 8192 + it;
  const float aexp = __expf(p.d_a_log[(jj * 2 + dir) * 8 + hh]);
  const float dtb = p.d_dt_bias[(jj * 2 + dir) * 8 + hh];
  f32x16 S[2]; zero16(S[0]); zero16(S[1]);
  const size_t sidx = ((size_t)(((cid.b * 2 + jj) * 2 + dir) * 8 + hh)) * 4096;
  { const int tid = tid0, lane = tid & 63, wave = tid >> 6, r = lane & 31, h = lane >> 5;
  if (ROLE != 1 && wave < 2 && cid.lat) {
    const int vh = wave & 1;
#pragma unroll
    for (int dt = 0; dt < 2; ++dt)
#pragma unroll
      for (int i = 0; i < 16; ++i) S[dt][i] = p.state_d[sidx + (dt * 32 + crow(i, h)) * 64 + vh * 32 + r];
  }
  }
  u16* CW = (u16*)(smem + 80640);
  __syncthreads();
  for (int i = tid0; i < 576; i += 256) { const int tap = i / 192, c2 = i - tap * 192; const int wh = c2 >> 6, dd = c2 & 63;
    CW[i] = f2bf(p.d_conv[(size_t)jj * 3 * 1536 + tap * 1536 + wh * 512 + hh * 64 + dd]); }
  for (int step_ = k0; step_ < cid.nch; step_ += kstep) {
    int step = step_;
    asm volatile("" : "+v"(step));
    if (ROLE == 1) wait_ge(done, step_ - RING + 1, tid0);
    if (ROLE == 2) wait_ge(ready + step_, 1, tid0);
    __syncthreads();
    if (ROLE == 2) { copy_in_t<IMG>(smem, slots + (size_t)(step_ % RING) * SLOT_BYTES, tid0); __syncthreads(); if (tid0 == 0) __hip_atomic_store(done, step_ + 1, __ATOMIC_RELAXED, __HIP_MEMORY_SCOPE_AGENT); }
    if (ROLE != 2) {
    {const int tid = opq(tid0), lane = tid & 63, wave = __builtin_amdgcn_readfirstlane(tid >> 6), r = lane & 31, h = lane >> 5, vh = wave & 1; (void)r; (void)h; (void)vh; (void)lane;
    if (wave == 0) {
      const int tok = tokof(cid, step, lane);
      const float da = bf2f(p.proj[(size_t)tok * ODN + 2304 + dir * 8 + hh]);
      const float db = bf2f(p.proj[(size_t)tok * ODN + 2320 + dir * 8 + hh]);
      const float x = da + dtb;
      const float sp = x > 20.f ? x : __logf(1.f + __expf(x));
      float G = -aexp * sp;
#pragma unroll
      for (int o = 1; o < 64; o <<= 1) { const float t = __int_as_float(__builtin_amdgcn_ds_bpermute((lane - o) << 2, __float_as_int(G))); if (lane >= o) G += t; }
      Gs[lane] = G; Bt[lane] = 1.f / (1.f + __expf(-db));
    }
    {
      const int c = tid >> 2, sg = tid & 3;
      const int tok = tokof(cid, step, c);
      const int pos = tok - cid.base;
      const bool hp = pos > 0, hn_ = pos < cid.T - 1;
#pragma unroll 1
      for (int wh = 0; wh < 3; ++wh) {
        const int ch0 = wh * 512 + hh * 64 + sg * 16;
        const u16* cur = p.proj + (size_t)tok * ODN + 768 + ch0;
        float y[16];
        float ss = 0.f;
#pragma unroll
        for (int hf = 0; hf < 2; ++hf) {
          const bf16x8 xc = *(const bf16x8*)(cur + hf * 8);
          bf16x8 xp, xn;
#pragma unroll
          for (int e = 0; e < 8; ++e) { xp[e] = 0; xn[e] = 0; }
          if (hp) xp = *(const bf16x8*)(cur - ODN + hf * 8);
          if (hn_) xn = *(const bf16x8*)(cur + ODN + hf * 8);
#pragma unroll
          for (int e = 0; e < 8; ++e) {
            const int ch = wh * 64 + sg * 16 + hf * 8 + e;
            float v = bf2f(CW[ch]) * bf2f((u16)xp[e]) + bf2f(CW[192 + ch]) * bf2f((u16)xc[e]) + bf2f(CW[384 + ch]) * bf2f((u16)xn[e]);
            v = v / (1.f + __expf(-v));
            y[hf * 8 + e] = v; ss += v * v;
          }
        }
        ss += shx(ss, lane, 1); ss += shx(ss, lane, 2);
        const float rn = rsqrtf(ss + 1e-6f);
        if (wh == 0) {
#pragma unroll
          for (int e = 0; e < 16; ++e) Qn[c * 72 + sg * 16 + e] = f2bf(y[e] * rn * 0.125f);
        } else if (wh == 1) {
#pragma unroll
          for (int e = 0; e < 16; ++e) { const u16 kb = f2bf(y[e] * rn); Kn[c * 72 + sg * 16 + e] = kb; Kt[(sg * 16 + e) * 72 + c] = kb; }
        } else {
#pragma unroll
          for (int e = 0; e < 16; ++e) Wv[c * 65 + sg * 16 + e] = y[e];
        }
      }
    }
    }
    __syncthreads();
    {const int tid = opq(tid0), lane = tid & 63, wave = __builtin_amdgcn_readfirstlane(tid >> 6), r = lane & 31, h = lane >> 5, vh = wave & 1; (void)r; (void)h; (void)vh; (void)lane;
    if (wave < 2) {
      f32x16 akk[2], aqk[2]; zero16(akk[0]); zero16(akk[1]); zero16(aqk[0]); zero16(aqk[1]);
#pragma unroll
      for (int ks = 0; ks < 4; ++ks) {
        const bf16x8 bk = *(const bf16x8*)(Kn + (vh * 32 + r) * 72 + ks * 16 + 8 * h);
#pragma unroll
        for (int ct = 0; ct < 2; ++ct) {
          const bf16x8 ak = *(const bf16x8*)(Kn + (ct * 32 + r) * 72 + ks * 16 + 8 * h);
          const bf16x8 aq = *(const bf16x8*)(Qn + (ct * 32 + r) * 72 + ks * 16 + 8 * h);
          akk[ct] = MFMA(ak, bk, akk[ct]);
          aqk[ct] = MFMA(aq, bk, aqk[ct]);
        }
      }
      const int s = vh * 32 + r;
      const float Gss = Gs[s];
#pragma unroll
      for (int ct = 0; ct < 2; ++ct)
#pragma unroll
        for (int g4 = 0; g4 < 4; ++g4) {
          const int c0 = ct * 32 + 8 * g4 + 4 * h;
          const float4 gv4 = *(const float4*)(Gs + c0), bv4 = *(const float4*)(Bt + c0);
          float4 val;
#pragma unroll
          for (int e = 0; e < 4; ++e) {
            const int c = c0 + e;
            const float Gc = e == 0 ? gv4.x : e == 1 ? gv4.y : e == 2 ? gv4.z : gv4.w;
            const float Bc = e == 0 ? bv4.x : e == 1 ? bv4.y : e == 2 ? bv4.z : bv4.w;
            const float gam = __expf(fminf(Gc - Gss, 0.f));
            const float av = (s < c) ? akk[ct][4 * g4 + e] * Bc * gam : 0.f;
            if (e == 0) val.x = av; else if (e == 1) val.y = av; else if (e == 2) val.z = av; else val.w = av;
            AQK[c * 72 + s] = f2bf((s <= c) ? aqk[ct][4 * g4 + e] * gam : 0.f);
          }
          *(float4*)(At + s * 68 + c0) = val;
        }
    }
    }
    __syncthreads();
    {const int tid = opq(tid0), lane = tid & 63, wave = __builtin_amdgcn_readfirstlane(tid >> 6), r = lane & 31, h = lane >> 5, vh = wave & 1; (void)r; (void)h; (void)vh; (void)lane;
    if (wave < 2) {
      const bool isv = wave == 0;
      const int col = lane;
#pragma unroll 1
      for (int bi = 0; bi < 4; ++bi) {
        float acc[16];
#pragma unroll
        for (int ci = 0; ci < 16; ++ci) {
          const int c = 16 * bi + ci;
          acc[ci] = isv ? Wv[c * 65 + col] * Bt[c] : bf2f(Kn[c * 72 + col]) * Bt[c] * __expf(Gs[c]);
        }
#pragma unroll 8
        for (int s2 = 0; s2 < 16 * bi; ++s2) {
          const float xs = isv ? Wv[s2 * 65 + col] : bf2f(KC[s2 * 72 + col]);
          const float4* a4 = (const float4*)(At + s2 * 68 + 16 * bi);
#pragma unroll
          for (int q = 0; q < 4; ++q) {
            const float4 a = a4[q];
            acc[4 * q] -= a.x * xs; acc[4 * q + 1] -= a.y * xs; acc[4 * q + 2] -= a.z * xs; acc[4 * q + 3] -= a.w * xs;
          }
        }
#pragma unroll
        for (int ci = 0; ci < 16; ++ci) {
          const float x = acc[ci];
          const float* arow = At + (16 * bi + ci) * 68 + 16 * bi;
#pragma unroll
          for (int cj = ci + 1; cj < 16; ++cj) acc[cj] -= arow[cj] * x;
          if (isv) Wv[(16 * bi + ci) * 65 + col] = x; else KC[(16 * bi + ci) * 72 + col] = f2bf(x);
        }
      }
    }
    }
    __syncthreads();
    }
    if (ROLE == 1) { copy_out(smem, slots + (size_t)(step_ % RING) * SLOT_BYTES, IMG, tid0); publish(ready + step_, 1, tid0); continue; }
    {const int tid = opq(tid0), lane = tid & 63, wave = __builtin_amdgcn_readfirstlane(tid >> 6), r = lane & 31, h = lane >> 5, vh = wave & 1; (void)r; (void)h; (void)vh; (void)lane;
    if (wave < 2) {
      f32x16 kS[2], qS[2]; zero16(kS[0]); zero16(kS[1]); zero16(qS[0]); zero16(qS[1]);
#pragma unroll
      for (int dt = 0; dt < 2; ++dt) {
        const bf16x8 xs0 = packs<0>(S[dt]), xs1 = packs<1>(S[dt]);
#pragma unroll
        for (int ct = 0; ct < 2; ++ct) {
          kS[ct] = MFMA(ld2x4(KC + (ct * 32 + r) * 72 + dt * 32 + 4 * h), xs0, kS[ct]);
          kS[ct] = MFMA(ld2x4(KC + (ct * 32 + r) * 72 + dt * 32 + 16 + 4 * h), xs1, kS[ct]);
          qS[ct] = MFMA(ld2x4(Qn + (ct * 32 + r) * 72 + dt * 32 + 4 * h), xs0, qS[ct]);
          qS[ct] = MFMA(ld2x4(Qn + (ct * 32 + r) * 72 + dt * 32 + 16 + 4 * h), xs1, qS[ct]);
        }
      }
      f32x16 vn[2], o[2];
      const float Glast = Gs[63];
#pragma unroll
      for (int ct = 0; ct < 2; ++ct)
#pragma unroll
        for (int i = 0; i < 16; ++i) {
          const int c = ct * 32 + crow(i, h);
          vn[ct][i] = Wv[c * 65 + vh * 32 + r] - kS[ct][i];
          o[ct][i] = qS[ct][i] * __expf(Gs[c]);
        }
#pragma unroll
      for (int st = 0; st < 2; ++st) {
        const bf16x8 xs0 = packs<0>(vn[st]), xs1 = packs<1>(vn[st]);
#pragma unroll
        for (int ct = 0; ct < 2; ++ct) {
          o[ct] = MFMA(ld2x4(AQK + (ct * 32 + r) * 72 + st * 32 + 4 * h), xs0, o[ct]);
          o[ct] = MFMA(ld2x4(AQK + (ct * 32 + r) * 72 + st * 32 + 16 + 4 * h), xs1, o[ct]);
        }
      }
      const float dl = __expf(Glast);
#pragma unroll
      for (int st = 0; st < 2; ++st) {
        asm volatile("" ::: "memory");
#pragma unroll
        for (int i = 0; i < 16; ++i) vn[st][i] *= __expf(Glast - Gs[st * 32 + crow(i, h)]);
      }
      asm volatile("" ::: "memory");
#pragma unroll
      for (int dt = 0; dt < 2; ++dt)
#pragma unroll
        for (int i = 0; i < 16; ++i) S[dt][i] *= dl;
#pragma unroll
      for (int st = 0; st < 2; ++st) {
        const bf16x8 xs0 = packs<0>(vn[st]), xs1 = packs<1>(vn[st]);
#pragma unroll
        for (int dt = 0; dt < 2; ++dt) {
          S[dt] = MFMA(ld2x4(Kt + (dt * 32 + r) * 72 + st * 32 + 4 * h), xs0, S[dt]);
          S[dt] = MFMA(ld2x4(Kt + (dt * 32 + r) * 72 + st * 32 + 16 + 4 * h), xs1, S[dt]);
        }
      }
#pragma unroll
      for (int ct = 0; ct < 2; ++ct)
#pragma unroll
        for (int i = 0; i < 16; ++i) At[(ct * 32 + crow(i, h)) * 68 + vh * 32 + r] = o[ct][i];
    }
    }
    __syncthreads();
    {
      const int tid = opq(tid0);
      const int c = tid >> 2, sg = tid & 3;
      const int tok = tokof(cid, step, c);
      u16* dst = (dir ? p.ot1 + (size_t)tok * 512 + hh * 64 : p.hn + (size_t)tok * 1024 + 512 + hh * 64) + sg * 16;
      bf16x8 w0, w1;
#pragma unroll
      for (int e = 0; e < 8; ++e) { w0[e] = (short)f2bf(At[c * 68 + sg * 16 + e]); w1[e] = (short)f2bf(At[c * 68 + sg * 16 + 8 + e]); }
      *(bf16x8*)dst = w0; *(bf16x8*)(dst + 8) = w1;
    }
  }
  {const int tid = opq(tid0), lane = tid & 63, wave = __builtin_amdgcn_readfirstlane(tid >> 6), r = lane & 31, h = lane >> 5, vh = wave & 1; (void)r; (void)h; (void)vh; (void)lane;
  if (wave < 2 && !cid.lat) {
#pragma unroll
    for (int dt = 0; dt < 2; ++dt)
#pragma unroll
      for (int i = 0; i < 16; ++i) p.out[OFF_SD + sidx + (dt * 32 + crow(i, h)) * 64 + vh * 32 + r] = S[dt][i];
  }
}
}

DI void mixer_phase(const P* __restrict__ gp, int l, char* smem, int fs = 0) {
  const P& p = *gp;
  const bool even = !(l & 1); const int jj = l >> 1;
  const bool teams = gridDim.x >= 512;
  if (teams) {
    const int bid = blockIdx.x;
    const int K = 3;
    if (bid < 128 * (K + 1)) {
      if (bid < 128) { if (even) gla_chain<2>(gp, jj, bid, smem, 0, 1, fs); else delta_chain<2>(gp, jj, bid, smem, 0, 1, fs); }
      else { const int ch = (bid - 128) & 127, k = (bid - 128) >> 7; if (even) gla_chain<1>(gp, jj, ch, smem, k, K, fs); else delta_chain<1>(gp, jj, ch, smem, k, K, fs); }
    }
  }
  const int first = teams ? 128 : 0;
  const int total = 384 + 2048 + 256;
  int* s_item = (int*)(smem + SMEM_BYTES - 16);
  int* cntp = uni(p.cnt) + l + 4 * fs;
  for (;;) {
    __syncthreads();
    if (opq(threadIdx.x) == 0) *s_item = atomicAdd(cntp, 1) + first;
    __syncthreads();
    const int item = __builtin_amdgcn_readfirstlane(*s_item);
    if (item >= total) break;
    if (item < 384) { if (even) gla_chain<0>(gp, jj, item, smem, 0, 1); else delta_chain<0>(gp, jj, item, smem, 0, 1); }
    else if (item < 384 + 2048) { if (even) attn_item<1>(gp, jj, item - 384, smem); else attn_item<3>(gp, jj, item - 384, smem); }
    else { if (even) attn_item<0>(gp, jj, item - 384 - 2048, smem); else attn_item<2>(gp, jj, item - 384 - 2048, smem); }
  }
}

DI void finalize_phase(const P* __restrict__ gp, int l) {
  const P& p = *gp;
  const bool even = !(l & 1); const int jj = l >> 1;
  int tid_ = threadIdx.x; asm volatile("" : "+v"(tid_)); const int tid = tid_;
  const int tk = tid >> 5, hh = (tid >> 2) & 7, sg = tid & 3;
  const int PS = even ? EVN : ODN; const int zcol = even ? 3104 : 2336;
  for (int item = blockIdx.x; item < NT_ / 8; item += gridDim.x) {
    const size_t tok = (size_t)item * 8 + tk;
    u16* a = p.hn + tok * 1024 + 512 + hh * 64 + sg * 16;
    const u16* bsrc = p.ot1 + tok * 512 + hh * 64 + sg * 16;
    const u16* zs = p.proj + tok * PS + zcol + hh * 64 + sg * 16;
    float o[16]; float ss = 0.f;
#pragma unroll
    for (int hf = 0; hf < 2; ++hf) {
      const bf16x8 x0 = *(const bf16x8*)(a + hf * 8), x1 = *(const bf16x8*)(bsrc + hf * 8);
#pragma unroll
      for (int e = 0; e < 8; ++e) { const float v = bf2f((u16)x0[e]) + bf2f((u16)x1[e]); o[hf * 8 + e] = v; ss += v * v; }
    }
    ss += shx(ss, tid & 63, 1); ss += shx(ss, tid & 63, 2);
    const float rstd = rsqrtf(ss * (1.f / 64.f) + 1e-6f);
    const float* ng = even ? p.b_norm_g + jj * 512 + hh * 64 + sg * 16 : p.d_norm_g + jj * 64 + sg * 16;
#pragma unroll
    for (int hf = 0; hf < 2; ++hf) {
      const bf16x8 z = *(const bf16x8*)(zs + hf * 8);
      bf16x8 w;
#pragma unroll
      for (int e = 0; e < 8; ++e) { const float zz = bf2f((u16)z[e]); w[e] = (short)f2bf(o[hf * 8 + e] * rstd * ng[hf * 8 + e] * siluf(zz)); }
      *(bf16x8*)(a + hf * 8) = w;
    }
  }
}


#define XB_TMO      128
#define XB_XCNT(j)  (256  + 64 * (j))
#define XB_XSUB(j)  (1280 + 64 * (j))
#define XB_XGEN(j)  (2304 + 64 * (j))
#define XB_TOP      3328
#define XB_TOPGEN   3392
#define XCD_BAR_WORDS 3456
#define XB_SPIN_CAP (1u << 18)
#define LAS __attribute__((address_space(3)))
DI unsigned xb_ld(unsigned* q)              { return __hip_atomic_load(q, __ATOMIC_RELAXED, __HIP_MEMORY_SCOPE_AGENT); }
DI unsigned xb_add(unsigned* q, unsigned v) { return __hip_atomic_fetch_add(q, v, __ATOMIC_RELAXED, __HIP_MEMORY_SCOPE_AGENT); }
DI unsigned xb_xcc_id() { return (unsigned)__builtin_amdgcn_s_getreg((3 << 11) | 20) & 0xFu; }
#define XB_SPIN(cond, bar) do { unsigned _sp = 0; while (cond) { __builtin_amdgcn_s_sleep(1); \
    if ((++_sp & 255u) == 0u) { if (xb_ld(&(bar)[XB_TMO])) break; if (_sp > XB_SPIN_CAP) { atomicAdd(&(bar)[XB_TMO], 1u); break; } } } } while (0)
struct XcdBarrier { unsigned* bar; unsigned x; volatile LAS unsigned* st; };
DI XcdBarrier xcd_barrier_post(unsigned* bar, volatile LAS unsigned* st) {
  XcdBarrier b; b.bar = bar; b.x = xb_xcc_id(); b.st = st;
  if (threadIdx.x == 0) (void)xb_add(&bar[XB_XCNT(b.x)], 1u);
  return b;
}
DI void xcd_barrier_complete(unsigned* bar, unsigned x, unsigned& nloc, unsigned& nx) {
  const unsigned G = gridDim.x * gridDim.y * gridDim.z;
  unsigned sum, cnt, mine, sp = 0u;
  for (;;) {
    sum = 0u; cnt = 0u; mine = 0u;
#pragma unroll
    for (unsigned j = 0; j < 16; ++j) { const unsigned c = xb_ld(&bar[XB_XCNT(j)]); sum += c; cnt += (c > 0u) ? 1u : 0u; mine = (j == x) ? c : mine; }
    if (sum == G) break;
    __builtin_amdgcn_s_sleep(1);
    if ((++sp & 255u) == 0u) { if (xb_ld(&bar[XB_TMO])) break; if (sp > XB_SPIN_CAP) { atomicAdd(&bar[XB_TMO], 1u); break; } }
  }
  nloc = mine > 0u ? mine : 1u; nx = cnt > 0u ? cnt : 1u;
}
DI void xcd_barrier(const XcdBarrier& b) {
  asm volatile("s_waitcnt vmcnt(0)" ::: "memory");
  __syncthreads();
  if (threadIdx.x == 0) {
    unsigned* bar = b.bar;
    __builtin_amdgcn_s_waitcnt(0);
    unsigned nloc = b.st[0], nx = b.st[1];
    if (nloc == 0u) { xcd_barrier_complete(bar, b.x, nloc, nx); b.st[0] = nloc; b.st[1] = nx; }
    const unsigned old = xb_add(&bar[XB_XSUB(b.x)], 1u);
    const unsigned gen = old / nloc;
    if (old + 1u == (gen + 1u) * nloc) {
      __builtin_amdgcn_fence(__ATOMIC_RELEASE, "agent");
      asm volatile("s_waitcnt vmcnt(0)" ::: "memory");
      const unsigned og = xb_add(&bar[XB_TOP], 1u);
      const unsigned tg = og / nx;
      if (og + 1u == (tg + 1u) * nx) xb_add(&bar[XB_TOPGEN], 1u);
      else XB_SPIN(xb_ld(&bar[XB_TOPGEN]) == tg, bar);
      __builtin_amdgcn_fence(__ATOMIC_ACQUIRE, "agent");
      xb_add(&bar[XB_XGEN(b.x)], 1u);
      asm volatile("s_waitcnt vmcnt(0)" ::: "memory");
    } else {
      XB_SPIN(xb_ld(&bar[XB_XGEN(b.x)]) == gen, bar);
      __builtin_amdgcn_fence(__ATOMIC_ACQUIRE, "agent");
      asm volatile("s_waitcnt vmcnt(0)" ::: "memory");
    }
  }
  __syncthreads();
}

DI void run_phase(const P* __restrict__ gp, int ph, char* smem) {
  const P& p = *gp;
  if (ph == 0) { prep_phase(gp, smem); return; }
  if (ph == NPH - 1) { norm_phase(gp, 0, 0, false, true); return; }
  const int l = (ph - 1) >> 3, s = (ph - 1) & 7;
  const bool even = !(l & 1);
  const u16* W = uni(p.wt) + (size_t)l * LW;
  const u16* hnp = uni(p.hn); const u16* projp = uni(p.proj);
  switch (s) {
    case 0: norm_phase(gp, l, 0, l == 0, false); break;
    case 1: gemm_phase<EPI_PROJ, 2>(gp, l, smem, hnp, 1024, W + WO_IN, 1024, 1024, 288, even ? 15 : 12, 0); break;
    case 2: mixer_phase(gp, l, smem); break;
    case 3: finalize_phase(gp, l); break;
    case 4: gemm_phase<EPI_RES, 1>(gp, l, smem, hnp, 1024, W + WO_OUT, 1024, 1024, 288, 8, 2); break;
    case 5: norm_phase(gp, l, 1, false, false); break;
    case 6: gemm_phase<EPI_FFN, 2>(gp, l, smem, hnp, 1024, W + WO_UP, 1024, 1024, 296, 22, 0); break;
    case 7: gemm_phase<EPI_RES, 1>(gp, l, smem, projp, 2816, W + WO_DN, 2816, 2816, 288, 8, 5); break;
  }
}

__global__ void __launch_bounds__(256, 2) mk(P p, P* gpmem, int ph0, int ph1) {
  __shared__ __attribute__((aligned(16))) char smem[SMEM_BYTES];
  const P* gp = &p;
  if (ph1 - ph0 > 1) {
    cg::grid_group grid = cg::this_grid();
    volatile LAS unsigned* xst = (volatile LAS unsigned*)(smem + SMEM_BYTES - 32);
    if (threadIdx.x == 0) { xst[0] = 0u; xst[1] = 0u; }
    __syncthreads();
    const XcdBarrier xbar = xcd_barrier_post(p.bar, xst);
    for (int ph = ph0; ph < ph1; ++ph) {
      run_phase(gp, ph, smem);
      if (ph + 1 < ph1) { if (ph1 > NPH) grid.sync(); else xcd_barrier(xbar); }
    }
  } else {
    run_phase(gp, ph0, smem);
  }
}

extern "C" void kernel_launch(void* const* d_in, const int* in_sizes, int n_in, void* d_out, int out_size, void* d_ws, size_t ws_size,
                              hipStream_t stream) {
  P p{};
  const float** f = (const float**)&p;
  for (int i = 0; i < 31; ++i) f[i] = (const float*)d_in[i];
  p.out = (float*)d_out;
  char* ws = (char*)d_ws;
  size_t off = 0;
  p.hn = (u16*)(ws + off); off += (size_t)NT_ * 1024 * 2;
  p.proj = (u16*)(ws + off); off += (size_t)NT_ * EVN * 2;
  p.ot1 = (u16*)(ws + off); off += (size_t)NT_ * 512 * 2;
  p.wt = (u16*)(ws + off); off += 4 * LW * 2;
  p.mods = (float*)(ws + off); off += 4 * 9 * 6144 * 4;
  p.rope = (float*)(ws + off); off += 64 * 16 * 2 * 4;
  P* gp = (P*)(ws + off); off += 4096;
  p.cnt = (int*)(ws + off); off += 256;
  p.flags = (int*)(ws + off); off += 8 * 8320 * 4;
  off = (off + 255) & ~(size_t)255;
  p.ring = ws + off; off += (size_t)128 * RING * SLOT_BYTES;
  p.bar = (unsigned*)(ws + off); off += XCD_BAR_WORDS * 4;
  static int grid_blocks = 0;
  if (!grid_blocks) {
    int dev = 0, cus = 0, per_cu = 0;
    hipGetDevice(&dev);
    hipDeviceGetAttribute(&cus, hipDeviceAttributeMultiprocessorCount, dev);
    hipOccupancyMaxActiveBlocksPerMultiprocessor(&per_cu, mk, 256, 0);
    if (per_cu < 1) per_cu = 1;
    if (per_cu > 2) per_cu = 2;
    grid_blocks = cus * per_cu;
  }
#if MK_MULTI
  for (int ph = 0; ph < NPH; ++ph) {
    int a = ph, b = ph + 1;
    hipLaunchKernelGGL(mk, dim3(grid_blocks), dim3(256), 0, stream, p, gp, a, b);
  }
#else
  hipMemsetAsync(p.bar, 0, XCD_BAR_WORDS * 4, stream);
  int ph0 = 0, ph1 = NPH;
  void* args[] = {&p, &gp, &ph0, &ph1};
  hipError_t e = hipLaunchCooperativeKernel((void*)mk, dim3(grid_blocks), dim3(256), args, 0, stream);
  if (e != hipSuccess) fprintf(stderr, "cooperative launch failed: %s (grid %d)\n", hipGetErrorString(e), grid_blocks);
#endif
}
```
